# Optimizing an MI355X kernel written in HIP

```python
import math
import jax, jax.numpy as jnp
from jax import lax
import numpy as np

D_MODEL = 2048
BATCH = 2
SEQ = 16384
DEPTH = 1

GRID_W = 64
CTX_LEN = 256
NORM_EPS = 1e-6
S5_WIDTH = 1024
S5_GROUP = 16
S5_GROUPS = S5_WIDTH // S5_GROUP
S5_STATE = 64
SCAN_CHUNK = 128
S5_DT_MIN = 1e-3
S5_DT_MAX = 1e-1
HY_WIDTH = 1024
HY_ORDER = 2
HY_SHORT = 3
HY_EMB = 33
HY_BANDS = (HY_EMB - 1) // 2
HY_FFN = 64
HY_FILT = 2 * HY_ORDER * HY_WIDTH
HY_DECAY_MIN = -math.log(1e-2) / 1.5
HY_DECAY_MAX = -math.log(1e-2) / 0.3
HY_NORM_EPS = 1e-6
IN_COLS = S5_WIDTH + 3 * HY_WIDTH + 2 * D_MODEL
N_EXPERTS = 32
TOP_K = 4
D_EXPERT = 2048
SWIGLU_LIMIT = 7.0
SWIGLU_ALPHA = 1.702
EXPERT_BLOCK = 256

kernel_name = 'hybrid_s5_hyena_moe_diffusion_block'


def rms_norm(x, g):
    xf = x.astype(jnp.float32)
    y = xf * lax.rsqrt(jnp.mean(xf * xf, axis=-1, keepdims=True) + NORM_EPS)
    return (y * g.astype(jnp.float32)).astype(x.dtype)


def modulate(x, shift, scale):
    return x * (1 + scale) + shift


def to_col_major(z):
    b, n, ch = z.shape
    rows = n // GRID_W
    return z.reshape(b, rows, GRID_W, ch).swapaxes(1, 2).reshape(b, n, ch)


def from_col_major(z):
    b, n, ch = z.shape
    rows = n // GRID_W
    return z.reshape(b, GRID_W, rows, ch).swapaxes(1, 2).reshape(b, n, ch)


def _scan_combine(left, right):
    a_l, b_l = left
    a_r, b_r = right
    return a_l * a_r, a_r * b_l + b_r


def s5_scan(u, lam_bar, b_bar, c_out, s0):
    bsz, seqlen = u.shape[0], u.shape[1]
    n_chunks = seqlen // SCAN_CHUNK
    u_chunks = u.reshape(bsz, n_chunks, SCAN_CHUNK, S5_GROUPS, S5_GROUP).swapaxes(0, 1)
    a = jnp.broadcast_to(lam_bar, (bsz, SCAN_CHUNK, S5_GROUPS, S5_STATE))

    def step(s, u_blk):
        bu = jnp.einsum('btgc,gpc->btgp', u_blk.astype(jnp.complex64), b_bar)
        a_cum, b_cum = lax.associative_scan(_scan_combine, (a, bu), axis=1)
        states = b_cum + a_cum * s[:, None]
        y = jnp.einsum('btgp,gcp->btgc', states, c_out).real
        return states[:, -1], y

    s_last, y = lax.scan(step, s0, u_chunks)
    return y.swapaxes(0, 1).reshape(bsz, seqlen, S5_WIDTH), s_last


def s5_discretise(lam_re, lam_im, log_dt, b_re, b_im, c_re, c_im):
    lam = lax.complex(lam_re.astype(jnp.float32), lam_im.astype(jnp.float32))
    dt = jnp.exp(log_dt.astype(jnp.float32))[:, None]
    lam_bar = jnp.exp(lam * dt)
    b = lax.complex(b_re.astype(jnp.float32), b_im.astype(jnp.float32))
    b_bar = ((lam_bar - 1) / lam)[..., None] * b
    c_out = lax.complex(c_re.astype(jnp.float32), c_im.astype(jnp.float32))
    return lam_bar, b_bar, c_out


def s5_branch(ua, uca, lam_re, lam_im, log_dt, b_re, b_im, c_re, c_im, d_skip, w_glu, ctx_out):
    out_dtype = ua.dtype
    fwd = s5_discretise(lam_re[0], lam_im[0], log_dt[0], b_re[0], b_im[0], c_re[0], c_im[0])
    bwd = s5_discretise(lam_re[1], lam_im[1], log_dt[1], b_re[1], b_im[1], c_re[1], c_im[1])
    u_lat = ua.astype(jnp.float32)
    u_ctx = uca.astype(jnp.float32)

    def grouped(u):
        return u.reshape(u.shape[0], u.shape[1], S5_GROUPS, S5_GROUP)

    s0 = jnp.zeros((u_ctx.shape[0], S5_GROUPS, S5_STATE), jnp.complex64)
    yc_f, sc_f = s5_scan(grouped(u_ctx), *fwd, s0)
    yc_b, sc_b = s5_scan(grouped(u_ctx[:, ::-1]), *bwd, s0)
    yl_f, _ = s5_scan(grouped(u_lat), *fwd, sc_f)
    yl_b, _ = s5_scan(grouped(u_lat[:, ::-1]), *bwd, sc_b)
    d = d_skip.astype(jnp.float32)
    wg = w_glu.astype(jnp.float32)

    def readout(y, u):
        y = jax.nn.gelu(y + u * d)
        return (y * jax.nn.sigmoid(y @ wg)).astype(out_dtype)

    y_lat = readout(yl_f + yl_b[:, ::-1], u_lat)
    y_ctx = readout(yc_f + yc_b[:, ::-1], u_ctx) if ctx_out else None
    return y_lat, y_ctx


def short_conv(z, w):
    ch = z.shape[-1]
    return lax.conv_general_dilated(z, w[:, None, :], window_strides=(1,),
                                    padding=[(HY_SHORT // 2, HY_SHORT // 2)],
                                    dimension_numbers=('NWC', 'WIO', 'NWC'),
                                    feature_group_count=ch)


def hyena_kernel_fft(seqlen, w1, b1, f1, w2, b2, f2, w3, b3, decay):
    f32 = jnp.float32
    t_idx = jnp.arange(seqlen, dtype=f32)
    t = t_idx / (seqlen - 1)
    bands = jnp.linspace(1e-4, HY_BANDS - 1, HY_BANDS, dtype=f32)
    ang = (2 * jnp.pi / seqlen) * t_idx[:, None] * bands[None, :]
    feats = jnp.concatenate([t[:, None], jnp.cos(ang), -jnp.sin(ang)], axis=-1)
    hid = jnp.sin(f1.astype(f32) * (feats @ w1.astype(f32) + b1.astype(f32)))
    hid = jnp.sin(f2.astype(f32) * (hid @ w2.astype(f32) + b2.astype(f32)))
    filt = (hid @ w3.astype(f32) + b3.astype(f32)) * jnp.exp(-t[:, None] * jnp.abs(decay.astype(f32)))
    filt = filt.reshape(seqlen, 2, HY_ORDER, HY_WIDTH)
    two_sided = jnp.concatenate([filt[:, 0], jnp.zeros((1, HY_ORDER, HY_WIDTH), f32),
                                 filt[:0:-1, 1]], axis=0)
    two_sided = two_sided / (jnp.sum(jnp.abs(two_sided), axis=0, keepdims=True) + HY_NORM_EPS)
    return jnp.fft.rfft(two_sided, axis=0)


def fft_conv(z, k_f, bias):
    seqlen = z.shape[1]
    n = 2 * seqlen
    y = jnp.fft.irfft(jnp.fft.rfft(z, n=n, axis=1) * k_f[None], n=n, axis=1)[:, :seqlen]
    return y + z * bias


def hyena_branch(z_in, short_w, w1, b1, f1, w2, b2, f2, w3, b3, decay, hy_bias):
    out_dtype = z_in.dtype
    seqlen = z_in.shape[1]
    z = short_conv(z_in, short_w.astype(out_dtype)).astype(jnp.float32)
    v, x1, x2 = jnp.split(z, 3, axis=-1)
    k_f = hyena_kernel_fft(seqlen, w1, b1, f1, w2, b2, f2, w3, b3, decay)
    bias = hy_bias.astype(jnp.float32)
    y = x1 * fft_conv(v, k_f[:, 0], bias[0])
    y = x2 * fft_conv(y, k_f[:, 1], bias[1])
    return y.astype(out_dtype)


def merge_branches(ya, yh, ug, w_bs5, w_bhy, w_o):
    ga, gh = jnp.split(jax.nn.sigmoid(ug), 2, axis=-1)
    return (ga * (ya @ w_bs5) + gh * (yh @ w_bhy)) @ w_o


def moe_ffn(h, router_w, router_b, w_gate_up, b_gate_up, w_down, b_down):
    n_tok, d = h.shape
    logits = (h @ router_w + router_b).astype(jnp.float32)
    top_val, top_idx = lax.top_k(logits, TOP_K)
    gates = jax.nn.softmax(top_val, axis=-1)
    n_assign = n_tok * TOP_K
    flat_e = top_idx.reshape(-1).astype(jnp.int32)
    flat_tok = jnp.arange(n_assign, dtype=jnp.int32) // TOP_K
    order = jnp.argsort(flat_e)
    e_sorted = flat_e[order]
    counts = jnp.bincount(flat_e, length=N_EXPERTS).astype(jnp.int32)
    padded = (counts + EXPERT_BLOCK - 1) // EXPERT_BLOCK * EXPERT_BLOCK
    start = jnp.cumsum(counts) - counts
    padded_end = jnp.cumsum(padded)
    padded_start = padded_end - padded
    dest = padded_start[e_sorted] + jnp.arange(n_assign, dtype=jnp.int32) - start[e_sorted]
    n_blocks = -(-n_assign // EXPERT_BLOCK) + N_EXPERTS
    cap = n_blocks * EXPERT_BLOCK
    slot_tok = jnp.full((cap,), n_tok, jnp.int32).at[dest].set(flat_tok[order])
    slot_gate = jnp.zeros((cap,), jnp.float32).at[dest].set(gates.reshape(-1)[order])
    block_start = jnp.arange(n_blocks, dtype=jnp.int32) * EXPERT_BLOCK
    block_expert = jnp.minimum(jnp.searchsorted(padded_end, block_start, side='right'),
                               N_EXPERTS - 1).astype(jnp.int32)
    h_pad = jnp.concatenate([h, jnp.zeros((1, d), h.dtype)], axis=0)

    def expert_block(acc, blk):
        tok, gate, e = blk
        gu = h_pad[tok] @ w_gate_up[e] + b_gate_up[e]
        glu = jnp.minimum(gu[:, 0::2], SWIGLU_LIMIT)
        lin = jnp.clip(gu[:, 1::2], -SWIGLU_LIMIT, SWIGLU_LIMIT)
        act = glu * jax.nn.sigmoid(SWIGLU_ALPHA * glu) * (lin + 1)
        y = act @ w_down[e] + b_down[e]
        return acc.at[tok].add(y * gate[:, None].astype(y.dtype)), None

    acc, _ = lax.scan(expert_block, jnp.zeros((n_tok + 1, d), h.dtype),
                      (slot_tok.reshape(n_blocks, EXPERT_BLOCK),
                       slot_gate.reshape(n_blocks, EXPERT_BLOCK), block_expert))
    return acc[:n_tok]


def setup_inputs(seed: int = 0) -> dict:
    key = jax.random.key(seed)
    ks = iter(jax.random.split(key, 48))
    f32 = jnp.float32

    def nrm(shape, scale):
        return scale * jax.random.normal(next(ks), shape, f32)

    def unif(shape, lo, hi):
        return jax.random.uniform(next(ks), shape, f32, lo, hi)

    L, G, P, GS = DEPTH, S5_GROUPS, S5_STATE, S5_GROUP
    lam_im_base = jnp.pi * jnp.arange(P, dtype=f32)
    return {
        'x': nrm((BATCH, SEQ, D_MODEL), 1.0),
        'c': nrm((BATCH, D_MODEL), 1.0),
        'ctx': nrm((BATCH, CTX_LEN, D_MODEL), 1.0),
        'c_ctx': nrm((D_MODEL,), 1.0),
        'w_ada': nrm((L, D_MODEL, 6 * D_MODEL), 0.5 * D_MODEL ** -0.5),
        'b_ada': nrm((L, 6 * D_MODEL), 0.02),
        'norm1_g': 1.0 + nrm((L, D_MODEL), 0.01),
        'norm2_g': 1.0 + nrm((L, D_MODEL), 0.01),
        'w_in': nrm((L, D_MODEL, IN_COLS), D_MODEL ** -0.5),
        's5_lam_re': -0.5 * jnp.exp(nrm((L, 2, G, P), 0.05)),
        's5_lam_im': lam_im_base + nrm((L, 2, G, P), 0.01),
        's5_log_dt': unif((L, 2, G), math.log(S5_DT_MIN), math.log(S5_DT_MAX)),
        's5_b_re': nrm((L, 2, G, P, GS), (2 * GS) ** -0.5),
        's5_b_im': nrm((L, 2, G, P, GS), (2 * GS) ** -0.5),
        's5_c_re': nrm((L, 2, G, GS, P), (2 * P) ** -0.5),
        's5_c_im': nrm((L, 2, G, GS, P), (2 * P) ** -0.5),
        's5_d': nrm((L, S5_WIDTH), 1.0),
        's5_w_glu': nrm((L, S5_WIDTH, S5_WIDTH), S5_WIDTH ** -0.5),
        'hy_short_w': nrm((L, HY_SHORT, 3 * HY_WIDTH), HY_SHORT ** -0.5),
        'hy_pos_w1': nrm((L, HY_EMB, HY_FFN), HY_EMB ** -0.5),
        'hy_pos_b1': nrm((L, HY_FFN), 0.1),
        'hy_freq1': 1.0 + nrm((L, HY_FFN), 0.1),
        'hy_pos_w2': nrm((L, HY_FFN, HY_FFN), HY_FFN ** -0.5),
        'hy_pos_b2': nrm((L, HY_FFN), 0.1),
        'hy_freq2': 1.0 + nrm((L, HY_FFN), 0.1),
        'hy_pos_w3': nrm((L, HY_FFN, HY_FILT), HY_FFN ** -0.5),
        'hy_pos_b3': nrm((L, HY_FILT), 0.02),
        'hy_decay': unif((L, HY_FILT), HY_DECAY_MIN, HY_DECAY_MAX),
        'hy_bias': nrm((L, HY_ORDER, HY_WIDTH), 1.0),
        'w_branch_s5': nrm((L, S5_WIDTH, D_MODEL), S5_WIDTH ** -0.5),
        'w_branch_hy': nrm((L, HY_WIDTH, D_MODEL), HY_WIDTH ** -0.5),
        'w_out': nrm((L, D_MODEL, D_MODEL), D_MODEL ** -0.5),
        'router_w': nrm((L, D_MODEL, N_EXPERTS), D_MODEL ** -0.5),
        'router_b': nrm((L, N_EXPERTS), 0.01),
        'w_gate_up': nrm((L, N_EXPERTS, D_MODEL, 2 * D_EXPERT), D_MODEL ** -0.5),
        'b_gate_up': nrm((L, N_EXPERTS, 2 * D_EXPERT), 0.01),
        'w_down': nrm((L, N_EXPERTS, D_EXPERT, D_MODEL), D_EXPERT ** -0.5),
        'b_down': nrm((L, N_EXPERTS, D_MODEL), 0.01),
        'final_g': 1.0 + nrm((D_MODEL,), 0.01),
    }


def reference(x, c, ctx, c_ctx, w_ada, b_ada, norm1_g, norm2_g, w_in,
              s5_lam_re, s5_lam_im, s5_log_dt, s5_b_re, s5_b_im, s5_c_re, s5_c_im,
              s5_d, s5_w_glu, hy_short_w, hy_pos_w1, hy_pos_b1, hy_freq1,
              hy_pos_w2, hy_pos_b2, hy_freq2, hy_pos_w3, hy_pos_b3, hy_decay, hy_bias,
              w_branch_s5, w_branch_hy, w_out, router_w, router_b,
              w_gate_up, b_gate_up, w_down, b_down, final_g):
    h, hc = x, ctx
    for i in range(DEPTH):
        last = i + 1 == DEPTH
        mod = jax.nn.silu(c) @ w_ada[i] + b_ada[i]
        sh1, sc1, g1, sh2, sc2, g2 = [m[:, None, :] for m in jnp.split(mod, 6, axis=-1)]
        mod_c = jax.nn.silu(c_ctx) @ w_ada[i] + b_ada[i]
        csh1, csc1, cg1, csh2, csc2, cg2 = jnp.split(mod_c, 6, axis=-1)
        filt_p = (hy_pos_w1[i], hy_pos_b1[i], hy_freq1[i], hy_pos_w2[i], hy_pos_b2[i],
                  hy_freq2[i], hy_pos_w3[i], hy_pos_b3[i], hy_decay[i], hy_bias[i])

        u = modulate(rms_norm(h, norm1_g[i]), sh1, sc1)
        uc = modulate(rms_norm(hc, norm1_g[i]), csh1, csc1)
        ua, uh, ug = jnp.split(u @ w_in[i], [S5_WIDTH, S5_WIDTH + 3 * HY_WIDTH], axis=-1)
        if last:
            uca = uc @ w_in[i][:, :S5_WIDTH]
        else:
            uca, uch, ucg = jnp.split(uc @ w_in[i], [S5_WIDTH, S5_WIDTH + 3 * HY_WIDTH], axis=-1)
        ya, yca = s5_branch(ua, uca, s5_lam_re[i], s5_lam_im[i], s5_log_dt[i],
                            s5_b_re[i], s5_b_im[i], s5_c_re[i], s5_c_im[i],
                            s5_d[i], s5_w_glu[i], not last)
        yh = from_col_major(hyena_branch(to_col_major(uh), hy_short_w[i], *filt_p))
        h = h + g1 * merge_branches(ya, yh, ug, w_branch_s5[i], w_branch_hy[i], w_out[i])

        hm = modulate(rms_norm(h, norm2_g[i]), sh2, sc2)
        h = h + g2 * moe_ffn(hm.reshape(-1, D_MODEL), router_w[i], router_b[i], w_gate_up[i],
                             b_gate_up[i], w_down[i], b_down[i]).reshape(h.shape)

        if not last:
            ych = hyena_branch(uch, hy_short_w[i], *filt_p)
            hc = hc + cg1 * merge_branches(yca, ych, ucg, w_branch_s5[i], w_branch_hy[i], w_out[i])
            hcm = modulate(rms_norm(hc, norm2_g[i]), csh2, csc2)
            hc = hc + cg2 * moe_ffn(hcm.reshape(-1, D_MODEL), router_w[i], router_b[i], w_gate_up[i],
                                    b_gate_up[i], w_down[i], b_down[i]).reshape(hc.shape)
    return rms_norm(h, final_g)
```

```cpp
#include <hip/hip_runtime.h>
#include <cstdio>
#include <cstdint>

#define GAS __attribute__((address_space(1)))
#define LAS __attribute__((address_space(3)))
typedef unsigned short bf16;
typedef short bf16x8 __attribute__((ext_vector_type(8)));
typedef float f32x4 __attribute__((ext_vector_type(4)));
typedef float f32x16 __attribute__((ext_vector_type(16)));
typedef float f32x2 __attribute__((ext_vector_type(2)));
typedef unsigned u32x4 __attribute__((ext_vector_type(4)));
typedef unsigned u32x2 __attribute__((ext_vector_type(2)));
typedef int i32x4 __attribute__((ext_vector_type(4)));
typedef int i32x8 __attribute__((ext_vector_type(8)));

constexpr int D = 2048, NB = 2, SEQ = 16384, NTOK = NB * SEQ, CTX = 256, NCTX = NB * CTX;
constexpr int S5W = 1024, HYW = 1024, INC = 8192, NEXP = 32, TOPK = 4, DEXP = 2048;
constexpr int NCH = 260;
constexpr int LISTCAP = 32768;

constexpr size_t MiB = 1u << 20;
constexpr size_t WS_CTL = 0, CTL_ZERO_BYTES = 1 * MiB;
constexpr size_t WS_MOD = 6 * MiB;
constexpr size_t WS_BBT = 7 * MiB;
constexpr size_t WS_CTT = WS_BBT + 512 * 1024;
constexpr size_t WS_LAM = 8 * MiB;
constexpr size_t WS_RWT = 8 * MiB + 256 * 1024;
constexpr size_t WS_BB2 = 8 * MiB + 512 * 1024;
constexpr size_t WS_WIN = 16 * MiB;
constexpr size_t WS_WGLU = 48 * MiB;
constexpr size_t WS_WBS5 = 50 * MiB;
constexpr size_t WS_WBHY = 54 * MiB;
constexpr size_t WS_WO = 58 * MiB;
constexpr size_t WS_WGU = 66 * MiB;
constexpr size_t WS_WDN = 578 * MiB;
constexpr size_t WS_U = 834 * MiB;
constexpr size_t WS_UCA = 964 * MiB;
constexpr size_t WS_UA = 966 * MiB;
constexpr size_t WS_UH = 1030 * MiB;
constexpr size_t WS_UG = 1222 * MiB;
constexpr size_t WS_E = 1478 * MiB;
constexpr size_t WS_SIN = 1511 * MiB;
constexpr size_t WS_FILT = 1544 * MiB;
constexpr size_t WS_HYS = 1800 * MiB;
constexpr size_t HYS_STRIDE = 768 * 1024;
constexpr size_t WS_YHCM = 1992 * MiB;
constexpr size_t WS_YH = 2056 * MiB;
constexpr size_t WS_Y = 2120 * MiB;
constexpr size_t WS_YA = 2184 * MiB;
constexpr size_t WS_T1 = 2248 * MiB;
constexpr size_t WS_T = 2376 * MiB;
constexpr size_t WS_HM = 2504 * MiB;
constexpr size_t WS_GATE = 2632 * MiB;
constexpr size_t WS_LIST = 2633 * MiB;
constexpr size_t WS_ACT = 2638 * MiB;
constexpr size_t WS_YS = 3182 * MiB;
constexpr size_t WS_H1 = 3694 * MiB;
constexpr size_t WS_HM8 = WS_T1;
constexpr size_t WS_U8 = WS_ACT;
constexpr size_t WS_WIN8 = WS_YS;
constexpr size_t WS_END = 3950 * MiB;

constexpr int CW_TMO = 0;
constexpr int CW_Q4 = 64;
constexpr int CW_CNT = 128;
constexpr int CW_BAR = 4096;

constexpr int RING_BYTES = 131072;
constexpr int LDS_X = 131072;
constexpr int MISC_OFF = 147456 - 512;
constexpr int LDS_BYTES = 147456;
constexpr int NWAVES = 8, NTHR = 512;
constexpr int NPHASE = 14;

__device__ __forceinline__ unsigned f2bf(float f) { unsigned u = __builtin_bit_cast(unsigned, f); return (u + 0x7fffu + ((u >> 16) & 1u)) >> 16; }
__device__ __forceinline__ unsigned pk2(float lo, float hi) { return f2bf(lo) | (f2bf(hi) << 16); }
__device__ __forceinline__ float bf2f(unsigned short b) { return __builtin_bit_cast(float, ((unsigned)b) << 16); }
__device__ __forceinline__ float bflo(unsigned w) { return __builtin_bit_cast(float, w << 16); }
__device__ __forceinline__ float bfhi(unsigned w) { return __builtin_bit_cast(float, w & 0xffff0000u); }
typedef __bf16 bf16x2_t __attribute__((ext_vector_type(2)));
__device__ __forceinline__ unsigned cvt_pk_bf16(float lo, float hi) { const f32x2 v = {lo, hi}; const bf16x2_t b = __builtin_convertvector(v, bf16x2_t); return __builtin_bit_cast(unsigned, b); }
__device__ __forceinline__ unsigned pk4_fp8(float a, float b, float c, float d) { unsigned w = 0u; w = (unsigned)__builtin_amdgcn_cvt_pk_fp8_f32(a, b, (int)w, false); w = (unsigned)__builtin_amdgcn_cvt_pk_fp8_f32(c, d, (int)w, true); return w; }
constexpr float W8SCALE = 64.0f;
__device__ __forceinline__ float sigmoidf_(float x) { return __builtin_amdgcn_rcpf(1.0f + __expf(-x)); }
__device__ __forceinline__ float sin_rev(float r) { return __builtin_amdgcn_sinf(__builtin_amdgcn_fractf(r)); }
__device__ __forceinline__ float cos_rev(float r) { return __builtin_amdgcn_cosf(__builtin_amdgcn_fractf(r)); }
__device__ __forceinline__ float wave_sum(float v) {
#pragma unroll
    for (int o = 1; o < 64; o <<= 1) v += __shfl_xor(v, o);
    return v;
}
__device__ __forceinline__ float wave_max(float v) {
#pragma unroll
    for (int o = 1; o < 64; o <<= 1) v = fmaxf(v, __shfl_xor(v, o));
    return v;
}
__device__ __forceinline__ f32x2 cmul(f32x2 a, f32x2 b) { return (f32x2){a.x * b.x - a.y * b.y, a.x * b.y + a.y * b.x}; }
#define LDS_WAIT() asm volatile("s_waitcnt lgkmcnt(0)" ::: "memory")
#define VM_WAIT() asm volatile("s_waitcnt vmcnt(0)" ::: "memory")

namespace pg8 {
constexpr int BM = 256, BK = 64, HALF = 128, HTB = HALF * BK * 2, STAGE_BYTES = 8 * HTB;
__host__ __device__ __forceinline__ int lds_byte(int r, int c) { const int st = (r >> 4) * 2 + (c >> 5), rr = r & 15, cc = c & 31, ob = rr * 64 + cc * 2; return st * 1024 + (ob ^ (((ob >> 9) & 1) << 5)); }
__host__ __device__ __forceinline__ void stage_rc(int b, int& R, int& C) { const int st = b / 1024, sb = b % 1024, swz = sb ^ (((sb >> 9) & 1) << 5); R = (st >> 1) * 16 + swz / 64; C = (st & 1) * 32 + (swz % 64) / 2; }
__host__ __device__ __forceinline__ int perm32(int rho) { const int n = rho >> 4, i = rho & 15; return 8 * (i >> 2) + 4 * n + (i & 3); }

struct Unit { int pm, pn, e, valid; };

template <class Epi, class Sched>
__device__ __forceinline__ void gemm_phase(LAS unsigned char* lds, const int Kel, const Sched& S, const Epi& E) {
    const int tid = threadIdx.x, wid = __builtin_amdgcn_readfirstlane(tid >> 6), lane = tid & 63, wr = wid >> 2, wc = wid & 3, fr = lane & 15, fq = lane >> 4;
    const int K = Epi::FP8 ? (Kel >> 1) : Kel;
    const int nt = K / BK;
    int Rs[2], Cs[2]; unsigned voffB[2];
#pragma unroll
    for (int i = 0; i < 2; ++i) { int R, C; stage_rc(tid * 16 + i * 8192, R, C); Rs[i] = R; Cs[i] = C; const int Rb = Epi::PERM ? ((R & ~31) + perm32(R & 31)) : R; voffB[i] = (unsigned)(Rb * K + C) * 2u; }
    const size_t kstep = (size_t)(BK * 2);
    const size_t hstep = (size_t)HALF * K * 2;
    const unsigned ldsw = (unsigned)wid * 1024u;
    const int aoff = lds_byte(wr * 64 + fr, fq * 8), boff = lds_byte(wc * 32 + fr, fq * 8);
    const int aoff8 = lds_byte(wr * 64 + fr, fq * 16), boff8 = lds_byte(wc * 32 + fr, fq * 16);
#define PG8_SA(b, h) (((b) * 2 + (h)) * HTB)
#define PG8_SB(b, h) ((4 + (b) * 2 + (h)) * HTB)
#define PG8_STAGE(bufoff, gbase, voff) do { _Pragma("unroll") for (int _i = 0; _i < 2; ++_i) \
        __builtin_amdgcn_global_load_lds((const unsigned*)((const char*)(gbase) + (voff)[_i]), (LAS unsigned*)(lds + (bufoff) + ldsw + _i * 8192), 16, 0, 0); } while (0)
#define PG8_LDA(dst, b, h) do { if constexpr (Epi::FP8) { _Pragma("unroll") for (int m = 0; m < 4; ++m) dst##8[m] = *(const LAS i32x8*)(lds + PG8_SA(b, h) + aoff8 + m * 2048); } \
        else { _Pragma("unroll") for (int m = 0; m < 4; ++m) _Pragma("unroll") for (int k = 0; k < 2; ++k) dst[m][k] = *(const LAS bf16x8*)(lds + PG8_SA(b, h) + aoff + m * 2048 + k * 1024); } } while (0)
#define PG8_LDB(dst, b, h) do { if constexpr (Epi::FP8) { _Pragma("unroll") for (int n = 0; n < 2; ++n) dst##8[n] = *(const LAS i32x8*)(lds + PG8_SB(b, h) + boff8 + n * 2048); } \
        else { _Pragma("unroll") for (int n = 0; n < 2; ++n) _Pragma("unroll") for (int k = 0; k < 2; ++k) dst[n][k] = *(const LAS bf16x8*)(lds + PG8_SB(b, h) + boff + n * 2048 + k * 1024); } } while (0)
#define PG8_MMA(ai, bj, At, Bt) do { __builtin_amdgcn_s_setprio(1); \
        if constexpr (Epi::FP8) { _Pragma("unroll") for (int m = 0; m < 4; ++m) _Pragma("unroll") for (int n = 0; n < 2; ++n) \
            asm volatile("v_mfma_scale_f32_16x16x128_f8f6f4 %0, %1, %2, %0, %3, %3 op_sel_hi:[0,0,0]" : "+v"(acc[ai][bj][m][n]) : "v"(Bt##8[n]), "v"(At##8[m]), "v"(scl1)); } \
        else { _Pragma("unroll") for (int m = 0; m < 4; ++m) _Pragma("unroll") for (int n = 0; n < 2; ++n) _Pragma("unroll") for (int k = 0; k < 2; ++k) \
        acc[ai][bj][m][n] = Epi::TRANS ? __builtin_amdgcn_mfma_f32_16x16x32_bf16(Bt[n][k], At[m][k], acc[ai][bj][m][n], 0, 0, 0) \
                                       : __builtin_amdgcn_mfma_f32_16x16x32_bf16(At[m][k], Bt[n][k], acc[ai][bj][m][n], 0, 0, 0); } __builtin_amdgcn_s_setprio(0); } while (0)
#define PG8_WAIT_V(n) asm volatile("s_waitcnt vmcnt(" #n ")" ::: "memory")
#define PG8_WAIT_L(n) asm volatile("s_waitcnt lgkmcnt(" #n ")" ::: "memory")
#define PG8_BAR __builtin_amdgcn_s_barrier()
#define PG8_SCHED __builtin_amdgcn_sched_barrier(0)
    Unit cur, nxt; int ui = 0;
    if (!S.next(0, cur)) return;
    f32x4 acc[2][2][4][2];
#pragma unroll
    for (int a = 0; a < 2; ++a)
#pragma unroll
        for (int b = 0; b < 2; ++b)
#pragma unroll
            for (int m = 0; m < 4; ++m)
#pragma unroll
                for (int n = 0; n < 2; ++n) acc[a][b][m][n] = (f32x4){0.f, 0.f, 0.f, 0.f};
    bf16x8 At[4][2], B0[2][2], B1[2][2]; i32x8 At8[4], B08[2], B18[2]; const int scl1 = 0x7F7F7F7F;
    const char* const Ab = S.a_base();
    const char* cB = S.b_base(cur);
    unsigned vC0[2], vC1[2];
#pragma unroll
    for (int i = 0; i < 2; ++i) { vC0[i] = (S.a_row(cur, Rs[i]) * (unsigned)K + (unsigned)Cs[i]) * 2u; vC1[i] = (S.a_row(cur, HALF + Rs[i]) * (unsigned)K + (unsigned)Cs[i]) * 2u; }
    PG8_STAGE(PG8_SB(0, 0), cB, voffB); PG8_STAGE(PG8_SB(0, 1), cB + hstep, voffB); PG8_STAGE(PG8_SA(0, 0), Ab, vC0); PG8_STAGE(PG8_SA(0, 1), Ab, vC1);
    if (wr == 1) PG8_BAR;
    PG8_WAIT_V(2); PG8_BAR;
    PG8_STAGE(PG8_SB(1, 0), cB + kstep, voffB); PG8_STAGE(PG8_SA(1, 0), Ab + kstep, vC0); PG8_STAGE(PG8_SB(1, 1), cB + hstep + kstep, voffB);
    PG8_WAIT_V(6); PG8_BAR;
    for (;;) {
        const bool has_next = S.next(ui + 1, nxt);
        const char* nB = has_next ? S.b_base(nxt) : cB;
        for (int t = 0; t < nt; t += 2) {
            const bool last = (t == nt - 2);
            const char* a1 = Ab + (size_t)(t + 1) * kstep;
            const char* a2 = last ? Ab : Ab + (size_t)(t + 2) * kstep; const char* b2 = last ? nB : cB + (size_t)(t + 2) * kstep;
            const char* a3 = a2 + kstep; const char* b3 = b2 + kstep;
            unsigned vX0[2], vX1[2];
            if (last && has_next) {
#pragma unroll
                for (int i = 0; i < 2; ++i) { vX0[i] = (S.a_row(nxt, Rs[i]) * (unsigned)K + (unsigned)Cs[i]) * 2u; vX1[i] = (S.a_row(nxt, HALF + Rs[i]) * (unsigned)K + (unsigned)Cs[i]) * 2u; }
            } else {
#pragma unroll
                for (int i = 0; i < 2; ++i) { vX0[i] = vC0[i]; vX1[i] = vC1[i]; }
            }
            PG8_LDB(B0, 0, 0); PG8_LDB(B1, 0, 1); PG8_SCHED; PG8_LDA(At, 0, 0); PG8_STAGE(PG8_SA(1, 1), a1, vC1);
            PG8_WAIT_V(8); PG8_WAIT_L(0); PG8_BAR; PG8_MMA(0, 0, At, B0); PG8_MMA(0, 1, At, B1); PG8_BAR; PG8_SCHED;
            PG8_LDA(At, 0, 1); PG8_STAGE(PG8_SB(0, 0), b2, voffB); PG8_STAGE(PG8_SB(0, 1), b2 + hstep, voffB); PG8_STAGE(PG8_SA(0, 0), a2, vX0);
            PG8_WAIT_V(8); PG8_WAIT_L(0); PG8_BAR; PG8_MMA(1, 0, At, B0); PG8_MMA(1, 1, At, B1); PG8_BAR; PG8_SCHED;
            PG8_LDB(B0, 1, 0); PG8_LDB(B1, 1, 1); PG8_SCHED; PG8_LDA(At, 1, 0); PG8_STAGE(PG8_SA(0, 1), a2, vX1);
            PG8_WAIT_V(8); PG8_WAIT_L(0); PG8_BAR; PG8_MMA(0, 0, At, B0); PG8_MMA(0, 1, At, B1); PG8_BAR; PG8_SCHED;
            PG8_LDA(At, 1, 1); PG8_STAGE(PG8_SB(1, 0), b3, voffB); PG8_STAGE(PG8_SB(1, 1), b3 + hstep, voffB); PG8_STAGE(PG8_SA(1, 0), a3, vX0);
            PG8_WAIT_V(8); PG8_WAIT_L(0); PG8_BAR; PG8_MMA(1, 0, At, B0); PG8_MMA(1, 1, At, B1); PG8_BAR; PG8_SCHED;
            if (last) {
#pragma unroll
                for (int i = 0; i < 2; ++i) { vC0[i] = vX0[i]; vC1[i] = vX1[i]; }
            }
        }
        if (wr == 0) PG8_BAR;
        if constexpr (Epi::FP8) asm volatile("s_nop 15\n\ts_nop 15" ::: "memory");
        E(acc, cur, wr, wc, fr, fq);
        if (!has_next) break;
#pragma unroll
        for (int a = 0; a < 2; ++a)
#pragma unroll
            for (int b = 0; b < 2; ++b)
#pragma unroll
                for (int m = 0; m < 4; ++m)
#pragma unroll
                    for (int n = 0; n < 2; ++n) acc[a][b][m][n] = (f32x4){0.f, 0.f, 0.f, 0.f};
        cur = nxt; cB = nB; ++ui;
        if (wr == 1) PG8_BAR;
    }
    PG8_WAIT_V(0);
    PG8_BAR;
#undef PG8_SA
#undef PG8_SB
#undef PG8_STAGE
#undef PG8_LDA
#undef PG8_LDB
#undef PG8_MMA
#undef PG8_WAIT_V
#undef PG8_WAIT_L
#undef PG8_BAR
#undef PG8_SCHED
}
}

#define XB_TMO      128
#define XB_XCNT(j)  (256  + 64 * (j))
#define XB_XSUB(j)  (1280 + 64 * (j))
#define XB_XGEN(j)  (2304 + 64 * (j))
#define XB_TOP      3328
#define XB_TOPGEN   3392
#define XCD_BAR_WORDS 3456
#define XB_SPIN_CAP (1u << 22)
__device__ __forceinline__ unsigned xb_ld(unsigned* p)              { return __hip_atomic_load(p, __ATOMIC_RELAXED, __HIP_MEMORY_SCOPE_AGENT); }
__device__ __forceinline__ unsigned xb_add(unsigned* p, unsigned v) { return __hip_atomic_fetch_add(p, v, __ATOMIC_RELAXED, __HIP_MEMORY_SCOPE_AGENT); }
__device__ __forceinline__ unsigned xb_xcc_id() { return (unsigned)__builtin_amdgcn_s_getreg((3 << 11) | 20) & 0xFu; }
#define XB_SPIN(cond, bar) do { unsigned _sp = 0; while (cond) { __builtin_amdgcn_s_sleep(1); \
    if ((++_sp & 255u) == 0u) { if (xb_ld(&(bar)[XB_TMO])) break; if (_sp > XB_SPIN_CAP) { atomicAdd(&(bar)[XB_TMO], 1u); break; } } } } while (0)
struct XcdBarrier { unsigned* bar; unsigned x; volatile LAS unsigned* st; };
__device__ __forceinline__ XcdBarrier xcd_barrier_post(unsigned* bar, volatile LAS unsigned* st) {
    XcdBarrier b; b.bar = bar; b.x = xb_xcc_id(); b.st = st;
    if (threadIdx.x == 0) (void)xb_add(&bar[XB_XCNT(b.x)], 1u);
    return b;
}
__device__ __forceinline__ void xcd_barrier_complete(unsigned* bar, unsigned x, unsigned& nloc, unsigned& nx) {
    const unsigned G = gridDim.x * gridDim.y * gridDim.z;
    unsigned sum, cnt, mine, sp = 0u;
    for (;;) {
        sum = 0u; cnt = 0u; mine = 0u;
#pragma unroll
        for (unsigned j = 0; j < 16; ++j) { const unsigned c = xb_ld(&bar[XB_XCNT(j)]); sum += c; cnt += (c > 0u) ? 1u : 0u; mine = (j == x) ? c : mine; }
        if (sum == G) break;
        __builtin_amdgcn_s_sleep(1);
        if ((++sp & 255u) == 0u) { if (xb_ld(&bar[XB_TMO])) break; if (sp > XB_SPIN_CAP) { atomicAdd(&bar[XB_TMO], 1u); break; } }
    }
    nloc = mine > 0u ? mine : 1u; nx = cnt > 0u ? cnt : 1u;
}
__device__ __forceinline__ void xcd_barrier(const XcdBarrier& b) {
    asm volatile("s_waitcnt vmcnt(0)" ::: "memory");
    __syncthreads();
    if (threadIdx.x == 0) {
        unsigned* bar = b.bar;
        __builtin_amdgcn_s_waitcnt(0);
        unsigned nloc = b.st[0], nx = b.st[1];
        if (nloc == 0u) { xcd_barrier_complete(bar, b.x, nloc, nx); b.st[0] = nloc; b.st[1] = nx; }
        const unsigned old = xb_add(&bar[XB_XSUB(b.x)], 1u);
        const unsigned gen = old / nloc;
        if (old + 1u == (gen + 1u) * nloc) {
            __builtin_amdgcn_fence(__ATOMIC_RELEASE, "agent");
            asm volatile("s_waitcnt vmcnt(0)" ::: "memory");
            const unsigned og = xb_add(&bar[XB_TOP], 1u);
            const unsigned tg = og / nx;
            if (og + 1u == (tg + 1u) * nx) xb_add(&bar[XB_TOPGEN], 1u);
            else XB_SPIN(xb_ld(&bar[XB_TOPGEN]) == tg, bar);
            __builtin_amdgcn_fence(__ATOMIC_ACQUIRE, "agent");
            xb_add(&bar[XB_XGEN(b.x)], 1u);
            asm volatile("s_waitcnt vmcnt(0)" ::: "memory");
        } else {
            XB_SPIN(xb_ld(&bar[XB_XGEN(b.x)]) == gen, bar);
            __builtin_amdgcn_fence(__ATOMIC_ACQUIRE, "agent");
            asm volatile("s_waitcnt vmcnt(0)" ::: "memory");
        }
    }
    __syncthreads();
}

struct Args { const float* in[39]; float* out; unsigned char* ws; int ph_lo, ph_hi; };
struct Frame {
    LAS unsigned char* lds;
    int tid, lane, wave, G, bx;
    const float* const* in; float* out; unsigned char* ws;
    GAS unsigned* ctl;
};
#define IN_X 0
#define IN_C 1
#define IN_CTX 2
#define IN_CCTX 3
#define IN_WADA 4
#define IN_BADA 5
#define IN_N1G 6
#define IN_N2G 7
#define IN_WIN 8
#define IN_LRE 9
#define IN_LIM 10
#define IN_LDT 11
#define IN_BRE 12
#define IN_BIM 13
#define IN_CRE 14
#define IN_CIM 15
#define IN_S5D 16
#define IN_WGLU 17
#define IN_HSW 18
#define IN_HW1 19
#define IN_HB1 20
#define IN_HF1 21
#define IN_HW2 22
#define IN_HB2 23
#define IN_HF2 24
#define IN_HW3 25
#define IN_HB3 26
#define IN_HDEC 27
#define IN_HBIAS 28
#define IN_WBS5 29
#define IN_WBHY 30
#define IN_WO 31
#define IN_RW 32
#define IN_RB 33
#define IN_WGU 34
#define IN_BGU 35
#define IN_WDN 36
#define IN_BDN 37
#define IN_FG 38

__device__ __forceinline__ void p0_adaln_item(Frame& F, int cb) {
    LAS float* sl = (LAS float*)F.lds;
    const float* c = F.in[IN_C]; const float* cc = F.in[IN_CCTX]; const float* W = F.in[IN_WADA];
    for (int i = F.tid; i < 3 * 2048; i += NTHR) { const int v = i >> 11, k = i & 2047; const float cv = (v < 2) ? c[v * 2048 + k] : cc[k]; sl[i] = cv * sigmoidf_(cv); }
    __syncthreads();
    const int col = F.tid % 48, ks = F.tid / 48;
    float a0 = 0.f, a1 = 0.f, a2 = 0.f;
    if (ks < 10) { const float* wp = W + 48 * cb + col;
#pragma unroll 16
        for (int j = 0; j < 205; ++j) { const int k = ks + 10 * j; if (k < 2048) { const float w = wp[(size_t)k * 12288]; a0 += sl[k] * w; a1 += sl[2048 + k] * w; a2 += sl[4096 + k] * w; } } }
    LAS float* red = sl + 6144;
    if (ks < 10) { red[(ks * 48 + col) * 3 + 0] = a0; red[(ks * 48 + col) * 3 + 1] = a1; red[(ks * 48 + col) * 3 + 2] = a2; }
    __syncthreads();
    if (F.tid < 144) { const int v = F.tid / 48, cl = F.tid % 48; float sacc = 0.f;
#pragma unroll
        for (int q = 0; q < 10; ++q) sacc += red[(q * 48 + cl) * 3 + v];
        ((float*)(F.ws + WS_MOD))[v * 12288 + 48 * cb + cl] = sacc + F.in[IN_BADA][48 * cb + cl]; }
    __syncthreads();
}
__device__ __forceinline__ void p0_filt_item(Frame& F, int tb) {
    LAS float* ft = (LAS float*)F.lds;
    LAS float* h1 = ft + 64 * 36;
    LAS float* h2 = h1 + 64 * 65;
    const int t0 = tb * 64, tl = F.tid >> 3, q = F.tid & 7; const float tf = (float)(t0 + tl);
    for (int f = q; f < 33; f += 8) {
        float v;
        if (f == 0) v = tf * (1.0f / 16383.0f);
        else { const int bi = (f - 1) & 15; const float band = 1e-4f + (float)bi * ((15.0f - 1e-4f) / 15.0f); const float rev = tf * band * (1.0f / 16384.0f);
               v = (f <= 16) ? cos_rev(rev) : -sin_rev(rev); }
        ft[tl * 36 + f] = v;
    }
    __syncthreads();
    { const float* w1 = F.in[IN_HW1]; const float* b1 = F.in[IN_HB1]; const float* f1 = F.in[IN_HF1];
      _Pragma("unroll 1") for (int j = q * 8; j < q * 8 + 8; ++j) { float a = b1[j]; _Pragma("unroll 3") for (int f = 0; f < 33; ++f) a += ft[tl * 36 + f] * w1[f * 64 + j]; h1[tl * 65 + j] = sin_rev(f1[j] * a * 0.15915494309189535f); } }
    __syncthreads();
    { const float* w2 = F.in[IN_HW2]; const float* b2 = F.in[IN_HB2]; const float* f2 = F.in[IN_HF2];
      _Pragma("unroll 1") for (int j = q * 8; j < q * 8 + 8; ++j) { float a = b2[j]; _Pragma("unroll 4") for (int i = 0; i < 64; ++i) a += h1[tl * 65 + i] * w2[i * 64 + j]; h2[tl * 64 + j] = sin_rev(f2[j] * a * 0.15915494309189535f); } }
    __syncthreads();
    LAS unsigned short* hb = (LAS unsigned short*)(h2 + 64 * 64);
    for (int i = F.tid; i < 64 * 64; i += NTHR) hb[(i >> 6) * 72 + (i & 63)] = (unsigned short)f2bf(h2[i]);
    __syncthreads();
    const float* w3 = F.in[IN_HW3]; const float* b3 = F.in[IN_HB3]; const float* dec = F.in[IN_HDEC]; bf16* FILT = (bf16*)(F.ws + WS_FILT);
    const int fr = F.lane & 15, fq = F.lane >> 4;
    bf16x8 af[4][2];
#pragma unroll
    for (int m = 0; m < 4; ++m)
#pragma unroll
        for (int ks = 0; ks < 2; ++ks) af[m][ks] = *(const LAS bf16x8*)(hb + (16 * m + fr) * 72 + 32 * ks + 8 * fq);
#pragma unroll 4
    for (int jt = F.wave; jt < 256; jt += NWAVES) {
        const int j = 16 * jt + fr;
        bf16x8 bfr[2];
#pragma unroll
        for (int ks = 0; ks < 2; ++ks) { float w[8];
#pragma unroll
            for (int e = 0; e < 8; ++e) w[e] = w3[(size_t)(32 * ks + 8 * fq + e) * 4096 + j];
            u32x4 pk; pk.x = pk2(w[0], w[1]); pk.y = pk2(w[2], w[3]); pk.z = pk2(w[4], w[5]); pk.w = pk2(w[6], w[7]); bfr[ks] = __builtin_bit_cast(bf16x8, pk); }
        const float bb = b3[j], dd = fabsf(dec[j]) * (1.0f / 16383.0f);
#pragma unroll
        for (int m = 0; m < 4; ++m) { f32x4 acc = (f32x4){0.f, 0.f, 0.f, 0.f};
#pragma unroll
            for (int ks = 0; ks < 2; ++ks) acc = __builtin_amdgcn_mfma_f32_16x16x32_bf16(af[m][ks], bfr[ks], acc, 0, 0, 0);
            const int tb0 = t0 + 16 * m + 4 * fq; f32x4 o;
#pragma unroll
            for (int e = 0; e < 4; ++e) o[e] = (acc[e] + bb) * __expf(-(float)(tb0 + e) * dd);
            *(u32x2*)(FILT + (size_t)j * SEQ + tb0) = (u32x2){cvt_pk_bf16(o[0], o[1]), cvt_pk_bf16(o[2], o[3])}; }
    }
    __syncthreads();
}
__device__ __forceinline__ void p0_s5tab_item(Frame& F, int item) {
    const int idx = item * NTHR + F.tid; const int d = idx >> 12, g = (idx >> 6) & 63, p = idx & 63, dg = d * 64 + g;
    const float lr = F.in[IN_LRE][dg * 64 + p], li = F.in[IN_LIM][dg * 64 + p], dt = expf(F.in[IN_LDT][dg]);
    const float mag = expf(lr * dt), ang = li * dt; const float lbr = mag * cosf(ang), lbi = mag * sinf(ang);
    const float den = lr * lr + li * li, cr = ((lbr - 1.f) * lr + lbi * li) / den, ci = (lbi * lr - (lbr - 1.f) * li) / den;
    bf16* BBT = (bf16*)(F.ws + WS_BBT); bf16* BB2 = (bf16*)(F.ws + WS_BB2); bf16* CTT = (bf16*)(F.ws + WS_CTT); f32x2* LAM = (f32x2*)(F.ws + WS_LAM);
    const float* bre = F.in[IN_BRE] + (size_t)(dg * 64 + p) * 16; const float* bim = F.in[IN_BIM] + (size_t)(dg * 64 + p) * 16;
    for (int c = 0; c < 16; ++c) { const float br = bre[c], bi = bim[c];
        BBT[(size_t)(dg * 128 + p) * 16 + c] = (bf16)f2bf(cr * br - ci * bi); BBT[(size_t)(dg * 128 + 64 + p) * 16 + c] = (bf16)f2bf(cr * bi + ci * br);
        BB2[(size_t)(dg * 128 + 2 * p) * 16 + c] = (bf16)f2bf(cr * br - ci * bi); BB2[(size_t)(dg * 128 + 2 * p + 1) * 16 + c] = (bf16)f2bf(cr * bi + ci * br); }
    const int k = 2 * p;
    for (int c = 0; c < 16; ++c) { const float cre = F.in[IN_CRE][(size_t)(dg * 16 + c) * 64 + p], cim = F.in[IN_CIM][(size_t)(dg * 16 + c) * 64 + p];
        CTT[(size_t)(dg * 16 + c) * 128 + k] = (bf16)f2bf(cre); CTT[(size_t)(dg * 16 + c) * 128 + k + 1] = (bf16)f2bf(-cim); }
    LAM[dg * 64 + p] = (f32x2){lbr, lbi};
}
__device__ __forceinline__ void p0_transpose_item(const float* W, int K, int N, bf16* WT, LAS unsigned short* scr, int kb, int nb, int lane) {
    const int k0 = 64 * kb, n0 = 128 * nb;
    const float* wp = W + (size_t)(k0 + (lane >> 5)) * N + n0 + 4 * (lane & 31);
#pragma unroll
    for (int half = 0; half < 2; ++half) { f32x4 v[16];
#pragma unroll
        for (int i = 0; i < 16; ++i) v[i] = *(const GAS f32x4*)(wp + (size_t)(32 * half + 2 * i) * N);
#pragma unroll
        for (int i = 0; i < 16; ++i) { const int kk = 32 * half + 2 * i + (lane >> 5); LAS unsigned* d = (LAS unsigned*)(scr + kk * 130 + 4 * (lane & 31)); d[0] = pk2(v[i].x, v[i].y); d[1] = pk2(v[i].z, v[i].w); } }
    LDS_WAIT(); asm volatile("" ::: "memory");
    const int c = lane & 7;
#pragma unroll
    for (int j = 0; j < 16; ++j) { const int r = (lane >> 3) + 8 * j; const LAS unsigned short* sp = scr + (8 * c) * 130 + r;
        u32x4 o; o.x = (unsigned)sp[0] | ((unsigned)sp[130] << 16); o.y = (unsigned)sp[2 * 130] | ((unsigned)sp[3 * 130] << 16); o.z = (unsigned)sp[4 * 130] | ((unsigned)sp[5 * 130] << 16); o.w = (unsigned)sp[6 * 130] | ((unsigned)sp[7 * 130] << 16);
        *(GAS u32x4*)(WT + (size_t)(n0 + r) * K + k0 + 8 * c) = o; }
    LDS_WAIT(); asm volatile("" ::: "memory");
}
__device__ __forceinline__ void p0_transpose_item8(const float* W, int K, int N, unsigned char* WT, LAS unsigned short* scr, int kb, int nb, int lane) {
    const int k0 = 64 * kb, n0 = 128 * nb;
    const float* wp = W + (size_t)(k0 + (lane >> 5)) * N + n0 + 4 * (lane & 31);
#pragma unroll
    for (int half = 0; half < 2; ++half) { f32x4 v[16];
#pragma unroll
        for (int i = 0; i < 16; ++i) v[i] = *(const GAS f32x4*)(wp + (size_t)(32 * half + 2 * i) * N);
#pragma unroll
        for (int i = 0; i < 16; ++i) { const int kk = 32 * half + 2 * i + (lane >> 5); LAS unsigned* d = (LAS unsigned*)(scr + kk * 130 + 4 * (lane & 31)); d[0] = pk2(v[i].x, v[i].y); d[1] = pk2(v[i].z, v[i].w); } }
    LDS_WAIT(); asm volatile("" ::: "memory");
    const int c = lane & 7;
#pragma unroll
    for (int j = 0; j < 16; ++j) { const int r = (lane >> 3) + 8 * j; const LAS unsigned short* sp = scr + (8 * c) * 130 + r;
        u32x2 o; o.x = pk4_fp8(bf2f(sp[0]) * W8SCALE, bf2f(sp[130]) * W8SCALE, bf2f(sp[2 * 130]) * W8SCALE, bf2f(sp[3 * 130]) * W8SCALE);
        o.y = pk4_fp8(bf2f(sp[4 * 130]) * W8SCALE, bf2f(sp[5 * 130]) * W8SCALE, bf2f(sp[6 * 130]) * W8SCALE, bf2f(sp[7 * 130]) * W8SCALE);
        *(GAS u32x2*)(WT + (size_t)(n0 + r) * K + k0 + 8 * c) = o; }
    LDS_WAIT(); asm volatile("" ::: "memory");
}
__device__ __forceinline__ void p0_prologue(Frame& F) {
    for (int it = F.bx; it < 256; it += F.G) p0_adaln_item(F, it);
    for (int it = F.bx; it < 256; it += F.G) p0_filt_item(F, it);
    for (int it = F.bx; it < 16; it += F.G) p0_s5tab_item(F, it);
    { const float* rw = F.in[IN_RW]; float* RWT = (float*)(F.ws + WS_RWT);
      for (int i = F.bx * NTHR + F.tid; i < 32 * 2048; i += F.G * NTHR) { const int e = i >> 11, k = i & 2047; RWT[i] = rw[k * 32 + e]; } }
    __syncthreads();
    LAS unsigned short* scr = (LAS unsigned short*)(F.lds + F.wave * 16640);
    constexpr int I_IN = 64 * 4, I_GLU = 8 * 2, I_BS5 = 16 * 2, I_BHY = 16 * 2, I_O = 16 * 4, I_GU1 = 32 * 4, I_DN1 = 16 * 4;
    constexpr int I_GU = 32 * I_GU1, I_DN = 32 * I_DN1;
    constexpr int NITEMS = I_IN + I_GLU + I_BS5 + I_BHY + I_O + I_GU + I_DN;
    const int w = F.wave;
    for (int it = F.bx; it < NITEMS; it += F.G) {
        int r = it;
        if (r < I_IN) { if ((r >> 2) < 32) p0_transpose_item(F.in[IN_WIN], 2048, 8192, (bf16*)(F.ws + WS_WIN), scr, 8 * (r & 3) + w, r >> 2, F.lane);
                        else p0_transpose_item8(F.in[IN_WIN], 2048, 8192, (unsigned char*)(F.ws + WS_WIN8) - (size_t)4096 * 2048, scr, 8 * (r & 3) + w, r >> 2, F.lane); continue; } r -= I_IN;
        if (r < I_GLU) { p0_transpose_item(F.in[IN_WGLU], 1024, 1024, (bf16*)(F.ws + WS_WGLU), scr, 8 * (r & 1) + w, r >> 1, F.lane); continue; } r -= I_GLU;
        if (r < I_BS5) { p0_transpose_item(F.in[IN_WBS5], 1024, 2048, (bf16*)(F.ws + WS_WBS5), scr, 8 * (r & 1) + w, r >> 1, F.lane); continue; } r -= I_BS5;
        if (r < I_BHY) { p0_transpose_item(F.in[IN_WBHY], 1024, 2048, (bf16*)(F.ws + WS_WBHY), scr, 8 * (r & 1) + w, r >> 1, F.lane); continue; } r -= I_BHY;
        if (r < I_O) { p0_transpose_item(F.in[IN_WO], 2048, 2048, (bf16*)(F.ws + WS_WO), scr, 8 * (r & 3) + w, r >> 2, F.lane); continue; } r -= I_O;
        if (r < I_GU) { const int e = r / I_GU1, q = r % I_GU1; p0_transpose_item8(F.in[IN_WGU] + (size_t)e * 2048 * 4096, 2048, 4096, (unsigned char*)(F.ws + WS_WGU) + (size_t)e * 4096 * 2048, scr, 8 * (q & 3) + w, q >> 2, F.lane); continue; } r -= I_GU;
        { const int e = r / I_DN1, q = r % I_DN1; p0_transpose_item8(F.in[IN_WDN] + (size_t)e * 2048 * 2048, 2048, 2048, (unsigned char*)(F.ws + WS_WDN) + (size_t)e * 2048 * 2048, scr, 8 * (q & 3) + w, q >> 2, F.lane); }
    }
}

__device__ __forceinline__ void p1_norm(Frame& F) {
    const int gw = F.bx * NWAVES + F.wave, NGW = F.G * NWAVES;
    const float* MOD = (const float*)(F.ws + WS_MOD); const float* g1n = F.in[IN_N1G];
    bf16* U = (bf16*)(F.ws + WS_U);
    int curv = -1; f32x4 ga[8], sh[8];
    for (int m = gw; m < NTOK + NCTX; m += NGW) {
        const int v = (m < NTOK) ? (m >> 14) : 2;
        if (v != curv) { curv = v;
#pragma unroll
            for (int j = 0; j < 8; ++j) { const int k = 4 * F.lane + 256 * j; const f32x4 g = *(const f32x4*)(g1n + k), sc = *(const f32x4*)(MOD + v * 12288 + 2048 + k); ga[j] = g * (sc + 1.0f); sh[j] = *(const f32x4*)(MOD + v * 12288 + k); } }
        const float* xr = (m < NTOK) ? (F.in[IN_X] + (size_t)m * D) : (F.in[IN_CTX] + (size_t)(m - NTOK) * D);
        f32x4 x[8]; float s = 0.f;
#pragma unroll
        for (int j = 0; j < 8; ++j) { x[j] = *(const GAS f32x4*)(xr + 4 * F.lane + 256 * j); s += (x[j].x * x[j].x + x[j].y * x[j].y) + (x[j].z * x[j].z + x[j].w * x[j].w); }
        const float rstd = 1.0f / sqrtf(wave_sum(s) * (1.0f / D) + 1e-6f);
        GAS u32x2* o = (GAS u32x2*)(U + (size_t)m * D) + F.lane; GAS unsigned* o8 = (GAS unsigned*)(F.ws + WS_U8 + (size_t)m * D) + F.lane;
#pragma unroll
        for (int j = 0; j < 8; ++j) { const f32x4 y = x[j] * rstd * ga[j] + sh[j]; o[64 * j] = (u32x2){pk2(y.x, y.y), pk2(y.z, y.w)}; if (m < NTOK) o8[64 * j] = pk4_fp8(y.x, y.y, y.z, y.w); }
    }
}

struct SchedIn {
    int G, c, nmain, npn, mode, nrep;
    const char* A; const char* Bt;
    __device__ __forceinline__ bool next(int i, pg8::Unit& u) const {
        int L = i * G + c; u.e = 0; u.valid = 256; { const int tot = nmain + (mode == 0 ? 8 : 0); if (nrep > 1 && L >= tot && L < 2 * tot) L -= tot; }
        if (L < nmain) {
            int wgid = L; { const int q = nmain / 8, xcd = wgid % 8, off = wgid / 8; wgid = xcd * q + off; }
            const int nig = 8 * npn, gid = wgid / nig; const int pm = gid * 8 + ((wgid % nig) % 8), pl = (wgid % nig) / 8;
            u.pm = pm; u.pn = (mode == 0) ? pl : (mode == 1 ? pl + 4 : pl + 16); return true;
        }
        if (mode == 0 && L < nmain + 8) { const int q = L - nmain; u.pm = 128 + (q >> 2); u.pn = q & 3; return true; }
        return false;
    }
    __device__ __forceinline__ unsigned a_row(const pg8::Unit& u, int r) const { return (u.pm < 128) ? (unsigned)((u.pm >> 6) * SEQ + r * 64 + (u.pm & 63)) : (unsigned)(NTOK + (u.pm - 128) * 256 + r); }
    __device__ __forceinline__ const char* a_base() const { return A; }
    __device__ __forceinline__ const char* b_base(const pg8::Unit& u) const { return (mode == 2) ? Bt + (size_t)(u.pn - 16) * 256 * D : Bt + (size_t)u.pn * 256 * D * 2; }
};
struct EpiInG8 {
    static constexpr bool PERM = true, TRANS = true, FP8 = true;
    bf16* UG;
    __device__ __forceinline__ void operator()(const f32x4 (&acc)[2][2][4][2], const pg8::Unit& u, int wr, int wc, int fr, int fq) const {
        const int col0 = (u.pn - 16) * 256 + wc * 32 + 8 * fq;
#pragma unroll
        for (int ai = 0; ai < 2; ++ai)
#pragma unroll
            for (int m = 0; m < 4; ++m) { const int r = ai * 128 + wr * 64 + m * 16 + fr; const size_t row = (size_t)((u.pm >> 6) * SEQ + r * 64 + (u.pm & 63));
                bf16* rowp = UG + row * 4096 + col0;
#pragma unroll
                for (int bj = 0; bj < 2; ++bj) { f32x4 v0 = acc[ai][bj][m][0] * (1.0f / W8SCALE), v1 = acc[ai][bj][m][1] * (1.0f / W8SCALE);
#pragma unroll
                    for (int j = 0; j < 4; ++j) { v0[j] = sigmoidf_(v0[j]); v1[j] = sigmoidf_(v1[j]); }
                    u32x4 w; w.x = cvt_pk_bf16(v0[0], v0[1]); w.y = cvt_pk_bf16(v0[2], v0[3]); w.z = cvt_pk_bf16(v1[0], v1[1]); w.w = cvt_pk_bf16(v1[2], v1[3]);
                    *(u32x4*)(rowp + bj * 128) = w; } }
    }
};
struct EpiInA {
    static constexpr bool PERM = true, TRANS = true, FP8 = false;
    unsigned char* ws;
    __device__ __forceinline__ void operator()(const f32x4 (&acc)[2][2][4][2], const pg8::Unit& u, int wr, int wc, int fr, int fq) const {
        const bool isctx = u.pm >= 128, isg = u.pn >= 16;
        const size_t boff = isctx ? WS_UCA : (isg ? WS_UG : WS_UA);
        bf16* base = (bf16*)(ws + boff); const size_t ld = isg ? 4096 : S5W; const int colt = isg ? (u.pn - 16) * 256 : u.pn * 256;
        const int col0 = colt + wc * 32 + 8 * fq;
#pragma unroll
        for (int ai = 0; ai < 2; ++ai)
#pragma unroll
            for (int m = 0; m < 4; ++m) { const int r = ai * 128 + wr * 64 + m * 16 + fr;
                const size_t row = isctx ? (size_t)((u.pm - 128) * 256 + r) : (size_t)((u.pm >> 6) * SEQ + r * 64 + (u.pm & 63));
                bf16* rowp = base + row * ld + col0;
#pragma unroll
                for (int bj = 0; bj < 2; ++bj) { f32x4 v0 = acc[ai][bj][m][0], v1 = acc[ai][bj][m][1];
                    if (isg) {
#pragma unroll
                        for (int j = 0; j < 4; ++j) { v0[j] = sigmoidf_(v0[j]); v1[j] = sigmoidf_(v1[j]); } }
                    u32x4 w; w.x = cvt_pk_bf16(v0[0], v0[1]); w.y = cvt_pk_bf16(v0[2], v0[3]); w.z = cvt_pk_bf16(v1[0], v1[1]); w.w = cvt_pk_bf16(v1[2], v1[3]);
                    *(u32x4*)(rowp + bj * 128) = w; } }
    }
};
struct EpiInH {
    static constexpr bool PERM = false, TRANS = false, FP8 = false;
    bf16* UH;
    __device__ __forceinline__ void operator()(const f32x4 (&acc)[2][2][4][2], const pg8::Unit& u, int wr, int wc, int fr, int fq) const {
        const int b = u.pm >> 6, w = u.pm & 63;
#pragma unroll
        for (int bj = 0; bj < 2; ++bj)
#pragma unroll
            for (int n = 0; n < 2; ++n) { const int ch = (u.pn - 4) * 256 + bj * 128 + wc * 32 + n * 16 + fr;
                bf16* cp = UH + ((size_t)(b * 3072 + ch) * SEQ + w * 256);
#pragma unroll
                for (int ai = 0; ai < 2; ++ai)
#pragma unroll
                    for (int m = 0; m < 4; ++m) { const int r0 = ai * 128 + wr * 64 + m * 16 + 4 * fq; const f32x4 v = acc[ai][bj][m][n];
                        *(u32x2*)(cp + r0) = (u32x2){cvt_pk_bf16(v[0], v[1]), cvt_pk_bf16(v[2], v[3])}; } }
    }
};

template <bool PASSB>
__device__ __forceinline__ void s5_pass(Frame& F) {
    constexpr int nk = PASSB ? 256 : 260;
    constexpr int nitems = 2 * nk * 8;
    LAS unsigned char* sl = F.lds + F.wave * 8704;
    const int lane = F.lane, pl = lane & 31, hi = lane >> 5, fr = lane & 15, fq = lane >> 4;
    const bf16* UA = (const bf16*)(F.ws + WS_UA); const bf16* UCA = (const bf16*)(F.ws + WS_UCA);
    const bf16* BBT = (const bf16*)(F.ws + WS_BBT); const bf16* CTT = (const bf16*)(F.ws + WS_CTT); const f32x2* LAM = (const f32x2*)(F.ws + WS_LAM);
    f32x2* EB = (f32x2*)(F.ws + WS_E); const f32x2* SINB = (const f32x2*)(F.ws + WS_SIN); bf16* Y = (bf16*)(F.ws + WS_Y);
    const int s_r = 16 * ((pl >> 2) & 1) + 4 * (pl >> 3) + (pl & 3);
    for (int it = F.bx; it < nitems; it += F.G) {
        const int gq = it & 7, rest = it >> 3; const int b = rest / nk, kk = rest % nk; const int kc = PASSB ? kk + 4 : kk;
        const int g = gq * 8 + F.wave;
        const bf16* urow = (kc < 4) ? (UCA + (size_t)(b * CTX + kc * 64) * S5W + 16 * g) : (UA + (size_t)(b * SEQ + (kc - 4) * 64) * S5W + 16 * g);
        f32x4 yacc[4];
#pragma unroll
        for (int q = 0; q < 4; ++q) yacc[q] = (f32x4){0.f, 0.f, 0.f, 0.f};
#pragma unroll
        for (int d = 0; d < 2; ++d) {
            const int dg = d * 64 + g;
            bf16x8 bb[4];
#pragma unroll
            for (int ni = 0; ni < 4; ++ni) bb[ni] = *(const bf16x8*)(BBT + (size_t)(dg * 128 + 32 * ni + pl) * 16 + 8 * hi);
            bf16x8 ct[4];
            if (PASSB) {
#pragma unroll
                for (int ks = 0; ks < 4; ++ks) ct[ks] = *(const bf16x8*)(CTT + (size_t)(dg * 16 + fr) * 128 + 32 * ks + 8 * fq);
            }
            const f32x2 lamA = LAM[dg * 64 + pl], lamB = LAM[dg * 64 + pl + 32];
            f32x2 l2 = cmul(lamA, lamA), l4 = cmul(l2, l2), l8 = cmul(l4, l4); const f32x2 lam16A = cmul(l8, l8);
            l2 = cmul(lamB, lamB); l4 = cmul(l2, l2); l8 = cmul(l4, l4); const f32x2 lam16B = cmul(l8, l8);
            f32x2 cA = (f32x2){0.f, 0.f}, cB = (f32x2){0.f, 0.f};
            const size_t sidx = ((size_t)((d * 2 + b) * NCH + kc)) * 4096 + g * 64 + pl;
            if (PASSB) { cA = SINB[sidx]; cB = SINB[sidx + 32]; }
#pragma unroll
            for (int sc = 0; sc < 2; ++sc) {
                const int iscan = 32 * sc + s_r; const int tok = (d == 0) ? iscan : 63 - iscan;
                const bf16x8 a = *(const bf16x8*)(urow + (size_t)tok * S5W + 8 * hi);
                f32x16 acc[4];
#pragma unroll
                for (int ni = 0; ni < 4; ++ni) { f32x16 z;
#pragma unroll
                    for (int i = 0; i < 16; ++i) z[i] = 0.f;
                    acc[ni] = __builtin_amdgcn_mfma_f32_32x32x16_bf16(a, bb[ni], z, 0, 0, 0); }
                asm volatile("s_nop 7\n\ts_nop 7" : "+v"(acc[0]), "+v"(acc[1]), "+v"(acc[2]), "+v"(acc[3]) : "v"(a), "v"(bb[0]), "v"(bb[1]), "v"(bb[2]), "v"(bb[3]));
                f32x2 sA = hi ? (f32x2){0.f, 0.f} : cA, sB = hi ? (f32x2){0.f, 0.f} : cB;
#pragma unroll
                for (int i = 0; i < 16; ++i) {
                    sA = (f32x2){lamA.x * sA.x - lamA.y * sA.y + acc[0][i], lamA.x * sA.y + lamA.y * sA.x + acc[2][i]}; acc[0][i] = sA.x; acc[2][i] = sA.y;
                    sB = (f32x2){lamB.x * sB.x - lamB.y * sB.y + acc[1][i], lamB.x * sB.y + lamB.y * sB.x + acc[3][i]}; acc[1][i] = sB.x; acc[3][i] = sB.y; }
                const f32x2 pA = (f32x2){__shfl_xor(sA.x, 32), __shfl_xor(sA.y, 32)}, pB = (f32x2){__shfl_xor(sB.x, 32), __shfl_xor(sB.y, 32)};
                const f32x2 tA = cmul(lam16A, hi ? pA : sA), tB = cmul(lam16B, hi ? pB : sB);
                const f32x2 e1A = (hi ? sA : pA) + tA, e1B = (hi ? sB : pB) + tB;
                const f32x2 ciA = hi ? pA : (f32x2){0.f, 0.f}, ciB = hi ? pB : (f32x2){0.f, 0.f};
                if (PASSB) {
                    f32x2 wA = cmul(lamA, ciA), wB = cmul(lamB, ciB);
#pragma unroll
                    for (int i = 0; i < 16; ++i) {
                        acc[0][i] += wA.x; acc[2][i] += wA.y; acc[1][i] += wB.x; acc[3][i] += wB.y;
                        *(LAS u32x2*)(sl + (16 * hi + i) * 272 + pl * 8) = (u32x2){cvt_pk_bf16(acc[0][i], acc[2][i]), cvt_pk_bf16(acc[1][i], acc[3][i])};
                        wA = cmul(wA, lamA); wB = cmul(wB, lamB); }
                    bf16x8 bsv[2][4];
#pragma unroll
                    for (int tt = 0; tt < 2; ++tt) {
                        const int rowi = (d == 0) ? (16 * tt + fr) : (16 * tt + 15 - fr);
#pragma unroll
                        for (int ks = 0; ks < 4; ++ks) bsv[tt][ks] = *(const LAS bf16x8*)(sl + rowi * 272 + (32 * ks + 8 * fq) * 2);
                    }
#pragma unroll
                    for (int tt = 0; tt < 2; ++tt) {
                        const int tq = (d == 0) ? (2 * sc + tt) : (3 - 2 * sc - tt);
#pragma unroll
                        for (int ks = 0; ks < 4; ++ks) yacc[tq] = __builtin_amdgcn_mfma_f32_16x16x32_bf16(ct[ks], bsv[tt][ks], yacc[tq], 0, 0, 0);
                    }
                    asm volatile("s_nop 7\n\ts_nop 7" : "+v"(yacc[0]), "+v"(yacc[1]), "+v"(yacc[2]), "+v"(yacc[3]) : "v"(bsv[0][0]), "v"(bsv[0][1]), "v"(bsv[0][2]), "v"(bsv[0][3]), "v"(bsv[1][0]), "v"(bsv[1][1]), "v"(bsv[1][2]), "v"(bsv[1][3]), "v"(ct[0]), "v"(ct[1]), "v"(ct[2]), "v"(ct[3]));
                    asm volatile("s_waitcnt lgkmcnt(0)" ::: "memory");
                }
                cA = e1A; cB = e1B;
            }
            if (!PASSB) { if (hi == 0) { EB[sidx] = cA; EB[sidx + 32] = cB; } }
        }
        if (PASSB) {
            const f32x4 dsk = *(const f32x4*)(F.in[IN_S5D] + 16 * g + 4 * fq);
#pragma unroll
            for (int tq = 0; tq < 4; ++tq) { const int tok = 16 * tq + fr;
                const u32x2 uu = *(const u32x2*)(urow + (size_t)tok * S5W + 4 * fq);
                f32x4 v; v[0] = yacc[tq][0] + bflo(uu.x) * dsk[0]; v[1] = yacc[tq][1] + bfhi(uu.x) * dsk[1]; v[2] = yacc[tq][2] + bflo(uu.y) * dsk[2]; v[3] = yacc[tq][3] + bfhi(uu.y) * dsk[3];
#pragma unroll
                for (int j = 0; j < 4; ++j) { const float x = v[j]; v[j] = x * sigmoidf_(1.5957691216f * (x + 0.044715f * x * x * x)); }
                *(u32x2*)(Y + (size_t)(b * SEQ + (kc - 4) * 64 + tok) * S5W + 16 * g + 4 * fq) = (u32x2){cvt_pk_bf16(v[0], v[1]), cvt_pk_bf16(v[2], v[3])}; }
        }
    }
}
__device__ __forceinline__ void s5_pass_a_simple(Frame& F) {
    constexpr int nitems = 2 * NCH * 8;
    const int lane = F.lane;
    const bf16* UA = (const bf16*)(F.ws + WS_UA); const bf16* UCA = (const bf16*)(F.ws + WS_UCA);
    const bf16* BBT = (const bf16*)(F.ws + WS_BBT); const f32x2* LAM = (const f32x2*)(F.ws + WS_LAM); f32x2* EB = (f32x2*)(F.ws + WS_E);
    for (int it = F.bx; it < nitems; it += F.G) {
        const int gq = it & 7, rest = it >> 3; const int b = rest / NCH, kc = rest % NCH; const int g = gq * 8 + F.wave;
        const bf16* urow = (kc < 4) ? (UCA + (size_t)(b * CTX + kc * 64) * S5W + 16 * g) : (UA + (size_t)(b * SEQ + (kc - 4) * 64) * S5W + 16 * g);
#pragma unroll 1
        for (int d = 0; d < 2; ++d) {
            const int dg = d * 64 + g; const f32x2 lam = LAM[dg * 64 + lane];
            float bre[16], bim[16];
            { const u32x4 r0 = *(const u32x4*)(BBT + (size_t)(dg * 128 + lane) * 16), r1 = *(const u32x4*)(BBT + (size_t)(dg * 128 + lane) * 16 + 8);
              const u32x4 i0 = *(const u32x4*)(BBT + (size_t)(dg * 128 + 64 + lane) * 16), i1 = *(const u32x4*)(BBT + (size_t)(dg * 128 + 64 + lane) * 16 + 8);
              bre[0] = bflo(r0.x); bre[1] = bfhi(r0.x); bre[2] = bflo(r0.y); bre[3] = bfhi(r0.y); bre[4] = bflo(r0.z); bre[5] = bfhi(r0.z); bre[6] = bflo(r0.w); bre[7] = bfhi(r0.w);
              bre[8] = bflo(r1.x); bre[9] = bfhi(r1.x); bre[10] = bflo(r1.y); bre[11] = bfhi(r1.y); bre[12] = bflo(r1.z); bre[13] = bfhi(r1.z); bre[14] = bflo(r1.w); bre[15] = bfhi(r1.w);
              bim[0] = bflo(i0.x); bim[1] = bfhi(i0.x); bim[2] = bflo(i0.y); bim[3] = bfhi(i0.y); bim[4] = bflo(i0.z); bim[5] = bfhi(i0.z); bim[6] = bflo(i0.w); bim[7] = bfhi(i0.w);
              bim[8] = bflo(i1.x); bim[9] = bfhi(i1.x); bim[10] = bflo(i1.y); bim[11] = bfhi(i1.y); bim[12] = bflo(i1.z); bim[13] = bfhi(i1.z); bim[14] = bflo(i1.w); bim[15] = bfhi(i1.w); }
            f32x2 st = (f32x2){0.f, 0.f};
#pragma unroll 4
            for (int i = 0; i < 64; ++i) { const int tok = (d == 0) ? i : 63 - i;
                const u32x4 u0 = *(const u32x4*)(urow + (size_t)tok * S5W), u1 = *(const u32x4*)(urow + (size_t)tok * S5W + 8);
                float u[16]; u[0] = bflo(u0.x); u[1] = bfhi(u0.x); u[2] = bflo(u0.y); u[3] = bfhi(u0.y); u[4] = bflo(u0.z); u[5] = bfhi(u0.z); u[6] = bflo(u0.w); u[7] = bfhi(u0.w);
                u[8] = bflo(u1.x); u[9] = bfhi(u1.x); u[10] = bflo(u1.y); u[11] = bfhi(u1.y); u[12] = bflo(u1.z); u[13] = bfhi(u1.z); u[14] = bflo(u1.w); u[15] = bfhi(u1.w);
                float br = 0.f, bi = 0.f;
#pragma unroll
                for (int c = 0; c < 16; ++c) { br += bre[c] * u[c]; bi += bim[c] * u[c]; }
                st = (f32x2){lam.x * st.x - lam.y * st.y + br, lam.x * st.y + lam.y * st.x + bi}; }
            EB[((size_t)((d * 2 + b) * NCH + kc)) * 4096 + g * 64 + lane] = st;
        }
    }
}
__device__ __forceinline__ void s5_pass_b2(Frame& F) {
    constexpr int nitems = 2 * 256 * 8;
    LAS unsigned char* sl = F.lds + F.wave * 8704;
    const int lane = F.lane, fr = lane & 15, fq = lane >> 4;
    const bf16* UA = (const bf16*)(F.ws + WS_UA); const bf16* BBT = (const bf16*)(F.ws + WS_BBT); const bf16* CTT = (const bf16*)(F.ws + WS_CTT);
    const f32x2* LAM = (const f32x2*)(F.ws + WS_LAM); const f32x2* SINB = (const f32x2*)(F.ws + WS_SIN); bf16* Y = (bf16*)(F.ws + WS_Y);
    for (int it = F.bx; it < nitems; it += F.G) {
        const int gq = it & 7, rest = it >> 3; const int b = rest >> 8, kc = (rest & 255) + 4; const int g = gq * 8 + F.wave;
        const bf16* urow = UA + (size_t)(b * SEQ + (kc - 4) * 64) * S5W + 16 * g;
        f32x4 yacc[4];
#pragma unroll
        for (int q = 0; q < 4; ++q) yacc[q] = (f32x4){0.f, 0.f, 0.f, 0.f};
#pragma unroll
        for (int d = 0; d < 2; ++d) {
            const int dg = d * 64 + g; const f32x2 lam = LAM[dg * 64 + lane];
            float bre[16], bim[16];
            { const u32x4 r0 = *(const u32x4*)(BBT + (size_t)(dg * 128 + lane) * 16), r1 = *(const u32x4*)(BBT + (size_t)(dg * 128 + lane) * 16 + 8);
              const u32x4 i0 = *(const u32x4*)(BBT + (size_t)(dg * 128 + 64 + lane) * 16), i1 = *(const u32x4*)(BBT + (size_t)(dg * 128 + 64 + lane) * 16 + 8);
              bre[0] = bflo(r0.x); bre[1] = bfhi(r0.x); bre[2] = bflo(r0.y); bre[3] = bfhi(r0.y); bre[4] = bflo(r0.z); bre[5] = bfhi(r0.z); bre[6] = bflo(r0.w); bre[7] = bfhi(r0.w);
              bre[8] = bflo(r1.x); bre[9] = bfhi(r1.x); bre[10] = bflo(r1.y); bre[11] = bfhi(r1.y); bre[12] = bflo(r1.z); bre[13] = bfhi(r1.z); bre[14] = bflo(r1.w); bre[15] = bfhi(r1.w);
              bim[0] = bflo(i0.x); bim[1] = bfhi(i0.x); bim[2] = bflo(i0.y); bim[3] = bfhi(i0.y); bim[4] = bflo(i0.z); bim[5] = bfhi(i0.z); bim[6] = bflo(i0.w); bim[7] = bfhi(i0.w);
              bim[8] = bflo(i1.x); bim[9] = bfhi(i1.x); bim[10] = bflo(i1.y); bim[11] = bfhi(i1.y); bim[12] = bflo(i1.z); bim[13] = bfhi(i1.z); bim[14] = bflo(i1.w); bim[15] = bfhi(i1.w); }
            bf16x8 ct[4];
#pragma unroll
            for (int ks = 0; ks < 4; ++ks) ct[ks] = *(const bf16x8*)(CTT + (size_t)(dg * 16 + fr) * 128 + 32 * ks + 8 * fq);
            f32x2 st = SINB[((size_t)((d * 2 + b) * NCH + kc)) * 4096 + g * 64 + lane];
#pragma unroll
            for (int h = 0; h < 2; ++h) {
#pragma unroll 4
                for (int i = 0; i < 32; ++i) { const int sc = 32 * h + i; const int tok = (d == 0) ? sc : 63 - sc;
                    const u32x4 u0 = *(const u32x4*)(urow + (size_t)tok * S5W), u1 = *(const u32x4*)(urow + (size_t)tok * S5W + 8);
                    float u[16]; u[0] = bflo(u0.x); u[1] = bfhi(u0.x); u[2] = bflo(u0.y); u[3] = bfhi(u0.y); u[4] = bflo(u0.z); u[5] = bfhi(u0.z); u[6] = bflo(u0.w); u[7] = bfhi(u0.w);
                    u[8] = bflo(u1.x); u[9] = bfhi(u1.x); u[10] = bflo(u1.y); u[11] = bfhi(u1.y); u[12] = bflo(u1.z); u[13] = bfhi(u1.z); u[14] = bflo(u1.w); u[15] = bfhi(u1.w);
                    float br = 0.f, bi = 0.f;
#pragma unroll
                    for (int c = 0; c < 16; ++c) { br += bre[c] * u[c]; bi += bim[c] * u[c]; }
                    st = (f32x2){lam.x * st.x - lam.y * st.y + br, lam.x * st.y + lam.y * st.x + bi};
                    *(LAS unsigned*)(sl + (tok & 31) * 272 + lane * 4) = cvt_pk_bf16(st.x, st.y); }
                const int t0q = (d == 0) ? 2 * h : 2 * (1 - h);
                bf16x8 bsv[2][4];
#pragma unroll
                for (int tt = 0; tt < 2; ++tt)
#pragma unroll
                    for (int ks = 0; ks < 4; ++ks) bsv[tt][ks] = *(const LAS bf16x8*)(sl + (16 * tt + fr) * 272 + (32 * ks + 8 * fq) * 2);
#pragma unroll
                for (int tt = 0; tt < 2; ++tt)
#pragma unroll
                    for (int ks = 0; ks < 4; ++ks) yacc[t0q + tt] = __builtin_amdgcn_mfma_f32_16x16x32_bf16(ct[ks], bsv[tt][ks], yacc[t0q + tt], 0, 0, 0);
                asm volatile("s_nop 7\n\ts_nop 7" : "+v"(yacc[0]), "+v"(yacc[1]), "+v"(yacc[2]), "+v"(yacc[3]) : "v"(bsv[0][0]), "v"(bsv[0][1]), "v"(bsv[0][2]), "v"(bsv[0][3]), "v"(bsv[1][0]), "v"(bsv[1][1]), "v"(bsv[1][2]), "v"(bsv[1][3]), "v"(ct[0]), "v"(ct[1]), "v"(ct[2]), "v"(ct[3]));
                asm volatile("s_waitcnt lgkmcnt(0)" ::: "memory");
            }
        }
        const f32x4 dsk = *(const f32x4*)(F.in[IN_S5D] + 16 * g + 4 * fq);
#pragma unroll
        for (int tq = 0; tq < 4; ++tq) { const int tok = 16 * tq + fr;
            const u32x2 uu = *(const u32x2*)(urow + (size_t)tok * S5W + 4 * fq);
            f32x4 v; v[0] = yacc[tq][0] + bflo(uu.x) * dsk[0]; v[1] = yacc[tq][1] + bfhi(uu.x) * dsk[1]; v[2] = yacc[tq][2] + bflo(uu.y) * dsk[2]; v[3] = yacc[tq][3] + bfhi(uu.y) * dsk[3];
#pragma unroll
            for (int j = 0; j < 4; ++j) { const float x = v[j]; v[j] = x * sigmoidf_(1.5957691216f * (x + 0.044715f * x * x * x)); }
            *(u32x2*)(Y + (size_t)(b * SEQ + (kc - 4) * 64 + tok) * S5W + 16 * g + 4 * fq) = (u32x2){cvt_pk_bf16(v[0], v[1]), cvt_pk_bf16(v[2], v[3])}; }
    }
}
template <bool PASSB>
__device__ __forceinline__ void s5_pass3(Frame& F) {
    constexpr int nk = PASSB ? 256 : NCH; constexpr int nitems = 2 * nk * 8;
    LAS unsigned char* sl = F.lds + F.wave * 8704;
    const int lane = F.lane, fr = lane & 15, fq = lane >> 4;
    const bf16* UA = (const bf16*)(F.ws + WS_UA); const bf16* UCA = (const bf16*)(F.ws + WS_UCA); const bf16* BB2 = (const bf16*)(F.ws + WS_BB2); const bf16* CTT = (const bf16*)(F.ws + WS_CTT);
    const f32x2* LAM = (const f32x2*)(F.ws + WS_LAM); const f32x2* SINB = (const f32x2*)(F.ws + WS_SIN); f32x2* EB = (f32x2*)(F.ws + WS_E); bf16* Y = (bf16*)(F.ws + WS_Y);
    const bf16x8 zf = (bf16x8){0, 0, 0, 0, 0, 0, 0, 0};
    int curg = -1; bf16x8 af[2][8], ct[2][4]; f32x2 lamv[2]; f32x4 dsk = (f32x4){0.f, 0.f, 0.f, 0.f};
    for (int it = F.bx; it < nitems; it += F.G) {
        const int gq = it & 7, rest = it >> 3; const int b = rest / nk, kk = rest % nk; const int kc = PASSB ? kk + 4 : kk; const int g = gq * 8 + F.wave;
        if (g != curg) { curg = g;
#pragma unroll
            for (int d = 0; d < 2; ++d) { const int dg = d * 64 + g; lamv[d] = LAM[dg * 64 + lane];
#pragma unroll
                for (int nt = 0; nt < 8; ++nt) af[d][nt] = (fq < 2) ? *(const bf16x8*)(BB2 + (size_t)(dg * 128 + 16 * nt + fr) * 16 + 8 * fq) : zf;
                if (PASSB) {
#pragma unroll
                    for (int ks = 0; ks < 4; ++ks) ct[d][ks] = *(const bf16x8*)(CTT + (size_t)(dg * 16 + fr) * 128 + 32 * ks + 8 * fq); } }
            if (PASSB) dsk = *(const f32x4*)(F.in[IN_S5D] + 16 * g + 4 * fq); }
        const bf16* urow = (kc < 4) ? (UCA + (size_t)(b * CTX + kc * 64) * S5W + 16 * g) : (UA + (size_t)(b * SEQ + (kc - 4) * 64) * S5W + 16 * g);
        bf16x8 uf[4];
#pragma unroll
        for (int q = 0; q < 4; ++q) uf[q] = (fq < 2) ? *(const bf16x8*)(urow + (size_t)(16 * q + fr) * S5W + 8 * fq) : zf;
        f32x2 st0[2];
#pragma unroll
        for (int d = 0; d < 2; ++d) st0[d] = PASSB ? SINB[((size_t)((d * 2 + b) * NCH + kc)) * 4096 + g * 64 + lane] : (f32x2){0.f, 0.f};
        f32x4 yacc[4];
#pragma unroll
        for (int q = 0; q < 4; ++q) yacc[q] = (f32x4){0.f, 0.f, 0.f, 0.f};
#pragma unroll
        for (int d = 0; d < 2; ++d) {
            const f32x2 lam = lamv[d]; f32x2 st = st0[d];
#pragma unroll
            for (int h = 0; h < 2; ++h) {
                const int T0 = (d == 0) ? 32 * h : 32 * (1 - h);
#pragma unroll
                for (int tt = 0; tt < 2; ++tt)
#pragma unroll
                    for (int nt = 0; nt < 8; ++nt) { const f32x4 dd = __builtin_amdgcn_mfma_f32_16x16x32_bf16(af[d][nt], uf[(T0 >> 4) + tt], (f32x4){0.f, 0.f, 0.f, 0.f}, 0, 0, 0);
                        *(LAS u32x2*)(sl + (16 * tt + fr) * 272 + (16 * nt + 4 * fq) * 2) = (u32x2){cvt_pk_bf16(dd[0], dd[1]), cvt_pk_bf16(dd[2], dd[3])}; }
                asm volatile("s_waitcnt lgkmcnt(0)" ::: "memory");
#pragma unroll 8
                for (int i = 0; i < 32; ++i) { const int r = (d == 0) ? i : 31 - i; LAS unsigned* cell = (LAS unsigned*)(sl + r * 272 + lane * 4);
                    const unsigned w = *cell; const float br = bflo(w), bi = bfhi(w);
                    st = (f32x2){lam.x * st.x - lam.y * st.y + br, lam.x * st.y + lam.y * st.x + bi};
                    if (PASSB) *cell = cvt_pk_bf16(st.x, st.y); }
                if (PASSB) {
                    const int t0q = T0 >> 4;
                    bf16x8 bsv[2][4];
#pragma unroll
                    for (int tt = 0; tt < 2; ++tt)
#pragma unroll
                        for (int ks = 0; ks < 4; ++ks) bsv[tt][ks] = *(const LAS bf16x8*)(sl + (16 * tt + fr) * 272 + (32 * ks + 8 * fq) * 2);
#pragma unroll
                    for (int tt = 0; tt < 2; ++tt)
#pragma unroll
                        for (int ks = 0; ks < 4; ++ks) yacc[t0q + tt] = __builtin_amdgcn_mfma_f32_16x16x32_bf16(ct[d][ks], bsv[tt][ks], yacc[t0q + tt], 0, 0, 0);
                    asm volatile("s_nop 7\n\ts_nop 7" : "+v"(yacc[0]), "+v"(yacc[1]), "+v"(yacc[2]), "+v"(yacc[3]) : "v"(bsv[0][0]), "v"(bsv[0][1]), "v"(bsv[0][2]), "v"(bsv[0][3]), "v"(bsv[1][0]), "v"(bsv[1][1]), "v"(bsv[1][2]), "v"(bsv[1][3]));
                }
                asm volatile("s_waitcnt lgkmcnt(0)" ::: "memory");
            }
            if (!PASSB) EB[((size_t)((d * 2 + b) * NCH + kc)) * 4096 + g * 64 + lane] = st;
        }
        if (PASSB) {
#pragma unroll
            for (int tq = 0; tq < 4; ++tq) { const int tok = 16 * tq + fr;
                const u32x2 uu = *(const u32x2*)(urow + (size_t)tok * S5W + 4 * fq);
                f32x4 v; v[0] = yacc[tq][0] + bflo(uu.x) * dsk[0]; v[1] = yacc[tq][1] + bfhi(uu.x) * dsk[1]; v[2] = yacc[tq][2] + bflo(uu.y) * dsk[2]; v[3] = yacc[tq][3] + bfhi(uu.y) * dsk[3];
#pragma unroll
                for (int j = 0; j < 4; ++j) { const float x = v[j]; v[j] = x * sigmoidf_(1.5957691216f * (x + 0.044715f * x * x * x)); }
                *(u32x2*)(Y + (size_t)(b * SEQ + (kc - 4) * 64 + tok) * S5W + 16 * g + 4 * fq) = (u32x2){cvt_pk_bf16(v[0], v[1]), cvt_pk_bf16(v[2], v[3])}; }
        }
    }
}
__device__ __forceinline__ void s5_carry_item(Frame& F, int item) {
    const int idx = item * NTHR + F.tid; const int d = idx >> 13, b = (idx >> 12) & 1, gp = idx & 4095;
    const f32x2 lam = ((const f32x2*)(F.ws + WS_LAM))[d * 4096 + gp];
    f32x2 l = cmul(lam, lam); l = cmul(l, l); l = cmul(l, l); l = cmul(l, l); l = cmul(l, l); l = cmul(l, l);
    const f32x2* EB = (const f32x2*)(F.ws + WS_E) + (size_t)((d * 2 + b) * NCH) * 4096 + gp; f32x2* SB = (f32x2*)(F.ws + WS_SIN) + (size_t)((d * 2 + b) * NCH) * 4096 + gp;
    f32x2 s = (f32x2){0.f, 0.f};
#pragma unroll 4
    for (int st = 0; st < NCH; ++st) { const int kc = (d == 0) ? st : (st < 4 ? 3 - st : NCH + 3 - st);
        const f32x2 e = EB[(size_t)kc * 4096]; SB[(size_t)kc * 4096] = s; s = cmul(l, s) + e; }
}

__device__ __forceinline__ int fsw(int i) { return i ^ ((i >> 5) & 7) ^ (((i >> 6) & 3) << 3); }
__host__ __device__ constexpr float w16c(int j) { return j == 0 ? 1.f : j == 1 ? 0.9238795325f : j == 2 ? 0.7071067812f : j == 3 ? 0.3826834324f : j == 4 ? 0.f : j == 5 ? -0.3826834324f : j == 6 ? -0.7071067812f : -0.9238795325f; }
__host__ __device__ constexpr float w16s(int j) { return j == 0 ? 0.f : j == 1 ? 0.3826834324f : j == 2 ? 0.7071067812f : j == 3 ? 0.9238795325f : j == 4 ? 1.f : j == 5 ? 0.9238795325f : j == 6 ? 0.7071067812f : 0.3826834324f; }
__host__ __device__ constexpr int bitrev(int q, int bits) { int r = 0; for (int i = 0; i < bits; ++i) r |= ((q >> i) & 1) << (bits - 1 - i); return r; }
template <int R, bool INV> __device__ __forceinline__ void dft_reg(f32x2 (&x)[R]) {
#pragma unroll
    for (int len = R; len >= 2; len >>= 1) { const int half = len >> 1, step = 16 / len;
#pragma unroll
        for (int b0 = 0; b0 < R; b0 += len)
#pragma unroll
            for (int k = 0; k < half; ++k) { const f32x2 a = x[b0 + k], b = x[b0 + k + half]; x[b0 + k] = a + b; const f32x2 dd = a - b; const int j = k * step;
                if (j == 0) x[b0 + k + half] = dd;
                else if (j == 4) x[b0 + k + half] = INV ? (f32x2){-dd.y, dd.x} : (f32x2){dd.y, -dd.x};
                else { const float c = w16c(j), s = w16s(j); x[b0 + k + half] = INV ? (f32x2){dd.x * c - dd.y * s, dd.x * s + dd.y * c} : (f32x2){dd.x * c + dd.y * s, dd.y * c - dd.x * s}; } } }
}
template <int R, int LOGN, bool INV> __device__ __forceinline__ void fft_pass(LAS f32x2* buf, int tid) {
    constexpr int LOGR = (R == 16) ? 4 : 3, LOGM = LOGN - LOGR, M = 1 << LOGM, NBF = 16384 / R / NTHR;
#pragma unroll 1
    for (int it = 0; it < NBF; ++it) {
        int tl = tid; asm volatile("" : "+v"(tl));
        const int bq = tl + NTHR * it, blk = bq >> LOGM, j = bq & (M - 1), base = (blk << LOGN) + j; const int fb = fsw(base);
#define FADDR(q) (fb ^ (((q) << LOGM) ^ ((((q) << LOGM) >> 5) & 7) ^ (((((q) << LOGM) >> 6) & 3) << 3)))
        f32x2 x[R];
#pragma unroll
        for (int q = 0; q < R; ++q) x[q] = buf[FADDR(q)];
        f32x2 w1 = (f32x2){1.f, 0.f};
        if (LOGM > 0) { const float rev = (float)j * (1.0f / (float)(1 << LOGN)); const float sn = sin_rev(rev); w1 = (f32x2){cos_rev(rev), INV ? sn : -sn}; }
        if (!INV) {
            dft_reg<R, false>(x);
            buf[fb] = x[0]; f32x2 w = w1;
#pragma unroll
            for (int q = 1; q < R; ++q) { buf[FADDR(q)] = (LOGM > 0) ? cmul(x[bitrev(q, LOGR)], w) : x[bitrev(q, LOGR)]; if (LOGM > 0) w = cmul(w, w1); }
        } else {
            if (LOGM > 0) { f32x2 w = w1;
#pragma unroll
                for (int q = 1; q < R; ++q) { x[q] = cmul(x[q], w); w = cmul(w, w1); } }
            dft_reg<R, true>(x);
#pragma unroll
            for (int q = 0; q < R; ++q) buf[FADDR(q)] = x[bitrev(q, LOGR)];
        }
#undef FADDR
    }
    __syncthreads();
}
#ifndef FFT_TEST
#define FFT_TEST 0
#endif
__device__ __forceinline__ void fft_fwd(LAS f32x2* buf, int tid) { if (FFT_TEST & 1) return; fft_pass<16, 14, false>(buf, tid); fft_pass<16, 10, false>(buf, tid); fft_pass<8, 6, false>(buf, tid); fft_pass<8, 3, false>(buf, tid); }
__device__ __forceinline__ void fft_inv(LAS f32x2* buf, int tid) { if (FFT_TEST & 2) return; fft_pass<8, 3, true>(buf, tid); fft_pass<8, 6, true>(buf, tid); fft_pass<16, 10, true>(buf, tid); fft_pass<16, 14, true>(buf, tid); }
__device__ __forceinline__ float block_sum(Frame& F, float v) {
    LAS float* red = (LAS float*)(F.lds + LDS_X);
    v = wave_sum(v); __syncthreads(); if (F.lane == 0) red[F.wave] = v; __syncthreads();
    float s = 0.f;
#pragma unroll
    for (int w = 0; w < NWAVES; ++w) s += red[w];
    return s;
}
__device__ __forceinline__ float sconv(const bf16* UH, int b, int ch, int t, float w0, float w1, float w2) {
    const bf16* p = UH + (size_t)(b * 3072 + ch) * SEQ;
    const int tm = t > 0 ? t - 1 : 0, tp = t < SEQ - 1 ? t + 1 : SEQ - 1;
    const float xm = bf2f(p[tm]), x0 = bf2f(p[t]), xp = bf2f(p[tp]);
    return w0 * (t > 0 ? xm : 0.f) + w1 * x0 + w2 * (t < SEQ - 1 ? xp : 0.f);
}
#define HY_UNPK(w) ((f32x2){bflo(w), bfhi(w)})
template <bool INV, class LD, class ST>
__device__ __forceinline__ void fft_edge_pass(LAS f32x2* buf, int tid, LD& ld, ST& st) {
    constexpr int R = 16, LOGN = 14, LOGM = 10;
#pragma unroll
    for (int it = 0; it < 2; ++it) {
        int tl = tid; asm volatile("" : "+v"(tl));
        const int j = tl + NTHR * it; const int fb = fsw(j);
        f32x2 x[R];
#pragma unroll
        for (int q = 0; q < R; ++q) x[q] = ld(2 * q + it, j + (q << LOGM), fb + (q << LOGM));
        const float rev = (float)j * (1.0f / 16384.0f); const float sn = sin_rev(rev); const f32x2 w1 = (f32x2){cos_rev(rev), INV ? sn : -sn};
        if (!INV) {
            dft_reg<R, false>(x);
            st(it, j, fb, x[0]); f32x2 w = w1;
#pragma unroll
            for (int q = 1; q < R; ++q) { st(2 * q + it, j + (q << LOGM), fb + (q << LOGM), cmul(x[bitrev(q, 4)], w)); w = cmul(w, w1); }
        } else {
            f32x2 w = w1;
#pragma unroll
            for (int q = 1; q < R; ++q) { x[q] = cmul(x[q], w); w = cmul(w, w1); }
            dft_reg<R, true>(x);
#pragma unroll
            for (int q = 0; q < R; ++q) st(2 * q + it, j + (q << LOGM), fb + (q << LOGM), x[bitrev(q, 4)]);
        }
        __builtin_amdgcn_sched_barrier(0);
    }
}
__device__ __forceinline__ void fft_last_to_ks(LAS f32x2* buf, int tid, unsigned* KS, float scale) {
#pragma unroll 1
    for (int it = 0; it < 4; ++it) { int tl = tid; asm volatile("" : "+v"(tl)); const int b = tl + NTHR * it; const int fb = fsw(8 * b);
        f32x2 x[8];
#pragma unroll
        for (int q = 0; q < 8; ++q) x[q] = buf[fb ^ q];
        dft_reg<8, false>(x);
        u32x4 o0, o1; f32x2 v;
        v = x[bitrev(0, 3)] * scale; o0.x = cvt_pk_bf16(v.x, v.y); v = x[bitrev(1, 3)] * scale; o0.y = cvt_pk_bf16(v.x, v.y); v = x[bitrev(2, 3)] * scale; o0.z = cvt_pk_bf16(v.x, v.y); v = x[bitrev(3, 3)] * scale; o0.w = cvt_pk_bf16(v.x, v.y);
        v = x[bitrev(4, 3)] * scale; o1.x = cvt_pk_bf16(v.x, v.y); v = x[bitrev(5, 3)] * scale; o1.y = cvt_pk_bf16(v.x, v.y); v = x[bitrev(6, 3)] * scale; o1.z = cvt_pk_bf16(v.x, v.y); v = x[bitrev(7, 3)] * scale; o1.w = cvt_pk_bf16(v.x, v.y);
        *(GAS u32x4*)(KS + 8 * b) = o0; *(GAS u32x4*)(KS + 8 * b + 4) = o1; }
}
__device__ __forceinline__ void fft_mid_mul(LAS f32x2* buf, int tid, const unsigned* KS) {
#pragma unroll 2
    for (int it = 0; it < 4; ++it) { int tl = tid; asm volatile("" : "+v"(tl)); const int b = tl + NTHR * it; const int fb = fsw(8 * b);
        const u32x4 k0 = *(const GAS u32x4*)(KS + 8 * b), k1 = *(const GAS u32x4*)(KS + 8 * b + 4);
        f32x2 x[8], y[8];
#pragma unroll
        for (int q = 0; q < 8; ++q) x[q] = buf[fb ^ q];
        dft_reg<8, false>(x);
        y[0] = cmul(x[bitrev(0, 3)], HY_UNPK(k0.x)); y[1] = cmul(x[bitrev(1, 3)], HY_UNPK(k0.y)); y[2] = cmul(x[bitrev(2, 3)], HY_UNPK(k0.z)); y[3] = cmul(x[bitrev(3, 3)], HY_UNPK(k0.w));
        y[4] = cmul(x[bitrev(4, 3)], HY_UNPK(k1.x)); y[5] = cmul(x[bitrev(5, 3)], HY_UNPK(k1.y)); y[6] = cmul(x[bitrev(6, 3)], HY_UNPK(k1.z)); y[7] = cmul(x[bitrev(7, 3)], HY_UNPK(k1.w));
        dft_reg<8, true>(y);
#pragma unroll
        for (int q = 0; q < 8; ++q) buf[fb ^ q] = y[bitrev(q, 3)]; }
    __syncthreads();
}
struct HyStLds { LAS f32x2* buf; __device__ __forceinline__ void operator()(int, int, int addr, f32x2 v) { buf[addr] = v; } };
struct HyLdLds { LAS f32x2* buf; __device__ __forceinline__ f32x2 operator()(int, int, int addr) { return buf[addr]; } };
struct HyLdKc { const bf16* f0; const bf16* f1; float part; __device__ __forceinline__ f32x2 operator()(int, int t, int) { const float a0 = bf2f(f0[t]), r1 = (t == 0) ? 0.f : bf2f(f1[SEQ - t]); part += fabsf(a0) + fabsf(r1); return (f32x2){a0 + r1, 0.f}; } };
struct HyLdKn { const bf16* f0; const bf16* f1; __device__ __forceinline__ f32x2 operator()(int, int t, int) { const float a0 = bf2f(f0[t]), r1 = (t == 0) ? 0.f : bf2f(f1[SEQ - t]); const float rev = (float)t * (1.0f / 32768.0f), v = a0 - r1; return (f32x2){v * cos_rev(rev), v * sin_rev(rev)}; } };
struct HyLdZ { const unsigned* z; __device__ __forceinline__ f32x2 operator()(int k, int, int) { return HY_UNPK(z[k]); } };
struct HyLdZpsi { const unsigned* z; __device__ __forceinline__ f32x2 operator()(int k, int t, int) { const float rev = (float)t * (1.0f / 32768.0f); return cmul(HY_UNPK(z[k]), (f32x2){cos_rev(rev), sin_rev(rev)}); } };
struct HyStYc { unsigned* yc; __device__ __forceinline__ void operator()(int k, int, int, f32x2 v) { const f32x2 w = v * (0.5f / 16384.0f); yc[k] = cvt_pk_bf16(w.x, w.y); } };
struct HyStComb { unsigned* z; const unsigned* yc; float bias;
    __device__ __forceinline__ void operator()(int k, int t, int, f32x2 v) { const float rev = (float)t * (1.0f / 32768.0f);
        const f32x2 yn = cmul(v, (f32x2){cos_rev(rev), -sin_rev(rev)}) * (0.5f / 16384.0f); const f32x2 y = yn + HY_UNPK(yc[k]) + HY_UNPK(z[k]) * bias; z[k] = cvt_pk_bf16(y.x, y.y); } };
template <bool NEG> __device__ __forceinline__ float hy_load_kernel(LAS f32x2* buf, int tid, const bf16* f0, const bf16* f1) {
    float part = 0.f;
#pragma unroll 2
    for (int r = 0; r < 4; ++r) { int tl = tid; asm volatile("" : "+v"(tl)); const int t0 = 8 * (tl + NTHR * r); const int fb = fsw(t0); float a[8], q[8];
        const u32x4 va = *(const GAS u32x4*)(f0 + t0), vr = *(const GAS u32x4*)(f1 + SEQ - t0 - 8); const float r0 = bf2f(f1[t0 > 0 ? SEQ - t0 : 0]);
        a[0] = bflo(va.x); a[1] = bfhi(va.x); a[2] = bflo(va.y); a[3] = bfhi(va.y); a[4] = bflo(va.z); a[5] = bfhi(va.z); a[6] = bflo(va.w); a[7] = bfhi(va.w);
        q[0] = t0 > 0 ? r0 : 0.f; q[1] = bfhi(vr.w); q[2] = bflo(vr.w); q[3] = bfhi(vr.z); q[4] = bflo(vr.z); q[5] = bfhi(vr.y); q[6] = bflo(vr.y); q[7] = bfhi(vr.x);
#pragma unroll
        for (int e = 0; e < 8; ++e) {
            if (!NEG) { part += fabsf(a[e]) + fabsf(q[e]); buf[fb ^ e] = (f32x2){a[e] + q[e], 0.f}; }
            else { const float rev = (float)(t0 + e) * (1.0f / 32768.0f), v = a[e] - q[e]; buf[fb ^ e] = (f32x2){v * cos_rev(rev), v * sin_rev(rev)}; } } }
    return part;
}
__device__ __forceinline__ void hy_conv8(const u32x4 v, float hm, float hp, float w0, float w1, float w2, float (&o)[8]) {
    const float x1 = bflo(v.x), x2 = bfhi(v.x), x3 = bflo(v.y), x4 = bfhi(v.y), x5 = bflo(v.z), x6 = bfhi(v.z), x7 = bflo(v.w), x8 = bfhi(v.w);
    o[0] = w0 * hm + w1 * x1 + w2 * x2; o[1] = w0 * x1 + w1 * x2 + w2 * x3; o[2] = w0 * x2 + w1 * x3 + w2 * x4; o[3] = w0 * x3 + w1 * x4 + w2 * x5;
    o[4] = w0 * x4 + w1 * x5 + w2 * x6; o[5] = w0 * x5 + w1 * x6 + w2 * x7; o[6] = w0 * x6 + w1 * x7 + w2 * x8; o[7] = w0 * x7 + w1 * x8 + w2 * hp;
}
__device__ __forceinline__ void hy_load_conv(LAS f32x2* buf, int tid, const bf16* UH, int ch, float w0, float w1, float w2) {
    const bf16* p0 = UH + (size_t)ch * SEQ; const bf16* p1 = UH + (size_t)(3072 + ch) * SEQ;
#pragma unroll 2
    for (int r = 0; r < 4; ++r) { int tl = tid; asm volatile("" : "+v"(tl)); const int t0 = 8 * (tl + NTHR * r); const int fb = fsw(t0);
        const int tm = t0 > 0 ? t0 - 1 : 0, tp = t0 + 8 < SEQ ? t0 + 8 : SEQ - 1;
        const u32x4 va = *(const GAS u32x4*)(p0 + t0), vb = *(const GAS u32x4*)(p1 + t0);
        float am = bf2f(p0[tm]), ap = bf2f(p0[tp]), bm = bf2f(p1[tm]), bp = bf2f(p1[tp]);
        if (t0 == 0) { am = 0.f; bm = 0.f; } if (t0 + 8 >= SEQ) { ap = 0.f; bp = 0.f; }
        float oa[8], ob[8]; hy_conv8(va, am, ap, w0, w1, w2, oa); hy_conv8(vb, bm, bp, w0, w1, w2, ob);
        buf[fb ^ 0] = (f32x2){oa[0], ob[0]}; buf[fb ^ 1] = (f32x2){oa[1], ob[1]}; buf[fb ^ 2] = (f32x2){oa[2], ob[2]}; buf[fb ^ 3] = (f32x2){oa[3], ob[3]};
        buf[fb ^ 4] = (f32x2){oa[4], ob[4]}; buf[fb ^ 5] = (f32x2){oa[5], ob[5]}; buf[fb ^ 6] = (f32x2){oa[6], ob[6]}; buf[fb ^ 7] = (f32x2){oa[7], ob[7]}; }
}
__device__ __forceinline__ void hyena_item(Frame& F, int c) {
    LAS f32x2* buf = (LAS f32x2*)F.lds;
    unsigned* KS = (unsigned*)(F.ws + WS_HYS + (size_t)F.bx * HYS_STRIDE);
    const bf16* FILT = (const bf16*)(F.ws + WS_FILT); const bf16* UH = (const bf16*)(F.ws + WS_UH);
    const int tid = F.tid; const int ft = fsw(tid);
#define FB(k) buf[ft + NTHR * (k)]
    const float* sw = F.in[IN_HSW];
    unsigned z[32], yc[32];
    HyStLds stl{buf}; HyLdLds ldl{buf};
    hy_load_conv(buf, tid, UH, c, sw[c], sw[3072 + c], sw[6144 + c]);
    __syncthreads();
#pragma unroll
    for (int k = 0; k < 32; ++k) { const f32x2 v_ = FB(k); z[k] = cvt_pk_bf16(v_.x, v_.y); }
#pragma unroll 1
    for (int o = 0; o < 2; ++o) {
        const bf16* f0 = FILT + (size_t)(o * 1024 + c) * SEQ; const bf16* f1 = FILT + (size_t)(2048 + o * 1024 + c) * SEQ;
        __syncthreads();
        const float part = hy_load_kernel<false>(buf, tid, f0, f1);
        const float inv = 1.0f / (block_sum(F, part) + 1e-6f);
        fft_edge_pass<false>(buf, tid, ldl, stl); __syncthreads();
        fft_pass<16, 10, false>(buf, tid); fft_pass<8, 6, false>(buf, tid);
        fft_last_to_ks(buf, tid, KS, inv); __syncthreads();
        { HyLdZ ldz{z}; fft_edge_pass<false>(buf, tid, ldz, stl); __syncthreads(); }
        fft_pass<16, 10, false>(buf, tid); fft_pass<8, 6, false>(buf, tid);
        fft_mid_mul(buf, tid, KS);
        fft_pass<8, 6, true>(buf, tid); fft_pass<16, 10, true>(buf, tid);
        { HyStYc styc{yc}; fft_edge_pass<true>(buf, tid, ldl, styc); }
        __syncthreads();
        (void)hy_load_kernel<true>(buf, tid, f0, f1); __syncthreads();
        fft_edge_pass<false>(buf, tid, ldl, stl); __syncthreads();
        fft_pass<16, 10, false>(buf, tid); fft_pass<8, 6, false>(buf, tid);
        fft_last_to_ks(buf, tid, KS, inv); __syncthreads();
        { HyLdZpsi ldzp{z}; fft_edge_pass<false>(buf, tid, ldzp, stl); __syncthreads(); }
        fft_pass<16, 10, false>(buf, tid); fft_pass<8, 6, false>(buf, tid);
        fft_mid_mul(buf, tid, KS);
        fft_pass<8, 6, true>(buf, tid); fft_pass<16, 10, true>(buf, tid);
        { HyStComb stc{z, yc, F.in[IN_HBIAS][o * 1024 + c]}; fft_edge_pass<true>(buf, tid, ldl, stc); }
#pragma unroll
        for (int k = 0; k < 32; ++k) FB(k) = HY_UNPK(z[k]);
        { const int xch = (o + 1) * 1024 + c; const float w0 = sw[xch], w1 = sw[3072 + xch], w2 = sw[6144 + xch];
#pragma unroll 8
          for (int k = 0; k < 32; ++k) { const int t = tid + NTHR * k; f32x2 v_ = FB(k); v_.x *= sconv(UH, 0, xch, t, w0, w1, w2); v_.y *= sconv(UH, 1, xch, t, w0, w1, w2); FB(k) = v_; } }
#pragma unroll
        for (int k = 0; k < 32; ++k) { const f32x2 v_ = FB(k); z[k] = cvt_pk_bf16(v_.x, v_.y); }
        __syncthreads();
    }
    bf16* YHCM = (bf16*)(F.ws + WS_YHCM);
#pragma unroll
    for (int k = 0; k < 32; ++k) FB(k) = HY_UNPK(z[k]);
#pragma unroll 8
    for (int k = 0; k < 32; ++k) { const int t = tid + NTHR * k; const f32x2 v_ = FB(k); YHCM[(size_t)c * SEQ + t] = (bf16)f2bf(v_.x); YHCM[(size_t)(1024 + c) * SEQ + t] = (bf16)f2bf(v_.y); }
    __syncthreads();
#undef FB
}
__device__ __forceinline__ void p4_hyena_carry(Frame& F, int qw) {
    volatile LAS int* qs = (volatile LAS int*)(F.lds + MISC_OFF + 64);
    for (;;) {
        __syncthreads();
        if (F.tid == 0) qs[0] = (int)__hip_atomic_fetch_add((unsigned*)(F.ctl + qw), 1u, __ATOMIC_RELAXED, __HIP_MEMORY_SCOPE_AGENT);
        __syncthreads();
        const int q = qs[0];
        if (q >= 32 + 1024) break;
        if (q < 1024) hyena_item(F, q); else s5_carry_item(F, q - 1024);
    }
}
__device__ __forceinline__ void yh_transpose(Frame& F) {
    const bf16* YHCM = (const bf16*)(F.ws + WS_YHCM); bf16* YH = (bf16*)(F.ws + WS_YH);
    LAS unsigned short* tl = (LAS unsigned short*)(F.lds + 8 * 8704 + F.wave * (64 * 72 * 2));
    const int gw = F.bx * NWAVES + F.wave, NGW = F.G * NWAVES, lane = F.lane;
    for (int it = gw; it < 2 * 16 * 256; it += NGW) {
        const int mt = it & 255, ct = (it >> 8) & 15, b = it >> 12; const int m0 = mt * 64, c0 = ct * 64;
#pragma unroll
        for (int j = 0; j < 8; ++j) { const int ch = 8 * j + (lane >> 3), mc = (lane & 7) * 8;
            const u32x4 v = *(const GAS u32x4*)(YHCM + (size_t)(b * 1024 + c0 + ch) * SEQ + m0 + mc); *(LAS u32x4*)(tl + ch * 72 + mc) = v; }
        LDS_WAIT(); asm volatile("" ::: "memory");
#pragma unroll
        for (int j = 0; j < 8; ++j) { const int mm = 8 * j + (lane >> 3), cc = (lane & 7) * 8; const int m = m0 + mm, w = m >> 8, r = m & 255;
            u32x4 o; o.x = (unsigned)tl[(cc + 0) * 72 + mm] | ((unsigned)tl[(cc + 1) * 72 + mm] << 16); o.y = (unsigned)tl[(cc + 2) * 72 + mm] | ((unsigned)tl[(cc + 3) * 72 + mm] << 16);
            o.z = (unsigned)tl[(cc + 4) * 72 + mm] | ((unsigned)tl[(cc + 5) * 72 + mm] << 16); o.w = (unsigned)tl[(cc + 6) * 72 + mm] | ((unsigned)tl[(cc + 7) * 72 + mm] << 16);
            *(GAS u32x4*)(YH + (size_t)(b * SEQ + r * 64 + w) * HYW + c0 + cc) = o; }
        LDS_WAIT(); asm volatile("" ::: "memory");
    }
}

struct SchedStd {
    int G, c, npn, K, nrep; const char* A; const char* Bt;
    __device__ __forceinline__ bool next(int i, pg8::Unit& u) const {
        int L = i * G + c; const int nwg = 128 * npn; u.e = 0; u.valid = 256;
        if (nrep > 1 && L >= nwg) L -= nwg;
        if (L >= nwg) return false;
        int wgid = L; { const int q = nwg / 8, xcd = wgid % 8, off = wgid / 8; wgid = xcd * q + off; }
        const int nig = 8 * npn, gid = wgid / nig; u.pm = gid * 8 + ((wgid % nig) % 8); u.pn = (wgid % nig) / 8; return true;
    }
    __device__ __forceinline__ unsigned a_row(const pg8::Unit& u, int r) const { return (unsigned)(u.pm * 256 + r); }
    __device__ __forceinline__ const char* a_base() const { return A; }
    __device__ __forceinline__ const char* b_base(const pg8::Unit& u) const { return Bt + (size_t)u.pn * 256 * K * 2; }
};
template <int MODE> struct EpiMix {
    static constexpr bool PERM = true, TRANS = true, FP8 = false;
    const bf16* P; const bf16* Q; bf16* O;
    __device__ __forceinline__ void operator()(const f32x4 (&acc)[2][2][4][2], const pg8::Unit& u, int wr, int wc, int fr, int fq) const {
        constexpr int ld = (MODE == 0) ? 1024 : 2048;
        const int col0 = u.pn * 256 + wc * 32 + 8 * fq;
#pragma unroll
        for (int ai = 0; ai < 2; ++ai)
#pragma unroll
            for (int m = 0; m < 4; ++m) { const size_t row = (size_t)u.pm * 256 + ai * 128 + wr * 64 + m * 16 + fr;
#pragma unroll
                for (int bj = 0; bj < 2; ++bj) { const int col = col0 + bj * 128; const f32x4 v0 = acc[ai][bj][m][0], v1 = acc[ai][bj][m][1]; float r[8];
                    if (MODE == 0) { const u32x4 y = *(const u32x4*)(P + row * 1024 + col);
                        r[0] = bflo(y.x) * sigmoidf_(v0[0]); r[1] = bfhi(y.x) * sigmoidf_(v0[1]); r[2] = bflo(y.y) * sigmoidf_(v0[2]); r[3] = bfhi(y.y) * sigmoidf_(v0[3]);
                        r[4] = bflo(y.z) * sigmoidf_(v1[0]); r[5] = bfhi(y.z) * sigmoidf_(v1[1]); r[6] = bflo(y.w) * sigmoidf_(v1[2]); r[7] = bfhi(y.w) * sigmoidf_(v1[3]); }
                    else { const u32x4 gg = *(const u32x4*)(P + row * 4096 + (MODE == 2 ? 2048 : 0) + col);
                        r[0] = bflo(gg.x) * v0[0]; r[1] = bfhi(gg.x) * v0[1]; r[2] = bflo(gg.y) * v0[2]; r[3] = bfhi(gg.y) * v0[3];
                        r[4] = bflo(gg.z) * v1[0]; r[5] = bfhi(gg.z) * v1[1]; r[6] = bflo(gg.w) * v1[2]; r[7] = bfhi(gg.w) * v1[3];
                        if (MODE == 2) { const u32x4 t1 = *(const u32x4*)(Q + row * 2048 + col);
                            r[0] += bflo(t1.x); r[1] += bfhi(t1.x); r[2] += bflo(t1.y); r[3] += bfhi(t1.y); r[4] += bflo(t1.z); r[5] += bfhi(t1.z); r[6] += bflo(t1.w); r[7] += bfhi(t1.w); } }
                    u32x4 w; w.x = cvt_pk_bf16(r[0], r[1]); w.y = cvt_pk_bf16(r[2], r[3]); w.z = cvt_pk_bf16(r[4], r[5]); w.w = cvt_pk_bf16(r[6], r[7]);
                    *(u32x4*)(O + row * ld + col) = w; } }
    }
};
struct EpiOut {
    static constexpr bool PERM = false, TRANS = true, FP8 = false;
    const float* X; const float* MOD; float* H1;
    __device__ __forceinline__ void operator()(const f32x4 (&acc)[2][2][4][2], const pg8::Unit& u, int wr, int wc, int fr, int fq) const {
        const int b = u.pm >> 6; const int col0 = u.pn * 256 + wc * 32 + 4 * fq;
        f32x4 gv[2][2];
#pragma unroll
        for (int bj = 0; bj < 2; ++bj)
#pragma unroll
            for (int n = 0; n < 2; ++n) gv[bj][n] = *(const f32x4*)(MOD + b * 12288 + 2 * 2048 + col0 + bj * 128 + n * 16);
#pragma unroll
        for (int ai = 0; ai < 2; ++ai)
#pragma unroll
            for (int m = 0; m < 4; ++m) { const size_t off = ((size_t)u.pm * 256 + ai * 128 + wr * 64 + m * 16 + fr) * D + col0;
#pragma unroll
                for (int bj = 0; bj < 2; ++bj)
#pragma unroll
                    for (int n = 0; n < 2; ++n) { const f32x4 xv = *(const f32x4*)(X + off + bj * 128 + n * 16); *(f32x4*)(H1 + off + bj * 128 + n * 16) = xv + gv[bj][n] * acc[ai][bj][m][n]; } }
    }
};

__device__ __forceinline__ void p10_router(Frame& F) {
    const int gw = F.bx * NWAVES + F.wave, NGW = F.G * NWAVES, lane = F.lane;
    const float* MOD = (const float*)(F.ws + WS_MOD); const float* g2n = F.in[IN_N2G]; const float* RWT = (const float*)(F.ws + WS_RWT); const float* rb = F.in[IN_RB];
    const float* H1 = (const float*)(F.ws + WS_H1); unsigned char* HM8 = (unsigned char*)(F.ws + WS_HM8); float* GATE = (float*)(F.ws + WS_GATE); int* LIST = (int*)(F.ws + WS_LIST);
    for (int m0 = 2 * gw; m0 < NTOK; m0 += 2 * NGW) {
        const int b = m0 >> 14;
        f32x4 h[2][8];
#pragma unroll
        for (int rr = 0; rr < 2; ++rr) { const float* xr = H1 + (size_t)(m0 + rr) * D; float s = 0.f;
#pragma unroll
            for (int j = 0; j < 8; ++j) { h[rr][j] = *(const GAS f32x4*)(xr + 4 * lane + 256 * j); s += (h[rr][j].x * h[rr][j].x + h[rr][j].y * h[rr][j].y) + (h[rr][j].z * h[rr][j].z + h[rr][j].w * h[rr][j].w); }
            const float rstd = 1.0f / sqrtf(wave_sum(s) * (1.0f / D) + 1e-6f);
            GAS unsigned* o = (GAS unsigned*)(HM8 + (size_t)(m0 + rr) * D) + lane;
#pragma unroll
            for (int j = 0; j < 8; ++j) { const int k = 4 * lane + 256 * j; const f32x4 g = *(const f32x4*)(g2n + k), sc = *(const f32x4*)(MOD + b * 12288 + 4 * 2048 + k), sh = *(const f32x4*)(MOD + b * 12288 + 3 * 2048 + k);
                h[rr][j] = h[rr][j] * rstd * g * (sc + 1.0f) + sh; o[64 * j] = pk4_fp8(h[rr][j].x, h[rr][j].y, h[rr][j].z, h[rr][j].w); } }
        float lg0 = -3.0e38f, lg1 = -3.0e38f;
#pragma unroll 2
        for (int e = 0; e < NEXP; ++e) { float s0 = 0.f, s1 = 0.f;
#pragma unroll
            for (int j = 0; j < 8; ++j) { const f32x4 w = *(const f32x4*)(RWT + e * 2048 + 4 * lane + 256 * j);
                s0 += (h[0][j].x * w.x + h[0][j].y * w.y) + (h[0][j].z * w.z + h[0][j].w * w.w); s1 += (h[1][j].x * w.x + h[1][j].y * w.y) + (h[1][j].z * w.z + h[1][j].w * w.w); }
            s0 = wave_sum(s0) + rb[e]; s1 = wave_sum(s1) + rb[e];
            if (lane == e) { lg0 = s0; lg1 = s1; } }
#pragma unroll
        for (int rr = 0; rr < 2; ++rr) { float lg = rr ? lg1 : lg0; int es[4]; float vs[4];
#pragma unroll
            for (int k = 0; k < 4; ++k) { const float mx = wave_max(lg); const unsigned long long bal = __ballot(lg == mx); const int idx = __ffsll((long long)bal) - 1; es[k] = idx; vs[k] = mx; if (lane == idx) lg = -3.0e38f; }
            const float e1 = __expf(vs[1] - vs[0]), e2 = __expf(vs[2] - vs[0]), e3 = __expf(vs[3] - vs[0]); const float inv = 1.0f / (1.0f + e1 + e2 + e3);
            if (lane < 4) { const int ee = lane == 0 ? es[0] : lane == 1 ? es[1] : lane == 2 ? es[2] : es[3]; const float gt = (lane == 0 ? 1.0f : lane == 1 ? e1 : lane == 2 ? e2 : e3) * inv;
                const int slot = (m0 + rr) * 4 + lane;
                const unsigned pos = __hip_atomic_fetch_add((unsigned*)(F.ctl + CW_CNT + 64 * ee), 1u, __ATOMIC_RELAXED, __HIP_MEMORY_SCOPE_AGENT);
                LIST[ee * LISTCAP + (int)pos] = slot; GATE[slot] = gt; } }
    }
}

__device__ __forceinline__ void moe_tables(Frame& F) {
    volatile LAS int* tb = (volatile LAS int*)(F.lds + LDS_X);
    __syncthreads();
    if (F.tid == 0) { int acc = 0; for (int e = 0; e < NEXP; ++e) { const int c = (int)__hip_atomic_load((unsigned*)(F.ctl + CW_CNT + 64 * e), __ATOMIC_RELAXED, __HIP_MEMORY_SCOPE_AGENT); tb[e] = acc; tb[64 + e] = c; acc += (c + 255) >> 8; } tb[32] = acc; }
    __syncthreads();
}
template <bool GATHER> struct SchedMoe {
    int G, c, npn, N, K, nrep; const char* A; const char* Bt; const int* LIST; volatile LAS int* tb;
    __device__ __forceinline__ bool next(int i, pg8::Unit& u) const {
        int L = i * G + c; { const int tot = tb[32] * npn; if (nrep > 1 && L >= tot) L -= tot; }
        int rt = L / npn, pnq = L % npn;
        if (G == 256 && nrep == 1) {
            const int x = c & 7, j = c >> 3;
            if (npn == 16) { pnq = 4 * (x & 3) + (j & 3); rt = 16 * i + (x >> 2) * 8 + (j >> 2); }
            else           { pnq = 2 * (x & 3) + (j & 1); rt = 32 * i + (x >> 2) * 16 + (j >> 1); }
        }
        if (rt >= tb[32]) return false;
        int e = 0;
        for (int q = 1; q < NEXP; ++q) e += (tb[q] <= rt) ? 1 : 0;
        e = __builtin_amdgcn_readfirstlane(e);
        u.pm = rt; u.pn = pnq; u.e = e; const int left = tb[64 + e] - 256 * (rt - tb[e]); u.valid = left < 256 ? left : 256; return true;
    }
    __device__ __forceinline__ unsigned a_row(const pg8::Unit& u, int r) const {
        if (GATHER) { return (r < u.valid) ? (unsigned)(LIST[u.e * LISTCAP + (u.pm - tb[u.e]) * 256 + r] >> 2) : 0u; }
        return (unsigned)(u.pm * 256 + r);
    }
    __device__ __forceinline__ const char* a_base() const { return A; }
    __device__ __forceinline__ const char* b_base(const pg8::Unit& u) const { return Bt + ((size_t)u.e * N + (size_t)u.pn * 256) * K; }
};
struct EpiMoe1 {
    static constexpr bool PERM = true, TRANS = true, FP8 = true;
    const float* BG; unsigned char* ACT;
    __device__ __forceinline__ void operator()(const f32x4 (&acc)[2][2][4][2], const pg8::Unit& u, int wr, int wc, int fr, int fq) const {
        const int c0 = u.pn * 256 + wc * 32 + 8 * fq;
        f32x4 bv[2][2];
#pragma unroll
        for (int bj = 0; bj < 2; ++bj)
#pragma unroll
            for (int n = 0; n < 2; ++n) bv[bj][n] = *(const f32x4*)(BG + (size_t)u.e * 4096 + c0 + bj * 128 + 4 * n);
#pragma unroll
        for (int ai = 0; ai < 2; ++ai)
#pragma unroll
            for (int m = 0; m < 4; ++m) { const size_t row = (size_t)u.pm * 256 + ai * 128 + wr * 64 + m * 16 + fr;
#pragma unroll
                for (int bj = 0; bj < 2; ++bj) { const f32x4 v0 = acc[ai][bj][m][0] * (1.0f / W8SCALE) + bv[bj][0], v1 = acc[ai][bj][m][1] * (1.0f / W8SCALE) + bv[bj][1]; float a[4];
#pragma unroll
                    for (int j = 0; j < 4; ++j) { const float gl = fminf(j < 2 ? v0[2 * j] : v1[2 * j - 4], 7.0f); const float ln = fminf(fmaxf(j < 2 ? v0[2 * j + 1] : v1[2 * j - 3], -7.0f), 7.0f);
                        a[j] = gl * sigmoidf_(1.702f * gl) * (ln + 1.0f); }
                    *(unsigned*)(ACT + row * DEXP + ((c0 + bj * 128) >> 1)) = pk4_fp8(a[0], a[1], a[2], a[3]); } }
    }
};
struct EpiMoe2 {
    static constexpr bool PERM = true, TRANS = true, FP8 = true;
    const float* BD; const float* GATE; const int* LIST; bf16* YS; volatile LAS int* tb;
    __device__ __forceinline__ void operator()(const f32x4 (&acc)[2][2][4][2], const pg8::Unit& u, int wr, int wc, int fr, int fq) const {
        const int c0 = u.pn * 256 + wc * 32 + 8 * fq; const int lbase = u.e * LISTCAP + (u.pm - tb[u.e]) * 256;
        f32x4 bv[2][2];
#pragma unroll
        for (int bj = 0; bj < 2; ++bj)
#pragma unroll
            for (int n = 0; n < 2; ++n) bv[bj][n] = *(const f32x4*)(BD + (size_t)u.e * D + c0 + bj * 128 + 4 * n);
#pragma unroll
        for (int ai = 0; ai < 2; ++ai)
#pragma unroll
            for (int m = 0; m < 4; ++m) { const int r = ai * 128 + wr * 64 + m * 16 + fr;
                if (r < u.valid) { const int slot = LIST[lbase + r]; const float gt = GATE[slot];
#pragma unroll
                    for (int bj = 0; bj < 2; ++bj) { const f32x4 v0 = (acc[ai][bj][m][0] * (1.0f / W8SCALE) + bv[bj][0]) * gt, v1 = (acc[ai][bj][m][1] * (1.0f / W8SCALE) + bv[bj][1]) * gt;
                        u32x4 w; w.x = cvt_pk_bf16(v0[0], v0[1]); w.y = cvt_pk_bf16(v0[2], v0[3]); w.z = cvt_pk_bf16(v1[0], v1[1]); w.w = cvt_pk_bf16(v1[2], v1[3]);
                        *(u32x4*)(YS + (size_t)slot * D + c0 + bj * 128) = w; } } }
    }
};
__device__ __forceinline__ void p13_final(Frame& F) {
    const int gw = F.bx * NWAVES + F.wave, NGW = F.G * NWAVES, lane = F.lane;
    const float* MOD = (const float*)(F.ws + WS_MOD); const float* fg = F.in[IN_FG]; const bf16* YS = (const bf16*)(F.ws + WS_YS); float* O = F.out;
    for (int m = gw; m < NTOK; m += NGW) {
        const int b = m >> 14; float* xr = O + (size_t)m * D; const float* hr = (const float*)(F.ws + WS_H1) + (size_t)m * D; f32x4 h[8]; float s = 0.f;
#pragma unroll
        for (int j = 0; j < 8; ++j) { const int k = 4 * lane + 256 * j; f32x4 a = (f32x4){0.f, 0.f, 0.f, 0.f};
#pragma unroll
            for (int q = 0; q < 4; ++q) { const u32x2 y = *(const GAS u32x2*)(YS + (size_t)(m * 4 + q) * D + k); a += (f32x4){bflo(y.x), bfhi(y.x), bflo(y.y), bfhi(y.y)}; }
            const f32x4 g2 = *(const f32x4*)(MOD + b * 12288 + 5 * 2048 + k);
            h[j] = *(const GAS f32x4*)(hr + k) + g2 * a; s += (h[j].x * h[j].x + h[j].y * h[j].y) + (h[j].z * h[j].z + h[j].w * h[j].w); }
        const float rstd = 1.0f / sqrtf(wave_sum(s) * (1.0f / D) + 1e-6f);
#pragma unroll
        for (int j = 0; j < 8; ++j) { const int k = 4 * lane + 256 * j; *(GAS f32x4*)(xr + k) = h[j] * rstd * *(const f32x4*)(fg + k); }
    }
}

__global__ void __launch_bounds__(NTHR, 2) fwd(Args args) {
    extern __shared__ __attribute__((aligned(16))) unsigned char lds_raw[];
    Frame F;
    F.lds = (LAS unsigned char*)lds_raw;
    F.tid = threadIdx.x; F.lane = F.tid & 63; F.wave = __builtin_amdgcn_readfirstlane(F.tid >> 6);
    F.G = gridDim.x; F.bx = blockIdx.x; F.in = args.in; F.out = args.out; F.ws = args.ws; F.ctl = (GAS unsigned*)(args.ws + WS_CTL);
    for (int u = F.tid; u < (LDS_BYTES - MISC_OFF) / 4; u += NTHR) ((LAS unsigned*)(F.lds + MISC_OFF))[u] = 0u;
    __syncthreads();
    const int lo = args.ph_lo, hi = args.ph_hi;
    XcdBarrier bar; bar.bar = (unsigned*)(F.ctl + CW_BAR); bar.x = 0; bar.st = nullptr;
    if (hi - lo > 1) bar = xcd_barrier_post((unsigned*)(F.ctl + CW_BAR), (volatile LAS unsigned*)(F.lds + MISC_OFF));
#ifndef PH_MASK
#define PH_MASK 0xffff
#endif
#define IN(k) (((PH_MASK >> (k)) & 1) && lo <= (k) && (k) < hi)
#define SEAM(k) do { if (IN(k) && IN((k) + 1)) xcd_barrier(bar); } while (0)
    unsigned char* ws = args.ws;
#ifndef PROBE_DUP
#define PROBE_DUP 0
#endif
#define DUPBAR(k) if ((PROBE_DUP >> (k)) & 1) xcd_barrier(bar)
#define DUP2(k, body) do { body; if ((PROBE_DUP >> (k)) & 1) { xcd_barrier(bar); body; } } while (0)
    if (IN(0)) { DUP2(0, p0_prologue(F)); } SEAM(0);
    if (IN(1)) { DUP2(1, p1_norm(F)); } SEAM(1);
    if (IN(2)) { {
        { SchedIn S{F.G, F.bx, 128 * 4, 4, 0, ((PROBE_DUP >> 2) & 1) ? 2 : 1, (const char*)(ws + WS_U), (const char*)(ws + WS_WIN)}; EpiInA E{ws};
          pg8::gemm_phase<EpiInA, SchedIn>(F.lds, D, S, E); }
        { SchedIn S{F.G, F.bx, 128 * 16, 16, 2, ((PROBE_DUP >> 2) & 1) ? 2 : 1, (const char*)(ws + WS_U8), (const char*)(ws + WS_WIN8)}; EpiInG8 E{(bf16*)(ws + WS_UG)};
          pg8::gemm_phase<EpiInG8, SchedIn>(F.lds, D, S, E); }
        { SchedIn S{F.G, F.bx, 128 * 12, 12, 1, ((PROBE_DUP >> 2) & 1) ? 2 : 1, (const char*)(ws + WS_U), (const char*)(ws + WS_WIN)}; EpiInH E{(bf16*)(ws + WS_UH)};
          pg8::gemm_phase<EpiInH, SchedIn>(F.lds, D, S, E); }
        }
    } SEAM(2);
    if (IN(3)) { DUP2(3, s5_pass3<false>(F)); } SEAM(3);
    if (IN(4)) { int q4w = CW_Q4; DUP2(4, (p4_hyena_carry(F, q4w), q4w += 16)); } SEAM(4);
    if (IN(5)) { DUP2(5, s5_pass3<true>(F)); __syncthreads(); DUP2(14, yh_transpose(F)); } SEAM(5);
    if (IN(6)) { { SchedStd S{F.G, F.bx, 4, 1024, ((PROBE_DUP >> 6) & 1) ? 2 : 1, (const char*)(ws + WS_Y), (const char*)(ws + WS_WGLU)}; EpiMix<0> E{(const bf16*)(ws + WS_Y), nullptr, (bf16*)(ws + WS_YA)};
        pg8::gemm_phase<EpiMix<0>, SchedStd>(F.lds, 1024, S, E); } } SEAM(6);
    if (IN(7)) { { SchedStd S{F.G, F.bx, 8, 1024, ((PROBE_DUP >> 7) & 1) ? 2 : 1, (const char*)(ws + WS_YA), (const char*)(ws + WS_WBS5)}; EpiMix<1> E{(const bf16*)(ws + WS_UG), nullptr, (bf16*)(ws + WS_T1)};
        pg8::gemm_phase<EpiMix<1>, SchedStd>(F.lds, 1024, S, E); } } SEAM(7);
    if (IN(8)) { { SchedStd S{F.G, F.bx, 8, 1024, ((PROBE_DUP >> 8) & 1) ? 2 : 1, (const char*)(ws + WS_YH), (const char*)(ws + WS_WBHY)}; EpiMix<2> E{(const bf16*)(ws + WS_UG), (const bf16*)(ws + WS_T1), (bf16*)(ws + WS_T)};
        pg8::gemm_phase<EpiMix<2>, SchedStd>(F.lds, 1024, S, E); } } SEAM(8);
    if (IN(9)) { { SchedStd S{F.G, F.bx, 8, 2048, ((PROBE_DUP >> 9) & 1) ? 2 : 1, (const char*)(ws + WS_T), (const char*)(ws + WS_WO)}; EpiOut E{F.in[IN_X], (const float*)(ws + WS_MOD), (float*)(ws + WS_H1)};
        pg8::gemm_phase<EpiOut, SchedStd>(F.lds, 2048, S, E); } } SEAM(9);
    if (IN(10)) { p10_router(F); } SEAM(10);
    if (IN(11)) { { moe_tables(F); volatile LAS int* tb = (volatile LAS int*)(F.lds + LDS_X);
        SchedMoe<true> S{F.G, F.bx, 16, 4096, 2048, ((PROBE_DUP >> 11) & 1) ? 2 : 1, (const char*)(ws + WS_HM8), (const char*)(ws + WS_WGU), (const int*)(ws + WS_LIST), tb}; EpiMoe1 E{F.in[IN_BGU], (unsigned char*)(ws + WS_ACT)};
        pg8::gemm_phase<EpiMoe1, SchedMoe<true>>(F.lds, 2048, S, E); } } SEAM(11);
    if (IN(12)) { { moe_tables(F); volatile LAS int* tb = (volatile LAS int*)(F.lds + LDS_X);
        SchedMoe<false> S{F.G, F.bx, 8, 2048, 2048, ((PROBE_DUP >> 12) & 1) ? 2 : 1, (const char*)(ws + WS_ACT), (const char*)(ws + WS_WDN), (const int*)(ws + WS_LIST), tb}; EpiMoe2 E{F.in[IN_BDN], (const float*)(ws + WS_GATE), (const int*)(ws + WS_LIST), (bf16*)(ws + WS_YS), tb};
        pg8::gemm_phase<EpiMoe2, SchedMoe<false>>(F.lds, 2048, S, E); } } SEAM(12);
    if (IN(13)) { DUP2(13, p13_final(F)); }
#undef IN
#undef SEAM
}

extern "C" void kernel_launch(void* const* d_in, const int* in_sizes, int n_in, void* d_out, int out_size, void* d_ws, size_t ws_size, hipStream_t stream) {
    static int grid = 0;
    if (grid == 0) {
        if (n_in != 39 || out_size != NTOK * D || ws_size < WS_END) { fprintf(stderr, "kernel_launch: unexpected shapes: n_in %d out %d ws %zu (need %zu)\n", n_in, out_size, ws_size, (size_t)WS_END); grid = -1; return; }
        int dev = 0, cus = 0, per_cu = 0;
        if (hipGetDevice(&dev) != hipSuccess || hipDeviceGetAttribute(&cus, hipDeviceAttributeMultiprocessorCount, dev) != hipSuccess) { grid = -1; return; }
        if (hipFuncSetAttribute((const void*)fwd, hipFuncAttributeMaxDynamicSharedMemorySize, LDS_BYTES) != hipSuccess) { fprintf(stderr, "kernel_launch: hipFuncSetAttribute failed\n"); grid = -1; return; }
        if (hipOccupancyMaxActiveBlocksPerMultiprocessor(&per_cu, (const void*)fwd, NTHR, LDS_BYTES) != hipSuccess || per_cu < 1) fprintf(stderr, "kernel_launch: occupancy query says %d\n", per_cu);
        (void)hipGetLastError();
        grid = cus;
    }
    if (grid < 0) return;
    if (hipMemsetAsync((char*)d_ws + WS_CTL, 0, CTL_ZERO_BYTES, stream) != hipSuccess) return;
    Args a{};
    for (int i = 0; i < 39; ++i) a.in[i] = (const float*)d_in[i];
    a.out = (float*)d_out; a.ws = (unsigned char*)d_ws;
#ifndef ONE_LAUNCH
#define ONE_LAUNCH 1
#endif
    if (ONE_LAUNCH) { a.ph_lo = 0; a.ph_hi = NPHASE; hipLaunchKernelGGL(fwd, dim3(grid), dim3(NTHR), LDS_BYTES, stream, a); }
    else for (int p = 0; p < NPHASE; ++p) { a.ph_lo = p; a.ph_hi = p + 1; hipLaunchKernelGGL(fwd, dim3(grid), dim3(NTHR), LDS_BYTES, stream, a); }
}
```

```cpp
#include <hip/hip_runtime.h>
#include <cstdio>
#include <cstdint>

#define GAS __attribute__((address_space(1)))
#define LAS __attribute__((address_space(3)))
typedef unsigned short bf16;
typedef short bf16x8 __attribute__((ext_vector_type(8)));
typedef float f32x4 __attribute__((ext_vector_type(4)));
typedef float f32x16 __attribute__((ext_vector_type(16)));
typedef float f32x2 __attribute__((ext_vector_type(2)));
typedef unsigned u32x4 __attribute__((ext_vector_type(4)));
typedef unsigned u32x2 __attribute__((ext_vector_type(2)));
typedef int i32x4 __attribute__((ext_vector_type(4)));
typedef int i32x8 __attribute__((ext_vector_type(8)));

constexpr int D = 2048, NB = 2, SEQ = 16384, NTOK = NB * SEQ, CTX = 256, NCTX = NB * CTX;
constexpr int S5W = 1024, HYW = 1024, INC = 8192, NEXP = 32, TOPK = 4, DEXP = 2048;
constexpr int NCH = 260;
constexpr int LISTCAP = 32768;

constexpr size_t MiB = 1u << 20;
constexpr size_t WS_CTL = 0, CTL_ZERO_BYTES = 1 * MiB;
constexpr size_t WS_MOD = 6 * MiB;
constexpr size_t WS_BBT = 7 * MiB;
constexpr size_t WS_CTT = WS_BBT + 512 * 1024;
constexpr size_t WS_LAM = 8 * MiB;
constexpr size_t WS_RWT = 8 * MiB + 256 * 1024;
constexpr size_t WS_BB2 = 8 * MiB + 512 * 1024;
constexpr size_t WS_WIN = 16 * MiB;
constexpr size_t WS_WGLU = 48 * MiB;
constexpr size_t WS_WBS5 = 50 * MiB;
constexpr size_t WS_WBHY = 54 * MiB;
constexpr size_t WS_WO = 58 * MiB;
constexpr size_t WS_WGU = 66 * MiB;
constexpr size_t WS_WDN = 578 * MiB;
constexpr size_t WS_U = 834 * MiB;
constexpr size_t WS_UCA = 964 * MiB;
constexpr size_t WS_UA = 966 * MiB;
constexpr size_t WS_UH = 1030 * MiB;
constexpr size_t WS_UG = 1222 * MiB;
constexpr size_t WS_E = 1478 * MiB;
constexpr size_t WS_SIN = 1511 * MiB;
constexpr size_t WS_FILT = 1544 * MiB;
constexpr size_t WS_HYS = 1800 * MiB;
constexpr size_t HYS_STRIDE = 768 * 1024;
constexpr size_t WS_YHCM = 1992 * MiB;
constexpr size_t WS_YH = 2056 * MiB;
constexpr size_t WS_Y = 2120 * MiB;
constexpr size_t WS_YA = 2184 * MiB;
constexpr size_t WS_T1 = 2248 * MiB;
constexpr size_t WS_T = 2376 * MiB;
constexpr size_t WS_HM = 2504 * MiB;
constexpr size_t WS_GATE = 2632 * MiB;
constexpr size_t WS_LIST = 2633 * MiB;
constexpr size_t WS_ACT = 2638 * MiB;
constexpr size_t WS_YS = 3182 * MiB;
constexpr size_t WS_H1 = 3694 * MiB;
constexpr size_t WS_HM8 = WS_T1;
constexpr size_t WS_U8 = WS_ACT;
constexpr size_t WS_WIN8 = WS_YS;
constexpr size_t WS_END = 3950 * MiB;
constexpr long long YS_DUMP_OFF = ((long long)(2 * MiB) - (long long)WS_YS) / 2;

constexpr int CW_TMO = 0;
constexpr int CW_Q4 = 64;
constexpr int CW_CNT = 128;
constexpr int CW_BAR = 4096;

constexpr int RING_BYTES = 131072;
constexpr int LDS_X = 131072;
constexpr int MISC_OFF = 147456 - 512;
constexpr int LDS_BYTES = 147456;
constexpr int NWAVES = 8, NTHR = 512;
constexpr int NPHASE = 14;

__device__ __forceinline__ unsigned f2bf(float f) { unsigned u = __builtin_bit_cast(unsigned, f); return (u + 0x7fffu + ((u >> 16) & 1u)) >> 16; }
__device__ __forceinline__ unsigned pk2(float lo, float hi) { return f2bf(lo) | (f2bf(hi) << 16); }
__device__ __forceinline__ float bf2f(unsigned short b) { return __builtin_bit_cast(float, ((unsigned)b) << 16); }
__device__ __forceinline__ float bflo(unsigned w) { return __builtin_bit_cast(float, w << 16); }
__device__ __forceinline__ float bfhi(unsigned w) { return __builtin_bit_cast(float, w & 0xffff0000u); }
typedef __bf16 bf16x2_t __attribute__((ext_vector_type(2)));
__device__ __forceinline__ unsigned cvt_pk_bf16(float lo, float hi) { const f32x2 v = {lo, hi}; const bf16x2_t b = __builtin_convertvector(v, bf16x2_t); return __builtin_bit_cast(unsigned, b); }
__device__ __forceinline__ unsigned pk4_fp8(float a, float b, float c, float d) { unsigned w = 0u; w = (unsigned)__builtin_amdgcn_cvt_pk_fp8_f32(a, b, (int)w, false); w = (unsigned)__builtin_amdgcn_cvt_pk_fp8_f32(c, d, (int)w, true); return w; }
constexpr float W8SCALE = 64.0f;
__device__ __forceinline__ float sigmoidf_(float x) { return __builtin_amdgcn_rcpf(1.0f + __expf(-x)); }
__device__ __forceinline__ float sin_rev(float r) { return __builtin_amdgcn_sinf(__builtin_amdgcn_fractf(r)); }
__device__ __forceinline__ float cos_rev(float r) { return __builtin_amdgcn_cosf(__builtin_amdgcn_fractf(r)); }
__device__ __forceinline__ float wave_sum(float v) {
#pragma unroll
    for (int o = 1; o < 64; o <<= 1) v += __shfl_xor(v, o);
    return v;
}
__device__ __forceinline__ float wave_max(float v) {
#pragma unroll
    for (int o = 1; o < 64; o <<= 1) v = fmaxf(v, __shfl_xor(v, o));
    return v;
}
__device__ __forceinline__ f32x2 cmul(f32x2 a, f32x2 b) { return (f32x2){a.x * b.x - a.y * b.y, a.x * b.y + a.y * b.x}; }
#define LDS_WAIT() asm volatile("s_waitcnt lgkmcnt(0)" ::: "memory")
#define VM_WAIT() asm volatile("s_waitcnt vmcnt(0)" ::: "memory")

namespace pg8 {
constexpr int BM = 256, BK = 64, HALF = 128, HTB = HALF * BK * 2, STAGE_BYTES = 8 * HTB;
__host__ __device__ __forceinline__ int lds_byte(int r, int c) { const int st = (r >> 4) * 2 + (c >> 5), rr = r & 15, cc = c & 31, ob = rr * 64 + cc * 2; return st * 1024 + (ob ^ (((ob >> 9) & 1) << 5)); }
__host__ __device__ __forceinline__ void stage_rc(int b, int& R, int& C) { const int st = b / 1024, sb = b % 1024, swz = sb ^ (((sb >> 9) & 1) << 5); R = (st >> 1) * 16 + swz / 64; C = (st & 1) * 32 + (swz % 64) / 2; }
__host__ __device__ __forceinline__ int perm32(int rho) { const int n = rho >> 4, i = rho & 15; return 8 * (i >> 2) + 4 * n + (i & 3); }

struct Unit { int pm, pn, e, valid; };

template <class Epi, class Sched>
__device__ __forceinline__ void gemm_phase(LAS unsigned char* lds, const int Kel, const Sched& S, const Epi& E) {
    const int tid = threadIdx.x, wid = __builtin_amdgcn_readfirstlane(tid >> 6), lane = tid & 63, wr = wid >> 2, wc = wid & 3, fr = lane & 15, fq = lane >> 4;
    const int K = Epi::FP8 ? (Kel >> 1) : Kel;
    const int nt = K / BK;
    int Rs[2], Cs[2]; unsigned voffB[2];
#pragma unroll
    for (int i = 0; i < 2; ++i) { int R, C; stage_rc(tid * 16 + i * 8192, R, C); Rs[i] = R; Cs[i] = C; const int Rb = Epi::PERM ? ((R & ~31) + perm32(R & 31)) : R; voffB[i] = (unsigned)(Rb * K + C) * 2u; }
    const size_t kstep = (size_t)(BK * 2);
    const size_t hstep = (size_t)HALF * K * 2;
    const unsigned ldsw = (unsigned)wid * 1024u;
    const int aoff = lds_byte(wr * 64 + fr, fq * 8), boff = lds_byte(wc * 32 + fr, fq * 8);
    const int aoff8 = lds_byte(wr * 64 + fr, fq * 16), boff8 = lds_byte(wc * 32 + fr, fq * 16);
#define PG8_SA(b, h) (((b) * 2 + (h)) * HTB)
#define PG8_SB(b, h) ((4 + (b) * 2 + (h)) * HTB)
#define PG8_STAGE(bufoff, gbase, voff) do { _Pragma("unroll") for (int _i = 0; _i < 2; ++_i) \
        __builtin_amdgcn_global_load_lds((const unsigned*)((const char*)(gbase) + (voff)[_i]), (LAS unsigned*)(lds + (bufoff) + ldsw + _i * 8192), 16, 0, 0); } while (0)
#define PG8_LDA(dst, b, h) do { if constexpr (Epi::FP8) { _Pragma("unroll") for (int m = 0; m < 4; ++m) { const i32x4 lo_ = *(const LAS i32x4*)(lds + PG8_SA(b, h) + aoff8 + m * 2048), hi_ = *(const LAS i32x4*)(lds + PG8_SA(b, h) + aoff8 + m * 2048 + 16); dst##8[m] = __builtin_shufflevector(lo_, hi_, 0, 1, 2, 3, 4, 5, 6, 7); } } \
        else { _Pragma("unroll") for (int m = 0; m < 4; ++m) _Pragma("unroll") for (int k = 0; k < 2; ++k) dst[m][k] = *(const LAS bf16x8*)(lds + PG8_SA(b, h) + aoff + m * 2048 + k * 1024); } } while (0)
#define PG8_LDB(dst, b, h) do { if constexpr (Epi::FP8) { _Pragma("unroll") for (int n = 0; n < 2; ++n) { const i32x4 lo_ = *(const LAS i32x4*)(lds + PG8_SB(b, h) + boff8 + n * 2048), hi_ = *(const LAS i32x4*)(lds + PG8_SB(b, h) + boff8 + n * 2048 + 16); dst##8[n] = __builtin_shufflevector(lo_, hi_, 0, 1, 2, 3, 4, 5, 6, 7); } } \
        else { _Pragma("unroll") for (int n = 0; n < 2; ++n) _Pragma("unroll") for (int k = 0; k < 2; ++k) dst[n][k] = *(const LAS bf16x8*)(lds + PG8_SB(b, h) + boff + n * 2048 + k * 1024); } } while (0)
#define PG8_MMA(ai, bj, At, Bt) do { __builtin_amdgcn_s_setprio(1); \
        if constexpr (Epi::FP8) { _Pragma("unroll") for (int m = 0; m < 4; ++m) _Pragma("unroll") for (int n = 0; n < 2; ++n) \
            asm volatile("v_mfma_scale_f32_16x16x128_f8f6f4 %0, %1, %2, %0, %3, %3 op_sel_hi:[0,0,0]" : "+v"(acc[ai][bj][m][n]) : "v"(Bt##8[n]), "v"(At##8[m]), "v"(scl1)); } \
        else { _Pragma("unroll") for (int m = 0; m < 4; ++m) _Pragma("unroll") for (int n = 0; n < 2; ++n) _Pragma("unroll") for (int k = 0; k < 2; ++k) \
        acc[ai][bj][m][n] = Epi::TRANS ? __builtin_amdgcn_mfma_f32_16x16x32_bf16(Bt[n][k], At[m][k], acc[ai][bj][m][n], 0, 0, 0) \
                                       : __builtin_amdgcn_mfma_f32_16x16x32_bf16(At[m][k], Bt[n][k], acc[ai][bj][m][n], 0, 0, 0); } __builtin_amdgcn_s_setprio(0); } while (0)
#define PG8_WAIT_V(n) asm volatile("s_waitcnt vmcnt(" #n ")" ::: "memory")
#define PG8_WAIT_L(n) asm volatile("s_waitcnt lgkmcnt(" #n ")" ::: "memory")
#define PG8_BAR __builtin_amdgcn_s_barrier()
#define PG8_SCHED __builtin_amdgcn_sched_barrier(0)
    Unit cur, nxt; int ui = 0;
    if (!S.next(0, cur)) return;
    f32x4 acc[2][2][4][2];
#pragma unroll
    for (int a = 0; a < 2; ++a)
#pragma unroll
        for (int b = 0; b < 2; ++b)
#pragma unroll
            for (int m = 0; m < 4; ++m)
#pragma unroll
                for (int n = 0; n < 2; ++n) acc[a][b][m][n] = (f32x4){0.f, 0.f, 0.f, 0.f};
    bf16x8 At[4][2], B0[2][2], B1[2][2]; i32x8 At8[4], B08[2], B18[2]; const int scl1 = 0x7F7F7F7F;
    const char* const Ab = S.a_base();
    const char* cB = S.b_base(cur);
    unsigned vC0[2], vC1[2];
#pragma unroll
    for (int i = 0; i < 2; ++i) { vC0[i] = (S.a_row(cur, Rs[i]) * (unsigned)K + (unsigned)Cs[i]) * 2u; vC1[i] = (S.a_row(cur, HALF + Rs[i]) * (unsigned)K + (unsigned)Cs[i]) * 2u; }
    PG8_STAGE(PG8_SB(0, 0), cB, voffB); PG8_STAGE(PG8_SB(0, 1), cB + hstep, voffB); PG8_STAGE(PG8_SA(0, 0), Ab, vC0); PG8_STAGE(PG8_SA(0, 1), Ab, vC1);
    if (wr == 1) PG8_BAR;
    PG8_WAIT_V(2); PG8_BAR;
    PG8_STAGE(PG8_SB(1, 0), cB + kstep, voffB); PG8_STAGE(PG8_SA(1, 0), Ab + kstep, vC0); PG8_STAGE(PG8_SB(1, 1), cB + hstep + kstep, voffB);
    PG8_WAIT_V(6); PG8_BAR;
    for (;;) {
        const bool has_next = S.next(ui + 1, nxt);
        const char* nB = has_next ? S.b_base(nxt) : cB;
        for (int t = 0; t < nt; t += 2) {
            const bool last = (t == nt - 2);
            const char* a1 = Ab + (size_t)(t + 1) * kstep;
            const char* a2 = last ? Ab : Ab + (size_t)(t + 2) * kstep; const char* b2 = last ? nB : cB + (size_t)(t + 2) * kstep;
            const char* a3 = a2 + kstep; const char* b3 = b2 + kstep;
            unsigned vX0[2], vX1[2];
            if (last && has_next) {
#pragma unroll
                for (int i = 0; i < 2; ++i) { vX0[i] = (S.a_row(nxt, Rs[i]) * (unsigned)K + (unsigned)Cs[i]) * 2u; vX1[i] = (S.a_row(nxt, HALF + Rs[i]) * (unsigned)K + (unsigned)Cs[i]) * 2u; }
            } else {
#pragma unroll
                for (int i = 0; i < 2; ++i) { vX0[i] = vC0[i]; vX1[i] = vC1[i]; }
            }
            PG8_LDB(B0, 0, 0); PG8_LDB(B1, 0, 1); PG8_SCHED; PG8_LDA(At, 0, 0); PG8_STAGE(PG8_SA(1, 1), a1, vC1);
            PG8_WAIT_V(8); PG8_WAIT_L(0); PG8_BAR; PG8_MMA(0, 0, At, B0); PG8_MMA(0, 1, At, B1); PG8_BAR; PG8_SCHED;
            PG8_LDA(At, 0, 1); PG8_STAGE(PG8_SB(0, 0), b2, voffB); PG8_STAGE(PG8_SB(0, 1), b2 + hstep, voffB); PG8_STAGE(PG8_SA(0, 0), a2, vX0);
            PG8_WAIT_V(8); PG8_WAIT_L(0); PG8_BAR; PG8_MMA(1, 0, At, B0); PG8_MMA(1, 1, At, B1); PG8_BAR; PG8_SCHED;
            PG8_LDB(B0, 1, 0); PG8_LDB(B1, 1, 1); PG8_SCHED; PG8_LDA(At, 1, 0); PG8_STAGE(PG8_SA(0, 1), a2, vX1);
            PG8_WAIT_V(8); PG8_WAIT_L(0); PG8_BAR; PG8_MMA(0, 0, At, B0); PG8_MMA(0, 1, At, B1); PG8_BAR; PG8_SCHED;
            PG8_LDA(At, 1, 1); PG8_STAGE(PG8_SB(1, 0), b3, voffB); PG8_STAGE(PG8_SB(1, 1), b3 + hstep, voffB); PG8_STAGE(PG8_SA(1, 0), a3, vX0);
            PG8_WAIT_V(8); PG8_WAIT_L(0); PG8_BAR; PG8_MMA(1, 0, At, B0); PG8_MMA(1, 1, At, B1); PG8_BAR; PG8_SCHED;
            if (last) {
#pragma unroll
                for (int i = 0; i < 2; ++i) { vC0[i] = vX0[i]; vC1[i] = vX1[i]; }
            }
        }
        if (wr == 0) PG8_BAR;
        if constexpr (Epi::FP8) asm volatile("s_nop 15\n\ts_nop 15" ::: "memory");
        E(acc, cur, wr, wc, fr, fq);
        if (!has_next) break;
#pragma unroll
        for (int a = 0; a < 2; ++a)
#pragma unroll
            for (int b = 0; b < 2; ++b)
#pragma unroll
                for (int m = 0; m < 4; ++m)
#pragma unroll
                    for (int n = 0; n < 2; ++n) acc[a][b][m][n] = (f32x4){0.f, 0.f, 0.f, 0.f};
        cur = nxt; cB = nB; ++ui;
        if (wr == 1) PG8_BAR;
    }
    PG8_WAIT_V(0);
    PG8_BAR;
#undef PG8_SA
#undef PG8_SB
#undef PG8_STAGE
#undef PG8_LDA
#undef PG8_LDB
#undef PG8_MMA
#undef PG8_WAIT_V
#undef PG8_WAIT_L
#undef PG8_BAR
#undef PG8_SCHED
}
}

#define XB_TMO      128
#define XB_XCNT(j)  (256  + 64 * (j))
#define XB_XSUB(j)  (1280 + 64 * (j))
#define XB_XGEN(j)  (2304 + 64 * (j))
#define XB_TOP      3328
#define XB_TOPGEN   3392
#define XCD_BAR_WORDS 3456
#define XB_SPIN_CAP (1u << 22)
__device__ __forceinline__ unsigned xb_ld(unsigned* p)              { return __hip_atomic_load(p, __ATOMIC_RELAXED, __HIP_MEMORY_SCOPE_AGENT); }
__device__ __forceinline__ unsigned xb_add(unsigned* p, unsigned v) { return __hip_atomic_fetch_add(p, v, __ATOMIC_RELAXED, __HIP_MEMORY_SCOPE_AGENT); }
__device__ __forceinline__ unsigned xb_xcc_id() { return (unsigned)__builtin_amdgcn_s_getreg((3 << 11) | 20) & 0xFu; }
#define XB_SPIN(cond, bar) do { unsigned _sp = 0; while (cond) { __builtin_amdgcn_s_sleep(1); \
    if ((++_sp & 255u) == 0u) { if (xb_ld(&(bar)[XB_TMO])) break; if (_sp > XB_SPIN_CAP) { atomicAdd(&(bar)[XB_TMO], 1u); break; } } } } while (0)
struct XcdBarrier { unsigned* bar; unsigned x; volatile LAS unsigned* st; };
__device__ __forceinline__ XcdBarrier xcd_barrier_post(unsigned* bar, volatile LAS unsigned* st) {
    XcdBarrier b; b.bar = bar; b.x = xb_xcc_id(); b.st = st;
    if (threadIdx.x == 0) (void)xb_add(&bar[XB_XCNT(b.x)], 1u);
    return b;
}
__device__ __forceinline__ void xcd_barrier_complete(unsigned* bar, unsigned x, unsigned& nloc, unsigned& nx) {
    const unsigned G = gridDim.x * gridDim.y * gridDim.z;
    unsigned sum, cnt, mine, sp = 0u;
    for (;;) {
        sum = 0u; cnt = 0u; mine = 0u;
#pragma unroll
        for (unsigned j = 0; j < 16; ++j) { const unsigned c = xb_ld(&bar[XB_XCNT(j)]); sum += c; cnt += (c > 0u) ? 1u : 0u; mine = (j == x) ? c : mine; }
        if (sum == G) break;
        __builtin_amdgcn_s_sleep(1);
        if ((++sp & 255u) == 0u) { if (xb_ld(&bar[XB_TMO])) break; if (sp > XB_SPIN_CAP) { atomicAdd(&bar[XB_TMO], 1u); break; } }
    }
    nloc = mine > 0u ? mine : 1u; nx = cnt > 0u ? cnt : 1u;
}
__device__ __forceinline__ void xcd_barrier(const XcdBarrier& b) {
    asm volatile("s_waitcnt vmcnt(0)" ::: "memory");
    __syncthreads();
    if (threadIdx.x == 0) {
        unsigned* bar = b.bar;
        __builtin_amdgcn_s_waitcnt(0);
        unsigned nloc = b.st[0], nx = b.st[1];
        if (nloc == 0u) { xcd_barrier_complete(bar, b.x, nloc, nx); b.st[0] = nloc; b.st[1] = nx; }
        const unsigned old = xb_add(&bar[XB_XSUB(b.x)], 1u);
        const unsigned gen = old / nloc;
        if (old + 1u == (gen + 1u) * nloc) {
            __builtin_amdgcn_fence(__ATOMIC_RELEASE, "agent");
            asm volatile("s_waitcnt vmcnt(0)" ::: "memory");
            const unsigned og = xb_add(&bar[XB_TOP], 1u);
            const unsigned tg = og / nx;
            if (og + 1u == (tg + 1u) * nx) xb_add(&bar[XB_TOPGEN], 1u);
            else XB_SPIN(xb_ld(&bar[XB_TOPGEN]) == tg, bar);
            __builtin_amdgcn_fence(__ATOMIC_ACQUIRE, "agent");
            xb_add(&bar[XB_XGEN(b.x)], 1u);
            asm volatile("s_waitcnt vmcnt(0)" ::: "memory");
        } else {
            XB_SPIN(xb_ld(&bar[XB_XGEN(b.x)]) == gen, bar);
            __builtin_amdgcn_fence(__ATOMIC_ACQUIRE, "agent");
            asm volatile("s_waitcnt vmcnt(0)" ::: "memory");
        }
    }
    __syncthreads();
}

struct Args { const float* in[39]; float* out; unsigned char* ws; int ph_lo, ph_hi; };
struct Frame {
    LAS unsigned char* lds;
    int tid, lane, wave, G, bx;
    const float* const* in; float* out; unsigned char* ws;
    GAS unsigned* ctl;
};
#define IN_X 0
#define IN_C 1
#define IN_CTX 2
#define IN_CCTX 3
#define IN_WADA 4
#define IN_BADA 5
#define IN_N1G 6
#define IN_N2G 7
#define IN_WIN 8
#define IN_LRE 9
#define IN_LIM 10
#define IN_LDT 11
#define IN_BRE 12
#define IN_BIM 13
#define IN_CRE 14
#define IN_CIM 15
#define IN_S5D 16
#define IN_WGLU 17
#define IN_HSW 18
#define IN_HW1 19
#define IN_HB1 20
#define IN_HF1 21
#define IN_HW2 22
#define IN_HB2 23
#define IN_HF2 24
#define IN_HW3 25
#define IN_HB3 26
#define IN_HDEC 27
#define IN_HBIAS 28
#define IN_WBS5 29
#define IN_WBHY 30
#define IN_WO 31
#define IN_RW 32
#define IN_RB 33
#define IN_WGU 34
#define IN_BGU 35
#define IN_WDN 36
#define IN_BDN 37
#define IN_FG 38

__device__ __forceinline__ void p0_adaln_item(Frame& F, int cb) {
    LAS float* sl = (LAS float*)F.lds;
    const float* c = F.in[IN_C]; const float* cc = F.in[IN_CCTX]; const float* W = F.in[IN_WADA];
    for (int i = F.tid; i < 3 * 2048; i += NTHR) { const int v = i >> 11, k = i & 2047; const float cv = (v < 2) ? c[v * 2048 + k] : cc[k]; sl[i] = cv * sigmoidf_(cv); }
    __syncthreads();
    const int col = F.tid % 48, ks = F.tid / 48;
    float a0 = 0.f, a1 = 0.f, a2 = 0.f;
    if (ks < 10) { const float* wp = W + 48 * cb + col;
#pragma unroll 16
        for (int j = 0; j < 205; ++j) { const int k = ks + 10 * j; if (k < 2048) { const float w = wp[(size_t)k * 12288]; a0 += sl[k] * w; a1 += sl[2048 + k] * w; a2 += sl[4096 + k] * w; } } }
    LAS float* red = sl + 6144;
    if (ks < 10) { red[(ks * 48 + col) * 3 + 0] = a0; red[(ks * 48 + col) * 3 + 1] = a1; red[(ks * 48 + col) * 3 + 2] = a2; }
    __syncthreads();
    if (F.tid < 144) { const int v = F.tid / 48, cl = F.tid % 48; float sacc = 0.f;
#pragma unroll
        for (int q = 0; q < 10; ++q) sacc += red[(q * 48 + cl) * 3 + v];
        ((float*)(F.ws + WS_MOD))[v * 12288 + 48 * cb + cl] = sacc + F.in[IN_BADA][48 * cb + cl]; }
    __syncthreads();
}
__device__ __forceinline__ void p0_filt_item(Frame& F, int tb) {
    LAS float* ft = (LAS float*)F.lds;
    LAS float* h1 = ft + 64 * 36;
    LAS float* h2 = h1 + 64 * 65;
    const int t0 = tb * 64, tl = F.tid >> 3, q = F.tid & 7; const float tf = (float)(t0 + tl);
    for (int f = q; f < 33; f += 8) {
        float v;
        if (f == 0) v = tf * (1.0f / 16383.0f);
        else { const int bi = (f - 1) & 15; const float band = 1e-4f + (float)bi * ((15.0f - 1e-4f) / 15.0f); const float rev = tf * band * (1.0f / 16384.0f);
               v = (f <= 16) ? cos_rev(rev) : -sin_rev(rev); }
        ft[tl * 36 + f] = v;
    }
    __syncthreads();
    { const float* w1 = F.in[IN_HW1]; const float* b1 = F.in[IN_HB1]; const float* f1 = F.in[IN_HF1];
      _Pragma("unroll 1") for (int j = q * 8; j < q * 8 + 8; ++j) { float a = b1[j]; _Pragma("unroll 3") for (int f = 0; f < 33; ++f) a += ft[tl * 36 + f] * w1[f * 64 + j]; h1[tl * 65 + j] = sin_rev(f1[j] * a * 0.15915494309189535f); } }
    __syncthreads();
    { const float* w2 = F.in[IN_HW2]; const float* b2 = F.in[IN_HB2]; const float* f2 = F.in[IN_HF2];
      _Pragma("unroll 1") for (int j = q * 8; j < q * 8 + 8; ++j) { float a = b2[j]; _Pragma("unroll 4") for (int i = 0; i < 64; ++i) a += h1[tl * 65 + i] * w2[i * 64 + j]; h2[tl * 64 + j] = sin_rev(f2[j] * a * 0.15915494309189535f); } }
    __syncthreads();
    LAS unsigned short* hb = (LAS unsigned short*)(h2 + 64 * 64);
    for (int i = F.tid; i < 64 * 64; i += NTHR) hb[(i >> 6) * 72 + (i & 63)] = (unsigned short)f2bf(h2[i]);
    __syncthreads();
    const float* w3 = F.in[IN_HW3]; const float* b3 = F.in[IN_HB3]; const float* dec = F.in[IN_HDEC]; bf16* FILT = (bf16*)(F.ws + WS_FILT);
    const int fr = F.lane & 15, fq = F.lane >> 4;
    bf16x8 af[4][2];
#pragma unroll
    for (int m = 0; m < 4; ++m)
#pragma unroll
        for (int ks = 0; ks < 2; ++ks) af[m][ks] = *(const LAS bf16x8*)(hb + (16 * m + fr) * 72 + 32 * ks + 8 * fq);
#pragma unroll 4
    for (int jt = F.wave; jt < 256; jt += NWAVES) {
        const int j = 16 * jt + fr;
        bf16x8 bfr[2];
#pragma unroll
        for (int ks = 0; ks < 2; ++ks) { float w[8];
#pragma unroll
            for (int e = 0; e < 8; ++e) w[e] = w3[(size_t)(32 * ks + 8 * fq + e) * 4096 + j];
            u32x4 pk; pk.x = pk2(w[0], w[1]); pk.y = pk2(w[2], w[3]); pk.z = pk2(w[4], w[5]); pk.w = pk2(w[6], w[7]); bfr[ks] = __builtin_bit_cast(bf16x8, pk); }
        const float bb = b3[j], dd = fabsf(dec[j]) * (1.0f / 16383.0f);
#pragma unroll
        for (int m = 0; m < 4; ++m) { f32x4 acc = (f32x4){0.f, 0.f, 0.f, 0.f};
#pragma unroll
            for (int ks = 0; ks < 2; ++ks) acc = __builtin_amdgcn_mfma_f32_16x16x32_bf16(af[m][ks], bfr[ks], acc, 0, 0, 0);
            const int tb0 = t0 + 16 * m + 4 * fq; f32x4 o;
#pragma unroll
            for (int e = 0; e < 4; ++e) o[e] = (acc[e] + bb) * __expf(-(float)(tb0 + e) * dd);
            *(u32x2*)(FILT + (size_t)j * SEQ + tb0) = (u32x2){cvt_pk_bf16(o[0], o[1]), cvt_pk_bf16(o[2], o[3])}; }
    }
    __syncthreads();
}
__device__ __forceinline__ void p0_s5tab_item(Frame& F, int item) {
    const int idx = item * NTHR + F.tid; const int d = idx >> 12, g = (idx >> 6) & 63, p = idx & 63, dg = d * 64 + g;
    const float lr = F.in[IN_LRE][dg * 64 + p], li = F.in[IN_LIM][dg * 64 + p], dt = expf(F.in[IN_LDT][dg]);
    const float mag = expf(lr * dt), ang = li * dt; const float lbr = mag * cosf(ang), lbi = mag * sinf(ang);
    const float den = lr * lr + li * li, cr = ((lbr - 1.f) * lr + lbi * li) / den, ci = (lbi * lr - (lbr - 1.f) * li) / den;
    bf16* BBT = (bf16*)(F.ws + WS_BBT); bf16* BB2 = (bf16*)(F.ws + WS_BB2); bf16* CTT = (bf16*)(F.ws + WS_CTT); f32x2* LAM = (f32x2*)(F.ws + WS_LAM);
    const float* bre = F.in[IN_BRE] + (size_t)(dg * 64 + p) * 16; const float* bim = F.in[IN_BIM] + (size_t)(dg * 64 + p) * 16;
    for (int c = 0; c < 16; ++c) { const float br = bre[c], bi = bim[c];
        BBT[(size_t)(dg * 128 + p) * 16 + c] = (bf16)f2bf(cr * br - ci * bi); BBT[(size_t)(dg * 128 + 64 + p) * 16 + c] = (bf16)f2bf(cr * bi + ci * br);
        BB2[(size_t)(dg * 128 + 2 * p) * 16 + c] = (bf16)f2bf(cr * br - ci * bi); BB2[(size_t)(dg * 128 + 2 * p + 1) * 16 + c] = (bf16)f2bf(cr * bi + ci * br); }
    const int k = 2 * p;
    for (int c = 0; c < 16; ++c) { const float cre = F.in[IN_CRE][(size_t)(dg * 16 + c) * 64 + p], cim = F.in[IN_CIM][(size_t)(dg * 16 + c) * 64 + p];
        CTT[(size_t)(dg * 16 + c) * 128 + k] = (bf16)f2bf(cre); CTT[(size_t)(dg * 16 + c) * 128 + k + 1] = (bf16)f2bf(-cim); }
    LAM[dg * 64 + p] = (f32x2){lbr, lbi};
}
__device__ __forceinline__ void p0_transpose_item(const float* W, int K, int N, bf16* WT, LAS unsigned short* scr, int kb, int nb, int lane) {
    const int k0 = 64 * kb, n0 = 128 * nb;
    const float* wp = W + (size_t)(k0 + (lane >> 5)) * N + n0 + 4 * (lane & 31);
#pragma unroll
    for (int half = 0; half < 2; ++half) { f32x4 v[16];
#pragma unroll
        for (int i = 0; i < 16; ++i) v[i] = *(const GAS f32x4*)(wp + (size_t)(32 * half + 2 * i) * N);
#pragma unroll
        for (int i = 0; i < 16; ++i) { const int kk = 32 * half + 2 * i + (lane >> 5); LAS unsigned* d = (LAS unsigned*)(scr + kk * 130 + 4 * (lane & 31)); d[0] = pk2(v[i].x, v[i].y); d[1] = pk2(v[i].z, v[i].w); } }
    LDS_WAIT(); asm volatile("" ::: "memory");
    const int c = lane & 7;
#pragma unroll
    for (int j = 0; j < 16; ++j) { const int r = (lane >> 3) + 8 * j; const LAS unsigned short* sp = scr + (8 * c) * 130 + r;
        u32x4 o; o.x = (unsigned)sp[0] | ((unsigned)sp[130] << 16); o.y = (unsigned)sp[2 * 130] | ((unsigned)sp[3 * 130] << 16); o.z = (unsigned)sp[4 * 130] | ((unsigned)sp[5 * 130] << 16); o.w = (unsigned)sp[6 * 130] | ((unsigned)sp[7 * 130] << 16);
        *(GAS u32x4*)(WT + (size_t)(n0 + r) * K + k0 + 8 * c) = o; }
    LDS_WAIT(); asm volatile("" ::: "memory");
}
__device__ __forceinline__ void p0_transpose_item8(const float* W, int K, int N, unsigned char* WT, LAS unsigned short* scr, int kb, int nb, int lane) {
    const int k0 = 64 * kb, n0 = 128 * nb;
    const float* wp = W + (size_t)(k0 + (lane >> 5)) * N + n0 + 4 * (lane & 31);
#pragma unroll
    for (int half = 0; half < 2; ++half) { f32x4 v[16];
#pragma unroll
        for (int i = 0; i < 16; ++i) v[i] = *(const GAS f32x4*)(wp + (size_t)(32 * half + 2 * i) * N);
#pragma unroll
        for (int i = 0; i < 16; ++i) { const int kk = 32 * half + 2 * i + (lane >> 5); LAS unsigned* d = (LAS unsigned*)(scr + kk * 130 + 4 * (lane & 31)); d[0] = pk2(v[i].x, v[i].y); d[1] = pk2(v[i].z, v[i].w); } }
    LDS_WAIT(); asm volatile("" ::: "memory");
    const int c = lane & 7;
#pragma unroll
    for (int j = 0; j < 16; ++j) { const int r = (lane >> 3) + 8 * j; const LAS unsigned short* sp = scr + (8 * c) * 130 + r;
        u32x2 o; o.x = pk4_fp8(bf2f(sp[0]) * W8SCALE, bf2f(sp[130]) * W8SCALE, bf2f(sp[2 * 130]) * W8SCALE, bf2f(sp[3 * 130]) * W8SCALE);
        o.y = pk4_fp8(bf2f(sp[4 * 130]) * W8SCALE, bf2f(sp[5 * 130]) * W8SCALE, bf2f(sp[6 * 130]) * W8SCALE, bf2f(sp[7 * 130]) * W8SCALE);
        *(GAS u32x2*)(WT + (size_t)(n0 + r) * K + k0 + 8 * c) = o; }
    LDS_WAIT(); asm volatile("" ::: "memory");
}
__device__ __forceinline__ void p0_prologue(Frame& F) {
    for (int it = F.bx; it < 256; it += F.G) p0_adaln_item(F, it);
    for (int it = F.bx; it < 256; it += F.G) p0_filt_item(F, it);
    for (int it = F.bx; it < 16; it += F.G) p0_s5tab_item(F, it);
    { const float* rw = F.in[IN_RW]; float* RWT = (float*)(F.ws + WS_RWT);
      for (int i = F.bx * NTHR + F.tid; i < 32 * 2048; i += F.G * NTHR) { const int e = i >> 11, k = i & 2047; RWT[i] = rw[k * 32 + e]; } }
    __syncthreads();
    LAS unsigned short* scr = (LAS unsigned short*)(F.lds + F.wave * 16640);
    constexpr int I_IN = 64 * 4, I_GLU = 8 * 2, I_BS5 = 16 * 2, I_BHY = 16 * 2, I_O = 16 * 4, I_GU1 = 32 * 4, I_DN1 = 16 * 4;
    constexpr int I_GU = 32 * I_GU1, I_DN = 32 * I_DN1;
    constexpr int NITEMS = I_IN + I_GLU + I_BS5 + I_BHY + I_O + I_GU + I_DN;
    const int w = F.wave;
    for (int it = F.bx; it < NITEMS; it += F.G) {
        int r = it;
        if (r < I_IN) { if ((r >> 2) < 32) p0_transpose_item(F.in[IN_WIN], 2048, 8192, (bf16*)(F.ws + WS_WIN), scr, 8 * (r & 3) + w, r >> 2, F.lane);
                        else p0_transpose_item8(F.in[IN_WIN], 2048, 8192, (unsigned char*)(F.ws + WS_WIN8) - (size_t)4096 * 2048, scr, 8 * (r & 3) + w, r >> 2, F.lane); continue; } r -= I_IN;
        if (r < I_GLU) { p0_transpose_item(F.in[IN_WGLU], 1024, 1024, (bf16*)(F.ws + WS_WGLU), scr, 8 * (r & 1) + w, r >> 1, F.lane); continue; } r -= I_GLU;
        if (r < I_BS5) { p0_transpose_item(F.in[IN_WBS5], 1024, 2048, (bf16*)(F.ws + WS_WBS5), scr, 8 * (r & 1) + w, r >> 1, F.lane); continue; } r -= I_BS5;
        if (r < I_BHY) { p0_transpose_item(F.in[IN_WBHY], 1024, 2048, (bf16*)(F.ws + WS_WBHY), scr, 8 * (r & 1) + w, r >> 1, F.lane); continue; } r -= I_BHY;
        if (r < I_O) { p0_transpose_item(F.in[IN_WO], 2048, 2048, (bf16*)(F.ws + WS_WO), scr, 8 * (r & 3) + w, r >> 2, F.lane); continue; } r -= I_O;
        if (r < I_GU) { const int e = r / I_GU1, q = r % I_GU1; p0_transpose_item8(F.in[IN_WGU] + (size_t)e * 2048 * 4096, 2048, 4096, (unsigned char*)(F.ws + WS_WGU) + (size_t)e * 4096 * 2048, scr, 8 * (q & 3) + w, q >> 2, F.lane); continue; } r -= I_GU;
        { const int e = r / I_DN1, q = r % I_DN1; p0_transpose_item8(F.in[IN_WDN] + (size_t)e * 2048 * 2048, 2048, 2048, (unsigned char*)(F.ws + WS_WDN) + (size_t)e * 2048 * 2048, scr, 8 * (q & 3) + w, q >> 2, F.lane); }
    }
}

__device__ __forceinline__ void p1_norm(Frame& F) {
    const int gw = F.bx * NWAVES + F.wave, NGW = F.G * NWAVES;
    const float* MOD = (const float*)(F.ws + WS_MOD); const float* g1n = F.in[IN_N1G];
    bf16* U = (bf16*)(F.ws + WS_U);
    int curv = -1; f32x4 ga[8], sh[8];
    for (int m = gw; m < NTOK + NCTX; m += NGW) {
        const int v = (m < NTOK) ? (m >> 14) : 2;
        if (v != curv) { curv = v;
#pragma unroll
            for (int j = 0; j < 8; ++j) { const int k = 4 * F.lane + 256 * j; const f32x4 g = *(const f32x4*)(g1n + k), sc = *(const f32x4*)(MOD + v * 12288 + 2048 + k); ga[j] = g * (sc + 1.0f); sh[j] = *(const f32x4*)(MOD + v * 12288 + k); } }
        const float* xr = (m < NTOK) ? (F.in[IN_X] + (size_t)m * D) : (F.in[IN_CTX] + (size_t)(m - NTOK) * D);
        f32x4 x[8]; float s = 0.f;
#pragma unroll
        for (int j = 0; j < 8; ++j) { x[j] = *(const GAS f32x4*)(xr + 4 * F.lane + 256 * j); s += (x[j].x * x[j].x + x[j].y * x[j].y) + (x[j].z * x[j].z + x[j].w * x[j].w); }
        const float rstd = 1.0f / sqrtf(wave_sum(s) * (1.0f / D) + 1e-6f);
        GAS u32x2* o = (GAS u32x2*)(U + (size_t)m * D) + F.lane; GAS unsigned* o8 = (GAS unsigned*)(F.ws + WS_U8 + (size_t)m * D) + F.lane;
#pragma unroll
        for (int j = 0; j < 8; ++j) { const f32x4 y = x[j] * rstd * ga[j] + sh[j]; o[64 * j] = (u32x2){pk2(y.x, y.y), pk2(y.z, y.w)}; if (m < NTOK) o8[64 * j] = pk4_fp8(y.x, y.y, y.z, y.w); }
    }
}

struct SchedIn {
    int G, c, nmain, npn, mode, nrep;
    const char* A; const char* Bt;
    __device__ __forceinline__ bool next(int i, pg8::Unit& u) const {
        int L = i * G + c; u.e = 0; u.valid = 256; { const int tot = nmain + (mode == 0 ? 8 : 0); if (nrep > 1 && L >= tot && L < 2 * tot) L -= tot; }
        if (L < nmain) {
            int wgid = L; { const int q = nmain / 8, xcd = wgid % 8, off = wgid / 8; wgid = xcd * q + off; }
            const int nig = 8 * npn, gid = wgid / nig; const int pm = gid * 8 + ((wgid % nig) % 8), pl = (wgid % nig) / 8;
            u.pm = pm; u.pn = (mode == 0) ? pl : (mode == 1 ? pl + 4 : pl + 16); return true;
        }
        if (mode == 0 && L < nmain + 8) { const int q = L - nmain; u.pm = 128 + (q >> 2); u.pn = q & 3; return true; }
        return false;
    }
    __device__ __forceinline__ unsigned a_row(const pg8::Unit& u, int r) const { return (u.pm < 128) ? (unsigned)((u.pm >> 6) * SEQ + r * 64 + (u.pm & 63)) : (unsigned)(NTOK + (u.pm - 128) * 256 + r); }
    __device__ __forceinline__ const char* a_base() const { return A; }
    __device__ __forceinline__ const char* b_base(const pg8::Unit& u) const { return (mode == 2) ? Bt + (size_t)(u.pn - 16) * 256 * D : Bt + (size_t)u.pn * 256 * D * 2; }
};
struct EpiInG8 {
    static constexpr bool PERM = true, TRANS = true, FP8 = true;
    bf16* UG;
    __device__ __forceinline__ void operator()(const f32x4 (&acc)[2][2][4][2], const pg8::Unit& u, int wr, int wc, int fr, int fq) const {
        const int col0 = (u.pn - 16) * 256 + wc * 32 + 8 * fq;
#pragma unroll
        for (int ai = 0; ai < 2; ++ai)
#pragma unroll
            for (int m = 0; m < 4; ++m) { const int r = ai * 128 + wr * 64 + m * 16 + fr; const size_t row = (size_t)((u.pm >> 6) * SEQ + r * 64 + (u.pm & 63));
                bf16* rowp = UG + row * 4096 + col0;
#pragma unroll
                for (int bj = 0; bj < 2; ++bj) { f32x4 v0 = acc[ai][bj][m][0] * (1.0f / W8SCALE), v1 = acc[ai][bj][m][1] * (1.0f / W8SCALE);
#pragma unroll
                    for (int j = 0; j < 4; ++j) { v0[j] = sigmoidf_(v0[j]); v1[j] = sigmoidf_(v1[j]); }
                    u32x4 w; w.x = cvt_pk_bf16(v0[0], v0[1]); w.y = cvt_pk_bf16(v0[2], v0[3]); w.z = cvt_pk_bf16(v1[0], v1[1]); w.w = cvt_pk_bf16(v1[2], v1[3]);
                    *(u32x4*)(rowp + bj * 128) = w; } }
    }
};
struct EpiInA {
    static constexpr bool PERM = true, TRANS = true, FP8 = false;
    unsigned char* ws;
    __device__ __forceinline__ void operator()(const f32x4 (&acc)[2][2][4][2], const pg8::Unit& u, int wr, int wc, int fr, int fq) const {
        const bool isctx = u.pm >= 128, isg = u.pn >= 16;
        const size_t boff = isctx ? WS_UCA : (isg ? WS_UG : WS_UA);
        bf16* base = (bf16*)(ws + boff); const size_t ld = isg ? 4096 : S5W; const int colt = isg ? (u.pn - 16) * 256 : u.pn * 256;
        const int col0 = colt + wc * 32 + 8 * fq;
#pragma unroll
        for (int ai = 0; ai < 2; ++ai)
#pragma unroll
            for (int m = 0; m < 4; ++m) { const int r = ai * 128 + wr * 64 + m * 16 + fr;
                const size_t row = isctx ? (size_t)((u.pm - 128) * 256 + r) : (size_t)((u.pm >> 6) * SEQ + r * 64 + (u.pm & 63));
                bf16* rowp = base + row * ld + col0;
#pragma unroll
                for (int bj = 0; bj < 2; ++bj) { f32x4 v0 = acc[ai][bj][m][0], v1 = acc[ai][bj][m][1];
                    if (isg) {
#pragma unroll
                        for (int j = 0; j < 4; ++j) { v0[j] = sigmoidf_(v0[j]); v1[j] = sigmoidf_(v1[j]); } }
                    u32x4 w; w.x = cvt_pk_bf16(v0[0], v0[1]); w.y = cvt_pk_bf16(v0[2], v0[3]); w.z = cvt_pk_bf16(v1[0], v1[1]); w.w = cvt_pk_bf16(v1[2], v1[3]);
                    *(u32x4*)(rowp + bj * 128) = w; } }
    }
};
struct EpiInH {
    static constexpr bool PERM = false, TRANS = false, FP8 = false;
    bf16* UH;
    __device__ __forceinline__ void operator()(const f32x4 (&acc)[2][2][4][2], const pg8::Unit& u, int wr, int wc, int fr, int fq) const {
        const int b = u.pm >> 6, w = u.pm & 63;
#pragma unroll
        for (int bj = 0; bj < 2; ++bj)
#pragma unroll
            for (int n = 0; n < 2; ++n) { const int ch = (u.pn - 4) * 256 + bj * 128 + wc * 32 + n * 16 + fr;
                bf16* cp = UH + ((size_t)(b * 3072 + ch) * SEQ + w * 256);
#pragma unroll
                for (int ai = 0; ai < 2; ++ai)
#pragma unroll
                    for (int m = 0; m < 4; ++m) { const int r0 = ai * 128 + wr * 64 + m * 16 + 4 * fq; const f32x4 v = acc[ai][bj][m][n];
                        *(u32x2*)(cp + r0) = (u32x2){cvt_pk_bf16(v[0], v[1]), cvt_pk_bf16(v[2], v[3])}; } }
    }
};

template <bool PASSB>
__device__ __forceinline__ void s5_pass(Frame& F) {
    constexpr int nk = PASSB ? 256 : 260;
    constexpr int nitems = 2 * nk * 8;
    LAS unsigned char* sl = F.lds + F.wave * 8704;
    const int lane = F.lane, pl = lane & 31, hi = lane >> 5, fr = lane & 15, fq = lane >> 4;
    const bf16* UA = (const bf16*)(F.ws + WS_UA); const bf16* UCA = (const bf16*)(F.ws + WS_UCA);
    const bf16* BBT = (const bf16*)(F.ws + WS_BBT); const bf16* CTT = (const bf16*)(F.ws + WS_CTT); const f32x2* LAM = (const f32x2*)(F.ws + WS_LAM);
    f32x2* EB = (f32x2*)(F.ws + WS_E); const f32x2* SINB = (const f32x2*)(F.ws + WS_SIN); bf16* Y = (bf16*)(F.ws + WS_Y);
    const int s_r = 16 * ((pl >> 2) & 1) + 4 * (pl >> 3) + (pl & 3);
    for (int it = F.bx; it < nitems; it += F.G) {
        const int gq = it & 7, rest = it >> 3; const int b = rest / nk, kk = rest % nk; const int kc = PASSB ? kk + 4 : kk;
        const int g = gq * 8 + F.wave;
        const bf16* urow = (kc < 4) ? (UCA + (size_t)(b * CTX + kc * 64) * S5W + 16 * g) : (UA + (size_t)(b * SEQ + (kc - 4) * 64) * S5W + 16 * g);
        f32x4 yacc[4];
#pragma unroll
        for (int q = 0; q < 4; ++q) yacc[q] = (f32x4){0.f, 0.f, 0.f, 0.f};
#pragma unroll
        for (int d = 0; d < 2; ++d) {
            const int dg = d * 64 + g;
            bf16x8 bb[4];
#pragma unroll
            for (int ni = 0; ni < 4; ++ni) bb[ni] = *(const bf16x8*)(BBT + (size_t)(dg * 128 + 32 * ni + pl) * 16 + 8 * hi);
            bf16x8 ct[4];
            if (PASSB) {
#pragma unroll
                for (int ks = 0; ks < 4; ++ks) ct[ks] = *(const bf16x8*)(CTT + (size_t)(dg * 16 + fr) * 128 + 32 * ks + 8 * fq);
            }
            const f32x2 lamA = LAM[dg * 64 + pl], lamB = LAM[dg * 64 + pl + 32];
            f32x2 l2 = cmul(lamA, lamA), l4 = cmul(l2, l2), l8 = cmul(l4, l4); const f32x2 lam16A = cmul(l8, l8);
            l2 = cmul(lamB, lamB); l4 = cmul(l2, l2); l8 = cmul(l4, l4); const f32x2 lam16B = cmul(l8, l8);
            f32x2 cA = (f32x2){0.f, 0.f}, cB = (f32x2){0.f, 0.f};
            const size_t sidx = ((size_t)((d * 2 + b) * NCH + kc)) * 4096 + g * 64 + pl;
            if (PASSB) { cA = SINB[sidx]; cB = SINB[sidx + 32]; }
#pragma unroll
            for (int sc = 0; sc < 2; ++sc) {
                const int iscan = 32 * sc + s_r; const int tok = (d == 0) ? iscan : 63 - iscan;
                const bf16x8 a = *(const bf16x8*)(urow + (size_t)tok * S5W + 8 * hi);
                f32x16 acc[4];
#pragma unroll
                for (int ni = 0; ni < 4; ++ni) { f32x16 z;
#pragma unroll
                    for (int i = 0; i < 16; ++i) z[i] = 0.f;
                    acc[ni] = __builtin_amdgcn_mfma_f32_32x32x16_bf16(a, bb[ni], z, 0, 0, 0); }
                asm volatile("s_nop 7\n\ts_nop 7" : "+v"(acc[0]), "+v"(acc[1]), "+v"(acc[2]), "+v"(acc[3]) : "v"(a), "v"(bb[0]), "v"(bb[1]), "v"(bb[2]), "v"(bb[3]));
                f32x2 sA = hi ? (f32x2){0.f, 0.f} : cA, sB = hi ? (f32x2){0.f, 0.f} : cB;
#pragma unroll
                for (int i = 0; i < 16; ++i) {
                    sA = (f32x2){lamA.x * sA.x - lamA.y * sA.y + acc[0][i], lamA.x * sA.y + lamA.y * sA.x + acc[2][i]}; acc[0][i] = sA.x; acc[2][i] = sA.y;
                    sB = (f32x2){lamB.x * sB.x - lamB.y * sB.y + acc[1][i], lamB.x * sB.y + lamB.y * sB.x + acc[3][i]}; acc[1][i] = sB.x; acc[3][i] = sB.y; }
                const f32x2 pA = (f32x2){__shfl_xor(sA.x, 32), __shfl_xor(sA.y, 32)}, pB = (f32x2){__shfl_xor(sB.x, 32), __shfl_xor(sB.y, 32)};
                const f32x2 tA = cmul(lam16A, hi ? pA : sA), tB = cmul(lam16B, hi ? pB : sB);
                const f32x2 e1A = (hi ? sA : pA) + tA, e1B = (hi ? sB : pB) + tB;
                const f32x2 ciA = hi ? pA : (f32x2){0.f, 0.f}, ciB = hi ? pB : (f32x2){0.f, 0.f};
                if (PASSB) {
                    f32x2 wA = cmul(lamA, ciA), wB = cmul(lamB, ciB);
#pragma unroll
                    for (int i = 0; i < 16; ++i) {
                        acc[0][i] += wA.x; acc[2][i] += wA.y; acc[1][i] += wB.x; acc[3][i] += wB.y;
                        *(LAS u32x2*)(sl + (16 * hi + i) * 272 + pl * 8) = (u32x2){cvt_pk_bf16(acc[0][i], acc[2][i]), cvt_pk_bf16(acc[1][i], acc[3][i])};
                        wA = cmul(wA, lamA); wB = cmul(wB, lamB); }
                    bf16x8 bsv[2][4];
#pragma unroll
                    for (int tt = 0; tt < 2; ++tt) {
                        const int rowi = (d == 0) ? (16 * tt + fr) : (16 * tt + 15 - fr);
#pragma unroll
                        for (int ks = 0; ks < 4; ++ks) bsv[tt][ks] = *(const LAS bf16x8*)(sl + rowi * 272 + (32 * ks + 8 * fq) * 2);
                    }
#pragma unroll
                    for (int tt = 0; tt < 2; ++tt) {
                        const int tq = (d == 0) ? (2 * sc + tt) : (3 - 2 * sc - tt);
#pragma unroll
                        for (int ks = 0; ks < 4; ++ks) yacc[tq] = __builtin_amdgcn_mfma_f32_16x16x32_bf16(ct[ks], bsv[tt][ks], yacc[tq], 0, 0, 0);
                    }
                    asm volatile("s_nop 7\n\ts_nop 7" : "+v"(yacc[0]), "+v"(yacc[1]), "+v"(yacc[2]), "+v"(yacc[3]) : "v"(bsv[0][0]), "v"(bsv[0][1]), "v"(bsv[0][2]), "v"(bsv[0][3]), "v"(bsv[1][0]), "v"(bsv[1][1]), "v"(bsv[1][2]), "v"(bsv[1][3]), "v"(ct[0]), "v"(ct[1]), "v"(ct[2]), "v"(ct[3]));
                    asm volatile("s_waitcnt lgkmcnt(0)" ::: "memory");
                }
                cA = e1A; cB = e1B;
            }
            if (!PASSB) { if (hi == 0) { EB[sidx] = cA; EB[sidx + 32] = cB; } }
        }
        if (PASSB) {
            const f32x4 dsk = *(const f32x4*)(F.in[IN_S5D] + 16 * g + 4 * fq);
#pragma unroll
            for (int tq = 0; tq < 4; ++tq) { const int tok = 16 * tq + fr;
                const u32x2 uu = *(const u32x2*)(urow + (size_t)tok * S5W + 4 * fq);
                f32x4 v; v[0] = yacc[tq][0] + bflo(uu.x) * dsk[0]; v[1] = yacc[tq][1] + bfhi(uu.x) * dsk[1]; v[2] = yacc[tq][2] + bflo(uu.y) * dsk[2]; v[3] = yacc[tq][3] + bfhi(uu.y) * dsk[3];
#pragma unroll
                for (int j = 0; j < 4; ++j) { const float x = v[j]; v[j] = x * sigmoidf_(1.5957691216f * (x + 0.044715f * x * x * x)); }
                *(u32x2*)(Y + (size_t)(b * SEQ + (kc - 4) * 64 + tok) * S5W + 16 * g + 4 * fq) = (u32x2){cvt_pk_bf16(v[0], v[1]), cvt_pk_bf16(v[2], v[3])}; }
        }
    }
}
__device__ __forceinline__ void s5_pass_a_simple(Frame& F) {
    constexpr int nitems = 2 * NCH * 8;
    const int lane = F.lane;
    const bf16* UA = (const bf16*)(F.ws + WS_UA); const bf16* UCA = (const bf16*)(F.ws + WS_UCA);
    const bf16* BBT = (const bf16*)(F.ws + WS_BBT); const f32x2* LAM = (const f32x2*)(F.ws + WS_LAM); f32x2* EB = (f32x2*)(F.ws + WS_E);
    for (int it = F.bx; it < nitems; it += F.G) {
        const int gq = it & 7, rest = it >> 3; const int b = rest / NCH, kc = rest % NCH; const int g = gq * 8 + F.wave;
        const bf16* urow = (kc < 4) ? (UCA + (size_t)(b * CTX + kc * 64) * S5W + 16 * g) : (UA + (size_t)(b * SEQ + (kc - 4) * 64) * S5W + 16 * g);
#pragma unroll 1
        for (int d = 0; d < 2; ++d) {
            const int dg = d * 64 + g; const f32x2 lam = LAM[dg * 64 + lane];
            float bre[16], bim[16];
            { const u32x4 r0 = *(const u32x4*)(BBT + (size_t)(dg * 128 + lane) * 16), r1 = *(const u32x4*)(BBT + (size_t)(dg * 128 + lane) * 16 + 8);
              const u32x4 i0 = *(const u32x4*)(BBT + (size_t)(dg * 128 + 64 + lane) * 16), i1 = *(const u32x4*)(BBT + (size_t)(dg * 128 + 64 + lane) * 16 + 8);
              bre[0] = bflo(r0.x); bre[1] = bfhi(r0.x); bre[2] = bflo(r0.y); bre[3] = bfhi(r0.y); bre[4] = bflo(r0.z); bre[5] = bfhi(r0.z); bre[6] = bflo(r0.w); bre[7] = bfhi(r0.w);
              bre[8] = bflo(r1.x); bre[9] = bfhi(r1.x); bre[10] = bflo(r1.y); bre[11] = bfhi(r1.y); bre[12] = bflo(r1.z); bre[13] = bfhi(r1.z); bre[14] = bflo(r1.w); bre[15] = bfhi(r1.w);
              bim[0] = bflo(i0.x); bim[1] = bfhi(i0.x); bim[2] = bflo(i0.y); bim[3] = bfhi(i0.y); bim[4] = bflo(i0.z); bim[5] = bfhi(i0.z); bim[6] = bflo(i0.w); bim[7] = bfhi(i0.w);
              bim[8] = bflo(i1.x); bim[9] = bfhi(i1.x); bim[10] = bflo(i1.y); bim[11] = bfhi(i1.y); bim[12] = bflo(i1.z); bim[13] = bfhi(i1.z); bim[14] = bflo(i1.w); bim[15] = bfhi(i1.w); }
            f32x2 st = (f32x2){0.f, 0.f};
#pragma unroll 4
            for (int i = 0; i < 64; ++i) { const int tok = (d == 0) ? i : 63 - i;
                const u32x4 u0 = *(const u32x4*)(urow + (size_t)tok * S5W), u1 = *(const u32x4*)(urow + (size_t)tok * S5W + 8);
                float u[16]; u[0] = bflo(u0.x); u[1] = bfhi(u0.x); u[2] = bflo(u0.y); u[3] = bfhi(u0.y); u[4] = bflo(u0.z); u[5] = bfhi(u0.z); u[6] = bflo(u0.w); u[7] = bfhi(u0.w);
                u[8] = bflo(u1.x); u[9] = bfhi(u1.x); u[10] = bflo(u1.y); u[11] = bfhi(u1.y); u[12] = bflo(u1.z); u[13] = bfhi(u1.z); u[14] = bflo(u1.w); u[15] = bfhi(u1.w);
                float br = 0.f, bi = 0.f;
#pragma unroll
                for (int c = 0; c < 16; ++c) { br += bre[c] * u[c]; bi += bim[c] * u[c]; }
                st = (f32x2){lam.x * st.x - lam.y * st.y + br, lam.x * st.y + lam.y * st.x + bi}; }
            EB[((size_t)((d * 2 + b) * NCH + kc)) * 4096 + g * 64 + lane] = st;
        }
    }
}
__device__ __forceinline__ void s5_pass_b2(Frame& F) {
    constexpr int nitems = 2 * 256 * 8;
    LAS unsigned char* sl = F.lds + F.wave * 8704;
    const int lane = F.lane, fr = lane & 15, fq = lane >> 4;
    const bf16* UA = (const bf16*)(F.ws + WS_UA); const bf16* BBT = (const bf16*)(F.ws + WS_BBT); const bf16* CTT = (const bf16*)(F.ws + WS_CTT);
    const f32x2* LAM = (const f32x2*)(F.ws + WS_LAM); const f32x2* SINB = (const f32x2*)(F.ws + WS_SIN); bf16* Y = (bf16*)(F.ws + WS_Y);
    for (int it = F.bx; it < nitems; it += F.G) {
        const int gq = it & 7, rest = it >> 3; const int b = rest >> 8, kc = (rest & 255) + 4; const int g = gq * 8 + F.wave;
        const bf16* urow = UA + (size_t)(b * SEQ + (kc - 4) * 64) * S5W + 16 * g;
        f32x4 yacc[4];
#pragma unroll
        for (int q = 0; q < 4; ++q) yacc[q] = (f32x4){0.f, 0.f, 0.f, 0.f};
#pragma unroll
        for (int d = 0; d < 2; ++d) {
            const int dg = d * 64 + g; const f32x2 lam = LAM[dg * 64 + lane];
            float bre[16], bim[16];
            { const u32x4 r0 = *(const u32x4*)(BBT + (size_t)(dg * 128 + lane) * 16), r1 = *(const u32x4*)(BBT + (size_t)(dg * 128 + lane) * 16 + 8);
              const u32x4 i0 = *(const u32x4*)(BBT + (size_t)(dg * 128 + 64 + lane) * 16), i1 = *(const u32x4*)(BBT + (size_t)(dg * 128 + 64 + lane) * 16 + 8);
              bre[0] = bflo(r0.x); bre[1] = bfhi(r0.x); bre[2] = bflo(r0.y); bre[3] = bfhi(r0.y); bre[4] = bflo(r0.z); bre[5] = bfhi(r0.z); bre[6] = bflo(r0.w); bre[7] = bfhi(r0.w);
              bre[8] = bflo(r1.x); bre[9] = bfhi(r1.x); bre[10] = bflo(r1.y); bre[11] = bfhi(r1.y); bre[12] = bflo(r1.z); bre[13] = bfhi(r1.z); bre[14] = bflo(r1.w); bre[15] = bfhi(r1.w);
              bim[0] = bflo(i0.x); bim[1] = bfhi(i0.x); bim[2] = bflo(i0.y); bim[3] = bfhi(i0.y); bim[4] = bflo(i0.z); bim[5] = bfhi(i0.z); bim[6] = bflo(i0.w); bim[7] = bfhi(i0.w);
              bim[8] = bflo(i1.x); bim[9] = bfhi(i1.x); bim[10] = bflo(i1.y); bim[11] = bfhi(i1.y); bim[12] = bflo(i1.z); bim[13] = bfhi(i1.z); bim[14] = bflo(i1.w); bim[15] = bfhi(i1.w); }
            bf16x8 ct[4];
#pragma unroll
            for (int ks = 0; ks < 4; ++ks) ct[ks] = *(const bf16x8*)(CTT + (size_t)(dg * 16 + fr) * 128 + 32 * ks + 8 * fq);
            f32x2 st = SINB[((size_t)((d * 2 + b) * NCH + kc)) * 4096 + g * 64 + lane];
#pragma unroll
            for (int h = 0; h < 2; ++h) {
#pragma unroll 4
                for (int i = 0; i < 32; ++i) { const int sc = 32 * h + i; const int tok = (d == 0) ? sc : 63 - sc;
                    const u32x4 u0 = *(const u32x4*)(urow + (size_t)tok * S5W), u1 = *(const u32x4*)(urow + (size_t)tok * S5W + 8);
                    float u[16]; u[0] = bflo(u0.x); u[1] = bfhi(u0.x); u[2] = bflo(u0.y); u[3] = bfhi(u0.y); u[4] = bflo(u0.z); u[5] = bfhi(u0.z); u[6] = bflo(u0.w); u[7] = bfhi(u0.w);
                    u[8] = bflo(u1.x); u[9] = bfhi(u1.x); u[10] = bflo(u1.y); u[11] = bfhi(u1.y); u[12] = bflo(u1.z); u[13] = bfhi(u1.z); u[14] = bflo(u1.w); u[15] = bfhi(u1.w);
                    float br = 0.f, bi = 0.f;
#pragma unroll
                    for (int c = 0; c < 16; ++c) { br += bre[c] * u[c]; bi += bim[c] * u[c]; }
                    st = (f32x2){lam.x * st.x - lam.y * st.y + br, lam.x * st.y + lam.y * st.x + bi};
                    *(LAS unsigned*)(sl + (tok & 31) * 272 + lane * 4) = cvt_pk_bf16(st.x, st.y); }
                const int t0q = (d == 0) ? 2 * h : 2 * (1 - h);
                bf16x8 bsv[2][4];
#pragma unroll
                for (int tt = 0; tt < 2; ++tt)
#pragma unroll
                    for (int ks = 0; ks < 4; ++ks) bsv[tt][ks] = *(const LAS bf16x8*)(sl + (16 * tt + fr) * 272 + (32 * ks + 8 * fq) * 2);
#pragma unroll
                for (int tt = 0; tt < 2; ++tt)
#pragma unroll
                    for (int ks = 0; ks < 4; ++ks) yacc[t0q + tt] = __builtin_amdgcn_mfma_f32_16x16x32_bf16(ct[ks], bsv[tt][ks], yacc[t0q + tt], 0, 0, 0);
                asm volatile("s_nop 7\n\ts_nop 7" : "+v"(yacc[0]), "+v"(yacc[1]), "+v"(yacc[2]), "+v"(yacc[3]) : "v"(bsv[0][0]), "v"(bsv[0][1]), "v"(bsv[0][2]), "v"(bsv[0][3]), "v"(bsv[1][0]), "v"(bsv[1][1]), "v"(bsv[1][2]), "v"(bsv[1][3]), "v"(ct[0]), "v"(ct[1]), "v"(ct[2]), "v"(ct[3]));
                asm volatile("s_waitcnt lgkmcnt(0)" ::: "memory");
            }
        }
        const f32x4 dsk = *(const f32x4*)(F.in[IN_S5D] + 16 * g + 4 * fq);
#pragma unroll
        for (int tq = 0; tq < 4; ++tq) { const int tok = 16 * tq + fr;
            const u32x2 uu = *(const u32x2*)(urow + (size_t)tok * S5W + 4 * fq);
            f32x4 v; v[0] = yacc[tq][0] + bflo(uu.x) * dsk[0]; v[1] = yacc[tq][1] + bfhi(uu.x) * dsk[1]; v[2] = yacc[tq][2] + bflo(uu.y) * dsk[2]; v[3] = yacc[tq][3] + bfhi(uu.y) * dsk[3];
#pragma unroll
            for (int j = 0; j < 4; ++j) { const float x = v[j]; v[j] = x * sigmoidf_(1.5957691216f * (x + 0.044715f * x * x * x)); }
            *(u32x2*)(Y + (size_t)(b * SEQ + (kc - 4) * 64 + tok) * S5W + 16 * g + 4 * fq) = (u32x2){cvt_pk_bf16(v[0], v[1]), cvt_pk_bf16(v[2], v[3])}; }
    }
}
template <bool PASSB>
__device__ __forceinline__ void s5_pass3(Frame& F) {
    constexpr int nk = PASSB ? 256 : NCH; constexpr int nitems = 2 * nk * 8;
    LAS unsigned char* sl = F.lds + F.wave * 8704;
    const int lane = F.lane, fr = lane & 15, fq = lane >> 4;
    const bf16* UA = (const bf16*)(F.ws + WS_UA); const bf16* UCA = (const bf16*)(F.ws + WS_UCA); const bf16* BB2 = (const bf16*)(F.ws + WS_BB2); const bf16* CTT = (const bf16*)(F.ws + WS_CTT);
    const f32x2* LAM = (const f32x2*)(F.ws + WS_LAM); const f32x2* SINB = (const f32x2*)(F.ws + WS_SIN); f32x2* EB = (f32x2*)(F.ws + WS_E); bf16* Y = (bf16*)(F.ws + WS_Y);
    const bf16x8 zf = (bf16x8){0, 0, 0, 0, 0, 0, 0, 0};
    int curg = -1; bf16x8 af[2][8], ct[2][4]; f32x2 lamv[2]; f32x4 dsk = (f32x4){0.f, 0.f, 0.f, 0.f};
    for (int it = F.bx; it < nitems; it += F.G) {
        const int gq = it & 7, rest = it >> 3; const int b = rest / nk, kk = rest % nk; const int kc = PASSB ? kk + 4 : kk; const int g = gq * 8 + F.wave;
        if (g != curg) { curg = g;
#pragma unroll
            for (int d = 0; d < 2; ++d) { const int dg = d * 64 + g; lamv[d] = LAM[dg * 64 + lane];
#pragma unroll
                for (int nt = 0; nt < 8; ++nt) af[d][nt] = (fq < 2) ? *(const bf16x8*)(BB2 + (size_t)(dg * 128 + 16 * nt + fr) * 16 + 8 * fq) : zf;
                if (PASSB) {
#pragma unroll
                    for (int ks = 0; ks < 4; ++ks) ct[d][ks] = *(const bf16x8*)(CTT + (size_t)(dg * 16 + fr) * 128 + 32 * ks + 8 * fq); } }
            if (PASSB) dsk = *(const f32x4*)(F.in[IN_S5D] + 16 * g + 4 * fq); }
        const bf16* urow = (kc < 4) ? (UCA + (size_t)(b * CTX + kc * 64) * S5W + 16 * g) : (UA + (size_t)(b * SEQ + (kc - 4) * 64) * S5W + 16 * g);
        bf16x8 uf[4];
#pragma unroll
        for (int q = 0; q < 4; ++q) uf[q] = (fq < 2) ? *(const bf16x8*)(urow + (size_t)(16 * q + fr) * S5W + 8 * fq) : zf;
        f32x2 st0[2];
#pragma unroll
        for (int d = 0; d < 2; ++d) st0[d] = PASSB ? SINB[((size_t)((d * 2 + b) * NCH + kc)) * 4096 + g * 64 + lane] : (f32x2){0.f, 0.f};
        f32x4 yacc[4];
#pragma unroll
        for (int q = 0; q < 4; ++q) yacc[q] = (f32x4){0.f, 0.f, 0.f, 0.f};
#pragma unroll
        for (int d = 0; d < 2; ++d) {
            const f32x2 lam = lamv[d]; f32x2 st = st0[d];
#pragma unroll
            for (int h = 0; h < 2; ++h) {
                const int T0 = (d == 0) ? 32 * h : 32 * (1 - h);
#pragma unroll
                for (int tt = 0; tt < 2; ++tt)
#pragma unroll
                    for (int nt = 0; nt < 8; ++nt) { const f32x4 dd = __builtin_amdgcn_mfma_f32_16x16x32_bf16(af[d][nt], uf[(T0 >> 4) + tt], (f32x4){0.f, 0.f, 0.f, 0.f}, 0, 0, 0);
                        *(LAS u32x2*)(sl + (16 * tt + fr) * 272 + (16 * nt + 4 * fq) * 2) = (u32x2){cvt_pk_bf16(dd[0], dd[1]), cvt_pk_bf16(dd[2], dd[3])}; }
                asm volatile("s_waitcnt lgkmcnt(0)" ::: "memory");
#pragma unroll 8
                for (int i = 0; i < 32; ++i) { const int r = (d == 0) ? i : 31 - i; LAS unsigned* cell = (LAS unsigned*)(sl + r * 272 + lane * 4);
                    const unsigned w = *cell; const float br = bflo(w), bi = bfhi(w);
                    st = (f32x2){lam.x * st.x - lam.y * st.y + br, lam.x * st.y + lam.y * st.x + bi};
                    if (PASSB) *cell = cvt_pk_bf16(st.x, st.y); }
                if (PASSB) {
                    const int t0q = T0 >> 4;
                    bf16x8 bsv[2][4];
#pragma unroll
                    for (int tt = 0; tt < 2; ++tt)
#pragma unroll
                        for (int ks = 0; ks < 4; ++ks) bsv[tt][ks] = *(const LAS bf16x8*)(sl + (16 * tt + fr) * 272 + (32 * ks + 8 * fq) * 2);
#pragma unroll
                    for (int tt = 0; tt < 2; ++tt)
#pragma unroll
                        for (int ks = 0; ks < 4; ++ks) yacc[t0q + tt] = __builtin_amdgcn_mfma_f32_16x16x32_bf16(ct[d][ks], bsv[tt][ks], yacc[t0q + tt], 0, 0, 0);
                    asm volatile("s_nop 7\n\ts_nop 7" : "+v"(yacc[0]), "+v"(yacc[1]), "+v"(yacc[2]), "+v"(yacc[3]) : "v"(bsv[0][0]), "v"(bsv[0][1]), "v"(bsv[0][2]), "v"(bsv[0][3]), "v"(bsv[1][0]), "v"(bsv[1][1]), "v"(bsv[1][2]), "v"(bsv[1][3]));
                }
                asm volatile("s_waitcnt lgkmcnt(0)" ::: "memory");
            }
            if (!PASSB) EB[((size_t)((d * 2 + b) * NCH + kc)) * 4096 + g * 64 + lane] = st;
        }
        if (PASSB) {
#pragma unroll
            for (int tq = 0; tq < 4; ++tq) { const int tok = 16 * tq + fr;
                const u32x2 uu = *(const u32x2*)(urow + (size_t)tok * S5W + 4 * fq);
                f32x4 v; v[0] = yacc[tq][0] + bflo(uu.x) * dsk[0]; v[1] = yacc[tq][1] + bfhi(uu.x) * dsk[1]; v[2] = yacc[tq][2] + bflo(uu.y) * dsk[2]; v[3] = yacc[tq][3] + bfhi(uu.y) * dsk[3];
#pragma unroll
                for (int j = 0; j < 4; ++j) { const float x = v[j]; v[j] = x * sigmoidf_(1.5957691216f * (x + 0.044715f * x * x * x)); }
                *(u32x2*)(Y + (size_t)(b * SEQ + (kc - 4) * 64 + tok) * S5W + 16 * g + 4 * fq) = (u32x2){cvt_pk_bf16(v[0], v[1]), cvt_pk_bf16(v[2], v[3])}; }
        }
    }
}
__device__ __forceinline__ void s5_carry_item(Frame& F, int item) {
    const int idx = item * NTHR + F.tid; const int d = idx >> 13, b = (idx >> 12) & 1, gp = idx & 4095;
    const f32x2 lam = ((const f32x2*)(F.ws + WS_LAM))[d * 4096 + gp];
    f32x2 l = cmul(lam, lam); l = cmul(l, l); l = cmul(l, l); l = cmul(l, l); l = cmul(l, l); l = cmul(l, l);
    const f32x2* EB = (const f32x2*)(F.ws + WS_E) + (size_t)((d * 2 + b) * NCH) * 4096 + gp; f32x2* SB = (f32x2*)(F.ws + WS_SIN) + (size_t)((d * 2 + b) * NCH) * 4096 + gp;
    f32x2 s = (f32x2){0.f, 0.f};
#pragma unroll 4
    for (int st = 0; st < NCH; ++st) { const int kc = (d == 0) ? st : (st < 4 ? 3 - st : NCH + 3 - st);
        const f32x2 e = EB[(size_t)kc * 4096]; SB[(size_t)kc * 4096] = s; s = cmul(l, s) + e; }
}

__device__ __forceinline__ int fsw(int i) { return i ^ ((i >> 5) & 7) ^ (((i >> 6) & 3) << 3); }
__host__ __device__ constexpr float w16c(int j) { return j == 0 ? 1.f : j == 1 ? 0.9238795325f : j == 2 ? 0.7071067812f : j == 3 ? 0.3826834324f : j == 4 ? 0.f : j == 5 ? -0.3826834324f : j == 6 ? -0.7071067812f : -0.9238795325f; }
__host__ __device__ constexpr float w16s(int j) { return j == 0 ? 0.f : j == 1 ? 0.3826834324f : j == 2 ? 0.7071067812f : j == 3 ? 0.9238795325f : j == 4 ? 1.f : j == 5 ? 0.9238795325f : j == 6 ? 0.7071067812f : 0.3826834324f; }
__host__ __device__ constexpr int bitrev(int q, int bits) { int r = 0; for (int i = 0; i < bits; ++i) r |= ((q >> i) & 1) << (bits - 1 - i); return r; }
template <int R, bool INV> __device__ __forceinline__ void dft_reg(f32x2 (&x)[R]) {
#pragma unroll
    for (int len = R; len >= 2; len >>= 1) { const int half = len >> 1, step = 16 / len;
#pragma unroll
        for (int b0 = 0; b0 < R; b0 += len)
#pragma unroll
            for (int k = 0; k < half; ++k) { const f32x2 a = x[b0 + k], b = x[b0 + k + half]; x[b0 + k] = a + b; const f32x2 dd = a - b; const int j = k * step;
                if (j == 0) x[b0 + k + half] = dd;
                else if (j == 4) x[b0 + k + half] = INV ? (f32x2){-dd.y, dd.x} : (f32x2){dd.y, -dd.x};
                else { const float c = w16c(j), s = w16s(j); x[b0 + k + half] = INV ? (f32x2){dd.x * c - dd.y * s, dd.x * s + dd.y * c} : (f32x2){dd.x * c + dd.y * s, dd.y * c - dd.x * s}; } } }
}
template <int R, int LOGN, bool INV> __device__ __forceinline__ void fft_pass(LAS f32x2* buf, int tid) {
    constexpr int LOGR = (R == 16) ? 4 : 3, LOGM = LOGN - LOGR, M = 1 << LOGM, NBF = 16384 / R / NTHR;
#pragma unroll 1
    for (int it = 0; it < NBF; ++it) {
        int tl = tid; asm volatile("" : "+v"(tl));
        const int bq = tl + NTHR * it, blk = bq >> LOGM, j = bq & (M - 1), base = (blk << LOGN) + j; const int fb = fsw(base);
#define FADDR(q) (fb ^ (((q) << LOGM) ^ ((((q) << LOGM) >> 5) & 7) ^ (((((q) << LOGM) >> 6) & 3) << 3)))
        f32x2 x[R];
#pragma unroll
        for (int q = 0; q < R; ++q) x[q] = buf[FADDR(q)];
        f32x2 w1 = (f32x2){1.f, 0.f};
        if (LOGM > 0) { const float rev = (float)j * (1.0f / (float)(1 << LOGN)); const float sn = sin_rev(rev); w1 = (f32x2){cos_rev(rev), INV ? sn : -sn}; }
        if (!INV) {
            dft_reg<R, false>(x);
            buf[fb] = x[0]; f32x2 w = w1;
#pragma unroll
            for (int q = 1; q < R; ++q) { buf[FADDR(q)] = (LOGM > 0) ? cmul(x[bitrev(q, LOGR)], w) : x[bitrev(q, LOGR)]; if (LOGM > 0) w = cmul(w, w1); }
        } else {
            if (LOGM > 0) { f32x2 w = w1;
#pragma unroll
                for (int q = 1; q < R; ++q) { x[q] = cmul(x[q], w); w = cmul(w, w1); } }
            dft_reg<R, true>(x);
#pragma unroll
            for (int q = 0; q < R; ++q) buf[FADDR(q)] = x[bitrev(q, LOGR)];
        }
#undef FADDR
    }
    __syncthreads();
}
#ifndef FFT_TEST
#define FFT_TEST 0
#endif
__device__ __forceinline__ void fft_fwd(LAS f32x2* buf, int tid) { if (FFT_TEST & 1) return; fft_pass<16, 14, false>(buf, tid); fft_pass<16, 10, false>(buf, tid); fft_pass<8, 6, false>(buf, tid); fft_pass<8, 3, false>(buf, tid); }
__device__ __forceinline__ void fft_inv(LAS f32x2* buf, int tid) { if (FFT_TEST & 2) return; fft_pass<8, 3, true>(buf, tid); fft_pass<8, 6, true>(buf, tid); fft_pass<16, 10, true>(buf, tid); fft_pass<16, 14, true>(buf, tid); }
__device__ __forceinline__ float block_sum(Frame& F, float v) {
    LAS float* red = (LAS float*)(F.lds + LDS_X);
    v = wave_sum(v); __syncthreads(); if (F.lane == 0) red[F.wave] = v; __syncthreads();
    float s = 0.f;
#pragma unroll
    for (int w = 0; w < NWAVES; ++w) s += red[w];
    return s;
}
__device__ __forceinline__ float sconv(const bf16* UH, int b, int ch, int t, float w0, float w1, float w2) {
    const bf16* p = UH + (size_t)(b * 3072 + ch) * SEQ;
    const int tm = t > 0 ? t - 1 : 0, tp = t < SEQ - 1 ? t + 1 : SEQ - 1;
    const float xm = bf2f(p[tm]), x0 = bf2f(p[t]), xp = bf2f(p[tp]);
    return w0 * (t > 0 ? xm : 0.f) + w1 * x0 + w2 * (t < SEQ - 1 ? xp : 0.f);
}
#define HY_UNPK(w) ((f32x2){bflo(w), bfhi(w)})
template <bool INV, class LD, class ST>
__device__ __forceinline__ void fft_edge_pass(LAS f32x2* buf, int tid, LD& ld, ST& st) {
    constexpr int R = 16, LOGN = 14, LOGM = 10;
#pragma unroll
    for (int it = 0; it < 2; ++it) {
        int tl = tid; asm volatile("" : "+v"(tl));
        const int j = tl + NTHR * it; const int fb = fsw(j);
        f32x2 x[R];
#pragma unroll
        for (int q = 0; q < R; ++q) x[q] = ld(2 * q + it, j + (q << LOGM), fb + (q << LOGM));
        const float rev = (float)j * (1.0f / 16384.0f); const float sn = sin_rev(rev); const f32x2 w1 = (f32x2){cos_rev(rev), INV ? sn : -sn};
        if (!INV) {
            dft_reg<R, false>(x);
            st(it, j, fb, x[0]); f32x2 w = w1;
#pragma unroll
            for (int q = 1; q < R; ++q) { st(2 * q + it, j + (q << LOGM), fb + (q << LOGM), cmul(x[bitrev(q, 4)], w)); w = cmul(w, w1); }
        } else {
            f32x2 w = w1;
#pragma unroll
            for (int q = 1; q < R; ++q) { x[q] = cmul(x[q], w); w = cmul(w, w1); }
            dft_reg<R, true>(x);
#pragma unroll
            for (int q = 0; q < R; ++q) st(2 * q + it, j + (q << LOGM), fb + (q << LOGM), x[bitrev(q, 4)]);
        }
        __builtin_amdgcn_sched_barrier(0);
    }
}
__device__ __forceinline__ void fft_last_to_ks(LAS f32x2* buf, int tid, unsigned* KS, float scale) {
#pragma unroll 1
    for (int it = 0; it < 4; ++it) { int tl = tid; asm volatile("" : "+v"(tl)); const int b = tl + NTHR * it; const int fb = fsw(8 * b);
        f32x2 x[8];
#pragma unroll
        for (int q = 0; q < 8; ++q) x[q] = buf[fb ^ q];
        dft_reg<8, false>(x);
        u32x4 o0, o1; f32x2 v;
        v = x[bitrev(0, 3)] * scale; o0.x = cvt_pk_bf16(v.x, v.y); v = x[bitrev(1, 3)] * scale; o0.y = cvt_pk_bf16(v.x, v.y); v = x[bitrev(2, 3)] * scale; o0.z = cvt_pk_bf16(v.x, v.y); v = x[bitrev(3, 3)] * scale; o0.w = cvt_pk_bf16(v.x, v.y);
        v = x[bitrev(4, 3)] * scale; o1.x = cvt_pk_bf16(v.x, v.y); v = x[bitrev(5, 3)] * scale; o1.y = cvt_pk_bf16(v.x, v.y); v = x[bitrev(6, 3)] * scale; o1.z = cvt_pk_bf16(v.x, v.y); v = x[bitrev(7, 3)] * scale; o1.w = cvt_pk_bf16(v.x, v.y);
        *(GAS u32x4*)(KS + 8 * b) = o0; *(GAS u32x4*)(KS + 8 * b + 4) = o1; }
}
__device__ __forceinline__ void fft_mid_mul(LAS f32x2* buf, int tid, const unsigned* KS) {
#pragma unroll 2
    for (int it = 0; it < 4; ++it) { int tl = tid; asm volatile("" : "+v"(tl)); const int b = tl + NTHR * it; const int fb = fsw(8 * b);
        const u32x4 k0 = *(const GAS u32x4*)(KS + 8 * b), k1 = *(const GAS u32x4*)(KS + 8 * b + 4);
        f32x2 x[8], y[8];
#pragma unroll
        for (int q = 0; q < 8; ++q) x[q] = buf[fb ^ q];
        dft_reg<8, false>(x);
        y[0] = cmul(x[bitrev(0, 3)], HY_UNPK(k0.x)); y[1] = cmul(x[bitrev(1, 3)], HY_UNPK(k0.y)); y[2] = cmul(x[bitrev(2, 3)], HY_UNPK(k0.z)); y[3] = cmul(x[bitrev(3, 3)], HY_UNPK(k0.w));
        y[4] = cmul(x[bitrev(4, 3)], HY_UNPK(k1.x)); y[5] = cmul(x[bitrev(5, 3)], HY_UNPK(k1.y)); y[6] = cmul(x[bitrev(6, 3)], HY_UNPK(k1.z)); y[7] = cmul(x[bitrev(7, 3)], HY_UNPK(k1.w));
        dft_reg<8, true>(y);
#pragma unroll
        for (int q = 0; q < 8; ++q) buf[fb ^ q] = y[bitrev(q, 3)]; }
    __syncthreads();
}
struct HyStLds { LAS f32x2* buf; __device__ __forceinline__ void operator()(int, int, int addr, f32x2 v) { buf[addr] = v; } };
struct HyLdLds { LAS f32x2* buf; __device__ __forceinline__ f32x2 operator()(int, int, int addr) { return buf[addr]; } };
struct HyLdKc { const bf16* f0; const bf16* f1; float part; __device__ __forceinline__ f32x2 operator()(int, int t, int) { const float a0 = bf2f(f0[t]), r1 = (t == 0) ? 0.f : bf2f(f1[SEQ - t]); part += fabsf(a0) + fabsf(r1); return (f32x2){a0 + r1, 0.f}; } };
struct HyLdKn { const bf16* f0; const bf16* f1; __device__ __forceinline__ f32x2 operator()(int, int t, int) { const float a0 = bf2f(f0[t]), r1 = (t == 0) ? 0.f : bf2f(f1[SEQ - t]); const float rev = (float)t * (1.0f / 32768.0f), v = a0 - r1; return (f32x2){v * cos_rev(rev), v * sin_rev(rev)}; } };
struct HyLdZ { const unsigned* z; __device__ __forceinline__ f32x2 operator()(int k, int, int) { return HY_UNPK(z[k]); } };
struct HyLdZpsi { const unsigned* z; __device__ __forceinline__ f32x2 operator()(int k, int t, int) { const float rev = (float)t * (1.0f / 32768.0f); return cmul(HY_UNPK(z[k]), (f32x2){cos_rev(rev), sin_rev(rev)}); } };
struct HyStYc { unsigned* yc; __device__ __forceinline__ void operator()(int k, int, int, f32x2 v) { const f32x2 w = v * (0.5f / 16384.0f); yc[k] = cvt_pk_bf16(w.x, w.y); } };
struct HyStComb { unsigned* z; const unsigned* yc; float bias;
    __device__ __forceinline__ void operator()(int k, int t, int, f32x2 v) { const float rev = (float)t * (1.0f / 32768.0f);
        const f32x2 yn = cmul(v, (f32x2){cos_rev(rev), -sin_rev(rev)}) * (0.5f / 16384.0f); const f32x2 y = yn + HY_UNPK(yc[k]) + HY_UNPK(z[k]) * bias; z[k] = cvt_pk_bf16(y.x, y.y); } };
template <bool NEG> __device__ __forceinline__ float hy_load_kernel(LAS f32x2* buf, int tid, const bf16* f0, const bf16* f1) {
    float part = 0.f;
#pragma unroll 2
    for (int r = 0; r < 4; ++r) { int tl = tid; asm volatile("" : "+v"(tl)); const int t0 = 8 * (tl + NTHR * r); const int fb = fsw(t0); float a[8], q[8];
        const u32x4 va = *(const GAS u32x4*)(f0 + t0), vr = *(const GAS u32x4*)(f1 + SEQ - t0 - 8); const float r0 = bf2f(f1[t0 > 0 ? SEQ - t0 : 0]);
        a[0] = bflo(va.x); a[1] = bfhi(va.x); a[2] = bflo(va.y); a[3] = bfhi(va.y); a[4] = bflo(va.z); a[5] = bfhi(va.z); a[6] = bflo(va.w); a[7] = bfhi(va.w);
        q[0] = t0 > 0 ? r0 : 0.f; q[1] = bfhi(vr.w); q[2] = bflo(vr.w); q[3] = bfhi(vr.z); q[4] = bflo(vr.z); q[5] = bfhi(vr.y); q[6] = bflo(vr.y); q[7] = bfhi(vr.x);
#pragma unroll
        for (int e = 0; e < 8; ++e) {
            if (!NEG) { part += fabsf(a[e]) + fabsf(q[e]); buf[fb ^ e] = (f32x2){a[e] + q[e], 0.f}; }
            else { const float rev = (float)(t0 + e) * (1.0f / 32768.0f), v = a[e] - q[e]; buf[fb ^ e] = (f32x2){v * cos_rev(rev), v * sin_rev(rev)}; } } }
    return part;
}
__device__ __forceinline__ void hy_conv8(const u32x4 v, float hm, float hp, float w0, float w1, float w2, float (&o)[8]) {
    const float x1 = bflo(v.x), x2 = bfhi(v.x), x3 = bflo(v.y), x4 = bfhi(v.y), x5 = bflo(v.z), x6 = bfhi(v.z), x7 = bflo(v.w), x8 = bfhi(v.w);
    o[0] = w0 * hm + w1 * x1 + w2 * x2; o[1] = w0 * x1 + w1 * x2 + w2 * x3; o[2] = w0 * x2 + w1 * x3 + w2 * x4; o[3] = w0 * x3 + w1 * x4 + w2 * x5;
    o[4] = w0 * x4 + w1 * x5 + w2 * x6; o[5] = w0 * x5 + w1 * x6 + w2 * x7; o[6] = w0 * x6 + w1 * x7 + w2 * x8; o[7] = w0 * x7 + w1 * x8 + w2 * hp;
}
__device__ __forceinline__ void hy_load_conv(LAS f32x2* buf, int tid, const bf16* UH, int ch, float w0, float w1, float w2) {
    const bf16* p0 = UH + (size_t)ch * SEQ; const bf16* p1 = UH + (size_t)(3072 + ch) * SEQ;
#pragma unroll 2
    for (int r = 0; r < 4; ++r) { int tl = tid; asm volatile("" : "+v"(tl)); const int t0 = 8 * (tl + NTHR * r); const int fb = fsw(t0);
        const int tm = t0 > 0 ? t0 - 1 : 0, tp = t0 + 8 < SEQ ? t0 + 8 : SEQ - 1;
        const u32x4 va = *(const GAS u32x4*)(p0 + t0), vb = *(const GAS u32x4*)(p1 + t0);
        float am = bf2f(p0[tm]), ap = bf2f(p0[tp]), bm = bf2f(p1[tm]), bp = bf2f(p1[tp]);
        if (t0 == 0) { am = 0.f; bm = 0.f; } if (t0 + 8 >= SEQ) { ap = 0.f; bp = 0.f; }
        float oa[8], ob[8]; hy_conv8(va, am, ap, w0, w1, w2, oa); hy_conv8(vb, bm, bp, w0, w1, w2, ob);
        buf[fb ^ 0] = (f32x2){oa[0], ob[0]}; buf[fb ^ 1] = (f32x2){oa[1], ob[1]}; buf[fb ^ 2] = (f32x2){oa[2], ob[2]}; buf[fb ^ 3] = (f32x2){oa[3], ob[3]};
        buf[fb ^ 4] = (f32x2){oa[4], ob[4]}; buf[fb ^ 5] = (f32x2){oa[5], ob[5]}; buf[fb ^ 6] = (f32x2){oa[6], ob[6]}; buf[fb ^ 7] = (f32x2){oa[7], ob[7]}; }
}
__device__ __forceinline__ void hyena_item(Frame& F, int c) {
    LAS f32x2* buf = (LAS f32x2*)F.lds;
    unsigned* KS = (unsigned*)(F.ws + WS_HYS + (size_t)F.bx * HYS_STRIDE);
    const bf16* FILT = (const bf16*)(F.ws + WS_FILT); const bf16* UH = (const bf16*)(F.ws + WS_UH);
    const int tid = F.tid; const int ft = fsw(tid);
#define FB(k) buf[ft + NTHR * (k)]
    const float* sw = F.in[IN_HSW];
    unsigned z[32], yc[32];
    HyStLds stl{buf}; HyLdLds ldl{buf};
    hy_load_conv(buf, tid, UH, c, sw[c], sw[3072 + c], sw[6144 + c]);
    __syncthreads();
#pragma unroll
    for (int k = 0; k < 32; ++k) { const f32x2 v_ = FB(k); z[k] = cvt_pk_bf16(v_.x, v_.y); }
#pragma unroll 1
    for (int o = 0; o < 2; ++o) {
        const bf16* f0 = FILT + (size_t)(o * 1024 + c) * SEQ; const bf16* f1 = FILT + (size_t)(2048 + o * 1024 + c) * SEQ;
        __syncthreads();
        const float part = hy_load_kernel<false>(buf, tid, f0, f1);
        const float inv = 1.0f / (block_sum(F, part) + 1e-6f);
        fft_edge_pass<false>(buf, tid, ldl, stl); __syncthreads();
        fft_pass<16, 10, false>(buf, tid); fft_pass<8, 6, false>(buf, tid);
        fft_last_to_ks(buf, tid, KS, inv); __syncthreads();
        { HyLdZ ldz{z}; fft_edge_pass<false>(buf, tid, ldz, stl); __syncthreads(); }
        fft_pass<16, 10, false>(buf, tid); fft_pass<8, 6, false>(buf, tid);
        fft_mid_mul(buf, tid, KS);
        fft_pass<8, 6, true>(buf, tid); fft_pass<16, 10, true>(buf, tid);
        { HyStYc styc{yc}; fft_edge_pass<true>(buf, tid, ldl, styc); }
        __syncthreads();
        (void)hy_load_kernel<true>(buf, tid, f0, f1); __syncthreads();
        fft_edge_pass<false>(buf, tid, ldl, stl); __syncthreads();
        fft_pass<16, 10, false>(buf, tid); fft_pass<8, 6, false>(buf, tid);
        fft_last_to_ks(buf, tid, KS, inv); __syncthreads();
        { HyLdZpsi ldzp{z}; fft_edge_pass<false>(buf, tid, ldzp, stl); __syncthreads(); }
        fft_pass<16, 10, false>(buf, tid); fft_pass<8, 6, false>(buf, tid);
        fft_mid_mul(buf, tid, KS);
        fft_pass<8, 6, true>(buf, tid); fft_pass<16, 10, true>(buf, tid);
        { HyStComb stc{z, yc, F.in[IN_HBIAS][o * 1024 + c]}; fft_edge_pass<true>(buf, tid, ldl, stc); }
#pragma unroll
        for (int k = 0; k < 32; ++k) FB(k) = HY_UNPK(z[k]);
        { const int xch = (o + 1) * 1024 + c; const float w0 = sw[xch], w1 = sw[3072 + xch], w2 = sw[6144 + xch];
#pragma unroll 8
          for (int k = 0; k < 32; ++k) { const int t = tid + NTHR * k; f32x2 v_ = FB(k); v_.x *= sconv(UH, 0, xch, t, w0, w1, w2); v_.y *= sconv(UH, 1, xch, t, w0, w1, w2); FB(k) = v_; } }
#pragma unroll
        for (int k = 0; k < 32; ++k) { const f32x2 v_ = FB(k); z[k] = cvt_pk_bf16(v_.x, v_.y); }
        __syncthreads();
    }
    bf16* YHCM = (bf16*)(F.ws + WS_YHCM);
#pragma unroll
    for (int k = 0; k < 32; ++k) FB(k) = HY_UNPK(z[k]);
#pragma unroll 8
    for (int k = 0; k < 32; ++k) { const int t = tid + NTHR * k; const f32x2 v_ = FB(k); YHCM[(size_t)c * SEQ + t] = (bf16)f2bf(v_.x); YHCM[(size_t)(1024 + c) * SEQ + t] = (bf16)f2bf(v_.y); }
    __syncthreads();
#undef FB
}
__device__ __forceinline__ void p4_hyena_carry(Frame& F, int qw) {
    volatile LAS int* qs = (volatile LAS int*)(F.lds + MISC_OFF + 64);
    for (;;) {
        __syncthreads();
        if (F.tid == 0) qs[0] = (int)__hip_atomic_fetch_add((unsigned*)(F.ctl + qw), 1u, __ATOMIC_RELAXED, __HIP_MEMORY_SCOPE_AGENT);
        __syncthreads();
        const int q = qs[0];
        if (q >= 32 + 1024) break;
        if (q < 1024) hyena_item(F, q); else s5_carry_item(F, q - 1024);
    }
}
__device__ __forceinline__ void yh_transpose(Frame& F) {
    const bf16* YHCM = (const bf16*)(F.ws + WS_YHCM); bf16* YH = (bf16*)(F.ws + WS_YH);
    LAS unsigned short* tl = (LAS unsigned short*)(F.lds + 8 * 8704 + F.wave * (64 * 72 * 2));
    const int gw = F.bx * NWAVES + F.wave, NGW = F.G * NWAVES, lane = F.lane;
    for (int it = gw; it < 2 * 16 * 256; it += NGW) {
        const int mt = it & 255, ct = (it >> 8) & 15, b = it >> 12; const int m0 = mt * 64, c0 = ct * 64;
#pragma unroll
        for (int j = 0; j < 8; ++j) { const int ch = 8 * j + (lane >> 3), mc = (lane & 7) * 8;
            const u32x4 v = *(const GAS u32x4*)(YHCM + (size_t)(b * 1024 + c0 + ch) * SEQ + m0 + mc); *(LAS u32x4*)(tl + ch * 72 + mc) = v; }
        LDS_WAIT(); asm volatile("" ::: "memory");
#pragma unroll
        for (int j = 0; j < 8; ++j) { const int mm = 8 * j + (lane >> 3), cc = (lane & 7) * 8; const int m = m0 + mm, w = m >> 8, r = m & 255;
            u32x4 o; o.x = (unsigned)tl[(cc + 0) * 72 + mm] | ((unsigned)tl[(cc + 1) * 72 + mm] << 16); o.y = (unsigned)tl[(cc + 2) * 72 + mm] | ((unsigned)tl[(cc + 3) * 72 + mm] << 16);
            o.z = (unsigned)tl[(cc + 4) * 72 + mm] | ((unsigned)tl[(cc + 5) * 72 + mm] << 16); o.w = (unsigned)tl[(cc + 6) * 72 + mm] | ((unsigned)tl[(cc + 7) * 72 + mm] << 16);
            *(GAS u32x4*)(YH + (size_t)(b * SEQ + r * 64 + w) * HYW + c0 + cc) = o; }
        LDS_WAIT(); asm volatile("" ::: "memory");
    }
}

struct SchedStd {
    int G, c, npn, K, nrep; const char* A; const char* Bt;
    __device__ __forceinline__ bool next(int i, pg8::Unit& u) const {
        int L = i * G + c; const int nwg = 128 * npn; u.e = 0; u.valid = 256;
        if (nrep > 1 && L >= nwg) L -= nwg;
        if (L >= nwg) return false;
        int wgid = L; { const int q = nwg / 8, xcd = wgid % 8, off = wgid / 8; wgid = xcd * q + off; }
        const int nig = 8 * npn, gid = wgid / nig; u.pm = gid * 8 + ((wgid % nig) % 8); u.pn = (wgid % nig) / 8; return true;
    }
    __device__ __forceinline__ unsigned a_row(const pg8::Unit& u, int r) const { return (unsigned)(u.pm * 256 + r); }
    __device__ __forceinline__ const char* a_base() const { return A; }
    __device__ __forceinline__ const char* b_base(const pg8::Unit& u) const { return Bt + (size_t)u.pn * 256 * K * 2; }
};
template <int MODE> struct EpiMix {
    static constexpr bool PERM = true, TRANS = true, FP8 = false;
    const bf16* P; const bf16* Q; bf16* O;
    __device__ __forceinline__ void operator()(const f32x4 (&acc)[2][2][4][2], const pg8::Unit& u, int wr, int wc, int fr, int fq) const {
        constexpr int ld = (MODE == 0) ? 1024 : 2048;
        const int col0 = u.pn * 256 + wc * 32 + 8 * fq;
#pragma unroll
        for (int ai = 0; ai < 2; ++ai)
#pragma unroll
            for (int m = 0; m < 4; ++m) { const size_t row = (size_t)u.pm * 256 + ai * 128 + wr * 64 + m * 16 + fr;
#pragma unroll
                for (int bj = 0; bj < 2; ++bj) { const int col = col0 + bj * 128; const f32x4 v0 = acc[ai][bj][m][0], v1 = acc[ai][bj][m][1]; float r[8];
                    if (MODE == 0) { const u32x4 y = *(const u32x4*)(P + row * 1024 + col);
                        r[0] = bflo(y.x) * sigmoidf_(v0[0]); r[1] = bfhi(y.x) * sigmoidf_(v0[1]); r[2] = bflo(y.y) * sigmoidf_(v0[2]); r[3] = bfhi(y.y) * sigmoidf_(v0[3]);
                        r[4] = bflo(y.z) * sigmoidf_(v1[0]); r[5] = bfhi(y.z) * sigmoidf_(v1[1]); r[6] = bflo(y.w) * sigmoidf_(v1[2]); r[7] = bfhi(y.w) * sigmoidf_(v1[3]); }
                    else { const u32x4 gg = *(const u32x4*)(P + row * 4096 + (MODE == 2 ? 2048 : 0) + col);
                        r[0] = bflo(gg.x) * v0[0]; r[1] = bfhi(gg.x) * v0[1]; r[2] = bflo(gg.y) * v0[2]; r[3] = bfhi(gg.y) * v0[3];
                        r[4] = bflo(gg.z) * v1[0]; r[5] = bfhi(gg.z) * v1[1]; r[6] = bflo(gg.w) * v1[2]; r[7] = bfhi(gg.w) * v1[3];
                        if (MODE == 2) { const u32x4 t1 = *(const u32x4*)(Q + row * 2048 + col);
                            r[0] += bflo(t1.x); r[1] += bfhi(t1.x); r[2] += bflo(t1.y); r[3] += bfhi(t1.y); r[4] += bflo(t1.z); r[5] += bfhi(t1.z); r[6] += bflo(t1.w); r[7] += bfhi(t1.w); } }
                    u32x4 w; w.x = cvt_pk_bf16(r[0], r[1]); w.y = cvt_pk_bf16(r[2], r[3]); w.z = cvt_pk_bf16(r[4], r[5]); w.w = cvt_pk_bf16(r[6], r[7]);
                    *(u32x4*)(O + row * ld + col) = w; } }
    }
};
struct EpiOut {
    static constexpr bool PERM = false, TRANS = true, FP8 = false;
    const float* X; const float* MOD; float* H1;
    __device__ __forceinline__ void operator()(const f32x4 (&acc)[2][2][4][2], const pg8::Unit& u, int wr, int wc, int fr, int fq) const {
        const int b = u.pm >> 6; const int col0 = u.pn * 256 + wc * 32 + 4 * fq;
        f32x4 gv[2][2];
#pragma unroll
        for (int bj = 0; bj < 2; ++bj)
#pragma unroll
            for (int n = 0; n < 2; ++n) gv[bj][n] = *(const f32x4*)(MOD + b * 12288 + 2 * 2048 + col0 + bj * 128 + n * 16);
#pragma unroll
        for (int ai = 0; ai < 2; ++ai)
#pragma unroll
            for (int m = 0; m < 4; ++m) { const size_t off = ((size_t)u.pm * 256 + ai * 128 + wr * 64 + m * 16 + fr) * D + col0;
#pragma unroll
                for (int bj = 0; bj < 2; ++bj)
#pragma unroll
                    for (int n = 0; n < 2; ++n) { const f32x4 xv = *(const f32x4*)(X + off + bj * 128 + n * 16); *(f32x4*)(H1 + off + bj * 128 + n * 16) = xv + gv[bj][n] * acc[ai][bj][m][n]; } }
    }
};

__device__ __forceinline__ void p10_router(Frame& F) {
    const int gw = F.bx * NWAVES + F.wave, NGW = F.G * NWAVES, lane = F.lane;
    const float* MOD = (const float*)(F.ws + WS_MOD); const float* g2n = F.in[IN_N2G]; const float* RWT = (const float*)(F.ws + WS_RWT); const float* rb = F.in[IN_RB];
    const float* H1 = (const float*)(F.ws + WS_H1); unsigned char* HM8 = (unsigned char*)(F.ws + WS_HM8); float* GATE = (float*)(F.ws + WS_GATE); int* LIST = (int*)(F.ws + WS_LIST);
    for (int m0 = 2 * gw; m0 < NTOK; m0 += 2 * NGW) {
        const int b = m0 >> 14;
        f32x4 h[2][8];
#pragma unroll
        for (int rr = 0; rr < 2; ++rr) { const float* xr = H1 + (size_t)(m0 + rr) * D; float s = 0.f;
#pragma unroll
            for (int j = 0; j < 8; ++j) { h[rr][j] = *(const GAS f32x4*)(xr + 4 * lane + 256 * j); s += (h[rr][j].x * h[rr][j].x + h[rr][j].y * h[rr][j].y) + (h[rr][j].z * h[rr][j].z + h[rr][j].w * h[rr][j].w); }
            const float rstd = 1.0f / sqrtf(wave_sum(s) * (1.0f / D) + 1e-6f);
            GAS unsigned* o = (GAS unsigned*)(HM8 + (size_t)(m0 + rr) * D) + lane;
#pragma unroll
            for (int j = 0; j < 8; ++j) { const int k = 4 * lane + 256 * j; const f32x4 g = *(const f32x4*)(g2n + k), sc = *(const f32x4*)(MOD + b * 12288 + 4 * 2048 + k), sh = *(const f32x4*)(MOD + b * 12288 + 3 * 2048 + k);
                h[rr][j] = h[rr][j] * rstd * g * (sc + 1.0f) + sh; o[64 * j] = pk4_fp8(h[rr][j].x, h[rr][j].y, h[rr][j].z, h[rr][j].w); } }
        float lg0 = -3.0e38f, lg1 = -3.0e38f;
#pragma unroll 2
        for (int e = 0; e < NEXP; ++e) { float s0 = 0.f, s1 = 0.f;
#pragma unroll
            for (int j = 0; j < 8; ++j) { const f32x4 w = *(const f32x4*)(RWT + e * 2048 + 4 * lane + 256 * j);
                s0 += (h[0][j].x * w.x + h[0][j].y * w.y) + (h[0][j].z * w.z + h[0][j].w * w.w); s1 += (h[1][j].x * w.x + h[1][j].y * w.y) + (h[1][j].z * w.z + h[1][j].w * w.w); }
            s0 = wave_sum(s0) + rb[e]; s1 = wave_sum(s1) + rb[e];
            if (lane == e) { lg0 = s0; lg1 = s1; } }
#pragma unroll
        for (int rr = 0; rr < 2; ++rr) { float lg = rr ? lg1 : lg0; int es[4]; float vs[4];
#pragma unroll
            for (int k = 0; k < 4; ++k) { const float mx = wave_max(lg); const unsigned long long bal = __ballot(lg == mx); const int idx = __ffsll((long long)bal) - 1; es[k] = idx; vs[k] = mx; if (lane == idx) lg = -3.0e38f; }
            const float e1 = __expf(vs[1] - vs[0]), e2 = __expf(vs[2] - vs[0]), e3 = __expf(vs[3] - vs[0]); const float inv = 1.0f / (1.0f + e1 + e2 + e3);
            if (lane < 4) { const int ee = lane == 0 ? es[0] : lane == 1 ? es[1] : lane == 2 ? es[2] : es[3]; const float gt = (lane == 0 ? 1.0f : lane == 1 ? e1 : lane == 2 ? e2 : e3) * inv;
                const int slot = (m0 + rr) * 4 + lane;
                const unsigned pos = __hip_atomic_fetch_add((unsigned*)(F.ctl + CW_CNT + 64 * ee), 1u, __ATOMIC_RELAXED, __HIP_MEMORY_SCOPE_AGENT);
                LIST[ee * LISTCAP + (int)pos] = slot; GATE[slot] = gt; } }
    }
}

__device__ __forceinline__ void moe_tables(Frame& F) {
    volatile LAS int* tb = (volatile LAS int*)(F.lds + LDS_X);
    __syncthreads();
    if (F.tid < NEXP) tb[64 + F.tid] = (int)__hip_atomic_load((unsigned*)(F.ctl + CW_CNT + 64 * F.tid), __ATOMIC_RELAXED, __HIP_MEMORY_SCOPE_AGENT);
    __syncthreads();
    if (F.tid == 0) { int acc = 0; for (int e = 0; e < NEXP; ++e) { const int c = tb[64 + e]; tb[e] = acc; acc += (c + 255) >> 8; } tb[32] = acc; }
    __syncthreads();
}
template <bool GATHER> struct SchedMoe {
    int G, c, npn, N, K, nrep; const char* A; const char* Bt; const int* LIST; volatile LAS int* tb;
    __device__ __forceinline__ bool next(int i, pg8::Unit& u) const {
        int L = i * G + c; { const int tot = tb[32] * npn; if (nrep > 1 && L >= tot) L -= tot; }
        int rt = L / npn, pnq = L % npn;
        if (G == 256 && nrep == 1) {
            const int x = c & 7, j = c >> 3;
            if (npn == 16) { pnq = 4 * (x & 3) + (j & 3); rt = 16 * i + (x >> 2) * 8 + (j >> 2); }
            else           { pnq = 2 * (x & 3) + (j & 1); rt = 32 * i + (x >> 2) * 16 + (j >> 1); }
        }
        if (rt >= tb[32]) return false;
        int e = 0;
        for (int q = 1; q < NEXP; ++q) e += (tb[q] <= rt) ? 1 : 0;
        e = __builtin_amdgcn_readfirstlane(e);
        u.pm = rt; u.pn = pnq; u.e = e; const int left = tb[64 + e] - 256 * (rt - tb[e]); u.valid = left < 256 ? left : 256; return true;
    }
    __device__ __forceinline__ unsigned a_row(const pg8::Unit& u, int r) const {
        if (GATHER) { const int rc = r < u.valid ? r : u.valid - 1; return (unsigned)(LIST[u.e * LISTCAP + (u.pm - tb[u.e]) * 256 + rc] >> 2); }
        return (unsigned)(u.pm * 256 + r);
    }
    __device__ __forceinline__ const char* a_base() const { return A; }
    __device__ __forceinline__ const char* b_base(const pg8::Unit& u) const { return Bt + ((size_t)u.e * N + (size_t)u.pn * 256) * K; }
};
struct EpiMoe1 {
    static constexpr bool PERM = true, TRANS = true, FP8 = true;
    const float* BG; unsigned char* ACT;
    __device__ __forceinline__ void operator()(const f32x4 (&acc)[2][2][4][2], const pg8::Unit& u, int wr, int wc, int fr, int fq) const {
        const int c0 = u.pn * 256 + wc * 32 + 8 * fq;
        f32x4 bv[2][2];
#pragma unroll
        for (int bj = 0; bj < 2; ++bj)
#pragma unroll
            for (int n = 0; n < 2; ++n) bv[bj][n] = *(const f32x4*)(BG + (size_t)u.e * 4096 + c0 + bj * 128 + 4 * n);
#pragma unroll
        for (int ai = 0; ai < 2; ++ai)
#pragma unroll
            for (int m = 0; m < 4; ++m) { const size_t row = (size_t)u.pm * 256 + ai * 128 + wr * 64 + m * 16 + fr;
#pragma unroll
                for (int bj = 0; bj < 2; ++bj) { const f32x4 v0 = acc[ai][bj][m][0] * (1.0f / W8SCALE) + bv[bj][0], v1 = acc[ai][bj][m][1] * (1.0f / W8SCALE) + bv[bj][1]; float a[4];
#pragma unroll
                    for (int j = 0; j < 4; ++j) { const float gl = fminf(j < 2 ? v0[2 * j] : v1[2 * j - 4], 7.0f); const float ln = fminf(fmaxf(j < 2 ? v0[2 * j + 1] : v1[2 * j - 3], -7.0f), 7.0f);
                        a[j] = gl * sigmoidf_(1.702f * gl) * (ln + 1.0f); }
                    *(unsigned*)(ACT + row * DEXP + ((c0 + bj * 128) >> 1)) = pk4_fp8(a[0], a[1], a[2], a[3]); } }
    }
};
struct EpiMoe2 {
    static constexpr bool PERM = true, TRANS = true, FP8 = true;
    const float* BD; const float* GATE; const int* LIST; bf16* YS; volatile LAS int* tb;
    __device__ __forceinline__ void operator()(const f32x4 (&acc)[2][2][4][2], const pg8::Unit& u, int wr, int wc, int fr, int fq) const {
        const int c0 = u.pn * 256 + wc * 32 + 8 * fq; const int lbase = u.e * LISTCAP + (u.pm - tb[u.e]) * 256;
        f32x4 bv[2][2];
#pragma unroll
        for (int bj = 0; bj < 2; ++bj)
#pragma unroll
            for (int n = 0; n < 2; ++n) bv[bj][n] = *(const f32x4*)(BD + (size_t)u.e * D + c0 + bj * 128 + 4 * n);
        int slot[2][4]; float gt_[2][4];
#pragma unroll
        for (int ai = 0; ai < 2; ++ai)
#pragma unroll
            for (int m = 0; m < 4; ++m) { const int r = ai * 128 + wr * 64 + m * 16 + fr; slot[ai][m] = LIST[lbase + (r < u.valid ? r : u.valid - 1)]; }
#pragma unroll
        for (int ai = 0; ai < 2; ++ai)
#pragma unroll
            for (int m = 0; m < 4; ++m) gt_[ai][m] = GATE[slot[ai][m]];
#pragma unroll
        for (int ai = 0; ai < 2; ++ai)
#pragma unroll
            for (int m = 0; m < 4; ++m) { const int r = ai * 128 + wr * 64 + m * 16 + fr; const float gt = gt_[ai][m];
                const long long ro = (r < u.valid) ? (long long)slot[ai][m] * D : YS_DUMP_OFF;
#pragma unroll
                for (int bj = 0; bj < 2; ++bj) { const f32x4 v0 = (acc[ai][bj][m][0] * (1.0f / W8SCALE) + bv[bj][0]) * gt, v1 = (acc[ai][bj][m][1] * (1.0f / W8SCALE) + bv[bj][1]) * gt;
                    u32x4 w; w.x = cvt_pk_bf16(v0[0], v0[1]); w.y = cvt_pk_bf16(v0[2], v0[3]); w.z = cvt_pk_bf16(v1[0], v1[1]); w.w = cvt_pk_bf16(v1[2], v1[3]);
                    *(u32x4*)(YS + ro + c0 + bj * 128) = w; } }
    }
};
__device__ __forceinline__ void p13_final(Frame& F) {
    const int gw = F.bx * NWAVES + F.wave, NGW = F.G * NWAVES, lane = F.lane;
    const float* MOD = (const float*)(F.ws + WS_MOD); const float* fg = F.in[IN_FG]; const bf16* YS = (const bf16*)(F.ws + WS_YS); float* O = F.out;
    for (int m = gw; m < NTOK; m += NGW) {
        const int b = m >> 14; float* xr = O + (size_t)m * D; const float* hr = (const float*)(F.ws + WS_H1) + (size_t)m * D; f32x4 h[8]; float s = 0.f;
#pragma unroll
        for (int j = 0; j < 8; ++j) { const int k = 4 * lane + 256 * j; f32x4 a = (f32x4){0.f, 0.f, 0.f, 0.f};
#pragma unroll
            for (int q = 0; q < 4; ++q) { const u32x2 y = *(const GAS u32x2*)(YS + (size_t)(m * 4 + q) * D + k); a += (f32x4){bflo(y.x), bfhi(y.x), bflo(y.y), bfhi(y.y)}; }
            const f32x4 g2 = *(const f32x4*)(MOD + b * 12288 + 5 * 2048 + k);
            h[j] = *(const GAS f32x4*)(hr + k) + g2 * a; s += (h[j].x * h[j].x + h[j].y * h[j].y) + (h[j].z * h[j].z + h[j].w * h[j].w); }
        const float rstd = 1.0f / sqrtf(wave_sum(s) * (1.0f / D) + 1e-6f);
#pragma unroll
        for (int j = 0; j < 8; ++j) { const int k = 4 * lane + 256 * j; *(GAS f32x4*)(xr + k) = h[j] * rstd * *(const f32x4*)(fg + k); }
    }
}

__global__ void __launch_bounds__(NTHR, 2) fwd(Args args) {
    extern __shared__ __attribute__((aligned(16))) unsigned char lds_raw[];
    Frame F;
    F.lds = (LAS unsigned char*)lds_raw;
    F.tid = threadIdx.x; F.lane = F.tid & 63; F.wave = __builtin_amdgcn_readfirstlane(F.tid >> 6);
    F.G = gridDim.x; F.bx = blockIdx.x; F.in = args.in; F.out = args.out; F.ws = args.ws; F.ctl = (GAS unsigned*)(args.ws + WS_CTL);
    for (int u = F.tid; u < (LDS_BYTES - MISC_OFF) / 4; u += NTHR) ((LAS unsigned*)(F.lds + MISC_OFF))[u] = 0u;
    __syncthreads();
    const int lo = args.ph_lo, hi = args.ph_hi;
    XcdBarrier bar; bar.bar = (unsigned*)(F.ctl + CW_BAR); bar.x = 0; bar.st = nullptr;
    if (hi - lo > 1) bar = xcd_barrier_post((unsigned*)(F.ctl + CW_BAR), (volatile LAS unsigned*)(F.lds + MISC_OFF));
#ifndef PH_MASK
#define PH_MASK 0xffff
#endif
#define IN(k) (((PH_MASK >> (k)) & 1) && lo <= (k) && (k) < hi)
#define SEAM(k) do { if (IN(k) && IN((k) + 1)) xcd_barrier(bar); } while (0)
    unsigned char* ws = args.ws;
#ifndef PROBE_DUP
#define PROBE_DUP 0
#endif
#define DUPBAR(k) if ((PROBE_DUP >> (k)) & 1) xcd_barrier(bar)
#define DUP2(k, body) do { body; if ((PROBE_DUP >> (k)) & 1) { xcd_barrier(bar); body; } } while (0)
    if (IN(0)) { DUP2(0, p0_prologue(F)); } SEAM(0);
    if (IN(1)) { DUP2(1, p1_norm(F)); } SEAM(1);
    if (IN(2)) { {
        { SchedIn S{F.G, F.bx, 128 * 4, 4, 0, ((PROBE_DUP >> 2) & 1) ? 2 : 1, (const char*)(ws + WS_U), (const char*)(ws + WS_WIN)}; EpiInA E{ws};
          pg8::gemm_phase<EpiInA, SchedIn>(F.lds, D, S, E); }
        { SchedIn S{F.G, F.bx, 128 * 16, 16, 2, ((PROBE_DUP >> 2) & 1) ? 2 : 1, (const char*)(ws + WS_U8), (const char*)(ws + WS_WIN8)}; EpiInG8 E{(bf16*)(ws + WS_UG)};
          pg8::gemm_phase<EpiInG8, SchedIn>(F.lds, D, S, E); }
        { SchedIn S{F.G, F.bx, 128 * 12, 12, 1, ((PROBE_DUP >> 2) & 1) ? 2 : 1, (const char*)(ws + WS_U), (const char*)(ws + WS_WIN)}; EpiInH E{(bf16*)(ws + WS_UH)};
          pg8::gemm_phase<EpiInH, SchedIn>(F.lds, D, S, E); }
        }
    } SEAM(2);
    if (IN(3)) { DUP2(3, s5_pass3<false>(F)); } SEAM(3);
    if (IN(4)) { int q4w = CW_Q4; DUP2(4, (p4_hyena_carry(F, q4w), q4w += 16)); } SEAM(4);
    if (IN(5)) { DUP2(5, s5_pass3<true>(F)); __syncthreads(); DUP2(14, yh_transpose(F)); } SEAM(5);
    if (IN(6)) { { SchedStd S{F.G, F.bx, 4, 1024, ((PROBE_DUP >> 6) & 1) ? 2 : 1, (const char*)(ws + WS_Y), (const char*)(ws + WS_WGLU)}; EpiMix<0> E{(const bf16*)(ws + WS_Y), nullptr, (bf16*)(ws + WS_YA)};
        pg8::gemm_phase<EpiMix<0>, SchedStd>(F.lds, 1024, S, E); } } SEAM(6);
    if (IN(7)) { { SchedStd S{F.G, F.bx, 8, 1024, ((PROBE_DUP >> 7) & 1) ? 2 : 1, (const char*)(ws + WS_YA), (const char*)(ws + WS_WBS5)}; EpiMix<1> E{(const bf16*)(ws + WS_UG), nullptr, (bf16*)(ws + WS_T1)};
        pg8::gemm_phase<EpiMix<1>, SchedStd>(F.lds, 1024, S, E); } } SEAM(7);
    if (IN(8)) { { SchedStd S{F.G, F.bx, 8, 1024, ((PROBE_DUP >> 8) & 1) ? 2 : 1, (const char*)(ws + WS_YH), (const char*)(ws + WS_WBHY)}; EpiMix<2> E{(const bf16*)(ws + WS_UG), (const bf16*)(ws + WS_T1), (bf16*)(ws + WS_T)};
        pg8::gemm_phase<EpiMix<2>, SchedStd>(F.lds, 1024, S, E); } } SEAM(8);
    if (IN(9)) { { SchedStd S{F.G, F.bx, 8, 2048, ((PROBE_DUP >> 9) & 1) ? 2 : 1, (const char*)(ws + WS_T), (const char*)(ws + WS_WO)}; EpiOut E{F.in[IN_X], (const float*)(ws + WS_MOD), (float*)(ws + WS_H1)};
        pg8::gemm_phase<EpiOut, SchedStd>(F.lds, 2048, S, E); } } SEAM(9);
    if (IN(10)) { p10_router(F); } SEAM(10);
    if (IN(11)) { { moe_tables(F); volatile LAS int* tb = (volatile LAS int*)(F.lds + LDS_X);
        SchedMoe<true> S{F.G, F.bx, 16, 4096, 2048, ((PROBE_DUP >> 11) & 1) ? 2 : 1, (const char*)(ws + WS_HM8), (const char*)(ws + WS_WGU), (const int*)(ws + WS_LIST), tb}; EpiMoe1 E{F.in[IN_BGU], (unsigned char*)(ws + WS_ACT)};
        pg8::gemm_phase<EpiMoe1, SchedMoe<true>>(F.lds, 2048, S, E); } } SEAM(11);
    if (IN(12)) { { moe_tables(F); volatile LAS int* tb = (volatile LAS int*)(F.lds + LDS_X);
        SchedMoe<false> S{F.G, F.bx, 8, 2048, 2048, ((PROBE_DUP >> 12) & 1) ? 2 : 1, (const char*)(ws + WS_ACT), (const char*)(ws + WS_WDN), (const int*)(ws + WS_LIST), tb}; EpiMoe2 E{F.in[IN_BDN], (const float*)(ws + WS_GATE), (const int*)(ws + WS_LIST), (bf16*)(ws + WS_YS), tb};
        pg8::gemm_phase<EpiMoe2, SchedMoe<false>>(F.lds, 2048, S, E); } } SEAM(12);
    if (IN(13)) { DUP2(13, p13_final(F)); }
#undef IN
#undef SEAM
}

extern "C" void kernel_launch(void* const* d_in, const int* in_sizes, int n_in, void* d_out, int out_size, void* d_ws, size_t ws_size, hipStream_t stream) {
    static int grid = 0;
    if (grid == 0) {
        if (n_in != 39 || out_size != NTOK * D || ws_size < WS_END) { fprintf(stderr, "kernel_launch: unexpected shapes: n_in %d out %d ws %zu (need %zu)\n", n_in, out_size, ws_size, (size_t)WS_END); grid = -1; return; }
        int dev = 0, cus = 0, per_cu = 0;
        if (hipGetDevice(&dev) != hipSuccess || hipDeviceGetAttribute(&cus, hipDeviceAttributeMultiprocessorCount, dev) != hipSuccess) { grid = -1; return; }
        if (hipFuncSetAttribute((const void*)fwd, hipFuncAttributeMaxDynamicSharedMemorySize, LDS_BYTES) != hipSuccess) { fprintf(stderr, "kernel_launch: hipFuncSetAttribute failed\n"); grid = -1; return; }
        if (hipOccupancyMaxActiveBlocksPerMultiprocessor(&per_cu, (const void*)fwd, NTHR, LDS_BYTES) != hipSuccess || per_cu < 1) fprintf(stderr, "kernel_launch: occupancy query says %d\n", per_cu);
        (void)hipGetLastError();
        grid = cus;
    }
    if (grid < 0) return;
    if (hipMemsetAsync((char*)d_ws + WS_CTL, 0, CTL_ZERO_BYTES, stream) != hipSuccess) return;
    Args a{};
    for (int i = 0; i < 39; ++i) a.in[i] = (const float*)d_in[i];
    a.out = (float*)d_out; a.ws = (unsigned char*)d_ws;
#ifndef ONE_LAUNCH
#define ONE_LAUNCH 1
#endif
    if (ONE_LAUNCH) { a.ph_lo = 0; a.ph_hi = NPHASE; hipLaunchKernelGGL(fwd, dim3(grid), dim3(NTHR), LDS_BYTES, stream, a); }
    else for (int p = 0; p < NPHASE; ++p) { a.ph_lo = p; a.ph_hi = p + 1; hipLaunchKernelGGL(fwd, dim3(grid), dim3(NTHR), LDS_BYTES, stream, a); }
}
```

```cpp
#include <hip/hip_runtime.h>
#include <cstdio>
#include <cstdint>

#define GAS __attribute__((address_space(1)))
#define LAS __attribute__((address_space(3)))
typedef unsigned short bf16;
typedef short bf16x8 __attribute__((ext_vector_type(8)));
typedef float f32x4 __attribute__((ext_vector_type(4)));
typedef float f32x16 __attribute__((ext_vector_type(16)));
typedef float f32x2 __attribute__((ext_vector_type(2)));
typedef unsigned u32x4 __attribute__((ext_vector_type(4)));
typedef unsigned u32x2 __attribute__((ext_vector_type(2)));
typedef int i32x4 __attribute__((ext_vector_type(4)));
typedef int i32x8 __attribute__((ext_vector_type(8)));

constexpr int D = 2048, NB = 2, SEQ = 16384, NTOK = NB * SEQ, CTX = 256, NCTX = NB * CTX;
constexpr int S5W = 1024, HYW = 1024, INC = 8192, NEXP = 32, TOPK = 4, DEXP = 2048;
constexpr int NCH = 260;
constexpr int LISTCAP = 32768;

constexpr size_t MiB = 1u << 20;
constexpr size_t WS_CTL = 0, CTL_ZERO_BYTES = 1 * MiB;
constexpr size_t WS_MOD = 6 * MiB;
constexpr size_t WS_BBT = 7 * MiB;
constexpr size_t WS_CTT = WS_BBT + 512 * 1024;
constexpr size_t WS_LAM = 8 * MiB;
constexpr size_t WS_RWT = 8 * MiB + 256 * 1024;
constexpr size_t WS_BB2 = 8 * MiB + 512 * 1024;
constexpr size_t WS_WIN = 16 * MiB;
constexpr size_t WS_WGLU = 48 * MiB;
constexpr size_t WS_WBS5 = 50 * MiB;
constexpr size_t WS_WBHY = 54 * MiB;
constexpr size_t WS_WO = 58 * MiB;
constexpr size_t WS_WGU = 66 * MiB;
constexpr size_t WS_WDN = 578 * MiB;
constexpr size_t WS_U = 834 * MiB;
constexpr size_t WS_UCA = 964 * MiB;
constexpr size_t WS_UA = 966 * MiB;
constexpr size_t WS_UH = 1030 * MiB;
constexpr size_t WS_UG = 1222 * MiB;
constexpr size_t WS_E = 1478 * MiB;
constexpr size_t WS_SIN = 1511 * MiB;
constexpr size_t WS_FILT = 1544 * MiB;
constexpr size_t WS_HYS = 1800 * MiB;
constexpr size_t HYS_STRIDE = 768 * 1024;
constexpr size_t WS_YHCM = 1992 * MiB;
constexpr size_t WS_YH = 2056 * MiB;
constexpr size_t WS_Y = 2120 * MiB;
constexpr size_t WS_YA = 2184 * MiB;
constexpr size_t WS_T1 = 2248 * MiB;
constexpr size_t WS_T = 2376 * MiB;
constexpr size_t WS_HM = 2504 * MiB;
constexpr size_t WS_GATE = 2632 * MiB;
constexpr size_t WS_LIST = 2633 * MiB;
constexpr size_t WS_ACT = 2638 * MiB;
constexpr size_t WS_YS = 3182 * MiB;
constexpr size_t WS_H1 = 3694 * MiB;
constexpr size_t WS_HM8 = WS_T1;
constexpr size_t WS_U8 = WS_ACT;
constexpr size_t WS_WIN8 = WS_YS;
constexpr size_t WS_END = 3950 * MiB;
constexpr long long YS_DUMP_OFF = ((long long)(2 * MiB) - (long long)WS_YS) / 2;

constexpr int CW_TMO = 0;
constexpr int CW_Q4 = 64;
constexpr int CW_QT = 96;
constexpr int CW_CNT = 128;
constexpr int CW_BAR = 4096;

constexpr int RING_BYTES = 131072;
constexpr int LDS_X = 131072;
constexpr int MISC_OFF = 147456 - 512;
constexpr int LDS_BYTES = 147456;
constexpr int NWAVES = 8, NTHR = 512;
constexpr int NPHASE = 14;

__device__ __forceinline__ unsigned f2bf(float f) { unsigned u = __builtin_bit_cast(unsigned, f); return (u + 0x7fffu + ((u >> 16) & 1u)) >> 16; }
__device__ __forceinline__ unsigned pk2(float lo, float hi) { return f2bf(lo) | (f2bf(hi) << 16); }
__device__ __forceinline__ float bf2f(unsigned short b) { return __builtin_bit_cast(float, ((unsigned)b) << 16); }
__device__ __forceinline__ float bflo(unsigned w) { return __builtin_bit_cast(float, w << 16); }
__device__ __forceinline__ float bfhi(unsigned w) { return __builtin_bit_cast(float, w & 0xffff0000u); }
typedef __bf16 bf16x2_t __attribute__((ext_vector_type(2)));
__device__ __forceinline__ unsigned cvt_pk_bf16(float lo, float hi) { const f32x2 v = {lo, hi}; const bf16x2_t b = __builtin_convertvector(v, bf16x2_t); return __builtin_bit_cast(unsigned, b); }
__device__ __forceinline__ unsigned pk4_fp8(float a, float b, float c, float d) { unsigned w = 0u; w = (unsigned)__builtin_amdgcn_cvt_pk_fp8_f32(a, b, (int)w, false); w = (unsigned)__builtin_amdgcn_cvt_pk_fp8_f32(c, d, (int)w, true); return w; }
constexpr float T8SCALE = 16.0f;
constexpr float W8SCALE = 64.0f;
__device__ __forceinline__ float sigmoidf_(float x) { return __builtin_amdgcn_rcpf(1.0f + __expf(-x)); }
__device__ __forceinline__ float sin_rev(float r) { return __builtin_amdgcn_sinf(__builtin_amdgcn_fractf(r)); }
__device__ __forceinline__ float cos_rev(float r) { return __builtin_amdgcn_cosf(__builtin_amdgcn_fractf(r)); }
__device__ __forceinline__ float wave_sum(float v) {
#pragma unroll
    for (int o = 1; o < 64; o <<= 1) v += __shfl_xor(v, o);
    return v;
}
__device__ __forceinline__ float wave_max(float v) {
#pragma unroll
    for (int o = 1; o < 64; o <<= 1) v = fmaxf(v, __shfl_xor(v, o));
    return v;
}
__device__ __forceinline__ f32x2 cmul(f32x2 a, f32x2 b) { return (f32x2){a.x * b.x - a.y * b.y, a.x * b.y + a.y * b.x}; }
#define LDS_WAIT() asm volatile("s_waitcnt lgkmcnt(0)" ::: "memory")
#define VM_WAIT() asm volatile("s_waitcnt vmcnt(0)" ::: "memory")

namespace pg8 {
constexpr int BM = 256, BK = 64, HALF = 128, HTB = HALF * BK * 2, STAGE_BYTES = 8 * HTB;
__host__ __device__ __forceinline__ int lds_byte(int r, int c) { const int st = (r >> 4) * 2 + (c >> 5), rr = r & 15, cc = c & 31, ob = rr * 64 + cc * 2; return st * 1024 + (ob ^ (((ob >> 9) & 1) << 5)); }
__host__ __device__ __forceinline__ void stage_rc(int b, int& R, int& C) { const int st = b / 1024, sb = b % 1024, swz = sb ^ (((sb >> 9) & 1) << 5); R = (st >> 1) * 16 + swz / 64; C = (st & 1) * 32 + (swz % 64) / 2; }
__host__ __device__ __forceinline__ int perm32(int rho) { const int n = rho >> 4, i = rho & 15; return 8 * (i >> 2) + 4 * n + (i & 3); }

struct Unit { int pm, pn, e, valid; };

template <class Epi, class Sched>
__device__ __forceinline__ void gemm_phase(LAS unsigned char* lds, const int Kel, const Sched& S, const Epi& E) {
    const int tid = threadIdx.x, wid = __builtin_amdgcn_readfirstlane(tid >> 6), lane = tid & 63, wr = wid >> 2, wc = wid & 3, fr = lane & 15, fq = lane >> 4;
    const int K = Epi::FP8 ? (Kel >> 1) : Kel;
    const int nt = K / BK;
    int Rs[2], Cs[2]; unsigned voffB[2];
#pragma unroll
    for (int i = 0; i < 2; ++i) { int R, C; stage_rc(tid * 16 + i * 8192, R, C); Rs[i] = R; Cs[i] = C; const int Rb = Epi::PERM ? ((R & ~31) + perm32(R & 31)) : R; voffB[i] = (unsigned)(Rb * K + C) * 2u; }
    const size_t kstep = (size_t)(BK * 2);
    const size_t hstep = (size_t)HALF * K * 2;
    const unsigned ldsw = (unsigned)wid * 1024u;
    const int aoff = lds_byte(wr * 64 + fr, fq * 8), boff = lds_byte(wc * 32 + fr, fq * 8);
    const int aoff8 = lds_byte(wr * 64 + fr, fq * 16), boff8 = lds_byte(wc * 32 + fr, fq * 16);
#define PG8_SA(b, h) (((b) * 2 + (h)) * HTB)
#define PG8_SB(b, h) ((4 + (b) * 2 + (h)) * HTB)
#define PG8_STAGE(bufoff, gbase, voff) do { _Pragma("unroll") for (int _i = 0; _i < 2; ++_i) \
        __builtin_amdgcn_global_load_lds((const unsigned*)((const char*)(gbase) + (voff)[_i]), (LAS unsigned*)(lds + (bufoff) + ldsw + _i * 8192), 16, 0, 0); } while (0)
#define PG8_LDA(dst, b, h) do { if constexpr (Epi::FP8) { _Pragma("unroll") for (int m = 0; m < 4; ++m) { const i32x4 lo_ = *(const LAS i32x4*)(lds + PG8_SA(b, h) + aoff8 + m * 2048), hi_ = *(const LAS i32x4*)(lds + PG8_SA(b, h) + aoff8 + m * 2048 + 16); dst##8[m] = __builtin_shufflevector(lo_, hi_, 0, 1, 2, 3, 4, 5, 6, 7); } } \
        else { _Pragma("unroll") for (int m = 0; m < 4; ++m) _Pragma("unroll") for (int k = 0; k < 2; ++k) dst[m][k] = *(const LAS bf16x8*)(lds + PG8_SA(b, h) + aoff + m * 2048 + k * 1024); } } while (0)
#define PG8_LDB(dst, b, h) do { if constexpr (Epi::FP8) { _Pragma("unroll") for (int n = 0; n < 2; ++n) { const i32x4 lo_ = *(const LAS i32x4*)(lds + PG8_SB(b, h) + boff8 + n * 2048), hi_ = *(const LAS i32x4*)(lds + PG8_SB(b, h) + boff8 + n * 2048 + 16); dst##8[n] = __builtin_shufflevector(lo_, hi_, 0, 1, 2, 3, 4, 5, 6, 7); } } \
        else { _Pragma("unroll") for (int n = 0; n < 2; ++n) _Pragma("unroll") for (int k = 0; k < 2; ++k) dst[n][k] = *(const LAS bf16x8*)(lds + PG8_SB(b, h) + boff + n * 2048 + k * 1024); } } while (0)
#define PG8_MMA(ai, bj, At, Bt) do { __builtin_amdgcn_s_setprio(1); \
        if constexpr (Epi::FP8) { _Pragma("unroll") for (int m = 0; m < 4; ++m) _Pragma("unroll") for (int n = 0; n < 2; ++n) \
            asm volatile("v_mfma_scale_f32_16x16x128_f8f6f4 %0, %1, %2, %0, %3, %3 op_sel_hi:[0,0,0]" : "+v"(acc[ai][bj][m][n]) : "v"(Bt##8[n]), "v"(At##8[m]), "v"(scl1)); } \
        else { _Pragma("unroll") for (int m = 0; m < 4; ++m) _Pragma("unroll") for (int n = 0; n < 2; ++n) _Pragma("unroll") for (int k = 0; k < 2; ++k) \
        acc[ai][bj][m][n] = Epi::TRANS ? __builtin_amdgcn_mfma_f32_16x16x32_bf16(Bt[n][k], At[m][k], acc[ai][bj][m][n], 0, 0, 0) \
                                       : __builtin_amdgcn_mfma_f32_16x16x32_bf16(At[m][k], Bt[n][k], acc[ai][bj][m][n], 0, 0, 0); } __builtin_amdgcn_s_setprio(0); } while (0)
#define PG8_WAIT_V(n) asm volatile("s_waitcnt vmcnt(" #n ")" ::: "memory")
#define PG8_WAIT_L(n) asm volatile("s_waitcnt lgkmcnt(" #n ")" ::: "memory")
#define PG8_BAR __builtin_amdgcn_s_barrier()
#define PG8_SCHED __builtin_amdgcn_sched_barrier(0)
    Unit cur, nxt; int ui = 0;
    if (!S.next(0, cur)) return;
    f32x4 acc[2][2][4][2];
#pragma unroll
    for (int a = 0; a < 2; ++a)
#pragma unroll
        for (int b = 0; b < 2; ++b)
#pragma unroll
            for (int m = 0; m < 4; ++m)
#pragma unroll
                for (int n = 0; n < 2; ++n) acc[a][b][m][n] = (f32x4){0.f, 0.f, 0.f, 0.f};
    bf16x8 At[4][2], B0[2][2], B1[2][2]; i32x8 At8[4], B08[2], B18[2]; const int scl1 = 0x7F7F7F7F;
    const char* const Ab = S.a_base();
    const char* cB = S.b_base(cur);
    unsigned vC0[2], vC1[2];
#pragma unroll
    for (int i = 0; i < 2; ++i) { vC0[i] = (S.a_row(cur, Rs[i]) * (unsigned)K + (unsigned)Cs[i]) * 2u; vC1[i] = (S.a_row(cur, HALF + Rs[i]) * (unsigned)K + (unsigned)Cs[i]) * 2u; }
    PG8_STAGE(PG8_SB(0, 0), cB, voffB); PG8_STAGE(PG8_SB(0, 1), cB + hstep, voffB); PG8_STAGE(PG8_SA(0, 0), Ab, vC0); PG8_STAGE(PG8_SA(0, 1), Ab, vC1);
    if (wr == 1) PG8_BAR;
    PG8_WAIT_V(2); PG8_BAR;
    PG8_STAGE(PG8_SB(1, 0), cB + kstep, voffB); PG8_STAGE(PG8_SA(1, 0), Ab + kstep, vC0); PG8_STAGE(PG8_SB(1, 1), cB + hstep + kstep, voffB);
    PG8_WAIT_V(6); PG8_BAR;
    for (;;) {
        const bool has_next = S.next(ui + 1, nxt);
        const char* nB = has_next ? S.b_base(nxt) : cB;
        for (int t = 0; t < nt; t += 2) {
            const bool last = (t == nt - 2);
            const char* a1 = Ab + (size_t)(t + 1) * kstep;
            const char* a2 = last ? Ab : Ab + (size_t)(t + 2) * kstep; const char* b2 = last ? nB : cB + (size_t)(t + 2) * kstep;
            const char* a3 = a2 + kstep; const char* b3 = b2 + kstep;
            unsigned vX0[2], vX1[2];
            if (last && has_next) {
#pragma unroll
                for (int i = 0; i < 2; ++i) { vX0[i] = (S.a_row(nxt, Rs[i]) * (unsigned)K + (unsigned)Cs[i]) * 2u; vX1[i] = (S.a_row(nxt, HALF + Rs[i]) * (unsigned)K + (unsigned)Cs[i]) * 2u; }
            } else {
#pragma unroll
                for (int i = 0; i < 2; ++i) { vX0[i] = vC0[i]; vX1[i] = vC1[i]; }
            }
            PG8_LDB(B0, 0, 0); PG8_LDB(B1, 0, 1); PG8_SCHED; PG8_LDA(At, 0, 0); PG8_STAGE(PG8_SA(1, 1), a1, vC1);
            PG8_WAIT_V(8); PG8_WAIT_L(0); PG8_BAR; PG8_MMA(0, 0, At, B0); PG8_MMA(0, 1, At, B1); PG8_BAR; PG8_SCHED;
            PG8_LDA(At, 0, 1); PG8_STAGE(PG8_SB(0, 0), b2, voffB); PG8_STAGE(PG8_SB(0, 1), b2 + hstep, voffB); PG8_STAGE(PG8_SA(0, 0), a2, vX0);
            PG8_WAIT_V(8); PG8_WAIT_L(0); PG8_BAR; PG8_MMA(1, 0, At, B0); PG8_MMA(1, 1, At, B1); PG8_BAR; PG8_SCHED;
            PG8_LDB(B0, 1, 0); PG8_LDB(B1, 1, 1); PG8_SCHED; PG8_LDA(At, 1, 0); PG8_STAGE(PG8_SA(0, 1), a2, vX1);
            PG8_WAIT_V(8); PG8_WAIT_L(0); PG8_BAR; PG8_MMA(0, 0, At, B0); PG8_MMA(0, 1, At, B1); PG8_BAR; PG8_SCHED;
            PG8_LDA(At, 1, 1); PG8_STAGE(PG8_SB(1, 0), b3, voffB); PG8_STAGE(PG8_SB(1, 1), b3 + hstep, voffB); PG8_STAGE(PG8_SA(1, 0), a3, vX0);
            PG8_WAIT_V(8); PG8_WAIT_L(0); PG8_BAR; PG8_MMA(1, 0, At, B0); PG8_MMA(1, 1, At, B1); PG8_BAR; PG8_SCHED;
            if (last) {
#pragma unroll
                for (int i = 0; i < 2; ++i) { vC0[i] = vX0[i]; vC1[i] = vX1[i]; }
            }
        }
        if (wr == 0) PG8_BAR;
        if constexpr (Epi::FP8) asm volatile("s_nop 15\n\ts_nop 15" ::: "memory");
        E(acc, cur, wr, wc, fr, fq);
        if (!has_next) break;
#pragma unroll
        for (int a = 0; a < 2; ++a)
#pragma unroll
            for (int b = 0; b < 2; ++b)
#pragma unroll
                for (int m = 0; m < 4; ++m)
#pragma unroll
                    for (int n = 0; n < 2; ++n) acc[a][b][m][n] = (f32x4){0.f, 0.f, 0.f, 0.f};
        cur = nxt; cB = nB; ++ui;
        if (wr == 1) PG8_BAR;
    }
    PG8_WAIT_V(0);
    PG8_BAR;
#undef PG8_SA
#undef PG8_SB
#undef PG8_STAGE
#undef PG8_LDA
#undef PG8_LDB
#undef PG8_MMA
#undef PG8_WAIT_V
#undef PG8_WAIT_L
#undef PG8_BAR
#undef PG8_SCHED
}
}

#define XB_TMO      128
#define XB_XCNT(j)  (256  + 64 * (j))
#define XB_XSUB(j)  (1280 + 64 * (j))
#define XB_XGEN(j)  (2304 + 64 * (j))
#define XB_TOP      3328
#define XB_TOPGEN   3392
#define XCD_BAR_WORDS 3456
#define XB_SPIN_CAP (1u << 22)
__device__ __forceinline__ unsigned xb_ld(unsigned* p)              { return __hip_atomic_load(p, __ATOMIC_RELAXED, __HIP_MEMORY_SCOPE_AGENT); }
__device__ __forceinline__ unsigned xb_add(unsigned* p, unsigned v) { return __hip_atomic_fetch_add(p, v, __ATOMIC_RELAXED, __HIP_MEMORY_SCOPE_AGENT); }
__device__ __forceinline__ unsigned xb_xcc_id() { return (unsigned)__builtin_amdgcn_s_getreg((3 << 11) | 20) & 0xFu; }
#define XB_SPIN(cond, bar) do { unsigned _sp = 0; while (cond) { __builtin_amdgcn_s_sleep(1); \
    if ((++_sp & 255u) == 0u) { if (xb_ld(&(bar)[XB_TMO])) break; if (_sp > XB_SPIN_CAP) { atomicAdd(&(bar)[XB_TMO], 1u); break; } } } } while (0)
struct XcdBarrier { unsigned* bar; unsigned x; volatile LAS unsigned* st; };
__device__ __forceinline__ XcdBarrier xcd_barrier_post(unsigned* bar, volatile LAS unsigned* st) {
    XcdBarrier b; b.bar = bar; b.x = xb_xcc_id(); b.st = st;
    if (threadIdx.x == 0) (void)xb_add(&bar[XB_XCNT(b.x)], 1u);
    return b;
}
__device__ __forceinline__ void xcd_barrier_complete(unsigned* bar, unsigned x, unsigned& nloc, unsigned& nx) {
    const unsigned G = gridDim.x * gridDim.y * gridDim.z;
    unsigned sum, cnt, mine, sp = 0u;
    for (;;) {
        sum = 0u; cnt = 0u; mine = 0u;
#pragma unroll
        for (unsigned j = 0; j < 16; ++j) { const unsigned c = xb_ld(&bar[XB_XCNT(j)]); sum += c; cnt += (c > 0u) ? 1u : 0u; mine = (j == x) ? c : mine; }
        if (sum == G) break;
        __builtin_amdgcn_s_sleep(1);
        if ((++sp & 255u) == 0u) { if (xb_ld(&bar[XB_TMO])) break; if (sp > XB_SPIN_CAP) { atomicAdd(&bar[XB_TMO], 1u); break; } }
    }
    nloc = mine > 0u ? mine : 1u; nx = cnt > 0u ? cnt : 1u;
}
__device__ __forceinline__ void xcd_barrier(const XcdBarrier& b) {
    asm volatile("s_waitcnt vmcnt(0)" ::: "memory");
    __syncthreads();
    if (threadIdx.x == 0) {
        unsigned* bar = b.bar;
        __builtin_amdgcn_s_waitcnt(0);
        unsigned nloc = b.st[0], nx = b.st[1];
        if (nloc == 0u) { xcd_barrier_complete(bar, b.x, nloc, nx); b.st[0] = nloc; b.st[1] = nx; }
        const unsigned old = xb_add(&bar[XB_XSUB(b.x)], 1u);
        const unsigned gen = old / nloc;
        if (old + 1u == (gen + 1u) * nloc) {
            __builtin_amdgcn_fence(__ATOMIC_RELEASE, "agent");
            asm volatile("s_waitcnt vmcnt(0)" ::: "memory");
            const unsigned og = xb_add(&bar[XB_TOP], 1u);
            const unsigned tg = og / nx;
            if (og + 1u == (tg + 1u) * nx) xb_add(&bar[XB_TOPGEN], 1u);
            else XB_SPIN(xb_ld(&bar[XB_TOPGEN]) == tg, bar);
            __builtin_amdgcn_fence(__ATOMIC_ACQUIRE, "agent");
            xb_add(&bar[XB_XGEN(b.x)], 1u);
            asm volatile("s_waitcnt vmcnt(0)" ::: "memory");
        } else {
            XB_SPIN(xb_ld(&bar[XB_XGEN(b.x)]) == gen, bar);
            __builtin_amdgcn_fence(__ATOMIC_ACQUIRE, "agent");
            asm volatile("s_waitcnt vmcnt(0)" ::: "memory");
        }
    }
    __syncthreads();
}

struct Args { const float* in[39]; float* out; unsigned char* ws; int ph_lo, ph_hi; };
struct Frame {
    LAS unsigned char* lds;
    int tid, lane, wave, G, bx;
    const float* const* in; float* out; unsigned char* ws;
    GAS unsigned* ctl;
};
#define IN_X 0
#define IN_C 1
#define IN_CTX 2
#define IN_CCTX 3
#define IN_WADA 4
#define IN_BADA 5
#define IN_N1G 6
#define IN_N2G 7
#define IN_WIN 8
#define IN_LRE 9
#define IN_LIM 10
#define IN_LDT 11
#define IN_BRE 12
#define IN_BIM 13
#define IN_CRE 14
#define IN_CIM 15
#define IN_S5D 16
#define IN_WGLU 17
#define IN_HSW 18
#define IN_HW1 19
#define IN_HB1 20
#define IN_HF1 21
#define IN_HW2 22
#define IN_HB2 23
#define IN_HF2 24
#define IN_HW3 25
#define IN_HB3 26
#define IN_HDEC 27
#define IN_HBIAS 28
#define IN_WBS5 29
#define IN_WBHY 30
#define IN_WO 31
#define IN_RW 32
#define IN_RB 33
#define IN_WGU 34
#define IN_BGU 35
#define IN_WDN 36
#define IN_BDN 37
#define IN_FG 38

__device__ __forceinline__ void p0_adaln_item(Frame& F, int cb) {
    LAS float* sl = (LAS float*)F.lds;
    const float* c = F.in[IN_C]; const float* cc = F.in[IN_CCTX]; const float* W = F.in[IN_WADA];
    for (int i = F.tid; i < 3 * 2048; i += NTHR) { const int v = i >> 11, k = i & 2047; const float cv = (v < 2) ? c[v * 2048 + k] : cc[k]; sl[i] = cv * sigmoidf_(cv); }
    __syncthreads();
    const int col = F.tid % 48, ks = F.tid / 48;
    float a0 = 0.f, a1 = 0.f, a2 = 0.f;
    if (ks < 10) { const float* wp = W + 48 * cb + col;
#pragma unroll 16
        for (int j = 0; j < 205; ++j) { const int k = ks + 10 * j; if (k < 2048) { const float w = wp[(size_t)k * 12288]; a0 += sl[k] * w; a1 += sl[2048 + k] * w; a2 += sl[4096 + k] * w; } } }
    LAS float* red = sl + 6144;
    if (ks < 10) { red[(ks * 48 + col) * 3 + 0] = a0; red[(ks * 48 + col) * 3 + 1] = a1; red[(ks * 48 + col) * 3 + 2] = a2; }
    __syncthreads();
    if (F.tid < 144) { const int v = F.tid / 48, cl = F.tid % 48; float sacc = 0.f;
#pragma unroll
        for (int q = 0; q < 10; ++q) sacc += red[(q * 48 + cl) * 3 + v];
        ((float*)(F.ws + WS_MOD))[v * 12288 + 48 * cb + cl] = sacc + F.in[IN_BADA][48 * cb + cl]; }
    __syncthreads();
}
__device__ __forceinline__ void p0_filt_item(Frame& F, int tb) {
    LAS float* ft = (LAS float*)F.lds;
    LAS float* h1 = ft + 64 * 36;
    LAS float* h2 = h1 + 64 * 65;
    const int t0 = tb * 64, tl = F.tid >> 3, q = F.tid & 7; const float tf = (float)(t0 + tl);
    for (int f = q; f < 33; f += 8) {
        float v;
        if (f == 0) v = tf * (1.0f / 16383.0f);
        else { const int bi = (f - 1) & 15; const float band = 1e-4f + (float)bi * ((15.0f - 1e-4f) / 15.0f); const float rev = tf * band * (1.0f / 16384.0f);
               v = (f <= 16) ? cos_rev(rev) : -sin_rev(rev); }
        ft[tl * 36 + f] = v;
    }
    __syncthreads();
    { const float* w1 = F.in[IN_HW1]; const float* b1 = F.in[IN_HB1]; const float* f1 = F.in[IN_HF1];
      _Pragma("unroll 1") for (int j = q * 8; j < q * 8 + 8; ++j) { float a = b1[j]; _Pragma("unroll 3") for (int f = 0; f < 33; ++f) a += ft[tl * 36 + f] * w1[f * 64 + j]; h1[tl * 65 + j] = sin_rev(f1[j] * a * 0.15915494309189535f); } }
    __syncthreads();
    { const float* w2 = F.in[IN_HW2]; const float* b2 = F.in[IN_HB2]; const float* f2 = F.in[IN_HF2];
      _Pragma("unroll 1") for (int j = q * 8; j < q * 8 + 8; ++j) { float a = b2[j]; _Pragma("unroll 4") for (int i = 0; i < 64; ++i) a += h1[tl * 65 + i] * w2[i * 64 + j]; h2[tl * 64 + j] = sin_rev(f2[j] * a * 0.15915494309189535f); } }
    __syncthreads();
    LAS unsigned short* hb = (LAS unsigned short*)(h2 + 64 * 64);
    for (int i = F.tid; i < 64 * 64; i += NTHR) hb[(i >> 6) * 72 + (i & 63)] = (unsigned short)f2bf(h2[i]);
    __syncthreads();
    const float* w3 = F.in[IN_HW3]; const float* b3 = F.in[IN_HB3]; const float* dec = F.in[IN_HDEC]; bf16* FILT = (bf16*)(F.ws + WS_FILT);
    const int fr = F.lane & 15, fq = F.lane >> 4;
    bf16x8 af[4][2];
#pragma unroll
    for (int m = 0; m < 4; ++m)
#pragma unroll
        for (int ks = 0; ks < 2; ++ks) af[m][ks] = *(const LAS bf16x8*)(hb + (16 * m + fr) * 72 + 32 * ks + 8 * fq);
#pragma unroll 4
    for (int jt = F.wave; jt < 256; jt += NWAVES) {
        const int j = 16 * jt + fr;
        bf16x8 bfr[2];
#pragma unroll
        for (int ks = 0; ks < 2; ++ks) { float w[8];
#pragma unroll
            for (int e = 0; e < 8; ++e) w[e] = w3[(size_t)(32 * ks + 8 * fq + e) * 4096 + j];
            u32x4 pk; pk.x = pk2(w[0], w[1]); pk.y = pk2(w[2], w[3]); pk.z = pk2(w[4], w[5]); pk.w = pk2(w[6], w[7]); bfr[ks] = __builtin_bit_cast(bf16x8, pk); }
        const float bb = b3[j], dd = fabsf(dec[j]) * (1.0f / 16383.0f);
#pragma unroll
        for (int m = 0; m < 4; ++m) { f32x4 acc = (f32x4){0.f, 0.f, 0.f, 0.f};
#pragma unroll
            for (int ks = 0; ks < 2; ++ks) acc = __builtin_amdgcn_mfma_f32_16x16x32_bf16(af[m][ks], bfr[ks], acc, 0, 0, 0);
            const int tb0 = t0 + 16 * m + 4 * fq; f32x4 o;
#pragma unroll
            for (int e = 0; e < 4; ++e) o[e] = (acc[e] + bb) * __expf(-(float)(tb0 + e) * dd);
            *(u32x2*)(FILT + (size_t)j * SEQ + tb0) = (u32x2){cvt_pk_bf16(o[0], o[1]), cvt_pk_bf16(o[2], o[3])}; }
    }
    __syncthreads();
}
__device__ __forceinline__ void p0_s5tab_item(Frame& F, int item) {
    const int idx = item * NTHR + F.tid; const int d = idx >> 12, g = (idx >> 6) & 63, p = idx & 63, dg = d * 64 + g;
    const float lr = F.in[IN_LRE][dg * 64 + p], li = F.in[IN_LIM][dg * 64 + p], dt = expf(F.in[IN_LDT][dg]);
    const float mag = expf(lr * dt), ang = li * dt; const float lbr = mag * cosf(ang), lbi = mag * sinf(ang);
    const float den = lr * lr + li * li, cr = ((lbr - 1.f) * lr + lbi * li) / den, ci = (lbi * lr - (lbr - 1.f) * li) / den;
    bf16* BBT = (bf16*)(F.ws + WS_BBT); bf16* BB2 = (bf16*)(F.ws + WS_BB2); bf16* CTT = (bf16*)(F.ws + WS_CTT); f32x2* LAM = (f32x2*)(F.ws + WS_LAM);
    const float* bre = F.in[IN_BRE] + (size_t)(dg * 64 + p) * 16; const float* bim = F.in[IN_BIM] + (size_t)(dg * 64 + p) * 16;
    for (int c = 0; c < 16; ++c) { const float br = bre[c], bi = bim[c];
        BBT[(size_t)(dg * 128 + p) * 16 + c] = (bf16)f2bf(cr * br - ci * bi); BBT[(size_t)(dg * 128 + 64 + p) * 16 + c] = (bf16)f2bf(cr * bi + ci * br);
        BB2[(size_t)(dg * 128 + 2 * p) * 16 + c] = (bf16)f2bf(cr * br - ci * bi); BB2[(size_t)(dg * 128 + 2 * p + 1) * 16 + c] = (bf16)f2bf(cr * bi + ci * br); }
    const int k = 2 * p;
    for (int c = 0; c < 16; ++c) { const float cre = F.in[IN_CRE][(size_t)(dg * 16 + c) * 64 + p], cim = F.in[IN_CIM][(size_t)(dg * 16 + c) * 64 + p];
        CTT[(size_t)(dg * 16 + c) * 128 + k] = (bf16)f2bf(cre); CTT[(size_t)(dg * 16 + c) * 128 + k + 1] = (bf16)f2bf(-cim); }
    LAM[dg * 64 + p] = (f32x2){lbr, lbi};
}
__device__ __forceinline__ void p0_transpose_item(const float* W, int K, int N, bf16* WT, LAS unsigned short* scr, int kb, int nb, int lane) {
    const int k0 = 64 * kb, n0 = 128 * nb;
    const float* wp = W + (size_t)(k0 + (lane >> 5)) * N + n0 + 4 * (lane & 31);
#pragma unroll
    for (int half = 0; half < 2; ++half) { f32x4 v[16];
#pragma unroll
        for (int i = 0; i < 16; ++i) v[i] = *(const GAS f32x4*)(wp + (size_t)(32 * half + 2 * i) * N);
#pragma unroll
        for (int i = 0; i < 16; ++i) { const int kk = 32 * half + 2 * i + (lane >> 5); LAS unsigned* d = (LAS unsigned*)(scr + kk * 130 + 4 * (lane & 31)); d[0] = pk2(v[i].x, v[i].y); d[1] = pk2(v[i].z, v[i].w); } }
    LDS_WAIT(); asm volatile("" ::: "memory");
    const int c = lane & 7;
#pragma unroll
    for (int j = 0; j < 16; ++j) { const int r = (lane >> 3) + 8 * j; const LAS unsigned short* sp = scr + (8 * c) * 130 + r;
        u32x4 o; o.x = (unsigned)sp[0] | ((unsigned)sp[130] << 16); o.y = (unsigned)sp[2 * 130] | ((unsigned)sp[3 * 130] << 16); o.z = (unsigned)sp[4 * 130] | ((unsigned)sp[5 * 130] << 16); o.w = (unsigned)sp[6 * 130] | ((unsigned)sp[7 * 130] << 16);
        *(GAS u32x4*)(WT + (size_t)(n0 + r) * K + k0 + 8 * c) = o; }
    LDS_WAIT(); asm volatile("" ::: "memory");
}
__device__ __forceinline__ void p0_transpose_item8(const float* W, int K, int N, unsigned char* WT, LAS unsigned short* scr, int kb, int nb, int lane) {
    const int k0 = 64 * kb, n0 = 128 * nb;
    const float* wp = W + (size_t)(k0 + (lane >> 5)) * N + n0 + 4 * (lane & 31);
#pragma unroll
    for (int half = 0; half < 2; ++half) { f32x4 v[16];
#pragma unroll
        for (int i = 0; i < 16; ++i) v[i] = *(const GAS f32x4*)(wp + (size_t)(32 * half + 2 * i) * N);
#pragma unroll
        for (int i = 0; i < 16; ++i) { const int kk = 32 * half + 2 * i + (lane >> 5); LAS unsigned* d = (LAS unsigned*)(scr + kk * 130 + 4 * (lane & 31)); d[0] = pk2(v[i].x, v[i].y); d[1] = pk2(v[i].z, v[i].w); } }
    LDS_WAIT(); asm volatile("" ::: "memory");
    const int c = lane & 7;
#pragma unroll
    for (int j = 0; j < 16; ++j) { const int r = (lane >> 3) + 8 * j; const LAS unsigned short* sp = scr + (8 * c) * 130 + r;
        u32x2 o; o.x = pk4_fp8(bf2f(sp[0]) * W8SCALE, bf2f(sp[130]) * W8SCALE, bf2f(sp[2 * 130]) * W8SCALE, bf2f(sp[3 * 130]) * W8SCALE);
        o.y = pk4_fp8(bf2f(sp[4 * 130]) * W8SCALE, bf2f(sp[5 * 130]) * W8SCALE, bf2f(sp[6 * 130]) * W8SCALE, bf2f(sp[7 * 130]) * W8SCALE);
        *(GAS u32x2*)(WT + (size_t)(n0 + r) * K + k0 + 8 * c) = o; }
    LDS_WAIT(); asm volatile("" ::: "memory");
}
__device__ __forceinline__ void p0_transpose_item8d(const float* W, int K, int N, unsigned char* WT, LAS unsigned short* scr, int kb, int nb, int lane) {
    const int k0 = 64 * kb, n0 = 128 * nb;
    const float* wp = W + (size_t)(k0 + (lane >> 5)) * N + n0 + 4 * (lane & 31);
    f32x4 v[32];
#pragma unroll
    for (int i = 0; i < 32; ++i) v[i] = *(const GAS f32x4*)(wp + (size_t)(2 * i) * N);
#pragma unroll
    for (int i = 0; i < 32; ++i) { const int kk = 2 * i + (lane >> 5); LAS unsigned* d = (LAS unsigned*)(scr + kk * 130 + 4 * (lane & 31)); d[0] = pk2(v[i].x, v[i].y); d[1] = pk2(v[i].z, v[i].w); }
    LDS_WAIT(); asm volatile("" ::: "memory");
    const int c = lane & 7;
#pragma unroll
    for (int j = 0; j < 16; ++j) { const int r = (lane >> 3) + 8 * j; const LAS unsigned short* sp = scr + (8 * c) * 130 + r;
        u32x2 o; o.x = pk4_fp8(bf2f(sp[0]) * W8SCALE, bf2f(sp[130]) * W8SCALE, bf2f(sp[2 * 130]) * W8SCALE, bf2f(sp[3 * 130]) * W8SCALE);
        o.y = pk4_fp8(bf2f(sp[4 * 130]) * W8SCALE, bf2f(sp[5 * 130]) * W8SCALE, bf2f(sp[6 * 130]) * W8SCALE, bf2f(sp[7 * 130]) * W8SCALE);
        *(GAS u32x2*)(WT + (size_t)(n0 + r) * K + k0 + 8 * c) = o; }
    LDS_WAIT(); asm volatile("" ::: "memory");
}
__device__ __forceinline__ void moe_weight_queue(Frame& F) {
    constexpr int W_GU1 = 32 * 32, W_DN1 = 16 * 32, W_GU = 32 * W_GU1, W_DN = 32 * W_DN1;
    LAS unsigned short* scr = (LAS unsigned short*)(F.lds + F.wave * 16640);
    const int lane = F.lane;
    __syncthreads();
    for (;;) {
        int r0 = 0;
        if (lane == 0) r0 = (int)__hip_atomic_fetch_add((unsigned*)(F.ctl + CW_QT), 4u, __ATOMIC_RELAXED, __HIP_MEMORY_SCOPE_AGENT);
        r0 = __builtin_amdgcn_readfirstlane(r0);
        if (r0 >= W_GU + W_DN) break;
#pragma unroll 1
        for (int sub = 0; sub < 4; ++sub) { const int r = r0 + sub;
            const float* W; unsigned char* WT; int N, kb, nb;
            if (r < W_GU) { const int e = r / W_GU1, q = r % W_GU1; W = F.in[IN_WGU] + (size_t)e * 2048 * 4096; WT = (unsigned char*)(F.ws + WS_WGU) + (size_t)e * 4096 * 2048; N = 4096; kb = q & 31; nb = q >> 5; }
            else { const int rr = r - W_GU; const int e = rr / W_DN1, q = rr % W_DN1; W = F.in[IN_WDN] + (size_t)e * 2048 * 2048; WT = (unsigned char*)(F.ws + WS_WDN) + (size_t)e * 2048 * 2048; N = 2048; kb = q & 31; nb = q >> 5; }
            const int K = 2048, k0 = 64 * kb, n0 = 128 * nb;
            const float* wp = W + (size_t)(k0 + (lane >> 5)) * N + n0 + 4 * (lane & 31);
            f32x4 v[32];
#pragma unroll
            for (int i = 0; i < 32; ++i) v[i] = __builtin_nontemporal_load((const GAS f32x4*)(wp + (size_t)(2 * i) * N));
            LAS unsigned char* sb = (LAS unsigned char*)scr;
#pragma unroll
            for (int i = 0; i < 32; ++i) { const int kk = 2 * i + (lane >> 5); *(LAS unsigned*)(sb + kk * 132 + 4 * (lane & 31)) = pk4_fp8(v[i].x * W8SCALE, v[i].y * W8SCALE, v[i].z * W8SCALE, v[i].w * W8SCALE); }
            LDS_WAIT(); asm volatile("" ::: "memory");
            const int c = lane & 7;
#pragma unroll
            for (int j = 0; j < 16; ++j) { const int rw = (lane >> 3) + 8 * j; const LAS unsigned char* sp = sb + (8 * c) * 132 + rw;
                u32x2 o; o.x = (unsigned)sp[0] | ((unsigned)sp[132] << 8) | ((unsigned)sp[2 * 132] << 16) | ((unsigned)sp[3 * 132] << 24);
                o.y = (unsigned)sp[4 * 132] | ((unsigned)sp[5 * 132] << 8) | ((unsigned)sp[6 * 132] << 16) | ((unsigned)sp[7 * 132] << 24);
                __builtin_nontemporal_store(o, (GAS u32x2*)(WT + (size_t)(n0 + rw) * K + k0 + 8 * c)); }
            LDS_WAIT(); asm volatile("" ::: "memory");
        }
    }
    __syncthreads();
}
__device__ __forceinline__ void p0_prologue(Frame& F) {
    for (int it = F.bx; it < 256; it += F.G) p0_adaln_item(F, it);
    for (int it = F.bx; it < 256; it += F.G) p0_filt_item(F, it);
    for (int it = F.bx; it < 16; it += F.G) p0_s5tab_item(F, it);
    { const float* rw = F.in[IN_RW]; float* RWT = (float*)(F.ws + WS_RWT);
      for (int i = F.bx * NTHR + F.tid; i < 32 * 2048; i += F.G * NTHR) { const int e = i >> 11, k = i & 2047; RWT[i] = rw[k * 32 + e]; } }
    __syncthreads();
    LAS unsigned short* scr = (LAS unsigned short*)(F.lds + F.wave * 16640);
    constexpr int I_IN = 64 * 4, I_GLU = 8 * 2, I_BS5 = 16 * 2, I_BHY = 16 * 2, I_O = 16 * 4;
    constexpr int NITEMS = I_IN + I_GLU + I_BS5 + I_BHY + I_O;
    const int w = F.wave;
    for (int it = F.bx; it < NITEMS; it += F.G) {
        int r = it;
        if (r < I_IN) { if ((r >> 2) < 32) p0_transpose_item(F.in[IN_WIN], 2048, 8192, (bf16*)(F.ws + WS_WIN), scr, 8 * (r & 3) + w, r >> 2, F.lane);
                        else p0_transpose_item8(F.in[IN_WIN], 2048, 8192, (unsigned char*)(F.ws + WS_WIN8) - (size_t)4096 * 2048, scr, 8 * (r & 3) + w, r >> 2, F.lane); continue; } r -= I_IN;
        if (r < I_GLU) { p0_transpose_item(F.in[IN_WGLU], 1024, 1024, (bf16*)(F.ws + WS_WGLU), scr, 8 * (r & 1) + w, r >> 1, F.lane); continue; } r -= I_GLU;
        if (r < I_BS5) { p0_transpose_item(F.in[IN_WBS5], 1024, 2048, (bf16*)(F.ws + WS_WBS5), scr, 8 * (r & 1) + w, r >> 1, F.lane); continue; } r -= I_BS5;
        if (r < I_BHY) { p0_transpose_item(F.in[IN_WBHY], 1024, 2048, (bf16*)(F.ws + WS_WBHY), scr, 8 * (r & 1) + w, r >> 1, F.lane); continue; } r -= I_BHY;
        { p0_transpose_item8(F.in[IN_WO], 2048, 2048, (unsigned char*)(F.ws + WS_WO), scr, 8 * (r & 3) + w, r >> 2, F.lane); }
    }
}

__device__ __forceinline__ void p1_norm(Frame& F) {
    const int gw = F.bx * NWAVES + F.wave, NGW = F.G * NWAVES;
    const float* MOD = (const float*)(F.ws + WS_MOD); const float* g1n = F.in[IN_N1G];
    bf16* U = (bf16*)(F.ws + WS_U);
    int curv = -1; f32x4 ga[8], sh[8];
    for (int m = gw; m < NTOK + NCTX; m += NGW) {
        const int v = (m < NTOK) ? (m >> 14) : 2;
        if (v != curv) { curv = v;
#pragma unroll
            for (int j = 0; j < 8; ++j) { const int k = 4 * F.lane + 256 * j; const f32x4 g = *(const f32x4*)(g1n + k), sc = *(const f32x4*)(MOD + v * 12288 + 2048 + k); ga[j] = g * (sc + 1.0f); sh[j] = *(const f32x4*)(MOD + v * 12288 + k); } }
        const float* xr = (m < NTOK) ? (F.in[IN_X] + (size_t)m * D) : (F.in[IN_CTX] + (size_t)(m - NTOK) * D);
        f32x4 x[8]; float s = 0.f;
#pragma unroll
        for (int j = 0; j < 8; ++j) { x[j] = *(const GAS f32x4*)(xr + 4 * F.lane + 256 * j); s += (x[j].x * x[j].x + x[j].y * x[j].y) + (x[j].z * x[j].z + x[j].w * x[j].w); }
        const float rstd = 1.0f / sqrtf(wave_sum(s) * (1.0f / D) + 1e-6f);
        GAS u32x2* o = (GAS u32x2*)(U + (size_t)m * D) + F.lane; GAS unsigned* o8 = (GAS unsigned*)(F.ws + WS_U8 + (size_t)m * D) + F.lane;
#pragma unroll
        for (int j = 0; j < 8; ++j) { const f32x4 y = x[j] * rstd * ga[j] + sh[j]; o[64 * j] = (u32x2){pk2(y.x, y.y), pk2(y.z, y.w)}; if (m < NTOK) o8[64 * j] = pk4_fp8(y.x, y.y, y.z, y.w); }
    }
}

struct SchedIn {
    int G, c, nmain, npn, mode, nrep;
    const char* A; const char* Bt;
    __device__ __forceinline__ bool next(int i, pg8::Unit& u) const {
        int L = i * G + c; u.e = 0; u.valid = 256; { const int tot = nmain + (mode == 0 ? 8 : 0); if (nrep > 1 && L >= tot && L < 2 * tot) L -= tot; }
        if (L < nmain) {
            int wgid = L; { const int q = nmain / 8, xcd = wgid % 8, off = wgid / 8; wgid = xcd * q + off; }
            const int nig = 8 * npn, gid = wgid / nig; const int pm = gid * 8 + ((wgid % nig) % 8), pl = (wgid % nig) / 8;
            u.pm = pm; u.pn = (mode == 0) ? pl : (mode == 1 ? pl + 4 : pl + 16); return true;
        }
        if (mode == 0 && L < nmain + 8) { const int q = L - nmain; u.pm = 128 + (q >> 2); u.pn = q & 3; return true; }
        return false;
    }
    __device__ __forceinline__ unsigned a_row(const pg8::Unit& u, int r) const { return (u.pm < 128) ? (unsigned)((u.pm >> 6) * SEQ + r * 64 + (u.pm & 63)) : (unsigned)(NTOK + (u.pm - 128) * 256 + r); }
    __device__ __forceinline__ const char* a_base() const { return A; }
    __device__ __forceinline__ const char* b_base(const pg8::Unit& u) const { return (mode == 2) ? Bt + (size_t)(u.pn - 16) * 256 * D : Bt + (size_t)u.pn * 256 * D * 2; }
};
struct EpiInG8 {
    static constexpr bool PERM = true, TRANS = true, FP8 = true;
    bf16* UG;
    __device__ __forceinline__ void operator()(const f32x4 (&acc)[2][2][4][2], const pg8::Unit& u, int wr, int wc, int fr, int fq) const {
        const int col0 = (u.pn - 16) * 256 + wc * 32 + 8 * fq;
#pragma unroll
        for (int ai = 0; ai < 2; ++ai)
#pragma unroll
            for (int m = 0; m < 4; ++m) { const int r = ai * 128 + wr * 64 + m * 16 + fr; const size_t row = (size_t)((u.pm >> 6) * SEQ + r * 64 + (u.pm & 63));
                bf16* rowp = UG + row * 4096 + col0;
#pragma unroll
                for (int bj = 0; bj < 2; ++bj) { f32x4 v0 = acc[ai][bj][m][0] * (1.0f / W8SCALE), v1 = acc[ai][bj][m][1] * (1.0f / W8SCALE);
#pragma unroll
                    for (int j = 0; j < 4; ++j) { v0[j] = sigmoidf_(v0[j]); v1[j] = sigmoidf_(v1[j]); }
                    u32x4 w; w.x = cvt_pk_bf16(v0[0], v0[1]); w.y = cvt_pk_bf16(v0[2], v0[3]); w.z = cvt_pk_bf16(v1[0], v1[1]); w.w = cvt_pk_bf16(v1[2], v1[3]);
                    *(u32x4*)(rowp + bj * 128) = w; } }
    }
};
struct EpiInA {
    static constexpr bool PERM = true, TRANS = true, FP8 = false;
    unsigned char* ws;
    __device__ __forceinline__ void operator()(const f32x4 (&acc)[2][2][4][2], const pg8::Unit& u, int wr, int wc, int fr, int fq) const {
        const bool isctx = u.pm >= 128, isg = u.pn >= 16;
        const size_t boff = isctx ? WS_UCA : (isg ? WS_UG : WS_UA);
        bf16* base = (bf16*)(ws + boff); const size_t ld = isg ? 4096 : S5W; const int colt = isg ? (u.pn - 16) * 256 : u.pn * 256;
        const int col0 = colt + wc * 32 + 8 * fq;
#pragma unroll
        for (int ai = 0; ai < 2; ++ai)
#pragma unroll
            for (int m = 0; m < 4; ++m) { const int r = ai * 128 + wr * 64 + m * 16 + fr;
                const size_t row = isctx ? (size_t)((u.pm - 128) * 256 + r) : (size_t)((u.pm >> 6) * SEQ + r * 64 + (u.pm & 63));
                bf16* rowp = base + row * ld + col0;
#pragma unroll
                for (int bj = 0; bj < 2; ++bj) { f32x4 v0 = acc[ai][bj][m][0], v1 = acc[ai][bj][m][1];
                    if (isg) {
#pragma unroll
                        for (int j = 0; j < 4; ++j) { v0[j] = sigmoidf_(v0[j]); v1[j] = sigmoidf_(v1[j]); } }
                    u32x4 w; w.x = cvt_pk_bf16(v0[0], v0[1]); w.y = cvt_pk_bf16(v0[2], v0[3]); w.z = cvt_pk_bf16(v1[0], v1[1]); w.w = cvt_pk_bf16(v1[2], v1[3]);
                    *(u32x4*)(rowp + bj * 128) = w; } }
    }
};
struct EpiInH {
    static constexpr bool PERM = false, TRANS = false, FP8 = false;
    bf16* UH;
    __device__ __forceinline__ void operator()(const f32x4 (&acc)[2][2][4][2], const pg8::Unit& u, int wr, int wc, int fr, int fq) const {
        const int b = u.pm >> 6, w = u.pm & 63;
#pragma unroll
        for (int bj = 0; bj < 2; ++bj)
#pragma unroll
            for (int n = 0; n < 2; ++n) { const int ch = (u.pn - 4) * 256 + bj * 128 + wc * 32 + n * 16 + fr;
                bf16* cp = UH + ((size_t)(b * 3072 + ch) * SEQ + w * 256);
#pragma unroll
                for (int ai = 0; ai < 2; ++ai)
#pragma unroll
                    for (int m = 0; m < 4; ++m) { const int r0 = ai * 128 + wr * 64 + m * 16 + 4 * fq; const f32x4 v = acc[ai][bj][m][n];
                        *(u32x2*)(cp + r0) = (u32x2){cvt_pk_bf16(v[0], v[1]), cvt_pk_bf16(v[2], v[3])}; } }
    }
};

template <bool PASSB>
__device__ __forceinline__ void s5_pass(Frame& F) {
    constexpr int nk = PASSB ? 256 : 260;
    constexpr int nitems = 2 * nk * 8;
    LAS unsigned char* sl = F.lds + F.wave * 8704;
    const int lane = F.lane, pl = lane & 31, hi = lane >> 5, fr = lane & 15, fq = lane >> 4;
    const bf16* UA = (const bf16*)(F.ws + WS_UA); const bf16* UCA = (const bf16*)(F.ws + WS_UCA);
    const bf16* BBT = (const bf16*)(F.ws + WS_BBT); const bf16* CTT = (const bf16*)(F.ws + WS_CTT); const f32x2* LAM = (const f32x2*)(F.ws + WS_LAM);
    f32x2* EB = (f32x2*)(F.ws + WS_E); const f32x2* SINB = (const f32x2*)(F.ws + WS_SIN); bf16* Y = (bf16*)(F.ws + WS_Y);
    const int s_r = 16 * ((pl >> 2) & 1) + 4 * (pl >> 3) + (pl & 3);
    for (int it = F.bx; it < nitems; it += F.G) {
        const int gq = it & 7, rest = it >> 3; const int b = rest / nk, kk = rest % nk; const int kc = PASSB ? kk + 4 : kk;
        const int g = gq * 8 + F.wave;
        const bf16* urow = (kc < 4) ? (UCA + (size_t)(b * CTX + kc * 64) * S5W + 16 * g) : (UA + (size_t)(b * SEQ + (kc - 4) * 64) * S5W + 16 * g);
        f32x4 yacc[4];
#pragma unroll
        for (int q = 0; q < 4; ++q) yacc[q] = (f32x4){0.f, 0.f, 0.f, 0.f};
#pragma unroll
        for (int d = 0; d < 2; ++d) {
            const int dg = d * 64 + g;
            bf16x8 bb[4];
#pragma unroll
            for (int ni = 0; ni < 4; ++ni) bb[ni] = *(const bf16x8*)(BBT + (size_t)(dg * 128 + 32 * ni + pl) * 16 + 8 * hi);
            bf16x8 ct[4];
            if (PASSB) {
#pragma unroll
                for (int ks = 0; ks < 4; ++ks) ct[ks] = *(const bf16x8*)(CTT + (size_t)(dg * 16 + fr) * 128 + 32 * ks + 8 * fq);
            }
            const f32x2 lamA = LAM[dg * 64 + pl], lamB = LAM[dg * 64 + pl + 32];
            f32x2 l2 = cmul(lamA, lamA), l4 = cmul(l2, l2), l8 = cmul(l4, l4); const f32x2 lam16A = cmul(l8, l8);
            l2 = cmul(lamB, lamB); l4 = cmul(l2, l2); l8 = cmul(l4, l4); const f32x2 lam16B = cmul(l8, l8);
            f32x2 cA = (f32x2){0.f, 0.f}, cB = (f32x2){0.f, 0.f};
            const size_t sidx = ((size_t)((d * 2 + b) * NCH + kc)) * 4096 + g * 64 + pl;
            if (PASSB) { cA = SINB[sidx]; cB = SINB[sidx + 32]; }
#pragma unroll
            for (int sc = 0; sc < 2; ++sc) {
                const int iscan = 32 * sc + s_r; const int tok = (d == 0) ? iscan : 63 - iscan;
                const bf16x8 a = *(const bf16x8*)(urow + (size_t)tok * S5W + 8 * hi);
                f32x16 acc[4];
#pragma unroll
                for (int ni = 0; ni < 4; ++ni) { f32x16 z;
#pragma unroll
                    for (int i = 0; i < 16; ++i) z[i] = 0.f;
                    acc[ni] = __builtin_amdgcn_mfma_f32_32x32x16_bf16(a, bb[ni], z, 0, 0, 0); }
                asm volatile("s_nop 7\n\ts_nop 7" : "+v"(acc[0]), "+v"(acc[1]), "+v"(acc[2]), "+v"(acc[3]) : "v"(a), "v"(bb[0]), "v"(bb[1]), "v"(bb[2]), "v"(bb[3]));
                f32x2 sA = hi ? (f32x2){0.f, 0.f} : cA, sB = hi ? (f32x2){0.f, 0.f} : cB;
#pragma unroll
                for (int i = 0; i < 16; ++i) {
                    sA = (f32x2){lamA.x * sA.x - lamA.y * sA.y + acc[0][i], lamA.x * sA.y + lamA.y * sA.x + acc[2][i]}; acc[0][i] = sA.x; acc[2][i] = sA.y;
                    sB = (f32x2){lamB.x * sB.x - lamB.y * sB.y + acc[1][i], lamB.x * sB.y + lamB.y * sB.x + acc[3][i]}; acc[1][i] = sB.x; acc[3][i] = sB.y; }
                const f32x2 pA = (f32x2){__shfl_xor(sA.x, 32), __shfl_xor(sA.y, 32)}, pB = (f32x2){__shfl_xor(sB.x, 32), __shfl_xor(sB.y, 32)};
                const f32x2 tA = cmul(lam16A, hi ? pA : sA), tB = cmul(lam16B, hi ? pB : sB);
                const f32x2 e1A = (hi ? sA : pA) + tA, e1B = (hi ? sB : pB) + tB;
                const f32x2 ciA = hi ? pA : (f32x2){0.f, 0.f}, ciB = hi ? pB : (f32x2){0.f, 0.f};
                if (PASSB) {
                    f32x2 wA = cmul(lamA, ciA), wB = cmul(lamB, ciB);
#pragma unroll
                    for (int i = 0; i < 16; ++i) {
                        acc[0][i] += wA.x; acc[2][i] += wA.y; acc[1][i] += wB.x; acc[3][i] += wB.y;
                        *(LAS u32x2*)(sl + (16 * hi + i) * 272 + pl * 8) = (u32x2){cvt_pk_bf16(acc[0][i], acc[2][i]), cvt_pk_bf16(acc[1][i], acc[3][i])};
                        wA = cmul(wA, lamA); wB = cmul(wB, lamB); }
                    bf16x8 bsv[2][4];
#pragma unroll
                    for (int tt = 0; tt < 2; ++tt) {
                        const int rowi = (d == 0) ? (16 * tt + fr) : (16 * tt + 15 - fr);
#pragma unroll
                        for (int ks = 0; ks < 4; ++ks) bsv[tt][ks] = *(const LAS bf16x8*)(sl + rowi * 272 + (32 * ks + 8 * fq) * 2);
                    }
#pragma unroll
                    for (int tt = 0; tt < 2; ++tt) {
                        const int tq = (d == 0) ? (2 * sc + tt) : (3 - 2 * sc - tt);
#pragma unroll
                        for (int ks = 0; ks < 4; ++ks) yacc[tq] = __builtin_amdgcn_mfma_f32_16x16x32_bf16(ct[ks], bsv[tt][ks], yacc[tq], 0, 0, 0);
                    }
                    asm volatile("s_nop 7\n\ts_nop 7" : "+v"(yacc[0]), "+v"(yacc[1]), "+v"(yacc[2]), "+v"(yacc[3]) : "v"(bsv[0][0]), "v"(bsv[0][1]), "v"(bsv[0][2]), "v"(bsv[0][3]), "v"(bsv[1][0]), "v"(bsv[1][1]), "v"(bsv[1][2]), "v"(bsv[1][3]), "v"(ct[0]), "v"(ct[1]), "v"(ct[2]), "v"(ct[3]));
                    asm volatile("s_waitcnt lgkmcnt(0)" ::: "memory");
                }
                cA = e1A; cB = e1B;
            }
            if (!PASSB) { if (hi == 0) { EB[sidx] = cA; EB[sidx + 32] = cB; } }
        }
        if (PASSB) {
            const f32x4 dsk = *(const f32x4*)(F.in[IN_S5D] + 16 * g + 4 * fq);
#pragma unroll
            for (int tq = 0; tq < 4; ++tq) { const int tok = 16 * tq + fr;
                const u32x2 uu = *(const u32x2*)(urow + (size_t)tok * S5W + 4 * fq);
                f32x4 v; v[0] = yacc[tq][0] + bflo(uu.x) * dsk[0]; v[1] = yacc[tq][1] + bfhi(uu.x) * dsk[1]; v[2] = yacc[tq][2] + bflo(uu.y) * dsk[2]; v[3] = yacc[tq][3] + bfhi(uu.y) * dsk[3];
#pragma unroll
                for (int j = 0; j < 4; ++j) { const float x = v[j]; v[j] = x * sigmoidf_(1.5957691216f * (x + 0.044715f * x * x * x)); }
                *(u32x2*)(Y + (size_t)(b * SEQ + (kc - 4) * 64 + tok) * S5W + 16 * g + 4 * fq) = (u32x2){cvt_pk_bf16(v[0], v[1]), cvt_pk_bf16(v[2], v[3])}; }
        }
    }
}
__device__ __forceinline__ void s5_pass_a_simple(Frame& F) {
    constexpr int nitems = 2 * NCH * 8;
    const int lane = F.lane;
    const bf16* UA = (const bf16*)(F.ws + WS_UA); const bf16* UCA = (const bf16*)(F.ws + WS_UCA);
    const bf16* BBT = (const bf16*)(F.ws + WS_BBT); const f32x2* LAM = (const f32x2*)(F.ws + WS_LAM); f32x2* EB = (f32x2*)(F.ws + WS_E);
    for (int it = F.bx; it < nitems; it += F.G) {
        const int gq = it & 7, rest = it >> 3; const int b = rest / NCH, kc = rest % NCH; const int g = gq * 8 + F.wave;
        const bf16* urow = (kc < 4) ? (UCA + (size_t)(b * CTX + kc * 64) * S5W + 16 * g) : (UA + (size_t)(b * SEQ + (kc - 4) * 64) * S5W + 16 * g);
#pragma unroll 1
        for (int d = 0; d < 2; ++d) {
            const int dg = d * 64 + g; const f32x2 lam = LAM[dg * 64 + lane];
            float bre[16], bim[16];
            { const u32x4 r0 = *(const u32x4*)(BBT + (size_t)(dg * 128 + lane) * 16), r1 = *(const u32x4*)(BBT + (size_t)(dg * 128 + lane) * 16 + 8);
              const u32x4 i0 = *(const u32x4*)(BBT + (size_t)(dg * 128 + 64 + lane) * 16), i1 = *(const u32x4*)(BBT + (size_t)(dg * 128 + 64 + lane) * 16 + 8);
              bre[0] = bflo(r0.x); bre[1] = bfhi(r0.x); bre[2] = bflo(r0.y); bre[3] = bfhi(r0.y); bre[4] = bflo(r0.z); bre[5] = bfhi(r0.z); bre[6] = bflo(r0.w); bre[7] = bfhi(r0.w);
              bre[8] = bflo(r1.x); bre[9] = bfhi(r1.x); bre[10] = bflo(r1.y); bre[11] = bfhi(r1.y); bre[12] = bflo(r1.z); bre[13] = bfhi(r1.z); bre[14] = bflo(r1.w); bre[15] = bfhi(r1.w);
              bim[0] = bflo(i0.x); bim[1] = bfhi(i0.x); bim[2] = bflo(i0.y); bim[3] = bfhi(i0.y); bim[4] = bflo(i0.z); bim[5] = bfhi(i0.z); bim[6] = bflo(i0.w); bim[7] = bfhi(i0.w);
              bim[8] = bflo(i1.x); bim[9] = bfhi(i1.x); bim[10] = bflo(i1.y); bim[11] = bfhi(i1.y); bim[12] = bflo(i1.z); bim[13] = bfhi(i1.z); bim[14] = bflo(i1.w); bim[15] = bfhi(i1.w); }
            f32x2 st = (f32x2){0.f, 0.f};
#pragma unroll 4
            for (int i = 0; i < 64; ++i) { const int tok = (d == 0) ? i : 63 - i;
                const u32x4 u0 = *(const u32x4*)(urow + (size_t)tok * S5W), u1 = *(const u32x4*)(urow + (size_t)tok * S5W + 8);
                float u[16]; u[0] = bflo(u0.x); u[1] = bfhi(u0.x); u[2] = bflo(u0.y); u[3] = bfhi(u0.y); u[4] = bflo(u0.z); u[5] = bfhi(u0.z); u[6] = bflo(u0.w); u[7] = bfhi(u0.w);
                u[8] = bflo(u1.x); u[9] = bfhi(u1.x); u[10] = bflo(u1.y); u[11] = bfhi(u1.y); u[12] = bflo(u1.z); u[13] = bfhi(u1.z); u[14] = bflo(u1.w); u[15] = bfhi(u1.w);
                float br = 0.f, bi = 0.f;
#pragma unroll
                for (int c = 0; c < 16; ++c) { br += bre[c] * u[c]; bi += bim[c] * u[c]; }
                st = (f32x2){lam.x * st.x - lam.y * st.y + br, lam.x * st.y + lam.y * st.x + bi}; }
            EB[((size_t)((d * 2 + b) * NCH + kc)) * 4096 + g * 64 + lane] = st;
        }
    }
}
__device__ __forceinline__ void s5_pass_b2(Frame& F) {
    constexpr int nitems = 2 * 256 * 8;
    LAS unsigned char* sl = F.lds + F.wave * 8704;
    const int lane = F.lane, fr = lane & 15, fq = lane >> 4;
    const bf16* UA = (const bf16*)(F.ws + WS_UA); const bf16* BBT = (const bf16*)(F.ws + WS_BBT); const bf16* CTT = (const bf16*)(F.ws + WS_CTT);
    const f32x2* LAM = (const f32x2*)(F.ws + WS_LAM); const f32x2* SINB = (const f32x2*)(F.ws + WS_SIN); bf16* Y = (bf16*)(F.ws + WS_Y);
    for (int it = F.bx; it < nitems; it += F.G) {
        const int gq = it & 7, rest = it >> 3; const int b = rest >> 8, kc = (rest & 255) + 4; const int g = gq * 8 + F.wave;
        const bf16* urow = UA + (size_t)(b * SEQ + (kc - 4) * 64) * S5W + 16 * g;
        f32x4 yacc[4];
#pragma unroll
        for (int q = 0; q < 4; ++q) yacc[q] = (f32x4){0.f, 0.f, 0.f, 0.f};
#pragma unroll
        for (int d = 0; d < 2; ++d) {
            const int dg = d * 64 + g; const f32x2 lam = LAM[dg * 64 + lane];
            float bre[16], bim[16];
            { const u32x4 r0 = *(const u32x4*)(BBT + (size_t)(dg * 128 + lane) * 16), r1 = *(const u32x4*)(BBT + (size_t)(dg * 128 + lane) * 16 + 8);
              const u32x4 i0 = *(const u32x4*)(BBT + (size_t)(dg * 128 + 64 + lane) * 16), i1 = *(const u32x4*)(BBT + (size_t)(dg * 128 + 64 + lane) * 16 + 8);
              bre[0] = bflo(r0.x); bre[1] = bfhi(r0.x); bre[2] = bflo(r0.y); bre[3] = bfhi(r0.y); bre[4] = bflo(r0.z); bre[5] = bfhi(r0.z); bre[6] = bflo(r0.w); bre[7] = bfhi(r0.w);
              bre[8] = bflo(r1.x); bre[9] = bfhi(r1.x); bre[10] = bflo(r1.y); bre[11] = bfhi(r1.y); bre[12] = bflo(r1.z); bre[13] = bfhi(r1.z); bre[14] = bflo(r1.w); bre[15] = bfhi(r1.w);
              bim[0] = bflo(i0.x); bim[1] = bfhi(i0.x); bim[2] = bflo(i0.y); bim[3] = bfhi(i0.y); bim[4] = bflo(i0.z); bim[5] = bfhi(i0.z); bim[6] = bflo(i0.w); bim[7] = bfhi(i0.w);
              bim[8] = bflo(i1.x); bim[9] = bfhi(i1.x); bim[10] = bflo(i1.y); bim[11] = bfhi(i1.y); bim[12] = bflo(i1.z); bim[13] = bfhi(i1.z); bim[14] = bflo(i1.w); bim[15] = bfhi(i1.w); }
            bf16x8 ct[4];
#pragma unroll
            for (int ks = 0; ks < 4; ++ks) ct[ks] = *(const bf16x8*)(CTT + (size_t)(dg * 16 + fr) * 128 + 32 * ks + 8 * fq);
            f32x2 st = SINB[((size_t)((d * 2 + b) * NCH + kc)) * 4096 + g * 64 + lane];
#pragma unroll
            for (int h = 0; h < 2; ++h) {
#pragma unroll 4
                for (int i = 0; i < 32; ++i) { const int sc = 32 * h + i; const int tok = (d == 0) ? sc : 63 - sc;
                    const u32x4 u0 = *(const u32x4*)(urow + (size_t)tok * S5W), u1 = *(const u32x4*)(urow + (size_t)tok * S5W + 8);
                    float u[16]; u[0] = bflo(u0.x); u[1] = bfhi(u0.x); u[2] = bflo(u0.y); u[3] = bfhi(u0.y); u[4] = bflo(u0.z); u[5] = bfhi(u0.z); u[6] = bflo(u0.w); u[7] = bfhi(u0.w);
                    u[8] = bflo(u1.x); u[9] = bfhi(u1.x); u[10] = bflo(u1.y); u[11] = bfhi(u1.y); u[12] = bflo(u1.z); u[13] = bfhi(u1.z); u[14] = bflo(u1.w); u[15] = bfhi(u1.w);
                    float br = 0.f, bi = 0.f;
#pragma unroll
                    for (int c = 0; c < 16; ++c) { br += bre[c] * u[c]; bi += bim[c] * u[c]; }
                    st = (f32x2){lam.x * st.x - lam.y * st.y + br, lam.x * st.y + lam.y * st.x + bi};
                    *(LAS unsigned*)(sl + (tok & 31) * 272 + lane * 4) = cvt_pk_bf16(st.x, st.y); }
                const int t0q = (d == 0) ? 2 * h : 2 * (1 - h);
                bf16x8 bsv[2][4];
#pragma unroll
                for (int tt = 0; tt < 2; ++tt)
#pragma unroll
                    for (int ks = 0; ks < 4; ++ks) bsv[tt][ks] = *(const LAS bf16x8*)(sl + (16 * tt + fr) * 272 + (32 * ks + 8 * fq) * 2);
#pragma unroll
                for (int tt = 0; tt < 2; ++tt)
#pragma unroll
                    for (int ks = 0; ks < 4; ++ks) yacc[t0q + tt] = __builtin_amdgcn_mfma_f32_16x16x32_bf16(ct[ks], bsv[tt][ks], yacc[t0q + tt], 0, 0, 0);
                asm volatile("s_nop 7\n\ts_nop 7" : "+v"(yacc[0]), "+v"(yacc[1]), "+v"(yacc[2]), "+v"(yacc[3]) : "v"(bsv[0][0]), "v"(bsv[0][1]), "v"(bsv[0][2]), "v"(bsv[0][3]), "v"(bsv[1][0]), "v"(bsv[1][1]), "v"(bsv[1][2]), "v"(bsv[1][3]), "v"(ct[0]), "v"(ct[1]), "v"(ct[2]), "v"(ct[3]));
                asm volatile("s_waitcnt lgkmcnt(0)" ::: "memory");
            }
        }
        const f32x4 dsk = *(const f32x4*)(F.in[IN_S5D] + 16 * g + 4 * fq);
#pragma unroll
        for (int tq = 0; tq < 4; ++tq) { const int tok = 16 * tq + fr;
            const u32x2 uu = *(const u32x2*)(urow + (size_t)tok * S5W + 4 * fq);
            f32x4 v; v[0] = yacc[tq][0] + bflo(uu.x) * dsk[0]; v[1] = yacc[tq][1] + bfhi(uu.x) * dsk[1]; v[2] = yacc[tq][2] + bflo(uu.y) * dsk[2]; v[3] = yacc[tq][3] + bfhi(uu.y) * dsk[3];
#pragma unroll
            for (int j = 0; j < 4; ++j) { const float x = v[j]; v[j] = x * sigmoidf_(1.5957691216f * (x + 0.044715f * x * x * x)); }
            *(u32x2*)(Y + (size_t)(b * SEQ + (kc - 4) * 64 + tok) * S5W + 16 * g + 4 * fq) = (u32x2){cvt_pk_bf16(v[0], v[1]), cvt_pk_bf16(v[2], v[3])}; }
    }
}
template <bool PASSB>
__device__ __forceinline__ void s5_pass3(Frame& F) {
    constexpr int nk = PASSB ? 256 : NCH; constexpr int nitems = 2 * nk * 8;
    LAS unsigned char* sl = F.lds + F.wave * 8704;
    const int lane = F.lane, fr = lane & 15, fq = lane >> 4;
    const bf16* UA = (const bf16*)(F.ws + WS_UA); const bf16* UCA = (const bf16*)(F.ws + WS_UCA); const bf16* BB2 = (const bf16*)(F.ws + WS_BB2); const bf16* CTT = (const bf16*)(F.ws + WS_CTT);
    const f32x2* LAM = (const f32x2*)(F.ws + WS_LAM); const f32x2* SINB = (const f32x2*)(F.ws + WS_SIN); f32x2* EB = (f32x2*)(F.ws + WS_E); bf16* Y = (bf16*)(F.ws + WS_Y);
    const bf16x8 zf = (bf16x8){0, 0, 0, 0, 0, 0, 0, 0};
    int curg = -1; bf16x8 af[2][8], ct[2][4]; f32x2 lamv[2]; f32x4 dsk = (f32x4){0.f, 0.f, 0.f, 0.f};
    for (int it = F.bx; it < nitems; it += F.G) {
        const int gq = it & 7, rest = it >> 3; const int b = rest / nk, kk = rest % nk; const int kc = PASSB ? kk + 4 : kk; const int g = gq * 8 + F.wave;
        if (g != curg) { curg = g;
#pragma unroll
            for (int d = 0; d < 2; ++d) { const int dg = d * 64 + g; lamv[d] = LAM[dg * 64 + lane];
#pragma unroll
                for (int nt = 0; nt < 8; ++nt) af[d][nt] = (fq < 2) ? *(const bf16x8*)(BB2 + (size_t)(dg * 128 + 16 * nt + fr) * 16 + 8 * fq) : zf;
                if (PASSB) {
#pragma unroll
                    for (int ks = 0; ks < 4; ++ks) ct[d][ks] = *(const bf16x8*)(CTT + (size_t)(dg * 16 + fr) * 128 + 32 * ks + 8 * fq); } }
            if (PASSB) dsk = *(const f32x4*)(F.in[IN_S5D] + 16 * g + 4 * fq); }
        const bf16* urow = (kc < 4) ? (UCA + (size_t)(b * CTX + kc * 64) * S5W + 16 * g) : (UA + (size_t)(b * SEQ + (kc - 4) * 64) * S5W + 16 * g);
        bf16x8 uf[4];
#pragma unroll
        for (int q = 0; q < 4; ++q) uf[q] = (fq < 2) ? *(const bf16x8*)(urow + (size_t)(16 * q + fr) * S5W + 8 * fq) : zf;
        u32x2 uu[4];
        if (PASSB) {
#pragma unroll
            for (int tq = 0; tq < 4; ++tq) uu[tq] = *(const u32x2*)(urow + (size_t)(16 * tq + fr) * S5W + 4 * fq); }
        f32x2 st0[2];
#pragma unroll
        for (int d = 0; d < 2; ++d) st0[d] = PASSB ? SINB[((size_t)((d * 2 + b) * NCH + kc)) * 4096 + g * 64 + lane] : (f32x2){0.f, 0.f};
        f32x4 yacc[4];
#pragma unroll
        for (int q = 0; q < 4; ++q) yacc[q] = (f32x4){0.f, 0.f, 0.f, 0.f};
#pragma unroll
        for (int d = 0; d < 2; ++d) {
            const f32x2 lam = lamv[d]; f32x2 st = st0[d];
#pragma unroll
            for (int h = 0; h < 2; ++h) {
                const int T0 = (d == 0) ? 32 * h : 32 * (1 - h);
#pragma unroll
                for (int tt = 0; tt < 2; ++tt)
#pragma unroll
                    for (int nt = 0; nt < 8; ++nt) { const f32x4 dd = __builtin_amdgcn_mfma_f32_16x16x32_bf16(af[d][nt], uf[(T0 >> 4) + tt], (f32x4){0.f, 0.f, 0.f, 0.f}, 0, 0, 0);
                        *(LAS u32x2*)(sl + (16 * tt + fr) * 272 + (16 * nt + 4 * fq) * 2) = (u32x2){cvt_pk_bf16(dd[0], dd[1]), cvt_pk_bf16(dd[2], dd[3])}; }
                asm volatile("s_waitcnt lgkmcnt(0)" ::: "memory");
#pragma unroll 8
                for (int i = 0; i < 32; ++i) { const int r = (d == 0) ? i : 31 - i; LAS unsigned* cell = (LAS unsigned*)(sl + r * 272 + lane * 4);
                    const unsigned w = *cell; const float br = bflo(w), bi = bfhi(w);
                    st = (f32x2){lam.x * st.x - lam.y * st.y + br, lam.x * st.y + lam.y * st.x + bi};
                    if (PASSB) *cell = cvt_pk_bf16(st.x, st.y); }
                if (PASSB) {
                    const int t0q = T0 >> 4;
                    bf16x8 bsv[2][4];
#pragma unroll
                    for (int tt = 0; tt < 2; ++tt)
#pragma unroll
                        for (int ks = 0; ks < 4; ++ks) bsv[tt][ks] = *(const LAS bf16x8*)(sl + (16 * tt + fr) * 272 + (32 * ks + 8 * fq) * 2);
#pragma unroll
                    for (int tt = 0; tt < 2; ++tt)
#pragma unroll
                        for (int ks = 0; ks < 4; ++ks) yacc[t0q + tt] = __builtin_amdgcn_mfma_f32_16x16x32_bf16(ct[d][ks], bsv[tt][ks], yacc[t0q + tt], 0, 0, 0);
                    asm volatile("s_nop 7\n\ts_nop 7" : "+v"(yacc[0]), "+v"(yacc[1]), "+v"(yacc[2]), "+v"(yacc[3]) : "v"(bsv[0][0]), "v"(bsv[0][1]), "v"(bsv[0][2]), "v"(bsv[0][3]), "v"(bsv[1][0]), "v"(bsv[1][1]), "v"(bsv[1][2]), "v"(bsv[1][3]));
                }
                asm volatile("s_waitcnt lgkmcnt(0)" ::: "memory");
            }
            if (!PASSB) EB[((size_t)((d * 2 + b) * NCH + kc)) * 4096 + g * 64 + lane] = st;
        }
        if (PASSB) {
#pragma unroll
            for (int tq = 0; tq < 4; ++tq) { const int tok = 16 * tq + fr;
                f32x4 v; v[0] = yacc[tq][0] + bflo(uu[tq].x) * dsk[0]; v[1] = yacc[tq][1] + bfhi(uu[tq].x) * dsk[1]; v[2] = yacc[tq][2] + bflo(uu[tq].y) * dsk[2]; v[3] = yacc[tq][3] + bfhi(uu[tq].y) * dsk[3];
#pragma unroll
                for (int j = 0; j < 4; ++j) { const float x = v[j]; v[j] = x * sigmoidf_(1.5957691216f * (x + 0.044715f * x * x * x)); }
                *(u32x2*)(Y + (size_t)(b * SEQ + (kc - 4) * 64 + tok) * S5W + 16 * g + 4 * fq) = (u32x2){cvt_pk_bf16(v[0], v[1]), cvt_pk_bf16(v[2], v[3])}; }
        }
    }
}
__device__ __forceinline__ void s5_carry_item(Frame& F, int item) {
    const int idx = item * NTHR + F.tid; const int d = idx >> 13, b = (idx >> 12) & 1, gp = idx & 4095;
    const f32x2 lam = ((const f32x2*)(F.ws + WS_LAM))[d * 4096 + gp];
    f32x2 l = cmul(lam, lam); l = cmul(l, l); l = cmul(l, l); l = cmul(l, l); l = cmul(l, l); l = cmul(l, l);
    const f32x2* EB = (const f32x2*)(F.ws + WS_E) + (size_t)((d * 2 + b) * NCH) * 4096 + gp; f32x2* SB = (f32x2*)(F.ws + WS_SIN) + (size_t)((d * 2 + b) * NCH) * 4096 + gp;
    f32x2 s = (f32x2){0.f, 0.f};
#pragma unroll 1
    for (int st0 = 0; st0 < NCH; st0 += 20) { f32x2 e[20];
#pragma unroll
        for (int j = 0; j < 20; ++j) { const int st = st0 + j; const int kc = (d == 0) ? st : (st < 4 ? 3 - st : NCH + 3 - st); e[j] = EB[(size_t)kc * 4096]; }
#pragma unroll
        for (int j = 0; j < 20; ++j) { const int st = st0 + j; const int kc = (d == 0) ? st : (st < 4 ? 3 - st : NCH + 3 - st); SB[(size_t)kc * 4096] = s; s = cmul(l, s) + e[j]; } }
}

__device__ __forceinline__ int fsw(int i) { return i ^ ((i >> 5) & 7) ^ (((i >> 6) & 3) << 3); }
__host__ __device__ constexpr float w16c(int j) { return j == 0 ? 1.f : j == 1 ? 0.9238795325f : j == 2 ? 0.7071067812f : j == 3 ? 0.3826834324f : j == 4 ? 0.f : j == 5 ? -0.3826834324f : j == 6 ? -0.7071067812f : -0.9238795325f; }
__host__ __device__ constexpr float w16s(int j) { return j == 0 ? 0.f : j == 1 ? 0.3826834324f : j == 2 ? 0.7071067812f : j == 3 ? 0.9238795325f : j == 4 ? 1.f : j == 5 ? 0.9238795325f : j == 6 ? 0.7071067812f : 0.3826834324f; }
__host__ __device__ constexpr int bitrev(int q, int bits) { int r = 0; for (int i = 0; i < bits; ++i) r |= ((q >> i) & 1) << (bits - 1 - i); return r; }
template <int R, bool INV> __device__ __forceinline__ void dft_reg(f32x2 (&x)[R]) {
#pragma unroll
    for (int len = R; len >= 2; len >>= 1) { const int half = len >> 1, step = 16 / len;
#pragma unroll
        for (int b0 = 0; b0 < R; b0 += len)
#pragma unroll
            for (int k = 0; k < half; ++k) { const f32x2 a = x[b0 + k], b = x[b0 + k + half]; x[b0 + k] = a + b; const f32x2 dd = a - b; const int j = k * step;
                if (j == 0) x[b0 + k + half] = dd;
                else if (j == 4) x[b0 + k + half] = INV ? (f32x2){-dd.y, dd.x} : (f32x2){dd.y, -dd.x};
                else { const float c = w16c(j), s = w16s(j); x[b0 + k + half] = INV ? (f32x2){dd.x * c - dd.y * s, dd.x * s + dd.y * c} : (f32x2){dd.x * c + dd.y * s, dd.y * c - dd.x * s}; } } }
}
template <int R, int LOGN, bool INV> __device__ __forceinline__ void fft_pass(LAS f32x2* buf, int tid) {
    constexpr int LOGR = (R == 16) ? 4 : 3, LOGM = LOGN - LOGR, M = 1 << LOGM, NBF = 16384 / R / NTHR;
#pragma unroll 1
    for (int it = 0; it < NBF; ++it) {
        int tl = tid; asm volatile("" : "+v"(tl));
        const int bq = tl + NTHR * it, blk = bq >> LOGM, j = bq & (M - 1), base = (blk << LOGN) + j; const int fb = fsw(base);
#define FADDR(q) (fb ^ (((q) << LOGM) ^ ((((q) << LOGM) >> 5) & 7) ^ (((((q) << LOGM) >> 6) & 3) << 3)))
        f32x2 x[R];
#pragma unroll
        for (int q = 0; q < R; ++q) x[q] = buf[FADDR(q)];
        f32x2 w1 = (f32x2){1.f, 0.f};
        if (LOGM > 0) { const float rev = (float)j * (1.0f / (float)(1 << LOGN)); const float sn = sin_rev(rev); w1 = (f32x2){cos_rev(rev), INV ? sn : -sn}; }
        if (!INV) {
            dft_reg<R, false>(x);
            buf[fb] = x[0]; f32x2 w = w1;
#pragma unroll
            for (int q = 1; q < R; ++q) { buf[FADDR(q)] = (LOGM > 0) ? cmul(x[bitrev(q, LOGR)], w) : x[bitrev(q, LOGR)]; if (LOGM > 0) w = cmul(w, w1); }
        } else {
            if (LOGM > 0) { f32x2 w = w1;
#pragma unroll
                for (int q = 1; q < R; ++q) { x[q] = cmul(x[q], w); w = cmul(w, w1); } }
            dft_reg<R, true>(x);
#pragma unroll
            for (int q = 0; q < R; ++q) buf[FADDR(q)] = x[bitrev(q, LOGR)];
        }
#undef FADDR
    }
    __syncthreads();
}
#ifndef FFT_TEST
#define FFT_TEST 0
#endif
__device__ __forceinline__ void fft_fwd(LAS f32x2* buf, int tid) { if (FFT_TEST & 1) return; fft_pass<16, 14, false>(buf, tid); fft_pass<16, 10, false>(buf, tid); fft_pass<8, 6, false>(buf, tid); fft_pass<8, 3, false>(buf, tid); }
__device__ __forceinline__ void fft_inv(LAS f32x2* buf, int tid) { if (FFT_TEST & 2) return; fft_pass<8, 3, true>(buf, tid); fft_pass<8, 6, true>(buf, tid); fft_pass<16, 10, true>(buf, tid); fft_pass<16, 14, true>(buf, tid); }
__device__ __forceinline__ float block_sum(Frame& F, float v) {
    LAS float* red = (LAS float*)(F.lds + LDS_X);
    v = wave_sum(v); __syncthreads(); if (F.lane == 0) red[F.wave] = v; __syncthreads();
    float s = 0.f;
#pragma unroll
    for (int w = 0; w < NWAVES; ++w) s += red[w];
    return s;
}
__device__ __forceinline__ float sconv(const bf16* UH, int b, int ch, int t, float w0, float w1, float w2) {
    const bf16* p = UH + (size_t)(b * 3072 + ch) * SEQ;
    const int tm = t > 0 ? t - 1 : 0, tp = t < SEQ - 1 ? t + 1 : SEQ - 1;
    const float xm = bf2f(p[tm]), x0 = bf2f(p[t]), xp = bf2f(p[tp]);
    return w0 * (t > 0 ? xm : 0.f) + w1 * x0 + w2 * (t < SEQ - 1 ? xp : 0.f);
}
#define HY_UNPK(w) ((f32x2){bflo(w), bfhi(w)})
template <bool INV, class LD, class ST>
__device__ __forceinline__ void fft_edge_pass(LAS f32x2* buf, int tid, LD& ld, ST& st) {
    constexpr int R = 16, LOGN = 14, LOGM = 10;
#pragma unroll
    for (int it = 0; it < 2; ++it) {
        int tl = tid; asm volatile("" : "+v"(tl));
        const int j = tl + NTHR * it; const int fb = fsw(j);
        f32x2 x[R];
#pragma unroll
        for (int q = 0; q < R; ++q) x[q] = ld(2 * q + it, j + (q << LOGM), fb + (q << LOGM));
        const float rev = (float)j * (1.0f / 16384.0f); const float sn = sin_rev(rev); const f32x2 w1 = (f32x2){cos_rev(rev), INV ? sn : -sn};
        if (!INV) {
            dft_reg<R, false>(x);
            st(it, j, fb, x[0]); f32x2 w = w1;
#pragma unroll
            for (int q = 1; q < R; ++q) { st(2 * q + it, j + (q << LOGM), fb + (q << LOGM), cmul(x[bitrev(q, 4)], w)); w = cmul(w, w1); }
        } else {
            f32x2 w = w1;
#pragma unroll
            for (int q = 1; q < R; ++q) { x[q] = cmul(x[q], w); w = cmul(w, w1); }
            dft_reg<R, true>(x);
#pragma unroll
            for (int q = 0; q < R; ++q) st(2 * q + it, j + (q << LOGM), fb + (q << LOGM), x[bitrev(q, 4)]);
        }
        __builtin_amdgcn_sched_barrier(0);
    }
}
__device__ __forceinline__ void fft_last_to_ks(LAS f32x2* buf, int tid, unsigned* KS, float scale) {
#pragma unroll 1
    for (int it = 0; it < 4; ++it) { int tl = tid; asm volatile("" : "+v"(tl)); const int b = tl + NTHR * it; const int fb = fsw(8 * b);
        f32x2 x[8];
#pragma unroll
        for (int q = 0; q < 8; ++q) x[q] = buf[fb ^ q];
        dft_reg<8, false>(x);
        u32x4 o0, o1; f32x2 v;
        v = x[bitrev(0, 3)] * scale; o0.x = cvt_pk_bf16(v.x, v.y); v = x[bitrev(1, 3)] * scale; o0.y = cvt_pk_bf16(v.x, v.y); v = x[bitrev(2, 3)] * scale; o0.z = cvt_pk_bf16(v.x, v.y); v = x[bitrev(3, 3)] * scale; o0.w = cvt_pk_bf16(v.x, v.y);
        v = x[bitrev(4, 3)] * scale; o1.x = cvt_pk_bf16(v.x, v.y); v = x[bitrev(5, 3)] * scale; o1.y = cvt_pk_bf16(v.x, v.y); v = x[bitrev(6, 3)] * scale; o1.z = cvt_pk_bf16(v.x, v.y); v = x[bitrev(7, 3)] * scale; o1.w = cvt_pk_bf16(v.x, v.y);
        *(GAS u32x4*)(KS + 8 * b) = o0; *(GAS u32x4*)(KS + 8 * b + 4) = o1; }
}
__device__ __forceinline__ void fft_mid_mul(LAS f32x2* buf, int tid, const unsigned* KS) {
#pragma unroll 2
    for (int it = 0; it < 4; ++it) { int tl = tid; asm volatile("" : "+v"(tl)); const int b = tl + NTHR * it; const int fb = fsw(8 * b);
        const u32x4 k0 = *(const GAS u32x4*)(KS + 8 * b), k1 = *(const GAS u32x4*)(KS + 8 * b + 4);
        f32x2 x[8], y[8];
#pragma unroll
        for (int q = 0; q < 8; ++q) x[q] = buf[fb ^ q];
        dft_reg<8, false>(x);
        y[0] = cmul(x[bitrev(0, 3)], HY_UNPK(k0.x)); y[1] = cmul(x[bitrev(1, 3)], HY_UNPK(k0.y)); y[2] = cmul(x[bitrev(2, 3)], HY_UNPK(k0.z)); y[3] = cmul(x[bitrev(3, 3)], HY_UNPK(k0.w));
        y[4] = cmul(x[bitrev(4, 3)], HY_UNPK(k1.x)); y[5] = cmul(x[bitrev(5, 3)], HY_UNPK(k1.y)); y[6] = cmul(x[bitrev(6, 3)], HY_UNPK(k1.z)); y[7] = cmul(x[bitrev(7, 3)], HY_UNPK(k1.w));
        dft_reg<8, true>(y);
#pragma unroll
        for (int q = 0; q < 8; ++q) buf[fb ^ q] = y[bitrev(q, 3)]; }
    __syncthreads();
}
struct HyStLds { LAS f32x2* buf; __device__ __forceinline__ void operator()(int, int, int addr, f32x2 v) { buf[addr] = v; } };
struct HyLdLds { LAS f32x2* buf; __device__ __forceinline__ f32x2 operator()(int, int, int addr) { return buf[addr]; } };
struct HyLdKc { const bf16* f0; const bf16* f1; float part; __device__ __forceinline__ f32x2 operator()(int, int t, int) { const float a0 = bf2f(f0[t]), r1 = (t == 0) ? 0.f : bf2f(f1[SEQ - t]); part += fabsf(a0) + fabsf(r1); return (f32x2){a0 + r1, 0.f}; } };
struct HyLdKn { const bf16* f0; const bf16* f1; __device__ __forceinline__ f32x2 operator()(int, int t, int) { const float a0 = bf2f(f0[t]), r1 = (t == 0) ? 0.f : bf2f(f1[SEQ - t]); const float rev = (float)t * (1.0f / 32768.0f), v = a0 - r1; return (f32x2){v * cos_rev(rev), v * sin_rev(rev)}; } };
struct HyLdZ { const unsigned* z; __device__ __forceinline__ f32x2 operator()(int k, int, int) { return HY_UNPK(z[k]); } };
struct HyLdZpsi { const unsigned* z; __device__ __forceinline__ f32x2 operator()(int k, int t, int) { const float rev = (float)t * (1.0f / 32768.0f); return cmul(HY_UNPK(z[k]), (f32x2){cos_rev(rev), sin_rev(rev)}); } };
struct HyStYc { unsigned* yc; __device__ __forceinline__ void operator()(int k, int, int, f32x2 v) { const f32x2 w = v * (0.5f / 16384.0f); yc[k] = cvt_pk_bf16(w.x, w.y); } };
struct HyStComb { unsigned* z; const unsigned* yc; float bias;
    __device__ __forceinline__ void operator()(int k, int t, int, f32x2 v) { const float rev = (float)t * (1.0f / 32768.0f);
        const f32x2 yn = cmul(v, (f32x2){cos_rev(rev), -sin_rev(rev)}) * (0.5f / 16384.0f); const f32x2 y = yn + HY_UNPK(yc[k]) + HY_UNPK(z[k]) * bias; z[k] = cvt_pk_bf16(y.x, y.y); } };
template <bool NEG> __device__ __forceinline__ float hy_load_kernel(LAS f32x2* buf, int tid, const bf16* f0, const bf16* f1) {
    float part = 0.f;
#pragma unroll 2
    for (int r = 0; r < 4; ++r) { int tl = tid; asm volatile("" : "+v"(tl)); const int t0 = 8 * (tl + NTHR * r); const int fb = fsw(t0); float a[8], q[8];
        const u32x4 va = *(const GAS u32x4*)(f0 + t0), vr = *(const GAS u32x4*)(f1 + SEQ - t0 - 8); const float r0 = bf2f(f1[t0 > 0 ? SEQ - t0 : 0]);
        a[0] = bflo(va.x); a[1] = bfhi(va.x); a[2] = bflo(va.y); a[3] = bfhi(va.y); a[4] = bflo(va.z); a[5] = bfhi(va.z); a[6] = bflo(va.w); a[7] = bfhi(va.w);
        q[0] = t0 > 0 ? r0 : 0.f; q[1] = bfhi(vr.w); q[2] = bflo(vr.w); q[3] = bfhi(vr.z); q[4] = bflo(vr.z); q[5] = bfhi(vr.y); q[6] = bflo(vr.y); q[7] = bfhi(vr.x);
#pragma unroll
        for (int e = 0; e < 8; ++e) {
            if (!NEG) { part += fabsf(a[e]) + fabsf(q[e]); buf[fb ^ e] = (f32x2){a[e] + q[e], 0.f}; }
            else { const float rev = (float)(t0 + e) * (1.0f / 32768.0f), v = a[e] - q[e]; buf[fb ^ e] = (f32x2){v * cos_rev(rev), v * sin_rev(rev)}; } } }
    return part;
}
__device__ __forceinline__ void hy_conv8(const u32x4 v, float hm, float hp, float w0, float w1, float w2, float (&o)[8]) {
    const float x1 = bflo(v.x), x2 = bfhi(v.x), x3 = bflo(v.y), x4 = bfhi(v.y), x5 = bflo(v.z), x6 = bfhi(v.z), x7 = bflo(v.w), x8 = bfhi(v.w);
    o[0] = w0 * hm + w1 * x1 + w2 * x2; o[1] = w0 * x1 + w1 * x2 + w2 * x3; o[2] = w0 * x2 + w1 * x3 + w2 * x4; o[3] = w0 * x3 + w1 * x4 + w2 * x5;
    o[4] = w0 * x4 + w1 * x5 + w2 * x6; o[5] = w0 * x5 + w1 * x6 + w2 * x7; o[6] = w0 * x6 + w1 * x7 + w2 * x8; o[7] = w0 * x7 + w1 * x8 + w2 * hp;
}
__device__ __forceinline__ void hy_load_conv(LAS f32x2* buf, int tid, const bf16* UH, int ch, float w0, float w1, float w2) {
    const bf16* p0 = UH + (size_t)ch * SEQ; const bf16* p1 = UH + (size_t)(3072 + ch) * SEQ;
#pragma unroll 2
    for (int r = 0; r < 4; ++r) { int tl = tid; asm volatile("" : "+v"(tl)); const int t0 = 8 * (tl + NTHR * r); const int fb = fsw(t0);
        const int tm = t0 > 0 ? t0 - 1 : 0, tp = t0 + 8 < SEQ ? t0 + 8 : SEQ - 1;
        const u32x4 va = *(const GAS u32x4*)(p0 + t0), vb = *(const GAS u32x4*)(p1 + t0);
        float am = bf2f(p0[tm]), ap = bf2f(p0[tp]), bm = bf2f(p1[tm]), bp = bf2f(p1[tp]);
        if (t0 == 0) { am = 0.f; bm = 0.f; } if (t0 + 8 >= SEQ) { ap = 0.f; bp = 0.f; }
        float oa[8], ob[8]; hy_conv8(va, am, ap, w0, w1, w2, oa); hy_conv8(vb, bm, bp, w0, w1, w2, ob);
        buf[fb ^ 0] = (f32x2){oa[0], ob[0]}; buf[fb ^ 1] = (f32x2){oa[1], ob[1]}; buf[fb ^ 2] = (f32x2){oa[2], ob[2]}; buf[fb ^ 3] = (f32x2){oa[3], ob[3]};
        buf[fb ^ 4] = (f32x2){oa[4], ob[4]}; buf[fb ^ 5] = (f32x2){oa[5], ob[5]}; buf[fb ^ 6] = (f32x2){oa[6], ob[6]}; buf[fb ^ 7] = (f32x2){oa[7], ob[7]}; }
}
__device__ __forceinline__ void hyena_item(Frame& F, int c) {
    LAS f32x2* buf = (LAS f32x2*)F.lds;
    unsigned* KS = (unsigned*)(F.ws + WS_HYS + (size_t)F.bx * HYS_STRIDE);
    const bf16* FILT = (const bf16*)(F.ws + WS_FILT); const bf16* UH = (const bf16*)(F.ws + WS_UH);
    const int tid = F.tid; const int ft = fsw(tid);
#define FB(k) buf[ft + NTHR * (k)]
    const float* sw = F.in[IN_HSW];
    unsigned z[32], yc[32];
    HyStLds stl{buf}; HyLdLds ldl{buf};
    hy_load_conv(buf, tid, UH, c, sw[c], sw[3072 + c], sw[6144 + c]);
    __syncthreads();
#pragma unroll
    for (int k = 0; k < 32; ++k) { const f32x2 v_ = FB(k); z[k] = cvt_pk_bf16(v_.x, v_.y); }
#pragma unroll 1
    for (int o = 0; o < 2; ++o) {
        const bf16* f0 = FILT + (size_t)(o * 1024 + c) * SEQ; const bf16* f1 = FILT + (size_t)(2048 + o * 1024 + c) * SEQ;
        __syncthreads();
        const float part = hy_load_kernel<false>(buf, tid, f0, f1);
        const float inv = 1.0f / (block_sum(F, part) + 1e-6f);
        fft_edge_pass<false>(buf, tid, ldl, stl); __syncthreads();
        fft_pass<16, 10, false>(buf, tid); fft_pass<8, 6, false>(buf, tid);
        fft_last_to_ks(buf, tid, KS, inv); __syncthreads();
        { HyLdZ ldz{z}; fft_edge_pass<false>(buf, tid, ldz, stl); __syncthreads(); }
        fft_pass<16, 10, false>(buf, tid); fft_pass<8, 6, false>(buf, tid);
        fft_mid_mul(buf, tid, KS);
        fft_pass<8, 6, true>(buf, tid); fft_pass<16, 10, true>(buf, tid);
        { HyStYc styc{yc}; fft_edge_pass<true>(buf, tid, ldl, styc); }
        __syncthreads();
        (void)hy_load_kernel<true>(buf, tid, f0, f1); __syncthreads();
        fft_edge_pass<false>(buf, tid, ldl, stl); __syncthreads();
        fft_pass<16, 10, false>(buf, tid); fft_pass<8, 6, false>(buf, tid);
        fft_last_to_ks(buf, tid, KS, inv); __syncthreads();
        { HyLdZpsi ldzp{z}; fft_edge_pass<false>(buf, tid, ldzp, stl); __syncthreads(); }
        fft_pass<16, 10, false>(buf, tid); fft_pass<8, 6, false>(buf, tid);
        fft_mid_mul(buf, tid, KS);
        fft_pass<8, 6, true>(buf, tid); fft_pass<16, 10, true>(buf, tid);
        { HyStComb stc{z, yc, F.in[IN_HBIAS][o * 1024 + c]}; fft_edge_pass<true>(buf, tid, ldl, stc); }
#pragma unroll
        for (int k = 0; k < 32; ++k) FB(k) = HY_UNPK(z[k]);
        { const int xch = (o + 1) * 1024 + c; const float w0 = sw[xch], w1 = sw[3072 + xch], w2 = sw[6144 + xch];
#pragma unroll 8
          for (int k = 0; k < 32; ++k) { const int t = tid + NTHR * k; f32x2 v_ = FB(k); v_.x *= sconv(UH, 0, xch, t, w0, w1, w2); v_.y *= sconv(UH, 1, xch, t, w0, w1, w2); FB(k) = v_; } }
#pragma unroll
        for (int k = 0; k < 32; ++k) { const f32x2 v_ = FB(k); z[k] = cvt_pk_bf16(v_.x, v_.y); }
        __syncthreads();
    }
    bf16* YHCM = (bf16*)(F.ws + WS_YHCM);
#pragma unroll
    for (int k = 0; k < 32; ++k) FB(k) = HY_UNPK(z[k]);
#pragma unroll 8
    for (int k = 0; k < 32; ++k) { const int t = tid + NTHR * k; const f32x2 v_ = FB(k); YHCM[(size_t)c * SEQ + t] = (bf16)f2bf(v_.x); YHCM[(size_t)(1024 + c) * SEQ + t] = (bf16)f2bf(v_.y); }
    __syncthreads();
#undef FB
}
__device__ __forceinline__ void p4_hyena_carry(Frame& F, int qw) {
    volatile LAS int* qs = (volatile LAS int*)(F.lds + MISC_OFF + 64);
    for (;;) {
        __syncthreads();
        if (F.tid == 0) qs[0] = (int)__hip_atomic_fetch_add((unsigned*)(F.ctl + qw), 1u, __ATOMIC_RELAXED, __HIP_MEMORY_SCOPE_AGENT);
        __syncthreads();
        const int q = qs[0];
        if (q >= 32 + 1024) break;
        if (q < 1024) hyena_item(F, q); else s5_carry_item(F, q - 1024);
    }
}
__device__ __forceinline__ void yh_transpose(Frame& F) {
    const bf16* YHCM = (const bf16*)(F.ws + WS_YHCM); bf16* YH = (bf16*)(F.ws + WS_YH);
    LAS unsigned short* tl = (LAS unsigned short*)(F.lds + 8 * 8704 + F.wave * (64 * 72 * 2));
    const int gw = F.bx * NWAVES + F.wave, NGW = F.G * NWAVES, lane = F.lane;
    for (int it = gw; it < 2 * 16 * 256; it += NGW) {
        const int mt = it & 255, ct = (it >> 8) & 15, b = it >> 12; const int m0 = mt * 64, c0 = ct * 64;
#pragma unroll
        for (int j = 0; j < 8; ++j) { const int ch = 8 * j + (lane >> 3), mc = (lane & 7) * 8;
            const u32x4 v = *(const GAS u32x4*)(YHCM + (size_t)(b * 1024 + c0 + ch) * SEQ + m0 + mc); *(LAS u32x4*)(tl + ch * 72 + mc) = v; }
        LDS_WAIT(); asm volatile("" ::: "memory");
#pragma unroll
        for (int j = 0; j < 8; ++j) { const int mm = 8 * j + (lane >> 3), cc = (lane & 7) * 8; const int m = m0 + mm, w = m >> 8, r = m & 255;
            u32x4 o; o.x = (unsigned)tl[(cc + 0) * 72 + mm] | ((unsigned)tl[(cc + 1) * 72 + mm] << 16); o.y = (unsigned)tl[(cc + 2) * 72 + mm] | ((unsigned)tl[(cc + 3) * 72 + mm] << 16);
            o.z = (unsigned)tl[(cc + 4) * 72 + mm] | ((unsigned)tl[(cc + 5) * 72 + mm] << 16); o.w = (unsigned)tl[(cc + 6) * 72 + mm] | ((unsigned)tl[(cc + 7) * 72 + mm] << 16);
            *(GAS u32x4*)(YH + (size_t)(b * SEQ + r * 64 + w) * HYW + c0 + cc) = o; }
        LDS_WAIT(); asm volatile("" ::: "memory");
    }
}

struct SchedStd {
    int G, c, npn, K, nrep; const char* A; const char* Bt; int esz = 2;
    __device__ __forceinline__ bool next(int i, pg8::Unit& u) const {
        int L = i * G + c; const int nwg = 128 * npn; u.e = 0; u.valid = 256;
        if (nrep > 1 && L >= nwg) L -= nwg;
        if (L >= nwg) return false;
        int wgid = L; { const int q = nwg / 8, xcd = wgid % 8, off = wgid / 8; wgid = xcd * q + off; }
        const int nig = 8 * npn, gid = wgid / nig; u.pm = gid * 8 + ((wgid % nig) % 8); u.pn = (wgid % nig) / 8; return true;
    }
    __device__ __forceinline__ unsigned a_row(const pg8::Unit& u, int r) const { return (unsigned)(u.pm * 256 + r); }
    __device__ __forceinline__ const char* a_base() const { return A; }
    __device__ __forceinline__ const char* b_base(const pg8::Unit& u) const { return Bt + (size_t)u.pn * 256 * K * esz; }
};
template <int MODE> struct EpiMix {
    static constexpr bool PERM = true, TRANS = true, FP8 = false;
    const bf16* P; const bf16* Q; bf16* O;
    __device__ __forceinline__ void operator()(const f32x4 (&acc)[2][2][4][2], const pg8::Unit& u, int wr, int wc, int fr, int fq) const {
        constexpr int ld = (MODE == 0) ? 1024 : 2048;
        const int col0 = u.pn * 256 + wc * 32 + 8 * fq;
#pragma unroll
        for (int ai = 0; ai < 2; ++ai) {
            u32x4 pv[4][2], qv[4][2];
#pragma unroll
            for (int m = 0; m < 4; ++m) { const size_t row = (size_t)u.pm * 256 + ai * 128 + wr * 64 + m * 16 + fr;
#pragma unroll
                for (int bj = 0; bj < 2; ++bj) { const int col = col0 + bj * 128;
                    pv[m][bj] = (MODE == 0) ? *(const u32x4*)(P + row * 1024 + col) : *(const u32x4*)(P + row * 4096 + (MODE == 2 ? 2048 : 0) + col);
                    if (MODE == 2) qv[m][bj] = *(const u32x4*)(Q + row * 2048 + col); } }
#pragma unroll
            for (int m = 0; m < 4; ++m) { const size_t row = (size_t)u.pm * 256 + ai * 128 + wr * 64 + m * 16 + fr;
#pragma unroll
                for (int bj = 0; bj < 2; ++bj) { const int col = col0 + bj * 128; const f32x4 v0 = acc[ai][bj][m][0], v1 = acc[ai][bj][m][1]; float r[8];
                    if (MODE == 0) { const u32x4 y = pv[m][bj];
                        r[0] = bflo(y.x) * sigmoidf_(v0[0]); r[1] = bfhi(y.x) * sigmoidf_(v0[1]); r[2] = bflo(y.y) * sigmoidf_(v0[2]); r[3] = bfhi(y.y) * sigmoidf_(v0[3]);
                        r[4] = bflo(y.z) * sigmoidf_(v1[0]); r[5] = bfhi(y.z) * sigmoidf_(v1[1]); r[6] = bflo(y.w) * sigmoidf_(v1[2]); r[7] = bfhi(y.w) * sigmoidf_(v1[3]); }
                    else { const u32x4 gg = pv[m][bj];
                        r[0] = bflo(gg.x) * v0[0]; r[1] = bfhi(gg.x) * v0[1]; r[2] = bflo(gg.y) * v0[2]; r[3] = bfhi(gg.y) * v0[3];
                        r[4] = bflo(gg.z) * v1[0]; r[5] = bfhi(gg.z) * v1[1]; r[6] = bflo(gg.w) * v1[2]; r[7] = bfhi(gg.w) * v1[3];
                        if (MODE == 2) { const u32x4 t1 = qv[m][bj];
                            r[0] += bflo(t1.x); r[1] += bfhi(t1.x); r[2] += bflo(t1.y); r[3] += bfhi(t1.y); r[4] += bflo(t1.z); r[5] += bfhi(t1.z); r[6] += bflo(t1.w); r[7] += bfhi(t1.w); } }
                    if (MODE == 2) {
                        *(u32x2*)((unsigned char*)O + row * ld + col) = (u32x2){pk4_fp8(r[0] * T8SCALE, r[1] * T8SCALE, r[2] * T8SCALE, r[3] * T8SCALE), pk4_fp8(r[4] * T8SCALE, r[5] * T8SCALE, r[6] * T8SCALE, r[7] * T8SCALE)}; }
                    else { u32x4 w; w.x = cvt_pk_bf16(r[0], r[1]); w.y = cvt_pk_bf16(r[2], r[3]); w.z = cvt_pk_bf16(r[4], r[5]); w.w = cvt_pk_bf16(r[6], r[7]);
                        *(u32x4*)(O + row * ld + col) = w; } } }
        }
    }
};
struct EpiOut {
    static constexpr bool PERM = false, TRANS = true, FP8 = true;
    const float* X; const float* MOD; float* H1;
    __device__ __forceinline__ void operator()(const f32x4 (&acc)[2][2][4][2], const pg8::Unit& u, int wr, int wc, int fr, int fq) const {
        const int b = u.pm >> 6; const int col0 = u.pn * 256 + wc * 32 + 4 * fq;
        f32x4 gv[2][2];
#pragma unroll
        for (int bj = 0; bj < 2; ++bj)
#pragma unroll
            for (int n = 0; n < 2; ++n) gv[bj][n] = *(const f32x4*)(MOD + b * 12288 + 2 * 2048 + col0 + bj * 128 + n * 16);
#pragma unroll
        for (int ai = 0; ai < 2; ++ai) {
            f32x4 xv[4][2][2];
#pragma unroll
            for (int m = 0; m < 4; ++m) { const size_t off = ((size_t)u.pm * 256 + ai * 128 + wr * 64 + m * 16 + fr) * D + col0;
#pragma unroll
                for (int bj = 0; bj < 2; ++bj)
#pragma unroll
                    for (int n = 0; n < 2; ++n) xv[m][bj][n] = *(const f32x4*)(X + off + bj * 128 + n * 16); }
#pragma unroll
            for (int m = 0; m < 4; ++m) { const size_t off = ((size_t)u.pm * 256 + ai * 128 + wr * 64 + m * 16 + fr) * D + col0;
#pragma unroll
                for (int bj = 0; bj < 2; ++bj)
#pragma unroll
                    for (int n = 0; n < 2; ++n) *(f32x4*)(H1 + off + bj * 128 + n * 16) = xv[m][bj][n] + gv[bj][n] * (acc[ai][bj][m][n] * (1.0f / (W8SCALE * T8SCALE))); }
        }
    }
};

__device__ __forceinline__ void p10_router(Frame& F) {
    const int gw = F.bx * NWAVES + F.wave, NGW = F.G * NWAVES, lane = F.lane;
    const float* MOD = (const float*)(F.ws + WS_MOD); const float* g2n = F.in[IN_N2G]; const float* RWT = (const float*)(F.ws + WS_RWT); const float* rb = F.in[IN_RB];
    const float* H1 = (const float*)(F.ws + WS_H1); unsigned char* HM8 = (unsigned char*)(F.ws + WS_HM8); float* GATE = (float*)(F.ws + WS_GATE); int* LIST = (int*)(F.ws + WS_LIST);
    for (int m0 = 2 * gw; m0 < NTOK; m0 += 2 * NGW) {
        const int b = m0 >> 14;
        f32x4 h[2][8];
#pragma unroll
        for (int rr = 0; rr < 2; ++rr) { const float* xr = H1 + (size_t)(m0 + rr) * D; float s = 0.f;
#pragma unroll
            for (int j = 0; j < 8; ++j) { h[rr][j] = *(const GAS f32x4*)(xr + 4 * lane + 256 * j); s += (h[rr][j].x * h[rr][j].x + h[rr][j].y * h[rr][j].y) + (h[rr][j].z * h[rr][j].z + h[rr][j].w * h[rr][j].w); }
            const float rstd = 1.0f / sqrtf(wave_sum(s) * (1.0f / D) + 1e-6f);
            GAS unsigned* o = (GAS unsigned*)(HM8 + (size_t)(m0 + rr) * D) + lane;
#pragma unroll
            for (int j = 0; j < 8; ++j) { const int k = 4 * lane + 256 * j; const f32x4 g = *(const f32x4*)(g2n + k), sc = *(const f32x4*)(MOD + b * 12288 + 4 * 2048 + k), sh = *(const f32x4*)(MOD + b * 12288 + 3 * 2048 + k);
                h[rr][j] = h[rr][j] * rstd * g * (sc + 1.0f) + sh; }
#pragma unroll
            for (int j = 0; j < 8; ++j) o[64 * j] = pk4_fp8(h[rr][j].x, h[rr][j].y, h[rr][j].z, h[rr][j].w); }
        float lg0 = -3.0e38f, lg1 = -3.0e38f;
#pragma unroll 2
        for (int e = 0; e < NEXP; ++e) { float s0 = 0.f, s1 = 0.f;
#pragma unroll
            for (int j = 0; j < 8; ++j) { const f32x4 w = *(const f32x4*)(RWT + e * 2048 + 4 * lane + 256 * j);
                s0 += (h[0][j].x * w.x + h[0][j].y * w.y) + (h[0][j].z * w.z + h[0][j].w * w.w); s1 += (h[1][j].x * w.x + h[1][j].y * w.y) + (h[1][j].z * w.z + h[1][j].w * w.w); }
            s0 = wave_sum(s0) + rb[e]; s1 = wave_sum(s1) + rb[e];
            if (lane == e) { lg0 = s0; lg1 = s1; } }
#pragma unroll
        for (int rr = 0; rr < 2; ++rr) { float lg = rr ? lg1 : lg0; int es[4]; float vs[4];
#pragma unroll
            for (int k = 0; k < 4; ++k) { const float mx = wave_max(lg); const unsigned long long bal = __ballot(lg == mx); const int idx = __ffsll((long long)bal) - 1; es[k] = idx; vs[k] = mx; if (lane == idx) lg = -3.0e38f; }
            const float e1 = __expf(vs[1] - vs[0]), e2 = __expf(vs[2] - vs[0]), e3 = __expf(vs[3] - vs[0]); const float inv = 1.0f / (1.0f + e1 + e2 + e3);
            if (lane < 4) { const int ee = lane == 0 ? es[0] : lane == 1 ? es[1] : lane == 2 ? es[2] : es[3]; const float gt = (lane == 0 ? 1.0f : lane == 1 ? e1 : lane == 2 ? e2 : e3) * inv;
                const int slot = (m0 + rr) * 4 + lane;
                const unsigned pos = __hip_atomic_fetch_add((unsigned*)(F.ctl + CW_CNT + 64 * ee), 1u, __ATOMIC_RELAXED, __HIP_MEMORY_SCOPE_AGENT);
                LIST[ee * LISTCAP + (int)pos] = slot; GATE[slot] = gt; } }
    }
}

__device__ __forceinline__ void moe_tables(Frame& F) {
    volatile LAS int* tb = (volatile LAS int*)(F.lds + LDS_X);
    __syncthreads();
    if (F.tid < NEXP) tb[64 + F.tid] = (int)__hip_atomic_load((unsigned*)(F.ctl + CW_CNT + 64 * F.tid), __ATOMIC_RELAXED, __HIP_MEMORY_SCOPE_AGENT);
    __syncthreads();
    if (F.tid == 0) { int acc = 0; for (int e = 0; e < NEXP; ++e) { const int c = tb[64 + e]; tb[e] = acc; acc += (c + 255) >> 8; } tb[32] = acc; }
    __syncthreads();
}
template <bool GATHER> struct SchedMoe {
    int G, c, npn, N, K, nrep; const char* A; const char* Bt; const int* LIST; volatile LAS int* tb;
    __device__ __forceinline__ bool next(int i, pg8::Unit& u) const {
        int L = i * G + c; { const int tot = tb[32] * npn; if (nrep > 1 && L >= tot) L -= tot; }
        int rt = L / npn, pnq = L % npn;
        if (G == 256 && nrep == 1) {
            const int x = c & 7, j = c >> 3;
            if (npn == 16) { pnq = 4 * (x & 3) + (j & 3); rt = 16 * i + (x >> 2) * 8 + (j >> 2); }
            else           { pnq = 2 * (x & 3) + (j & 1); rt = 32 * i + (x >> 2) * 16 + (j >> 1); }
        }
        if (rt >= tb[32]) return false;
        int e = 0;
        for (int q = 1; q < NEXP; ++q) e += (tb[q] <= rt) ? 1 : 0;
        e = __builtin_amdgcn_readfirstlane(e);
        u.pm = rt; u.pn = pnq; u.e = e; const int left = tb[64 + e] - 256 * (rt - tb[e]); u.valid = left < 256 ? left : 256; return true;
    }
    __device__ __forceinline__ unsigned a_row(const pg8::Unit& u, int r) const {
        if (GATHER) { const int rc = r < u.valid ? r : u.valid - 1; return (unsigned)(LIST[u.e * LISTCAP + (u.pm - tb[u.e]) * 256 + rc] >> 2); }
        return (unsigned)(u.pm * 256 + r);
    }
    __device__ __forceinline__ const char* a_base() const { return A; }
    __device__ __forceinline__ const char* b_base(const pg8::Unit& u) const { return Bt + ((size_t)u.e * N + (size_t)u.pn * 256) * K; }
};
struct EpiMoe1 {
    static constexpr bool PERM = true, TRANS = true, FP8 = true;
    const float* BG; unsigned char* ACT;
    __device__ __forceinline__ void operator()(const f32x4 (&acc)[2][2][4][2], const pg8::Unit& u, int wr, int wc, int fr, int fq) const {
        const int c0 = u.pn * 256 + wc * 32 + 8 * fq;
        f32x4 bv[2][2];
#pragma unroll
        for (int bj = 0; bj < 2; ++bj)
#pragma unroll
            for (int n = 0; n < 2; ++n) bv[bj][n] = *(const f32x4*)(BG + (size_t)u.e * 4096 + c0 + bj * 128 + 4 * n);
#pragma unroll
        for (int ai = 0; ai < 2; ++ai)
#pragma unroll
            for (int m = 0; m < 4; ++m) { const size_t row = (size_t)u.pm * 256 + ai * 128 + wr * 64 + m * 16 + fr;
#pragma unroll
                for (int bj = 0; bj < 2; ++bj) { const f32x4 v0 = acc[ai][bj][m][0] * (1.0f / W8SCALE) + bv[bj][0], v1 = acc[ai][bj][m][1] * (1.0f / W8SCALE) + bv[bj][1]; float a[4];
#pragma unroll
                    for (int j = 0; j < 4; ++j) { const float gl = fminf(j < 2 ? v0[2 * j] : v1[2 * j - 4], 7.0f); const float ln = fminf(fmaxf(j < 2 ? v0[2 * j + 1] : v1[2 * j - 3], -7.0f), 7.0f);
                        a[j] = gl * sigmoidf_(1.702f * gl) * (ln + 1.0f); }
                    *(unsigned*)(ACT + row * DEXP + ((c0 + bj * 128) >> 1)) = pk4_fp8(a[0], a[1], a[2], a[3]); } }
    }
};
struct EpiMoe2 {
    static constexpr bool PERM = true, TRANS = true, FP8 = true;
    const float* BD; const float* GATE; const int* LIST; bf16* YS; volatile LAS int* tb;
    __device__ __forceinline__ void operator()(const f32x4 (&acc)[2][2][4][2], const pg8::Unit& u, int wr, int wc, int fr, int fq) const {
        const int c0 = u.pn * 256 + wc * 32 + 8 * fq; const int lbase = u.e * LISTCAP + (u.pm - tb[u.e]) * 256;
        f32x4 bv[2][2];
#pragma unroll
        for (int bj = 0; bj < 2; ++bj)
#pragma unroll
            for (int n = 0; n < 2; ++n) bv[bj][n] = *(const f32x4*)(BD + (size_t)u.e * D + c0 + bj * 128 + 4 * n);
        int slot[2][4]; float gt_[2][4];
#pragma unroll
        for (int ai = 0; ai < 2; ++ai)
#pragma unroll
            for (int m = 0; m < 4; ++m) { const int r = ai * 128 + wr * 64 + m * 16 + fr; slot[ai][m] = LIST[lbase + (r < u.valid ? r : u.valid - 1)]; }
#pragma unroll
        for (int ai = 0; ai < 2; ++ai)
#pragma unroll
            for (int m = 0; m < 4; ++m) gt_[ai][m] = GATE[slot[ai][m]];
#pragma unroll
        for (int ai = 0; ai < 2; ++ai)
#pragma unroll
            for (int m = 0; m < 4; ++m) { const int r = ai * 128 + wr * 64 + m * 16 + fr; const float gt = gt_[ai][m];
                const long long ro = (r < u.valid) ? (long long)slot[ai][m] * D : YS_DUMP_OFF;
#pragma unroll
                for (int bj = 0; bj < 2; ++bj) { const f32x4 v0 = (acc[ai][bj][m][0] * (1.0f / W8SCALE) + bv[bj][0]) * gt, v1 = (acc[ai][bj][m][1] * (1.0f / W8SCALE) + bv[bj][1]) * gt;
                    u32x4 w; w.x = cvt_pk_bf16(v0[0], v0[1]); w.y = cvt_pk_bf16(v0[2], v0[3]); w.z = cvt_pk_bf16(v1[0], v1[1]); w.w = cvt_pk_bf16(v1[2], v1[3]);
                    *(u32x4*)(YS + ro + c0 + bj * 128) = w; } }
    }
};
__device__ __forceinline__ void p13_final(Frame& F) {
    const int gw = F.bx * NWAVES + F.wave, NGW = F.G * NWAVES, lane = F.lane;
    const float* MOD = (const float*)(F.ws + WS_MOD); const float* fg = F.in[IN_FG]; const bf16* YS = (const bf16*)(F.ws + WS_YS); float* O = F.out;
    f32x4 fgv[8], g2v[8]; int curb = -1;
#pragma unroll
    for (int j = 0; j < 8; ++j) fgv[j] = *(const f32x4*)(fg + 4 * lane + 256 * j);
    for (int m = gw; m < NTOK; m += NGW) {
        const int b = m >> 14; float* xr = O + (size_t)m * D;
        if (b != curb) { curb = b;
#pragma unroll
            for (int j = 0; j < 8; ++j) g2v[j] = *(const f32x4*)(MOD + b * 12288 + 5 * 2048 + 4 * lane + 256 * j); } const float* hr = (const float*)(F.ws + WS_H1) + (size_t)m * D; f32x4 h[8]; float s = 0.f;
#pragma unroll
        for (int j = 0; j < 8; ++j) { const int k = 4 * lane + 256 * j; f32x4 a = (f32x4){0.f, 0.f, 0.f, 0.f};
#pragma unroll
            for (int q = 0; q < 4; ++q) { const u32x2 y = *(const GAS u32x2*)(YS + (size_t)(m * 4 + q) * D + k); a += (f32x4){bflo(y.x), bfhi(y.x), bflo(y.y), bfhi(y.y)}; }
            h[j] = *(const GAS f32x4*)(hr + k) + g2v[j] * a; s += (h[j].x * h[j].x + h[j].y * h[j].y) + (h[j].z * h[j].z + h[j].w * h[j].w); }
        const float rstd = 1.0f / sqrtf(wave_sum(s) * (1.0f / D) + 1e-6f);
#pragma unroll
        for (int j = 0; j < 8; ++j) { const int k = 4 * lane + 256 * j; *(GAS f32x4*)(xr + k) = h[j] * rstd * fgv[j]; }
    }
}

__global__ void __launch_bounds__(NTHR, 2) fwd(Args args) {
    extern __shared__ __attribute__((aligned(16))) unsigned char lds_raw[];
    Frame F;
    F.lds = (LAS unsigned char*)lds_raw;
    F.tid = threadIdx.x; F.lane = F.tid & 63; F.wave = __builtin_amdgcn_readfirstlane(F.tid >> 6);
    F.G = gridDim.x; F.bx = blockIdx.x; F.in = args.in; F.out = args.out; F.ws = args.ws; F.ctl = (GAS unsigned*)(args.ws + WS_CTL);
    for (int u = F.tid; u < (LDS_BYTES - MISC_OFF) / 4; u += NTHR) ((LAS unsigned*)(F.lds + MISC_OFF))[u] = 0u;
    __syncthreads();
    const int lo = args.ph_lo, hi = args.ph_hi;
    XcdBarrier bar; bar.bar = (unsigned*)(F.ctl + CW_BAR); bar.x = 0; bar.st = nullptr;
    if (hi - lo > 1) bar = xcd_barrier_post((unsigned*)(F.ctl + CW_BAR), (volatile LAS unsigned*)(F.lds + MISC_OFF));
#ifndef PH_MASK
#define PH_MASK 0xffff
#endif
#define IN(k) (((PH_MASK >> (k)) & 1) && lo <= (k) && (k) < hi)
#define SEAM(k) do { if (IN(k) && IN((k) + 1)) xcd_barrier(bar); } while (0)
    unsigned char* ws = args.ws;
#ifndef PROBE_DUP
#define PROBE_DUP 0
#endif
#define DUPBAR(k) if ((PROBE_DUP >> (k)) & 1) xcd_barrier(bar)
#define DUP2(k, body) do { body; if ((PROBE_DUP >> (k)) & 1) { xcd_barrier(bar); body; } } while (0)
    if (IN(0)) { DUP2(0, p0_prologue(F)); } SEAM(0);
    if (IN(1)) { DUP2(1, p1_norm(F)); } SEAM(1);
    if (IN(2)) { {
        const int GW = (F.G == 256) ? 192 : F.G; const int nr = ((PROBE_DUP >> 2) & 1) ? 2 : 1;
        if (F.bx < GW) {
            const int r1 = (128 * 4 + 8) % GW, r2 = (r1 + 128 * 16) % GW; const int c1 = F.bx, c2 = (F.bx - r1 + GW) % GW, c3 = (F.bx - r2 + GW) % GW;
            { SchedIn S{GW, c1, 128 * 4, 4, 0, nr, (const char*)(ws + WS_U), (const char*)(ws + WS_WIN)}; EpiInA E{ws};
              pg8::gemm_phase<EpiInA, SchedIn>(F.lds, D, S, E); }
            { SchedIn S{GW, c2, 128 * 16, 16, 2, nr, (const char*)(ws + WS_U8), (const char*)(ws + WS_WIN8)}; EpiInG8 E{(bf16*)(ws + WS_UG)};
              pg8::gemm_phase<EpiInG8, SchedIn>(F.lds, D, S, E); }
            { SchedIn S{GW, c3, 128 * 12, 12, 1, nr, (const char*)(ws + WS_U), (const char*)(ws + WS_WIN)}; EpiInH E{(bf16*)(ws + WS_UH)};
              pg8::gemm_phase<EpiInH, SchedIn>(F.lds, D, S, E); }
        }
        moe_weight_queue(F);
        }
    } SEAM(2);
    if (IN(3)) { DUP2(3, s5_pass3<false>(F)); } SEAM(3);
    if (IN(4)) { int q4w = CW_Q4; DUP2(4, (p4_hyena_carry(F, q4w), q4w += 16)); } SEAM(4);
    if (IN(5)) { DUP2(5, s5_pass3<true>(F)); __syncthreads(); DUP2(14, yh_transpose(F)); } SEAM(5);
    if (IN(6)) { { SchedStd S{F.G, F.bx, 4, 1024, ((PROBE_DUP >> 6) & 1) ? 2 : 1, (const char*)(ws + WS_Y), (const char*)(ws + WS_WGLU)}; EpiMix<0> E{(const bf16*)(ws + WS_Y), nullptr, (bf16*)(ws + WS_YA)};
        pg8::gemm_phase<EpiMix<0>, SchedStd>(F.lds, 1024, S, E); } } SEAM(6);
    if (IN(7)) { { SchedStd S{F.G, F.bx, 8, 1024, ((PROBE_DUP >> 7) & 1) ? 2 : 1, (const char*)(ws + WS_YA), (const char*)(ws + WS_WBS5)}; EpiMix<1> E{(const bf16*)(ws + WS_UG), nullptr, (bf16*)(ws + WS_T1)};
        pg8::gemm_phase<EpiMix<1>, SchedStd>(F.lds, 1024, S, E); } } SEAM(7);
    if (IN(8)) { { SchedStd S{F.G, F.bx, 8, 1024, ((PROBE_DUP >> 8) & 1) ? 2 : 1, (const char*)(ws + WS_YH), (const char*)(ws + WS_WBHY)}; EpiMix<2> E{(const bf16*)(ws + WS_UG), (const bf16*)(ws + WS_T1), (bf16*)(ws + WS_T)};
        pg8::gemm_phase<EpiMix<2>, SchedStd>(F.lds, 1024, S, E); } } SEAM(8);
    if (IN(9)) { { SchedStd S{F.G, F.bx, 8, 2048, ((PROBE_DUP >> 9) & 1) ? 2 : 1, (const char*)(ws + WS_T), (const char*)(ws + WS_WO), 1}; EpiOut E{F.in[IN_X], (const float*)(ws + WS_MOD), (float*)(ws + WS_H1)};
        pg8::gemm_phase<EpiOut, SchedStd>(F.lds, 2048, S, E); } } SEAM(9);
    if (IN(10)) { p10_router(F); } SEAM(10);
    if (IN(11)) { { moe_tables(F); volatile LAS int* tb = (volatile LAS int*)(F.lds + LDS_X);
        SchedMoe<true> S{F.G, F.bx, 16, 4096, 2048, ((PROBE_DUP >> 11) & 1) ? 2 : 1, (const char*)(ws + WS_HM8), (const char*)(ws + WS_WGU), (const int*)(ws + WS_LIST), tb}; EpiMoe1 E{F.in[IN_BGU], (unsigned char*)(ws + WS_ACT)};
        pg8::gemm_phase<EpiMoe1, SchedMoe<true>>(F.lds, 2048, S, E); } } SEAM(11);
    if (IN(12)) { { moe_tables(F); volatile LAS int* tb = (volatile LAS int*)(F.lds + LDS_X);
        SchedMoe<false> S{F.G, F.bx, 8, 2048, 2048, ((PROBE_DUP >> 12) & 1) ? 2 : 1, (const char*)(ws + WS_ACT), (const char*)(ws + WS_WDN), (const int*)(ws + WS_LIST), tb}; EpiMoe2 E{F.in[IN_BDN], (const float*)(ws + WS_GATE), (const int*)(ws + WS_LIST), (bf16*)(ws + WS_YS), tb};
        pg8::gemm_phase<EpiMoe2, SchedMoe<false>>(F.lds, 2048, S, E); } } SEAM(12);
    if (IN(13)) { DUP2(13, p13_final(F)); }
#undef IN
#undef SEAM
}

extern "C" void kernel_launch(void* const* d_in, const int* in_sizes, int n_in, void* d_out, int out_size, void* d_ws, size_t ws_size, hipStream_t stream) {
    static int grid = 0;
    if (grid == 0) {
        if (n_in != 39 || out_size != NTOK * D || ws_size < WS_END) { fprintf(stderr, "kernel_launch: unexpected shapes: n_in %d out %d ws %zu (need %zu)\n", n_in, out_size, ws_size, (size_t)WS_END); grid = -1; return; }
        int dev = 0, cus = 0, per_cu = 0;
        if (hipGetDevice(&dev) != hipSuccess || hipDeviceGetAttribute(&cus, hipDeviceAttributeMultiprocessorCount, dev) != hipSuccess) { grid = -1; return; }
        if (hipFuncSetAttribute((const void*)fwd, hipFuncAttributeMaxDynamicSharedMemorySize, LDS_BYTES) != hipSuccess) { fprintf(stderr, "kernel_launch: hipFuncSetAttribute failed\n"); grid = -1; return; }
        if (hipOccupancyMaxActiveBlocksPerMultiprocessor(&per_cu, (const void*)fwd, NTHR, LDS_BYTES) != hipSuccess || per_cu < 1) fprintf(stderr, "kernel_launch: occupancy query says %d\n", per_cu);
        (void)hipGetLastError();
        grid = cus;
    }
    if (grid < 0) return;
    if (hipMemsetAsync((char*)d_ws + WS_CTL, 0, CTL_ZERO_BYTES, stream) != hipSuccess) return;
    Args a{};
    for (int i = 0; i < 39; ++i) a.in[i] = (const float*)d_in[i];
    a.out = (float*)d_out; a.ws = (unsigned char*)d_ws;
#ifndef ONE_LAUNCH
#define ONE_LAUNCH 1
#endif
    if (ONE_LAUNCH) { a.ph_lo = 0; a.ph_hi = NPHASE; hipLaunchKernelGGL(fwd, dim3(grid), dim3(NTHR), LDS_BYTES, stream, a); }
    else for (int p = 0; p < NPHASE; ++p) { a.ph_lo = p; a.ph_hi = p + 1; hipLaunchKernelGGL(fwd, dim3(grid), dim3(NTHR), LDS_BYTES, stream, a); }
}
```

```cpp
#include <hip/hip_runtime.h>
#include <cstdio>
#include <cstdint>

#define GAS __attribute__((address_space(1)))
#define LAS __attribute__((address_space(3)))
typedef unsigned short bf16;
typedef short bf16x8 __attribute__((ext_vector_type(8)));
typedef float f32x4 __attribute__((ext_vector_type(4)));
typedef float f32x16 __attribute__((ext_vector_type(16)));
typedef float f32x2 __attribute__((ext_vector_type(2)));
typedef unsigned u32x4 __attribute__((ext_vector_type(4)));
typedef unsigned u32x2 __attribute__((ext_vector_type(2)));
typedef int i32x4 __attribute__((ext_vector_type(4)));
typedef int i32x8 __attribute__((ext_vector_type(8)));

constexpr int D = 2048, NB = 2, SEQ = 16384, NTOK = NB * SEQ, CTX = 256, NCTX = NB * CTX;
constexpr int S5W = 1024, HYW = 1024, INC = 8192, NEXP = 32, TOPK = 4, DEXP = 2048;
constexpr int NCH = 260;
constexpr int LISTCAP = 32768;

constexpr size_t MiB = 1u << 20;
constexpr size_t WS_CTL = 0, CTL_ZERO_BYTES = 1 * MiB;
constexpr size_t WS_MOD = 6 * MiB;
constexpr size_t WS_BBT = 7 * MiB;
constexpr size_t WS_CTT = WS_BBT + 512 * 1024;
constexpr size_t WS_LAM = 8 * MiB;
constexpr size_t WS_RWT = 8 * MiB + 256 * 1024;
constexpr size_t WS_BB2 = 8 * MiB + 512 * 1024;
constexpr size_t WS_WIN = 16 * MiB;
constexpr size_t WS_WGLU = 48 * MiB;
constexpr size_t WS_WBS5 = 50 * MiB;
constexpr size_t WS_WBHY = 54 * MiB;
constexpr size_t WS_WO = 58 * MiB;
constexpr size_t WS_WGU = 66 * MiB;
constexpr size_t WS_WDN = 578 * MiB;
constexpr size_t WS_U = 834 * MiB;
constexpr size_t WS_UCA = 964 * MiB;
constexpr size_t WS_UA = 966 * MiB;
constexpr size_t WS_UH = 1030 * MiB;
constexpr size_t WS_UG = 1222 * MiB;
constexpr size_t WS_E = 1478 * MiB;
constexpr size_t WS_SIN = 1511 * MiB;
constexpr size_t WS_FILT = 1544 * MiB;
constexpr size_t WS_HYS = 1800 * MiB;
constexpr size_t HYS_STRIDE = 768 * 1024;
constexpr size_t WS_YHCM = 1992 * MiB;
constexpr size_t WS_YH = 2056 * MiB;
constexpr size_t WS_Y = 2120 * MiB;
constexpr size_t WS_YA = 2184 * MiB;
constexpr size_t WS_T1 = 2248 * MiB;
constexpr size_t WS_T = 2376 * MiB;
constexpr size_t WS_HM = 2504 * MiB;
constexpr size_t WS_GATE = 2632 * MiB;
constexpr size_t WS_LIST = 2633 * MiB;
constexpr size_t WS_ACT = 2638 * MiB;
constexpr size_t WS_YS = 3182 * MiB;
constexpr size_t WS_H1 = 3694 * MiB;
constexpr size_t WS_HM8 = WS_T1;
constexpr size_t WS_U8 = WS_ACT;
constexpr size_t WS_WIN8 = WS_YS;
constexpr size_t WS_END = 3950 * MiB;
constexpr long long YS_DUMP_OFF = (long long)(2 * MiB) - (long long)WS_YS;

constexpr int CW_TMO = 0;
constexpr int CW_Q4 = 64;
constexpr int CW_QT = 96;
constexpr int CW_CNT = 128;
constexpr int CW_BAR = 4096;

constexpr int RING_BYTES = 131072;
constexpr int LDS_X = 131072;
constexpr int MISC_OFF = 147456 - 512;
constexpr int LDS_BYTES = 147456;
constexpr int NWAVES = 8, NTHR = 512;
constexpr int NPHASE = 14;

__device__ __forceinline__ unsigned f2bf(float f) { unsigned u = __builtin_bit_cast(unsigned, f); return (u + 0x7fffu + ((u >> 16) & 1u)) >> 16; }
__device__ __forceinline__ unsigned pk2(float lo, float hi) { return f2bf(lo) | (f2bf(hi) << 16); }
__device__ __forceinline__ float bf2f(unsigned short b) { return __builtin_bit_cast(float, ((unsigned)b) << 16); }
__device__ __forceinline__ float bflo(unsigned w) { return __builtin_bit_cast(float, w << 16); }
__device__ __forceinline__ float bfhi(unsigned w) { return __builtin_bit_cast(float, w & 0xffff0000u); }
typedef __bf16 bf16x2_t __attribute__((ext_vector_type(2)));
__device__ __forceinline__ unsigned cvt_pk_bf16(float lo, float hi) { const f32x2 v = {lo, hi}; const bf16x2_t b = __builtin_convertvector(v, bf16x2_t); return __builtin_bit_cast(unsigned, b); }
__device__ __forceinline__ unsigned pk4_fp8(float a, float b, float c, float d) { unsigned w = 0u; w = (unsigned)__builtin_amdgcn_cvt_pk_fp8_f32(a, b, (int)w, false); w = (unsigned)__builtin_amdgcn_cvt_pk_fp8_f32(c, d, (int)w, true); return w; }
constexpr float Y8SCALE = 8.0f;
constexpr float T8SCALE = 16.0f;
constexpr float W8SCALE = 64.0f;
__device__ __forceinline__ float sigmoidf_(float x) { return __builtin_amdgcn_rcpf(1.0f + __expf(-x)); }
__device__ __forceinline__ float sin_rev(float r) { return __builtin_amdgcn_sinf(__builtin_amdgcn_fractf(r)); }
__device__ __forceinline__ float cos_rev(float r) { return __builtin_amdgcn_cosf(__builtin_amdgcn_fractf(r)); }
__device__ __forceinline__ float wave_sum(float v) {
#pragma unroll
    for (int o = 1; o < 64; o <<= 1) v += __shfl_xor(v, o);
    return v;
}
__device__ __forceinline__ float wave_max(float v) {
#pragma unroll
    for (int o = 1; o < 64; o <<= 1) v = fmaxf(v, __shfl_xor(v, o));
    return v;
}
__device__ __forceinline__ f32x2 cmul(f32x2 a, f32x2 b) { return (f32x2){a.x * b.x - a.y * b.y, a.x * b.y + a.y * b.x}; }
#define LDS_WAIT() asm volatile("s_waitcnt lgkmcnt(0)" ::: "memory")
#define VM_WAIT() asm volatile("s_waitcnt vmcnt(0)" ::: "memory")

namespace pg8 {
constexpr int BM = 256, BK = 64, HALF = 128, HTB = HALF * BK * 2, STAGE_BYTES = 8 * HTB;
__host__ __device__ __forceinline__ int lds_byte(int r, int c) { const int st = (r >> 4) * 2 + (c >> 5), rr = r & 15, cc = c & 31, ob = rr * 64 + cc * 2; return st * 1024 + (ob ^ (((ob >> 9) & 1) << 5)); }
__host__ __device__ __forceinline__ void stage_rc(int b, int& R, int& C) { const int st = b / 1024, sb = b % 1024, swz = sb ^ (((sb >> 9) & 1) << 5); R = (st >> 1) * 16 + swz / 64; C = (st & 1) * 32 + (swz % 64) / 2; }
__host__ __device__ __forceinline__ int perm32(int rho) { const int n = rho >> 4, i = rho & 15; return 8 * (i >> 2) + 4 * n + (i & 3); }

struct Unit { int pm, pn, e, valid; };

template <class Epi, class Sched>
__device__ __forceinline__ void gemm_phase(LAS unsigned char* lds, const int Kel, const Sched& S, const Epi& E) {
    const int tid = threadIdx.x, wid = __builtin_amdgcn_readfirstlane(tid >> 6), lane = tid & 63, wr = wid >> 2, wc = wid & 3, fr = lane & 15, fq = lane >> 4;
    const int K = Epi::FP8 ? (Kel >> 1) : Kel;
    const int nt = K / BK;
    int Rs[2], Cs[2]; unsigned voffB[2];
#pragma unroll
    for (int i = 0; i < 2; ++i) { int R, C; stage_rc(tid * 16 + i * 8192, R, C); Rs[i] = R; Cs[i] = C; const int Rb = Epi::PERM ? ((R & ~31) + perm32(R & 31)) : R; voffB[i] = (unsigned)(Rb * K + C) * 2u; }
    const size_t kstep = (size_t)(BK * 2);
    const size_t hstep = (size_t)HALF * K * 2;
    const unsigned ldsw = (unsigned)wid * 1024u;
    const int aoff = lds_byte(wr * 64 + fr, fq * 8), boff = lds_byte(wc * 32 + fr, fq * 8);
    const int aoff8 = lds_byte(wr * 64 + fr, fq * 16), boff8 = lds_byte(wc * 32 + fr, fq * 16);
#define PG8_SA(b, h) (((b) * 2 + (h)) * HTB)
#define PG8_SB(b, h) ((4 + (b) * 2 + (h)) * HTB)
#define PG8_STAGE(bufoff, gbase, voff) do { _Pragma("unroll") for (int _i = 0; _i < 2; ++_i) \
        __builtin_amdgcn_global_load_lds((const unsigned*)((const char*)(gbase) + (voff)[_i]), (LAS unsigned*)(lds + (bufoff) + ldsw + _i * 8192), 16, 0, 0); } while (0)
#define PG8_LDA(dst, b, h) do { if constexpr (Epi::FP8) { _Pragma("unroll") for (int m = 0; m < 4; ++m) { const i32x4 lo_ = *(const LAS i32x4*)(lds + PG8_SA(b, h) + aoff8 + m * 2048), hi_ = *(const LAS i32x4*)(lds + PG8_SA(b, h) + aoff8 + m * 2048 + 16); dst##8[m] = __builtin_shufflevector(lo_, hi_, 0, 1, 2, 3, 4, 5, 6, 7); } } \
        else { _Pragma("unroll") for (int m = 0; m < 4; ++m) _Pragma("unroll") for (int k = 0; k < 2; ++k) dst[m][k] = *(const LAS bf16x8*)(lds + PG8_SA(b, h) + aoff + m * 2048 + k * 1024); } } while (0)
#define PG8_LDB(dst, b, h) do { if constexpr (Epi::FP8) { _Pragma("unroll") for (int n = 0; n < 2; ++n) { const i32x4 lo_ = *(const LAS i32x4*)(lds + PG8_SB(b, h) + boff8 + n * 2048), hi_ = *(const LAS i32x4*)(lds + PG8_SB(b, h) + boff8 + n * 2048 + 16); dst##8[n] = __builtin_shufflevector(lo_, hi_, 0, 1, 2, 3, 4, 5, 6, 7); } } \
        else { _Pragma("unroll") for (int n = 0; n < 2; ++n) _Pragma("unroll") for (int k = 0; k < 2; ++k) dst[n][k] = *(const LAS bf16x8*)(lds + PG8_SB(b, h) + boff + n * 2048 + k * 1024); } } while (0)
#define PG8_MMA(ai, bj, At, Bt) do { __builtin_amdgcn_s_setprio(1); \
        if constexpr (Epi::FP8) { _Pragma("unroll") for (int m = 0; m < 4; ++m) _Pragma("unroll") for (int n = 0; n < 2; ++n) \
            asm volatile("v_mfma_scale_f32_16x16x128_f8f6f4 %0, %1, %2, %0, %3, %3 op_sel_hi:[0,0,0]" : "+v"(acc[ai][bj][m][n]) : "v"(Bt##8[n]), "v"(At##8[m]), "v"(scl1)); } \
        else { _Pragma("unroll") for (int m = 0; m < 4; ++m) _Pragma("unroll") for (int n = 0; n < 2; ++n) _Pragma("unroll") for (int k = 0; k < 2; ++k) \
        acc[ai][bj][m][n] = Epi::TRANS ? __builtin_amdgcn_mfma_f32_16x16x32_bf16(Bt[n][k], At[m][k], acc[ai][bj][m][n], 0, 0, 0) \
                                       : __builtin_amdgcn_mfma_f32_16x16x32_bf16(At[m][k], Bt[n][k], acc[ai][bj][m][n], 0, 0, 0); } __builtin_amdgcn_s_setprio(0); } while (0)
#define PG8_WAIT_V(n) asm volatile("s_waitcnt vmcnt(" #n ")" ::: "memory")
#define PG8_WAIT_L(n) asm volatile("s_waitcnt lgkmcnt(" #n ")" ::: "memory")
#define PG8_BAR __builtin_amdgcn_s_barrier()
#define PG8_SCHED __builtin_amdgcn_sched_barrier(0)
    Unit cur, nxt; int ui = 0;
    if (!S.next(0, cur)) return;
    f32x4 acc[2][2][4][2];
#pragma unroll
    for (int a = 0; a < 2; ++a)
#pragma unroll
        for (int b = 0; b < 2; ++b)
#pragma unroll
            for (int m = 0; m < 4; ++m)
#pragma unroll
                for (int n = 0; n < 2; ++n) acc[a][b][m][n] = (f32x4){0.f, 0.f, 0.f, 0.f};
    bf16x8 At[4][2], B0[2][2], B1[2][2]; i32x8 At8[4], B08[2], B18[2]; const int scl1 = 0x7F7F7F7F;
    const char* const Ab = S.a_base();
    const char* cB = S.b_base(cur);
    unsigned vC0[2], vC1[2];
#pragma unroll
    for (int i = 0; i < 2; ++i) { vC0[i] = (S.a_row(cur, Rs[i]) * (unsigned)K + (unsigned)Cs[i]) * 2u; vC1[i] = (S.a_row(cur, HALF + Rs[i]) * (unsigned)K + (unsigned)Cs[i]) * 2u; }
    PG8_STAGE(PG8_SB(0, 0), cB, voffB); PG8_STAGE(PG8_SB(0, 1), cB + hstep, voffB); PG8_STAGE(PG8_SA(0, 0), Ab, vC0); PG8_STAGE(PG8_SA(0, 1), Ab, vC1);
    if (wr == 1) PG8_BAR;
    PG8_WAIT_V(2); PG8_BAR;
    PG8_STAGE(PG8_SB(1, 0), cB + kstep, voffB); PG8_STAGE(PG8_SA(1, 0), Ab + kstep, vC0); PG8_STAGE(PG8_SB(1, 1), cB + hstep + kstep, voffB);
    PG8_WAIT_V(6); PG8_BAR;
    for (;;) {
        const bool has_next = S.next(ui + 1, nxt);
        const char* nB = has_next ? S.b_base(nxt) : cB;
        for (int t = 0; t < nt; t += 2) {
            const bool last = (t == nt - 2);
            const char* a1 = Ab + (size_t)(t + 1) * kstep;
            const char* a2 = last ? Ab : Ab + (size_t)(t + 2) * kstep; const char* b2 = last ? nB : cB + (size_t)(t + 2) * kstep;
            const char* a3 = a2 + kstep; const char* b3 = b2 + kstep;
            unsigned vX0[2], vX1[2];
            if (last && has_next) {
#pragma unroll
                for (int i = 0; i < 2; ++i) { vX0[i] = (S.a_row(nxt, Rs[i]) * (unsigned)K + (unsigned)Cs[i]) * 2u; vX1[i] = (S.a_row(nxt, HALF + Rs[i]) * (unsigned)K + (unsigned)Cs[i]) * 2u; }
            } else {
#pragma unroll
                for (int i = 0; i < 2; ++i) { vX0[i] = vC0[i]; vX1[i] = vC1[i]; }
            }
            PG8_LDB(B0, 0, 0); PG8_LDB(B1, 0, 1); PG8_SCHED; PG8_LDA(At, 0, 0); PG8_STAGE(PG8_SA(1, 1), a1, vC1);
            PG8_WAIT_V(8); PG8_WAIT_L(0); PG8_BAR; PG8_MMA(0, 0, At, B0); PG8_MMA(0, 1, At, B1); PG8_BAR; PG8_SCHED;
            PG8_LDA(At, 0, 1); PG8_STAGE(PG8_SB(0, 0), b2, voffB); PG8_STAGE(PG8_SB(0, 1), b2 + hstep, voffB); PG8_STAGE(PG8_SA(0, 0), a2, vX0);
            PG8_WAIT_V(8); PG8_WAIT_L(0); PG8_BAR; PG8_MMA(1, 0, At, B0); PG8_MMA(1, 1, At, B1); PG8_BAR; PG8_SCHED;
            PG8_LDB(B0, 1, 0); PG8_LDB(B1, 1, 1); PG8_SCHED; PG8_LDA(At, 1, 0); PG8_STAGE(PG8_SA(0, 1), a2, vX1);
            PG8_WAIT_V(8); PG8_WAIT_L(0); PG8_BAR; PG8_MMA(0, 0, At, B0); PG8_MMA(0, 1, At, B1); PG8_BAR; PG8_SCHED;
            PG8_LDA(At, 1, 1); PG8_STAGE(PG8_SB(1, 0), b3, voffB); PG8_STAGE(PG8_SB(1, 1), b3 + hstep, voffB); PG8_STAGE(PG8_SA(1, 0), a3, vX0);
            PG8_WAIT_V(8); PG8_WAIT_L(0); PG8_BAR; PG8_MMA(1, 0, At, B0); PG8_MMA(1, 1, At, B1); PG8_BAR; PG8_SCHED;
            if (last) {
#pragma unroll
                for (int i = 0; i < 2; ++i) { vC0[i] = vX0[i]; vC1[i] = vX1[i]; }
            }
        }
        if (wr == 0) PG8_BAR;
        if constexpr (Epi::FP8) asm volatile("s_nop 15\n\ts_nop 15" ::: "memory");
        E(acc, cur, wr, wc, fr, fq);
        if (!has_next) break;
#pragma unroll
        for (int a = 0; a < 2; ++a)
#pragma unroll
            for (int b = 0; b < 2; ++b)
#pragma unroll
                for (int m = 0; m < 4; ++m)
#pragma unroll
                    for (int n = 0; n < 2; ++n) acc[a][b][m][n] = (f32x4){0.f, 0.f, 0.f, 0.f};
        cur = nxt; cB = nB; ++ui;
        if (wr == 1) PG8_BAR;
    }
    PG8_WAIT_V(0);
    PG8_BAR;
#undef PG8_SA
#undef PG8_SB
#undef PG8_STAGE
#undef PG8_LDA
#undef PG8_LDB
#undef PG8_MMA
#undef PG8_WAIT_V
#undef PG8_WAIT_L
#undef PG8_BAR
#undef PG8_SCHED
}
}

#define XB_TMO      128
#define XB_XCNT(j)  (256  + 64 * (j))
#define XB_XSUB(j)  (1280 + 64 * (j))
#define XB_XGEN(j)  (2304 + 64 * (j))
#define XB_TOP      3328
#define XB_TOPGEN   3392
#define XCD_BAR_WORDS 3456
#define XB_SPIN_CAP (1u << 22)
__device__ __forceinline__ unsigned xb_ld(unsigned* p)              { return __hip_atomic_load(p, __ATOMIC_RELAXED, __HIP_MEMORY_SCOPE_AGENT); }
__device__ __forceinline__ unsigned xb_add(unsigned* p, unsigned v) { return __hip_atomic_fetch_add(p, v, __ATOMIC_RELAXED, __HIP_MEMORY_SCOPE_AGENT); }
__device__ __forceinline__ unsigned xb_xcc_id() { return (unsigned)__builtin_amdgcn_s_getreg((3 << 11) | 20) & 0xFu; }
#define XB_SPIN(cond, bar) do { unsigned _sp = 0; while (cond) { __builtin_amdgcn_s_sleep(1); \
    if ((++_sp & 255u) == 0u) { if (xb_ld(&(bar)[XB_TMO])) break; if (_sp > XB_SPIN_CAP) { atomicAdd(&(bar)[XB_TMO], 1u); break; } } } } while (0)
struct XcdBarrier { unsigned* bar; unsigned x; volatile LAS unsigned* st; };
__device__ __forceinline__ XcdBarrier xcd_barrier_post(unsigned* bar, volatile LAS unsigned* st) {
    XcdBarrier b; b.bar = bar; b.x = xb_xcc_id(); b.st = st;
    if (threadIdx.x == 0) (void)xb_add(&bar[XB_XCNT(b.x)], 1u);
    return b;
}
__device__ __forceinline__ void xcd_barrier_complete(unsigned* bar, unsigned x, unsigned& nloc, unsigned& nx) {
    const unsigned G = gridDim.x * gridDim.y * gridDim.z;
    unsigned sum, cnt, mine, sp = 0u;
    for (;;) {
        sum = 0u; cnt = 0u; mine = 0u;
#pragma unroll
        for (unsigned j = 0; j < 16; ++j) { const unsigned c = xb_ld(&bar[XB_XCNT(j)]); sum += c; cnt += (c > 0u) ? 1u : 0u; mine = (j == x) ? c : mine; }
        if (sum == G) break;
        __builtin_amdgcn_s_sleep(1);
        if ((++sp & 255u) == 0u) { if (xb_ld(&bar[XB_TMO])) break; if (sp > XB_SPIN_CAP) { atomicAdd(&bar[XB_TMO], 1u); break; } }
    }
    nloc = mine > 0u ? mine : 1u; nx = cnt > 0u ? cnt : 1u;
}
__device__ __forceinline__ void xcd_barrier(const XcdBarrier& b) {
    asm volatile("s_waitcnt vmcnt(0)" ::: "memory");
    __syncthreads();
    if (threadIdx.x == 0) {
        unsigned* bar = b.bar;
        __builtin_amdgcn_s_waitcnt(0);
        unsigned nloc = b.st[0], nx = b.st[1];
        if (nloc == 0u) { xcd_barrier_complete(bar, b.x, nloc, nx); b.st[0] = nloc; b.st[1] = nx; }
        const unsigned old = xb_add(&bar[XB_XSUB(b.x)], 1u);
        const unsigned gen = old / nloc;
        if (old + 1u == (gen + 1u) * nloc) {
            __builtin_amdgcn_fence(__ATOMIC_RELEASE, "agent");
            asm volatile("s_waitcnt vmcnt(0)" ::: "memory");
            const unsigned og = xb_add(&bar[XB_TOP], 1u);
            const unsigned tg = og / nx;
            if (og + 1u == (tg + 1u) * nx) xb_add(&bar[XB_TOPGEN], 1u);
            else XB_SPIN(xb_ld(&bar[XB_TOPGEN]) == tg, bar);
            __builtin_amdgcn_fence(__ATOMIC_ACQUIRE, "agent");
            xb_add(&bar[XB_XGEN(b.x)], 1u);
            asm volatile("s_waitcnt vmcnt(0)" ::: "memory");
        } else {
            XB_SPIN(xb_ld(&bar[XB_XGEN(b.x)]) == gen, bar);
            __builtin_amdgcn_fence(__ATOMIC_ACQUIRE, "agent");
            asm volatile("s_waitcnt vmcnt(0)" ::: "memory");
        }
    }
    __syncthreads();
}

struct Args { const float* in[39]; float* out; unsigned char* ws; int ph_lo, ph_hi; };
struct Frame {
    LAS unsigned char* lds;
    int tid, lane, wave, G, bx;
    const float* const* in; float* out; unsigned char* ws;
    GAS unsigned* ctl;
};
#define IN_X 0
#define IN_C 1
#define IN_CTX 2
#define IN_CCTX 3
#define IN_WADA 4
#define IN_BADA 5
#define IN_N1G 6
#define IN_N2G 7
#define IN_WIN 8
#define IN_LRE 9
#define IN_LIM 10
#define IN_LDT 11
#define IN_BRE 12
#define IN_BIM 13
#define IN_CRE 14
#define IN_CIM 15
#define IN_S5D 16
#define IN_WGLU 17
#define IN_HSW 18
#define IN_HW1 19
#define IN_HB1 20
#define IN_HF1 21
#define IN_HW2 22
#define IN_HB2 23
#define IN_HF2 24
#define IN_HW3 25
#define IN_HB3 26
#define IN_HDEC 27
#define IN_HBIAS 28
#define IN_WBS5 29
#define IN_WBHY 30
#define IN_WO 31
#define IN_RW 32
#define IN_RB 33
#define IN_WGU 34
#define IN_BGU 35
#define IN_WDN 36
#define IN_BDN 37
#define IN_FG 38

__device__ __forceinline__ void p0_adaln_item(Frame& F, int cb) {
    LAS float* sl = (LAS float*)F.lds;
    const float* c = F.in[IN_C]; const float* cc = F.in[IN_CCTX]; const float* W = F.in[IN_WADA];
    for (int i = F.tid; i < 3 * 2048; i += NTHR) { const int v = i >> 11, k = i & 2047; const float cv = (v < 2) ? c[v * 2048 + k] : cc[k]; sl[i] = cv * sigmoidf_(cv); }
    __syncthreads();
    const int col = F.tid % 48, ks = F.tid / 48;
    float a0 = 0.f, a1 = 0.f, a2 = 0.f;
    if (ks < 10) { const float* wp = W + 48 * cb + col;
#pragma unroll 16
        for (int j = 0; j < 205; ++j) { const int k = ks + 10 * j; if (k < 2048) { const float w = wp[(size_t)k * 12288]; a0 += sl[k] * w; a1 += sl[2048 + k] * w; a2 += sl[4096 + k] * w; } } }
    LAS float* red = sl + 6144;
    if (ks < 10) { red[(ks * 48 + col) * 3 + 0] = a0; red[(ks * 48 + col) * 3 + 1] = a1; red[(ks * 48 + col) * 3 + 2] = a2; }
    __syncthreads();
    if (F.tid < 144) { const int v = F.tid / 48, cl = F.tid % 48; float sacc = 0.f;
#pragma unroll
        for (int q = 0; q < 10; ++q) sacc += red[(q * 48 + cl) * 3 + v];
        ((float*)(F.ws + WS_MOD))[v * 12288 + 48 * cb + cl] = sacc + F.in[IN_BADA][48 * cb + cl]; }
    __syncthreads();
}
__device__ __forceinline__ void p0_filt_item(Frame& F, int tb) {
    LAS float* ft = (LAS float*)F.lds;
    LAS float* h1 = ft + 64 * 36;
    LAS float* h2 = h1 + 64 * 65;
    const int t0 = tb * 64, tl = F.tid >> 3, q = F.tid & 7; const float tf = (float)(t0 + tl);
    for (int f = q; f < 33; f += 8) {
        float v;
        if (f == 0) v = tf * (1.0f / 16383.0f);
        else { const int bi = (f - 1) & 15; const float band = 1e-4f + (float)bi * ((15.0f - 1e-4f) / 15.0f); const float rev = tf * band * (1.0f / 16384.0f);
               v = (f <= 16) ? cos_rev(rev) : -sin_rev(rev); }
        ft[tl * 36 + f] = v;
    }
    __syncthreads();
    { const float* w1 = F.in[IN_HW1]; const float* b1 = F.in[IN_HB1]; const float* f1 = F.in[IN_HF1];
      _Pragma("unroll 1") for (int j = q * 8; j < q * 8 + 8; ++j) { float a = b1[j]; _Pragma("unroll 3") for (int f = 0; f < 33; ++f) a += ft[tl * 36 + f] * w1[f * 64 + j]; h1[tl * 65 + j] = sin_rev(f1[j] * a * 0.15915494309189535f); } }
    __syncthreads();
    { const float* w2 = F.in[IN_HW2]; const float* b2 = F.in[IN_HB2]; const float* f2 = F.in[IN_HF2];
      _Pragma("unroll 1") for (int j = q * 8; j < q * 8 + 8; ++j) { float a = b2[j]; _Pragma("unroll 4") for (int i = 0; i < 64; ++i) a += h1[tl * 65 + i] * w2[i * 64 + j]; h2[tl * 64 + j] = sin_rev(f2[j] * a * 0.15915494309189535f); } }
    __syncthreads();
    LAS unsigned short* hb = (LAS unsigned short*)(h2 + 64 * 64);
    for (int i = F.tid; i < 64 * 64; i += NTHR) hb[(i >> 6) * 72 + (i & 63)] = (unsigned short)f2bf(h2[i]);
    __syncthreads();
    const float* w3 = F.in[IN_HW3]; const float* b3 = F.in[IN_HB3]; const float* dec = F.in[IN_HDEC]; bf16* FILT = (bf16*)(F.ws + WS_FILT);
    const int fr = F.lane & 15, fq = F.lane >> 4;
    bf16x8 af[4][2];
#pragma unroll
    for (int m = 0; m < 4; ++m)
#pragma unroll
        for (int ks = 0; ks < 2; ++ks) af[m][ks] = *(const LAS bf16x8*)(hb + (16 * m + fr) * 72 + 32 * ks + 8 * fq);
#pragma unroll 4
    for (int jt = F.wave; jt < 256; jt += NWAVES) {
        const int j = 16 * jt + fr;
        bf16x8 bfr[2];
#pragma unroll
        for (int ks = 0; ks < 2; ++ks) { float w[8];
#pragma unroll
            for (int e = 0; e < 8; ++e) w[e] = w3[(size_t)(32 * ks + 8 * fq + e) * 4096 + j];
            u32x4 pk; pk.x = pk2(w[0], w[1]); pk.y = pk2(w[2], w[3]); pk.z = pk2(w[4], w[5]); pk.w = pk2(w[6], w[7]); bfr[ks] = __builtin_bit_cast(bf16x8, pk); }
        const float bb = b3[j], dd = fabsf(dec[j]) * (1.0f / 16383.0f);
#pragma unroll
        for (int m = 0; m < 4; ++m) { f32x4 acc = (f32x4){0.f, 0.f, 0.f, 0.f};
#pragma unroll
            for (int ks = 0; ks < 2; ++ks) acc = __builtin_amdgcn_mfma_f32_16x16x32_bf16(af[m][ks], bfr[ks], acc, 0, 0, 0);
            const int tb0 = t0 + 16 * m + 4 * fq; f32x4 o;
#pragma unroll
            for (int e = 0; e < 4; ++e) o[e] = (acc[e] + bb) * __expf(-(float)(tb0 + e) * dd);
            *(u32x2*)(FILT + (size_t)j * SEQ + tb0) = (u32x2){cvt_pk_bf16(o[0], o[1]), cvt_pk_bf16(o[2], o[3])}; }
    }
    __syncthreads();
}
__device__ __forceinline__ void p0_s5tab_item(Frame& F, int item) {
    const int idx = item * NTHR + F.tid; const int d = idx >> 12, g = (idx >> 6) & 63, p = idx & 63, dg = d * 64 + g;
    const float lr = F.in[IN_LRE][dg * 64 + p], li = F.in[IN_LIM][dg * 64 + p], dt = expf(F.in[IN_LDT][dg]);
    const float mag = expf(lr * dt), ang = li * dt; const float lbr = mag * cosf(ang), lbi = mag * sinf(ang);
    const float den = lr * lr + li * li, cr = ((lbr - 1.f) * lr + lbi * li) / den, ci = (lbi * lr - (lbr - 1.f) * li) / den;
    bf16* BBT = (bf16*)(F.ws + WS_BBT); bf16* BB2 = (bf16*)(F.ws + WS_BB2); bf16* CTT = (bf16*)(F.ws + WS_CTT); f32x2* LAM = (f32x2*)(F.ws + WS_LAM);
    const float* bre = F.in[IN_BRE] + (size_t)(dg * 64 + p) * 16; const float* bim = F.in[IN_BIM] + (size_t)(dg * 64 + p) * 16;
    for (int c = 0; c < 16; ++c) { const float br = bre[c], bi = bim[c];
        BBT[(size_t)(dg * 128 + p) * 16 + c] = (bf16)f2bf(cr * br - ci * bi); BBT[(size_t)(dg * 128 + 64 + p) * 16 + c] = (bf16)f2bf(cr * bi + ci * br);
        BB2[(size_t)(dg * 128 + 2 * p) * 16 + c] = (bf16)f2bf(cr * br - ci * bi); BB2[(size_t)(dg * 128 + 2 * p + 1) * 16 + c] = (bf16)f2bf(cr * bi + ci * br); }
    const int k = 2 * p;
    for (int c = 0; c < 16; ++c) { const float cre = F.in[IN_CRE][(size_t)(dg * 16 + c) * 64 + p], cim = F.in[IN_CIM][(size_t)(dg * 16 + c) * 64 + p];
        CTT[(size_t)(dg * 16 + c) * 128 + k] = (bf16)f2bf(cre); CTT[(size_t)(dg * 16 + c) * 128 + k + 1] = (bf16)f2bf(-cim); }
    LAM[dg * 64 + p] = (f32x2){lbr, lbi};
}
__device__ __forceinline__ void p0_transpose_item(const float* W, int K, int N, bf16* WT, LAS unsigned short* scr, int kb, int nb, int lane) {
    const int k0 = 64 * kb, n0 = 128 * nb;
    const float* wp = W + (size_t)(k0 + (lane >> 5)) * N + n0 + 4 * (lane & 31);
#pragma unroll
    for (int half = 0; half < 2; ++half) { f32x4 v[16];
#pragma unroll
        for (int i = 0; i < 16; ++i) v[i] = *(const GAS f32x4*)(wp + (size_t)(32 * half + 2 * i) * N);
#pragma unroll
        for (int i = 0; i < 16; ++i) { const int kk = 32 * half + 2 * i + (lane >> 5); LAS unsigned* d = (LAS unsigned*)(scr + kk * 130 + 4 * (lane & 31)); d[0] = pk2(v[i].x, v[i].y); d[1] = pk2(v[i].z, v[i].w); } }
    LDS_WAIT(); asm volatile("" ::: "memory");
    const int c = lane & 7;
#pragma unroll
    for (int j = 0; j < 16; ++j) { const int r = (lane >> 3) + 8 * j; const LAS unsigned short* sp = scr + (8 * c) * 130 + r;
        u32x4 o; o.x = (unsigned)sp[0] | ((unsigned)sp[130] << 16); o.y = (unsigned)sp[2 * 130] | ((unsigned)sp[3 * 130] << 16); o.z = (unsigned)sp[4 * 130] | ((unsigned)sp[5 * 130] << 16); o.w = (unsigned)sp[6 * 130] | ((unsigned)sp[7 * 130] << 16);
        *(GAS u32x4*)(WT + (size_t)(n0 + r) * K + k0 + 8 * c) = o; }
    LDS_WAIT(); asm volatile("" ::: "memory");
}
__device__ __forceinline__ void p0_transpose_item8(const float* W, int K, int N, unsigned char* WT, LAS unsigned short* scr, int kb, int nb, int lane) {
    const int k0 = 64 * kb, n0 = 128 * nb;
    const float* wp = W + (size_t)(k0 + (lane >> 5)) * N + n0 + 4 * (lane & 31);
#pragma unroll
    for (int half = 0; half < 2; ++half) { f32x4 v[16];
#pragma unroll
        for (int i = 0; i < 16; ++i) v[i] = *(const GAS f32x4*)(wp + (size_t)(32 * half + 2 * i) * N);
#pragma unroll
        for (int i = 0; i < 16; ++i) { const int kk = 32 * half + 2 * i + (lane >> 5); LAS unsigned* d = (LAS unsigned*)(scr + kk * 130 + 4 * (lane & 31)); d[0] = pk2(v[i].x, v[i].y); d[1] = pk2(v[i].z, v[i].w); } }
    LDS_WAIT(); asm volatile("" ::: "memory");
    const int c = lane & 7;
#pragma unroll
    for (int j = 0; j < 16; ++j) { const int r = (lane >> 3) + 8 * j; const LAS unsigned short* sp = scr + (8 * c) * 130 + r;
        u32x2 o; o.x = pk4_fp8(bf2f(sp[0]) * W8SCALE, bf2f(sp[130]) * W8SCALE, bf2f(sp[2 * 130]) * W8SCALE, bf2f(sp[3 * 130]) * W8SCALE);
        o.y = pk4_fp8(bf2f(sp[4 * 130]) * W8SCALE, bf2f(sp[5 * 130]) * W8SCALE, bf2f(sp[6 * 130]) * W8SCALE, bf2f(sp[7 * 130]) * W8SCALE);
        *(GAS u32x2*)(WT + (size_t)(n0 + r) * K + k0 + 8 * c) = o; }
    LDS_WAIT(); asm volatile("" ::: "memory");
}
__device__ __forceinline__ void p0_transpose_item8d(const float* W, int K, int N, unsigned char* WT, LAS unsigned short* scr, int kb, int nb, int lane) {
    const int k0 = 64 * kb, n0 = 128 * nb;
    const float* wp = W + (size_t)(k0 + (lane >> 5)) * N + n0 + 4 * (lane & 31);
    f32x4 v[32];
#pragma unroll
    for (int i = 0; i < 32; ++i) v[i] = *(const GAS f32x4*)(wp + (size_t)(2 * i) * N);
#pragma unroll
    for (int i = 0; i < 32; ++i) { const int kk = 2 * i + (lane >> 5); LAS unsigned* d = (LAS unsigned*)(scr + kk * 130 + 4 * (lane & 31)); d[0] = pk2(v[i].x, v[i].y); d[1] = pk2(v[i].z, v[i].w); }
    LDS_WAIT(); asm volatile("" ::: "memory");
    const int c = lane & 7;
#pragma unroll
    for (int j = 0; j < 16; ++j) { const int r = (lane >> 3) + 8 * j; const LAS unsigned short* sp = scr + (8 * c) * 130 + r;
        u32x2 o; o.x = pk4_fp8(bf2f(sp[0]) * W8SCALE, bf2f(sp[130]) * W8SCALE, bf2f(sp[2 * 130]) * W8SCALE, bf2f(sp[3 * 130]) * W8SCALE);
        o.y = pk4_fp8(bf2f(sp[4 * 130]) * W8SCALE, bf2f(sp[5 * 130]) * W8SCALE, bf2f(sp[6 * 130]) * W8SCALE, bf2f(sp[7 * 130]) * W8SCALE);
        *(GAS u32x2*)(WT + (size_t)(n0 + r) * K + k0 + 8 * c) = o; }
    LDS_WAIT(); asm volatile("" ::: "memory");
}
__device__ __forceinline__ void moe_weight_queue(Frame& F) {
    constexpr int W_GU1 = 32 * 32, W_DN1 = 16 * 32, W_GU = 32 * W_GU1, W_DN = 32 * W_DN1;
    LAS unsigned short* scr = (LAS unsigned short*)(F.lds + F.wave * 16640);
    const int lane = F.lane;
    __syncthreads();
    for (;;) {
        int r0 = 0;
        if (lane == 0) r0 = (int)__hip_atomic_fetch_add((unsigned*)(F.ctl + CW_QT), 4u, __ATOMIC_RELAXED, __HIP_MEMORY_SCOPE_AGENT);
        r0 = __builtin_amdgcn_readfirstlane(r0);
        if (r0 >= W_GU + W_DN) break;
#pragma unroll 1
        for (int sub = 0; sub < 4; ++sub) { const int r = r0 + sub;
            const float* W; unsigned char* WT; int N, kb, nb;
            if (r < W_GU) { const int e = r / W_GU1, q = r % W_GU1; W = F.in[IN_WGU] + (size_t)e * 2048 * 4096; WT = (unsigned char*)(F.ws + WS_WGU) + (size_t)e * 4096 * 2048; N = 4096; kb = q & 31; nb = q >> 5; }
            else { const int rr = r - W_GU; const int e = rr / W_DN1, q = rr % W_DN1; W = F.in[IN_WDN] + (size_t)e * 2048 * 2048; WT = (unsigned char*)(F.ws + WS_WDN) + (size_t)e * 2048 * 2048; N = 2048; kb = q & 31; nb = q >> 5; }
            const int K = 2048, k0 = 64 * kb, n0 = 128 * nb;
            const float* wp = W + (size_t)(k0 + (lane >> 5)) * N + n0 + 4 * (lane & 31);
            f32x4 v[32];
#pragma unroll
            for (int i = 0; i < 32; ++i) v[i] = __builtin_nontemporal_load((const GAS f32x4*)(wp + (size_t)(2 * i) * N));
            LAS unsigned char* sb = (LAS unsigned char*)scr;
#pragma unroll
            for (int i = 0; i < 32; ++i) { const int kk = 2 * i + (lane >> 5); *(LAS unsigned*)(sb + kk * 132 + 4 * (lane & 31)) = pk4_fp8(v[i].x * W8SCALE, v[i].y * W8SCALE, v[i].z * W8SCALE, v[i].w * W8SCALE); }
            LDS_WAIT(); asm volatile("" ::: "memory");
            const int c = lane & 7;
#pragma unroll
            for (int j = 0; j < 16; ++j) { const int rw = (lane >> 3) + 8 * j; const LAS unsigned char* sp = sb + (8 * c) * 132 + rw;
                u32x2 o; o.x = (unsigned)sp[0] | ((unsigned)sp[132] << 8) | ((unsigned)sp[2 * 132] << 16) | ((unsigned)sp[3 * 132] << 24);
                o.y = (unsigned)sp[4 * 132] | ((unsigned)sp[5 * 132] << 8) | ((unsigned)sp[6 * 132] << 16) | ((unsigned)sp[7 * 132] << 24);
                __builtin_nontemporal_store(o, (GAS u32x2*)(WT + (size_t)(n0 + rw) * K + k0 + 8 * c)); }
            LDS_WAIT(); asm volatile("" ::: "memory");
        }
    }
    __syncthreads();
}
__device__ __forceinline__ void p0_prologue(Frame& F) {
    for (int it = F.bx; it < 256; it += F.G) p0_adaln_item(F, it);
    for (int it = F.bx; it < 256; it += F.G) p0_filt_item(F, it);
    for (int it = F.bx; it < 16; it += F.G) p0_s5tab_item(F, it);
    { const float* rw = F.in[IN_RW]; float* RWT = (float*)(F.ws + WS_RWT);
      for (int i = F.bx * NTHR + F.tid; i < 32 * 2048; i += F.G * NTHR) { const int e = i >> 11, k = i & 2047; RWT[i] = rw[k * 32 + e]; } }
    __syncthreads();
    LAS unsigned short* scr = (LAS unsigned short*)(F.lds + F.wave * 16640);
    constexpr int I_IN = 64 * 4, I_GLU = 8 * 2, I_BS5 = 16 * 2, I_BHY = 16 * 2, I_O = 16 * 4;
    constexpr int NITEMS = I_IN + I_GLU + I_BS5 + I_BHY + I_O;
    const int w = F.wave;
    for (int it = F.bx; it < NITEMS; it += F.G) {
        int r = it;
        if (r < I_IN) { if ((r >> 2) < 32) p0_transpose_item(F.in[IN_WIN], 2048, 8192, (bf16*)(F.ws + WS_WIN), scr, 8 * (r & 3) + w, r >> 2, F.lane);
                        else p0_transpose_item8(F.in[IN_WIN], 2048, 8192, (unsigned char*)(F.ws + WS_WIN8) - (size_t)4096 * 2048, scr, 8 * (r & 3) + w, r >> 2, F.lane); continue; } r -= I_IN;
        if (r < I_GLU) { p0_transpose_item(F.in[IN_WGLU], 1024, 1024, (bf16*)(F.ws + WS_WGLU), scr, 8 * (r & 1) + w, r >> 1, F.lane); continue; } r -= I_GLU;
        if (r < I_BS5) { p0_transpose_item(F.in[IN_WBS5], 1024, 2048, (bf16*)(F.ws + WS_WBS5), scr, 8 * (r & 1) + w, r >> 1, F.lane); continue; } r -= I_BS5;
        if (r < I_BHY) { p0_transpose_item(F.in[IN_WBHY], 1024, 2048, (bf16*)(F.ws + WS_WBHY), scr, 8 * (r & 1) + w, r >> 1, F.lane); continue; } r -= I_BHY;
        { p0_transpose_item8(F.in[IN_WO], 2048, 2048, (unsigned char*)(F.ws + WS_WO), scr, 8 * (r & 3) + w, r >> 2, F.lane); }
    }
}

__device__ __forceinline__ void p1_norm(Frame& F) {
    const int gw = F.bx * NWAVES + F.wave, NGW = F.G * NWAVES;
    const float* MOD = (const float*)(F.ws + WS_MOD); const float* g1n = F.in[IN_N1G];
    bf16* U = (bf16*)(F.ws + WS_U);
    int curv = -1; f32x4 ga[8], sh[8];
    for (int m = gw; m < NTOK + NCTX; m += NGW) {
        const int v = (m < NTOK) ? (m >> 14) : 2;
        if (v != curv) { curv = v;
#pragma unroll
            for (int j = 0; j < 8; ++j) { const int k = 4 * F.lane + 256 * j; const f32x4 g = *(const f32x4*)(g1n + k), sc = *(const f32x4*)(MOD + v * 12288 + 2048 + k); ga[j] = g * (sc + 1.0f); sh[j] = *(const f32x4*)(MOD + v * 12288 + k); } }
        const float* xr = (m < NTOK) ? (F.in[IN_X] + (size_t)m * D) : (F.in[IN_CTX] + (size_t)(m - NTOK) * D);
        f32x4 x[8]; float s = 0.f;
#pragma unroll
        for (int j = 0; j < 8; ++j) { x[j] = *(const GAS f32x4*)(xr + 4 * F.lane + 256 * j); s += (x[j].x * x[j].x + x[j].y * x[j].y) + (x[j].z * x[j].z + x[j].w * x[j].w); }
        const float rstd = 1.0f / sqrtf(wave_sum(s) * (1.0f / D) + 1e-6f);
        GAS u32x2* o = (GAS u32x2*)(U + (size_t)m * D) + F.lane; GAS unsigned* o8 = (GAS unsigned*)(F.ws + WS_U8 + (size_t)m * D) + F.lane;
#pragma unroll
        for (int j = 0; j < 8; ++j) { const f32x4 y = x[j] * rstd * ga[j] + sh[j]; o[64 * j] = (u32x2){pk2(y.x, y.y), pk2(y.z, y.w)}; if (m < NTOK) o8[64 * j] = pk4_fp8(y.x, y.y, y.z, y.w); }
    }
}

struct SchedIn {
    int G, c, nmain, npn, mode, nrep;
    const char* A; const char* Bt;
    __device__ __forceinline__ bool next(int i, pg8::Unit& u) const {
        int L = i * G + c; u.e = 0; u.valid = 256; { const int tot = nmain + (mode == 0 ? 8 : 0); if (nrep > 1 && L >= tot && L < 2 * tot) L -= tot; }
        if (L < nmain) {
            int wgid = L; { const int q = nmain / 8, xcd = wgid % 8, off = wgid / 8; wgid = xcd * q + off; }
            const int nig = 8 * npn, gid = wgid / nig; const int pm = gid * 8 + ((wgid % nig) % 8), pl = (wgid % nig) / 8;
            u.pm = pm; u.pn = (mode == 0) ? pl : (mode == 1 ? pl + 4 : pl + 16); return true;
        }
        if (mode == 0 && L < nmain + 8) { const int q = L - nmain; u.pm = 128 + (q >> 2); u.pn = q & 3; return true; }
        return false;
    }
    __device__ __forceinline__ unsigned a_row(const pg8::Unit& u, int r) const { return (u.pm < 128) ? (unsigned)((u.pm >> 6) * SEQ + r * 64 + (u.pm & 63)) : (unsigned)(NTOK + (u.pm - 128) * 256 + r); }
    __device__ __forceinline__ const char* a_base() const { return A; }
    __device__ __forceinline__ const char* b_base(const pg8::Unit& u) const { return (mode == 2) ? Bt + (size_t)(u.pn - 16) * 256 * D : Bt + (size_t)u.pn * 256 * D * 2; }
};
__device__ __forceinline__ unsigned q8(float s) { return (unsigned)(s * 255.0f + 0.5f); }
struct EpiInG8 {
    static constexpr bool PERM = true, TRANS = true, FP8 = true;
    unsigned char* UG;
    __device__ __forceinline__ void operator()(const f32x4 (&acc)[2][2][4][2], const pg8::Unit& u, int wr, int wc, int fr, int fq) const {
        const int col0 = (u.pn - 16) * 256 + wc * 32 + 8 * fq;
#pragma unroll
        for (int ai = 0; ai < 2; ++ai)
#pragma unroll
            for (int m = 0; m < 4; ++m) { const int r = ai * 128 + wr * 64 + m * 16 + fr; const size_t row = (size_t)((u.pm >> 6) * SEQ + r * 64 + (u.pm & 63));
                unsigned char* rowp = UG + row * 4096 + col0;
#pragma unroll
                for (int bj = 0; bj < 2; ++bj) { f32x4 v0 = acc[ai][bj][m][0] * (1.0f / W8SCALE), v1 = acc[ai][bj][m][1] * (1.0f / W8SCALE);
#pragma unroll
                    for (int j = 0; j < 4; ++j) { v0[j] = sigmoidf_(v0[j]); v1[j] = sigmoidf_(v1[j]); }
                    u32x2 w; w.x = q8(v0[0]) | (q8(v0[1]) << 8) | (q8(v0[2]) << 16) | (q8(v0[3]) << 24); w.y = q8(v1[0]) | (q8(v1[1]) << 8) | (q8(v1[2]) << 16) | (q8(v1[3]) << 24);
                    *(u32x2*)(rowp + bj * 128) = w; } }
    }
};
struct EpiInA {
    static constexpr bool PERM = true, TRANS = true, FP8 = false;
    unsigned char* ws;
    __device__ __forceinline__ void operator()(const f32x4 (&acc)[2][2][4][2], const pg8::Unit& u, int wr, int wc, int fr, int fq) const {
        const bool isctx = u.pm >= 128, isg = u.pn >= 16;
        const size_t boff = isctx ? WS_UCA : (isg ? WS_UG : WS_UA);
        bf16* base = (bf16*)(ws + boff); const size_t ld = isg ? 4096 : S5W; const int colt = isg ? (u.pn - 16) * 256 : u.pn * 256;
        const int col0 = colt + wc * 32 + 8 * fq;
#pragma unroll
        for (int ai = 0; ai < 2; ++ai)
#pragma unroll
            for (int m = 0; m < 4; ++m) { const int r = ai * 128 + wr * 64 + m * 16 + fr;
                const size_t row = isctx ? (size_t)((u.pm - 128) * 256 + r) : (size_t)((u.pm >> 6) * SEQ + r * 64 + (u.pm & 63));
                bf16* rowp = base + row * ld + col0;
#pragma unroll
                for (int bj = 0; bj < 2; ++bj) { f32x4 v0 = acc[ai][bj][m][0], v1 = acc[ai][bj][m][1];
                    if (isg) {
#pragma unroll
                        for (int j = 0; j < 4; ++j) { v0[j] = sigmoidf_(v0[j]); v1[j] = sigmoidf_(v1[j]); } }
                    u32x4 w; w.x = cvt_pk_bf16(v0[0], v0[1]); w.y = cvt_pk_bf16(v0[2], v0[3]); w.z = cvt_pk_bf16(v1[0], v1[1]); w.w = cvt_pk_bf16(v1[2], v1[3]);
                    *(u32x4*)(rowp + bj * 128) = w; } }
    }
};
struct EpiInH {
    static constexpr bool PERM = false, TRANS = false, FP8 = false;
    bf16* UH;
    __device__ __forceinline__ void operator()(const f32x4 (&acc)[2][2][4][2], const pg8::Unit& u, int wr, int wc, int fr, int fq) const {
        const int b = u.pm >> 6, w = u.pm & 63;
#pragma unroll
        for (int bj = 0; bj < 2; ++bj)
#pragma unroll
            for (int n = 0; n < 2; ++n) { const int ch = (u.pn - 4) * 256 + bj * 128 + wc * 32 + n * 16 + fr;
                bf16* cp = UH + ((size_t)(b * 3072 + ch) * SEQ + w * 256);
#pragma unroll
                for (int ai = 0; ai < 2; ++ai)
#pragma unroll
                    for (int m = 0; m < 4; ++m) { const int r0 = ai * 128 + wr * 64 + m * 16 + 4 * fq; const f32x4 v = acc[ai][bj][m][n];
                        *(u32x2*)(cp + r0) = (u32x2){cvt_pk_bf16(v[0], v[1]), cvt_pk_bf16(v[2], v[3])}; } }
    }
};

template <bool PASSB>
__device__ __forceinline__ void s5_pass(Frame& F) {
    constexpr int nk = PASSB ? 256 : 260;
    constexpr int nitems = 2 * nk * 8;
    LAS unsigned char* sl = F.lds + F.wave * 8704;
    const int lane = F.lane, pl = lane & 31, hi = lane >> 5, fr = lane & 15, fq = lane >> 4;
    const bf16* UA = (const bf16*)(F.ws + WS_UA); const bf16* UCA = (const bf16*)(F.ws + WS_UCA);
    const bf16* BBT = (const bf16*)(F.ws + WS_BBT); const bf16* CTT = (const bf16*)(F.ws + WS_CTT); const f32x2* LAM = (const f32x2*)(F.ws + WS_LAM);
    f32x2* EB = (f32x2*)(F.ws + WS_E); const f32x2* SINB = (const f32x2*)(F.ws + WS_SIN); bf16* Y = (bf16*)(F.ws + WS_Y);
    const int s_r = 16 * ((pl >> 2) & 1) + 4 * (pl >> 3) + (pl & 3);
    for (int it = F.bx; it < nitems; it += F.G) {
        const int gq = it & 7, rest = it >> 3; const int b = rest / nk, kk = rest % nk; const int kc = PASSB ? kk + 4 : kk;
        const int g = gq * 8 + F.wave;
        const bf16* urow = (kc < 4) ? (UCA + (size_t)(b * CTX + kc * 64) * S5W + 16 * g) : (UA + (size_t)(b * SEQ + (kc - 4) * 64) * S5W + 16 * g);
        f32x4 yacc[4];
#pragma unroll
        for (int q = 0; q < 4; ++q) yacc[q] = (f32x4){0.f, 0.f, 0.f, 0.f};
#pragma unroll
        for (int d = 0; d < 2; ++d) {
            const int dg = d * 64 + g;
            bf16x8 bb[4];
#pragma unroll
            for (int ni = 0; ni < 4; ++ni) bb[ni] = *(const bf16x8*)(BBT + (size_t)(dg * 128 + 32 * ni + pl) * 16 + 8 * hi);
            bf16x8 ct[4];
            if (PASSB) {
#pragma unroll
                for (int ks = 0; ks < 4; ++ks) ct[ks] = *(const bf16x8*)(CTT + (size_t)(dg * 16 + fr) * 128 + 32 * ks + 8 * fq);
            }
            const f32x2 lamA = LAM[dg * 64 + pl], lamB = LAM[dg * 64 + pl + 32];
            f32x2 l2 = cmul(lamA, lamA), l4 = cmul(l2, l2), l8 = cmul(l4, l4); const f32x2 lam16A = cmul(l8, l8);
            l2 = cmul(lamB, lamB); l4 = cmul(l2, l2); l8 = cmul(l4, l4); const f32x2 lam16B = cmul(l8, l8);
            f32x2 cA = (f32x2){0.f, 0.f}, cB = (f32x2){0.f, 0.f};
            const size_t sidx = ((size_t)((d * 2 + b) * NCH + kc)) * 4096 + g * 64 + pl;
            if (PASSB) { cA = SINB[sidx]; cB = SINB[sidx + 32]; }
#pragma unroll
            for (int sc = 0; sc < 2; ++sc) {
                const int iscan = 32 * sc + s_r; const int tok = (d == 0) ? iscan : 63 - iscan;
                const bf16x8 a = *(const bf16x8*)(urow + (size_t)tok * S5W + 8 * hi);
                f32x16 acc[4];
#pragma unroll
                for (int ni = 0; ni < 4; ++ni) { f32x16 z;
#pragma unroll
                    for (int i = 0; i < 16; ++i) z[i] = 0.f;
                    acc[ni] = __builtin_amdgcn_mfma_f32_32x32x16_bf16(a, bb[ni], z, 0, 0, 0); }
                asm volatile("s_nop 7\n\ts_nop 7" : "+v"(acc[0]), "+v"(acc[1]), "+v"(acc[2]), "+v"(acc[3]) : "v"(a), "v"(bb[0]), "v"(bb[1]), "v"(bb[2]), "v"(bb[3]));
                f32x2 sA = hi ? (f32x2){0.f, 0.f} : cA, sB = hi ? (f32x2){0.f, 0.f} : cB;
#pragma unroll
                for (int i = 0; i < 16; ++i) {
                    sA = (f32x2){lamA.x * sA.x - lamA.y * sA.y + acc[0][i], lamA.x * sA.y + lamA.y * sA.x + acc[2][i]}; acc[0][i] = sA.x; acc[2][i] = sA.y;
                    sB = (f32x2){lamB.x * sB.x - lamB.y * sB.y + acc[1][i], lamB.x * sB.y + lamB.y * sB.x + acc[3][i]}; acc[1][i] = sB.x; acc[3][i] = sB.y; }
                const f32x2 pA = (f32x2){__shfl_xor(sA.x, 32), __shfl_xor(sA.y, 32)}, pB = (f32x2){__shfl_xor(sB.x, 32), __shfl_xor(sB.y, 32)};
                const f32x2 tA = cmul(lam16A, hi ? pA : sA), tB = cmul(lam16B, hi ? pB : sB);
                const f32x2 e1A = (hi ? sA : pA) + tA, e1B = (hi ? sB : pB) + tB;
                const f32x2 ciA = hi ? pA : (f32x2){0.f, 0.f}, ciB = hi ? pB : (f32x2){0.f, 0.f};
                if (PASSB) {
                    f32x2 wA = cmul(lamA, ciA), wB = cmul(lamB, ciB);
#pragma unroll
                    for (int i = 0; i < 16; ++i) {
                        acc[0][i] += wA.x; acc[2][i] += wA.y; acc[1][i] += wB.x; acc[3][i] += wB.y;
                        *(LAS u32x2*)(sl + (16 * hi + i) * 272 + pl * 8) = (u32x2){cvt_pk_bf16(acc[0][i], acc[2][i]), cvt_pk_bf16(acc[1][i], acc[3][i])};
                        wA = cmul(wA, lamA); wB = cmul(wB, lamB); }
                    bf16x8 bsv[2][4];
#pragma unroll
                    for (int tt = 0; tt < 2; ++tt) {
                        const int rowi = (d == 0) ? (16 * tt + fr) : (16 * tt + 15 - fr);
#pragma unroll
                        for (int ks = 0; ks < 4; ++ks) bsv[tt][ks] = *(const LAS bf16x8*)(sl + rowi * 272 + (32 * ks + 8 * fq) * 2);
                    }
#pragma unroll
                    for (int tt = 0; tt < 2; ++tt) {
                        const int tq = (d == 0) ? (2 * sc + tt) : (3 - 2 * sc - tt);
#pragma unroll
                        for (int ks = 0; ks < 4; ++ks) yacc[tq] = __builtin_amdgcn_mfma_f32_16x16x32_bf16(ct[ks], bsv[tt][ks], yacc[tq], 0, 0, 0);
                    }
                    asm volatile("s_nop 7\n\ts_nop 7" : "+v"(yacc[0]), "+v"(yacc[1]), "+v"(yacc[2]), "+v"(yacc[3]) : "v"(bsv[0][0]), "v"(bsv[0][1]), "v"(bsv[0][2]), "v"(bsv[0][3]), "v"(bsv[1][0]), "v"(bsv[1][1]), "v"(bsv[1][2]), "v"(bsv[1][3]), "v"(ct[0]), "v"(ct[1]), "v"(ct[2]), "v"(ct[3]));
                    asm volatile("s_waitcnt lgkmcnt(0)" ::: "memory");
                }
                cA = e1A; cB = e1B;
            }
            if (!PASSB) { if (hi == 0) { EB[sidx] = cA; EB[sidx + 32] = cB; } }
        }
        if (PASSB) {
            const f32x4 dsk = *(const f32x4*)(F.in[IN_S5D] + 16 * g + 4 * fq);
#pragma unroll
            for (int tq = 0; tq < 4; ++tq) { const int tok = 16 * tq + fr;
                const u32x2 uu = *(const u32x2*)(urow + (size_t)tok * S5W + 4 * fq);
                f32x4 v; v[0] = yacc[tq][0] + bflo(uu.x) * dsk[0]; v[1] = yacc[tq][1] + bfhi(uu.x) * dsk[1]; v[2] = yacc[tq][2] + bflo(uu.y) * dsk[2]; v[3] = yacc[tq][3] + bfhi(uu.y) * dsk[3];
#pragma unroll
                for (int j = 0; j < 4; ++j) { const float x = v[j]; v[j] = x * sigmoidf_(1.5957691216f * (x + 0.044715f * x * x * x)); }
                *(u32x2*)(Y + (size_t)(b * SEQ + (kc - 4) * 64 + tok) * S5W + 16 * g + 4 * fq) = (u32x2){cvt_pk_bf16(v[0], v[1]), cvt_pk_bf16(v[2], v[3])}; }
        }
    }
}
__device__ __forceinline__ void s5_pass_a_simple(Frame& F) {
    constexpr int nitems = 2 * NCH * 8;
    const int lane = F.lane;
    const bf16* UA = (const bf16*)(F.ws + WS_UA); const bf16* UCA = (const bf16*)(F.ws + WS_UCA);
    const bf16* BBT = (const bf16*)(F.ws + WS_BBT); const f32x2* LAM = (const f32x2*)(F.ws + WS_LAM); f32x2* EB = (f32x2*)(F.ws + WS_E);
    for (int it = F.bx; it < nitems; it += F.G) {
        const int gq = it & 7, rest = it >> 3; const int b = rest / NCH, kc = rest % NCH; const int g = gq * 8 + F.wave;
        const bf16* urow = (kc < 4) ? (UCA + (size_t)(b * CTX + kc * 64) * S5W + 16 * g) : (UA + (size_t)(b * SEQ + (kc - 4) * 64) * S5W + 16 * g);
#pragma unroll 1
        for (int d = 0; d < 2; ++d) {
            const int dg = d * 64 + g; const f32x2 lam = LAM[dg * 64 + lane];
            float bre[16], bim[16];
            { const u32x4 r0 = *(const u32x4*)(BBT + (size_t)(dg * 128 + lane) * 16), r1 = *(const u32x4*)(BBT + (size_t)(dg * 128 + lane) * 16 + 8);
              const u32x4 i0 = *(const u32x4*)(BBT + (size_t)(dg * 128 + 64 + lane) * 16), i1 = *(const u32x4*)(BBT + (size_t)(dg * 128 + 64 + lane) * 16 + 8);
              bre[0] = bflo(r0.x); bre[1] = bfhi(r0.x); bre[2] = bflo(r0.y); bre[3] = bfhi(r0.y); bre[4] = bflo(r0.z); bre[5] = bfhi(r0.z); bre[6] = bflo(r0.w); bre[7] = bfhi(r0.w);
              bre[8] = bflo(r1.x); bre[9] = bfhi(r1.x); bre[10] = bflo(r1.y); bre[11] = bfhi(r1.y); bre[12] = bflo(r1.z); bre[13] = bfhi(r1.z); bre[14] = bflo(r1.w); bre[15] = bfhi(r1.w);
              bim[0] = bflo(i0.x); bim[1] = bfhi(i0.x); bim[2] = bflo(i0.y); bim[3] = bfhi(i0.y); bim[4] = bflo(i0.z); bim[5] = bfhi(i0.z); bim[6] = bflo(i0.w); bim[7] = bfhi(i0.w);
              bim[8] = bflo(i1.x); bim[9] = bfhi(i1.x); bim[10] = bflo(i1.y); bim[11] = bfhi(i1.y); bim[12] = bflo(i1.z); bim[13] = bfhi(i1.z); bim[14] = bflo(i1.w); bim[15] = bfhi(i1.w); }
            f32x2 st = (f32x2){0.f, 0.f};
#pragma unroll 4
            for (int i = 0; i < 64; ++i) { const int tok = (d == 0) ? i : 63 - i;
                const u32x4 u0 = *(const u32x4*)(urow + (size_t)tok * S5W), u1 = *(const u32x4*)(urow + (size_t)tok * S5W + 8);
                float u[16]; u[0] = bflo(u0.x); u[1] = bfhi(u0.x); u[2] = bflo(u0.y); u[3] = bfhi(u0.y); u[4] = bflo(u0.z); u[5] = bfhi(u0.z); u[6] = bflo(u0.w); u[7] = bfhi(u0.w);
                u[8] = bflo(u1.x); u[9] = bfhi(u1.x); u[10] = bflo(u1.y); u[11] = bfhi(u1.y); u[12] = bflo(u1.z); u[13] = bfhi(u1.z); u[14] = bflo(u1.w); u[15] = bfhi(u1.w);
                float br = 0.f, bi = 0.f;
#pragma unroll
                for (int c = 0; c < 16; ++c) { br += bre[c] * u[c]; bi += bim[c] * u[c]; }
                st = (f32x2){lam.x * st.x - lam.y * st.y + br, lam.x * st.y + lam.y * st.x + bi}; }
            EB[((size_t)((d * 2 + b) * NCH + kc)) * 4096 + g * 64 + lane] = st;
        }
    }
}
__device__ __forceinline__ void s5_pass_b2(Frame& F) {
    constexpr int nitems = 2 * 256 * 8;
    LAS unsigned char* sl = F.lds + F.wave * 8704;
    const int lane = F.lane, fr = lane & 15, fq = lane >> 4;
    const bf16* UA = (const bf16*)(F.ws + WS_UA); const bf16* BBT = (const bf16*)(F.ws + WS_BBT); const bf16* CTT = (const bf16*)(F.ws + WS_CTT);
    const f32x2* LAM = (const f32x2*)(F.ws + WS_LAM); const f32x2* SINB = (const f32x2*)(F.ws + WS_SIN); bf16* Y = (bf16*)(F.ws + WS_Y);
    for (int it = F.bx; it < nitems; it += F.G) {
        const int gq = it & 7, rest = it >> 3; const int b = rest >> 8, kc = (rest & 255) + 4; const int g = gq * 8 + F.wave;
        const bf16* urow = UA + (size_t)(b * SEQ + (kc - 4) * 64) * S5W + 16 * g;
        f32x4 yacc[4];
#pragma unroll
        for (int q = 0; q < 4; ++q) yacc[q] = (f32x4){0.f, 0.f, 0.f, 0.f};
#pragma unroll
        for (int d = 0; d < 2; ++d) {
            const int dg = d * 64 + g; const f32x2 lam = LAM[dg * 64 + lane];
            float bre[16], bim[16];
            { const u32x4 r0 = *(const u32x4*)(BBT + (size_t)(dg * 128 + lane) * 16), r1 = *(const u32x4*)(BBT + (size_t)(dg * 128 + lane) * 16 + 8);
              const u32x4 i0 = *(const u32x4*)(BBT + (size_t)(dg * 128 + 64 + lane) * 16), i1 = *(const u32x4*)(BBT + (size_t)(dg * 128 + 64 + lane) * 16 + 8);
              bre[0] = bflo(r0.x); bre[1] = bfhi(r0.x); bre[2] = bflo(r0.y); bre[3] = bfhi(r0.y); bre[4] = bflo(r0.z); bre[5] = bfhi(r0.z); bre[6] = bflo(r0.w); bre[7] = bfhi(r0.w);
              bre[8] = bflo(r1.x); bre[9] = bfhi(r1.x); bre[10] = bflo(r1.y); bre[11] = bfhi(r1.y); bre[12] = bflo(r1.z); bre[13] = bfhi(r1.z); bre[14] = bflo(r1.w); bre[15] = bfhi(r1.w);
              bim[0] = bflo(i0.x); bim[1] = bfhi(i0.x); bim[2] = bflo(i0.y); bim[3] = bfhi(i0.y); bim[4] = bflo(i0.z); bim[5] = bfhi(i0.z); bim[6] = bflo(i0.w); bim[7] = bfhi(i0.w);
              bim[8] = bflo(i1.x); bim[9] = bfhi(i1.x); bim[10] = bflo(i1.y); bim[11] = bfhi(i1.y); bim[12] = bflo(i1.z); bim[13] = bfhi(i1.z); bim[14] = bflo(i1.w); bim[15] = bfhi(i1.w); }
            bf16x8 ct[4];
#pragma unroll
            for (int ks = 0; ks < 4; ++ks) ct[ks] = *(const bf16x8*)(CTT + (size_t)(dg * 16 + fr) * 128 + 32 * ks + 8 * fq);
            f32x2 st = SINB[((size_t)((d * 2 + b) * NCH + kc)) * 4096 + g * 64 + lane];
#pragma unroll
            for (int h = 0; h < 2; ++h) {
#pragma unroll 4
                for (int i = 0; i < 32; ++i) { const int sc = 32 * h + i; const int tok = (d == 0) ? sc : 63 - sc;
                    const u32x4 u0 = *(const u32x4*)(urow + (size_t)tok * S5W), u1 = *(const u32x4*)(urow + (size_t)tok * S5W + 8);
                    float u[16]; u[0] = bflo(u0.x); u[1] = bfhi(u0.x); u[2] = bflo(u0.y); u[3] = bfhi(u0.y); u[4] = bflo(u0.z); u[5] = bfhi(u0.z); u[6] = bflo(u0.w); u[7] = bfhi(u0.w);
                    u[8] = bflo(u1.x); u[9] = bfhi(u1.x); u[10] = bflo(u1.y); u[11] = bfhi(u1.y); u[12] = bflo(u1.z); u[13] = bfhi(u1.z); u[14] = bflo(u1.w); u[15] = bfhi(u1.w);
                    float br = 0.f, bi = 0.f;
#pragma unroll
                    for (int c = 0; c < 16; ++c) { br += bre[c] * u[c]; bi += bim[c] * u[c]; }
                    st = (f32x2){lam.x * st.x - lam.y * st.y + br, lam.x * st.y + lam.y * st.x + bi};
                    *(LAS unsigned*)(sl + (tok & 31) * 272 + lane * 4) = cvt_pk_bf16(st.x, st.y); }
                const int t0q = (d == 0) ? 2 * h : 2 * (1 - h);
                bf16x8 bsv[2][4];
#pragma unroll
                for (int tt = 0; tt < 2; ++tt)
#pragma unroll
                    for (int ks = 0; ks < 4; ++ks) bsv[tt][ks] = *(const LAS bf16x8*)(sl + (16 * tt + fr) * 272 + (32 * ks + 8 * fq) * 2);
#pragma unroll
                for (int tt = 0; tt < 2; ++tt)
#pragma unroll
                    for (int ks = 0; ks < 4; ++ks) yacc[t0q + tt] = __builtin_amdgcn_mfma_f32_16x16x32_bf16(ct[ks], bsv[tt][ks], yacc[t0q + tt], 0, 0, 0);
                asm volatile("s_nop 7\n\ts_nop 7" : "+v"(yacc[0]), "+v"(yacc[1]), "+v"(yacc[2]), "+v"(yacc[3]) : "v"(bsv[0][0]), "v"(bsv[0][1]), "v"(bsv[0][2]), "v"(bsv[0][3]), "v"(bsv[1][0]), "v"(bsv[1][1]), "v"(bsv[1][2]), "v"(bsv[1][3]), "v"(ct[0]), "v"(ct[1]), "v"(ct[2]), "v"(ct[3]));
                asm volatile("s_waitcnt lgkmcnt(0)" ::: "memory");
            }
        }
        const f32x4 dsk = *(const f32x4*)(F.in[IN_S5D] + 16 * g + 4 * fq);
#pragma unroll
        for (int tq = 0; tq < 4; ++tq) { const int tok = 16 * tq + fr;
            const u32x2 uu = *(const u32x2*)(urow + (size_t)tok * S5W + 4 * fq);
            f32x4 v; v[0] = yacc[tq][0] + bflo(uu.x) * dsk[0]; v[1] = yacc[tq][1] + bfhi(uu.x) * dsk[1]; v[2] = yacc[tq][2] + bflo(uu.y) * dsk[2]; v[3] = yacc[tq][3] + bfhi(uu.y) * dsk[3];
#pragma unroll
            for (int j = 0; j < 4; ++j) { const float x = v[j]; v[j] = x * sigmoidf_(1.5957691216f * (x + 0.044715f * x * x * x)); }
            *(u32x2*)(Y + (size_t)(b * SEQ + (kc - 4) * 64 + tok) * S5W + 16 * g + 4 * fq) = (u32x2){cvt_pk_bf16(v[0], v[1]), cvt_pk_bf16(v[2], v[3])}; }
    }
}
template <bool PASSB>
__device__ __forceinline__ void s5_pass3(Frame& F) {
    constexpr int nk = PASSB ? 256 : NCH; constexpr int nitems = 2 * nk * 8;
    LAS unsigned char* sl = F.lds + F.wave * 8704;
    const int lane = F.lane, fr = lane & 15, fq = lane >> 4;
    const bf16* UA = (const bf16*)(F.ws + WS_UA); const bf16* UCA = (const bf16*)(F.ws + WS_UCA); const bf16* BB2 = (const bf16*)(F.ws + WS_BB2); const bf16* CTT = (const bf16*)(F.ws + WS_CTT);
    const f32x2* LAM = (const f32x2*)(F.ws + WS_LAM); const f32x2* SINB = (const f32x2*)(F.ws + WS_SIN); f32x2* EB = (f32x2*)(F.ws + WS_E); bf16* Y = (bf16*)(F.ws + WS_Y);
    const bf16x8 zf = (bf16x8){0, 0, 0, 0, 0, 0, 0, 0};
    int curg = -1; bf16x8 af[2][8], ct[2][4]; f32x2 lamv[2]; f32x4 dsk = (f32x4){0.f, 0.f, 0.f, 0.f};
    for (int it = F.bx; it < nitems; it += F.G) {
        const int gq = it & 7, rest = it >> 3; const int b = rest / nk, kk = rest % nk; const int kc = PASSB ? kk + 4 : kk; const int g = gq * 8 + F.wave;
        if (g != curg) { curg = g;
#pragma unroll
            for (int d = 0; d < 2; ++d) { const int dg = d * 64 + g; lamv[d] = LAM[dg * 64 + lane];
#pragma unroll
                for (int nt = 0; nt < 8; ++nt) af[d][nt] = (fq < 2) ? *(const bf16x8*)(BB2 + (size_t)(dg * 128 + 16 * nt + fr) * 16 + 8 * fq) : zf;
                if (PASSB) {
#pragma unroll
                    for (int ks = 0; ks < 4; ++ks) ct[d][ks] = *(const bf16x8*)(CTT + (size_t)(dg * 16 + fr) * 128 + 32 * ks + 8 * fq); } }
            if (PASSB) dsk = *(const f32x4*)(F.in[IN_S5D] + 16 * g + 4 * fq); }
        const bf16* urow = (kc < 4) ? (UCA + (size_t)(b * CTX + kc * 64) * S5W + 16 * g) : (UA + (size_t)(b * SEQ + (kc - 4) * 64) * S5W + 16 * g);
        bf16x8 uf[4];
#pragma unroll
        for (int q = 0; q < 4; ++q) uf[q] = (fq < 2) ? *(const bf16x8*)(urow + (size_t)(16 * q + fr) * S5W + 8 * fq) : zf;
        u32x2 uu[4];
        if (PASSB) {
#pragma unroll
            for (int tq = 0; tq < 4; ++tq) uu[tq] = *(const u32x2*)(urow + (size_t)(16 * tq + fr) * S5W + 4 * fq); }
        f32x2 st0[2];
#pragma unroll
        for (int d = 0; d < 2; ++d) st0[d] = PASSB ? SINB[((size_t)((d * 2 + b) * NCH + kc)) * 4096 + g * 64 + lane] : (f32x2){0.f, 0.f};
        f32x4 yacc[4];
#pragma unroll
        for (int q = 0; q < 4; ++q) yacc[q] = (f32x4){0.f, 0.f, 0.f, 0.f};
#pragma unroll
        for (int d = 0; d < 2; ++d) {
            const f32x2 lam = lamv[d]; f32x2 st = st0[d];
#pragma unroll
            for (int h = 0; h < 2; ++h) {
                const int T0 = (d == 0) ? 32 * h : 32 * (1 - h);
#pragma unroll
                for (int tt = 0; tt < 2; ++tt)
#pragma unroll
                    for (int nt = 0; nt < 8; ++nt) { const f32x4 dd = __builtin_amdgcn_mfma_f32_16x16x32_bf16(af[d][nt], uf[(T0 >> 4) + tt], (f32x4){0.f, 0.f, 0.f, 0.f}, 0, 0, 0);
                        *(LAS u32x2*)(sl + (16 * tt + fr) * 272 + (16 * nt + 4 * fq) * 2) = (u32x2){cvt_pk_bf16(dd[0], dd[1]), cvt_pk_bf16(dd[2], dd[3])}; }
                asm volatile("s_waitcnt lgkmcnt(0)" ::: "memory");
#pragma unroll 8
                for (int i = 0; i < 32; ++i) { const int r = (d == 0) ? i : 31 - i; LAS unsigned* cell = (LAS unsigned*)(sl + r * 272 + lane * 4);
                    const unsigned w = *cell; const float br = bflo(w), bi = bfhi(w);
                    st = (f32x2){lam.x * st.x - lam.y * st.y + br, lam.x * st.y + lam.y * st.x + bi};
                    if (PASSB) *cell = cvt_pk_bf16(st.x, st.y); }
                if (PASSB) {
                    const int t0q = T0 >> 4;
                    bf16x8 bsv[2][4];
#pragma unroll
                    for (int tt = 0; tt < 2; ++tt)
#pragma unroll
                        for (int ks = 0; ks < 4; ++ks) bsv[tt][ks] = *(const LAS bf16x8*)(sl + (16 * tt + fr) * 272 + (32 * ks + 8 * fq) * 2);
#pragma unroll
                    for (int tt = 0; tt < 2; ++tt)
#pragma unroll
                        for (int ks = 0; ks < 4; ++ks) yacc[t0q + tt] = __builtin_amdgcn_mfma_f32_16x16x32_bf16(ct[d][ks], bsv[tt][ks], yacc[t0q + tt], 0, 0, 0);
                    asm volatile("s_nop 7\n\ts_nop 7" : "+v"(yacc[0]), "+v"(yacc[1]), "+v"(yacc[2]), "+v"(yacc[3]) : "v"(bsv[0][0]), "v"(bsv[0][1]), "v"(bsv[0][2]), "v"(bsv[0][3]), "v"(bsv[1][0]), "v"(bsv[1][1]), "v"(bsv[1][2]), "v"(bsv[1][3]));
                }
                asm volatile("s_waitcnt lgkmcnt(0)" ::: "memory");
            }
            if (!PASSB) EB[((size_t)((d * 2 + b) * NCH + kc)) * 4096 + g * 64 + lane] = st;
        }
        if (PASSB) {
#pragma unroll
            for (int tq = 0; tq < 4; ++tq) { const int tok = 16 * tq + fr;
                f32x4 v; v[0] = yacc[tq][0] + bflo(uu[tq].x) * dsk[0]; v[1] = yacc[tq][1] + bfhi(uu[tq].x) * dsk[1]; v[2] = yacc[tq][2] + bflo(uu[tq].y) * dsk[2]; v[3] = yacc[tq][3] + bfhi(uu[tq].y) * dsk[3];
#pragma unroll
                for (int j = 0; j < 4; ++j) { const float x = v[j]; v[j] = x * sigmoidf_(1.5957691216f * (x + 0.044715f * x * x * x)); }
                *(u32x2*)(Y + (size_t)(b * SEQ + (kc - 4) * 64 + tok) * S5W + 16 * g + 4 * fq) = (u32x2){cvt_pk_bf16(v[0], v[1]), cvt_pk_bf16(v[2], v[3])}; }
        }
    }
}
__device__ __forceinline__ void s5_carry_item(Frame& F, int item) {
    const int idx = item * NTHR + F.tid; const int d = idx >> 13, b = (idx >> 12) & 1, gp = idx & 4095;
    const f32x2 lam = ((const f32x2*)(F.ws + WS_LAM))[d * 4096 + gp];
    f32x2 l = cmul(lam, lam); l = cmul(l, l); l = cmul(l, l); l = cmul(l, l); l = cmul(l, l); l = cmul(l, l);
    const f32x2* EB = (const f32x2*)(F.ws + WS_E) + (size_t)((d * 2 + b) * NCH) * 4096 + gp; f32x2* SB = (f32x2*)(F.ws + WS_SIN) + (size_t)((d * 2 + b) * NCH) * 4096 + gp;
    f32x2 s = (f32x2){0.f, 0.f};
#pragma unroll 1
    for (int st0 = 0; st0 < NCH; st0 += 20) { f32x2 e[20];
#pragma unroll
        for (int j = 0; j < 20; ++j) { const int st = st0 + j; const int kc = (d == 0) ? st : (st < 4 ? 3 - st : NCH + 3 - st); e[j] = EB[(size_t)kc * 4096]; }
#pragma unroll
        for (int j = 0; j < 20; ++j) { const int st = st0 + j; const int kc = (d == 0) ? st : (st < 4 ? 3 - st : NCH + 3 - st); SB[(size_t)kc * 4096] = s; s = cmul(l, s) + e[j]; } }
}

__device__ __forceinline__ int fsw(int i) { return i ^ ((i >> 5) & 7) ^ (((i >> 6) & 3) << 3); }
__host__ __device__ constexpr float w16c(int j) { return j == 0 ? 1.f : j == 1 ? 0.9238795325f : j == 2 ? 0.7071067812f : j == 3 ? 0.3826834324f : j == 4 ? 0.f : j == 5 ? -0.3826834324f : j == 6 ? -0.7071067812f : -0.9238795325f; }
__host__ __device__ constexpr float w16s(int j) { return j == 0 ? 0.f : j == 1 ? 0.3826834324f : j == 2 ? 0.7071067812f : j == 3 ? 0.9238795325f : j == 4 ? 1.f : j == 5 ? 0.9238795325f : j == 6 ? 0.7071067812f : 0.3826834324f; }
__host__ __device__ constexpr int bitrev(int q, int bits) { int r = 0; for (int i = 0; i < bits; ++i) r |= ((q >> i) & 1) << (bits - 1 - i); return r; }
template <int R, bool INV> __device__ __forceinline__ void dft_reg(f32x2 (&x)[R]) {
#pragma unroll
    for (int len = R; len >= 2; len >>= 1) { const int half = len >> 1, step = 16 / len;
#pragma unroll
        for (int b0 = 0; b0 < R; b0 += len)
#pragma unroll
            for (int k = 0; k < half; ++k) { const f32x2 a = x[b0 + k], b = x[b0 + k + half]; x[b0 + k] = a + b; const f32x2 dd = a - b; const int j = k * step;
                if (j == 0) x[b0 + k + half] = dd;
                else if (j == 4) x[b0 + k + half] = INV ? (f32x2){-dd.y, dd.x} : (f32x2){dd.y, -dd.x};
                else { const float c = w16c(j), s = w16s(j); x[b0 + k + half] = INV ? (f32x2){dd.x * c - dd.y * s, dd.x * s + dd.y * c} : (f32x2){dd.x * c + dd.y * s, dd.y * c - dd.x * s}; } } }
}
template <int R, int LOGN, bool INV> __device__ __forceinline__ void fft_pass(LAS f32x2* buf, int tid) {
    constexpr int LOGR = (R == 16) ? 4 : 3, LOGM = LOGN - LOGR, M = 1 << LOGM, NBF = 16384 / R / NTHR;
#pragma unroll 1
    for (int it = 0; it < NBF; ++it) {
        int tl = tid; asm volatile("" : "+v"(tl));
        const int bq = tl + NTHR * it, blk = bq >> LOGM, j = bq & (M - 1), base = (blk << LOGN) + j; const int fb = fsw(base);
#define FADDR(q) (fb ^ (((q) << LOGM) ^ ((((q) << LOGM) >> 5) & 7) ^ (((((q) << LOGM) >> 6) & 3) << 3)))
        f32x2 x[R];
#pragma unroll
        for (int q = 0; q < R; ++q) x[q] = buf[FADDR(q)];
        f32x2 w1 = (f32x2){1.f, 0.f};
        if (LOGM > 0) { const float rev = (float)j * (1.0f / (float)(1 << LOGN)); const float sn = sin_rev(rev); w1 = (f32x2){cos_rev(rev), INV ? sn : -sn}; }
        if (!INV) {
            dft_reg<R, false>(x);
            buf[fb] = x[0]; f32x2 w = w1;
#pragma unroll
            for (int q = 1; q < R; ++q) { buf[FADDR(q)] = (LOGM > 0) ? cmul(x[bitrev(q, LOGR)], w) : x[bitrev(q, LOGR)]; if (LOGM > 0) w = cmul(w, w1); }
        } else {
            if (LOGM > 0) { f32x2 w = w1;
#pragma unroll
                for (int q = 1; q < R; ++q) { x[q] = cmul(x[q], w); w = cmul(w, w1); } }
            dft_reg<R, true>(x);
#pragma unroll
            for (int q = 0; q < R; ++q) buf[FADDR(q)] = x[bitrev(q, LOGR)];
        }
#undef FADDR
    }
    __syncthreads();
}
#ifndef FFT_TEST
#define FFT_TEST 0
#endif
__device__ __forceinline__ void fft_fwd(LAS f32x2* buf, int tid) { if (FFT_TEST & 1) return; fft_pass<16, 14, false>(buf, tid); fft_pass<16, 10, false>(buf, tid); fft_pass<8, 6, false>(buf, tid); fft_pass<8, 3, false>(buf, tid); }
__device__ __forceinline__ void fft_inv(LAS f32x2* buf, int tid) { if (FFT_TEST & 2) return; fft_pass<8, 3, true>(buf, tid); fft_pass<8, 6, true>(buf, tid); fft_pass<16, 10, true>(buf, tid); fft_pass<16, 14, true>(buf, tid); }
__device__ __forceinline__ float block_sum(Frame& F, float v) {
    LAS float* red = (LAS float*)(F.lds + LDS_X);
    v = wave_sum(v); __syncthreads(); if (F.lane == 0) red[F.wave] = v; __syncthreads();
    float s = 0.f;
#pragma unroll
    for (int w = 0; w < NWAVES; ++w) s += red[w];
    return s;
}
__device__ __forceinline__ float sconv(const bf16* UH, int b, int ch, int t, float w0, float w1, float w2) {
    const bf16* p = UH + (size_t)(b * 3072 + ch) * SEQ;
    const int tm = t > 0 ? t - 1 : 0, tp = t < SEQ - 1 ? t + 1 : SEQ - 1;
    const float xm = bf2f(p[tm]), x0 = bf2f(p[t]), xp = bf2f(p[tp]);
    return w0 * (t > 0 ? xm : 0.f) + w1 * x0 + w2 * (t < SEQ - 1 ? xp : 0.f);
}
#define HY_UNPK(w) ((f32x2){bflo(w), bfhi(w)})
template <bool INV, class LD, class ST>
__device__ __forceinline__ void fft_edge_pass(LAS f32x2* buf, int tid, LD& ld, ST& st) {
    constexpr int R = 16, LOGN = 14, LOGM = 10;
#pragma unroll
    for (int it = 0; it < 2; ++it) {
        int tl = tid; asm volatile("" : "+v"(tl));
        const int j = tl + NTHR * it; const int fb = fsw(j);
        f32x2 x[R];
#pragma unroll
        for (int q = 0; q < R; ++q) x[q] = ld(2 * q + it, j + (q << LOGM), fb + (q << LOGM));
        const float rev = (float)j * (1.0f / 16384.0f); const float sn = sin_rev(rev); const f32x2 w1 = (f32x2){cos_rev(rev), INV ? sn : -sn};
        if (!INV) {
            dft_reg<R, false>(x);
            st(it, j, fb, x[0]); f32x2 w = w1;
#pragma unroll
            for (int q = 1; q < R; ++q) { st(2 * q + it, j + (q << LOGM), fb + (q << LOGM), cmul(x[bitrev(q, 4)], w)); w = cmul(w, w1); }
        } else {
            f32x2 w = w1;
#pragma unroll
            for (int q = 1; q < R; ++q) { x[q] = cmul(x[q], w); w = cmul(w, w1); }
            dft_reg<R, true>(x);
#pragma unroll
            for (int q = 0; q < R; ++q) st(2 * q + it, j + (q << LOGM), fb + (q << LOGM), x[bitrev(q, 4)]);
        }
        __builtin_amdgcn_sched_barrier(0);
    }
}
__device__ __forceinline__ void fft_last_to_ks(LAS f32x2* buf, int tid, unsigned* KS, float scale) {
#pragma unroll 1
    for (int it = 0; it < 4; ++it) { int tl = tid; asm volatile("" : "+v"(tl)); const int b = tl + NTHR * it; const int fb = fsw(8 * b);
        f32x2 x[8];
#pragma unroll
        for (int q = 0; q < 8; ++q) x[q] = buf[fb ^ q];
        dft_reg<8, false>(x);
        u32x4 o0, o1; f32x2 v;
        v = x[bitrev(0, 3)] * scale; o0.x = cvt_pk_bf16(v.x, v.y); v = x[bitrev(1, 3)] * scale; o0.y = cvt_pk_bf16(v.x, v.y); v = x[bitrev(2, 3)] * scale; o0.z = cvt_pk_bf16(v.x, v.y); v = x[bitrev(3, 3)] * scale; o0.w = cvt_pk_bf16(v.x, v.y);
        v = x[bitrev(4, 3)] * scale; o1.x = cvt_pk_bf16(v.x, v.y); v = x[bitrev(5, 3)] * scale; o1.y = cvt_pk_bf16(v.x, v.y); v = x[bitrev(6, 3)] * scale; o1.z = cvt_pk_bf16(v.x, v.y); v = x[bitrev(7, 3)] * scale; o1.w = cvt_pk_bf16(v.x, v.y);
        *(GAS u32x4*)(KS + 8 * b) = o0; *(GAS u32x4*)(KS + 8 * b + 4) = o1; }
}
__device__ __forceinline__ void fft_mid_mul(LAS f32x2* buf, int tid, const unsigned* KS) {
#pragma unroll 2
    for (int it = 0; it < 4; ++it) { int tl = tid; asm volatile("" : "+v"(tl)); const int b = tl + NTHR * it; const int fb = fsw(8 * b);
        const u32x4 k0 = *(const GAS u32x4*)(KS + 8 * b), k1 = *(const GAS u32x4*)(KS + 8 * b + 4);
        f32x2 x[8], y[8];
#pragma unroll
        for (int q = 0; q < 8; ++q) x[q] = buf[fb ^ q];
        dft_reg<8, false>(x);
        y[0] = cmul(x[bitrev(0, 3)], HY_UNPK(k0.x)); y[1] = cmul(x[bitrev(1, 3)], HY_UNPK(k0.y)); y[2] = cmul(x[bitrev(2, 3)], HY_UNPK(k0.z)); y[3] = cmul(x[bitrev(3, 3)], HY_UNPK(k0.w));
        y[4] = cmul(x[bitrev(4, 3)], HY_UNPK(k1.x)); y[5] = cmul(x[bitrev(5, 3)], HY_UNPK(k1.y)); y[6] = cmul(x[bitrev(6, 3)], HY_UNPK(k1.z)); y[7] = cmul(x[bitrev(7, 3)], HY_UNPK(k1.w));
        dft_reg<8, true>(y);
#pragma unroll
        for (int q = 0; q < 8; ++q) buf[fb ^ q] = y[bitrev(q, 3)]; }
    __syncthreads();
}
struct HyStLds { LAS f32x2* buf; __device__ __forceinline__ void operator()(int, int, int addr, f32x2 v) { buf[addr] = v; } };
struct HyLdLds { LAS f32x2* buf; __device__ __forceinline__ f32x2 operator()(int, int, int addr) { return buf[addr]; } };
struct HyLdKc { const bf16* f0; const bf16* f1; float part; __device__ __forceinline__ f32x2 operator()(int, int t, int) { const float a0 = bf2f(f0[t]), r1 = (t == 0) ? 0.f : bf2f(f1[SEQ - t]); part += fabsf(a0) + fabsf(r1); return (f32x2){a0 + r1, 0.f}; } };
struct HyLdKn { const bf16* f0; const bf16* f1; __device__ __forceinline__ f32x2 operator()(int, int t, int) { const float a0 = bf2f(f0[t]), r1 = (t == 0) ? 0.f : bf2f(f1[SEQ - t]); const float rev = (float)t * (1.0f / 32768.0f), v = a0 - r1; return (f32x2){v * cos_rev(rev), v * sin_rev(rev)}; } };
struct HyLdZ { const unsigned* z; __device__ __forceinline__ f32x2 operator()(int k, int, int) { return HY_UNPK(z[k]); } };
struct HyLdZpsi { const unsigned* z; __device__ __forceinline__ f32x2 operator()(int k, int t, int) { const float rev = (float)t * (1.0f / 32768.0f); return cmul(HY_UNPK(z[k]), (f32x2){cos_rev(rev), sin_rev(rev)}); } };
struct HyStYc { unsigned* yc; __device__ __forceinline__ void operator()(int k, int, int, f32x2 v) { const f32x2 w = v * (0.5f / 16384.0f); yc[k] = cvt_pk_bf16(w.x, w.y); } };
struct HyStComb { unsigned* z; const unsigned* yc; float bias;
    __device__ __forceinline__ void operator()(int k, int t, int, f32x2 v) { const float rev = (float)t * (1.0f / 32768.0f);
        const f32x2 yn = cmul(v, (f32x2){cos_rev(rev), -sin_rev(rev)}) * (0.5f / 16384.0f); const f32x2 y = yn + HY_UNPK(yc[k]) + HY_UNPK(z[k]) * bias; z[k] = cvt_pk_bf16(y.x, y.y); } };
template <bool NEG> __device__ __forceinline__ float hy_load_kernel(LAS f32x2* buf, int tid, const bf16* f0, const bf16* f1) {
    float part = 0.f;
#pragma unroll 2
    for (int r = 0; r < 4; ++r) { int tl = tid; asm volatile("" : "+v"(tl)); const int t0 = 8 * (tl + NTHR * r); const int fb = fsw(t0); float a[8], q[8];
        const u32x4 va = *(const GAS u32x4*)(f0 + t0), vr = *(const GAS u32x4*)(f1 + SEQ - t0 - 8); const float r0 = bf2f(f1[t0 > 0 ? SEQ - t0 : 0]);
        a[0] = bflo(va.x); a[1] = bfhi(va.x); a[2] = bflo(va.y); a[3] = bfhi(va.y); a[4] = bflo(va.z); a[5] = bfhi(va.z); a[6] = bflo(va.w); a[7] = bfhi(va.w);
        q[0] = t0 > 0 ? r0 : 0.f; q[1] = bfhi(vr.w); q[2] = bflo(vr.w); q[3] = bfhi(vr.z); q[4] = bflo(vr.z); q[5] = bfhi(vr.y); q[6] = bflo(vr.y); q[7] = bfhi(vr.x);
#pragma unroll
        for (int e = 0; e < 8; ++e) {
            if (!NEG) { part += fabsf(a[e]) + fabsf(q[e]); buf[fb ^ e] = (f32x2){a[e] + q[e], 0.f}; }
            else { const float rev = (float)(t0 + e) * (1.0f / 32768.0f), v = a[e] - q[e]; buf[fb ^ e] = (f32x2){v * cos_rev(rev), v * sin_rev(rev)}; } } }
    return part;
}
__device__ __forceinline__ void hy_conv8(const u32x4 v, float hm, float hp, float w0, float w1, float w2, float (&o)[8]) {
    const float x1 = bflo(v.x), x2 = bfhi(v.x), x3 = bflo(v.y), x4 = bfhi(v.y), x5 = bflo(v.z), x6 = bfhi(v.z), x7 = bflo(v.w), x8 = bfhi(v.w);
    o[0] = w0 * hm + w1 * x1 + w2 * x2; o[1] = w0 * x1 + w1 * x2 + w2 * x3; o[2] = w0 * x2 + w1 * x3 + w2 * x4; o[3] = w0 * x3 + w1 * x4 + w2 * x5;
    o[4] = w0 * x4 + w1 * x5 + w2 * x6; o[5] = w0 * x5 + w1 * x6 + w2 * x7; o[6] = w0 * x6 + w1 * x7 + w2 * x8; o[7] = w0 * x7 + w1 * x8 + w2 * hp;
}
__device__ __forceinline__ void hy_load_conv(LAS f32x2* buf, int tid, const bf16* UH, int ch, float w0, float w1, float w2) {
    const bf16* p0 = UH + (size_t)ch * SEQ; const bf16* p1 = UH + (size_t)(3072 + ch) * SEQ;
#pragma unroll 2
    for (int r = 0; r < 4; ++r) { int tl = tid; asm volatile("" : "+v"(tl)); const int t0 = 8 * (tl + NTHR * r); const int fb = fsw(t0);
        const int tm = t0 > 0 ? t0 - 1 : 0, tp = t0 + 8 < SEQ ? t0 + 8 : SEQ - 1;
        const u32x4 va = *(const GAS u32x4*)(p0 + t0), vb = *(const GAS u32x4*)(p1 + t0);
        float am = bf2f(p0[tm]), ap = bf2f(p0[tp]), bm = bf2f(p1[tm]), bp = bf2f(p1[tp]);
        if (t0 == 0) { am = 0.f; bm = 0.f; } if (t0 + 8 >= SEQ) { ap = 0.f; bp = 0.f; }
        float oa[8], ob[8]; hy_conv8(va, am, ap, w0, w1, w2, oa); hy_conv8(vb, bm, bp, w0, w1, w2, ob);
        buf[fb ^ 0] = (f32x2){oa[0], ob[0]}; buf[fb ^ 1] = (f32x2){oa[1], ob[1]}; buf[fb ^ 2] = (f32x2){oa[2], ob[2]}; buf[fb ^ 3] = (f32x2){oa[3], ob[3]};
        buf[fb ^ 4] = (f32x2){oa[4], ob[4]}; buf[fb ^ 5] = (f32x2){oa[5], ob[5]}; buf[fb ^ 6] = (f32x2){oa[6], ob[6]}; buf[fb ^ 7] = (f32x2){oa[7], ob[7]}; }
}
__device__ __forceinline__ void hyena_item(Frame& F, int c) {
    LAS f32x2* buf = (LAS f32x2*)F.lds;
    unsigned* KS = (unsigned*)(F.ws + WS_HYS + (size_t)F.bx * HYS_STRIDE);
    const bf16* FILT = (const bf16*)(F.ws + WS_FILT); const bf16* UH = (const bf16*)(F.ws + WS_UH);
    const int tid = F.tid; const int ft = fsw(tid);
#define FB(k) buf[ft + NTHR * (k)]
    const float* sw = F.in[IN_HSW];
    unsigned z[32], yc[32];
    HyStLds stl{buf}; HyLdLds ldl{buf};
    hy_load_conv(buf, tid, UH, c, sw[c], sw[3072 + c], sw[6144 + c]);
    __syncthreads();
#pragma unroll
    for (int k = 0; k < 32; ++k) { const f32x2 v_ = FB(k); z[k] = cvt_pk_bf16(v_.x, v_.y); }
#pragma unroll 1
    for (int o = 0; o < 2; ++o) {
        const bf16* f0 = FILT + (size_t)(o * 1024 + c) * SEQ; const bf16* f1 = FILT + (size_t)(2048 + o * 1024 + c) * SEQ;
        __syncthreads();
        const float part = hy_load_kernel<false>(buf, tid, f0, f1);
        const float inv = 1.0f / (block_sum(F, part) + 1e-6f);
        fft_edge_pass<false>(buf, tid, ldl, stl); __syncthreads();
        fft_pass<16, 10, false>(buf, tid); fft_pass<8, 6, false>(buf, tid);
        fft_last_to_ks(buf, tid, KS, inv); __syncthreads();
        { HyLdZ ldz{z}; fft_edge_pass<false>(buf, tid, ldz, stl); __syncthreads(); }
        fft_pass<16, 10, false>(buf, tid); fft_pass<8, 6, false>(buf, tid);
        fft_mid_mul(buf, tid, KS);
        fft_pass<8, 6, true>(buf, tid); fft_pass<16, 10, true>(buf, tid);
        { HyStYc styc{yc}; fft_edge_pass<true>(buf, tid, ldl, styc); }
        __syncthreads();
        (void)hy_load_kernel<true>(buf, tid, f0, f1); __syncthreads();
        fft_edge_pass<false>(buf, tid, ldl, stl); __syncthreads();
        fft_pass<16, 10, false>(buf, tid); fft_pass<8, 6, false>(buf, tid);
        fft_last_to_ks(buf, tid, KS, inv); __syncthreads();
        { HyLdZpsi ldzp{z}; fft_edge_pass<false>(buf, tid, ldzp, stl); __syncthreads(); }
        fft_pass<16, 10, false>(buf, tid); fft_pass<8, 6, false>(buf, tid);
        fft_mid_mul(buf, tid, KS);
        fft_pass<8, 6, true>(buf, tid); fft_pass<16, 10, true>(buf, tid);
        { HyStComb stc{z, yc, F.in[IN_HBIAS][o * 1024 + c]}; fft_edge_pass<true>(buf, tid, ldl, stc); }
#pragma unroll
        for (int k = 0; k < 32; ++k) FB(k) = HY_UNPK(z[k]);
        { const int xch = (o + 1) * 1024 + c; const float w0 = sw[xch], w1 = sw[3072 + xch], w2 = sw[6144 + xch];
#pragma unroll 8
          for (int k = 0; k < 32; ++k) { const int t = tid + NTHR * k; f32x2 v_ = FB(k); v_.x *= sconv(UH, 0, xch, t, w0, w1, w2); v_.y *= sconv(UH, 1, xch, t, w0, w1, w2); FB(k) = v_; } }
#pragma unroll
        for (int k = 0; k < 32; ++k) { const f32x2 v_ = FB(k); z[k] = cvt_pk_bf16(v_.x, v_.y); }
        __syncthreads();
    }
    bf16* YHCM = (bf16*)(F.ws + WS_YHCM);
#pragma unroll
    for (int k = 0; k < 32; ++k) FB(k) = HY_UNPK(z[k]);
#pragma unroll 8
    for (int k = 0; k < 32; ++k) { const int t = tid + NTHR * k; const f32x2 v_ = FB(k); YHCM[(size_t)c * SEQ + t] = (bf16)f2bf(v_.x); YHCM[(size_t)(1024 + c) * SEQ + t] = (bf16)f2bf(v_.y); }
    __syncthreads();
#undef FB
}
__device__ __forceinline__ void p4_hyena_carry(Frame& F, int qw) {
    volatile LAS int* qs = (volatile LAS int*)(F.lds + MISC_OFF + 64);
    for (;;) {
        __syncthreads();
        if (F.tid == 0) qs[0] = (int)__hip_atomic_fetch_add((unsigned*)(F.ctl + qw), 1u, __ATOMIC_RELAXED, __HIP_MEMORY_SCOPE_AGENT);
        __syncthreads();
        const int q = qs[0];
        if (q >= 32 + 1024) break;
        if (q < 1024) hyena_item(F, q); else s5_carry_item(F, q - 1024);
    }
}
__device__ __forceinline__ void yh_transpose(Frame& F) {
    const bf16* YHCM = (const bf16*)(F.ws + WS_YHCM); bf16* YH = (bf16*)(F.ws + WS_YH);
    LAS unsigned short* tl = (LAS unsigned short*)(F.lds + 8 * 8704 + F.wave * (64 * 72 * 2));
    const int gw = F.bx * NWAVES + F.wave, NGW = F.G * NWAVES, lane = F.lane;
    for (int it = gw; it < 2 * 16 * 256; it += NGW) {
        const int mt = it & 255, ct = (it >> 8) & 15, b = it >> 12; const int m0 = mt * 64, c0 = ct * 64;
#pragma unroll
        for (int j = 0; j < 8; ++j) { const int ch = 8 * j + (lane >> 3), mc = (lane & 7) * 8;
            const u32x4 v = *(const GAS u32x4*)(YHCM + (size_t)(b * 1024 + c0 + ch) * SEQ + m0 + mc); *(LAS u32x4*)(tl + ch * 72 + mc) = v; }
        LDS_WAIT(); asm volatile("" ::: "memory");
#pragma unroll
        for (int j = 0; j < 8; ++j) { const int mm = 8 * j + (lane >> 3), cc = (lane & 7) * 8; const int m = m0 + mm, w = m >> 8, r = m & 255;
            u32x4 o; o.x = (unsigned)tl[(cc + 0) * 72 + mm] | ((unsigned)tl[(cc + 1) * 72 + mm] << 16); o.y = (unsigned)tl[(cc + 2) * 72 + mm] | ((unsigned)tl[(cc + 3) * 72 + mm] << 16);
            o.z = (unsigned)tl[(cc + 4) * 72 + mm] | ((unsigned)tl[(cc + 5) * 72 + mm] << 16); o.w = (unsigned)tl[(cc + 6) * 72 + mm] | ((unsigned)tl[(cc + 7) * 72 + mm] << 16);
            *(GAS u32x4*)(YH + (size_t)(b * SEQ + r * 64 + w) * HYW + c0 + cc) = o; }
        LDS_WAIT(); asm volatile("" ::: "memory");
    }
}

struct SchedStd {
    int G, c, npn, K, nrep; const char* A; const char* Bt; int esz = 2;
    __device__ __forceinline__ bool next(int i, pg8::Unit& u) const {
        int L = i * G + c; const int nwg = 128 * npn; u.e = 0; u.valid = 256;
        if (nrep > 1 && L >= nwg) L -= nwg;
        if (L >= nwg) return false;
        int wgid = L; { const int q = nwg / 8, xcd = wgid % 8, off = wgid / 8; wgid = xcd * q + off; }
        const int nig = 8 * npn, gid = wgid / nig; u.pm = gid * 8 + ((wgid % nig) % 8); u.pn = (wgid % nig) / 8; return true;
    }
    __device__ __forceinline__ unsigned a_row(const pg8::Unit& u, int r) const { return (unsigned)(u.pm * 256 + r); }
    __device__ __forceinline__ const char* a_base() const { return A; }
    __device__ __forceinline__ const char* b_base(const pg8::Unit& u) const { return Bt + (size_t)u.pn * 256 * K * esz; }
};
template <int MODE> struct EpiMix {
    static constexpr bool PERM = true, TRANS = true, FP8 = false;
    const bf16* P; const bf16* Q; bf16* O;
    __device__ __forceinline__ void operator()(const f32x4 (&acc)[2][2][4][2], const pg8::Unit& u, int wr, int wc, int fr, int fq) const {
        constexpr int ld = (MODE == 0) ? 1024 : 2048;
        const int col0 = u.pn * 256 + wc * 32 + 8 * fq;
#pragma unroll
        for (int ai = 0; ai < 2; ++ai) {
            u32x4 pv[4][2], qv[4][2];
#pragma unroll
            for (int m = 0; m < 4; ++m) { const size_t row = (size_t)u.pm * 256 + ai * 128 + wr * 64 + m * 16 + fr;
#pragma unroll
                for (int bj = 0; bj < 2; ++bj) { const int col = col0 + bj * 128;
                    if (MODE == 0) pv[m][bj] = *(const u32x4*)(P + row * 1024 + col);
                    else { const u32x2 g8 = *(const u32x2*)((const unsigned char*)P + row * 4096 + (MODE == 2 ? 2048 : 0) + col); pv[m][bj] = (u32x4){g8.x, g8.y, 0u, 0u}; }
                    if (MODE == 2) qv[m][bj] = *(const u32x4*)(Q + row * 2048 + col); } }
#pragma unroll
            for (int m = 0; m < 4; ++m) { const size_t row = (size_t)u.pm * 256 + ai * 128 + wr * 64 + m * 16 + fr;
#pragma unroll
                for (int bj = 0; bj < 2; ++bj) { const int col = col0 + bj * 128; const f32x4 v0 = acc[ai][bj][m][0], v1 = acc[ai][bj][m][1]; float r[8];
                    if (MODE == 0) { const u32x4 y = pv[m][bj];
                        r[0] = bflo(y.x) * sigmoidf_(v0[0]); r[1] = bfhi(y.x) * sigmoidf_(v0[1]); r[2] = bflo(y.y) * sigmoidf_(v0[2]); r[3] = bfhi(y.y) * sigmoidf_(v0[3]);
                        r[4] = bflo(y.z) * sigmoidf_(v1[0]); r[5] = bfhi(y.z) * sigmoidf_(v1[1]); r[6] = bflo(y.w) * sigmoidf_(v1[2]); r[7] = bfhi(y.w) * sigmoidf_(v1[3]); }
                    else { const u32x4 gg = pv[m][bj]; constexpr float q = 1.0f / 255.0f;
                        r[0] = (float)(gg.x & 255u) * q * v0[0]; r[1] = (float)((gg.x >> 8) & 255u) * q * v0[1]; r[2] = (float)((gg.x >> 16) & 255u) * q * v0[2]; r[3] = (float)(gg.x >> 24) * q * v0[3];
                        r[4] = (float)(gg.y & 255u) * q * v1[0]; r[5] = (float)((gg.y >> 8) & 255u) * q * v1[1]; r[6] = (float)((gg.y >> 16) & 255u) * q * v1[2]; r[7] = (float)(gg.y >> 24) * q * v1[3];
                        if (MODE == 2) { const u32x4 t1 = qv[m][bj];
                            r[0] += bflo(t1.x); r[1] += bfhi(t1.x); r[2] += bflo(t1.y); r[3] += bfhi(t1.y); r[4] += bflo(t1.z); r[5] += bfhi(t1.z); r[6] += bflo(t1.w); r[7] += bfhi(t1.w); } }
                    if (MODE == 2) {
                        *(u32x2*)((unsigned char*)O + row * ld + col) = (u32x2){pk4_fp8(r[0] * T8SCALE, r[1] * T8SCALE, r[2] * T8SCALE, r[3] * T8SCALE), pk4_fp8(r[4] * T8SCALE, r[5] * T8SCALE, r[6] * T8SCALE, r[7] * T8SCALE)}; }
                    else { u32x4 w; w.x = cvt_pk_bf16(r[0], r[1]); w.y = cvt_pk_bf16(r[2], r[3]); w.z = cvt_pk_bf16(r[4], r[5]); w.w = cvt_pk_bf16(r[6], r[7]);
                        *(u32x4*)(O + row * ld + col) = w; } } }
        }
    }
};
struct EpiOut {
    static constexpr bool PERM = true, TRANS = true, FP8 = true;
    const float* X; const float* MOD; bf16* H1;
    __device__ __forceinline__ void operator()(const f32x4 (&acc)[2][2][4][2], const pg8::Unit& u, int wr, int wc, int fr, int fq) const {
        const int b = u.pm >> 6; const int c0 = u.pn * 256 + wc * 32 + 8 * fq;
        f32x4 gv[2][2];
#pragma unroll
        for (int bj = 0; bj < 2; ++bj)
#pragma unroll
            for (int n = 0; n < 2; ++n) gv[bj][n] = *(const f32x4*)(MOD + b * 12288 + 2 * 2048 + c0 + bj * 128 + 4 * n) * (1.0f / (W8SCALE * T8SCALE));
#pragma unroll
        for (int ai = 0; ai < 2; ++ai) {
            f32x4 xv[4][2][2];
#pragma unroll
            for (int m = 0; m < 4; ++m) { const size_t off = ((size_t)u.pm * 256 + ai * 128 + wr * 64 + m * 16 + fr) * D + c0;
#pragma unroll
                for (int bj = 0; bj < 2; ++bj)
#pragma unroll
                    for (int n = 0; n < 2; ++n) xv[m][bj][n] = *(const f32x4*)(X + off + bj * 128 + 4 * n); }
#pragma unroll
            for (int m = 0; m < 4; ++m) { const size_t off = ((size_t)u.pm * 256 + ai * 128 + wr * 64 + m * 16 + fr) * D + c0;
#pragma unroll
                for (int bj = 0; bj < 2; ++bj) { const f32x4 v0 = xv[m][bj][0] + gv[bj][0] * acc[ai][bj][m][0], v1 = xv[m][bj][1] + gv[bj][1] * acc[ai][bj][m][1];
                    u32x4 w; w.x = cvt_pk_bf16(v0[0], v0[1]); w.y = cvt_pk_bf16(v0[2], v0[3]); w.z = cvt_pk_bf16(v1[0], v1[1]); w.w = cvt_pk_bf16(v1[2], v1[3]);
                    *(u32x4*)(H1 + off + bj * 128) = w; } }
        }
    }
};

__device__ __forceinline__ void p10_router(Frame& F) {
    const int gw = F.bx * NWAVES + F.wave, NGW = F.G * NWAVES, lane = F.lane;
    const float* MOD = (const float*)(F.ws + WS_MOD); const float* g2n = F.in[IN_N2G]; const float* RWT = (const float*)(F.ws + WS_RWT); const float* rb = F.in[IN_RB];
    const bf16* H1 = (const bf16*)(F.ws + WS_H1); unsigned char* HM8 = (unsigned char*)(F.ws + WS_HM8); float* GATE = (float*)(F.ws + WS_GATE); int* LIST = (int*)(F.ws + WS_LIST);
    for (int m0 = 2 * gw; m0 < NTOK; m0 += 2 * NGW) {
        const int b = m0 >> 14;
        f32x4 h[2][8];
#pragma unroll
        for (int rr = 0; rr < 2; ++rr) { const bf16* xr = H1 + (size_t)(m0 + rr) * D; float s = 0.f;
#pragma unroll
            for (int j = 0; j < 8; ++j) { const u32x2 hb = *(const GAS u32x2*)(xr + 4 * lane + 256 * j); h[rr][j] = (f32x4){bflo(hb.x), bfhi(hb.x), bflo(hb.y), bfhi(hb.y)}; s += (h[rr][j].x * h[rr][j].x + h[rr][j].y * h[rr][j].y) + (h[rr][j].z * h[rr][j].z + h[rr][j].w * h[rr][j].w); }
            const float rstd = 1.0f / sqrtf(wave_sum(s) * (1.0f / D) + 1e-6f);
            GAS unsigned* o = (GAS unsigned*)(HM8 + (size_t)(m0 + rr) * D) + lane;
#pragma unroll
            for (int j = 0; j < 8; ++j) { const int k = 4 * lane + 256 * j; const f32x4 g = *(const f32x4*)(g2n + k), sc = *(const f32x4*)(MOD + b * 12288 + 4 * 2048 + k), sh = *(const f32x4*)(MOD + b * 12288 + 3 * 2048 + k);
                h[rr][j] = h[rr][j] * rstd * g * (sc + 1.0f) + sh; }
#pragma unroll
            for (int j = 0; j < 8; ++j) o[64 * j] = pk4_fp8(h[rr][j].x, h[rr][j].y, h[rr][j].z, h[rr][j].w); }
        float lg0 = -3.0e38f, lg1 = -3.0e38f;
#pragma unroll 2
        for (int e = 0; e < NEXP; ++e) { float s0 = 0.f, s1 = 0.f;
#pragma unroll
            for (int j = 0; j < 8; ++j) { const f32x4 w = *(const f32x4*)(RWT + e * 2048 + 4 * lane + 256 * j);
                s0 += (h[0][j].x * w.x + h[0][j].y * w.y) + (h[0][j].z * w.z + h[0][j].w * w.w); s1 += (h[1][j].x * w.x + h[1][j].y * w.y) + (h[1][j].z * w.z + h[1][j].w * w.w); }
            s0 = wave_sum(s0) + rb[e]; s1 = wave_sum(s1) + rb[e];
            if (lane == e) { lg0 = s0; lg1 = s1; } }
#pragma unroll
        for (int rr = 0; rr < 2; ++rr) { float lg = rr ? lg1 : lg0; int es[4]; float vs[4];
#pragma unroll
            for (int k = 0; k < 4; ++k) { const float mx = wave_max(lg); const unsigned long long bal = __ballot(lg == mx); const int idx = __ffsll((long long)bal) - 1; es[k] = idx; vs[k] = mx; if (lane == idx) lg = -3.0e38f; }
            const float e1 = __expf(vs[1] - vs[0]), e2 = __expf(vs[2] - vs[0]), e3 = __expf(vs[3] - vs[0]); const float inv = 1.0f / (1.0f + e1 + e2 + e3);
            if (lane < 4) { const int ee = lane == 0 ? es[0] : lane == 1 ? es[1] : lane == 2 ? es[2] : es[3]; const float gt = (lane == 0 ? 1.0f : lane == 1 ? e1 : lane == 2 ? e2 : e3) * inv;
                const int slot = (m0 + rr) * 4 + lane;
                const unsigned pos = __hip_atomic_fetch_add((unsigned*)(F.ctl + CW_CNT + 64 * ee), 1u, __ATOMIC_RELAXED, __HIP_MEMORY_SCOPE_AGENT);
                LIST[ee * LISTCAP + (int)pos] = slot; GATE[slot] = gt; } }
    }
}

__device__ __forceinline__ void moe_tables(Frame& F) {
    volatile LAS int* tb = (volatile LAS int*)(F.lds + LDS_X);
    __syncthreads();
    if (F.tid < NEXP) tb[64 + F.tid] = (int)__hip_atomic_load((unsigned*)(F.ctl + CW_CNT + 64 * F.tid), __ATOMIC_RELAXED, __HIP_MEMORY_SCOPE_AGENT);
    __syncthreads();
    if (F.tid == 0) { int acc = 0; for (int e = 0; e < NEXP; ++e) { const int c = tb[64 + e]; tb[e] = acc; acc += (c + 255) >> 8; } tb[32] = acc; }
    __syncthreads();
}
template <bool GATHER> struct SchedMoe {
    int G, c, npn, N, K, nrep; const char* A; const char* Bt; const int* LIST; volatile LAS int* tb;
    __device__ __forceinline__ bool next(int i, pg8::Unit& u) const {
        int L = i * G + c; { const int tot = tb[32] * npn; if (nrep > 1 && L >= tot) L -= tot; }
        int rt = L / npn, pnq = L % npn;
        if (G == 256 && nrep == 1) {
            const int x = c & 7, j = c >> 3;
            if (npn == 16) { pnq = 4 * (x & 3) + (j & 3); rt = 16 * i + (x >> 2) * 8 + (j >> 2); }
            else           { pnq = 2 * (x & 3) + (j & 1); rt = 32 * i + (x >> 2) * 16 + (j >> 1); }
        }
        if (rt >= tb[32]) return false;
        int e = 0;
        for (int q = 1; q < NEXP; ++q) e += (tb[q] <= rt) ? 1 : 0;
        e = __builtin_amdgcn_readfirstlane(e);
        u.pm = rt; u.pn = pnq; u.e = e; const int left = tb[64 + e] - 256 * (rt - tb[e]); u.valid = left < 256 ? left : 256; return true;
    }
    __device__ __forceinline__ unsigned a_row(const pg8::Unit& u, int r) const {
        if (GATHER) { const int rc = r < u.valid ? r : u.valid - 1; return (unsigned)(LIST[u.e * LISTCAP + (u.pm - tb[u.e]) * 256 + rc] >> 2); }
        return (unsigned)(u.pm * 256 + r);
    }
    __device__ __forceinline__ const char* a_base() const { return A; }
    __device__ __forceinline__ const char* b_base(const pg8::Unit& u) const { return Bt + ((size_t)u.e * N + (size_t)u.pn * 256) * K; }
};
struct EpiMoe1 {
    static constexpr bool PERM = true, TRANS = true, FP8 = true;
    const float* BG; unsigned char* ACT;
    __device__ __forceinline__ void operator()(const f32x4 (&acc)[2][2][4][2], const pg8::Unit& u, int wr, int wc, int fr, int fq) const {
        const int c0 = u.pn * 256 + wc * 32 + 8 * fq;
        f32x4 bv[2][2];
#pragma unroll
        for (int bj = 0; bj < 2; ++bj)
#pragma unroll
            for (int n = 0; n < 2; ++n) bv[bj][n] = *(const f32x4*)(BG + (size_t)u.e * 4096 + c0 + bj * 128 + 4 * n);
#pragma unroll
        for (int ai = 0; ai < 2; ++ai)
#pragma unroll
            for (int m = 0; m < 4; ++m) { const size_t row = (size_t)u.pm * 256 + ai * 128 + wr * 64 + m * 16 + fr;
#pragma unroll
                for (int bj = 0; bj < 2; ++bj) { const f32x4 v0 = acc[ai][bj][m][0] * (1.0f / W8SCALE) + bv[bj][0], v1 = acc[ai][bj][m][1] * (1.0f / W8SCALE) + bv[bj][1]; float a[4];
#pragma unroll
                    for (int j = 0; j < 4; ++j) { const float gl = fminf(j < 2 ? v0[2 * j] : v1[2 * j - 4], 7.0f); const float ln = fminf(fmaxf(j < 2 ? v0[2 * j + 1] : v1[2 * j - 3], -7.0f), 7.0f);
                        a[j] = gl * sigmoidf_(1.702f * gl) * (ln + 1.0f); }
                    *(unsigned*)(ACT + row * DEXP + ((c0 + bj * 128) >> 1)) = pk4_fp8(a[0], a[1], a[2], a[3]); } }
    }
};
struct EpiMoe2 {
    static constexpr bool PERM = true, TRANS = true, FP8 = true;
    const float* BD; const float* GATE; const int* LIST; unsigned char* YS; volatile LAS int* tb;
    __device__ __forceinline__ void operator()(const f32x4 (&acc)[2][2][4][2], const pg8::Unit& u, int wr, int wc, int fr, int fq) const {
        const int c0 = u.pn * 256 + wc * 32 + 8 * fq; const int lbase = u.e * LISTCAP + (u.pm - tb[u.e]) * 256;
        f32x4 bv[2][2];
#pragma unroll
        for (int bj = 0; bj < 2; ++bj)
#pragma unroll
            for (int n = 0; n < 2; ++n) bv[bj][n] = *(const f32x4*)(BD + (size_t)u.e * D + c0 + bj * 128 + 4 * n);
        int slot[2][4]; float gt_[2][4];
#pragma unroll
        for (int ai = 0; ai < 2; ++ai)
#pragma unroll
            for (int m = 0; m < 4; ++m) { const int r = ai * 128 + wr * 64 + m * 16 + fr; slot[ai][m] = LIST[lbase + (r < u.valid ? r : u.valid - 1)]; }
#pragma unroll
        for (int ai = 0; ai < 2; ++ai)
#pragma unroll
            for (int m = 0; m < 4; ++m) gt_[ai][m] = GATE[slot[ai][m]] * Y8SCALE;
#pragma unroll
        for (int ai = 0; ai < 2; ++ai)
#pragma unroll
            for (int m = 0; m < 4; ++m) { const int r = ai * 128 + wr * 64 + m * 16 + fr; const float gt = gt_[ai][m];
                const long long ro = (r < u.valid) ? (long long)slot[ai][m] * D : YS_DUMP_OFF;
#pragma unroll
                for (int bj = 0; bj < 2; ++bj) { const f32x4 v0 = (acc[ai][bj][m][0] * (1.0f / W8SCALE) + bv[bj][0]) * gt, v1 = (acc[ai][bj][m][1] * (1.0f / W8SCALE) + bv[bj][1]) * gt;
                    *(u32x2*)(YS + ro + c0 + bj * 128) = (u32x2){pk4_fp8(v0[0], v0[1], v0[2], v0[3]), pk4_fp8(v1[0], v1[1], v1[2], v1[3])}; } }
    }
};
__device__ __forceinline__ void p13_final(Frame& F) {
    const int gw = F.bx * NWAVES + F.wave, NGW = F.G * NWAVES, lane = F.lane;
    const float* MOD = (const float*)(F.ws + WS_MOD); const float* fg = F.in[IN_FG]; const unsigned char* YS = (const unsigned char*)(F.ws + WS_YS); float* O = F.out;
    f32x4 fgv[8], g2v[8]; int curb = -1;
#pragma unroll
    for (int j = 0; j < 8; ++j) fgv[j] = *(const f32x4*)(fg + 4 * lane + 256 * j);
    for (int m = gw; m < NTOK; m += NGW) {
        const int b = m >> 14; float* xr = O + (size_t)m * D;
        if (b != curb) { curb = b;
#pragma unroll
            for (int j = 0; j < 8; ++j) g2v[j] = *(const f32x4*)(MOD + b * 12288 + 5 * 2048 + 4 * lane + 256 * j) * (1.0f / Y8SCALE); }   const bf16* hr = (const bf16*)(F.ws + WS_H1) + (size_t)m * D; f32x4 h[8]; float s = 0.f;
#pragma unroll
        for (int j = 0; j < 8; ++j) { const int k = 4 * lane + 256 * j; f32x4 a = (f32x4){0.f, 0.f, 0.f, 0.f};
#pragma unroll
            for (int q = 0; q < 4; ++q) { const unsigned y = *(const GAS unsigned*)(YS + (size_t)(m * 4 + q) * D + k);
                const f32x2 lo = __builtin_amdgcn_cvt_pk_f32_fp8((int)y, false), hi = __builtin_amdgcn_cvt_pk_f32_fp8((int)y, true); a += (f32x4){lo.x, lo.y, hi.x, hi.y}; }
            const u32x2 hb = *(const GAS u32x2*)(hr + k); h[j] = (f32x4){bflo(hb.x), bfhi(hb.x), bflo(hb.y), bfhi(hb.y)} + g2v[j] * a; s += (h[j].x * h[j].x + h[j].y * h[j].y) + (h[j].z * h[j].z + h[j].w * h[j].w); }
        const float rstd = 1.0f / sqrtf(wave_sum(s) * (1.0f / D) + 1e-6f);
#pragma unroll
        for (int j = 0; j < 8; ++j) { const int k = 4 * lane + 256 * j; *(GAS f32x4*)(xr + k) = h[j] * rstd * fgv[j]; }
    }
}

__global__ void __launch_bounds__(NTHR, 2) fwd(Args args) {
    extern __shared__ __attribute__((aligned(16))) unsigned char lds_raw[];
    Frame F;
    F.lds = (LAS unsigned char*)lds_raw;
    F.tid = threadIdx.x; F.lane = F.tid & 63; F.wave = __builtin_amdgcn_readfirstlane(F.tid >> 6);
    F.G = gridDim.x; F.bx = blockIdx.x; F.in = args.in; F.out = args.out; F.ws = args.ws; F.ctl = (GAS unsigned*)(args.ws + WS_CTL);
    for (int u = F.tid; u < (LDS_BYTES - MISC_OFF) / 4; u += NTHR) ((LAS unsigned*)(F.lds + MISC_OFF))[u] = 0u;
    __syncthreads();
    const int lo = args.ph_lo, hi = args.ph_hi;
    XcdBarrier bar; bar.bar = (unsigned*)(F.ctl + CW_BAR); bar.x = 0; bar.st = nullptr;
    if (hi - lo > 1) bar = xcd_barrier_post((unsigned*)(F.ctl + CW_BAR), (volatile LAS unsigned*)(F.lds + MISC_OFF));
#ifndef PH_MASK
#define PH_MASK 0xffff
#endif
#define IN(k) (((PH_MASK >> (k)) & 1) && lo <= (k) && (k) < hi)
#define SEAM(k) do { if (IN(k) && IN((k) + 1)) xcd_barrier(bar); } while (0)
    unsigned char* ws = args.ws;
#ifndef PROBE_DUP
#define PROBE_DUP 0
#endif
#define DUPBAR(k) if ((PROBE_DUP >> (k)) & 1) xcd_barrier(bar)
#define DUP2(k, body) do { body; if ((PROBE_DUP >> (k)) & 1) { xcd_barrier(bar); body; } } while (0)
    if (IN(0)) { DUP2(0, p0_prologue(F)); } SEAM(0);
    if (IN(1)) { DUP2(1, p1_norm(F)); } SEAM(1);
    if (IN(2)) { {
        const int GW = (F.G == 256) ? 192 : F.G; const int nr = ((PROBE_DUP >> 2) & 1) ? 2 : 1;
        if (F.bx < GW) {
            const int r1 = (128 * 4 + 8) % GW, r2 = (r1 + 128 * 16) % GW; const int c1 = F.bx, c2 = (F.bx - r1 + GW) % GW, c3 = (F.bx - r2 + GW) % GW;
            { SchedIn S{GW, c1, 128 * 4, 4, 0, nr, (const char*)(ws + WS_U), (const char*)(ws + WS_WIN)}; EpiInA E{ws};
              pg8::gemm_phase<EpiInA, SchedIn>(F.lds, D, S, E); }
            { SchedIn S{GW, c2, 128 * 16, 16, 2, nr, (const char*)(ws + WS_U8), (const char*)(ws + WS_WIN8)}; EpiInG8 E{(unsigned char*)(ws + WS_UG)};
              pg8::gemm_phase<EpiInG8, SchedIn>(F.lds, D, S, E); }
            { SchedIn S{GW, c3, 128 * 12, 12, 1, nr, (const char*)(ws + WS_U), (const char*)(ws + WS_WIN)}; EpiInH E{(bf16*)(ws + WS_UH)};
              pg8::gemm_phase<EpiInH, SchedIn>(F.lds, D, S, E); }
        }
        moe_weight_queue(F);
        }
    } SEAM(2);
    if (IN(3)) { DUP2(3, s5_pass3<false>(F)); } SEAM(3);
    if (IN(4)) { int q4w = CW_Q4; DUP2(4, (p4_hyena_carry(F, q4w), q4w += 16)); } SEAM(4);
    if (IN(5)) { DUP2(5, s5_pass3<true>(F)); __syncthreads(); DUP2(14, yh_transpose(F)); } SEAM(5);
    if (IN(6)) { { SchedStd S{F.G, F.bx, 4, 1024, ((PROBE_DUP >> 6) & 1) ? 2 : 1, (const char*)(ws + WS_Y), (const char*)(ws + WS_WGLU)}; EpiMix<0> E{(const bf16*)(ws + WS_Y), nullptr, (bf16*)(ws + WS_YA)};
        pg8::gemm_phase<EpiMix<0>, SchedStd>(F.lds, 1024, S, E); } } SEAM(6);
    if (IN(7)) { { SchedStd S{F.G, F.bx, 8, 1024, ((PROBE_DUP >> 7) & 1) ? 2 : 1, (const char*)(ws + WS_YA), (const char*)(ws + WS_WBS5)}; EpiMix<1> E{(const bf16*)(ws + WS_UG), nullptr, (bf16*)(ws + WS_T1)};
        pg8::gemm_phase<EpiMix<1>, SchedStd>(F.lds, 1024, S, E); } } SEAM(7);
    if (IN(8)) { { SchedStd S{F.G, F.bx, 8, 1024, ((PROBE_DUP >> 8) & 1) ? 2 : 1, (const char*)(ws + WS_YH), (const char*)(ws + WS_WBHY)}; EpiMix<2> E{(const bf16*)(ws + WS_UG), (const bf16*)(ws + WS_T1), (bf16*)(ws + WS_T)};
        pg8::gemm_phase<EpiMix<2>, SchedStd>(F.lds, 1024, S, E); } } SEAM(8);
    if (IN(9)) { { SchedStd S{F.G, F.bx, 8, 2048, ((PROBE_DUP >> 9) & 1) ? 2 : 1, (const char*)(ws + WS_T), (const char*)(ws + WS_WO), 1}; EpiOut E{F.in[IN_X], (const float*)(ws + WS_MOD), (bf16*)(ws + WS_H1)};
        pg8::gemm_phase<EpiOut, SchedStd>(F.lds, 2048, S, E); } } SEAM(9);
    if (IN(10)) { p10_router(F); } SEAM(10);
    if (IN(11)) { { moe_tables(F); volatile LAS int* tb = (volatile LAS int*)(F.lds + LDS_X);
        SchedMoe<true> S{F.G, F.bx, 16, 4096, 2048, ((PROBE_DUP >> 11) & 1) ? 2 : 1, (const char*)(ws + WS_HM8), (const char*)(ws + WS_WGU), (const int*)(ws + WS_LIST), tb}; EpiMoe1 E{F.in[IN_BGU], (unsigned char*)(ws + WS_ACT)};
        pg8::gemm_phase<EpiMoe1, SchedMoe<true>>(F.lds, 2048, S, E); } } SEAM(11);
    if (IN(12)) { { moe_tables(F); volatile LAS int* tb = (volatile LAS int*)(F.lds + LDS_X);
        SchedMoe<false> S{F.G, F.bx, 8, 2048, 2048, ((PROBE_DUP >> 12) & 1) ? 2 : 1, (const char*)(ws + WS_ACT), (const char*)(ws + WS_WDN), (const int*)(ws + WS_LIST), tb}; EpiMoe2 E{F.in[IN_BDN], (const float*)(ws + WS_GATE), (const int*)(ws + WS_LIST), (unsigned char*)(ws + WS_YS), tb};
        pg8::gemm_phase<EpiMoe2, SchedMoe<false>>(F.lds, 2048, S, E); } } SEAM(12);
    if (IN(13)) { DUP2(13, p13_final(F)); }
#undef IN
#undef SEAM
}

extern "C" void kernel_launch(void* const* d_in, const int* in_sizes, int n_in, void* d_out, int out_size, void* d_ws, size_t ws_size, hipStream_t stream) {
    static int grid = 0;
    if (grid == 0) {
        if (n_in != 39 || out_size != NTOK * D || ws_size < WS_END) { fprintf(stderr, "kernel_launch: unexpected shapes: n_in %d out %d ws %zu (need %zu)\n", n_in, out_size, ws_size, (size_t)WS_END); grid = -1; return; }
        int dev = 0, cus = 0, per_cu = 0;
        if (hipGetDevice(&dev) != hipSuccess || hipDeviceGetAttribute(&cus, hipDeviceAttributeMultiprocessorCount, dev) != hipSuccess) { grid = -1; return; }
        if (hipFuncSetAttribute((const void*)fwd, hipFuncAttributeMaxDynamicSharedMemorySize, LDS_BYTES) != hipSuccess) { fprintf(stderr, "kernel_launch: hipFuncSetAttribute failed\n"); grid = -1; return; }
        if (hipOccupancyMaxActiveBlocksPerMultiprocessor(&per_cu, (const void*)fwd, NTHR, LDS_BYTES) != hipSuccess || per_cu < 1) fprintf(stderr, "kernel_launch: occupancy query says %d\n", per_cu);
        (void)hipGetLastError();
        grid = cus;
    }
    if (grid < 0) return;
    if (hipMemsetAsync((char*)d_ws + WS_CTL, 0, CTL_ZERO_BYTES, stream) != hipSuccess) return;
    Args a{};
    for (int i = 0; i < 39; ++i) a.in[i] = (const float*)d_in[i];
    a.out = (float*)d_out; a.ws = (unsigned char*)d_ws;
#ifndef ONE_LAUNCH
#define ONE_LAUNCH 1
#endif
    if (ONE_LAUNCH) { a.ph_lo = 0; a.ph_hi = NPHASE; hipLaunchKernelGGL(fwd, dim3(grid), dim3(NTHR), LDS_BYTES, stream, a); }
    else for (int p = 0; p < NPHASE; ++p) { a.ph_lo = p; a.ph_hi = p + 1; hipLaunchKernelGGL(fwd, dim3(grid), dim3(NTHR), LDS_BYTES, stream, a); }
}
```

```cpp
#include <hip/hip_runtime.h>
#include <cstdio>
#include <cstdint>

#define GAS __attribute__((address_space(1)))
#define LAS __attribute__((address_space(3)))
typedef unsigned short bf16;
typedef short bf16x8 __attribute__((ext_vector_type(8)));
typedef float f32x4 __attribute__((ext_vector_type(4)));
typedef float f32x16 __attribute__((ext_vector_type(16)));
typedef float f32x2 __attribute__((ext_vector_type(2)));
typedef unsigned u32x4 __attribute__((ext_vector_type(4)));
typedef unsigned u32x2 __attribute__((ext_vector_type(2)));
typedef int i32x4 __attribute__((ext_vector_type(4)));
typedef int i32x8 __attribute__((ext_vector_type(8)));

constexpr int D = 2048, NB = 2, SEQ = 16384, NTOK = NB * SEQ, CTX = 256, NCTX = NB * CTX;
constexpr int S5W = 1024, HYW = 1024, INC = 8192, NEXP = 32, TOPK = 4, DEXP = 2048;
constexpr int NCH = 260;
constexpr int LISTCAP = 32768;

constexpr size_t MiB = 1u << 20;
constexpr size_t WS_CTL = 0, CTL_ZERO_BYTES = 1 * MiB;
constexpr size_t WS_MOD = 6 * MiB;
constexpr size_t WS_BBT = 7 * MiB;
constexpr size_t WS_CTT = WS_BBT + 512 * 1024;
constexpr size_t WS_LAM = 8 * MiB;
constexpr size_t WS_RWT = 8 * MiB + 256 * 1024;
constexpr size_t WS_BB2 = 8 * MiB + 512 * 1024;
constexpr size_t WS_WIN = 16 * MiB;
constexpr size_t WS_WGLU = 48 * MiB;
constexpr size_t WS_WBS5 = 50 * MiB;
constexpr size_t WS_WBHY = 54 * MiB;
constexpr size_t WS_WO = 58 * MiB;
constexpr size_t WS_WGU = 66 * MiB;
constexpr size_t WS_WDN = 578 * MiB;
constexpr size_t WS_U = 834 * MiB;
constexpr size_t WS_UCA = 964 * MiB;
constexpr size_t WS_UA = 966 * MiB;
constexpr size_t WS_UH = 1030 * MiB;
constexpr size_t WS_UG = 1222 * MiB;
constexpr size_t WS_E = 1478 * MiB;
constexpr size_t WS_SIN = 1511 * MiB;
constexpr size_t WS_FILT = 1544 * MiB;
constexpr size_t WS_HYS = 1800 * MiB;
constexpr size_t HYS_STRIDE = 768 * 1024;
constexpr size_t WS_YHCM = 1992 * MiB;
constexpr size_t WS_YH = 2056 * MiB;
constexpr size_t WS_Y = 2120 * MiB;
constexpr size_t WS_YA = 2184 * MiB;
constexpr size_t WS_T1 = 2248 * MiB;
constexpr size_t WS_T = 2376 * MiB;
constexpr size_t WS_HM = 2504 * MiB;
constexpr size_t WS_GATE = 2632 * MiB;
constexpr size_t WS_LIST = 2633 * MiB;
constexpr size_t WS_ACT = 2638 * MiB;
constexpr size_t WS_YS = 3182 * MiB;
constexpr size_t WS_H1 = 3694 * MiB;
constexpr size_t WS_HM8 = WS_T1;
constexpr size_t WS_U8 = WS_ACT;
constexpr size_t WS_WIN8 = WS_YS;
constexpr size_t WS_END = 3950 * MiB;
constexpr long long YS_DUMP_OFF = (long long)(2 * MiB) - (long long)WS_YS;

constexpr int CW_TMO = 0;
constexpr int CW_Q4 = 64;
constexpr int CW_QT = 96;
constexpr int CW_CNT = 128;
constexpr int CW_BAR = 4096;

constexpr int RING_BYTES = 131072;
constexpr int LDS_X = 131072;
constexpr int MISC_OFF = 147456 - 512;
constexpr int LDS_BYTES = 147456;
constexpr int NWAVES = 8, NTHR = 512;
constexpr int NPHASE = 14;

__device__ __forceinline__ unsigned f2bf(float f) { unsigned u = __builtin_bit_cast(unsigned, f); return (u + 0x7fffu + ((u >> 16) & 1u)) >> 16; }
__device__ __forceinline__ unsigned pk2(float lo, float hi) { return f2bf(lo) | (f2bf(hi) << 16); }
__device__ __forceinline__ float bf2f(unsigned short b) { return __builtin_bit_cast(float, ((unsigned)b) << 16); }
__device__ __forceinline__ float bflo(unsigned w) { return __builtin_bit_cast(float, w << 16); }
__device__ __forceinline__ float bfhi(unsigned w) { return __builtin_bit_cast(float, w & 0xffff0000u); }
typedef __bf16 bf16x2_t __attribute__((ext_vector_type(2)));
__device__ __forceinline__ unsigned cvt_pk_bf16(float lo, float hi) { const f32x2 v = {lo, hi}; const bf16x2_t b = __builtin_convertvector(v, bf16x2_t); return __builtin_bit_cast(unsigned, b); }
__device__ __forceinline__ unsigned pk4_fp8(float a, float b, float c, float d) { unsigned w = 0u; w = (unsigned)__builtin_amdgcn_cvt_pk_fp8_f32(a, b, (int)w, false); w = (unsigned)__builtin_amdgcn_cvt_pk_fp8_f32(c, d, (int)w, true); return w; }
constexpr float Y8SCALE = 8.0f;
constexpr float T8SCALE = 16.0f;
constexpr float W8SCALE = 64.0f;
__device__ __forceinline__ float sigmoidf_(float x) { return __builtin_amdgcn_rcpf(1.0f + __expf(-x)); }
__device__ __forceinline__ float sin_rev(float r) { return __builtin_amdgcn_sinf(__builtin_amdgcn_fractf(r)); }
__device__ __forceinline__ float cos_rev(float r) { return __builtin_amdgcn_cosf(__builtin_amdgcn_fractf(r)); }
__device__ __forceinline__ float wave_sum(float v) {
#pragma unroll
    for (int o = 1; o < 64; o <<= 1) v += __shfl_xor(v, o);
    return v;
}
__device__ __forceinline__ float wave_max(float v) {
#pragma unroll
    for (int o = 1; o < 64; o <<= 1) v = fmaxf(v, __shfl_xor(v, o));
    return v;
}
__device__ __forceinline__ f32x2 cmul(f32x2 a, f32x2 b) { return (f32x2){a.x * b.x - a.y * b.y, a.x * b.y + a.y * b.x}; }
#define LDS_WAIT() asm volatile("s_waitcnt lgkmcnt(0)" ::: "memory")
#define VM_WAIT() asm volatile("s_waitcnt vmcnt(0)" ::: "memory")

namespace pg8 {
constexpr int BM = 256, BK = 64, HALF = 128, HTB = HALF * BK * 2, STAGE_BYTES = 8 * HTB;
__host__ __device__ __forceinline__ int lds_byte(int r, int c) { const int st = (r >> 4) * 2 + (c >> 5), rr = r & 15, cc = c & 31, ob = rr * 64 + cc * 2; return st * 1024 + (ob ^ (((ob >> 9) & 1) << 5)); }
__host__ __device__ __forceinline__ void stage_rc(int b, int& R, int& C) { const int st = b / 1024, sb = b % 1024, swz = sb ^ (((sb >> 9) & 1) << 5); R = (st >> 1) * 16 + swz / 64; C = (st & 1) * 32 + (swz % 64) / 2; }
__host__ __device__ __forceinline__ int perm32(int rho) { const int n = rho >> 4, i = rho & 15; return 8 * (i >> 2) + 4 * n + (i & 3); }

struct Unit { int pm, pn, e, valid; };

template <class Epi, class Sched>
__device__ __forceinline__ void gemm_phase(LAS unsigned char* lds, const int Kel, const Sched& S, const Epi& E) {
    const int tid = threadIdx.x, wid = __builtin_amdgcn_readfirstlane(tid >> 6), lane = tid & 63, wr = wid >> 2, wc = wid & 3, fr = lane & 15, fq = lane >> 4;
    const int K = Epi::FP8 ? (Kel >> 1) : Kel;
    const int nt = K / BK;
    int Rs[2], Cs[2]; unsigned voffB[2];
#pragma unroll
    for (int i = 0; i < 2; ++i) { int R, C; stage_rc(tid * 16 + i * 8192, R, C); Rs[i] = R; Cs[i] = C; const int Rb = Epi::PERM ? ((R & ~31) + perm32(R & 31)) : R; voffB[i] = (unsigned)(Rb * K + C) * 2u; }
    const size_t kstep = (size_t)(BK * 2);
    const size_t hstep = (size_t)HALF * K * 2;
    const unsigned ldsw = (unsigned)wid * 1024u;
    const int aoff = lds_byte(wr * 64 + fr, fq * 8), boff = lds_byte(wc * 32 + fr, fq * 8);
    const int aoff8 = lds_byte(wr * 64 + fr, fq * 16), boff8 = lds_byte(wc * 32 + fr, fq * 16);
#define PG8_SA(b, h) (((b) * 2 + (h)) * HTB)
#define PG8_SB(b, h) ((4 + (b) * 2 + (h)) * HTB)
#define PG8_STAGE(bufoff, gbase, voff) do { _Pragma("unroll") for (int _i = 0; _i < 2; ++_i) \
        __builtin_amdgcn_global_load_lds((const unsigned*)((const char*)(gbase) + (voff)[_i]), (LAS unsigned*)(lds + (bufoff) + ldsw + _i * 8192), 16, 0, 0); } while (0)
#define PG8_LDA(dst, b, h) do { if constexpr (Epi::FP8) { _Pragma("unroll") for (int m = 0; m < 4; ++m) { const i32x4 lo_ = *(const LAS i32x4*)(lds + PG8_SA(b, h) + aoff8 + m * 2048), hi_ = *(const LAS i32x4*)(lds + PG8_SA(b, h) + aoff8 + m * 2048 + 16); dst##8[m] = __builtin_shufflevector(lo_, hi_, 0, 1, 2, 3, 4, 5, 6, 7); } } \
        else { _Pragma("unroll") for (int m = 0; m < 4; ++m) _Pragma("unroll") for (int k = 0; k < 2; ++k) dst[m][k] = *(const LAS bf16x8*)(lds + PG8_SA(b, h) + aoff + m * 2048 + k * 1024); } } while (0)
#define PG8_LDB(dst, b, h) do { if constexpr (Epi::FP8) { _Pragma("unroll") for (int n = 0; n < 2; ++n) { const i32x4 lo_ = *(const LAS i32x4*)(lds + PG8_SB(b, h) + boff8 + n * 2048), hi_ = *(const LAS i32x4*)(lds + PG8_SB(b, h) + boff8 + n * 2048 + 16); dst##8[n] = __builtin_shufflevector(lo_, hi_, 0, 1, 2, 3, 4, 5, 6, 7); } } \
        else { _Pragma("unroll") for (int n = 0; n < 2; ++n) _Pragma("unroll") for (int k = 0; k < 2; ++k) dst[n][k] = *(const LAS bf16x8*)(lds + PG8_SB(b, h) + boff + n * 2048 + k * 1024); } } while (0)
#define PG8_MMA(ai, bj, At, Bt) do { __builtin_amdgcn_s_setprio(1); \
        if constexpr (Epi::FP8) { _Pragma("unroll") for (int m = 0; m < 4; ++m) _Pragma("unroll") for (int n = 0; n < 2; ++n) \
            asm volatile("v_mfma_scale_f32_16x16x128_f8f6f4 %0, %1, %2, %0, %3, %3 op_sel_hi:[0,0,0]" : "+v"(acc[ai][bj][m][n]) : "v"(Bt##8[n]), "v"(At##8[m]), "v"(scl1)); } \
        else { _Pragma("unroll") for (int m = 0; m < 4; ++m) _Pragma("unroll") for (int n = 0; n < 2; ++n) _Pragma("unroll") for (int k = 0; k < 2; ++k) \
        acc[ai][bj][m][n] = Epi::TRANS ? __builtin_amdgcn_mfma_f32_16x16x32_bf16(Bt[n][k], At[m][k], acc[ai][bj][m][n], 0, 0, 0) \
                                       : __builtin_amdgcn_mfma_f32_16x16x32_bf16(At[m][k], Bt[n][k], acc[ai][bj][m][n], 0, 0, 0); } __builtin_amdgcn_s_setprio(0); } while (0)
#define PG8_WAIT_V(n) asm volatile("s_waitcnt vmcnt(" #n ")" ::: "memory")
#define PG8_WAIT_L(n) asm volatile("s_waitcnt lgkmcnt(" #n ")" ::: "memory")
#define PG8_BAR __builtin_amdgcn_s_barrier()
#define PG8_SCHED __builtin_amdgcn_sched_barrier(0)
    Unit cur, nxt; int ui = 0;
    if (!S.next(0, cur)) return;
    f32x4 acc[2][2][4][2];
#pragma unroll
    for (int a = 0; a < 2; ++a)
#pragma unroll
        for (int b = 0; b < 2; ++b)
#pragma unroll
            for (int m = 0; m < 4; ++m)
#pragma unroll
                for (int n = 0; n < 2; ++n) acc[a][b][m][n] = (f32x4){0.f, 0.f, 0.f, 0.f};
    bf16x8 At[4][2], B0[2][2], B1[2][2]; i32x8 At8[4], B08[2], B18[2]; const int scl1 = 0x7F7F7F7F;
    const char* const Ab = S.a_base();
    const char* cB = S.b_base(cur);
    unsigned vC0[2], vC1[2];
#pragma unroll
    for (int i = 0; i < 2; ++i) { vC0[i] = (S.a_row(cur, Rs[i]) * (unsigned)K + (unsigned)Cs[i]) * 2u; vC1[i] = (S.a_row(cur, HALF + Rs[i]) * (unsigned)K + (unsigned)Cs[i]) * 2u; }
    PG8_STAGE(PG8_SB(0, 0), cB, voffB); PG8_STAGE(PG8_SB(0, 1), cB + hstep, voffB); PG8_STAGE(PG8_SA(0, 0), Ab, vC0); PG8_STAGE(PG8_SA(0, 1), Ab, vC1);
    if (wr == 1) PG8_BAR;
    PG8_WAIT_V(2); PG8_BAR;
    PG8_STAGE(PG8_SB(1, 0), cB + kstep, voffB); PG8_STAGE(PG8_SA(1, 0), Ab + kstep, vC0); PG8_STAGE(PG8_SB(1, 1), cB + hstep + kstep, voffB);
    PG8_WAIT_V(6); PG8_BAR;
    for (;;) {
        const bool has_next = S.next(ui + 1, nxt);
        const char* nB = has_next ? S.b_base(nxt) : cB;
        for (int t = 0; t < nt; t += 2) {
            const bool last = (t == nt - 2);
            const char* a1 = Ab + (size_t)(t + 1) * kstep;
            const char* a2 = last ? Ab : Ab + (size_t)(t + 2) * kstep; const char* b2 = last ? nB : cB + (size_t)(t + 2) * kstep;
            const char* a3 = a2 + kstep; const char* b3 = b2 + kstep;
            unsigned vX0[2], vX1[2];
            if (last && has_next) {
#pragma unroll
                for (int i = 0; i < 2; ++i) { vX0[i] = (S.a_row(nxt, Rs[i]) * (unsigned)K + (unsigned)Cs[i]) * 2u; vX1[i] = (S.a_row(nxt, HALF + Rs[i]) * (unsigned)K + (unsigned)Cs[i]) * 2u; }
            } else {
#pragma unroll
                for (int i = 0; i < 2; ++i) { vX0[i] = vC0[i]; vX1[i] = vC1[i]; }
            }
            PG8_LDB(B0, 0, 0); PG8_LDB(B1, 0, 1); PG8_SCHED; PG8_LDA(At, 0, 0); PG8_STAGE(PG8_SA(1, 1), a1, vC1);
            PG8_WAIT_V(8); PG8_WAIT_L(0); PG8_BAR; PG8_MMA(0, 0, At, B0); PG8_MMA(0, 1, At, B1); PG8_BAR; PG8_SCHED;
            PG8_LDA(At, 0, 1); PG8_STAGE(PG8_SB(0, 0), b2, voffB); PG8_STAGE(PG8_SB(0, 1), b2 + hstep, voffB); PG8_STAGE(PG8_SA(0, 0), a2, vX0);
            PG8_WAIT_V(8); PG8_WAIT_L(0); PG8_BAR; PG8_MMA(1, 0, At, B0); PG8_MMA(1, 1, At, B1); PG8_BAR; PG8_SCHED;
            PG8_LDB(B0, 1, 0); PG8_LDB(B1, 1, 1); PG8_SCHED; PG8_LDA(At, 1, 0); PG8_STAGE(PG8_SA(0, 1), a2, vX1);
            PG8_WAIT_V(8); PG8_WAIT_L(0); PG8_BAR; PG8_MMA(0, 0, At, B0); PG8_MMA(0, 1, At, B1); PG8_BAR; PG8_SCHED;
            PG8_LDA(At, 1, 1); PG8_STAGE(PG8_SB(1, 0), b3, voffB); PG8_STAGE(PG8_SB(1, 1), b3 + hstep, voffB); PG8_STAGE(PG8_SA(1, 0), a3, vX0);
            PG8_WAIT_V(8); PG8_WAIT_L(0); PG8_BAR; PG8_MMA(1, 0, At, B0); PG8_MMA(1, 1, At, B1); PG8_BAR; PG8_SCHED;
            if (last) {
#pragma unroll
                for (int i = 0; i < 2; ++i) { vC0[i] = vX0[i]; vC1[i] = vX1[i]; }
            }
        }
        if (wr == 0) PG8_BAR;
        if constexpr (Epi::FP8) asm volatile("s_nop 15\n\ts_nop 15" ::: "memory");
        E(acc, cur, wr, wc, fr, fq);
        if (!has_next) break;
#pragma unroll
        for (int a = 0; a < 2; ++a)
#pragma unroll
            for (int b = 0; b < 2; ++b)
#pragma unroll
                for (int m = 0; m < 4; ++m)
#pragma unroll
                    for (int n = 0; n < 2; ++n) acc[a][b][m][n] = (f32x4){0.f, 0.f, 0.f, 0.f};
        cur = nxt; cB = nB; ++ui;
        if (wr == 1) PG8_BAR;
    }
    PG8_WAIT_V(0);
    PG8_BAR;
#undef PG8_SA
#undef PG8_SB
#undef PG8_STAGE
#undef PG8_LDA
#undef PG8_LDB
#undef PG8_MMA
#undef PG8_WAIT_V
#undef PG8_WAIT_L
#undef PG8_BAR
#undef PG8_SCHED
}
}

#define XB_TMO      128
#define XB_XCNT(j)  (256  + 64 * (j))
#define XB_XSUB(j)  (1280 + 64 * (j))
#define XB_XGEN(j)  (2304 + 64 * (j))
#define XB_TOP      3328
#define XB_TOPGEN   3392
#define XCD_BAR_WORDS 3456
#define XB_SPIN_CAP (1u << 22)
__device__ __forceinline__ unsigned xb_ld(unsigned* p)              { return __hip_atomic_load(p, __ATOMIC_RELAXED, __HIP_MEMORY_SCOPE_AGENT); }
__device__ __forceinline__ unsigned xb_add(unsigned* p, unsigned v) { return __hip_atomic_fetch_add(p, v, __ATOMIC_RELAXED, __HIP_MEMORY_SCOPE_AGENT); }
__device__ __forceinline__ unsigned xb_xcc_id() { return (unsigned)__builtin_amdgcn_s_getreg((3 << 11) | 20) & 0xFu; }
#define XB_SPIN(cond, bar) do { unsigned _sp = 0; while (cond) { __builtin_amdgcn_s_sleep(1); \
    if ((++_sp & 255u) == 0u) { if (xb_ld(&(bar)[XB_TMO])) break; if (_sp > XB_SPIN_CAP) { atomicAdd(&(bar)[XB_TMO], 1u); break; } } } } while (0)
struct XcdBarrier { unsigned* bar; unsigned x; volatile LAS unsigned* st; };
__device__ __forceinline__ XcdBarrier xcd_barrier_post(unsigned* bar, volatile LAS unsigned* st) {
    XcdBarrier b; b.bar = bar; b.x = xb_xcc_id(); b.st = st;
    if (threadIdx.x == 0) (void)xb_add(&bar[XB_XCNT(b.x)], 1u);
    return b;
}
__device__ __forceinline__ void xcd_barrier_complete(unsigned* bar, unsigned x, unsigned& nloc, unsigned& nx) {
    const unsigned G = gridDim.x * gridDim.y * gridDim.z;
    unsigned sum, cnt, mine, sp = 0u;
    for (;;) {
        sum = 0u; cnt = 0u; mine = 0u;
#pragma unroll
        for (unsigned j = 0; j < 16; ++j) { const unsigned c = xb_ld(&bar[XB_XCNT(j)]); sum += c; cnt += (c > 0u) ? 1u : 0u; mine = (j == x) ? c : mine; }
        if (sum == G) break;
        __builtin_amdgcn_s_sleep(1);
        if ((++sp & 255u) == 0u) { if (xb_ld(&bar[XB_TMO])) break; if (sp > XB_SPIN_CAP) { atomicAdd(&bar[XB_TMO], 1u); break; } }
    }
    nloc = mine > 0u ? mine : 1u; nx = cnt > 0u ? cnt : 1u;
}
__device__ __forceinline__ void xcd_barrier(const XcdBarrier& b) {
    asm volatile("s_waitcnt vmcnt(0)" ::: "memory");
    __syncthreads();
    if (threadIdx.x == 0) {
        unsigned* bar = b.bar;
        __builtin_amdgcn_s_waitcnt(0);
        unsigned nloc = b.st[0], nx = b.st[1];
        if (nloc == 0u) { xcd_barrier_complete(bar, b.x, nloc, nx); b.st[0] = nloc; b.st[1] = nx; }
        const unsigned old = xb_add(&bar[XB_XSUB(b.x)], 1u);
        const unsigned gen = old / nloc;
        if (old + 1u == (gen + 1u) * nloc) {
            __builtin_amdgcn_fence(__ATOMIC_RELEASE, "agent");
            asm volatile("s_waitcnt vmcnt(0)" ::: "memory");
            const unsigned og = xb_add(&bar[XB_TOP], 1u);
            const unsigned tg = og / nx;
            if (og + 1u == (tg + 1u) * nx) xb_add(&bar[XB_TOPGEN], 1u);
            else XB_SPIN(xb_ld(&bar[XB_TOPGEN]) == tg, bar);
            __builtin_amdgcn_fence(__ATOMIC_ACQUIRE, "agent");
            xb_add(&bar[XB_XGEN(b.x)], 1u);
            asm volatile("s_waitcnt vmcnt(0)" ::: "memory");
        } else {
            XB_SPIN(xb_ld(&bar[XB_XGEN(b.x)]) == gen, bar);
            __builtin_amdgcn_fence(__ATOMIC_ACQUIRE, "agent");
            asm volatile("s_waitcnt vmcnt(0)" ::: "memory");
        }
    }
    __syncthreads();
}

struct Args { const float* in[39]; float* out; unsigned char* ws; int ph_lo, ph_hi; };
struct Frame {
    LAS unsigned char* lds;
    int tid, lane, wave, G, bx;
    const float* const* in; float* out; unsigned char* ws;
    GAS unsigned* ctl;
};
#define IN_X 0
#define IN_C 1
#define IN_CTX 2
#define IN_CCTX 3
#define IN_WADA 4
#define IN_BADA 5
#define IN_N1G 6
#define IN_N2G 7
#define IN_WIN 8
#define IN_LRE 9
#define IN_LIM 10
#define IN_LDT 11
#define IN_BRE 12
#define IN_BIM 13
#define IN_CRE 14
#define IN_CIM 15
#define IN_S5D 16
#define IN_WGLU 17
#define IN_HSW 18
#define IN_HW1 19
#define IN_HB1 20
#define IN_HF1 21
#define IN_HW2 22
#define IN_HB2 23
#define IN_HF2 24
#define IN_HW3 25
#define IN_HB3 26
#define IN_HDEC 27
#define IN_HBIAS 28
#define IN_WBS5 29
#define IN_WBHY 30
#define IN_WO 31
#define IN_RW 32
#define IN_RB 33
#define IN_WGU 34
#define IN_BGU 35
#define IN_WDN 36
#define IN_BDN 37
#define IN_FG 38

__device__ __forceinline__ void p0_adaln_item(Frame& F, int cb) {
    LAS float* sl = (LAS float*)F.lds;
    const float* c = F.in[IN_C]; const float* cc = F.in[IN_CCTX]; const float* W = F.in[IN_WADA];
    for (int i = F.tid; i < 3 * 2048; i += NTHR) { const int v = i >> 11, k = i & 2047; const float cv = (v < 2) ? c[v * 2048 + k] : cc[k]; sl[i] = cv * sigmoidf_(cv); }
    __syncthreads();
    const int col = F.tid % 48, ks = F.tid / 48;
    float a0 = 0.f, a1 = 0.f, a2 = 0.f;
    if (ks < 10) { const float* wp = W + 48 * cb + col;
#pragma unroll 16
        for (int j = 0; j < 205; ++j) { const int k = ks + 10 * j; if (k < 2048) { const float w = wp[(size_t)k * 12288]; a0 += sl[k] * w; a1 += sl[2048 + k] * w; a2 += sl[4096 + k] * w; } } }
    LAS float* red = sl + 6144;
    if (ks < 10) { red[(ks * 48 + col) * 3 + 0] = a0; red[(ks * 48 + col) * 3 + 1] = a1; red[(ks * 48 + col) * 3 + 2] = a2; }
    __syncthreads();
    if (F.tid < 144) { const int v = F.tid / 48, cl = F.tid % 48; float sacc = 0.f;
#pragma unroll
        for (int q = 0; q < 10; ++q) sacc += red[(q * 48 + cl) * 3 + v];
        ((float*)(F.ws + WS_MOD))[v * 12288 + 48 * cb + cl] = sacc + F.in[IN_BADA][48 * cb + cl]; }
    __syncthreads();
}
__device__ __forceinline__ void p0_filt_item(Frame& F, int tb) {
    LAS float* ft = (LAS float*)F.lds;
    LAS float* h1 = ft + 64 * 36;
    LAS float* h2 = h1 + 64 * 65;
    const int t0 = tb * 64, tl = F.tid >> 3, q = F.tid & 7; const float tf = (float)(t0 + tl);
    for (int f = q; f < 33; f += 8) {
        float v;
        if (f == 0) v = tf * (1.0f / 16383.0f);
        else { const int bi = (f - 1) & 15; const float band = 1e-4f + (float)bi * ((15.0f - 1e-4f) / 15.0f); const float rev = tf * band * (1.0f / 16384.0f);
               v = (f <= 16) ? cos_rev(rev) : -sin_rev(rev); }
        ft[tl * 36 + f] = v;
    }
    __syncthreads();
    { const float* w1 = F.in[IN_HW1]; const float* b1 = F.in[IN_HB1]; const float* f1 = F.in[IN_HF1];
      _Pragma("unroll 1") for (int j = q * 8; j < q * 8 + 8; ++j) { float a = b1[j]; _Pragma("unroll 3") for (int f = 0; f < 33; ++f) a += ft[tl * 36 + f] * w1[f * 64 + j]; h1[tl * 65 + j] = sin_rev(f1[j] * a * 0.15915494309189535f); } }
    __syncthreads();
    { const float* w2 = F.in[IN_HW2]; const float* b2 = F.in[IN_HB2]; const float* f2 = F.in[IN_HF2];
      _Pragma("unroll 1") for (int j = q * 8; j < q * 8 + 8; ++j) { float a = b2[j]; _Pragma("unroll 4") for (int i = 0; i < 64; ++i) a += h1[tl * 65 + i] * w2[i * 64 + j]; h2[tl * 64 + j] = sin_rev(f2[j] * a * 0.15915494309189535f); } }
    __syncthreads();
    LAS unsigned short* hb = (LAS unsigned short*)(h2 + 64 * 64);
    for (int i = F.tid; i < 64 * 64; i += NTHR) hb[(i >> 6) * 72 + (i & 63)] = (unsigned short)f2bf(h2[i]);
    __syncthreads();
    const float* w3 = F.in[IN_HW3]; const float* b3 = F.in[IN_HB3]; const float* dec = F.in[IN_HDEC]; bf16* FILT = (bf16*)(F.ws + WS_FILT);
    const int fr = F.lane & 15, fq = F.lane >> 4;
    bf16x8 af[4][2];
#pragma unroll
    for (int m = 0; m < 4; ++m)
#pragma unroll
        for (int ks = 0; ks < 2; ++ks) af[m][ks] = *(const LAS bf16x8*)(hb + (16 * m + fr) * 72 + 32 * ks + 8 * fq);
#pragma unroll 4
    for (int jt = F.wave; jt < 256; jt += NWAVES) {
        const int j = 16 * jt + fr;
        bf16x8 bfr[2];
#pragma unroll
        for (int ks = 0; ks < 2; ++ks) { float w[8];
#pragma unroll
            for (int e = 0; e < 8; ++e) w[e] = w3[(size_t)(32 * ks + 8 * fq + e) * 4096 + j];
            u32x4 pk; pk.x = pk2(w[0], w[1]); pk.y = pk2(w[2], w[3]); pk.z = pk2(w[4], w[5]); pk.w = pk2(w[6], w[7]); bfr[ks] = __builtin_bit_cast(bf16x8, pk); }
        const float bb = b3[j], dd = fabsf(dec[j]) * (1.0f / 16383.0f);
#pragma unroll
        for (int m = 0; m < 4; ++m) { f32x4 acc = (f32x4){0.f, 0.f, 0.f, 0.f};
#pragma unroll
            for (int ks = 0; ks < 2; ++ks) acc = __builtin_amdgcn_mfma_f32_16x16x32_bf16(af[m][ks], bfr[ks], acc, 0, 0, 0);
            const int tb0 = t0 + 16 * m + 4 * fq; f32x4 o;
#pragma unroll
            for (int e = 0; e < 4; ++e) o[e] = (acc[e] + bb) * __expf(-(float)(tb0 + e) * dd);
            *(u32x2*)(FILT + (size_t)j * SEQ + tb0) = (u32x2){cvt_pk_bf16(o[0], o[1]), cvt_pk_bf16(o[2], o[3])}; }
    }
    __syncthreads();
}
__device__ __forceinline__ void p0_s5tab_item(Frame& F, int item) {
    const int idx = item * NTHR + F.tid; const int d = idx >> 12, g = (idx >> 6) & 63, p = idx & 63, dg = d * 64 + g;
    const float lr = F.in[IN_LRE][dg * 64 + p], li = F.in[IN_LIM][dg * 64 + p], dt = expf(F.in[IN_LDT][dg]);
    const float mag = expf(lr * dt), ang = li * dt; const float lbr = mag * cosf(ang), lbi = mag * sinf(ang);
    const float den = lr * lr + li * li, cr = ((lbr - 1.f) * lr + lbi * li) / den, ci = (lbi * lr - (lbr - 1.f) * li) / den;
    bf16* BBT = (bf16*)(F.ws + WS_BBT); bf16* BB2 = (bf16*)(F.ws + WS_BB2); bf16* CTT = (bf16*)(F.ws + WS_CTT); f32x2* LAM = (f32x2*)(F.ws + WS_LAM);
    const float* bre = F.in[IN_BRE] + (size_t)(dg * 64 + p) * 16; const float* bim = F.in[IN_BIM] + (size_t)(dg * 64 + p) * 16;
    for (int c = 0; c < 16; ++c) { const float br = bre[c], bi = bim[c];
        BBT[(size_t)(dg * 128 + p) * 16 + c] = (bf16)f2bf(cr * br - ci * bi); BBT[(size_t)(dg * 128 + 64 + p) * 16 + c] = (bf16)f2bf(cr * bi + ci * br);
        BB2[(size_t)(dg * 128 + 2 * p) * 16 + c] = (bf16)f2bf(cr * br - ci * bi); BB2[(size_t)(dg * 128 + 2 * p + 1) * 16 + c] = (bf16)f2bf(cr * bi + ci * br); }
    const int k = 2 * p;
    for (int c = 0; c < 16; ++c) { const float cre = F.in[IN_CRE][(size_t)(dg * 16 + c) * 64 + p], cim = F.in[IN_CIM][(size_t)(dg * 16 + c) * 64 + p];
        CTT[(size_t)(dg * 16 + c) * 128 + k] = (bf16)f2bf(cre); CTT[(size_t)(dg * 16 + c) * 128 + k + 1] = (bf16)f2bf(-cim); }
    LAM[dg * 64 + p] = (f32x2){lbr, lbi};
}
__device__ __forceinline__ void p0_transpose_item(const float* W, int K, int N, bf16* WT, LAS unsigned short* scr, int kb, int nb, int lane) {
    const int k0 = 64 * kb, n0 = 128 * nb;
    const float* wp = W + (size_t)(k0 + (lane >> 5)) * N + n0 + 4 * (lane & 31);
#pragma unroll
    for (int half = 0; half < 2; ++half) { f32x4 v[16];
#pragma unroll
        for (int i = 0; i < 16; ++i) v[i] = *(const GAS f32x4*)(wp + (size_t)(32 * half + 2 * i) * N);
#pragma unroll
        for (int i = 0; i < 16; ++i) { const int kk = 32 * half + 2 * i + (lane >> 5); LAS unsigned* d = (LAS unsigned*)(scr + kk * 130 + 4 * (lane & 31)); d[0] = pk2(v[i].x, v[i].y); d[1] = pk2(v[i].z, v[i].w); } }
    LDS_WAIT(); asm volatile("" ::: "memory");
    const int c = lane & 7;
#pragma unroll
    for (int j = 0; j < 16; ++j) { const int r = (lane >> 3) + 8 * j; const LAS unsigned short* sp = scr + (8 * c) * 130 + r;
        u32x4 o; o.x = (unsigned)sp[0] | ((unsigned)sp[130] << 16); o.y = (unsigned)sp[2 * 130] | ((unsigned)sp[3 * 130] << 16); o.z = (unsigned)sp[4 * 130] | ((unsigned)sp[5 * 130] << 16); o.w = (unsigned)sp[6 * 130] | ((unsigned)sp[7 * 130] << 16);
        *(GAS u32x4*)(WT + (size_t)(n0 + r) * K + k0 + 8 * c) = o; }
    LDS_WAIT(); asm volatile("" ::: "memory");
}
__device__ __forceinline__ void p0_transpose_item8(const float* W, int K, int N, unsigned char* WT, LAS unsigned short* scr, int kb, int nb, int lane) {
    const int k0 = 64 * kb, n0 = 128 * nb;
    const float* wp = W + (size_t)(k0 + (lane >> 5)) * N + n0 + 4 * (lane & 31);
#pragma unroll
    for (int half = 0; half < 2; ++half) { f32x4 v[16];
#pragma unroll
        for (int i = 0; i < 16; ++i) v[i] = *(const GAS f32x4*)(wp + (size_t)(32 * half + 2 * i) * N);
#pragma unroll
        for (int i = 0; i < 16; ++i) { const int kk = 32 * half + 2 * i + (lane >> 5); LAS unsigned* d = (LAS unsigned*)(scr + kk * 130 + 4 * (lane & 31)); d[0] = pk2(v[i].x, v[i].y); d[1] = pk2(v[i].z, v[i].w); } }
    LDS_WAIT(); asm volatile("" ::: "memory");
    const int c = lane & 7;
#pragma unroll
    for (int j = 0; j < 16; ++j) { const int r = (lane >> 3) + 8 * j; const LAS unsigned short* sp = scr + (8 * c) * 130 + r;
        u32x2 o; o.x = pk4_fp8(bf2f(sp[0]) * W8SCALE, bf2f(sp[130]) * W8SCALE, bf2f(sp[2 * 130]) * W8SCALE, bf2f(sp[3 * 130]) * W8SCALE);
        o.y = pk4_fp8(bf2f(sp[4 * 130]) * W8SCALE, bf2f(sp[5 * 130]) * W8SCALE, bf2f(sp[6 * 130]) * W8SCALE, bf2f(sp[7 * 130]) * W8SCALE);
        *(GAS u32x2*)(WT + (size_t)(n0 + r) * K + k0 + 8 * c) = o; }
    LDS_WAIT(); asm volatile("" ::: "memory");
}
__device__ __forceinline__ void p0_transpose_item8d(const float* W, int K, int N, unsigned char* WT, LAS unsigned short* scr, int kb, int nb, int lane) {
    const int k0 = 64 * kb, n0 = 128 * nb;
    const float* wp = W + (size_t)(k0 + (lane >> 5)) * N + n0 + 4 * (lane & 31);
    f32x4 v[32];
#pragma unroll
    for (int i = 0; i < 32; ++i) v[i] = *(const GAS f32x4*)(wp + (size_t)(2 * i) * N);
#pragma unroll
    for (int i = 0; i < 32; ++i) { const int kk = 2 * i + (lane >> 5); LAS unsigned* d = (LAS unsigned*)(scr + kk * 130 + 4 * (lane & 31)); d[0] = pk2(v[i].x, v[i].y); d[1] = pk2(v[i].z, v[i].w); }
    LDS_WAIT(); asm volatile("" ::: "memory");
    const int c = lane & 7;
#pragma unroll
    for (int j = 0; j < 16; ++j) { const int r = (lane >> 3) + 8 * j; const LAS unsigned short* sp = scr + (8 * c) * 130 + r;
        u32x2 o; o.x = pk4_fp8(bf2f(sp[0]) * W8SCALE, bf2f(sp[130]) * W8SCALE, bf2f(sp[2 * 130]) * W8SCALE, bf2f(sp[3 * 130]) * W8SCALE);
        o.y = pk4_fp8(bf2f(sp[4 * 130]) * W8SCALE, bf2f(sp[5 * 130]) * W8SCALE, bf2f(sp[6 * 130]) * W8SCALE, bf2f(sp[7 * 130]) * W8SCALE);
        *(GAS u32x2*)(WT + (size_t)(n0 + r) * K + k0 + 8 * c) = o; }
    LDS_WAIT(); asm volatile("" ::: "memory");
}
__device__ __forceinline__ void moe_weight_queue(Frame& F) {
    constexpr int W_GU1 = 32 * 32, W_DN1 = 16 * 32, W_GU = 32 * W_GU1, W_DN = 32 * W_DN1;
    LAS unsigned short* scr = (LAS unsigned short*)(F.lds + F.wave * 16640);
    const int lane = F.lane;
    __syncthreads();
    for (;;) {
        int r0 = 0;
        if (lane == 0) r0 = (int)__hip_atomic_fetch_add((unsigned*)(F.ctl + CW_QT), 4u, __ATOMIC_RELAXED, __HIP_MEMORY_SCOPE_AGENT);
        r0 = __builtin_amdgcn_readfirstlane(r0);
        if (r0 >= W_GU + W_DN) break;
#pragma unroll 1
        for (int sub = 0; sub < 4; ++sub) { const int r = r0 + sub;
            const float* W; unsigned char* WT; int N, kb, nb;
            if (r < W_GU) { const int e = r / W_GU1, q = r % W_GU1; W = F.in[IN_WGU] + (size_t)e * 2048 * 4096; WT = (unsigned char*)(F.ws + WS_WGU) + (size_t)e * 4096 * 2048; N = 4096; kb = q & 31; nb = q >> 5; }
            else { const int rr = r - W_GU; const int e = rr / W_DN1, q = rr % W_DN1; W = F.in[IN_WDN] + (size_t)e * 2048 * 2048; WT = (unsigned char*)(F.ws + WS_WDN) + (size_t)e * 2048 * 2048; N = 2048; kb = q & 31; nb = q >> 5; }
            const int K = 2048, k0 = 64 * kb, n0 = 128 * nb;
            const float* wp = W + (size_t)(k0 + (lane >> 5)) * N + n0 + 4 * (lane & 31);
            f32x4 v[32];
#pragma unroll
            for (int i = 0; i < 32; ++i) v[i] = __builtin_nontemporal_load((const GAS f32x4*)(wp + (size_t)(2 * i) * N));
            LAS unsigned char* sb = (LAS unsigned char*)scr;
#pragma unroll
            for (int i = 0; i < 32; ++i) { const int kk = 2 * i + (lane >> 5); *(LAS unsigned*)(sb + kk * 132 + 4 * (lane & 31)) = pk4_fp8(v[i].x * W8SCALE, v[i].y * W8SCALE, v[i].z * W8SCALE, v[i].w * W8SCALE); }
            LDS_WAIT(); asm volatile("" ::: "memory");
            const int c = lane & 7;
#pragma unroll
            for (int j = 0; j < 16; ++j) { const int rw = (lane >> 3) + 8 * j; const LAS unsigned char* sp = sb + (8 * c) * 132 + rw;
                u32x2 o; o.x = (unsigned)sp[0] | ((unsigned)sp[132] << 8) | ((unsigned)sp[2 * 132] << 16) | ((unsigned)sp[3 * 132] << 24);
                o.y = (unsigned)sp[4 * 132] | ((unsigned)sp[5 * 132] << 8) | ((unsigned)sp[6 * 132] << 16) | ((unsigned)sp[7 * 132] << 24);
                __builtin_nontemporal_store(o, (GAS u32x2*)(WT + (size_t)(n0 + rw) * K + k0 + 8 * c)); }
            LDS_WAIT(); asm volatile("" ::: "memory");
        }
    }
    __syncthreads();
}
__device__ __forceinline__ void p0_prologue(Frame& F) {
    for (int it = F.bx; it < 256; it += F.G) p0_adaln_item(F, it);
    for (int it = F.bx; it < 256; it += F.G) p0_filt_item(F, it);
    for (int it = F.bx; it < 16; it += F.G) p0_s5tab_item(F, it);
    { const float* rw = F.in[IN_RW]; float* RWT = (float*)(F.ws + WS_RWT);
      for (int i = F.bx * NTHR + F.tid; i < 32 * 2048; i += F.G * NTHR) { const int e = i >> 11, k = i & 2047; RWT[i] = rw[k * 32 + e]; } }
    __syncthreads();
    LAS unsigned short* scr = (LAS unsigned short*)(F.lds + F.wave * 16640);
    constexpr int I_IN = 64 * 4, I_GLU = 8 * 2, I_BS5 = 16 * 2, I_BHY = 16 * 2, I_O = 16 * 4;
    constexpr int NITEMS = I_IN + I_GLU + I_BS5 + I_BHY + I_O;
    const int w = F.wave;
    for (int it = F.bx; it < NITEMS; it += F.G) {
        int r = it;
        if (r < I_IN) { if ((r >> 2) < 32) p0_transpose_item(F.in[IN_WIN], 2048, 8192, (bf16*)(F.ws + WS_WIN), scr, 8 * (r & 3) + w, r >> 2, F.lane);
                        else p0_transpose_item8(F.in[IN_WIN], 2048, 8192, (unsigned char*)(F.ws + WS_WIN8) - (size_t)4096 * 2048, scr, 8 * (r & 3) + w, r >> 2, F.lane); continue; } r -= I_IN;
        if (r < I_GLU) { p0_transpose_item(F.in[IN_WGLU], 1024, 1024, (bf16*)(F.ws + WS_WGLU), scr, 8 * (r & 1) + w, r >> 1, F.lane); continue; } r -= I_GLU;
        if (r < I_BS5) { p0_transpose_item(F.in[IN_WBS5], 1024, 2048, (bf16*)(F.ws + WS_WBS5), scr, 8 * (r & 1) + w, r >> 1, F.lane); continue; } r -= I_BS5;
        if (r < I_BHY) { p0_transpose_item(F.in[IN_WBHY], 1024, 2048, (bf16*)(F.ws + WS_WBHY), scr, 8 * (r & 1) + w, r >> 1, F.lane); continue; } r -= I_BHY;
        { p0_transpose_item8(F.in[IN_WO], 2048, 2048, (unsigned char*)(F.ws + WS_WO), scr, 8 * (r & 3) + w, r >> 2, F.lane); }
    }
}

__device__ __forceinline__ void p1_norm(Frame& F) {
    const int gw = F.bx * NWAVES + F.wave, NGW = F.G * NWAVES;
    const float* MOD = (const float*)(F.ws + WS_MOD); const float* g1n = F.in[IN_N1G];
    bf16* U = (bf16*)(F.ws + WS_U);
    int curv = -1; f32x4 ga[8], sh[8];
    for (int m = gw; m < NTOK + NCTX; m += NGW) {
        const int v = (m < NTOK) ? (m >> 14) : 2;
        if (v != curv) { curv = v;
#pragma unroll
            for (int j = 0; j < 8; ++j) { const int k = 4 * F.lane + 256 * j; const f32x4 g = *(const f32x4*)(g1n + k), sc = *(const f32x4*)(MOD + v * 12288 + 2048 + k); ga[j] = g * (sc + 1.0f); sh[j] = *(const f32x4*)(MOD + v * 12288 + k); } }
        const float* xr = (m < NTOK) ? (F.in[IN_X] + (size_t)m * D) : (F.in[IN_CTX] + (size_t)(m - NTOK) * D);
        f32x4 x[8]; float s = 0.f;
#pragma unroll
        for (int j = 0; j < 8; ++j) { x[j] = *(const GAS f32x4*)(xr + 4 * F.lane + 256 * j); s += (x[j].x * x[j].x + x[j].y * x[j].y) + (x[j].z * x[j].z + x[j].w * x[j].w); }
        const float rstd = 1.0f / sqrtf(wave_sum(s) * (1.0f / D) + 1e-6f);
        GAS u32x2* o = (GAS u32x2*)(U + (size_t)m * D) + F.lane; GAS unsigned* o8 = (GAS unsigned*)(F.ws + WS_U8 + (size_t)m * D) + F.lane;
#pragma unroll
        for (int j = 0; j < 8; ++j) { const f32x4 y = x[j] * rstd * ga[j] + sh[j]; o[64 * j] = (u32x2){pk2(y.x, y.y), pk2(y.z, y.w)}; if (m < NTOK) o8[64 * j] = pk4_fp8(y.x, y.y, y.z, y.w); }
    }
}

struct SchedIn {
    int G, c, nmain, npn, mode, nrep;
    const char* A; const char* Bt;
    __device__ __forceinline__ bool next(int i, pg8::Unit& u) const {
        int L = i * G + c; u.e = 0; u.valid = 256; { const int tot = nmain + (mode == 0 ? 8 : 0); if (nrep > 1 && L >= tot && L < 2 * tot) L -= tot; }
        if (L < nmain) {
            int wgid = L; { const int q = nmain / 8, xcd = wgid % 8, off = wgid / 8; wgid = xcd * q + off; }
            const int nig = 8 * npn, gid = wgid / nig; const int pm = gid * 8 + ((wgid % nig) % 8), pl = (wgid % nig) / 8;
            u.pm = pm; u.pn = (mode == 0) ? pl : (mode == 1 ? pl + 4 : pl + 16); return true;
        }
        if (mode == 0 && L < nmain + 8) { const int q = L - nmain; u.pm = 128 + (q >> 2); u.pn = q & 3; return true; }
        return false;
    }
    __device__ __forceinline__ unsigned a_row(const pg8::Unit& u, int r) const { return (u.pm < 128) ? (unsigned)((u.pm >> 6) * SEQ + r * 64 + (u.pm & 63)) : (unsigned)(NTOK + (u.pm - 128) * 256 + r); }
    __device__ __forceinline__ const char* a_base() const { return A; }
    __device__ __forceinline__ const char* b_base(const pg8::Unit& u) const { return (mode == 2) ? Bt + (size_t)(u.pn - 16) * 256 * D : Bt + (size_t)u.pn * 256 * D * 2; }
};
__device__ __forceinline__ unsigned q8(float s) { return (unsigned)(s * 255.0f + 0.5f); }
struct EpiInG8 {
    static constexpr bool PERM = true, TRANS = true, FP8 = true;
    unsigned char* UG;
    __device__ __forceinline__ void operator()(const f32x4 (&acc)[2][2][4][2], const pg8::Unit& u, int wr, int wc, int fr, int fq) const {
        const int col0 = (u.pn - 16) * 256 + wc * 32 + 8 * fq;
#pragma unroll
        for (int ai = 0; ai < 2; ++ai)
#pragma unroll
            for (int m = 0; m < 4; ++m) { const int r = ai * 128 + wr * 64 + m * 16 + fr; const size_t row = (size_t)((u.pm >> 6) * SEQ + r * 64 + (u.pm & 63));
                unsigned char* rowp = UG + row * 4096 + col0;
#pragma unroll
                for (int bj = 0; bj < 2; ++bj) { f32x4 v0 = acc[ai][bj][m][0] * (1.0f / W8SCALE), v1 = acc[ai][bj][m][1] * (1.0f / W8SCALE);
#pragma unroll
                    for (int j = 0; j < 4; ++j) { v0[j] = sigmoidf_(v0[j]); v1[j] = sigmoidf_(v1[j]); }
                    u32x2 w; w.x = q8(v0[0]) | (q8(v0[1]) << 8) | (q8(v0[2]) << 16) | (q8(v0[3]) << 24); w.y = q8(v1[0]) | (q8(v1[1]) << 8) | (q8(v1[2]) << 16) | (q8(v1[3]) << 24);
                    *(u32x2*)(rowp + bj * 128) = w; } }
    }
};
struct EpiInA {
    static constexpr bool PERM = true, TRANS = true, FP8 = false;
    unsigned char* ws;
    __device__ __forceinline__ void operator()(const f32x4 (&acc)[2][2][4][2], const pg8::Unit& u, int wr, int wc, int fr, int fq) const {
        const bool isctx = u.pm >= 128, isg = u.pn >= 16;
        const size_t boff = isctx ? WS_UCA : (isg ? WS_UG : WS_UA);
        bf16* base = (bf16*)(ws + boff); const size_t ld = isg ? 4096 : S5W; const int colt = isg ? (u.pn - 16) * 256 : u.pn * 256;
        const int col0 = colt + wc * 32 + 8 * fq;
#pragma unroll
        for (int ai = 0; ai < 2; ++ai)
#pragma unroll
            for (int m = 0; m < 4; ++m) { const int r = ai * 128 + wr * 64 + m * 16 + fr;
                const size_t row = isctx ? (size_t)((u.pm - 128) * 256 + r) : (size_t)((u.pm >> 6) * SEQ + r * 64 + (u.pm & 63));
                bf16* rowp = base + row * ld + col0;
#pragma unroll
                for (int bj = 0; bj < 2; ++bj) { f32x4 v0 = acc[ai][bj][m][0], v1 = acc[ai][bj][m][1];
                    if (isg) {
#pragma unroll
                        for (int j = 0; j < 4; ++j) { v0[j] = sigmoidf_(v0[j]); v1[j] = sigmoidf_(v1[j]); } }
                    u32x4 w; w.x = cvt_pk_bf16(v0[0], v0[1]); w.y = cvt_pk_bf16(v0[2], v0[3]); w.z = cvt_pk_bf16(v1[0], v1[1]); w.w = cvt_pk_bf16(v1[2], v1[3]);
                    *(u32x4*)(rowp + bj * 128) = w; } }
    }
};
struct EpiInH {
    static constexpr bool PERM = false, TRANS = false, FP8 = false;
    bf16* UH;
    __device__ __forceinline__ void operator()(const f32x4 (&acc)[2][2][4][2], const pg8::Unit& u, int wr, int wc, int fr, int fq) const {
        const int b = u.pm >> 6, w = u.pm & 63;
#pragma unroll
        for (int bj = 0; bj < 2; ++bj)
#pragma unroll
            for (int n = 0; n < 2; ++n) { const int ch = (u.pn - 4) * 256 + bj * 128 + wc * 32 + n * 16 + fr;
                bf16* cp = UH + ((size_t)(b * 3072 + ch) * SEQ + w * 256);
#pragma unroll
                for (int ai = 0; ai < 2; ++ai)
#pragma unroll
                    for (int m = 0; m < 4; ++m) { const int r0 = ai * 128 + wr * 64 + m * 16 + 4 * fq; const f32x4 v = acc[ai][bj][m][n];
                        *(u32x2*)(cp + r0) = (u32x2){cvt_pk_bf16(v[0], v[1]), cvt_pk_bf16(v[2], v[3])}; } }
    }
};

template <bool PASSB>
__device__ __forceinline__ void s5_pass(Frame& F) {
    constexpr int nk = PASSB ? 256 : 260;
    constexpr int nitems = 2 * nk * 8;
    LAS unsigned char* sl = F.lds + F.wave * 8704;
    const int lane = F.lane, pl = lane & 31, hi = lane >> 5, fr = lane & 15, fq = lane >> 4;
    const bf16* UA = (const bf16*)(F.ws + WS_UA); const bf16* UCA = (const bf16*)(F.ws + WS_UCA);
    const bf16* BBT = (const bf16*)(F.ws + WS_BBT); const bf16* CTT = (const bf16*)(F.ws + WS_CTT); const f32x2* LAM = (const f32x2*)(F.ws + WS_LAM);
    f32x2* EB = (f32x2*)(F.ws + WS_E); const f32x2* SINB = (const f32x2*)(F.ws + WS_SIN); bf16* Y = (bf16*)(F.ws + WS_Y);
    const int s_r = 16 * ((pl >> 2) & 1) + 4 * (pl >> 3) + (pl & 3);
    for (int it = F.bx; it < nitems; it += F.G) {
        const int gq = it & 7, rest = it >> 3; const int b = rest / nk, kk = rest % nk; const int kc = PASSB ? kk + 4 : kk;
        const int g = gq * 8 + F.wave;
        const bf16* urow = (kc < 4) ? (UCA + (size_t)(b * CTX + kc * 64) * S5W + 16 * g) : (UA + (size_t)(b * SEQ + (kc - 4) * 64) * S5W + 16 * g);
        f32x4 yacc[4];
#pragma unroll
        for (int q = 0; q < 4; ++q) yacc[q] = (f32x4){0.f, 0.f, 0.f, 0.f};
#pragma unroll
        for (int d = 0; d < 2; ++d) {
            const int dg = d * 64 + g;
            bf16x8 bb[4];
#pragma unroll
            for (int ni = 0; ni < 4; ++ni) bb[ni] = *(const bf16x8*)(BBT + (size_t)(dg * 128 + 32 * ni + pl) * 16 + 8 * hi);
            bf16x8 ct[4];
            if (PASSB) {
#pragma unroll
                for (int ks = 0; ks < 4; ++ks) ct[ks] = *(const bf16x8*)(CTT + (size_t)(dg * 16 + fr) * 128 + 32 * ks + 8 * fq);
            }
            const f32x2 lamA = LAM[dg * 64 + pl], lamB = LAM[dg * 64 + pl + 32];
            f32x2 l2 = cmul(lamA, lamA), l4 = cmul(l2, l2), l8 = cmul(l4, l4); const f32x2 lam16A = cmul(l8, l8);
            l2 = cmul(lamB, lamB); l4 = cmul(l2, l2); l8 = cmul(l4, l4); const f32x2 lam16B = cmul(l8, l8);
            f32x2 cA = (f32x2){0.f, 0.f}, cB = (f32x2){0.f, 0.f};
            const size_t sidx = ((size_t)((d * 2 + b) * NCH + kc)) * 4096 + g * 64 + pl;
            if (PASSB) { cA = SINB[sidx]; cB = SINB[sidx + 32]; }
#pragma unroll
            for (int sc = 0; sc < 2; ++sc) {
                const int iscan = 32 * sc + s_r; const int tok = (d == 0) ? iscan : 63 - iscan;
                const bf16x8 a = *(const bf16x8*)(urow + (size_t)tok * S5W + 8 * hi);
                f32x16 acc[4];
#pragma unroll
                for (int ni = 0; ni < 4; ++ni) { f32x16 z;
#pragma unroll
                    for (int i = 0; i < 16; ++i) z[i] = 0.f;
                    acc[ni] = __builtin_amdgcn_mfma_f32_32x32x16_bf16(a, bb[ni], z, 0, 0, 0); }
                asm volatile("s_nop 7\n\ts_nop 7" : "+v"(acc[0]), "+v"(acc[1]), "+v"(acc[2]), "+v"(acc[3]) : "v"(a), "v"(bb[0]), "v"(bb[1]), "v"(bb[2]), "v"(bb[3]));
                f32x2 sA = hi ? (f32x2){0.f, 0.f} : cA, sB = hi ? (f32x2){0.f, 0.f} : cB;
#pragma unroll
                for (int i = 0; i < 16; ++i) {
                    sA = (f32x2){lamA.x * sA.x - lamA.y * sA.y + acc[0][i], lamA.x * sA.y + lamA.y * sA.x + acc[2][i]}; acc[0][i] = sA.x; acc[2][i] = sA.y;
                    sB = (f32x2){lamB.x * sB.x - lamB.y * sB.y + acc[1][i], lamB.x * sB.y + lamB.y * sB.x + acc[3][i]}; acc[1][i] = sB.x; acc[3][i] = sB.y; }
                const f32x2 pA = (f32x2){__shfl_xor(sA.x, 32), __shfl_xor(sA.y, 32)}, pB = (f32x2){__shfl_xor(sB.x, 32), __shfl_xor(sB.y, 32)};
                const f32x2 tA = cmul(lam16A, hi ? pA : sA), tB = cmul(lam16B, hi ? pB : sB);
                const f32x2 e1A = (hi ? sA : pA) + tA, e1B = (hi ? sB : pB) + tB;
                const f32x2 ciA = hi ? pA : (f32x2){0.f, 0.f}, ciB = hi ? pB : (f32x2){0.f, 0.f};
                if (PASSB) {
                    f32x2 wA = cmul(lamA, ciA), wB = cmul(lamB, ciB);
#pragma unroll
                    for (int i = 0; i < 16; ++i) {
                        acc[0][i] += wA.x; acc[2][i] += wA.y; acc[1][i] += wB.x; acc[3][i] += wB.y;
                        *(LAS u32x2*)(sl + (16 * hi + i) * 272 + pl * 8) = (u32x2){cvt_pk_bf16(acc[0][i], acc[2][i]), cvt_pk_bf16(acc[1][i], acc[3][i])};
                        wA = cmul(wA, lamA); wB = cmul(wB, lamB); }
                    bf16x8 bsv[2][4];
#pragma unroll
                    for (int tt = 0; tt < 2; ++tt) {
                        const int rowi = (d == 0) ? (16 * tt + fr) : (16 * tt + 15 - fr);
#pragma unroll
                        for (int ks = 0; ks < 4; ++ks) bsv[tt][ks] = *(const LAS bf16x8*)(sl + rowi * 272 + (32 * ks + 8 * fq) * 2);
                    }
#pragma unroll
                    for (int tt = 0; tt < 2; ++tt) {
                        const int tq = (d == 0) ? (2 * sc + tt) : (3 - 2 * sc - tt);
#pragma unroll
                        for (int ks = 0; ks < 4; ++ks) yacc[tq] = __builtin_amdgcn_mfma_f32_16x16x32_bf16(ct[ks], bsv[tt][ks], yacc[tq], 0, 0, 0);
                    }
                    asm volatile("s_nop 7\n\ts_nop 7" : "+v"(yacc[0]), "+v"(yacc[1]), "+v"(yacc[2]), "+v"(yacc[3]) : "v"(bsv[0][0]), "v"(bsv[0][1]), "v"(bsv[0][2]), "v"(bsv[0][3]), "v"(bsv[1][0]), "v"(bsv[1][1]), "v"(bsv[1][2]), "v"(bsv[1][3]), "v"(ct[0]), "v"(ct[1]), "v"(ct[2]), "v"(ct[3]));
                    asm volatile("s_waitcnt lgkmcnt(0)" ::: "memory");
                }
                cA = e1A; cB = e1B;
            }
            if (!PASSB) { if (hi == 0) { EB[sidx] = cA; EB[sidx + 32] = cB; } }
        }
        if (PASSB) {
            const f32x4 dsk = *(const f32x4*)(F.in[IN_S5D] + 16 * g + 4 * fq);
#pragma unroll
            for (int tq = 0; tq < 4; ++tq) { const int tok = 16 * tq + fr;
                const u32x2 uu = *(const u32x2*)(urow + (size_t)tok * S5W + 4 * fq);
                f32x4 v; v[0] = yacc[tq][0] + bflo(uu.x) * dsk[0]; v[1] = yacc[tq][1] + bfhi(uu.x) * dsk[1]; v[2] = yacc[tq][2] + bflo(uu.y) * dsk[2]; v[3] = yacc[tq][3] + bfhi(uu.y) * dsk[3];
#pragma unroll
                for (int j = 0; j < 4; ++j) { const float x = v[j]; v[j] = x * sigmoidf_(1.5957691216f * (x + 0.044715f * x * x * x)); }
                *(u32x2*)(Y + (size_t)(b * SEQ + (kc - 4) * 64 + tok) * S5W + 16 * g + 4 * fq) = (u32x2){cvt_pk_bf16(v[0], v[1]), cvt_pk_bf16(v[2], v[3])}; }
        }
    }
}
__device__ __forceinline__ void s5_pass_a_simple(Frame& F) {
    constexpr int nitems = 2 * NCH * 8;
    const int lane = F.lane;
    const bf16* UA = (const bf16*)(F.ws + WS_UA); const bf16* UCA = (const bf16*)(F.ws + WS_UCA);
    const bf16* BBT = (const bf16*)(F.ws + WS_BBT); const f32x2* LAM = (const f32x2*)(F.ws + WS_LAM); f32x2* EB = (f32x2*)(F.ws + WS_E);
    for (int it = F.bx; it < nitems; it += F.G) {
        const int gq = it & 7, rest = it >> 3; const int b = rest / NCH, kc = rest % NCH; const int g = gq * 8 + F.wave;
        const bf16* urow = (kc < 4) ? (UCA + (size_t)(b * CTX + kc * 64) * S5W + 16 * g) : (UA + (size_t)(b * SEQ + (kc - 4) * 64) * S5W + 16 * g);
#pragma unroll 1
        for (int d = 0; d < 2; ++d) {
            const int dg = d * 64 + g; const f32x2 lam = LAM[dg * 64 + lane];
            float bre[16], bim[16];
            { const u32x4 r0 = *(const u32x4*)(BBT + (size_t)(dg * 128 + lane) * 16), r1 = *(const u32x4*)(BBT + (size_t)(dg * 128 + lane) * 16 + 8);
              const u32x4 i0 = *(const u32x4*)(BBT + (size_t)(dg * 128 + 64 + lane) * 16), i1 = *(const u32x4*)(BBT + (size_t)(dg * 128 + 64 + lane) * 16 + 8);
              bre[0] = bflo(r0.x); bre[1] = bfhi(r0.x); bre[2] = bflo(r0.y); bre[3] = bfhi(r0.y); bre[4] = bflo(r0.z); bre[5] = bfhi(r0.z); bre[6] = bflo(r0.w); bre[7] = bfhi(r0.w);
              bre[8] = bflo(r1.x); bre[9] = bfhi(r1.x); bre[10] = bflo(r1.y); bre[11] = bfhi(r1.y); bre[12] = bflo(r1.z); bre[13] = bfhi(r1.z); bre[14] = bflo(r1.w); bre[15] = bfhi(r1.w);
              bim[0] = bflo(i0.x); bim[1] = bfhi(i0.x); bim[2] = bflo(i0.y); bim[3] = bfhi(i0.y); bim[4] = bflo(i0.z); bim[5] = bfhi(i0.z); bim[6] = bflo(i0.w); bim[7] = bfhi(i0.w);
              bim[8] = bflo(i1.x); bim[9] = bfhi(i1.x); bim[10] = bflo(i1.y); bim[11] = bfhi(i1.y); bim[12] = bflo(i1.z); bim[13] = bfhi(i1.z); bim[14] = bflo(i1.w); bim[15] = bfhi(i1.w); }
            f32x2 st = (f32x2){0.f, 0.f};
#pragma unroll 4
            for (int i = 0; i < 64; ++i) { const int tok = (d == 0) ? i : 63 - i;
                const u32x4 u0 = *(const u32x4*)(urow + (size_t)tok * S5W), u1 = *(const u32x4*)(urow + (size_t)tok * S5W + 8);
                float u[16]; u[0] = bflo(u0.x); u[1] = bfhi(u0.x); u[2] = bflo(u0.y); u[3] = bfhi(u0.y); u[4] = bflo(u0.z); u[5] = bfhi(u0.z); u[6] = bflo(u0.w); u[7] = bfhi(u0.w);
                u[8] = bflo(u1.x); u[9] = bfhi(u1.x); u[10] = bflo(u1.y); u[11] = bfhi(u1.y); u[12] = bflo(u1.z); u[13] = bfhi(u1.z); u[14] = bflo(u1.w); u[15] = bfhi(u1.w);
                float br = 0.f, bi = 0.f;
#pragma unroll
                for (int c = 0; c < 16; ++c) { br += bre[c] * u[c]; bi += bim[c] * u[c]; }
                st = (f32x2){lam.x * st.x - lam.y * st.y + br, lam.x * st.y + lam.y * st.x + bi}; }
            EB[((size_t)((d * 2 + b) * NCH + kc)) * 4096 + g * 64 + lane] = st;
        }
    }
}
__device__ __forceinline__ void s5_pass_b2(Frame& F) {
    constexpr int nitems = 2 * 256 * 8;
    LAS unsigned char* sl = F.lds + F.wave * 8704;
    const int lane = F.lane, fr = lane & 15, fq = lane >> 4;
    const bf16* UA = (const bf16*)(F.ws + WS_UA); const bf16* BBT = (const bf16*)(F.ws + WS_BBT); const bf16* CTT = (const bf16*)(F.ws + WS_CTT);
    const f32x2* LAM = (const f32x2*)(F.ws + WS_LAM); const f32x2* SINB = (const f32x2*)(F.ws + WS_SIN); bf16* Y = (bf16*)(F.ws + WS_Y);
    for (int it = F.bx; it < nitems; it += F.G) {
        const int gq = it & 7, rest = it >> 3; const int b = rest >> 8, kc = (rest & 255) + 4; const int g = gq * 8 + F.wave;
        const bf16* urow = UA + (size_t)(b * SEQ + (kc - 4) * 64) * S5W + 16 * g;
        f32x4 yacc[4];
#pragma unroll
        for (int q = 0; q < 4; ++q) yacc[q] = (f32x4){0.f, 0.f, 0.f, 0.f};
#pragma unroll
        for (int d = 0; d < 2; ++d) {
            const int dg = d * 64 + g; const f32x2 lam = LAM[dg * 64 + lane];
            float bre[16], bim[16];
            { const u32x4 r0 = *(const u32x4*)(BBT + (size_t)(dg * 128 + lane) * 16), r1 = *(const u32x4*)(BBT + (size_t)(dg * 128 + lane) * 16 + 8);
              const u32x4 i0 = *(const u32x4*)(BBT + (size_t)(dg * 128 + 64 + lane) * 16), i1 = *(const u32x4*)(BBT + (size_t)(dg * 128 + 64 + lane) * 16 + 8);
              bre[0] = bflo(r0.x); bre[1] = bfhi(r0.x); bre[2] = bflo(r0.y); bre[3] = bfhi(r0.y); bre[4] = bflo(r0.z); bre[5] = bfhi(r0.z); bre[6] = bflo(r0.w); bre[7] = bfhi(r0.w);
              bre[8] = bflo(r1.x); bre[9] = bfhi(r1.x); bre[10] = bflo(r1.y); bre[11] = bfhi(r1.y); bre[12] = bflo(r1.z); bre[13] = bfhi(r1.z); bre[14] = bflo(r1.w); bre[15] = bfhi(r1.w);
              bim[0] = bflo(i0.x); bim[1] = bfhi(i0.x); bim[2] = bflo(i0.y); bim[3] = bfhi(i0.y); bim[4] = bflo(i0.z); bim[5] = bfhi(i0.z); bim[6] = bflo(i0.w); bim[7] = bfhi(i0.w);
              bim[8] = bflo(i1.x); bim[9] = bfhi(i1.x); bim[10] = bflo(i1.y); bim[11] = bfhi(i1.y); bim[12] = bflo(i1.z); bim[13] = bfhi(i1.z); bim[14] = bflo(i1.w); bim[15] = bfhi(i1.w); }
            bf16x8 ct[4];
#pragma unroll
            for (int ks = 0; ks < 4; ++ks) ct[ks] = *(const bf16x8*)(CTT + (size_t)(dg * 16 + fr) * 128 + 32 * ks + 8 * fq);
            f32x2 st = SINB[((size_t)((d * 2 + b) * NCH + kc)) * 4096 + g * 64 + lane];
#pragma unroll
            for (int h = 0; h < 2; ++h) {
#pragma unroll 4
                for (int i = 0; i < 32; ++i) { const int sc = 32 * h + i; const int tok = (d == 0) ? sc : 63 - sc;
                    const u32x4 u0 = *(const u32x4*)(urow + (size_t)tok * S5W), u1 = *(const u32x4*)(urow + (size_t)tok * S5W + 8);
                    float u[16]; u[0] = bflo(u0.x); u[1] = bfhi(u0.x); u[2] = bflo(u0.y); u[3] = bfhi(u0.y); u[4] = bflo(u0.z); u[5] = bfhi(u0.z); u[6] = bflo(u0.w); u[7] = bfhi(u0.w);
                    u[8] = bflo(u1.x); u[9] = bfhi(u1.x); u[10] = bflo(u1.y); u[11] = bfhi(u1.y); u[12] = bflo(u1.z); u[13] = bfhi(u1.z); u[14] = bflo(u1.w); u[15] = bfhi(u1.w);
                    float br = 0.f, bi = 0.f;
#pragma unroll
                    for (int c = 0; c < 16; ++c) { br += bre[c] * u[c]; bi += bim[c] * u[c]; }
                    st = (f32x2){lam.x * st.x - lam.y * st.y + br, lam.x * st.y + lam.y * st.x + bi};
                    *(LAS unsigned*)(sl + (tok & 31) * 272 + lane * 4) = cvt_pk_bf16(st.x, st.y); }
                const int t0q = (d == 0) ? 2 * h : 2 * (1 - h);
                bf16x8 bsv[2][4];
#pragma unroll
                for (int tt = 0; tt < 2; ++tt)
#pragma unroll
                    for (int ks = 0; ks < 4; ++ks) bsv[tt][ks] = *(const LAS bf16x8*)(sl + (16 * tt + fr) * 272 + (32 * ks + 8 * fq) * 2);
#pragma unroll
                for (int tt = 0; tt < 2; ++tt)
#pragma unroll
                    for (int ks = 0; ks < 4; ++ks) yacc[t0q + tt] = __builtin_amdgcn_mfma_f32_16x16x32_bf16(ct[ks], bsv[tt][ks], yacc[t0q + tt], 0, 0, 0);
                asm volatile("s_nop 7\n\ts_nop 7" : "+v"(yacc[0]), "+v"(yacc[1]), "+v"(yacc[2]), "+v"(yacc[3]) : "v"(bsv[0][0]), "v"(bsv[0][1]), "v"(bsv[0][2]), "v"(bsv[0][3]), "v"(bsv[1][0]), "v"(bsv[1][1]), "v"(bsv[1][2]), "v"(bsv[1][3]), "v"(ct[0]), "v"(ct[1]), "v"(ct[2]), "v"(ct[3]));
                asm volatile("s_waitcnt lgkmcnt(0)" ::: "memory");
            }
        }
        const f32x4 dsk = *(const f32x4*)(F.in[IN_S5D] + 16 * g + 4 * fq);
#pragma unroll
        for (int tq = 0; tq < 4; ++tq) { const int tok = 16 * tq + fr;
            const u32x2 uu = *(const u32x2*)(urow + (size_t)tok * S5W + 4 * fq);
            f32x4 v; v[0] = yacc[tq][0] + bflo(uu.x) * dsk[0]; v[1] = yacc[tq][1] + bfhi(uu.x) * dsk[1]; v[2] = yacc[tq][2] + bflo(uu.y) * dsk[2]; v[3] = yacc[tq][3] + bfhi(uu.y) * dsk[3];
#pragma unroll
            for (int j = 0; j < 4; ++j) { const float x = v[j]; v[j] = x * sigmoidf_(1.5957691216f * (x + 0.044715f * x * x * x)); }
            *(u32x2*)(Y + (size_t)(b * SEQ + (kc - 4) * 64 + tok) * S5W + 16 * g + 4 * fq) = (u32x2){cvt_pk_bf16(v[0], v[1]), cvt_pk_bf16(v[2], v[3])}; }
    }
}
template <bool PASSB>
__device__ __forceinline__ void s5_pass3(Frame& F) {
    constexpr int nk = PASSB ? 256 : NCH; constexpr int nitems = 2 * nk * 8;
    LAS unsigned char* sl = F.lds + F.wave * 8704;
    const int lane = F.lane, fr = lane & 15, fq = lane >> 4;
    const bf16* UA = (const bf16*)(F.ws + WS_UA); const bf16* UCA = (const bf16*)(F.ws + WS_UCA); const bf16* BB2 = (const bf16*)(F.ws + WS_BB2); const bf16* CTT = (const bf16*)(F.ws + WS_CTT);
    const f32x2* LAM = (const f32x2*)(F.ws + WS_LAM); const f32x2* SINB = (const f32x2*)(F.ws + WS_SIN); f32x2* EB = (f32x2*)(F.ws + WS_E); bf16* Y = (bf16*)(F.ws + WS_Y);
    const bf16x8 zf = (bf16x8){0, 0, 0, 0, 0, 0, 0, 0};
    int curg = -1; bf16x8 af[2][8], ct[2][4]; f32x2 lamv[2]; f32x4 dsk = (f32x4){0.f, 0.f, 0.f, 0.f};
    for (int it = F.bx; it < nitems; it += F.G) {
        const int gq = it & 7, rest = it >> 3; const int b = rest / nk, kk = rest % nk; const int kc = PASSB ? kk + 4 : kk; const int g = gq * 8 + F.wave;
        if (g != curg) { curg = g;
#pragma unroll
            for (int d = 0; d < 2; ++d) { const int dg = d * 64 + g; lamv[d] = LAM[dg * 64 + lane];
#pragma unroll
                for (int nt = 0; nt < 8; ++nt) af[d][nt] = (fq < 2) ? *(const bf16x8*)(BB2 + (size_t)(dg * 128 + 16 * nt + fr) * 16 + 8 * fq) : zf;
                if (PASSB) {
#pragma unroll
                    for (int ks = 0; ks < 4; ++ks) ct[d][ks] = *(const bf16x8*)(CTT + (size_t)(dg * 16 + fr) * 128 + 32 * ks + 8 * fq); } }
            if (PASSB) dsk = *(const f32x4*)(F.in[IN_S5D] + 16 * g + 4 * fq); }
        const bf16* urow = (kc < 4) ? (UCA + (size_t)(b * CTX + kc * 64) * S5W + 16 * g) : (UA + (size_t)(b * SEQ + (kc - 4) * 64) * S5W + 16 * g);
        bf16x8 uf[4];
#pragma unroll
        for (int q = 0; q < 4; ++q) uf[q] = (fq < 2) ? *(const bf16x8*)(urow + (size_t)(16 * q + fr) * S5W + 8 * fq) : zf;
        u32x2 uu[4];
        if (PASSB) {
#pragma unroll
            for (int tq = 0; tq < 4; ++tq) uu[tq] = *(const u32x2*)(urow + (size_t)(16 * tq + fr) * S5W + 4 * fq); }
        f32x2 st0[2];
#pragma unroll
        for (int d = 0; d < 2; ++d) st0[d] = PASSB ? SINB[((size_t)((d * 2 + b) * NCH + kc)) * 4096 + g * 64 + lane] : (f32x2){0.f, 0.f};
        f32x4 yacc[4];
#pragma unroll
        for (int q = 0; q < 4; ++q) yacc[q] = (f32x4){0.f, 0.f, 0.f, 0.f};
#pragma unroll
        for (int d = 0; d < 2; ++d) {
            const f32x2 lam = lamv[d]; f32x2 st = st0[d];
#pragma unroll
            for (int h = 0; h < 2; ++h) {
                const int T0 = (d == 0) ? 32 * h : 32 * (1 - h);
#pragma unroll
                for (int tt = 0; tt < 2; ++tt)
#pragma unroll
                    for (int nt = 0; nt < 8; ++nt) { const f32x4 dd = __builtin_amdgcn_mfma_f32_16x16x32_bf16(af[d][nt], uf[(T0 >> 4) + tt], (f32x4){0.f, 0.f, 0.f, 0.f}, 0, 0, 0);
                        *(LAS u32x2*)(sl + (16 * tt + fr) * 272 + (16 * nt + 4 * fq) * 2) = (u32x2){cvt_pk_bf16(dd[0], dd[1]), cvt_pk_bf16(dd[2], dd[3])}; }
                asm volatile("s_waitcnt lgkmcnt(0)" ::: "memory");
#pragma unroll 8
                for (int i = 0; i < 32; ++i) { const int r = (d == 0) ? i : 31 - i; LAS unsigned* cell = (LAS unsigned*)(sl + r * 272 + lane * 4);
                    const unsigned w = *cell; const float br = bflo(w), bi = bfhi(w);
                    st = (f32x2){lam.x * st.x - lam.y * st.y + br, lam.x * st.y + lam.y * st.x + bi};
                    if (PASSB) *cell = cvt_pk_bf16(st.x, st.y); }
                if (PASSB) {
                    const int t0q = T0 >> 4;
                    bf16x8 bsv[2][4];
#pragma unroll
                    for (int tt = 0; tt < 2; ++tt)
#pragma unroll
                        for (int ks = 0; ks < 4; ++ks) bsv[tt][ks] = *(const LAS bf16x8*)(sl + (16 * tt + fr) * 272 + (32 * ks + 8 * fq) * 2);
#pragma unroll
                    for (int tt = 0; tt < 2; ++tt)
#pragma unroll
                        for (int ks = 0; ks < 4; ++ks) yacc[t0q + tt] = __builtin_amdgcn_mfma_f32_16x16x32_bf16(ct[d][ks], bsv[tt][ks], yacc[t0q + tt], 0, 0, 0);
                    asm volatile("s_nop 7\n\ts_nop 7" : "+v"(yacc[0]), "+v"(yacc[1]), "+v"(yacc[2]), "+v"(yacc[3]) : "v"(bsv[0][0]), "v"(bsv[0][1]), "v"(bsv[0][2]), "v"(bsv[0][3]), "v"(bsv[1][0]), "v"(bsv[1][1]), "v"(bsv[1][2]), "v"(bsv[1][3]));
                }
                asm volatile("s_waitcnt lgkmcnt(0)" ::: "memory");
            }
            if (!PASSB) EB[((size_t)((d * 2 + b) * NCH + kc)) * 4096 + g * 64 + lane] = st;
        }
        if (PASSB) {
#pragma unroll
            for (int tq = 0; tq < 4; ++tq) { const int tok = 16 * tq + fr;
                f32x4 v; v[0] = yacc[tq][0] + bflo(uu[tq].x) * dsk[0]; v[1] = yacc[tq][1] + bfhi(uu[tq].x) * dsk[1]; v[2] = yacc[tq][2] + bflo(uu[tq].y) * dsk[2]; v[3] = yacc[tq][3] + bfhi(uu[tq].y) * dsk[3];
#pragma unroll
                for (int j = 0; j < 4; ++j) { const float x = v[j]; v[j] = x * sigmoidf_(1.5957691216f * (x + 0.044715f * x * x * x)); }
                *(u32x2*)(Y + (size_t)(b * SEQ + (kc - 4) * 64 + tok) * S5W + 16 * g + 4 * fq) = (u32x2){cvt_pk_bf16(v[0], v[1]), cvt_pk_bf16(v[2], v[3])}; }
        }
    }
}
__device__ __forceinline__ void s5_carry_item(Frame& F, int item) {
    const int idx = item * NTHR + F.tid; const int d = idx >> 13, b = (idx >> 12) & 1, gp = idx & 4095;
    const f32x2 lam = ((const f32x2*)(F.ws + WS_LAM))[d * 4096 + gp];
    f32x2 l = cmul(lam, lam); l = cmul(l, l); l = cmul(l, l); l = cmul(l, l); l = cmul(l, l); l = cmul(l, l);
    const f32x2* EB = (const f32x2*)(F.ws + WS_E) + (size_t)((d * 2 + b) * NCH) * 4096 + gp; f32x2* SB = (f32x2*)(F.ws + WS_SIN) + (size_t)((d * 2 + b) * NCH) * 4096 + gp;
    f32x2 s = (f32x2){0.f, 0.f};
#pragma unroll 1
    for (int st0 = 0; st0 < NCH; st0 += 20) { f32x2 e[20];
#pragma unroll
        for (int j = 0; j < 20; ++j) { const int st = st0 + j; const int kc = (d == 0) ? st : (st < 4 ? 3 - st : NCH + 3 - st); e[j] = EB[(size_t)kc * 4096]; }
#pragma unroll
        for (int j = 0; j < 20; ++j) { const int st = st0 + j; const int kc = (d == 0) ? st : (st < 4 ? 3 - st : NCH + 3 - st); SB[(size_t)kc * 4096] = s; s = cmul(l, s) + e[j]; } }
}

__device__ __forceinline__ int fsw(int i) { return i ^ ((i >> 5) & 7) ^ (((i >> 6) & 3) << 3); }
__host__ __device__ constexpr float w16c(int j) { return j == 0 ? 1.f : j == 1 ? 0.9238795325f : j == 2 ? 0.7071067812f : j == 3 ? 0.3826834324f : j == 4 ? 0.f : j == 5 ? -0.3826834324f : j == 6 ? -0.7071067812f : -0.9238795325f; }
__host__ __device__ constexpr float w16s(int j) { return j == 0 ? 0.f : j == 1 ? 0.3826834324f : j == 2 ? 0.7071067812f : j == 3 ? 0.9238795325f : j == 4 ? 1.f : j == 5 ? 0.9238795325f : j == 6 ? 0.7071067812f : 0.3826834324f; }
__host__ __device__ constexpr int bitrev(int q, int bits) { int r = 0; for (int i = 0; i < bits; ++i) r |= ((q >> i) & 1) << (bits - 1 - i); return r; }
template <int R, bool INV> __device__ __forceinline__ void dft_reg(f32x2 (&x)[R]) {
#pragma unroll
    for (int len = R; len >= 2; len >>= 1) { const int half = len >> 1, step = 16 / len;
#pragma unroll
        for (int b0 = 0; b0 < R; b0 += len)
#pragma unroll
            for (int k = 0; k < half; ++k) { const f32x2 a = x[b0 + k], b = x[b0 + k + half]; x[b0 + k] = a + b; const f32x2 dd = a - b; const int j = k * step;
                if (j == 0) x[b0 + k + half] = dd;
                else if (j == 4) x[b0 + k + half] = INV ? (f32x2){-dd.y, dd.x} : (f32x2){dd.y, -dd.x};
                else { const float c = w16c(j), s = w16s(j); x[b0 + k + half] = INV ? (f32x2){dd.x * c - dd.y * s, dd.x * s + dd.y * c} : (f32x2){dd.x * c + dd.y * s, dd.y * c - dd.x * s}; } } }
}
template <int R, int LOGN, bool INV> __device__ __forceinline__ void fft_pass(LAS f32x2* buf, int tid) {
    constexpr int LOGR = (R == 16) ? 4 : 3, LOGM = LOGN - LOGR, M = 1 << LOGM, NBF = 16384 / R / NTHR;
#pragma unroll 1
    for (int it = 0; it < NBF; ++it) {
        int tl = tid; asm volatile("" : "+v"(tl));
        const int bq = tl + NTHR * it, blk = bq >> LOGM, j = bq & (M - 1), base = (blk << LOGN) + j; const int fb = fsw(base);
#define FADDR(q) (fb ^ (((q) << LOGM) ^ ((((q) << LOGM) >> 5) & 7) ^ (((((q) << LOGM) >> 6) & 3) << 3)))
        f32x2 x[R];
#pragma unroll
        for (int q = 0; q < R; ++q) x[q] = buf[FADDR(q)];
        f32x2 w1 = (f32x2){1.f, 0.f};
        if (LOGM > 0) { const float rev = (float)j * (1.0f / (float)(1 << LOGN)); const float sn = sin_rev(rev); w1 = (f32x2){cos_rev(rev), INV ? sn : -sn}; }
        if (!INV) {
            dft_reg<R, false>(x);
            buf[fb] = x[0]; f32x2 w = w1;
#pragma unroll
            for (int q = 1; q < R; ++q) { buf[FADDR(q)] = (LOGM > 0) ? cmul(x[bitrev(q, LOGR)], w) : x[bitrev(q, LOGR)]; if (LOGM > 0) w = cmul(w, w1); }
        } else {
            if (LOGM > 0) { f32x2 w = w1;
#pragma unroll
                for (int q = 1; q < R; ++q) { x[q] = cmul(x[q], w); w = cmul(w, w1); } }
            dft_reg<R, true>(x);
#pragma unroll
            for (int q = 0; q < R; ++q) buf[FADDR(q)] = x[bitrev(q, LOGR)];
        }
#undef FADDR
    }
    __syncthreads();
}
#ifndef FFT_TEST
#define FFT_TEST 0
#endif
__device__ __forceinline__ void fft_fwd(LAS f32x2* buf, int tid) { if (FFT_TEST & 1) return; fft_pass<16, 14, false>(buf, tid); fft_pass<16, 10, false>(buf, tid); fft_pass<8, 6, false>(buf, tid); fft_pass<8, 3, false>(buf, tid); }
__device__ __forceinline__ void fft_inv(LAS f32x2* buf, int tid) { if (FFT_TEST & 2) return; fft_pass<8, 3, true>(buf, tid); fft_pass<8, 6, true>(buf, tid); fft_pass<16, 10, true>(buf, tid); fft_pass<16, 14, true>(buf, tid); }
__device__ __forceinline__ float block_sum(Frame& F, float v) {
    LAS float* red = (LAS float*)(F.lds + LDS_X);
    v = wave_sum(v); __syncthreads(); if (F.lane == 0) red[F.wave] = v; __syncthreads();
    float s = 0.f;
#pragma unroll
    for (int w = 0; w < NWAVES; ++w) s += red[w];
    return s;
}
__device__ __forceinline__ float sconv(const bf16* UH, int b, int ch, int t, float w0, float w1, float w2) {
    const bf16* p = UH + (size_t)(b * 3072 + ch) * SEQ;
    const int tm = t > 0 ? t - 1 : 0, tp = t < SEQ - 1 ? t + 1 : SEQ - 1;
    const float xm = bf2f(p[tm]), x0 = bf2f(p[t]), xp = bf2f(p[tp]);
    return w0 * (t > 0 ? xm : 0.f) + w1 * x0 + w2 * (t < SEQ - 1 ? xp : 0.f);
}
#define HY_UNPK(w) ((f32x2){bflo(w), bfhi(w)})
template <bool INV, class LD, class ST>
__device__ __forceinline__ void fft_edge_pass(LAS f32x2* buf, int tid, LD& ld, ST& st) {
    constexpr int R = 16, LOGN = 14, LOGM = 10;
#pragma unroll
    for (int it = 0; it < 2; ++it) {
        int tl = tid; asm volatile("" : "+v"(tl));
        const int j = tl + NTHR * it; const int fb = fsw(j);
        f32x2 x[R];
#pragma unroll
        for (int q = 0; q < R; ++q) x[q] = ld(2 * q + it, j + (q << LOGM), fb + (q << LOGM));
        const float rev = (float)j * (1.0f / 16384.0f); const float sn = sin_rev(rev); const f32x2 w1 = (f32x2){cos_rev(rev), INV ? sn : -sn};
        if (!INV) {
            dft_reg<R, false>(x);
            st(it, j, fb, x[0]); f32x2 w = w1;
#pragma unroll
            for (int q = 1; q < R; ++q) { st(2 * q + it, j + (q << LOGM), fb + (q << LOGM), cmul(x[bitrev(q, 4)], w)); w = cmul(w, w1); }
        } else {
            f32x2 w = w1;
#pragma unroll
            for (int q = 1; q < R; ++q) { x[q] = cmul(x[q], w); w = cmul(w, w1); }
            dft_reg<R, true>(x);
#pragma unroll
            for (int q = 0; q < R; ++q) st(2 * q + it, j + (q << LOGM), fb + (q << LOGM), x[bitrev(q, 4)]);
        }
        __builtin_amdgcn_sched_barrier(0);
    }
}
__device__ __forceinline__ void fft_last_to_ks(LAS f32x2* buf, int tid, unsigned* KS, float scale) {
#pragma unroll 1
    for (int it = 0; it < 4; ++it) { int tl = tid; asm volatile("" : "+v"(tl)); const int b = tl + NTHR * it; const int fb = fsw(8 * b);
        f32x2 x[8];
#pragma unroll
        for (int q = 0; q < 8; ++q) x[q] = buf[fb ^ q];
        dft_reg<8, false>(x);
        u32x4 o0, o1; f32x2 v;
        v = x[bitrev(0, 3)] * scale; o0.x = cvt_pk_bf16(v.x, v.y); v = x[bitrev(1, 3)] * scale; o0.y = cvt_pk_bf16(v.x, v.y); v = x[bitrev(2, 3)] * scale; o0.z = cvt_pk_bf16(v.x, v.y); v = x[bitrev(3, 3)] * scale; o0.w = cvt_pk_bf16(v.x, v.y);
        v = x[bitrev(4, 3)] * scale; o1.x = cvt_pk_bf16(v.x, v.y); v = x[bitrev(5, 3)] * scale; o1.y = cvt_pk_bf16(v.x, v.y); v = x[bitrev(6, 3)] * scale; o1.z = cvt_pk_bf16(v.x, v.y); v = x[bitrev(7, 3)] * scale; o1.w = cvt_pk_bf16(v.x, v.y);
        *(GAS u32x4*)(KS + 8 * b) = o0; *(GAS u32x4*)(KS + 8 * b + 4) = o1; }
}
__device__ __forceinline__ void fft_mid_mul(LAS f32x2* buf, int tid, const unsigned* KS) {
#pragma unroll 2
    for (int it = 0; it < 4; ++it) { int tl = tid; asm volatile("" : "+v"(tl)); const int b = tl + NTHR * it; const int fb = fsw(8 * b);
        const u32x4 k0 = *(const GAS u32x4*)(KS + 8 * b), k1 = *(const GAS u32x4*)(KS + 8 * b + 4);
        f32x2 x[8], y[8];
#pragma unroll
        for (int q = 0; q < 8; ++q) x[q] = buf[fb ^ q];
        dft_reg<8, false>(x);
        y[0] = cmul(x[bitrev(0, 3)], HY_UNPK(k0.x)); y[1] = cmul(x[bitrev(1, 3)], HY_UNPK(k0.y)); y[2] = cmul(x[bitrev(2, 3)], HY_UNPK(k0.z)); y[3] = cmul(x[bitrev(3, 3)], HY_UNPK(k0.w));
        y[4] = cmul(x[bitrev(4, 3)], HY_UNPK(k1.x)); y[5] = cmul(x[bitrev(5, 3)], HY_UNPK(k1.y)); y[6] = cmul(x[bitrev(6, 3)], HY_UNPK(k1.z)); y[7] = cmul(x[bitrev(7, 3)], HY_UNPK(k1.w));
        dft_reg<8, true>(y);
#pragma unroll
        for (int q = 0; q < 8; ++q) buf[fb ^ q] = y[bitrev(q, 3)]; }
    __syncthreads();
}
struct HyStLds { LAS f32x2* buf; __device__ __forceinline__ void operator()(int, int, int addr, f32x2 v) { buf[addr] = v; } };
struct HyLdLds { LAS f32x2* buf; __device__ __forceinline__ f32x2 operator()(int, int, int addr) { return buf[addr]; } };
struct HyLdKc { const bf16* f0; const bf16* f1; float part; __device__ __forceinline__ f32x2 operator()(int, int t, int) { const float a0 = bf2f(f0[t]), r1 = (t == 0) ? 0.f : bf2f(f1[SEQ - t]); part += fabsf(a0) + fabsf(r1); return (f32x2){a0 + r1, 0.f}; } };
struct HyLdKn { const bf16* f0; const bf16* f1; __device__ __forceinline__ f32x2 operator()(int, int t, int) { const float a0 = bf2f(f0[t]), r1 = (t == 0) ? 0.f : bf2f(f1[SEQ - t]); const float rev = (float)t * (1.0f / 32768.0f), v = a0 - r1; return (f32x2){v * cos_rev(rev), v * sin_rev(rev)}; } };
struct HyLdZ { const unsigned* z; __device__ __forceinline__ f32x2 operator()(int k, int, int) { return HY_UNPK(z[k]); } };
struct HyLdZpsi { const unsigned* z; __device__ __forceinline__ f32x2 operator()(int k, int t, int) { const float rev = (float)t * (1.0f / 32768.0f); return cmul(HY_UNPK(z[k]), (f32x2){cos_rev(rev), sin_rev(rev)}); } };
struct HyStYc { unsigned* yc; __device__ __forceinline__ void operator()(int k, int, int, f32x2 v) { const f32x2 w = v * (0.5f / 16384.0f); yc[k] = cvt_pk_bf16(w.x, w.y); } };
struct HyStComb { unsigned* z; const unsigned* yc; float bias;
    __device__ __forceinline__ void operator()(int k, int t, int, f32x2 v) { const float rev = (float)t * (1.0f / 32768.0f);
        const f32x2 yn = cmul(v, (f32x2){cos_rev(rev), -sin_rev(rev)}) * (0.5f / 16384.0f); const f32x2 y = yn + HY_UNPK(yc[k]) + HY_UNPK(z[k]) * bias; z[k] = cvt_pk_bf16(y.x, y.y); } };
template <bool NEG> __device__ __forceinline__ float hy_load_kernel(LAS f32x2* buf, int tid, const bf16* f0, const bf16* f1) {
    float part = 0.f;
#pragma unroll 2
    for (int r = 0; r < 4; ++r) { int tl = tid; asm volatile("" : "+v"(tl)); const int t0 = 8 * (tl + NTHR * r); const int fb = fsw(t0); float a[8], q[8];
        const u32x4 va = *(const GAS u32x4*)(f0 + t0), vr = *(const GAS u32x4*)(f1 + SEQ - t0 - 8); const float r0 = bf2f(f1[t0 > 0 ? SEQ - t0 : 0]);
        a[0] = bflo(va.x); a[1] = bfhi(va.x); a[2] = bflo(va.y); a[3] = bfhi(va.y); a[4] = bflo(va.z); a[5] = bfhi(va.z); a[6] = bflo(va.w); a[7] = bfhi(va.w);
        q[0] = t0 > 0 ? r0 : 0.f; q[1] = bfhi(vr.w); q[2] = bflo(vr.w); q[3] = bfhi(vr.z); q[4] = bflo(vr.z); q[5] = bfhi(vr.y); q[6] = bflo(vr.y); q[7] = bfhi(vr.x);
#pragma unroll
        for (int e = 0; e < 8; ++e) {
            if (!NEG) { part += fabsf(a[e]) + fabsf(q[e]); buf[fb ^ e] = (f32x2){a[e] + q[e], 0.f}; }
            else { const float rev = (float)(t0 + e) * (1.0f / 32768.0f), v = a[e] - q[e]; buf[fb ^ e] = (f32x2){v * cos_rev(rev), v * sin_rev(rev)}; } } }
    return part;
}
template <bool NEG> __device__ __forceinline__ void hy_load_kernel2(LAS f32x2* buf, int tid, const bf16* f0a, const bf16* f1a, const bf16* f0b, const bf16* f1b, float& part0, float& part1) {
#pragma unroll 2
    for (int r = 0; r < 4; ++r) { int tl = tid; asm volatile("" : "+v"(tl)); const int t0 = 8 * (tl + NTHR * r); const int fb = fsw(t0); float a[8], q[8], b[8], p[8];
        const u32x4 va = *(const GAS u32x4*)(f0a + t0), vr = *(const GAS u32x4*)(f1a + SEQ - t0 - 8); const float r0 = bf2f(f1a[t0 > 0 ? SEQ - t0 : 0]);
        const u32x4 vb = *(const GAS u32x4*)(f0b + t0), vs = *(const GAS u32x4*)(f1b + SEQ - t0 - 8); const float s0 = bf2f(f1b[t0 > 0 ? SEQ - t0 : 0]);
        a[0] = bflo(va.x); a[1] = bfhi(va.x); a[2] = bflo(va.y); a[3] = bfhi(va.y); a[4] = bflo(va.z); a[5] = bfhi(va.z); a[6] = bflo(va.w); a[7] = bfhi(va.w);
        q[0] = t0 > 0 ? r0 : 0.f; q[1] = bfhi(vr.w); q[2] = bflo(vr.w); q[3] = bfhi(vr.z); q[4] = bflo(vr.z); q[5] = bfhi(vr.y); q[6] = bflo(vr.y); q[7] = bfhi(vr.x);
        b[0] = bflo(vb.x); b[1] = bfhi(vb.x); b[2] = bflo(vb.y); b[3] = bfhi(vb.y); b[4] = bflo(vb.z); b[5] = bfhi(vb.z); b[6] = bflo(vb.w); b[7] = bfhi(vb.w);
        p[0] = t0 > 0 ? s0 : 0.f; p[1] = bfhi(vs.w); p[2] = bflo(vs.w); p[3] = bfhi(vs.z); p[4] = bflo(vs.z); p[5] = bfhi(vs.y); p[6] = bflo(vs.y); p[7] = bfhi(vs.x);
#pragma unroll
        for (int e = 0; e < 8; ++e) {
            if (!NEG) { part0 += fabsf(a[e]) + fabsf(q[e]); part1 += fabsf(b[e]) + fabsf(p[e]); buf[fb ^ e] = (f32x2){a[e] + q[e], b[e] + p[e]}; }
            else { const float rev = (float)(t0 + e) * (1.0f / 32768.0f), v0 = a[e] - q[e], v1 = b[e] - p[e]; buf[fb ^ e] = cmul((f32x2){v0, v1}, (f32x2){cos_rev(rev), sin_rev(rev)}); } } }
}
template <bool NEG> __device__ __forceinline__ void hy_split_to_ks(LAS f32x2* buf, int tid, unsigned* KS0, unsigned* KS1, float inv0, float inv1) {
    constexpr int S = NEG ? 1 : 0;
#pragma unroll 1
    for (int it = 0; it < 4; ++it) { int tl = tid; asm volatile("" : "+v"(tl)); const int b = tl + NTHR * it;
        const int l = (b >> 7) + 16 * ((b >> 3) & 15) + 256 * (b & 7); const int nl = (S - l) & 2047; const int br = (l > S) ? 1 : 0;
        const int bp = (nl & 15) * 128 + ((nl >> 4) & 15) * 8 + ((nl >> 8) & 7);
        const int fb = fsw(8 * b), fp = fsw(8 * bp);
        unsigned o0[8], o1[8]; const float h0 = 0.5f * inv0, h1 = 0.5f * inv1;
#pragma unroll
        for (int q = 0; q < 8; ++q) { const f32x2 zz = buf[fb ^ q], zp = buf[fp ^ ((-q - br) & 7)];
            o0[q] = cvt_pk_bf16((zz.x + zp.x) * h0, (zz.y - zp.y) * h0); o1[q] = cvt_pk_bf16((zz.y + zp.y) * h1, (zp.x - zz.x) * h1); }
        *(GAS u32x4*)(KS0 + 8 * b) = (u32x4){o0[0], o0[1], o0[2], o0[3]}; *(GAS u32x4*)(KS0 + 8 * b + 4) = (u32x4){o0[4], o0[5], o0[6], o0[7]};
        *(GAS u32x4*)(KS1 + 8 * b) = (u32x4){o1[0], o1[1], o1[2], o1[3]}; *(GAS u32x4*)(KS1 + 8 * b + 4) = (u32x4){o1[4], o1[5], o1[6], o1[7]}; }
}
__device__ __forceinline__ void hy_conv8(const u32x4 v, float hm, float hp, float w0, float w1, float w2, float (&o)[8]) {
    const float x1 = bflo(v.x), x2 = bfhi(v.x), x3 = bflo(v.y), x4 = bfhi(v.y), x5 = bflo(v.z), x6 = bfhi(v.z), x7 = bflo(v.w), x8 = bfhi(v.w);
    o[0] = w0 * hm + w1 * x1 + w2 * x2; o[1] = w0 * x1 + w1 * x2 + w2 * x3; o[2] = w0 * x2 + w1 * x3 + w2 * x4; o[3] = w0 * x3 + w1 * x4 + w2 * x5;
    o[4] = w0 * x4 + w1 * x5 + w2 * x6; o[5] = w0 * x5 + w1 * x6 + w2 * x7; o[6] = w0 * x6 + w1 * x7 + w2 * x8; o[7] = w0 * x7 + w1 * x8 + w2 * hp;
}
__device__ __forceinline__ void hy_load_conv(LAS f32x2* buf, int tid, const bf16* UH, int ch, float w0, float w1, float w2) {
    const bf16* p0 = UH + (size_t)ch * SEQ; const bf16* p1 = UH + (size_t)(3072 + ch) * SEQ;
#pragma unroll 2
    for (int r = 0; r < 4; ++r) { int tl = tid; asm volatile("" : "+v"(tl)); const int t0 = 8 * (tl + NTHR * r); const int fb = fsw(t0);
        const int tm = t0 > 0 ? t0 - 1 : 0, tp = t0 + 8 < SEQ ? t0 + 8 : SEQ - 1;
        const u32x4 va = *(const GAS u32x4*)(p0 + t0), vb = *(const GAS u32x4*)(p1 + t0);
        float am = bf2f(p0[tm]), ap = bf2f(p0[tp]), bm = bf2f(p1[tm]), bp = bf2f(p1[tp]);
        if (t0 == 0) { am = 0.f; bm = 0.f; } if (t0 + 8 >= SEQ) { ap = 0.f; bp = 0.f; }
        float oa[8], ob[8]; hy_conv8(va, am, ap, w0, w1, w2, oa); hy_conv8(vb, bm, bp, w0, w1, w2, ob);
        buf[fb ^ 0] = (f32x2){oa[0], ob[0]}; buf[fb ^ 1] = (f32x2){oa[1], ob[1]}; buf[fb ^ 2] = (f32x2){oa[2], ob[2]}; buf[fb ^ 3] = (f32x2){oa[3], ob[3]};
        buf[fb ^ 4] = (f32x2){oa[4], ob[4]}; buf[fb ^ 5] = (f32x2){oa[5], ob[5]}; buf[fb ^ 6] = (f32x2){oa[6], ob[6]}; buf[fb ^ 7] = (f32x2){oa[7], ob[7]}; }
}
__device__ __forceinline__ void hyena_item(Frame& F, int c) {
    LAS f32x2* buf = (LAS f32x2*)F.lds;
    unsigned* KS = (unsigned*)(F.ws + WS_HYS + (size_t)F.bx * HYS_STRIDE);
    const bf16* FILT = (const bf16*)(F.ws + WS_FILT); const bf16* UH = (const bf16*)(F.ws + WS_UH);
    const int tid = F.tid; const int ft = fsw(tid);
#define FB(k) buf[ft + NTHR * (k)]
    const float* sw = F.in[IN_HSW];
    unsigned z[32], yc[32];
    HyStLds stl{buf}; HyLdLds ldl{buf};
    hy_load_conv(buf, tid, UH, c, sw[c], sw[3072 + c], sw[6144 + c]);
    __syncthreads();
#pragma unroll
    for (int k = 0; k < 32; ++k) { const f32x2 v_ = FB(k); z[k] = cvt_pk_bf16(v_.x, v_.y); }
    { const bf16* f0a = FILT + (size_t)c * SEQ; const bf16* f1a = FILT + (size_t)(2048 + c) * SEQ; const bf16* f0b = FILT + (size_t)(1024 + c) * SEQ; const bf16* f1b = FILT + (size_t)(3072 + c) * SEQ;
      float part0 = 0.f, part1 = 0.f;
      __syncthreads();
      hy_load_kernel2<false>(buf, tid, f0a, f1a, f0b, f1b, part0, part1);
      const float inv0 = 1.0f / (block_sum(F, part0) + 1e-6f); const float inv1 = 1.0f / (block_sum(F, part1) + 1e-6f);
      fft_edge_pass<false>(buf, tid, ldl, stl); __syncthreads();
      fft_pass<16, 10, false>(buf, tid); fft_pass<8, 6, false>(buf, tid); fft_pass<8, 3, false>(buf, tid);
      hy_split_to_ks<false>(buf, tid, KS, KS + 16384, inv0, inv1); __syncthreads();
      { float d0 = 0.f, d1 = 0.f; hy_load_kernel2<true>(buf, tid, f0a, f1a, f0b, f1b, d0, d1); } __syncthreads();
      fft_edge_pass<false>(buf, tid, ldl, stl); __syncthreads();
      fft_pass<16, 10, false>(buf, tid); fft_pass<8, 6, false>(buf, tid); fft_pass<8, 3, false>(buf, tid);
      hy_split_to_ks<true>(buf, tid, KS + 2 * 16384, KS + 3 * 16384, inv0, inv1); __syncthreads(); }
#pragma unroll 1
    for (int o = 0; o < 2; ++o) {
        { HyLdZ ldz{z}; fft_edge_pass<false>(buf, tid, ldz, stl); __syncthreads(); }
        fft_pass<16, 10, false>(buf, tid); fft_pass<8, 6, false>(buf, tid);
        fft_mid_mul(buf, tid, KS + o * 16384);
        fft_pass<8, 6, true>(buf, tid); fft_pass<16, 10, true>(buf, tid);
        { HyStYc styc{yc}; fft_edge_pass<true>(buf, tid, ldl, styc); }
        __syncthreads();
        { HyLdZpsi ldzp{z}; fft_edge_pass<false>(buf, tid, ldzp, stl); __syncthreads(); }
        fft_pass<16, 10, false>(buf, tid); fft_pass<8, 6, false>(buf, tid);
        fft_mid_mul(buf, tid, KS + (2 + o) * 16384);
        fft_pass<8, 6, true>(buf, tid); fft_pass<16, 10, true>(buf, tid);
        { HyStComb stc{z, yc, F.in[IN_HBIAS][o * 1024 + c]}; fft_edge_pass<true>(buf, tid, ldl, stc); }
#pragma unroll
        for (int k = 0; k < 32; ++k) FB(k) = HY_UNPK(z[k]);
        { const int xch = (o + 1) * 1024 + c; const float w0 = sw[xch], w1 = sw[3072 + xch], w2 = sw[6144 + xch];
#pragma unroll 8
          for (int k = 0; k < 32; ++k) { const int t = tid + NTHR * k; f32x2 v_ = FB(k); v_.x *= sconv(UH, 0, xch, t, w0, w1, w2); v_.y *= sconv(UH, 1, xch, t, w0, w1, w2); FB(k) = v_; } }
#pragma unroll
        for (int k = 0; k < 32; ++k) { const f32x2 v_ = FB(k); z[k] = cvt_pk_bf16(v_.x, v_.y); }
        __syncthreads();
    }
    bf16* YHCM = (bf16*)(F.ws + WS_YHCM);
#pragma unroll
    for (int k = 0; k < 32; ++k) FB(k) = HY_UNPK(z[k]);
#pragma unroll 8
    for (int k = 0; k < 32; ++k) { const int t = tid + NTHR * k; const f32x2 v_ = FB(k); YHCM[(size_t)c * SEQ + t] = (bf16)f2bf(v_.x); YHCM[(size_t)(1024 + c) * SEQ + t] = (bf16)f2bf(v_.y); }
    __syncthreads();
#undef FB
}
__device__ __forceinline__ void p4_hyena_carry(Frame& F, int qw) {
    volatile LAS int* qs = (volatile LAS int*)(F.lds + MISC_OFF + 64);
    for (;;) {
        __syncthreads();
        if (F.tid == 0) qs[0] = (int)__hip_atomic_fetch_add((unsigned*)(F.ctl + qw), 1u, __ATOMIC_RELAXED, __HIP_MEMORY_SCOPE_AGENT);
        __syncthreads();
        const int q = qs[0];
        if (q >= 32 + 1024) break;
        if (q < 1024) hyena_item(F, q); else s5_carry_item(F, q - 1024);
    }
}
__device__ __forceinline__ void yh_transpose(Frame& F) {
    const bf16* YHCM = (const bf16*)(F.ws + WS_YHCM); bf16* YH = (bf16*)(F.ws + WS_YH);
    LAS unsigned short* tl = (LAS unsigned short*)(F.lds + 8 * 8704 + F.wave * (64 * 72 * 2));
    const int gw = F.bx * NWAVES + F.wave, NGW = F.G * NWAVES, lane = F.lane;
    for (int it = gw; it < 2 * 16 * 256; it += NGW) {
        const int mt = it & 255, ct = (it >> 8) & 15, b = it >> 12; const int m0 = mt * 64, c0 = ct * 64;
#pragma unroll
        for (int j = 0; j < 8; ++j) { const int ch = 8 * j + (lane >> 3), mc = (lane & 7) * 8;
            const u32x4 v = *(const GAS u32x4*)(YHCM + (size_t)(b * 1024 + c0 + ch) * SEQ + m0 + mc); *(LAS u32x4*)(tl + ch * 72 + mc) = v; }
        LDS_WAIT(); asm volatile("" ::: "memory");
#pragma unroll
        for (int j = 0; j < 8; ++j) { const int mm = 8 * j + (lane >> 3), cc = (lane & 7) * 8; const int m = m0 + mm, w = m >> 8, r = m & 255;
            u32x4 o; o.x = (unsigned)tl[(cc + 0) * 72 + mm] | ((unsigned)tl[(cc + 1) * 72 + mm] << 16); o.y = (unsigned)tl[(cc + 2) * 72 + mm] | ((unsigned)tl[(cc + 3) * 72 + mm] << 16);
            o.z = (unsigned)tl[(cc + 4) * 72 + mm] | ((unsigned)tl[(cc + 5) * 72 + mm] << 16); o.w = (unsigned)tl[(cc + 6) * 72 + mm] | ((unsigned)tl[(cc + 7) * 72 + mm] << 16);
            *(GAS u32x4*)(YH + (size_t)(b * SEQ + r * 64 + w) * HYW + c0 + cc) = o; }
        LDS_WAIT(); asm volatile("" ::: "memory");
    }
}

struct SchedStd {
    int G, c, npn, K, nrep; const char* A; const char* Bt; int esz = 2;
    __device__ __forceinline__ bool next(int i, pg8::Unit& u) const {
        int L = i * G + c; const int nwg = 128 * npn; u.e = 0; u.valid = 256;
        if (nrep > 1 && L >= nwg) L -= nwg;
        if (L >= nwg) return false;
        int wgid = L; { const int q = nwg / 8, xcd = wgid % 8, off = wgid / 8; wgid = xcd * q + off; }
        const int nig = 8 * npn, gid = wgid / nig; u.pm = gid * 8 + ((wgid % nig) % 8); u.pn = (wgid % nig) / 8; return true;
    }
    __device__ __forceinline__ unsigned a_row(const pg8::Unit& u, int r) const { return (unsigned)(u.pm * 256 + r); }
    __device__ __forceinline__ const char* a_base() const { return A; }
    __device__ __forceinline__ const char* b_base(const pg8::Unit& u) const { return Bt + (size_t)u.pn * 256 * K * esz; }
};
template <int MODE> struct EpiMix {
    static constexpr bool PERM = true, TRANS = true, FP8 = false;
    const bf16* P; const bf16* Q; bf16* O;
    __device__ __forceinline__ void operator()(const f32x4 (&acc)[2][2][4][2], const pg8::Unit& u, int wr, int wc, int fr, int fq) const {
        constexpr int ld = (MODE == 0) ? 1024 : 2048;
        const int col0 = u.pn * 256 + wc * 32 + 8 * fq;
#pragma unroll
        for (int ai = 0; ai < 2; ++ai) {
            u32x4 pv[4][2], qv[4][2];
#pragma unroll
            for (int m = 0; m < 4; ++m) { const size_t row = (size_t)u.pm * 256 + ai * 128 + wr * 64 + m * 16 + fr;
#pragma unroll
                for (int bj = 0; bj < 2; ++bj) { const int col = col0 + bj * 128;
                    if (MODE == 0) pv[m][bj] = *(const u32x4*)(P + row * 1024 + col);
                    else { const u32x2 g8 = *(const u32x2*)((const unsigned char*)P + row * 4096 + (MODE == 2 ? 2048 : 0) + col); pv[m][bj] = (u32x4){g8.x, g8.y, 0u, 0u}; }
                    if (MODE == 2) qv[m][bj] = *(const u32x4*)(Q + row * 2048 + col); } }
#pragma unroll
            for (int m = 0; m < 4; ++m) { const size_t row = (size_t)u.pm * 256 + ai * 128 + wr * 64 + m * 16 + fr;
#pragma unroll
                for (int bj = 0; bj < 2; ++bj) { const int col = col0 + bj * 128; const f32x4 v0 = acc[ai][bj][m][0], v1 = acc[ai][bj][m][1]; float r[8];
                    if (MODE == 0) { const u32x4 y = pv[m][bj];
                        r[0] = bflo(y.x) * sigmoidf_(v0[0]); r[1] = bfhi(y.x) * sigmoidf_(v0[1]); r[2] = bflo(y.y) * sigmoidf_(v0[2]); r[3] = bfhi(y.y) * sigmoidf_(v0[3]);
                        r[4] = bflo(y.z) * sigmoidf_(v1[0]); r[5] = bfhi(y.z) * sigmoidf_(v1[1]); r[6] = bflo(y.w) * sigmoidf_(v1[2]); r[7] = bfhi(y.w) * sigmoidf_(v1[3]); }
                    else { const u32x4 gg = pv[m][bj]; constexpr float q = 1.0f / 255.0f;
                        r[0] = (float)(gg.x & 255u) * q * v0[0]; r[1] = (float)((gg.x >> 8) & 255u) * q * v0[1]; r[2] = (float)((gg.x >> 16) & 255u) * q * v0[2]; r[3] = (float)(gg.x >> 24) * q * v0[3];
                        r[4] = (float)(gg.y & 255u) * q * v1[0]; r[5] = (float)((gg.y >> 8) & 255u) * q * v1[1]; r[6] = (float)((gg.y >> 16) & 255u) * q * v1[2]; r[7] = (float)(gg.y >> 24) * q * v1[3];
                        if (MODE == 2) { const u32x4 t1 = qv[m][bj];
                            r[0] += bflo(t1.x); r[1] += bfhi(t1.x); r[2] += bflo(t1.y); r[3] += bfhi(t1.y); r[4] += bflo(t1.z); r[5] += bfhi(t1.z); r[6] += bflo(t1.w); r[7] += bfhi(t1.w); } }
                    if (MODE == 2) {
                        *(u32x2*)((unsigned char*)O + row * ld + col) = (u32x2){pk4_fp8(r[0] * T8SCALE, r[1] * T8SCALE, r[2] * T8SCALE, r[3] * T8SCALE), pk4_fp8(r[4] * T8SCALE, r[5] * T8SCALE, r[6] * T8SCALE, r[7] * T8SCALE)}; }
                    else { u32x4 w; w.x = cvt_pk_bf16(r[0], r[1]); w.y = cvt_pk_bf16(r[2], r[3]); w.z = cvt_pk_bf16(r[4], r[5]); w.w = cvt_pk_bf16(r[6], r[7]);
                        *(u32x4*)(O + row * ld + col) = w; } } }
        }
    }
};
struct EpiOut {
    static constexpr bool PERM = true, TRANS = true, FP8 = true;
    const float* X; const float* MOD; bf16* H1;
    __device__ __forceinline__ void operator()(const f32x4 (&acc)[2][2][4][2], const pg8::Unit& u, int wr, int wc, int fr, int fq) const {
        const int b = u.pm >> 6; const int c0 = u.pn * 256 + wc * 32 + 8 * fq;
        f32x4 gv[2][2];
#pragma unroll
        for (int bj = 0; bj < 2; ++bj)
#pragma unroll
            for (int n = 0; n < 2; ++n) gv[bj][n] = *(const f32x4*)(MOD + b * 12288 + 2 * 2048 + c0 + bj * 128 + 4 * n) * (1.0f / (W8SCALE * T8SCALE));
#pragma unroll
        for (int ai = 0; ai < 2; ++ai) {
            f32x4 xv[4][2][2];
#pragma unroll
            for (int m = 0; m < 4; ++m) { const size_t off = ((size_t)u.pm * 256 + ai * 128 + wr * 64 + m * 16 + fr) * D + c0;
#pragma unroll
                for (int bj = 0; bj < 2; ++bj)
#pragma unroll
                    for (int n = 0; n < 2; ++n) xv[m][bj][n] = *(const f32x4*)(X + off + bj * 128 + 4 * n); }
#pragma unroll
            for (int m = 0; m < 4; ++m) { const size_t off = ((size_t)u.pm * 256 + ai * 128 + wr * 64 + m * 16 + fr) * D + c0;
#pragma unroll
                for (int bj = 0; bj < 2; ++bj) { const f32x4 v0 = xv[m][bj][0] + gv[bj][0] * acc[ai][bj][m][0], v1 = xv[m][bj][1] + gv[bj][1] * acc[ai][bj][m][1];
                    u32x4 w; w.x = cvt_pk_bf16(v0[0], v0[1]); w.y = cvt_pk_bf16(v0[2], v0[3]); w.z = cvt_pk_bf16(v1[0], v1[1]); w.w = cvt_pk_bf16(v1[2], v1[3]);
                    *(u32x4*)(H1 + off + bj * 128) = w; } }
        }
    }
};

__device__ __forceinline__ void p10_router(Frame& F) {
    const int gw = F.bx * NWAVES + F.wave, NGW = F.G * NWAVES, lane = F.lane;
    const float* MOD = (const float*)(F.ws + WS_MOD); const float* g2n = F.in[IN_N2G]; const float* RWT = (const float*)(F.ws + WS_RWT); const float* rb = F.in[IN_RB];
    const bf16* H1 = (const bf16*)(F.ws + WS_H1); unsigned char* HM8 = (unsigned char*)(F.ws + WS_HM8); float* GATE = (float*)(F.ws + WS_GATE); int* LIST = (int*)(F.ws + WS_LIST);
    for (int m0 = 2 * gw; m0 < NTOK; m0 += 2 * NGW) {
        const int b = m0 >> 14;
        f32x4 h[2][8];
#pragma unroll
        for (int rr = 0; rr < 2; ++rr) { const bf16* xr = H1 + (size_t)(m0 + rr) * D; float s = 0.f;
#pragma unroll
            for (int j = 0; j < 8; ++j) { const u32x2 hb = *(const GAS u32x2*)(xr + 4 * lane + 256 * j); h[rr][j] = (f32x4){bflo(hb.x), bfhi(hb.x), bflo(hb.y), bfhi(hb.y)}; s += (h[rr][j].x * h[rr][j].x + h[rr][j].y * h[rr][j].y) + (h[rr][j].z * h[rr][j].z + h[rr][j].w * h[rr][j].w); }
            const float rstd = 1.0f / sqrtf(wave_sum(s) * (1.0f / D) + 1e-6f);
            GAS unsigned* o = (GAS unsigned*)(HM8 + (size_t)(m0 + rr) * D) + lane;
#pragma unroll
            for (int j = 0; j < 8; ++j) { const int k = 4 * lane + 256 * j; const f32x4 g = *(const f32x4*)(g2n + k), sc = *(const f32x4*)(MOD + b * 12288 + 4 * 2048 + k), sh = *(const f32x4*)(MOD + b * 12288 + 3 * 2048 + k);
                h[rr][j] = h[rr][j] * rstd * g * (sc + 1.0f) + sh; }
#pragma unroll
            for (int j = 0; j < 8; ++j) o[64 * j] = pk4_fp8(h[rr][j].x, h[rr][j].y, h[rr][j].z, h[rr][j].w); }
        float lg0 = -3.0e38f, lg1 = -3.0e38f;
#pragma unroll 2
        for (int e = 0; e < NEXP; ++e) { float s0 = 0.f, s1 = 0.f;
#pragma unroll
            for (int j = 0; j < 8; ++j) { const f32x4 w = *(const f32x4*)(RWT + e * 2048 + 4 * lane + 256 * j);
                s0 += (h[0][j].x * w.x + h[0][j].y * w.y) + (h[0][j].z * w.z + h[0][j].w * w.w); s1 += (h[1][j].x * w.x + h[1][j].y * w.y) + (h[1][j].z * w.z + h[1][j].w * w.w); }
            s0 = wave_sum(s0) + rb[e]; s1 = wave_sum(s1) + rb[e];
            if (lane == e) { lg0 = s0; lg1 = s1; } }
#pragma unroll
        for (int rr = 0; rr < 2; ++rr) { float lg = rr ? lg1 : lg0; int es[4]; float vs[4];
#pragma unroll
            for (int k = 0; k < 4; ++k) { const float mx = wave_max(lg); const unsigned long long bal = __ballot(lg == mx); const int idx = __ffsll((long long)bal) - 1; es[k] = idx; vs[k] = mx; if (lane == idx) lg = -3.0e38f; }
            const float e1 = __expf(vs[1] - vs[0]), e2 = __expf(vs[2] - vs[0]), e3 = __expf(vs[3] - vs[0]); const float inv = 1.0f / (1.0f + e1 + e2 + e3);
            if (lane < 4) { const int ee = lane == 0 ? es[0] : lane == 1 ? es[1] : lane == 2 ? es[2] : es[3]; const float gt = (lane == 0 ? 1.0f : lane == 1 ? e1 : lane == 2 ? e2 : e3) * inv;
                const int slot = (m0 + rr) * 4 + lane;
                const unsigned pos = __hip_atomic_fetch_add((unsigned*)(F.ctl + CW_CNT + 64 * ee), 1u, __ATOMIC_RELAXED, __HIP_MEMORY_SCOPE_AGENT);
                LIST[ee * LISTCAP + (int)pos] = slot; GATE[slot] = gt; } }
    }
}

__device__ __forceinline__ void moe_tables(Frame& F) {
    volatile LAS int* tb = (volatile LAS int*)(F.lds + LDS_X);
    __syncthreads();
    if (F.tid < NEXP) tb[64 + F.tid] = (int)__hip_atomic_load((unsigned*)(F.ctl + CW_CNT + 64 * F.tid), __ATOMIC_RELAXED, __HIP_MEMORY_SCOPE_AGENT);
    __syncthreads();
    if (F.tid == 0) { int acc = 0; for (int e = 0; e < NEXP; ++e) { const int c = tb[64 + e]; tb[e] = acc; acc += (c + 255) >> 8; } tb[32] = acc; }
    __syncthreads();
}
template <bool GATHER> struct SchedMoe {
    int G, c, npn, N, K, nrep; const char* A; const char* Bt; const int* LIST; volatile LAS int* tb;
    __device__ __forceinline__ bool next(int i, pg8::Unit& u) const {
        int L = i * G + c; { const int tot = tb[32] * npn; if (nrep > 1 && L >= tot) L -= tot; }
        int rt = L / npn, pnq = L % npn;
        if (G == 256 && nrep == 1) {
            const int x = c & 7, j = c >> 3;
            if (npn == 16) { pnq = 4 * (x & 3) + (j & 3); rt = 16 * i + (x >> 2) * 8 + (j >> 2); }
            else           { pnq = 2 * (x & 3) + (j & 1); rt = 32 * i + (x >> 2) * 16 + (j >> 1); }
        }
        if (rt >= tb[32]) return false;
        int e = 0;
        for (int q = 1; q < NEXP; ++q) e += (tb[q] <= rt) ? 1 : 0;
        e = __builtin_amdgcn_readfirstlane(e);
        u.pm = rt; u.pn = pnq; u.e = e; const int left = tb[64 + e] - 256 * (rt - tb[e]); u.valid = left < 256 ? left : 256; return true;
    }
    __device__ __forceinline__ unsigned a_row(const pg8::Unit& u, int r) const {
        if (GATHER) { const int rc = r < u.valid ? r : u.valid - 1; return (unsigned)(LIST[u.e * LISTCAP + (u.pm - tb[u.e]) * 256 + rc] >> 2); }
        return (unsigned)(u.pm * 256 + r);
    }
    __device__ __forceinline__ const char* a_base() const { return A; }
    __device__ __forceinline__ const char* b_base(const pg8::Unit& u) const { return Bt + ((size_t)u.e * N + (size_t)u.pn * 256) * K; }
};
struct EpiMoe1 {
    static constexpr bool PERM = true, TRANS = true, FP8 = true;
    const float* BG; unsigned char* ACT;
    __device__ __forceinline__ void operator()(const f32x4 (&acc)[2][2][4][2], const pg8::Unit& u, int wr, int wc, int fr, int fq) const {
        const int c0 = u.pn * 256 + wc * 32 + 8 * fq;
        f32x4 bv[2][2];
#pragma unroll
        for (int bj = 0; bj < 2; ++bj)
#pragma unroll
            for (int n = 0; n < 2; ++n) bv[bj][n] = *(const f32x4*)(BG + (size_t)u.e * 4096 + c0 + bj * 128 + 4 * n);
#pragma unroll
        for (int ai = 0; ai < 2; ++ai)
#pragma unroll
            for (int m = 0; m < 4; ++m) { const size_t row = (size_t)u.pm * 256 + ai * 128 + wr * 64 + m * 16 + fr;
#pragma unroll
                for (int bj = 0; bj < 2; ++bj) { const f32x4 v0 = acc[ai][bj][m][0] * (1.0f / W8SCALE) + bv[bj][0], v1 = acc[ai][bj][m][1] * (1.0f / W8SCALE) + bv[bj][1]; float a[4];
#pragma unroll
                    for (int j = 0; j < 4; ++j) { const float gl = fminf(j < 2 ? v0[2 * j] : v1[2 * j - 4], 7.0f); const float ln = fminf(fmaxf(j < 2 ? v0[2 * j + 1] : v1[2 * j - 3], -7.0f), 7.0f);
                        a[j] = gl * sigmoidf_(1.702f * gl) * (ln + 1.0f); }
                    *(unsigned*)(ACT + row * DEXP + ((c0 + bj * 128) >> 1)) = pk4_fp8(a[0], a[1], a[2], a[3]); } }
    }
};
struct EpiMoe2 {
    static constexpr bool PERM = true, TRANS = true, FP8 = true;
    const float* BD; const float* GATE; const int* LIST; unsigned char* YS; volatile LAS int* tb;
    __device__ __forceinline__ void operator()(const f32x4 (&acc)[2][2][4][2], const pg8::Unit& u, int wr, int wc, int fr, int fq) const {
        const int c0 = u.pn * 256 + wc * 32 + 8 * fq; const int lbase = u.e * LISTCAP + (u.pm - tb[u.e]) * 256;
        f32x4 bv[2][2];
#pragma unroll
        for (int bj = 0; bj < 2; ++bj)
#pragma unroll
            for (int n = 0; n < 2; ++n) bv[bj][n] = *(const f32x4*)(BD + (size_t)u.e * D + c0 + bj * 128 + 4 * n);
        int slot[2][4]; float gt_[2][4];
#pragma unroll
        for (int ai = 0; ai < 2; ++ai)
#pragma unroll
            for (int m = 0; m < 4; ++m) { const int r = ai * 128 + wr * 64 + m * 16 + fr; slot[ai][m] = LIST[lbase + (r < u.valid ? r : u.valid - 1)]; }
#pragma unroll
        for (int ai = 0; ai < 2; ++ai)
#pragma unroll
            for (int m = 0; m < 4; ++m) gt_[ai][m] = GATE[slot[ai][m]] * Y8SCALE;
#pragma unroll
        for (int ai = 0; ai < 2; ++ai)
#pragma unroll
            for (int m = 0; m < 4; ++m) { const int r = ai * 128 + wr * 64 + m * 16 + fr; const float gt = gt_[ai][m];
                const long long ro = (r < u.valid) ? (long long)slot[ai][m] * D : YS_DUMP_OFF;
#pragma unroll
                for (int bj = 0; bj < 2; ++bj) { const f32x4 v0 = (acc[ai][bj][m][0] * (1.0f / W8SCALE) + bv[bj][0]) * gt, v1 = (acc[ai][bj][m][1] * (1.0f / W8SCALE) + bv[bj][1]) * gt;
                    *(u32x2*)(YS + ro + c0 + bj * 128) = (u32x2){pk4_fp8(v0[0], v0[1], v0[2], v0[3]), pk4_fp8(v1[0], v1[1], v1[2], v1[3])}; } }
    }
};
__device__ __forceinline__ void p13_final(Frame& F) {
    const int gw = F.bx * NWAVES + F.wave, NGW = F.G * NWAVES, lane = F.lane;
    const float* MOD = (const float*)(F.ws + WS_MOD); const float* fg = F.in[IN_FG]; const unsigned char* YS = (const unsigned char*)(F.ws + WS_YS); float* O = F.out;
    f32x4 fgv[8], g2v[8]; int curb = -1;
#pragma unroll
    for (int j = 0; j < 8; ++j) fgv[j] = *(const f32x4*)(fg + 4 * lane + 256 * j);
    for (int m = gw; m < NTOK; m += NGW) {
        const int b = m >> 14; float* xr = O + (size_t)m * D;
        if (b != curb) { curb = b;
#pragma unroll
            for (int j = 0; j < 8; ++j) g2v[j] = *(const f32x4*)(MOD + b * 12288 + 5 * 2048 + 4 * lane + 256 * j) * (1.0f / Y8SCALE); }   const bf16* hr = (const bf16*)(F.ws + WS_H1) + (size_t)m * D; f32x4 h[8]; float s = 0.f;
#pragma unroll
        for (int j = 0; j < 8; ++j) { const int k = 4 * lane + 256 * j; f32x4 a = (f32x4){0.f, 0.f, 0.f, 0.f};
#pragma unroll
            for (int q = 0; q < 4; ++q) { const unsigned y = *(const GAS unsigned*)(YS + (size_t)(m * 4 + q) * D + k);
                const f32x2 lo = __builtin_amdgcn_cvt_pk_f32_fp8((int)y, false), hi = __builtin_amdgcn_cvt_pk_f32_fp8((int)y, true); a += (f32x4){lo.x, lo.y, hi.x, hi.y}; }
            const u32x2 hb = *(const GAS u32x2*)(hr + k); h[j] = (f32x4){bflo(hb.x), bfhi(hb.x), bflo(hb.y), bfhi(hb.y)} + g2v[j] * a; s += (h[j].x * h[j].x + h[j].y * h[j].y) + (h[j].z * h[j].z + h[j].w * h[j].w); }
        const float rstd = 1.0f / sqrtf(wave_sum(s) * (1.0f / D) + 1e-6f);
#pragma unroll
        for (int j = 0; j < 8; ++j) { const int k = 4 * lane + 256 * j; *(GAS f32x4*)(xr + k) = h[j] * rstd * fgv[j]; }
    }
}

__global__ void __launch_bounds__(NTHR, 2) fwd(Args args) {
    extern __shared__ __attribute__((aligned(16))) unsigned char lds_raw[];
    Frame F;
    F.lds = (LAS unsigned char*)lds_raw;
    F.tid = threadIdx.x; F.lane = F.tid & 63; F.wave = __builtin_amdgcn_readfirstlane(F.tid >> 6);
    F.G = gridDim.x; F.bx = blockIdx.x; F.in = args.in; F.out = args.out; F.ws = args.ws; F.ctl = (GAS unsigned*)(args.ws + WS_CTL);
    for (int u = F.tid; u < (LDS_BYTES - MISC_OFF) / 4; u += NTHR) ((LAS unsigned*)(F.lds + MISC_OFF))[u] = 0u;
    __syncthreads();
    const int lo = args.ph_lo, hi = args.ph_hi;
    XcdBarrier bar; bar.bar = (unsigned*)(F.ctl + CW_BAR); bar.x = 0; bar.st = nullptr;
    if (hi - lo > 1) bar = xcd_barrier_post((unsigned*)(F.ctl + CW_BAR), (volatile LAS unsigned*)(F.lds + MISC_OFF));
#ifndef PH_MASK
#define PH_MASK 0xffff
#endif
#define IN(k) (((PH_MASK >> (k)) & 1) && lo <= (k) && (k) < hi)
#define SEAM(k) do { if (IN(k) && IN((k) + 1)) xcd_barrier(bar); } while (0)
    unsigned char* ws = args.ws;
#ifndef PROBE_DUP
#define PROBE_DUP 0
#endif
#define DUPBAR(k) if ((PROBE_DUP >> (k)) & 1) xcd_barrier(bar)
#define DUP2(k, body) do { body; if ((PROBE_DUP >> (k)) & 1) { xcd_barrier(bar); body; } } while (0)
    if (IN(0)) { DUP2(0, p0_prologue(F)); } SEAM(0);
    if (IN(1)) { DUP2(1, p1_norm(F)); } SEAM(1);
    if (IN(2)) { {
        const int GW = (F.G == 256) ? 192 : F.G; const int nr = ((PROBE_DUP >> 2) & 1) ? 2 : 1;
        if (F.bx < GW) {
            const int r1 = (128 * 4 + 8) % GW, r2 = (r1 + 128 * 16) % GW; const int c1 = F.bx, c2 = (F.bx - r1 + GW) % GW, c3 = (F.bx - r2 + GW) % GW;
            { SchedIn S{GW, c1, 128 * 4, 4, 0, nr, (const char*)(ws + WS_U), (const char*)(ws + WS_WIN)}; EpiInA E{ws};
              pg8::gemm_phase<EpiInA, SchedIn>(F.lds, D, S, E); }
            { SchedIn S{GW, c2, 128 * 16, 16, 2, nr, (const char*)(ws + WS_U8), (const char*)(ws + WS_WIN8)}; EpiInG8 E{(unsigned char*)(ws + WS_UG)};
              pg8::gemm_phase<EpiInG8, SchedIn>(F.lds, D, S, E); }
            { SchedIn S{GW, c3, 128 * 12, 12, 1, nr, (const char*)(ws + WS_U), (const char*)(ws + WS_WIN)}; EpiInH E{(bf16*)(ws + WS_UH)};
              pg8::gemm_phase<EpiInH, SchedIn>(F.lds, D, S, E); }
        }
        moe_weight_queue(F);
        }
    } SEAM(2);
    if (IN(3)) { DUP2(3, s5_pass3<false>(F)); } SEAM(3);
    if (IN(4)) { int q4w = CW_Q4; DUP2(4, (p4_hyena_carry(F, q4w), q4w += 16)); } SEAM(4);
    if (IN(5)) { DUP2(5, s5_pass3<true>(F)); __syncthreads(); DUP2(14, yh_transpose(F)); } SEAM(5);
    if (IN(6)) { { SchedStd S{F.G, F.bx, 4, 1024, ((PROBE_DUP >> 6) & 1) ? 2 : 1, (const char*)(ws + WS_Y), (const char*)(ws + WS_WGLU)}; EpiMix<0> E{(const bf16*)(ws + WS_Y), nullptr, (bf16*)(ws + WS_YA)};
        pg8::gemm_phase<EpiMix<0>, SchedStd>(F.lds, 1024, S, E); } } SEAM(6);
    if (IN(7)) { { SchedStd S{F.G, F.bx, 8, 1024, ((PROBE_DUP >> 7) & 1) ? 2 : 1, (const char*)(ws + WS_YA), (const char*)(ws + WS_WBS5)}; EpiMix<1> E{(const bf16*)(ws + WS_UG), nullptr, (bf16*)(ws + WS_T1)};
        pg8::gemm_phase<EpiMix<1>, SchedStd>(F.lds, 1024, S, E); } } SEAM(7);
    if (IN(8)) { { SchedStd S{F.G, F.bx, 8, 1024, ((PROBE_DUP >> 8) & 1) ? 2 : 1, (const char*)(ws + WS_YH), (const char*)(ws + WS_WBHY)}; EpiMix<2> E{(const bf16*)(ws + WS_UG), (const bf16*)(ws + WS_T1), (bf16*)(ws + WS_T)};
        pg8::gemm_phase<EpiMix<2>, SchedStd>(F.lds, 1024, S, E); } } SEAM(8);
    if (IN(9)) { { SchedStd S{F.G, F.bx, 8, 2048, ((PROBE_DUP >> 9) & 1) ? 2 : 1, (const char*)(ws + WS_T), (const char*)(ws + WS_WO), 1}; EpiOut E{F.in[IN_X], (const float*)(ws + WS_MOD), (bf16*)(ws + WS_H1)};
        pg8::gemm_phase<EpiOut, SchedStd>(F.lds, 2048, S, E); } } SEAM(9);
    if (IN(10)) { p10_router(F); } SEAM(10);
    if (IN(11)) { { moe_tables(F); volatile LAS int* tb = (volatile LAS int*)(F.lds + LDS_X);
        SchedMoe<true> S{F.G, F.bx, 16, 4096, 2048, ((PROBE_DUP >> 11) & 1) ? 2 : 1, (const char*)(ws + WS_HM8), (const char*)(ws + WS_WGU), (const int*)(ws + WS_LIST), tb}; EpiMoe1 E{F.in[IN_BGU], (unsigned char*)(ws + WS_ACT)};
        pg8::gemm_phase<EpiMoe1, SchedMoe<true>>(F.lds, 2048, S, E); } } SEAM(11);
    if (IN(12)) { { moe_tables(F); volatile LAS int* tb = (volatile LAS int*)(F.lds + LDS_X);
        SchedMoe<false> S{F.G, F.bx, 8, 2048, 2048, ((PROBE_DUP >> 12) & 1) ? 2 : 1, (const char*)(ws + WS_ACT), (const char*)(ws + WS_WDN), (const int*)(ws + WS_LIST), tb}; EpiMoe2 E{F.in[IN_BDN], (const float*)(ws + WS_GATE), (const int*)(ws + WS_LIST), (unsigned char*)(ws + WS_YS), tb};
        pg8::gemm_phase<EpiMoe2, SchedMoe<false>>(F.lds, 2048, S, E); } } SEAM(12);
    if (IN(13)) { DUP2(13, p13_final(F)); }
#undef IN
#undef SEAM
}

extern "C" void kernel_launch(void* const* d_in, const int* in_sizes, int n_in, void* d_out, int out_size, void* d_ws, size_t ws_size, hipStream_t stream) {
    static int grid = 0;
    if (grid == 0) {
        if (n_in != 39 || out_size != NTOK * D || ws_size < WS_END) { fprintf(stderr, "kernel_launch: unexpected shapes: n_in %d out %d ws %zu (need %zu)\n", n_in, out_size, ws_size, (size_t)WS_END); grid = -1; return; }
        int dev = 0, cus = 0, per_cu = 0;
        if (hipGetDevice(&dev) != hipSuccess || hipDeviceGetAttribute(&cus, hipDeviceAttributeMultiprocessorCount, dev) != hipSuccess) { grid = -1; return; }
        if (hipFuncSetAttribute((const void*)fwd, hipFuncAttributeMaxDynamicSharedMemorySize, LDS_BYTES) != hipSuccess) { fprintf(stderr, "kernel_launch: hipFuncSetAttribute failed\n"); grid = -1; return; }
        if (hipOccupancyMaxActiveBlocksPerMultiprocessor(&per_cu, (const void*)fwd, NTHR, LDS_BYTES) != hipSuccess || per_cu < 1) fprintf(stderr, "kernel_launch: occupancy query says %d\n", per_cu);
        (void)hipGetLastError();
        grid = cus;
    }
    if (grid < 0) return;
    if (hipMemsetAsync((char*)d_ws + WS_CTL, 0, CTL_ZERO_BYTES, stream) != hipSuccess) return;
    Args a{};
    for (int i = 0; i < 39; ++i) a.in[i] = (const float*)d_in[i];
    a.out = (float*)d_out; a.ws = (unsigned char*)d_ws;
#ifndef ONE_LAUNCH
#define ONE_LAUNCH 1
#endif
    if (ONE_LAUNCH) { a.ph_lo = 0; a.ph_hi = NPHASE; hipLaunchKernelGGL(fwd, dim3(grid), dim3(NTHR), LDS_BYTES, stream, a); }
    else for (int p = 0; p < NPHASE; ++p) { a.ph_lo = p; a.ph_hi = p + 1; hipLaunchKernelGGL(fwd, dim3(grid), dim3(NTHR), LDS_BYTES, stream, a); }
}
```

```cpp
#include <hip/hip_runtime.h>
#include <cstdio>
#include <cstdint>

#define GAS __attribute__((address_space(1)))
#define LAS __attribute__((address_space(3)))
typedef unsigned short bf16;
typedef short bf16x8 __attribute__((ext_vector_type(8)));
typedef float f32x4 __attribute__((ext_vector_type(4)));
typedef float f32x16 __attribute__((ext_vector_type(16)));
typedef float f32x2 __attribute__((ext_vector_type(2)));
typedef unsigned u32x4 __attribute__((ext_vector_type(4)));
typedef unsigned u32x2 __attribute__((ext_vector_type(2)));
typedef int i32x4 __attribute__((ext_vector_type(4)));
typedef int i32x8 __attribute__((ext_vector_type(8)));

constexpr int D = 2048, NB = 2, SEQ = 16384, NTOK = NB * SEQ, CTX = 256, NCTX = NB * CTX;
constexpr int S5W = 1024, HYW = 1024, INC = 8192, NEXP = 32, TOPK = 4, DEXP = 2048;
constexpr int NCH = 260;
constexpr int LISTCAP = 32768;

constexpr size_t MiB = 1u << 20;
constexpr size_t WS_CTL = 0, CTL_ZERO_BYTES = 1 * MiB;
constexpr size_t WS_MOD = 6 * MiB;
constexpr size_t WS_BBT = 7 * MiB;
constexpr size_t WS_CTT = WS_BBT + 512 * 1024;
constexpr size_t WS_LAM = 8 * MiB;
constexpr size_t WS_RWT = 8 * MiB + 256 * 1024;
constexpr size_t WS_BB2 = 8 * MiB + 512 * 1024;
constexpr size_t WS_WIN = 16 * MiB;
constexpr size_t WS_WGLU = 48 * MiB;
constexpr size_t WS_WBS5 = 50 * MiB;
constexpr size_t WS_WBHY = 54 * MiB;
constexpr size_t WS_WO = 58 * MiB;
constexpr size_t WS_WGU = 66 * MiB;
constexpr size_t WS_WDN = 578 * MiB;
constexpr size_t WS_U = 834 * MiB;
constexpr size_t WS_UCA = 964 * MiB;
constexpr size_t WS_UA = 966 * MiB;
constexpr size_t WS_UH = 1030 * MiB;
constexpr size_t WS_UG = 1222 * MiB;
constexpr size_t WS_E = 1478 * MiB;
constexpr size_t WS_SIN = 1511 * MiB;
constexpr size_t WS_FILT = 1544 * MiB;
constexpr size_t WS_HYS = 1800 * MiB;
constexpr size_t HYS_STRIDE = 768 * 1024;
constexpr size_t WS_YHCM = 1992 * MiB;
constexpr size_t WS_YH = 2056 * MiB;
constexpr size_t WS_Y = 2120 * MiB;
constexpr size_t WS_YA = 2184 * MiB;
constexpr size_t WS_T1 = 2248 * MiB;
constexpr size_t WS_T = 2376 * MiB;
constexpr size_t WS_HM = 2504 * MiB;
constexpr size_t WS_GATE = 2632 * MiB;
constexpr size_t WS_LIST = 2633 * MiB;
constexpr size_t WS_ACT = 2638 * MiB;
constexpr size_t WS_YS = 3182 * MiB;
constexpr size_t WS_H1 = 3694 * MiB;
constexpr size_t WS_HM8 = WS_T1;
constexpr size_t WS_U8 = WS_ACT;
constexpr size_t WS_WIN8 = WS_YS;
constexpr size_t WS_END = 3950 * MiB;
constexpr long long YS_DUMP_OFF = (long long)(2 * MiB) - (long long)WS_YS;

constexpr int CW_TMO = 0;
constexpr int CW_Q4 = 64;
constexpr int CW_P3 = 112;
constexpr int CW_QT = 96;
constexpr int CW_CNT = 128;
constexpr int CW_BAR = 4096;

constexpr int RING_BYTES = 131072;
constexpr int LDS_X = 131072;
constexpr int MISC_OFF = 147456 - 512;
constexpr int LDS_BYTES = 147456;
constexpr int NWAVES = 8, NTHR = 512;
constexpr int NPHASE = 14;

__device__ __forceinline__ unsigned f2bf(float f) { unsigned u = __builtin_bit_cast(unsigned, f); return (u + 0x7fffu + ((u >> 16) & 1u)) >> 16; }
__device__ __forceinline__ unsigned pk2(float lo, float hi) { return f2bf(lo) | (f2bf(hi) << 16); }
__device__ __forceinline__ float bf2f(unsigned short b) { return __builtin_bit_cast(float, ((unsigned)b) << 16); }
__device__ __forceinline__ float bflo(unsigned w) { return __builtin_bit_cast(float, w << 16); }
__device__ __forceinline__ float bfhi(unsigned w) { return __builtin_bit_cast(float, w & 0xffff0000u); }
typedef __bf16 bf16x2_t __attribute__((ext_vector_type(2)));
__device__ __forceinline__ unsigned cvt_pk_bf16(float lo, float hi) { const f32x2 v = {lo, hi}; const bf16x2_t b = __builtin_convertvector(v, bf16x2_t); return __builtin_bit_cast(unsigned, b); }
__device__ __forceinline__ unsigned pk4_fp8(float a, float b, float c, float d) { unsigned w = 0u; w = (unsigned)__builtin_amdgcn_cvt_pk_fp8_f32(a, b, (int)w, false); w = (unsigned)__builtin_amdgcn_cvt_pk_fp8_f32(c, d, (int)w, true); return w; }
constexpr float Y8SCALE = 8.0f;
constexpr float T8SCALE = 16.0f;
constexpr float W8SCALE = 64.0f;
__device__ __forceinline__ float sigmoidf_(float x) { return __builtin_amdgcn_rcpf(1.0f + __expf(-x)); }
__device__ __forceinline__ float sin_rev(float r) { return __builtin_amdgcn_sinf(__builtin_amdgcn_fractf(r)); }
__device__ __forceinline__ float cos_rev(float r) { return __builtin_amdgcn_cosf(__builtin_amdgcn_fractf(r)); }
__device__ __forceinline__ float wave_sum(float v) {
#pragma unroll
    for (int o = 1; o < 64; o <<= 1) v += __shfl_xor(v, o);
    return v;
}
__device__ __forceinline__ float wave_max(float v) {
#pragma unroll
    for (int o = 1; o < 64; o <<= 1) v = fmaxf(v, __shfl_xor(v, o));
    return v;
}
__device__ __forceinline__ f32x2 cmul(f32x2 a, f32x2 b) { return (f32x2){a.x * b.x - a.y * b.y, a.x * b.y + a.y * b.x}; }
#define LDS_WAIT() asm volatile("s_waitcnt lgkmcnt(0)" ::: "memory")
#define VM_WAIT() asm volatile("s_waitcnt vmcnt(0)" ::: "memory")

namespace pg8 {
constexpr int BM = 256, BK = 64, HALF = 128, HTB = HALF * BK * 2, STAGE_BYTES = 8 * HTB;
__host__ __device__ __forceinline__ int lds_byte(int r, int c) { const int st = (r >> 4) * 2 + (c >> 5), rr = r & 15, cc = c & 31, ob = rr * 64 + cc * 2; return st * 1024 + (ob ^ (((ob >> 9) & 1) << 5)); }
__host__ __device__ __forceinline__ void stage_rc(int b, int& R, int& C) { const int st = b / 1024, sb = b % 1024, swz = sb ^ (((sb >> 9) & 1) << 5); R = (st >> 1) * 16 + swz / 64; C = (st & 1) * 32 + (swz % 64) / 2; }
__host__ __device__ __forceinline__ int perm32(int rho) { const int n = rho >> 4, i = rho & 15; return 8 * (i >> 2) + 4 * n + (i & 3); }

struct Unit { int pm, pn, e, valid; };

template <class Epi, class Sched>
__device__ __forceinline__ void gemm_phase(LAS unsigned char* lds, const int Kel, const Sched& S, const Epi& E) {
    const int tid = threadIdx.x, wid = __builtin_amdgcn_readfirstlane(tid >> 6), lane = tid & 63, wr = wid >> 2, wc = wid & 3, fr = lane & 15, fq = lane >> 4;
    const int K = Epi::FP8 ? (Kel >> 1) : Kel;
    const int nt = K / BK;
    int Rs[2], Cs[2]; unsigned voffB[2];
#pragma unroll
    for (int i = 0; i < 2; ++i) { int R, C; stage_rc(tid * 16 + i * 8192, R, C); Rs[i] = R; Cs[i] = C; const int Rb = Epi::PERM ? ((R & ~31) + perm32(R & 31)) : R; voffB[i] = (unsigned)(Rb * K + C) * 2u; }
    const size_t kstep = (size_t)(BK * 2);
    const size_t hstep = (size_t)HALF * K * 2;
    const unsigned ldsw = (unsigned)wid * 1024u;
    const int aoff = lds_byte(wr * 64 + fr, fq * 8), boff = lds_byte(wc * 32 + fr, fq * 8);
    const int aoff8 = lds_byte(wr * 64 + fr, fq * 16), boff8 = lds_byte(wc * 32 + fr, fq * 16);
#define PG8_SA(b, h) (((b) * 2 + (h)) * HTB)
#define PG8_SB(b, h) ((4 + (b) * 2 + (h)) * HTB)
#define PG8_STAGE(bufoff, gbase, voff) do { _Pragma("unroll") for (int _i = 0; _i < 2; ++_i) \
        __builtin_amdgcn_global_load_lds((const unsigned*)((const char*)(gbase) + (voff)[_i]), (LAS unsigned*)(lds + (bufoff) + ldsw + _i * 8192), 16, 0, 0); } while (0)
#define PG8_LDA(dst, b, h) do { if constexpr (Epi::FP8) { _Pragma("unroll") for (int m = 0; m < 4; ++m) { const i32x4 lo_ = *(const LAS i32x4*)(lds + PG8_SA(b, h) + aoff8 + m * 2048), hi_ = *(const LAS i32x4*)(lds + PG8_SA(b, h) + aoff8 + m * 2048 + 16); dst##8[m] = __builtin_shufflevector(lo_, hi_, 0, 1, 2, 3, 4, 5, 6, 7); } } \
        else { _Pragma("unroll") for (int m = 0; m < 4; ++m) _Pragma("unroll") for (int k = 0; k < 2; ++k) dst[m][k] = *(const LAS bf16x8*)(lds + PG8_SA(b, h) + aoff + m * 2048 + k * 1024); } } while (0)
#define PG8_LDB(dst, b, h) do { if constexpr (Epi::FP8) { _Pragma("unroll") for (int n = 0; n < 2; ++n) { const i32x4 lo_ = *(const LAS i32x4*)(lds + PG8_SB(b, h) + boff8 + n * 2048), hi_ = *(const LAS i32x4*)(lds + PG8_SB(b, h) + boff8 + n * 2048 + 16); dst##8[n] = __builtin_shufflevector(lo_, hi_, 0, 1, 2, 3, 4, 5, 6, 7); } } \
        else { _Pragma("unroll") for (int n = 0; n < 2; ++n) _Pragma("unroll") for (int k = 0; k < 2; ++k) dst[n][k] = *(const LAS bf16x8*)(lds + PG8_SB(b, h) + boff + n * 2048 + k * 1024); } } while (0)
#define PG8_MMA(ai, bj, At, Bt) do { __builtin_amdgcn_s_setprio(1); \
        if constexpr (Epi::FP8) { _Pragma("unroll") for (int m = 0; m < 4; ++m) _Pragma("unroll") for (int n = 0; n < 2; ++n) \
            asm volatile("v_mfma_scale_f32_16x16x128_f8f6f4 %0, %1, %2, %0, %3, %3 op_sel_hi:[0,0,0]" : "+v"(acc[ai][bj][m][n]) : "v"(Bt##8[n]), "v"(At##8[m]), "v"(scl1)); } \
        else { _Pragma("unroll") for (int m = 0; m < 4; ++m) _Pragma("unroll") for (int n = 0; n < 2; ++n) _Pragma("unroll") for (int k = 0; k < 2; ++k) \
        acc[ai][bj][m][n] = Epi::TRANS ? __builtin_amdgcn_mfma_f32_16x16x32_bf16(Bt[n][k], At[m][k], acc[ai][bj][m][n], 0, 0, 0) \
                                       : __builtin_amdgcn_mfma_f32_16x16x32_bf16(At[m][k], Bt[n][k], acc[ai][bj][m][n], 0, 0, 0); } __builtin_amdgcn_s_setprio(0); } while (0)
#define PG8_WAIT_V(n) asm volatile("s_waitcnt vmcnt(" #n ")" ::: "memory")
#define PG8_WAIT_L(n) asm volatile("s_waitcnt lgkmcnt(" #n ")" ::: "memory")
#define PG8_BAR __builtin_amdgcn_s_barrier()
#define PG8_SCHED __builtin_amdgcn_sched_barrier(0)
    Unit cur, nxt; int ui = 0;
    if (!S.next(0, cur)) return;
    f32x4 acc[2][2][4][2];
#pragma unroll
    for (int a = 0; a < 2; ++a)
#pragma unroll
        for (int b = 0; b < 2; ++b)
#pragma unroll
            for (int m = 0; m < 4; ++m)
#pragma unroll
                for (int n = 0; n < 2; ++n) acc[a][b][m][n] = (f32x4){0.f, 0.f, 0.f, 0.f};
    bf16x8 At[4][2], B0[2][2], B1[2][2]; i32x8 At8[4], B08[2], B18[2]; const int scl1 = 0x7F7F7F7F;
    const char* const Ab = S.a_base();
    const char* cB = S.b_base(cur);
    unsigned vC0[2], vC1[2];
#pragma unroll
    for (int i = 0; i < 2; ++i) { vC0[i] = (S.a_row(cur, Rs[i]) * (unsigned)K + (unsigned)Cs[i]) * 2u; vC1[i] = (S.a_row(cur, HALF + Rs[i]) * (unsigned)K + (unsigned)Cs[i]) * 2u; }
    PG8_STAGE(PG8_SB(0, 0), cB, voffB); PG8_STAGE(PG8_SB(0, 1), cB + hstep, voffB); PG8_STAGE(PG8_SA(0, 0), Ab, vC0); PG8_STAGE(PG8_SA(0, 1), Ab, vC1);
    if (wr == 1) PG8_BAR;
    PG8_WAIT_V(2); PG8_BAR;
    PG8_STAGE(PG8_SB(1, 0), cB + kstep, voffB); PG8_STAGE(PG8_SA(1, 0), Ab + kstep, vC0); PG8_STAGE(PG8_SB(1, 1), cB + hstep + kstep, voffB);
    PG8_WAIT_V(6); PG8_BAR;
    for (;;) {
        const bool has_next = S.next(ui + 1, nxt);
        const char* nB = has_next ? S.b_base(nxt) : cB;
        for (int t = 0; t < nt; t += 2) {
            const bool last = (t == nt - 2);
            const char* a1 = Ab + (size_t)(t + 1) * kstep;
            const char* a2 = last ? Ab : Ab + (size_t)(t + 2) * kstep; const char* b2 = last ? nB : cB + (size_t)(t + 2) * kstep;
            const char* a3 = a2 + kstep; const char* b3 = b2 + kstep;
            unsigned vX0[2], vX1[2];
            if (last && has_next) {
#pragma unroll
                for (int i = 0; i < 2; ++i) { vX0[i] = (S.a_row(nxt, Rs[i]) * (unsigned)K + (unsigned)Cs[i]) * 2u; vX1[i] = (S.a_row(nxt, HALF + Rs[i]) * (unsigned)K + (unsigned)Cs[i]) * 2u; }
            } else {
#pragma unroll
                for (int i = 0; i < 2; ++i) { vX0[i] = vC0[i]; vX1[i] = vC1[i]; }
            }
            PG8_LDB(B0, 0, 0); PG8_LDB(B1, 0, 1); PG8_SCHED; PG8_LDA(At, 0, 0); PG8_STAGE(PG8_SA(1, 1), a1, vC1);
            PG8_WAIT_V(8); PG8_WAIT_L(0); PG8_BAR; PG8_MMA(0, 0, At, B0); PG8_MMA(0, 1, At, B1); PG8_BAR; PG8_SCHED;
            PG8_LDA(At, 0, 1); PG8_STAGE(PG8_SB(0, 0), b2, voffB); PG8_STAGE(PG8_SB(0, 1), b2 + hstep, voffB); PG8_STAGE(PG8_SA(0, 0), a2, vX0);
            PG8_WAIT_V(8); PG8_WAIT_L(0); PG8_BAR; PG8_MMA(1, 0, At, B0); PG8_MMA(1, 1, At, B1); PG8_BAR; PG8_SCHED;
            PG8_LDB(B0, 1, 0); PG8_LDB(B1, 1, 1); PG8_SCHED; PG8_LDA(At, 1, 0); PG8_STAGE(PG8_SA(0, 1), a2, vX1);
            PG8_WAIT_V(8); PG8_WAIT_L(0); PG8_BAR; PG8_MMA(0, 0, At, B0); PG8_MMA(0, 1, At, B1); PG8_BAR; PG8_SCHED;
            PG8_LDA(At, 1, 1); PG8_STAGE(PG8_SB(1, 0), b3, voffB); PG8_STAGE(PG8_SB(1, 1), b3 + hstep, voffB); PG8_STAGE(PG8_SA(1, 0), a3, vX0);
            PG8_WAIT_V(8); PG8_WAIT_L(0); PG8_BAR; PG8_MMA(1, 0, At, B0); PG8_MMA(1, 1, At, B1); PG8_BAR; PG8_SCHED;
            if (last) {
#pragma unroll
                for (int i = 0; i < 2; ++i) { vC0[i] = vX0[i]; vC1[i] = vX1[i]; }
            }
        }
        if (wr == 0) PG8_BAR;
        if constexpr (Epi::FP8) asm volatile("s_nop 15\n\ts_nop 15" ::: "memory");
        E(acc, cur, wr, wc, fr, fq);
        if (!has_next) break;
#pragma unroll
        for (int a = 0; a < 2; ++a)
#pragma unroll
            for (int b = 0; b < 2; ++b)
#pragma unroll
                for (int m = 0; m < 4; ++m)
#pragma unroll
                    for (int n = 0; n < 2; ++n) acc[a][b][m][n] = (f32x4){0.f, 0.f, 0.f, 0.f};
        cur = nxt; cB = nB; ++ui;
        if (wr == 1) PG8_BAR;
    }
    PG8_WAIT_V(0);
    PG8_BAR;
#undef PG8_SA
#undef PG8_SB
#undef PG8_STAGE
#undef PG8_LDA
#undef PG8_LDB
#undef PG8_MMA
#undef PG8_WAIT_V
#undef PG8_WAIT_L
#undef PG8_BAR
#undef PG8_SCHED
}
}

#define XB_TMO      128
#define XB_XCNT(j)  (256  + 64 * (j))
#define XB_XSUB(j)  (1280 + 64 * (j))
#define XB_XGEN(j)  (2304 + 64 * (j))
#define XB_TOP      3328
#define XB_TOPGEN   3392
#define XCD_BAR_WORDS 3456
#define XB_SPIN_CAP (1u << 22)
__device__ __forceinline__ unsigned xb_ld(unsigned* p)              { return __hip_atomic_load(p, __ATOMIC_RELAXED, __HIP_MEMORY_SCOPE_AGENT); }
__device__ __forceinline__ unsigned xb_add(unsigned* p, unsigned v) { return __hip_atomic_fetch_add(p, v, __ATOMIC_RELAXED, __HIP_MEMORY_SCOPE_AGENT); }
__device__ __forceinline__ unsigned xb_xcc_id() { return (unsigned)__builtin_amdgcn_s_getreg((3 << 11) | 20) & 0xFu; }
#define XB_SPIN(cond, bar) do { unsigned _sp = 0; while (cond) { __builtin_amdgcn_s_sleep(1); \
    if ((++_sp & 255u) == 0u) { if (xb_ld(&(bar)[XB_TMO])) break; if (_sp > XB_SPIN_CAP) { atomicAdd(&(bar)[XB_TMO], 1u); break; } } } } while (0)
struct XcdBarrier { unsigned* bar; unsigned x; volatile LAS unsigned* st; };
__device__ __forceinline__ XcdBarrier xcd_barrier_post(unsigned* bar, volatile LAS unsigned* st) {
    XcdBarrier b; b.bar = bar; b.x = xb_xcc_id(); b.st = st;
    if (threadIdx.x == 0) (void)xb_add(&bar[XB_XCNT(b.x)], 1u);
    return b;
}
__device__ __forceinline__ void xcd_barrier_complete(unsigned* bar, unsigned x, unsigned& nloc, unsigned& nx) {
    const unsigned G = gridDim.x * gridDim.y * gridDim.z;
    unsigned sum, cnt, mine, sp = 0u;
    for (;;) {
        sum = 0u; cnt = 0u; mine = 0u;
#pragma unroll
        for (unsigned j = 0; j < 16; ++j) { const unsigned c = xb_ld(&bar[XB_XCNT(j)]); sum += c; cnt += (c > 0u) ? 1u : 0u; mine = (j == x) ? c : mine; }
        if (sum == G) break;
        __builtin_amdgcn_s_sleep(1);
        if ((++sp & 255u) == 0u) { if (xb_ld(&bar[XB_TMO])) break; if (sp > XB_SPIN_CAP) { atomicAdd(&bar[XB_TMO], 1u); break; } }
    }
    nloc = mine > 0u ? mine : 1u; nx = cnt > 0u ? cnt : 1u;
}
__device__ __forceinline__ void xcd_barrier(const XcdBarrier& b) {
    asm volatile("s_waitcnt vmcnt(0)" ::: "memory");
    __syncthreads();
    if (threadIdx.x == 0) {
        unsigned* bar = b.bar;
        __builtin_amdgcn_s_waitcnt(0);
        unsigned nloc = b.st[0], nx = b.st[1];
        if (nloc == 0u) { xcd_barrier_complete(bar, b.x, nloc, nx); b.st[0] = nloc; b.st[1] = nx; }
        const unsigned old = xb_add(&bar[XB_XSUB(b.x)], 1u);
        const unsigned gen = old / nloc;
        if (old + 1u == (gen + 1u) * nloc) {
            __builtin_amdgcn_fence(__ATOMIC_RELEASE, "agent");
            asm volatile("s_waitcnt vmcnt(0)" ::: "memory");
            const unsigned og = xb_add(&bar[XB_TOP], 1u);
            const unsigned tg = og / nx;
            if (og + 1u == (tg + 1u) * nx) xb_add(&bar[XB_TOPGEN], 1u);
            else XB_SPIN(xb_ld(&bar[XB_TOPGEN]) == tg, bar);
            __builtin_amdgcn_fence(__ATOMIC_ACQUIRE, "agent");
            xb_add(&bar[XB_XGEN(b.x)], 1u);
            asm volatile("s_waitcnt vmcnt(0)" ::: "memory");
        } else {
            XB_SPIN(xb_ld(&bar[XB_XGEN(b.x)]) == gen, bar);
            __builtin_amdgcn_fence(__ATOMIC_ACQUIRE, "agent");
            asm volatile("s_waitcnt vmcnt(0)" ::: "memory");
        }
    }
    __syncthreads();
}

struct Args { const float* in[39]; float* out; unsigned char* ws; int ph_lo, ph_hi; };
struct Frame {
    LAS unsigned char* lds;
    int tid, lane, wave, G, bx;
    const float* const* in; float* out; unsigned char* ws;
    GAS unsigned* ctl;
};
#define IN_X 0
#define IN_C 1
#define IN_CTX 2
#define IN_CCTX 3
#define IN_WADA 4
#define IN_BADA 5
#define IN_N1G 6
#define IN_N2G 7
#define IN_WIN 8
#define IN_LRE 9
#define IN_LIM 10
#define IN_LDT 11
#define IN_BRE 12
#define IN_BIM 13
#define IN_CRE 14
#define IN_CIM 15
#define IN_S5D 16
#define IN_WGLU 17
#define IN_HSW 18
#define IN_HW1 19
#define IN_HB1 20
#define IN_HF1 21
#define IN_HW2 22
#define IN_HB2 23
#define IN_HF2 24
#define IN_HW3 25
#define IN_HB3 26
#define IN_HDEC 27
#define IN_HBIAS 28
#define IN_WBS5 29
#define IN_WBHY 30
#define IN_WO 31
#define IN_RW 32
#define IN_RB 33
#define IN_WGU 34
#define IN_BGU 35
#define IN_WDN 36
#define IN_BDN 37
#define IN_FG 38

__device__ __forceinline__ void p0_adaln_item(Frame& F, int cb) {
    LAS float* sl = (LAS float*)F.lds;
    const float* c = F.in[IN_C]; const float* cc = F.in[IN_CCTX]; const float* W = F.in[IN_WADA];
    for (int i = F.tid; i < 3 * 2048; i += NTHR) { const int v = i >> 11, k = i & 2047; const float cv = (v < 2) ? c[v * 2048 + k] : cc[k]; sl[i] = cv * sigmoidf_(cv); }
    __syncthreads();
    const int col = F.tid % 48, ks = F.tid / 48;
    float a0 = 0.f, a1 = 0.f, a2 = 0.f;
    if (ks < 10) { const float* wp = W + 48 * cb + col;
#pragma unroll 16
        for (int j = 0; j < 205; ++j) { const int k = ks + 10 * j; if (k < 2048) { const float w = wp[(size_t)k * 12288]; a0 += sl[k] * w; a1 += sl[2048 + k] * w; a2 += sl[4096 + k] * w; } } }
    LAS float* red = sl + 6144;
    if (ks < 10) { red[(ks * 48 + col) * 3 + 0] = a0; red[(ks * 48 + col) * 3 + 1] = a1; red[(ks * 48 + col) * 3 + 2] = a2; }
    __syncthreads();
    if (F.tid < 144) { const int v = F.tid / 48, cl = F.tid % 48; float sacc = 0.f;
#pragma unroll
        for (int q = 0; q < 10; ++q) sacc += red[(q * 48 + cl) * 3 + v];
        ((float*)(F.ws + WS_MOD))[v * 12288 + 48 * cb + cl] = sacc + F.in[IN_BADA][48 * cb + cl]; }
    __syncthreads();
}
__device__ __forceinline__ void p0_filt_item(Frame& F, int tb) {
    LAS float* ft = (LAS float*)F.lds;
    LAS float* h1 = ft + 64 * 36;
    LAS float* h2 = h1 + 64 * 65;
    const int t0 = tb * 64, tl = F.tid >> 3, q = F.tid & 7; const float tf = (float)(t0 + tl);
    for (int f = q; f < 33; f += 8) {
        float v;
        if (f == 0) v = tf * (1.0f / 16383.0f);
        else { const int bi = (f - 1) & 15; const float band = 1e-4f + (float)bi * ((15.0f - 1e-4f) / 15.0f); const float rev = tf * band * (1.0f / 16384.0f);
               v = (f <= 16) ? cos_rev(rev) : -sin_rev(rev); }
        ft[tl * 36 + f] = v;
    }
    LAS float* w1s = ft + 13312; LAS float* w2s = w1s + 33 * 64;
    for (int i = F.tid; i < 33 * 64; i += NTHR) w1s[i] = F.in[IN_HW1][i];
    for (int i = F.tid; i < 64 * 64; i += NTHR) w2s[i] = F.in[IN_HW2][i];
    __syncthreads();
    { const float* b1 = F.in[IN_HB1]; const float* f1 = F.in[IN_HF1]; float a[8];
#pragma unroll
      for (int jj = 0; jj < 8; ++jj) a[jj] = b1[q * 8 + jj];
#pragma unroll 11
      for (int f = 0; f < 33; ++f) { const float xv = ft[tl * 36 + f]; const f32x4 wa = *(const LAS f32x4*)(w1s + f * 64 + q * 8), wb = *(const LAS f32x4*)(w1s + f * 64 + q * 8 + 4);
          a[0] += xv * wa.x; a[1] += xv * wa.y; a[2] += xv * wa.z; a[3] += xv * wa.w; a[4] += xv * wb.x; a[5] += xv * wb.y; a[6] += xv * wb.z; a[7] += xv * wb.w; }
#pragma unroll
      for (int jj = 0; jj < 8; ++jj) { const int j = q * 8 + jj; h1[tl * 65 + j] = sin_rev(f1[j] * a[jj] * 0.15915494309189535f); } }
    __syncthreads();
    { const float* b2 = F.in[IN_HB2]; const float* f2 = F.in[IN_HF2]; float a[8];
#pragma unroll
      for (int jj = 0; jj < 8; ++jj) a[jj] = b2[q * 8 + jj];
#pragma unroll 16
      for (int i = 0; i < 64; ++i) { const float xv = h1[tl * 65 + i]; const f32x4 wa = *(const LAS f32x4*)(w2s + i * 64 + q * 8), wb = *(const LAS f32x4*)(w2s + i * 64 + q * 8 + 4);
          a[0] += xv * wa.x; a[1] += xv * wa.y; a[2] += xv * wa.z; a[3] += xv * wa.w; a[4] += xv * wb.x; a[5] += xv * wb.y; a[6] += xv * wb.z; a[7] += xv * wb.w; }
#pragma unroll
      for (int jj = 0; jj < 8; ++jj) { const int j = q * 8 + jj; h2[tl * 64 + j] = sin_rev(f2[j] * a[jj] * 0.15915494309189535f); } }
    __syncthreads();
    LAS unsigned short* hb = (LAS unsigned short*)(h2 + 64 * 64);
    for (int i = F.tid; i < 64 * 64; i += NTHR) hb[(i >> 6) * 72 + (i & 63)] = (unsigned short)f2bf(h2[i]);
    __syncthreads();
    const float* w3 = F.in[IN_HW3]; const float* b3 = F.in[IN_HB3]; const float* dec = F.in[IN_HDEC]; bf16* FILT = (bf16*)(F.ws + WS_FILT);
    const int fr = F.lane & 15, fq = F.lane >> 4;
    bf16x8 af[4][2];
#pragma unroll
    for (int m = 0; m < 4; ++m)
#pragma unroll
        for (int ks = 0; ks < 2; ++ks) af[m][ks] = *(const LAS bf16x8*)(hb + (16 * m + fr) * 72 + 32 * ks + 8 * fq);
#pragma unroll 4
    for (int jt = F.wave; jt < 256; jt += NWAVES) {
        const int j = 16 * jt + fr;
        bf16x8 bfr[2];
#pragma unroll
        for (int ks = 0; ks < 2; ++ks) { float w[8];
#pragma unroll
            for (int e = 0; e < 8; ++e) w[e] = w3[(size_t)(32 * ks + 8 * fq + e) * 4096 + j];
            u32x4 pk; pk.x = pk2(w[0], w[1]); pk.y = pk2(w[2], w[3]); pk.z = pk2(w[4], w[5]); pk.w = pk2(w[6], w[7]); bfr[ks] = __builtin_bit_cast(bf16x8, pk); }
        const float bb = b3[j], dd = fabsf(dec[j]) * (1.0f / 16383.0f);
#pragma unroll
        for (int m = 0; m < 4; ++m) { f32x4 acc = (f32x4){0.f, 0.f, 0.f, 0.f};
#pragma unroll
            for (int ks = 0; ks < 2; ++ks) acc = __builtin_amdgcn_mfma_f32_16x16x32_bf16(af[m][ks], bfr[ks], acc, 0, 0, 0);
            const int tb0 = t0 + 16 * m + 4 * fq; f32x4 o;
#pragma unroll
            for (int e = 0; e < 4; ++e) o[e] = (acc[e] + bb) * __expf(-(float)(tb0 + e) * dd);
            *(u32x2*)(FILT + (size_t)j * SEQ + tb0) = (u32x2){cvt_pk_bf16(o[0], o[1]), cvt_pk_bf16(o[2], o[3])}; }
    }
    __syncthreads();
}
__device__ __forceinline__ void p0_s5tab_item(Frame& F, int item) {
    const int idx = item * NTHR + F.tid; const int d = idx >> 12, g = (idx >> 6) & 63, p = idx & 63, dg = d * 64 + g;
    const float lr = F.in[IN_LRE][dg * 64 + p], li = F.in[IN_LIM][dg * 64 + p], dt = expf(F.in[IN_LDT][dg]);
    const float mag = expf(lr * dt), ang = li * dt; const float lbr = mag * cosf(ang), lbi = mag * sinf(ang);
    const float den = lr * lr + li * li, cr = ((lbr - 1.f) * lr + lbi * li) / den, ci = (lbi * lr - (lbr - 1.f) * li) / den;
    bf16* BBT = (bf16*)(F.ws + WS_BBT); bf16* BB2 = (bf16*)(F.ws + WS_BB2); bf16* CTT = (bf16*)(F.ws + WS_CTT); f32x2* LAM = (f32x2*)(F.ws + WS_LAM);
    const float* bre = F.in[IN_BRE] + (size_t)(dg * 64 + p) * 16; const float* bim = F.in[IN_BIM] + (size_t)(dg * 64 + p) * 16;
    for (int c = 0; c < 16; ++c) { const float br = bre[c], bi = bim[c];
        BBT[(size_t)(dg * 128 + p) * 16 + c] = (bf16)f2bf(cr * br - ci * bi); BBT[(size_t)(dg * 128 + 64 + p) * 16 + c] = (bf16)f2bf(cr * bi + ci * br);
        BB2[(size_t)(dg * 128 + 2 * p) * 16 + c] = (bf16)f2bf(cr * br - ci * bi); BB2[(size_t)(dg * 128 + 2 * p + 1) * 16 + c] = (bf16)f2bf(cr * bi + ci * br); }
    const int k = 2 * p;
    for (int c = 0; c < 16; ++c) { const float cre = F.in[IN_CRE][(size_t)(dg * 16 + c) * 64 + p], cim = F.in[IN_CIM][(size_t)(dg * 16 + c) * 64 + p];
        CTT[(size_t)(dg * 16 + c) * 128 + k] = (bf16)f2bf(cre); CTT[(size_t)(dg * 16 + c) * 128 + k + 1] = (bf16)f2bf(-cim); }
    LAM[dg * 64 + p] = (f32x2){lbr, lbi};
}
__device__ __forceinline__ void p0_transpose_item(const float* W, int K, int N, bf16* WT, LAS unsigned short* scr, int kb, int nb, int lane) {
    const int k0 = 64 * kb, n0 = 128 * nb;
    const float* wp = W + (size_t)(k0 + (lane >> 5)) * N + n0 + 4 * (lane & 31);
#pragma unroll
    for (int half = 0; half < 2; ++half) { f32x4 v[16];
#pragma unroll
        for (int i = 0; i < 16; ++i) v[i] = *(const GAS f32x4*)(wp + (size_t)(32 * half + 2 * i) * N);
#pragma unroll
        for (int i = 0; i < 16; ++i) { const int kk = 32 * half + 2 * i + (lane >> 5); LAS unsigned* d = (LAS unsigned*)(scr + kk * 130 + 4 * (lane & 31)); d[0] = pk2(v[i].x, v[i].y); d[1] = pk2(v[i].z, v[i].w); } }
    LDS_WAIT(); asm volatile("" ::: "memory");
    const int c = lane & 7;
#pragma unroll
    for (int j = 0; j < 16; ++j) { const int r = (lane >> 3) + 8 * j; const LAS unsigned short* sp = scr + (8 * c) * 130 + r;
        u32x4 o; o.x = (unsigned)sp[0] | ((unsigned)sp[130] << 16); o.y = (unsigned)sp[2 * 130] | ((unsigned)sp[3 * 130] << 16); o.z = (unsigned)sp[4 * 130] | ((unsigned)sp[5 * 130] << 16); o.w = (unsigned)sp[6 * 130] | ((unsigned)sp[7 * 130] << 16);
        *(GAS u32x4*)(WT + (size_t)(n0 + r) * K + k0 + 8 * c) = o; }
    LDS_WAIT(); asm volatile("" ::: "memory");
}
__device__ __forceinline__ void p0_transpose_item8(const float* W, int K, int N, unsigned char* WT, LAS unsigned short* scr, int kb, int nb, int lane) {
    const int k0 = 64 * kb, n0 = 128 * nb;
    const float* wp = W + (size_t)(k0 + (lane >> 5)) * N + n0 + 4 * (lane & 31);
#pragma unroll
    for (int half = 0; half < 2; ++half) { f32x4 v[16];
#pragma unroll
        for (int i = 0; i < 16; ++i) v[i] = *(const GAS f32x4*)(wp + (size_t)(32 * half + 2 * i) * N);
#pragma unroll
        for (int i = 0; i < 16; ++i) { const int kk = 32 * half + 2 * i + (lane >> 5); LAS unsigned* d = (LAS unsigned*)(scr + kk * 130 + 4 * (lane & 31)); d[0] = pk2(v[i].x, v[i].y); d[1] = pk2(v[i].z, v[i].w); } }
    LDS_WAIT(); asm volatile("" ::: "memory");
    const int c = lane & 7;
#pragma unroll
    for (int j = 0; j < 16; ++j) { const int r = (lane >> 3) + 8 * j; const LAS unsigned short* sp = scr + (8 * c) * 130 + r;
        u32x2 o; o.x = pk4_fp8(bf2f(sp[0]) * W8SCALE, bf2f(sp[130]) * W8SCALE, bf2f(sp[2 * 130]) * W8SCALE, bf2f(sp[3 * 130]) * W8SCALE);
        o.y = pk4_fp8(bf2f(sp[4 * 130]) * W8SCALE, bf2f(sp[5 * 130]) * W8SCALE, bf2f(sp[6 * 130]) * W8SCALE, bf2f(sp[7 * 130]) * W8SCALE);
        *(GAS u32x2*)(WT + (size_t)(n0 + r) * K + k0 + 8 * c) = o; }
    LDS_WAIT(); asm volatile("" ::: "memory");
}
__device__ __forceinline__ void p0_transpose_item8d(const float* W, int K, int N, unsigned char* WT, LAS unsigned short* scr, int kb, int nb, int lane) {
    const int k0 = 64 * kb, n0 = 128 * nb;
    const float* wp = W + (size_t)(k0 + (lane >> 5)) * N + n0 + 4 * (lane & 31);
    f32x4 v[32];
#pragma unroll
    for (int i = 0; i < 32; ++i) v[i] = *(const GAS f32x4*)(wp + (size_t)(2 * i) * N);
#pragma unroll
    for (int i = 0; i < 32; ++i) { const int kk = 2 * i + (lane >> 5); LAS unsigned* d = (LAS unsigned*)(scr + kk * 130 + 4 * (lane & 31)); d[0] = pk2(v[i].x, v[i].y); d[1] = pk2(v[i].z, v[i].w); }
    LDS_WAIT(); asm volatile("" ::: "memory");
    const int c = lane & 7;
#pragma unroll
    for (int j = 0; j < 16; ++j) { const int r = (lane >> 3) + 8 * j; const LAS unsigned short* sp = scr + (8 * c) * 130 + r;
        u32x2 o; o.x = pk4_fp8(bf2f(sp[0]) * W8SCALE, bf2f(sp[130]) * W8SCALE, bf2f(sp[2 * 130]) * W8SCALE, bf2f(sp[3 * 130]) * W8SCALE);
        o.y = pk4_fp8(bf2f(sp[4 * 130]) * W8SCALE, bf2f(sp[5 * 130]) * W8SCALE, bf2f(sp[6 * 130]) * W8SCALE, bf2f(sp[7 * 130]) * W8SCALE);
        *(GAS u32x2*)(WT + (size_t)(n0 + r) * K + k0 + 8 * c) = o; }
    LDS_WAIT(); asm volatile("" ::: "memory");
}
__device__ __forceinline__ void moe_weight_queue(Frame& F) {
    constexpr int W_GU1 = 32 * 32, W_DN1 = 16 * 32, W_GU = 32 * W_GU1, W_DN = 32 * W_DN1;
    LAS unsigned short* scr = (LAS unsigned short*)(F.lds + F.wave * 16640);
    const int lane = F.lane;
    __syncthreads();
    for (;;) {
        int r0 = 0;
        if (lane == 0) r0 = (int)__hip_atomic_fetch_add((unsigned*)(F.ctl + CW_QT), 4u, __ATOMIC_RELAXED, __HIP_MEMORY_SCOPE_AGENT);
        r0 = __builtin_amdgcn_readfirstlane(r0);
        if (r0 >= W_GU + W_DN) break;
#pragma unroll 1
        for (int sub = 0; sub < 4; ++sub) { const int r = r0 + sub;
            const float* W; unsigned char* WT; int N, kb, nb;
            if (r < W_GU) { const int e = r / W_GU1, q = r % W_GU1; W = F.in[IN_WGU] + (size_t)e * 2048 * 4096; WT = (unsigned char*)(F.ws + WS_WGU) + (size_t)e * 4096 * 2048; N = 4096; kb = q & 31; nb = q >> 5; }
            else { const int rr = r - W_GU; const int e = rr / W_DN1, q = rr % W_DN1; W = F.in[IN_WDN] + (size_t)e * 2048 * 2048; WT = (unsigned char*)(F.ws + WS_WDN) + (size_t)e * 2048 * 2048; N = 2048; kb = q & 31; nb = q >> 5; }
            const int K = 2048, k0 = 64 * kb, n0 = 128 * nb;
            const float* wp = W + (size_t)(k0 + (lane >> 5)) * N + n0 + 4 * (lane & 31);
            f32x4 v[32];
#pragma unroll
            for (int i = 0; i < 32; ++i) v[i] = __builtin_nontemporal_load((const GAS f32x4*)(wp + (size_t)(2 * i) * N));
            LAS unsigned char* sb = (LAS unsigned char*)scr;
#pragma unroll
            for (int i = 0; i < 32; ++i) { const int kk = 2 * i + (lane >> 5); *(LAS unsigned*)(sb + kk * 132 + 4 * (lane & 31)) = pk4_fp8(v[i].x * W8SCALE, v[i].y * W8SCALE, v[i].z * W8SCALE, v[i].w * W8SCALE); }
            LDS_WAIT(); asm volatile("" ::: "memory");
            const int c = lane & 7;
#pragma unroll
            for (int j = 0; j < 16; ++j) { const int rw = (lane >> 3) + 8 * j; const LAS unsigned char* sp = sb + (8 * c) * 132 + rw;
                u32x2 o; o.x = (unsigned)sp[0] | ((unsigned)sp[132] << 8) | ((unsigned)sp[2 * 132] << 16) | ((unsigned)sp[3 * 132] << 24);
                o.y = (unsigned)sp[4 * 132] | ((unsigned)sp[5 * 132] << 8) | ((unsigned)sp[6 * 132] << 16) | ((unsigned)sp[7 * 132] << 24);
                __builtin_nontemporal_store(o, (GAS u32x2*)(WT + (size_t)(n0 + rw) * K + k0 + 8 * c)); }
            LDS_WAIT(); asm volatile("" ::: "memory");
        }
    }
    __syncthreads();
}
__device__ __forceinline__ void p0_prologue(Frame& F) {
    for (int it = F.bx; it < 256; it += F.G) p0_adaln_item(F, it);
    for (int it = F.bx; it < 256; it += F.G) p0_filt_item(F, it);
    for (int it = F.bx; it < 16; it += F.G) p0_s5tab_item(F, it);
    { const float* rw = F.in[IN_RW]; float* RWT = (float*)(F.ws + WS_RWT);
      for (int i = F.bx * NTHR + F.tid; i < 32 * 2048; i += F.G * NTHR) { const int e = i >> 11, k = i & 2047; RWT[i] = rw[k * 32 + e]; } }
    __syncthreads();
    LAS unsigned short* scr = (LAS unsigned short*)(F.lds + F.wave * 16640);
    constexpr int I_IN = 64 * 4, I_GLU = 8 * 2, I_BS5 = 16 * 2, I_BHY = 16 * 2, I_O = 16 * 4;
    constexpr int NITEMS = I_IN + I_GLU + I_BS5 + I_BHY + I_O;
    const int w = F.wave;
    for (int it = F.bx; it < NITEMS; it += F.G) {
        int r = it;
        if (r < I_IN) { if ((r >> 2) < 32) p0_transpose_item(F.in[IN_WIN], 2048, 8192, (bf16*)(F.ws + WS_WIN), scr, 8 * (r & 3) + w, r >> 2, F.lane);
                        else p0_transpose_item8(F.in[IN_WIN], 2048, 8192, (unsigned char*)(F.ws + WS_WIN8) - (size_t)4096 * 2048, scr, 8 * (r & 3) + w, r >> 2, F.lane); continue; } r -= I_IN;
        if (r < I_GLU) { p0_transpose_item(F.in[IN_WGLU], 1024, 1024, (bf16*)(F.ws + WS_WGLU), scr, 8 * (r & 1) + w, r >> 1, F.lane); continue; } r -= I_GLU;
        if (r < I_BS5) { p0_transpose_item(F.in[IN_WBS5], 1024, 2048, (bf16*)(F.ws + WS_WBS5), scr, 8 * (r & 1) + w, r >> 1, F.lane); continue; } r -= I_BS5;
        if (r < I_BHY) { p0_transpose_item(F.in[IN_WBHY], 1024, 2048, (bf16*)(F.ws + WS_WBHY), scr, 8 * (r & 1) + w, r >> 1, F.lane); continue; } r -= I_BHY;
        { p0_transpose_item8(F.in[IN_WO], 2048, 2048, (unsigned char*)(F.ws + WS_WO), scr, 8 * (r & 3) + w, r >> 2, F.lane); }
    }
}

__device__ __forceinline__ void p1_norm(Frame& F) {
    const int gw = F.bx * NWAVES + F.wave, NGW = F.G * NWAVES;
    const float* MOD = (const float*)(F.ws + WS_MOD); const float* g1n = F.in[IN_N1G];
    bf16* U = (bf16*)(F.ws + WS_U);
    int curv = -1; f32x4 ga[8], sh[8];
    for (int m = gw; m < NTOK + NCTX; m += NGW) {
        const int v = (m < NTOK) ? (m >> 14) : 2;
        if (v != curv) { curv = v;
#pragma unroll
            for (int j = 0; j < 8; ++j) { const int k = 4 * F.lane + 256 * j; const f32x4 g = *(const f32x4*)(g1n + k), sc = *(const f32x4*)(MOD + v * 12288 + 2048 + k); ga[j] = g * (sc + 1.0f); sh[j] = *(const f32x4*)(MOD + v * 12288 + k); } }
        const float* xr = (m < NTOK) ? (F.in[IN_X] + (size_t)m * D) : (F.in[IN_CTX] + (size_t)(m - NTOK) * D);
        f32x4 x[8]; float s = 0.f;
#pragma unroll
        for (int j = 0; j < 8; ++j) { x[j] = *(const GAS f32x4*)(xr + 4 * F.lane + 256 * j); s += (x[j].x * x[j].x + x[j].y * x[j].y) + (x[j].z * x[j].z + x[j].w * x[j].w); }
        const float rstd = 1.0f / sqrtf(wave_sum(s) * (1.0f / D) + 1e-6f);
        GAS u32x2* o = (GAS u32x2*)(U + (size_t)m * D) + F.lane; GAS unsigned* o8 = (GAS unsigned*)(F.ws + WS_U8 + (size_t)m * D) + F.lane;
#pragma unroll
        for (int j = 0; j < 8; ++j) { const f32x4 y = x[j] * rstd * ga[j] + sh[j]; o[64 * j] = (u32x2){pk2(y.x, y.y), pk2(y.z, y.w)}; if (m < NTOK) o8[64 * j] = pk4_fp8(y.x, y.y, y.z, y.w); }
    }
}

struct SchedIn {
    int G, c, nmain, npn, mode, nrep;
    const char* A; const char* Bt;
    __device__ __forceinline__ bool next(int i, pg8::Unit& u) const {
        int L = i * G + c; u.e = 0; u.valid = 256; { const int tot = nmain + (mode == 0 ? 8 : 0); if (nrep > 1 && L >= tot && L < 2 * tot) L -= tot; }
        if (L < nmain) {
            int wgid = L; { const int q = nmain / 8, xcd = wgid % 8, off = wgid / 8; wgid = xcd * q + off; }
            const int nig = 8 * npn, gid = wgid / nig; const int pm = gid * 8 + ((wgid % nig) % 8), pl = (wgid % nig) / 8;
            u.pm = pm; u.pn = (mode == 0) ? pl : (mode == 1 ? pl + 4 : pl + 16); return true;
        }
        if (mode == 0 && L < nmain + 8) { const int q = L - nmain; u.pm = 128 + (q >> 2); u.pn = q & 3; return true; }
        return false;
    }
    __device__ __forceinline__ unsigned a_row(const pg8::Unit& u, int r) const { return (u.pm < 128) ? (unsigned)((u.pm >> 6) * SEQ + r * 64 + (u.pm & 63)) : (unsigned)(NTOK + (u.pm - 128) * 256 + r); }
    __device__ __forceinline__ const char* a_base() const { return A; }
    __device__ __forceinline__ const char* b_base(const pg8::Unit& u) const { return (mode == 2) ? Bt + (size_t)(u.pn - 16) * 256 * D : Bt + (size_t)u.pn * 256 * D * 2; }
};
__device__ __forceinline__ unsigned q8(float s) { return (unsigned)(s * 255.0f + 0.5f); }
struct EpiInG8 {
    static constexpr bool PERM = true, TRANS = true, FP8 = true;
    unsigned char* UG;
    __device__ __forceinline__ void operator()(const f32x4 (&acc)[2][2][4][2], const pg8::Unit& u, int wr, int wc, int fr, int fq) const {
        const int col0 = (u.pn - 16) * 256 + wc * 32 + 8 * fq;
#pragma unroll
        for (int ai = 0; ai < 2; ++ai)
#pragma unroll
            for (int m = 0; m < 4; ++m) { const int r = ai * 128 + wr * 64 + m * 16 + fr; const size_t row = (size_t)((u.pm >> 6) * SEQ + r * 64 + (u.pm & 63));
                unsigned char* rowp = UG + row * 4096 + col0;
#pragma unroll
                for (int bj = 0; bj < 2; ++bj) { f32x4 v0 = acc[ai][bj][m][0] * (1.0f / W8SCALE), v1 = acc[ai][bj][m][1] * (1.0f / W8SCALE);
#pragma unroll
                    for (int j = 0; j < 4; ++j) { v0[j] = sigmoidf_(v0[j]); v1[j] = sigmoidf_(v1[j]); }
                    u32x2 w; w.x = q8(v0[0]) | (q8(v0[1]) << 8) | (q8(v0[2]) << 16) | (q8(v0[3]) << 24); w.y = q8(v1[0]) | (q8(v1[1]) << 8) | (q8(v1[2]) << 16) | (q8(v1[3]) << 24);
                    *(u32x2*)(rowp + bj * 128) = w; } }
    }
};
struct EpiInA {
    static constexpr bool PERM = true, TRANS = true, FP8 = false;
    unsigned char* ws;
    __device__ __forceinline__ void operator()(const f32x4 (&acc)[2][2][4][2], const pg8::Unit& u, int wr, int wc, int fr, int fq) const {
        const bool isctx = u.pm >= 128, isg = u.pn >= 16;
        const size_t boff = isctx ? WS_UCA : (isg ? WS_UG : WS_UA);
        bf16* base = (bf16*)(ws + boff); const size_t ld = isg ? 4096 : S5W; const int colt = isg ? (u.pn - 16) * 256 : u.pn * 256;
        const int col0 = colt + wc * 32 + 8 * fq;
#pragma unroll
        for (int ai = 0; ai < 2; ++ai)
#pragma unroll
            for (int m = 0; m < 4; ++m) { const int r = ai * 128 + wr * 64 + m * 16 + fr;
                const size_t row = isctx ? (size_t)((u.pm - 128) * 256 + r) : (size_t)((u.pm >> 6) * SEQ + r * 64 + (u.pm & 63));
                bf16* rowp = base + row * ld + col0;
#pragma unroll
                for (int bj = 0; bj < 2; ++bj) { f32x4 v0 = acc[ai][bj][m][0], v1 = acc[ai][bj][m][1];
                    if (isg) {
#pragma unroll
                        for (int j = 0; j < 4; ++j) { v0[j] = sigmoidf_(v0[j]); v1[j] = sigmoidf_(v1[j]); } }
                    u32x4 w; w.x = cvt_pk_bf16(v0[0], v0[1]); w.y = cvt_pk_bf16(v0[2], v0[3]); w.z = cvt_pk_bf16(v1[0], v1[1]); w.w = cvt_pk_bf16(v1[2], v1[3]);
                    *(u32x4*)(rowp + bj * 128) = w; } }
    }
};
struct EpiInH {
    static constexpr bool PERM = false, TRANS = false, FP8 = false;
    bf16* UH;
    __device__ __forceinline__ void operator()(const f32x4 (&acc)[2][2][4][2], const pg8::Unit& u, int wr, int wc, int fr, int fq) const {
        const int b = u.pm >> 6, w = u.pm & 63;
#pragma unroll
        for (int bj = 0; bj < 2; ++bj)
#pragma unroll
            for (int n = 0; n < 2; ++n) { const int ch = (u.pn - 4) * 256 + bj * 128 + wc * 32 + n * 16 + fr;
                bf16* cp = UH + ((size_t)(b * 3072 + ch) * SEQ + w * 256);
#pragma unroll
                for (int ai = 0; ai < 2; ++ai)
#pragma unroll
                    for (int m = 0; m < 4; ++m) { const int r0 = ai * 128 + wr * 64 + m * 16 + 4 * fq; const f32x4 v = acc[ai][bj][m][n];
                        *(u32x2*)(cp + r0) = (u32x2){cvt_pk_bf16(v[0], v[1]), cvt_pk_bf16(v[2], v[3])}; } }
    }
};

template <bool PASSB>
__device__ __forceinline__ void s5_pass(Frame& F) {
    constexpr int nk = PASSB ? 256 : 260;
    constexpr int nitems = 2 * nk * 8;
    LAS unsigned char* sl = F.lds + F.wave * 8704;
    const int lane = F.lane, pl = lane & 31, hi = lane >> 5, fr = lane & 15, fq = lane >> 4;
    const bf16* UA = (const bf16*)(F.ws + WS_UA); const bf16* UCA = (const bf16*)(F.ws + WS_UCA);
    const bf16* BBT = (const bf16*)(F.ws + WS_BBT); const bf16* CTT = (const bf16*)(F.ws + WS_CTT); const f32x2* LAM = (const f32x2*)(F.ws + WS_LAM);
    f32x2* EB = (f32x2*)(F.ws + WS_E); const f32x2* SINB = (const f32x2*)(F.ws + WS_SIN); bf16* Y = (bf16*)(F.ws + WS_Y);
    const int s_r = 16 * ((pl >> 2) & 1) + 4 * (pl >> 3) + (pl & 3);
    for (int it = F.bx; it < nitems; it += F.G) {
        const int gq = it & 7, rest = it >> 3; const int b = rest / nk, kk = rest % nk; const int kc = PASSB ? kk + 4 : kk;
        const int g = gq * 8 + F.wave;
        const bf16* urow = (kc < 4) ? (UCA + (size_t)(b * CTX + kc * 64) * S5W + 16 * g) : (UA + (size_t)(b * SEQ + (kc - 4) * 64) * S5W + 16 * g);
        f32x4 yacc[4];
#pragma unroll
        for (int q = 0; q < 4; ++q) yacc[q] = (f32x4){0.f, 0.f, 0.f, 0.f};
#pragma unroll
        for (int d = 0; d < 2; ++d) {
            const int dg = d * 64 + g;
            bf16x8 bb[4];
#pragma unroll
            for (int ni = 0; ni < 4; ++ni) bb[ni] = *(const bf16x8*)(BBT + (size_t)(dg * 128 + 32 * ni + pl) * 16 + 8 * hi);
            bf16x8 ct[4];
            if (PASSB) {
#pragma unroll
                for (int ks = 0; ks < 4; ++ks) ct[ks] = *(const bf16x8*)(CTT + (size_t)(dg * 16 + fr) * 128 + 32 * ks + 8 * fq);
            }
            const f32x2 lamA = LAM[dg * 64 + pl], lamB = LAM[dg * 64 + pl + 32];
            f32x2 l2 = cmul(lamA, lamA), l4 = cmul(l2, l2), l8 = cmul(l4, l4); const f32x2 lam16A = cmul(l8, l8);
            l2 = cmul(lamB, lamB); l4 = cmul(l2, l2); l8 = cmul(l4, l4); const f32x2 lam16B = cmul(l8, l8);
            f32x2 cA = (f32x2){0.f, 0.f}, cB = (f32x2){0.f, 0.f};
            const size_t sidx = ((size_t)((d * 2 + b) * NCH + kc)) * 4096 + g * 64 + pl;
            if (PASSB) { cA = SINB[sidx]; cB = SINB[sidx + 32]; }
#pragma unroll
            for (int sc = 0; sc < 2; ++sc) {
                const int iscan = 32 * sc + s_r; const int tok = (d == 0) ? iscan : 63 - iscan;
                const bf16x8 a = *(const bf16x8*)(urow + (size_t)tok * S5W + 8 * hi);
                f32x16 acc[4];
#pragma unroll
                for (int ni = 0; ni < 4; ++ni) { f32x16 z;
#pragma unroll
                    for (int i = 0; i < 16; ++i) z[i] = 0.f;
                    acc[ni] = __builtin_amdgcn_mfma_f32_32x32x16_bf16(a, bb[ni], z, 0, 0, 0); }
                asm volatile("s_nop 7\n\ts_nop 7" : "+v"(acc[0]), "+v"(acc[1]), "+v"(acc[2]), "+v"(acc[3]) : "v"(a), "v"(bb[0]), "v"(bb[1]), "v"(bb[2]), "v"(bb[3]));
                f32x2 sA = hi ? (f32x2){0.f, 0.f} : cA, sB = hi ? (f32x2){0.f, 0.f} : cB;
#pragma unroll
                for (int i = 0; i < 16; ++i) {
                    sA = (f32x2){lamA.x * sA.x - lamA.y * sA.y + acc[0][i], lamA.x * sA.y + lamA.y * sA.x + acc[2][i]}; acc[0][i] = sA.x; acc[2][i] = sA.y;
                    sB = (f32x2){lamB.x * sB.x - lamB.y * sB.y + acc[1][i], lamB.x * sB.y + lamB.y * sB.x + acc[3][i]}; acc[1][i] = sB.x; acc[3][i] = sB.y; }
                const f32x2 pA = (f32x2){__shfl_xor(sA.x, 32), __shfl_xor(sA.y, 32)}, pB = (f32x2){__shfl_xor(sB.x, 32), __shfl_xor(sB.y, 32)};
                const f32x2 tA = cmul(lam16A, hi ? pA : sA), tB = cmul(lam16B, hi ? pB : sB);
                const f32x2 e1A = (hi ? sA : pA) + tA, e1B = (hi ? sB : pB) + tB;
                const f32x2 ciA = hi ? pA : (f32x2){0.f, 0.f}, ciB = hi ? pB : (f32x2){0.f, 0.f};
                if (PASSB) {
                    f32x2 wA = cmul(lamA, ciA), wB = cmul(lamB, ciB);
#pragma unroll
                    for (int i = 0; i < 16; ++i) {
                        acc[0][i] += wA.x; acc[2][i] += wA.y; acc[1][i] += wB.x; acc[3][i] += wB.y;
                        *(LAS u32x2*)(sl + (16 * hi + i) * 272 + pl * 8) = (u32x2){cvt_pk_bf16(acc[0][i], acc[2][i]), cvt_pk_bf16(acc[1][i], acc[3][i])};
                        wA = cmul(wA, lamA); wB = cmul(wB, lamB); }
                    bf16x8 bsv[2][4];
#pragma unroll
                    for (int tt = 0; tt < 2; ++tt) {
                        const int rowi = (d == 0) ? (16 * tt + fr) : (16 * tt + 15 - fr);
#pragma unroll
                        for (int ks = 0; ks < 4; ++ks) bsv[tt][ks] = *(const LAS bf16x8*)(sl + rowi * 272 + (32 * ks + 8 * fq) * 2);
                    }
#pragma unroll
                    for (int tt = 0; tt < 2; ++tt) {
                        const int tq = (d == 0) ? (2 * sc + tt) : (3 - 2 * sc - tt);
#pragma unroll
                        for (int ks = 0; ks < 4; ++ks) yacc[tq] = __builtin_amdgcn_mfma_f32_16x16x32_bf16(ct[ks], bsv[tt][ks], yacc[tq], 0, 0, 0);
                    }
                    asm volatile("s_nop 7\n\ts_nop 7" : "+v"(yacc[0]), "+v"(yacc[1]), "+v"(yacc[2]), "+v"(yacc[3]) : "v"(bsv[0][0]), "v"(bsv[0][1]), "v"(bsv[0][2]), "v"(bsv[0][3]), "v"(bsv[1][0]), "v"(bsv[1][1]), "v"(bsv[1][2]), "v"(bsv[1][3]), "v"(ct[0]), "v"(ct[1]), "v"(ct[2]), "v"(ct[3]));
                    asm volatile("s_waitcnt lgkmcnt(0)" ::: "memory");
                }
                cA = e1A; cB = e1B;
            }
            if (!PASSB) { if (hi == 0) { EB[sidx] = cA; EB[sidx + 32] = cB; } }
        }
        if (PASSB) {
            const f32x4 dsk = *(const f32x4*)(F.in[IN_S5D] + 16 * g + 4 * fq);
#pragma unroll
            for (int tq = 0; tq < 4; ++tq) { const int tok = 16 * tq + fr;
                const u32x2 uu = *(const u32x2*)(urow + (size_t)tok * S5W + 4 * fq);
                f32x4 v; v[0] = yacc[tq][0] + bflo(uu.x) * dsk[0]; v[1] = yacc[tq][1] + bfhi(uu.x) * dsk[1]; v[2] = yacc[tq][2] + bflo(uu.y) * dsk[2]; v[3] = yacc[tq][3] + bfhi(uu.y) * dsk[3];
#pragma unroll
                for (int j = 0; j < 4; ++j) { const float x = v[j]; v[j] = x * sigmoidf_(1.5957691216f * (x + 0.044715f * x * x * x)); }
                *(u32x2*)(Y + (size_t)(b * SEQ + (kc - 4) * 64 + tok) * S5W + 16 * g + 4 * fq) = (u32x2){cvt_pk_bf16(v[0], v[1]), cvt_pk_bf16(v[2], v[3])}; }
        }
    }
}
__device__ __forceinline__ void s5_pass_a_simple(Frame& F) {
    constexpr int nitems = 2 * NCH * 8;
    const int lane = F.lane;
    const bf16* UA = (const bf16*)(F.ws + WS_UA); const bf16* UCA = (const bf16*)(F.ws + WS_UCA);
    const bf16* BBT = (const bf16*)(F.ws + WS_BBT); const f32x2* LAM = (const f32x2*)(F.ws + WS_LAM); f32x2* EB = (f32x2*)(F.ws + WS_E);
    for (int it = F.bx; it < nitems; it += F.G) {
        const int gq = it & 7, rest = it >> 3; const int b = rest / NCH, kc = rest % NCH; const int g = gq * 8 + F.wave;
        const bf16* urow = (kc < 4) ? (UCA + (size_t)(b * CTX + kc * 64) * S5W + 16 * g) : (UA + (size_t)(b * SEQ + (kc - 4) * 64) * S5W + 16 * g);
#pragma unroll 1
        for (int d = 0; d < 2; ++d) {
            const int dg = d * 64 + g; const f32x2 lam = LAM[dg * 64 + lane];
            float bre[16], bim[16];
            { const u32x4 r0 = *(const u32x4*)(BBT + (size_t)(dg * 128 + lane) * 16), r1 = *(const u32x4*)(BBT + (size_t)(dg * 128 + lane) * 16 + 8);
              const u32x4 i0 = *(const u32x4*)(BBT + (size_t)(dg * 128 + 64 + lane) * 16), i1 = *(const u32x4*)(BBT + (size_t)(dg * 128 + 64 + lane) * 16 + 8);
              bre[0] = bflo(r0.x); bre[1] = bfhi(r0.x); bre[2] = bflo(r0.y); bre[3] = bfhi(r0.y); bre[4] = bflo(r0.z); bre[5] = bfhi(r0.z); bre[6] = bflo(r0.w); bre[7] = bfhi(r0.w);
              bre[8] = bflo(r1.x); bre[9] = bfhi(r1.x); bre[10] = bflo(r1.y); bre[11] = bfhi(r1.y); bre[12] = bflo(r1.z); bre[13] = bfhi(r1.z); bre[14] = bflo(r1.w); bre[15] = bfhi(r1.w);
              bim[0] = bflo(i0.x); bim[1] = bfhi(i0.x); bim[2] = bflo(i0.y); bim[3] = bfhi(i0.y); bim[4] = bflo(i0.z); bim[5] = bfhi(i0.z); bim[6] = bflo(i0.w); bim[7] = bfhi(i0.w);
              bim[8] = bflo(i1.x); bim[9] = bfhi(i1.x); bim[10] = bflo(i1.y); bim[11] = bfhi(i1.y); bim[12] = bflo(i1.z); bim[13] = bfhi(i1.z); bim[14] = bflo(i1.w); bim[15] = bfhi(i1.w); }
            f32x2 st = (f32x2){0.f, 0.f};
#pragma unroll 4
            for (int i = 0; i < 64; ++i) { const int tok = (d == 0) ? i : 63 - i;
                const u32x4 u0 = *(const u32x4*)(urow + (size_t)tok * S5W), u1 = *(const u32x4*)(urow + (size_t)tok * S5W + 8);
                float u[16]; u[0] = bflo(u0.x); u[1] = bfhi(u0.x); u[2] = bflo(u0.y); u[3] = bfhi(u0.y); u[4] = bflo(u0.z); u[5] = bfhi(u0.z); u[6] = bflo(u0.w); u[7] = bfhi(u0.w);
                u[8] = bflo(u1.x); u[9] = bfhi(u1.x); u[10] = bflo(u1.y); u[11] = bfhi(u1.y); u[12] = bflo(u1.z); u[13] = bfhi(u1.z); u[14] = bflo(u1.w); u[15] = bfhi(u1.w);
                float br = 0.f, bi = 0.f;
#pragma unroll
                for (int c = 0; c < 16; ++c) { br += bre[c] * u[c]; bi += bim[c] * u[c]; }
                st = (f32x2){lam.x * st.x - lam.y * st.y + br, lam.x * st.y + lam.y * st.x + bi}; }
            EB[((size_t)((d * 2 + b) * NCH + kc)) * 4096 + g * 64 + lane] = st;
        }
    }
}
__device__ __forceinline__ void s5_pass_b2(Frame& F) {
    constexpr int nitems = 2 * 256 * 8;
    LAS unsigned char* sl = F.lds + F.wave * 8704;
    const int lane = F.lane, fr = lane & 15, fq = lane >> 4;
    const bf16* UA = (const bf16*)(F.ws + WS_UA); const bf16* BBT = (const bf16*)(F.ws + WS_BBT); const bf16* CTT = (const bf16*)(F.ws + WS_CTT);
    const f32x2* LAM = (const f32x2*)(F.ws + WS_LAM); const f32x2* SINB = (const f32x2*)(F.ws + WS_SIN); bf16* Y = (bf16*)(F.ws + WS_Y);
    for (int it = F.bx; it < nitems; it += F.G) {
        const int gq = it & 7, rest = it >> 3; const int b = rest >> 8, kc = (rest & 255) + 4; const int g = gq * 8 + F.wave;
        const bf16* urow = UA + (size_t)(b * SEQ + (kc - 4) * 64) * S5W + 16 * g;
        f32x4 yacc[4];
#pragma unroll
        for (int q = 0; q < 4; ++q) yacc[q] = (f32x4){0.f, 0.f, 0.f, 0.f};
#pragma unroll
        for (int d = 0; d < 2; ++d) {
            const int dg = d * 64 + g; const f32x2 lam = LAM[dg * 64 + lane];
            float bre[16], bim[16];
            { const u32x4 r0 = *(const u32x4*)(BBT + (size_t)(dg * 128 + lane) * 16), r1 = *(const u32x4*)(BBT + (size_t)(dg * 128 + lane) * 16 + 8);
              const u32x4 i0 = *(const u32x4*)(BBT + (size_t)(dg * 128 + 64 + lane) * 16), i1 = *(const u32x4*)(BBT + (size_t)(dg * 128 + 64 + lane) * 16 + 8);
              bre[0] = bflo(r0.x); bre[1] = bfhi(r0.x); bre[2] = bflo(r0.y); bre[3] = bfhi(r0.y); bre[4] = bflo(r0.z); bre[5] = bfhi(r0.z); bre[6] = bflo(r0.w); bre[7] = bfhi(r0.w);
              bre[8] = bflo(r1.x); bre[9] = bfhi(r1.x); bre[10] = bflo(r1.y); bre[11] = bfhi(r1.y); bre[12] = bflo(r1.z); bre[13] = bfhi(r1.z); bre[14] = bflo(r1.w); bre[15] = bfhi(r1.w);
              bim[0] = bflo(i0.x); bim[1] = bfhi(i0.x); bim[2] = bflo(i0.y); bim[3] = bfhi(i0.y); bim[4] = bflo(i0.z); bim[5] = bfhi(i0.z); bim[6] = bflo(i0.w); bim[7] = bfhi(i0.w);
              bim[8] = bflo(i1.x); bim[9] = bfhi(i1.x); bim[10] = bflo(i1.y); bim[11] = bfhi(i1.y); bim[12] = bflo(i1.z); bim[13] = bfhi(i1.z); bim[14] = bflo(i1.w); bim[15] = bfhi(i1.w); }
            bf16x8 ct[4];
#pragma unroll
            for (int ks = 0; ks < 4; ++ks) ct[ks] = *(const bf16x8*)(CTT + (size_t)(dg * 16 + fr) * 128 + 32 * ks + 8 * fq);
            f32x2 st = SINB[((size_t)((d * 2 + b) * NCH + kc)) * 4096 + g * 64 + lane];
#pragma unroll
            for (int h = 0; h < 2; ++h) {
#pragma unroll 4
                for (int i = 0; i < 32; ++i) { const int sc = 32 * h + i; const int tok = (d == 0) ? sc : 63 - sc;
                    const u32x4 u0 = *(const u32x4*)(urow + (size_t)tok * S5W), u1 = *(const u32x4*)(urow + (size_t)tok * S5W + 8);
                    float u[16]; u[0] = bflo(u0.x); u[1] = bfhi(u0.x); u[2] = bflo(u0.y); u[3] = bfhi(u0.y); u[4] = bflo(u0.z); u[5] = bfhi(u0.z); u[6] = bflo(u0.w); u[7] = bfhi(u0.w);
                    u[8] = bflo(u1.x); u[9] = bfhi(u1.x); u[10] = bflo(u1.y); u[11] = bfhi(u1.y); u[12] = bflo(u1.z); u[13] = bfhi(u1.z); u[14] = bflo(u1.w); u[15] = bfhi(u1.w);
                    float br = 0.f, bi = 0.f;
#pragma unroll
                    for (int c = 0; c < 16; ++c) { br += bre[c] * u[c]; bi += bim[c] * u[c]; }
                    st = (f32x2){lam.x * st.x - lam.y * st.y + br, lam.x * st.y + lam.y * st.x + bi};
                    *(LAS unsigned*)(sl + (tok & 31) * 272 + lane * 4) = cvt_pk_bf16(st.x, st.y); }
                const int t0q = (d == 0) ? 2 * h : 2 * (1 - h);
                bf16x8 bsv[2][4];
#pragma unroll
                for (int tt = 0; tt < 2; ++tt)
#pragma unroll
                    for (int ks = 0; ks < 4; ++ks) bsv[tt][ks] = *(const LAS bf16x8*)(sl + (16 * tt + fr) * 272 + (32 * ks + 8 * fq) * 2);
#pragma unroll
                for (int tt = 0; tt < 2; ++tt)
#pragma unroll
                    for (int ks = 0; ks < 4; ++ks) yacc[t0q + tt] = __builtin_amdgcn_mfma_f32_16x16x32_bf16(ct[ks], bsv[tt][ks], yacc[t0q + tt], 0, 0, 0);
                asm volatile("s_nop 7\n\ts_nop 7" : "+v"(yacc[0]), "+v"(yacc[1]), "+v"(yacc[2]), "+v"(yacc[3]) : "v"(bsv[0][0]), "v"(bsv[0][1]), "v"(bsv[0][2]), "v"(bsv[0][3]), "v"(bsv[1][0]), "v"(bsv[1][1]), "v"(bsv[1][2]), "v"(bsv[1][3]), "v"(ct[0]), "v"(ct[1]), "v"(ct[2]), "v"(ct[3]));
                asm volatile("s_waitcnt lgkmcnt(0)" ::: "memory");
            }
        }
        const f32x4 dsk = *(const f32x4*)(F.in[IN_S5D] + 16 * g + 4 * fq);
#pragma unroll
        for (int tq = 0; tq < 4; ++tq) { const int tok = 16 * tq + fr;
            const u32x2 uu = *(const u32x2*)(urow + (size_t)tok * S5W + 4 * fq);
            f32x4 v; v[0] = yacc[tq][0] + bflo(uu.x) * dsk[0]; v[1] = yacc[tq][1] + bfhi(uu.x) * dsk[1]; v[2] = yacc[tq][2] + bflo(uu.y) * dsk[2]; v[3] = yacc[tq][3] + bfhi(uu.y) * dsk[3];
#pragma unroll
            for (int j = 0; j < 4; ++j) { const float x = v[j]; v[j] = x * sigmoidf_(1.5957691216f * (x + 0.044715f * x * x * x)); }
            *(u32x2*)(Y + (size_t)(b * SEQ + (kc - 4) * 64 + tok) * S5W + 16 * g + 4 * fq) = (u32x2){cvt_pk_bf16(v[0], v[1]), cvt_pk_bf16(v[2], v[3])}; }
    }
}
template <bool PASSB>
__device__ __forceinline__ void s5_pass3(Frame& F) {
    constexpr int nk = PASSB ? 256 : NCH; constexpr int nitems = 2 * nk * 8;
    LAS unsigned char* sl = F.lds + F.wave * 8704;
    const int lane = F.lane, fr = lane & 15, fq = lane >> 4;
    const bf16* UA = (const bf16*)(F.ws + WS_UA); const bf16* UCA = (const bf16*)(F.ws + WS_UCA); const bf16* BB2 = (const bf16*)(F.ws + WS_BB2); const bf16* CTT = (const bf16*)(F.ws + WS_CTT);
    const f32x2* LAM = (const f32x2*)(F.ws + WS_LAM); const f32x2* SINB = (const f32x2*)(F.ws + WS_SIN); f32x2* EB = (f32x2*)(F.ws + WS_E); bf16* Y = (bf16*)(F.ws + WS_Y);
    const bf16x8 zf = (bf16x8){0, 0, 0, 0, 0, 0, 0, 0};
    int curg = -1; bf16x8 af[2][8], ct[2][4]; f32x2 lamv[2]; f32x4 dsk = (f32x4){0.f, 0.f, 0.f, 0.f};
    for (int it = F.bx; it < nitems; it += F.G) {
        const int gq = it & 7, rest = it >> 3; const int b = rest / nk, kk = rest % nk; const int kc = PASSB ? kk + 4 : kk; const int g = gq * 8 + F.wave;
        if (g != curg) { curg = g;
#pragma unroll
            for (int d = 0; d < 2; ++d) { const int dg = d * 64 + g; lamv[d] = LAM[dg * 64 + lane];
#pragma unroll
                for (int nt = 0; nt < 8; ++nt) af[d][nt] = (fq < 2) ? *(const bf16x8*)(BB2 + (size_t)(dg * 128 + 16 * nt + fr) * 16 + 8 * fq) : zf;
                if (PASSB) {
#pragma unroll
                    for (int ks = 0; ks < 4; ++ks) ct[d][ks] = *(const bf16x8*)(CTT + (size_t)(dg * 16 + fr) * 128 + 32 * ks + 8 * fq); } }
            if (PASSB) dsk = *(const f32x4*)(F.in[IN_S5D] + 16 * g + 4 * fq); }
        const bf16* urow = (kc < 4) ? (UCA + (size_t)(b * CTX + kc * 64) * S5W + 16 * g) : (UA + (size_t)(b * SEQ + (kc - 4) * 64) * S5W + 16 * g);
        bf16x8 uf[4];
#pragma unroll
        for (int q = 0; q < 4; ++q) uf[q] = (fq < 2) ? *(const bf16x8*)(urow + (size_t)(16 * q + fr) * S5W + 8 * fq) : zf;
        u32x2 uu[4];
        if (PASSB) {
#pragma unroll
            for (int tq = 0; tq < 4; ++tq) uu[tq] = *(const u32x2*)(urow + (size_t)(16 * tq + fr) * S5W + 4 * fq); }
        f32x2 st0[2];
#pragma unroll
        for (int d = 0; d < 2; ++d) st0[d] = PASSB ? SINB[((size_t)((d * 2 + b) * NCH + kc)) * 4096 + g * 64 + lane] : (f32x2){0.f, 0.f};
        f32x4 yacc[4];
#pragma unroll
        for (int q = 0; q < 4; ++q) yacc[q] = (f32x4){0.f, 0.f, 0.f, 0.f};
#pragma unroll
        for (int d = 0; d < 2; ++d) {
            const f32x2 lam = lamv[d]; f32x2 st = st0[d];
#pragma unroll
            for (int h = 0; h < 2; ++h) {
                const int T0 = (d == 0) ? 32 * h : 32 * (1 - h);
#pragma unroll
                for (int tt = 0; tt < 2; ++tt)
#pragma unroll
                    for (int nt = 0; nt < 8; ++nt) { const f32x4 dd = __builtin_amdgcn_mfma_f32_16x16x32_bf16(af[d][nt], uf[(T0 >> 4) + tt], (f32x4){0.f, 0.f, 0.f, 0.f}, 0, 0, 0);
                        *(LAS u32x2*)(sl + (16 * tt + fr) * 272 + (16 * nt + 4 * fq) * 2) = (u32x2){cvt_pk_bf16(dd[0], dd[1]), cvt_pk_bf16(dd[2], dd[3])}; }
                asm volatile("s_waitcnt lgkmcnt(0)" ::: "memory");
#pragma unroll 8
                for (int i = 0; i < 32; ++i) { const int r = (d == 0) ? i : 31 - i; LAS unsigned* cell = (LAS unsigned*)(sl + r * 272 + lane * 4);
                    const unsigned w = *cell; const float br = bflo(w), bi = bfhi(w);
                    st = (f32x2){lam.x * st.x - lam.y * st.y + br, lam.x * st.y + lam.y * st.x + bi};
                    if (PASSB) *cell = cvt_pk_bf16(st.x, st.y); }
                if (PASSB) {
                    const int t0q = T0 >> 4;
                    bf16x8 bsv[2][4];
#pragma unroll
                    for (int tt = 0; tt < 2; ++tt)
#pragma unroll
                        for (int ks = 0; ks < 4; ++ks) bsv[tt][ks] = *(const LAS bf16x8*)(sl + (16 * tt + fr) * 272 + (32 * ks + 8 * fq) * 2);
#pragma unroll
                    for (int tt = 0; tt < 2; ++tt)
#pragma unroll
                        for (int ks = 0; ks < 4; ++ks) yacc[t0q + tt] = __builtin_amdgcn_mfma_f32_16x16x32_bf16(ct[d][ks], bsv[tt][ks], yacc[t0q + tt], 0, 0, 0);
                    asm volatile("s_nop 7\n\ts_nop 7" : "+v"(yacc[0]), "+v"(yacc[1]), "+v"(yacc[2]), "+v"(yacc[3]) : "v"(bsv[0][0]), "v"(bsv[0][1]), "v"(bsv[0][2]), "v"(bsv[0][3]), "v"(bsv[1][0]), "v"(bsv[1][1]), "v"(bsv[1][2]), "v"(bsv[1][3]));
                }
                asm volatile("s_waitcnt lgkmcnt(0)" ::: "memory");
            }
            if (!PASSB) EB[((size_t)((d * 2 + b) * NCH + kc)) * 4096 + g * 64 + lane] = st;
        }
        if (PASSB) {
#pragma unroll
            for (int tq = 0; tq < 4; ++tq) { const int tok = 16 * tq + fr;
                f32x4 v; v[0] = yacc[tq][0] + bflo(uu[tq].x) * dsk[0]; v[1] = yacc[tq][1] + bfhi(uu[tq].x) * dsk[1]; v[2] = yacc[tq][2] + bflo(uu[tq].y) * dsk[2]; v[3] = yacc[tq][3] + bfhi(uu[tq].y) * dsk[3];
#pragma unroll
                for (int j = 0; j < 4; ++j) { const float x = v[j]; v[j] = x * sigmoidf_(1.5957691216f * (x + 0.044715f * x * x * x)); }
                *(u32x2*)(Y + (size_t)(b * SEQ + (kc - 4) * 64 + tok) * S5W + 16 * g + 4 * fq) = (u32x2){cvt_pk_bf16(v[0], v[1]), cvt_pk_bf16(v[2], v[3])}; }
        }
    }
}
__device__ __forceinline__ void s5_carry_item(Frame& F, int item) {
    const int idx = item * NTHR + F.tid; const int d = idx >> 13, b = (idx >> 12) & 1, gp = idx & 4095;
    const f32x2 lam = ((const f32x2*)(F.ws + WS_LAM))[d * 4096 + gp];
    f32x2 l = cmul(lam, lam); l = cmul(l, l); l = cmul(l, l); l = cmul(l, l); l = cmul(l, l); l = cmul(l, l);
    const f32x2* EB = (const f32x2*)(F.ws + WS_E) + (size_t)((d * 2 + b) * NCH) * 4096 + gp; f32x2* SB = (f32x2*)(F.ws + WS_SIN) + (size_t)((d * 2 + b) * NCH) * 4096 + gp;
    f32x2 s = (f32x2){0.f, 0.f};
#pragma unroll 1
    for (int st0 = 0; st0 < NCH; st0 += 20) { f32x2 e[20];
#pragma unroll
        for (int j = 0; j < 20; ++j) { const int st = st0 + j; const int kc = (d == 0) ? st : (st < 4 ? 3 - st : NCH + 3 - st); e[j] = EB[(size_t)kc * 4096]; }
#pragma unroll
        for (int j = 0; j < 20; ++j) { const int st = st0 + j; const int kc = (d == 0) ? st : (st < 4 ? 3 - st : NCH + 3 - st); SB[(size_t)kc * 4096] = s; s = cmul(l, s) + e[j]; } }
}

__device__ __forceinline__ int fsw(int i) { return i ^ ((i >> 5) & 7) ^ (((i >> 6) & 3) << 3); }
__host__ __device__ constexpr float w16c(int j) { return j == 0 ? 1.f : j == 1 ? 0.9238795325f : j == 2 ? 0.7071067812f : j == 3 ? 0.3826834324f : j == 4 ? 0.f : j == 5 ? -0.3826834324f : j == 6 ? -0.7071067812f : -0.9238795325f; }
__host__ __device__ constexpr float w16s(int j) { return j == 0 ? 0.f : j == 1 ? 0.3826834324f : j == 2 ? 0.7071067812f : j == 3 ? 0.9238795325f : j == 4 ? 1.f : j == 5 ? 0.9238795325f : j == 6 ? 0.7071067812f : 0.3826834324f; }
__host__ __device__ constexpr int bitrev(int q, int bits) { int r = 0; for (int i = 0; i < bits; ++i) r |= ((q >> i) & 1) << (bits - 1 - i); return r; }
template <int R, bool INV> __device__ __forceinline__ void dft_reg(f32x2 (&x)[R]) {
#pragma unroll
    for (int len = R; len >= 2; len >>= 1) { const int half = len >> 1, step = 16 / len;
#pragma unroll
        for (int b0 = 0; b0 < R; b0 += len)
#pragma unroll
            for (int k = 0; k < half; ++k) { const f32x2 a = x[b0 + k], b = x[b0 + k + half]; x[b0 + k] = a + b; const f32x2 dd = a - b; const int j = k * step;
                if (j == 0) x[b0 + k + half] = dd;
                else if (j == 4) x[b0 + k + half] = INV ? (f32x2){-dd.y, dd.x} : (f32x2){dd.y, -dd.x};
                else { const float c = w16c(j), s = w16s(j); x[b0 + k + half] = INV ? (f32x2){dd.x * c - dd.y * s, dd.x * s + dd.y * c} : (f32x2){dd.x * c + dd.y * s, dd.y * c - dd.x * s}; } } }
}
template <int R, int LOGN, bool INV> __device__ __forceinline__ void fft_pass(LAS f32x2* buf, int tid) {
    constexpr int LOGR = (R == 16) ? 4 : 3, LOGM = LOGN - LOGR, M = 1 << LOGM, NBF = 16384 / R / NTHR;
#pragma unroll 1
    for (int it = 0; it < NBF; ++it) {
        int tl = tid; asm volatile("" : "+v"(tl));
        const int bq = tl + NTHR * it, blk = bq >> LOGM, j = bq & (M - 1), base = (blk << LOGN) + j; const int fb = fsw(base);
#define FADDR(q) (fb ^ (((q) << LOGM) ^ ((((q) << LOGM) >> 5) & 7) ^ (((((q) << LOGM) >> 6) & 3) << 3)))
        f32x2 x[R];
#pragma unroll
        for (int q = 0; q < R; ++q) x[q] = buf[FADDR(q)];
        f32x2 w1 = (f32x2){1.f, 0.f};
        if (LOGM > 0) { const float rev = (float)j * (1.0f / (float)(1 << LOGN)); const float sn = sin_rev(rev); w1 = (f32x2){cos_rev(rev), INV ? sn : -sn}; }
        if (!INV) {
            dft_reg<R, false>(x);
            buf[fb] = x[0]; f32x2 w = w1;
#pragma unroll
            for (int q = 1; q < R; ++q) { buf[FADDR(q)] = (LOGM > 0) ? cmul(x[bitrev(q, LOGR)], w) : x[bitrev(q, LOGR)]; if (LOGM > 0) w = cmul(w, w1); }
        } else {
            if (LOGM > 0) { f32x2 w = w1;
#pragma unroll
                for (int q = 1; q < R; ++q) { x[q] = cmul(x[q], w); w = cmul(w, w1); } }
            dft_reg<R, true>(x);
#pragma unroll
            for (int q = 0; q < R; ++q) buf[FADDR(q)] = x[bitrev(q, LOGR)];
        }
#undef FADDR
    }
    __syncthreads();
}
#ifndef FFT_TEST
#define FFT_TEST 0
#endif
__device__ __forceinline__ void fft_fwd(LAS f32x2* buf, int tid) { if (FFT_TEST & 1) return; fft_pass<16, 14, false>(buf, tid); fft_pass<16, 10, false>(buf, tid); fft_pass<8, 6, false>(buf, tid); fft_pass<8, 3, false>(buf, tid); }
__device__ __forceinline__ void fft_inv(LAS f32x2* buf, int tid) { if (FFT_TEST & 2) return; fft_pass<8, 3, true>(buf, tid); fft_pass<8, 6, true>(buf, tid); fft_pass<16, 10, true>(buf, tid); fft_pass<16, 14, true>(buf, tid); }
__device__ __forceinline__ float block_sum(Frame& F, float v) {
    LAS float* red = (LAS float*)(F.lds + LDS_X);
    v = wave_sum(v); __syncthreads(); if (F.lane == 0) red[F.wave] = v; __syncthreads();
    float s = 0.f;
#pragma unroll
    for (int w = 0; w < NWAVES; ++w) s += red[w];
    return s;
}
__device__ __forceinline__ float sconv(const bf16* UH, int b, int ch, int t, float w0, float w1, float w2) {
    const bf16* p = UH + (size_t)(b * 3072 + ch) * SEQ;
    const int tm = t > 0 ? t - 1 : 0, tp = t < SEQ - 1 ? t + 1 : SEQ - 1;
    const float xm = bf2f(p[tm]), x0 = bf2f(p[t]), xp = bf2f(p[tp]);
    return w0 * (t > 0 ? xm : 0.f) + w1 * x0 + w2 * (t < SEQ - 1 ? xp : 0.f);
}
#define HY_UNPK(w) ((f32x2){bflo(w), bfhi(w)})
template <bool INV, class LD, class ST>
__device__ __forceinline__ void fft_edge_pass(LAS f32x2* buf, int tid, LD& ld, ST& st) {
    constexpr int R = 16, LOGN = 14, LOGM = 10;
#pragma unroll
    for (int it = 0; it < 2; ++it) {
        int tl = tid; asm volatile("" : "+v"(tl));
        const int j = tl + NTHR * it; const int fb = fsw(j);
        f32x2 x[R];
#pragma unroll
        for (int q = 0; q < R; ++q) x[q] = ld(2 * q + it, j + (q << LOGM), fb + (q << LOGM));
        const float rev = (float)j * (1.0f / 16384.0f); const float sn = sin_rev(rev); const f32x2 w1 = (f32x2){cos_rev(rev), INV ? sn : -sn};
        if (!INV) {
            dft_reg<R, false>(x);
            st(it, j, fb, x[0]); f32x2 w = w1;
#pragma unroll
            for (int q = 1; q < R; ++q) { st(2 * q + it, j + (q << LOGM), fb + (q << LOGM), cmul(x[bitrev(q, 4)], w)); w = cmul(w, w1); }
        } else {
            f32x2 w = w1;
#pragma unroll
            for (int q = 1; q < R; ++q) { x[q] = cmul(x[q], w); w = cmul(w, w1); }
            dft_reg<R, true>(x);
#pragma unroll
            for (int q = 0; q < R; ++q) st(2 * q + it, j + (q << LOGM), fb + (q << LOGM), x[bitrev(q, 4)]);
        }
        __builtin_amdgcn_sched_barrier(0);
    }
}
__device__ __forceinline__ void fft_last_to_ks(LAS f32x2* buf, int tid, unsigned* KS, float scale) {
#pragma unroll 1
    for (int it = 0; it < 4; ++it) { int tl = tid; asm volatile("" : "+v"(tl)); const int b = tl + NTHR * it; const int fb = fsw(8 * b);
        f32x2 x[8];
#pragma unroll
        for (int q = 0; q < 8; ++q) x[q] = buf[fb ^ q];
        dft_reg<8, false>(x);
        u32x4 o0, o1; f32x2 v;
        v = x[bitrev(0, 3)] * scale; o0.x = cvt_pk_bf16(v.x, v.y); v = x[bitrev(1, 3)] * scale; o0.y = cvt_pk_bf16(v.x, v.y); v = x[bitrev(2, 3)] * scale; o0.z = cvt_pk_bf16(v.x, v.y); v = x[bitrev(3, 3)] * scale; o0.w = cvt_pk_bf16(v.x, v.y);
        v = x[bitrev(4, 3)] * scale; o1.x = cvt_pk_bf16(v.x, v.y); v = x[bitrev(5, 3)] * scale; o1.y = cvt_pk_bf16(v.x, v.y); v = x[bitrev(6, 3)] * scale; o1.z = cvt_pk_bf16(v.x, v.y); v = x[bitrev(7, 3)] * scale; o1.w = cvt_pk_bf16(v.x, v.y);
        *(GAS u32x4*)(KS + 8 * b) = o0; *(GAS u32x4*)(KS + 8 * b + 4) = o1; }
}
__device__ __forceinline__ void fft_mid_mul(LAS f32x2* buf, int tid, const unsigned* KS) {
#pragma unroll 2
    for (int it = 0; it < 4; ++it) { int tl = tid; asm volatile("" : "+v"(tl)); const int b = tl + NTHR * it; const int fb = fsw(8 * b);
        const u32x4 k0 = *(const GAS u32x4*)(KS + 8 * b), k1 = *(const GAS u32x4*)(KS + 8 * b + 4);
        f32x2 x[8], y[8];
#pragma unroll
        for (int q = 0; q < 8; ++q) x[q] = buf[fb ^ q];
        dft_reg<8, false>(x);
        y[0] = cmul(x[bitrev(0, 3)], HY_UNPK(k0.x)); y[1] = cmul(x[bitrev(1, 3)], HY_UNPK(k0.y)); y[2] = cmul(x[bitrev(2, 3)], HY_UNPK(k0.z)); y[3] = cmul(x[bitrev(3, 3)], HY_UNPK(k0.w));
        y[4] = cmul(x[bitrev(4, 3)], HY_UNPK(k1.x)); y[5] = cmul(x[bitrev(5, 3)], HY_UNPK(k1.y)); y[6] = cmul(x[bitrev(6, 3)], HY_UNPK(k1.z)); y[7] = cmul(x[bitrev(7, 3)], HY_UNPK(k1.w));
        dft_reg<8, true>(y);
#pragma unroll
        for (int q = 0; q < 8; ++q) buf[fb ^ q] = y[bitrev(q, 3)]; }
    __syncthreads();
}
struct HyStLds { LAS f32x2* buf; __device__ __forceinline__ void operator()(int, int, int addr, f32x2 v) { buf[addr] = v; } };
struct HyLdLds { LAS f32x2* buf; __device__ __forceinline__ f32x2 operator()(int, int, int addr) { return buf[addr]; } };
struct HyLdKc { const bf16* f0; const bf16* f1; float part; __device__ __forceinline__ f32x2 operator()(int, int t, int) { const float a0 = bf2f(f0[t]), r1 = (t == 0) ? 0.f : bf2f(f1[SEQ - t]); part += fabsf(a0) + fabsf(r1); return (f32x2){a0 + r1, 0.f}; } };
struct HyLdKn { const bf16* f0; const bf16* f1; __device__ __forceinline__ f32x2 operator()(int, int t, int) { const float a0 = bf2f(f0[t]), r1 = (t == 0) ? 0.f : bf2f(f1[SEQ - t]); const float rev = (float)t * (1.0f / 32768.0f), v = a0 - r1; return (f32x2){v * cos_rev(rev), v * sin_rev(rev)}; } };
struct HyLdZ { const unsigned* z; __device__ __forceinline__ f32x2 operator()(int k, int, int) { return HY_UNPK(z[k]); } };
struct HyLdZpsi { const unsigned* z; __device__ __forceinline__ f32x2 operator()(int k, int t, int) { const float rev = (float)t * (1.0f / 32768.0f); return cmul(HY_UNPK(z[k]), (f32x2){cos_rev(rev), sin_rev(rev)}); } };
struct HyStYc { unsigned* yc; __device__ __forceinline__ void operator()(int k, int, int, f32x2 v) { const f32x2 w = v * (0.5f / 16384.0f); yc[k] = cvt_pk_bf16(w.x, w.y); } };
struct HyStComb { unsigned* z; const unsigned* yc; float bias;
    __device__ __forceinline__ void operator()(int k, int t, int, f32x2 v) { const float rev = (float)t * (1.0f / 32768.0f);
        const f32x2 yn = cmul(v, (f32x2){cos_rev(rev), -sin_rev(rev)}) * (0.5f / 16384.0f); const f32x2 y = yn + HY_UNPK(yc[k]) + HY_UNPK(z[k]) * bias; z[k] = cvt_pk_bf16(y.x, y.y); } };
template <bool NEG> __device__ __forceinline__ float hy_load_kernel(LAS f32x2* buf, int tid, const bf16* f0, const bf16* f1) {
    float part = 0.f;
#pragma unroll 2
    for (int r = 0; r < 4; ++r) { int tl = tid; asm volatile("" : "+v"(tl)); const int t0 = 8 * (tl + NTHR * r); const int fb = fsw(t0); float a[8], q[8];
        const u32x4 va = *(const GAS u32x4*)(f0 + t0), vr = *(const GAS u32x4*)(f1 + SEQ - t0 - 8); const float r0 = bf2f(f1[t0 > 0 ? SEQ - t0 : 0]);
        a[0] = bflo(va.x); a[1] = bfhi(va.x); a[2] = bflo(va.y); a[3] = bfhi(va.y); a[4] = bflo(va.z); a[5] = bfhi(va.z); a[6] = bflo(va.w); a[7] = bfhi(va.w);
        q[0] = t0 > 0 ? r0 : 0.f; q[1] = bfhi(vr.w); q[2] = bflo(vr.w); q[3] = bfhi(vr.z); q[4] = bflo(vr.z); q[5] = bfhi(vr.y); q[6] = bflo(vr.y); q[7] = bfhi(vr.x);
#pragma unroll
        for (int e = 0; e < 8; ++e) {
            if (!NEG) { part += fabsf(a[e]) + fabsf(q[e]); buf[fb ^ e] = (f32x2){a[e] + q[e], 0.f}; }
            else { const float rev = (float)(t0 + e) * (1.0f / 32768.0f), v = a[e] - q[e]; buf[fb ^ e] = (f32x2){v * cos_rev(rev), v * sin_rev(rev)}; } } }
    return part;
}
template <bool NEG> __device__ __forceinline__ void hy_load_kernel2(LAS f32x2* buf, int tid, const bf16* f0a, const bf16* f1a, const bf16* f0b, const bf16* f1b, float& part0, float& part1) {
#pragma unroll 2
    for (int r = 0; r < 4; ++r) { int tl = tid; asm volatile("" : "+v"(tl)); const int t0 = 8 * (tl + NTHR * r); const int fb = fsw(t0); float a[8], q[8], b[8], p[8];
        const u32x4 va = *(const GAS u32x4*)(f0a + t0), vr = *(const GAS u32x4*)(f1a + SEQ - t0 - 8); const float r0 = bf2f(f1a[t0 > 0 ? SEQ - t0 : 0]);
        const u32x4 vb = *(const GAS u32x4*)(f0b + t0), vs = *(const GAS u32x4*)(f1b + SEQ - t0 - 8); const float s0 = bf2f(f1b[t0 > 0 ? SEQ - t0 : 0]);
        a[0] = bflo(va.x); a[1] = bfhi(va.x); a[2] = bflo(va.y); a[3] = bfhi(va.y); a[4] = bflo(va.z); a[5] = bfhi(va.z); a[6] = bflo(va.w); a[7] = bfhi(va.w);
        q[0] = t0 > 0 ? r0 : 0.f; q[1] = bfhi(vr.w); q[2] = bflo(vr.w); q[3] = bfhi(vr.z); q[4] = bflo(vr.z); q[5] = bfhi(vr.y); q[6] = bflo(vr.y); q[7] = bfhi(vr.x);
        b[0] = bflo(vb.x); b[1] = bfhi(vb.x); b[2] = bflo(vb.y); b[3] = bfhi(vb.y); b[4] = bflo(vb.z); b[5] = bfhi(vb.z); b[6] = bflo(vb.w); b[7] = bfhi(vb.w);
        p[0] = t0 > 0 ? s0 : 0.f; p[1] = bfhi(vs.w); p[2] = bflo(vs.w); p[3] = bfhi(vs.z); p[4] = bflo(vs.z); p[5] = bfhi(vs.y); p[6] = bflo(vs.y); p[7] = bfhi(vs.x);
#pragma unroll
        for (int e = 0; e < 8; ++e) {
            if (!NEG) { part0 += fabsf(a[e]) + fabsf(q[e]); part1 += fabsf(b[e]) + fabsf(p[e]); buf[fb ^ e] = (f32x2){a[e] + q[e], b[e] + p[e]}; }
            else { const float rev = (float)(t0 + e) * (1.0f / 32768.0f), v0 = a[e] - q[e], v1 = b[e] - p[e]; buf[fb ^ e] = cmul((f32x2){v0, v1}, (f32x2){cos_rev(rev), sin_rev(rev)}); } } }
}
template <bool NEG> __device__ __forceinline__ void hy_split_to_ks(LAS f32x2* buf, int tid, unsigned* KS0, unsigned* KS1, float inv0, float inv1) {
    constexpr int S = NEG ? 1 : 0;
#pragma unroll 1
    for (int it = 0; it < 4; ++it) { int tl = tid; asm volatile("" : "+v"(tl)); const int b = tl + NTHR * it;
        const int l = (b >> 7) + 16 * ((b >> 3) & 15) + 256 * (b & 7); const int nl = (S - l) & 2047; const int br = (l > S) ? 1 : 0;
        const int bp = (nl & 15) * 128 + ((nl >> 4) & 15) * 8 + ((nl >> 8) & 7);
        const int fb = fsw(8 * b), fp = fsw(8 * bp);
        unsigned o0[8], o1[8]; const float h0 = 0.5f * inv0, h1 = 0.5f * inv1;
#pragma unroll
        for (int q = 0; q < 8; ++q) { const f32x2 zz = buf[fb ^ q], zp = buf[fp ^ ((-q - br) & 7)];
            o0[q] = cvt_pk_bf16((zz.x + zp.x) * h0, (zz.y - zp.y) * h0); o1[q] = cvt_pk_bf16((zz.y + zp.y) * h1, (zp.x - zz.x) * h1); }
        *(GAS u32x4*)(KS0 + 8 * b) = (u32x4){o0[0], o0[1], o0[2], o0[3]}; *(GAS u32x4*)(KS0 + 8 * b + 4) = (u32x4){o0[4], o0[5], o0[6], o0[7]};
        *(GAS u32x4*)(KS1 + 8 * b) = (u32x4){o1[0], o1[1], o1[2], o1[3]}; *(GAS u32x4*)(KS1 + 8 * b + 4) = (u32x4){o1[4], o1[5], o1[6], o1[7]}; }
}
__device__ __forceinline__ void hy_conv8(const u32x4 v, float hm, float hp, float w0, float w1, float w2, float (&o)[8]) {
    const float x1 = bflo(v.x), x2 = bfhi(v.x), x3 = bflo(v.y), x4 = bfhi(v.y), x5 = bflo(v.z), x6 = bfhi(v.z), x7 = bflo(v.w), x8 = bfhi(v.w);
    o[0] = w0 * hm + w1 * x1 + w2 * x2; o[1] = w0 * x1 + w1 * x2 + w2 * x3; o[2] = w0 * x2 + w1 * x3 + w2 * x4; o[3] = w0 * x3 + w1 * x4 + w2 * x5;
    o[4] = w0 * x4 + w1 * x5 + w2 * x6; o[5] = w0 * x5 + w1 * x6 + w2 * x7; o[6] = w0 * x6 + w1 * x7 + w2 * x8; o[7] = w0 * x7 + w1 * x8 + w2 * hp;
}
__device__ __forceinline__ void hy_load_conv(LAS f32x2* buf, int tid, const bf16* UH, int ch, float w0, float w1, float w2) {
    const bf16* p0 = UH + (size_t)ch * SEQ; const bf16* p1 = UH + (size_t)(3072 + ch) * SEQ;
#pragma unroll 2
    for (int r = 0; r < 4; ++r) { int tl = tid; asm volatile("" : "+v"(tl)); const int t0 = 8 * (tl + NTHR * r); const int fb = fsw(t0);
        const int tm = t0 > 0 ? t0 - 1 : 0, tp = t0 + 8 < SEQ ? t0 + 8 : SEQ - 1;
        const u32x4 va = *(const GAS u32x4*)(p0 + t0), vb = *(const GAS u32x4*)(p1 + t0);
        float am = bf2f(p0[tm]), ap = bf2f(p0[tp]), bm = bf2f(p1[tm]), bp = bf2f(p1[tp]);
        if (t0 == 0) { am = 0.f; bm = 0.f; } if (t0 + 8 >= SEQ) { ap = 0.f; bp = 0.f; }
        float oa[8], ob[8]; hy_conv8(va, am, ap, w0, w1, w2, oa); hy_conv8(vb, bm, bp, w0, w1, w2, ob);
        buf[fb ^ 0] = (f32x2){oa[0], ob[0]}; buf[fb ^ 1] = (f32x2){oa[1], ob[1]}; buf[fb ^ 2] = (f32x2){oa[2], ob[2]}; buf[fb ^ 3] = (f32x2){oa[3], ob[3]};
        buf[fb ^ 4] = (f32x2){oa[4], ob[4]}; buf[fb ^ 5] = (f32x2){oa[5], ob[5]}; buf[fb ^ 6] = (f32x2){oa[6], ob[6]}; buf[fb ^ 7] = (f32x2){oa[7], ob[7]}; }
}
__device__ __forceinline__ void hyena_item(Frame& F, int c) {
    LAS f32x2* buf = (LAS f32x2*)F.lds;
    unsigned* KS = (unsigned*)(F.ws + WS_HYS + (size_t)F.bx * HYS_STRIDE);
    const bf16* FILT = (const bf16*)(F.ws + WS_FILT); const bf16* UH = (const bf16*)(F.ws + WS_UH);
    const int tid = F.tid; const int ft = fsw(tid);
#define FB(k) buf[ft + NTHR * (k)]
    const float* sw = F.in[IN_HSW];
    unsigned z[32], yc[32];
    HyStLds stl{buf}; HyLdLds ldl{buf};
    hy_load_conv(buf, tid, UH, c, sw[c], sw[3072 + c], sw[6144 + c]);
    __syncthreads();
#pragma unroll
    for (int k = 0; k < 32; ++k) { const f32x2 v_ = FB(k); z[k] = cvt_pk_bf16(v_.x, v_.y); }
    { const bf16* f0a = FILT + (size_t)c * SEQ; const bf16* f1a = FILT + (size_t)(2048 + c) * SEQ; const bf16* f0b = FILT + (size_t)(1024 + c) * SEQ; const bf16* f1b = FILT + (size_t)(3072 + c) * SEQ;
      float part0 = 0.f, part1 = 0.f;
      __syncthreads();
      hy_load_kernel2<false>(buf, tid, f0a, f1a, f0b, f1b, part0, part1);
      const float inv0 = 1.0f / (block_sum(F, part0) + 1e-6f); const float inv1 = 1.0f / (block_sum(F, part1) + 1e-6f);
      fft_edge_pass<false>(buf, tid, ldl, stl); __syncthreads();
      fft_pass<16, 10, false>(buf, tid); fft_pass<8, 6, false>(buf, tid); fft_pass<8, 3, false>(buf, tid);
      hy_split_to_ks<false>(buf, tid, KS, KS + 16384, inv0, inv1); __syncthreads();
      { float d0 = 0.f, d1 = 0.f; hy_load_kernel2<true>(buf, tid, f0a, f1a, f0b, f1b, d0, d1); } __syncthreads();
      fft_edge_pass<false>(buf, tid, ldl, stl); __syncthreads();
      fft_pass<16, 10, false>(buf, tid); fft_pass<8, 6, false>(buf, tid); fft_pass<8, 3, false>(buf, tid);
      hy_split_to_ks<true>(buf, tid, KS + 2 * 16384, KS + 3 * 16384, inv0, inv1); __syncthreads(); }
#pragma unroll 1
    for (int o = 0; o < 2; ++o) {
        { HyLdZ ldz{z}; fft_edge_pass<false>(buf, tid, ldz, stl); __syncthreads(); }
        fft_pass<16, 10, false>(buf, tid); fft_pass<8, 6, false>(buf, tid);
        fft_mid_mul(buf, tid, KS + o * 16384);
        fft_pass<8, 6, true>(buf, tid); fft_pass<16, 10, true>(buf, tid);
        { HyStYc styc{yc}; fft_edge_pass<true>(buf, tid, ldl, styc); }
        __syncthreads();
        { HyLdZpsi ldzp{z}; fft_edge_pass<false>(buf, tid, ldzp, stl); __syncthreads(); }
        fft_pass<16, 10, false>(buf, tid); fft_pass<8, 6, false>(buf, tid);
        fft_mid_mul(buf, tid, KS + (2 + o) * 16384);
        fft_pass<8, 6, true>(buf, tid); fft_pass<16, 10, true>(buf, tid);
        { HyStComb stc{z, yc, F.in[IN_HBIAS][o * 1024 + c]}; fft_edge_pass<true>(buf, tid, ldl, stc); }
#pragma unroll
        for (int k = 0; k < 32; ++k) FB(k) = HY_UNPK(z[k]);
        { const int xch = (o + 1) * 1024 + c; const float w0 = sw[xch], w1 = sw[3072 + xch], w2 = sw[6144 + xch];
#pragma unroll 8
          for (int k = 0; k < 32; ++k) { const int t = tid + NTHR * k; f32x2 v_ = FB(k); v_.x *= sconv(UH, 0, xch, t, w0, w1, w2); v_.y *= sconv(UH, 1, xch, t, w0, w1, w2); FB(k) = v_; } }
#pragma unroll
        for (int k = 0; k < 32; ++k) { const f32x2 v_ = FB(k); z[k] = cvt_pk_bf16(v_.x, v_.y); }
        __syncthreads();
    }
    bf16* YHCM = (bf16*)(F.ws + WS_YHCM);
#pragma unroll
    for (int k = 0; k < 32; ++k) FB(k) = HY_UNPK(z[k]);
#pragma unroll 8
    for (int k = 0; k < 32; ++k) { const int t = tid + NTHR * k; const f32x2 v_ = FB(k); YHCM[(size_t)c * SEQ + t] = (bf16)f2bf(v_.x); YHCM[(size_t)(1024 + c) * SEQ + t] = (bf16)f2bf(v_.y); }
    __syncthreads();
#undef FB
}
__device__ __forceinline__ void p3_publish(Frame& F) {
    asm volatile("s_waitcnt vmcnt(0)" ::: "memory");
    __syncthreads();
    if (F.tid == 0) { __builtin_amdgcn_fence(__ATOMIC_RELEASE, "agent"); asm volatile("s_waitcnt vmcnt(0)" ::: "memory"); (void)xb_add((unsigned*)(F.ctl + CW_P3), 1u); }
}
__device__ __forceinline__ void p3_wait(Frame& F) {
    if (F.tid == 0) { unsigned* bar = (unsigned*)(F.ctl + CW_BAR);
        XB_SPIN(xb_ld((unsigned*)(F.ctl + CW_P3)) < (unsigned)F.G, bar);
        __builtin_amdgcn_fence(__ATOMIC_ACQUIRE, "agent"); asm volatile("s_waitcnt vmcnt(0)" ::: "memory"); }
    __syncthreads();
}
__device__ __forceinline__ void p4_hyena_carry(Frame& F, int qw) {
    volatile LAS int* qs = (volatile LAS int*)(F.lds + MISC_OFF + 64);
    for (;;) {
        __syncthreads();
        if (F.tid == 0) qs[0] = (int)__hip_atomic_fetch_add((unsigned*)(F.ctl + qw), 1u, __ATOMIC_RELAXED, __HIP_MEMORY_SCOPE_AGENT);
        __syncthreads();
        const int q = qs[0];
        if (q >= 32 + 1024) break;
        if (q < 1024) hyena_item(F, q); else { p3_wait(F); s5_carry_item(F, q - 1024); }
    }
}
__device__ __forceinline__ void yh_transpose(Frame& F) {
    const bf16* YHCM = (const bf16*)(F.ws + WS_YHCM); bf16* YH = (bf16*)(F.ws + WS_YH);
    LAS unsigned short* tl = (LAS unsigned short*)(F.lds + 8 * 8704 + F.wave * (64 * 72 * 2));
    const int gw = F.bx * NWAVES + F.wave, NGW = F.G * NWAVES, lane = F.lane;
    for (int it = gw; it < 2 * 16 * 256; it += NGW) {
        const int mt = it & 255, ct = (it >> 8) & 15, b = it >> 12; const int m0 = mt * 64, c0 = ct * 64;
#pragma unroll
        for (int j = 0; j < 8; ++j) { const int ch = 8 * j + (lane >> 3), mc = (lane & 7) * 8;
            const u32x4 v = *(const GAS u32x4*)(YHCM + (size_t)(b * 1024 + c0 + ch) * SEQ + m0 + mc); *(LAS u32x4*)(tl + ch * 72 + mc) = v; }
        LDS_WAIT(); asm volatile("" ::: "memory");
#pragma unroll
        for (int j = 0; j < 8; ++j) { const int mm = 8 * j + (lane >> 3), cc = (lane & 7) * 8; const int m = m0 + mm, w = m >> 8, r = m & 255;
            u32x4 o; o.x = (unsigned)tl[(cc + 0) * 72 + mm] | ((unsigned)tl[(cc + 1) * 72 + mm] << 16); o.y = (unsigned)tl[(cc + 2) * 72 + mm] | ((unsigned)tl[(cc + 3) * 72 + mm] << 16);
            o.z = (unsigned)tl[(cc + 4) * 72 + mm] | ((unsigned)tl[(cc + 5) * 72 + mm] << 16); o.w = (unsigned)tl[(cc + 6) * 72 + mm] | ((unsigned)tl[(cc + 7) * 72 + mm] << 16);
            *(GAS u32x4*)(YH + (size_t)(b * SEQ + r * 64 + w) * HYW + c0 + cc) = o; }
        LDS_WAIT(); asm volatile("" ::: "memory");
    }
}

struct SchedStd {
    int G, c, npn, K, nrep; const char* A; const char* Bt; int esz = 2;
    __device__ __forceinline__ bool next(int i, pg8::Unit& u) const {
        int L = i * G + c; const int nwg = 128 * npn; u.e = 0; u.valid = 256;
        if (nrep > 1 && L >= nwg) L -= nwg;
        if (L >= nwg) return false;
        int wgid = L; { const int q = nwg / 8, xcd = wgid % 8, off = wgid / 8; wgid = xcd * q + off; }
        const int nig = 8 * npn, gid = wgid / nig; u.pm = gid * 8 + ((wgid % nig) % 8); u.pn = (wgid % nig) / 8; return true;
    }
    __device__ __forceinline__ unsigned a_row(const pg8::Unit& u, int r) const { return (unsigned)(u.pm * 256 + r); }
    __device__ __forceinline__ const char* a_base() const { return A; }
    __device__ __forceinline__ const char* b_base(const pg8::Unit& u) const { return Bt + (size_t)u.pn * 256 * K * esz; }
};
template <int MODE> struct EpiMix {
    static constexpr bool PERM = true, TRANS = true, FP8 = false;
    const bf16* P; const bf16* Q; bf16* O;
    __device__ __forceinline__ void operator()(const f32x4 (&acc)[2][2][4][2], const pg8::Unit& u, int wr, int wc, int fr, int fq) const {
        constexpr int ld = (MODE == 0) ? 1024 : 2048;
        const int col0 = u.pn * 256 + wc * 32 + 8 * fq;
#pragma unroll
        for (int ai = 0; ai < 2; ++ai) {
            u32x4 pv[4][2], qv[4][2];
#pragma unroll
            for (int m = 0; m < 4; ++m) { const size_t row = (size_t)u.pm * 256 + ai * 128 + wr * 64 + m * 16 + fr;
#pragma unroll
                for (int bj = 0; bj < 2; ++bj) { const int col = col0 + bj * 128;
                    if (MODE == 0) pv[m][bj] = *(const u32x4*)(P + row * 1024 + col);
                    else { const u32x2 g8 = *(const u32x2*)((const unsigned char*)P + row * 4096 + (MODE == 2 ? 2048 : 0) + col); pv[m][bj] = (u32x4){g8.x, g8.y, 0u, 0u}; }
                    if (MODE == 2) qv[m][bj] = *(const u32x4*)(Q + row * 2048 + col); } }
#pragma unroll
            for (int m = 0; m < 4; ++m) { const size_t row = (size_t)u.pm * 256 + ai * 128 + wr * 64 + m * 16 + fr;
#pragma unroll
                for (int bj = 0; bj < 2; ++bj) { const int col = col0 + bj * 128; const f32x4 v0 = acc[ai][bj][m][0], v1 = acc[ai][bj][m][1]; float r[8];
                    if (MODE == 0) { const u32x4 y = pv[m][bj];
                        r[0] = bflo(y.x) * sigmoidf_(v0[0]); r[1] = bfhi(y.x) * sigmoidf_(v0[1]); r[2] = bflo(y.y) * sigmoidf_(v0[2]); r[3] = bfhi(y.y) * sigmoidf_(v0[3]);
                        r[4] = bflo(y.z) * sigmoidf_(v1[0]); r[5] = bfhi(y.z) * sigmoidf_(v1[1]); r[6] = bflo(y.w) * sigmoidf_(v1[2]); r[7] = bfhi(y.w) * sigmoidf_(v1[3]); }
                    else { const u32x4 gg = pv[m][bj]; constexpr float q = 1.0f / 255.0f;
                        r[0] = (float)(gg.x & 255u) * q * v0[0]; r[1] = (float)((gg.x >> 8) & 255u) * q * v0[1]; r[2] = (float)((gg.x >> 16) & 255u) * q * v0[2]; r[3] = (float)(gg.x >> 24) * q * v0[3];
                        r[4] = (float)(gg.y & 255u) * q * v1[0]; r[5] = (float)((gg.y >> 8) & 255u) * q * v1[1]; r[6] = (float)((gg.y >> 16) & 255u) * q * v1[2]; r[7] = (float)(gg.y >> 24) * q * v1[3];
                        if (MODE == 2) { const u32x4 t1 = qv[m][bj];
                            r[0] += bflo(t1.x); r[1] += bfhi(t1.x); r[2] += bflo(t1.y); r[3] += bfhi(t1.y); r[4] += bflo(t1.z); r[5] += bfhi(t1.z); r[6] += bflo(t1.w); r[7] += bfhi(t1.w); } }
                    if (MODE == 2) {
                        *(u32x2*)((unsigned char*)O + row * ld + col) = (u32x2){pk4_fp8(r[0] * T8SCALE, r[1] * T8SCALE, r[2] * T8SCALE, r[3] * T8SCALE), pk4_fp8(r[4] * T8SCALE, r[5] * T8SCALE, r[6] * T8SCALE, r[7] * T8SCALE)}; }
                    else { u32x4 w; w.x = cvt_pk_bf16(r[0], r[1]); w.y = cvt_pk_bf16(r[2], r[3]); w.z = cvt_pk_bf16(r[4], r[5]); w.w = cvt_pk_bf16(r[6], r[7]);
                        *(u32x4*)(O + row * ld + col) = w; } } }
        }
    }
};
struct EpiOut {
    static constexpr bool PERM = true, TRANS = true, FP8 = true;
    const float* X; const float* MOD; bf16* H1;
    __device__ __forceinline__ void operator()(const f32x4 (&acc)[2][2][4][2], const pg8::Unit& u, int wr, int wc, int fr, int fq) const {
        const int b = u.pm >> 6; const int c0 = u.pn * 256 + wc * 32 + 8 * fq;
        f32x4 gv[2][2];
#pragma unroll
        for (int bj = 0; bj < 2; ++bj)
#pragma unroll
            for (int n = 0; n < 2; ++n) gv[bj][n] = *(const f32x4*)(MOD + b * 12288 + 2 * 2048 + c0 + bj * 128 + 4 * n) * (1.0f / (W8SCALE * T8SCALE));
#pragma unroll
        for (int ai = 0; ai < 2; ++ai) {
            f32x4 xv[4][2][2];
#pragma unroll
            for (int m = 0; m < 4; ++m) { const size_t off = ((size_t)u.pm * 256 + ai * 128 + wr * 64 + m * 16 + fr) * D + c0;
#pragma unroll
                for (int bj = 0; bj < 2; ++bj)
#pragma unroll
                    for (int n = 0; n < 2; ++n) xv[m][bj][n] = *(const f32x4*)(X + off + bj * 128 + 4 * n); }
#pragma unroll
            for (int m = 0; m < 4; ++m) { const size_t off = ((size_t)u.pm * 256 + ai * 128 + wr * 64 + m * 16 + fr) * D + c0;
#pragma unroll
                for (int bj = 0; bj < 2; ++bj) { const f32x4 v0 = xv[m][bj][0] + gv[bj][0] * acc[ai][bj][m][0], v1 = xv[m][bj][1] + gv[bj][1] * acc[ai][bj][m][1];
                    u32x4 w; w.x = cvt_pk_bf16(v0[0], v0[1]); w.y = cvt_pk_bf16(v0[2], v0[3]); w.z = cvt_pk_bf16(v1[0], v1[1]); w.w = cvt_pk_bf16(v1[2], v1[3]);
                    *(u32x4*)(H1 + off + bj * 128) = w; } }
        }
    }
};

__device__ __forceinline__ void p10_router(Frame& F) {
    const int gw = F.bx * NWAVES + F.wave, NGW = F.G * NWAVES, lane = F.lane;
    const float* MOD = (const float*)(F.ws + WS_MOD); const float* g2n = F.in[IN_N2G]; const float* RWT = (const float*)(F.ws + WS_RWT); const float* rb = F.in[IN_RB];
    const bf16* H1 = (const bf16*)(F.ws + WS_H1); unsigned char* HM8 = (unsigned char*)(F.ws + WS_HM8); float* GATE = (float*)(F.ws + WS_GATE); int* LIST = (int*)(F.ws + WS_LIST);
    for (int m0 = 2 * gw; m0 < NTOK; m0 += 2 * NGW) {
        const int b = m0 >> 14;
        f32x4 h[2][8];
#pragma unroll
        for (int rr = 0; rr < 2; ++rr) { const bf16* xr = H1 + (size_t)(m0 + rr) * D; float s = 0.f;
#pragma unroll
            for (int j = 0; j < 8; ++j) { const u32x2 hb = *(const GAS u32x2*)(xr + 4 * lane + 256 * j); h[rr][j] = (f32x4){bflo(hb.x), bfhi(hb.x), bflo(hb.y), bfhi(hb.y)}; s += (h[rr][j].x * h[rr][j].x + h[rr][j].y * h[rr][j].y) + (h[rr][j].z * h[rr][j].z + h[rr][j].w * h[rr][j].w); }
            const float rstd = 1.0f / sqrtf(wave_sum(s) * (1.0f / D) + 1e-6f);
            GAS unsigned* o = (GAS unsigned*)(HM8 + (size_t)(m0 + rr) * D) + lane;
#pragma unroll
            for (int j = 0; j < 8; ++j) { const int k = 4 * lane + 256 * j; const f32x4 g = *(const f32x4*)(g2n + k), sc = *(const f32x4*)(MOD + b * 12288 + 4 * 2048 + k), sh = *(const f32x4*)(MOD + b * 12288 + 3 * 2048 + k);
                h[rr][j] = h[rr][j] * rstd * g * (sc + 1.0f) + sh; }
#pragma unroll
            for (int j = 0; j < 8; ++j) o[64 * j] = pk4_fp8(h[rr][j].x, h[rr][j].y, h[rr][j].z, h[rr][j].w); }
        float lg0 = -3.0e38f, lg1 = -3.0e38f;
#pragma unroll 2
        for (int e = 0; e < NEXP; ++e) { float s0 = 0.f, s1 = 0.f;
#pragma unroll
            for (int j = 0; j < 8; ++j) { const f32x4 w = *(const f32x4*)(RWT + e * 2048 + 4 * lane + 256 * j);
                s0 += (h[0][j].x * w.x + h[0][j].y * w.y) + (h[0][j].z * w.z + h[0][j].w * w.w); s1 += (h[1][j].x * w.x + h[1][j].y * w.y) + (h[1][j].z * w.z + h[1][j].w * w.w); }
            s0 = wave_sum(s0) + rb[e]; s1 = wave_sum(s1) + rb[e];
            if (lane == e) { lg0 = s0; lg1 = s1; } }
#pragma unroll
        for (int rr = 0; rr < 2; ++rr) { float lg = rr ? lg1 : lg0; int es[4]; float vs[4];
#pragma unroll
            for (int k = 0; k < 4; ++k) { const float mx = wave_max(lg); const unsigned long long bal = __ballot(lg == mx); const int idx = __ffsll((long long)bal) - 1; es[k] = idx; vs[k] = mx; if (lane == idx) lg = -3.0e38f; }
            const float e1 = __expf(vs[1] - vs[0]), e2 = __expf(vs[2] - vs[0]), e3 = __expf(vs[3] - vs[0]); const float inv = 1.0f / (1.0f + e1 + e2 + e3);
            if (lane < 4) { const int ee = lane == 0 ? es[0] : lane == 1 ? es[1] : lane == 2 ? es[2] : es[3]; const float gt = (lane == 0 ? 1.0f : lane == 1 ? e1 : lane == 2 ? e2 : e3) * inv;
                const int slot = (m0 + rr) * 4 + lane;
                const unsigned pos = __hip_atomic_fetch_add((unsigned*)(F.ctl + CW_CNT + 64 * ee), 1u, __ATOMIC_RELAXED, __HIP_MEMORY_SCOPE_AGENT);
                LIST[ee * LISTCAP + (int)pos] = slot; GATE[slot] = gt; } }
    }
}

__device__ __forceinline__ void moe_tables(Frame& F) {
    volatile LAS int* tb = (volatile LAS int*)(F.lds + LDS_X);
    __syncthreads();
    if (F.tid < NEXP) tb[64 + F.tid] = (int)__hip_atomic_load((unsigned*)(F.ctl + CW_CNT + 64 * F.tid), __ATOMIC_RELAXED, __HIP_MEMORY_SCOPE_AGENT);
    __syncthreads();
    if (F.tid == 0) { int acc = 0; for (int e = 0; e < NEXP; ++e) { const int c = tb[64 + e]; tb[e] = acc; acc += (c + 255) >> 8; } tb[32] = acc; }
    __syncthreads();
}
template <bool GATHER> struct SchedMoe {
    int G, c, npn, N, K, nrep; const char* A; const char* Bt; const int* LIST; volatile LAS int* tb;
    __device__ __forceinline__ bool next(int i, pg8::Unit& u) const {
        int L = i * G + c; { const int tot = tb[32] * npn; if (nrep > 1 && L >= tot) L -= tot; }
        int rt = L / npn, pnq = L % npn;
        if (G == 256 && nrep == 1) {
            const int x = c & 7, j = c >> 3;
            if (npn == 16) { pnq = 4 * (x & 3) + (j & 3); rt = 16 * i + (x >> 2) * 8 + (j >> 2); }
            else           { pnq = 2 * (x & 3) + (j & 1); rt = 32 * i + (x >> 2) * 16 + (j >> 1); }
        }
        if (rt >= tb[32]) return false;
        int e = 0;
        for (int q = 1; q < NEXP; ++q) e += (tb[q] <= rt) ? 1 : 0;
        e = __builtin_amdgcn_readfirstlane(e);
        u.pm = rt; u.pn = pnq; u.e = e; const int left = tb[64 + e] - 256 * (rt - tb[e]); u.valid = left < 256 ? left : 256; return true;
    }
    __device__ __forceinline__ unsigned a_row(const pg8::Unit& u, int r) const {
        if (GATHER) { const int rc = r < u.valid ? r : u.valid - 1; return (unsigned)(LIST[u.e * LISTCAP + (u.pm - tb[u.e]) * 256 + rc] >> 2); }
        return (unsigned)(u.pm * 256 + r);
    }
    __device__ __forceinline__ const char* a_base() const { return A; }
    __device__ __forceinline__ const char* b_base(const pg8::Unit& u) const { return Bt + ((size_t)u.e * N + (size_t)u.pn * 256) * K; }
};
struct EpiMoe1 {
    static constexpr bool PERM = true, TRANS = true, FP8 = true;
    const float* BG; unsigned char* ACT;
    __device__ __forceinline__ void operator()(const f32x4 (&acc)[2][2][4][2], const pg8::Unit& u, int wr, int wc, int fr, int fq) const {
        const int c0 = u.pn * 256 + wc * 32 + 8 * fq;
        f32x4 bv[2][2];
#pragma unroll
        for (int bj = 0; bj < 2; ++bj)
#pragma unroll
            for (int n = 0; n < 2; ++n) bv[bj][n] = *(const f32x4*)(BG + (size_t)u.e * 4096 + c0 + bj * 128 + 4 * n);
#pragma unroll
        for (int ai = 0; ai < 2; ++ai)
#pragma unroll
            for (int m = 0; m < 4; ++m) { const size_t row = (size_t)u.pm * 256 + ai * 128 + wr * 64 + m * 16 + fr;
#pragma unroll
                for (int bj = 0; bj < 2; ++bj) { const f32x4 v0 = acc[ai][bj][m][0] * (1.0f / W8SCALE) + bv[bj][0], v1 = acc[ai][bj][m][1] * (1.0f / W8SCALE) + bv[bj][1]; float a[4];
#pragma unroll
                    for (int j = 0; j < 4; ++j) { const float gl = fminf(j < 2 ? v0[2 * j] : v1[2 * j - 4], 7.0f); const float ln = fminf(fmaxf(j < 2 ? v0[2 * j + 1] : v1[2 * j - 3], -7.0f), 7.0f);
                        a[j] = gl * sigmoidf_(1.702f * gl) * (ln + 1.0f); }
                    *(unsigned*)(ACT + row * DEXP + ((c0 + bj * 128) >> 1)) = pk4_fp8(a[0], a[1], a[2], a[3]); } }
    }
};
struct EpiMoe2 {
    static constexpr bool PERM = true, TRANS = true, FP8 = true;
    const float* BD; const float* GATE; const int* LIST; unsigned char* YS; volatile LAS int* tb;
    __device__ __forceinline__ void operator()(const f32x4 (&acc)[2][2][4][2], const pg8::Unit& u, int wr, int wc, int fr, int fq) const {
        const int c0 = u.pn * 256 + wc * 32 + 8 * fq; const int lbase = u.e * LISTCAP + (u.pm - tb[u.e]) * 256;
        f32x4 bv[2][2];
#pragma unroll
        for (int bj = 0; bj < 2; ++bj)
#pragma unroll
            for (int n = 0; n < 2; ++n) bv[bj][n] = *(const f32x4*)(BD + (size_t)u.e * D + c0 + bj * 128 + 4 * n);
        int slot[2][4]; float gt_[2][4];
#pragma unroll
        for (int ai = 0; ai < 2; ++ai)
#pragma unroll
            for (int m = 0; m < 4; ++m) { const int r = ai * 128 + wr * 64 + m * 16 + fr; slot[ai][m] = LIST[lbase + (r < u.valid ? r : u.valid - 1)]; }
#pragma unroll
        for (int ai = 0; ai < 2; ++ai)
#pragma unroll
            for (int m = 0; m < 4; ++m) gt_[ai][m] = GATE[slot[ai][m]] * Y8SCALE;
#pragma unroll
        for (int ai = 0; ai < 2; ++ai)
#pragma unroll
            for (int m = 0; m < 4; ++m) { const int r = ai * 128 + wr * 64 + m * 16 + fr; const float gt = gt_[ai][m];
                const long long ro = (r < u.valid) ? (long long)slot[ai][m] * D : YS_DUMP_OFF;
#pragma unroll
                for (int bj = 0; bj < 2; ++bj) { const f32x4 v0 = (acc[ai][bj][m][0] * (1.0f / W8SCALE) + bv[bj][0]) * gt, v1 = (acc[ai][bj][m][1] * (1.0f / W8SCALE) + bv[bj][1]) * gt;
                    *(u32x2*)(YS + ro + c0 + bj * 128) = (u32x2){pk4_fp8(v0[0], v0[1], v0[2], v0[3]), pk4_fp8(v1[0], v1[1], v1[2], v1[3])}; } }
    }
};
__device__ __forceinline__ void p13_final(Frame& F) {
    const int gw = F.bx * NWAVES + F.wave, NGW = F.G * NWAVES, lane = F.lane;
    const float* MOD = (const float*)(F.ws + WS_MOD); const float* fg = F.in[IN_FG]; const unsigned char* YS = (const unsigned char*)(F.ws + WS_YS); float* O = F.out;
    f32x4 g2v[8]; int curb = -1;
    for (int m0 = 2 * gw; m0 < NTOK; m0 += 2 * NGW) {
        const int b = m0 >> 14;
        if (b != curb) { curb = b;
#pragma unroll
            for (int j = 0; j < 8; ++j) g2v[j] = *(const f32x4*)(MOD + b * 12288 + 5 * 2048 + 4 * lane + 256 * j) * (1.0f / Y8SCALE); }
        unsigned yv[2][8][4]; u32x2 hv[2][8]; f32x4 fgv[8];
#pragma unroll
        for (int rr = 0; rr < 2; ++rr) { const int m = m0 + rr; const bf16* hr = (const bf16*)(F.ws + WS_H1) + (size_t)m * D;
#pragma unroll
            for (int j = 0; j < 8; ++j) { const int k = 4 * lane + 256 * j;
#pragma unroll
                for (int q = 0; q < 4; ++q) yv[rr][j][q] = *(const GAS unsigned*)(YS + (size_t)(m * 4 + q) * D + k);
                hv[rr][j] = *(const GAS u32x2*)(hr + k); } }
#pragma unroll
        for (int j = 0; j < 8; ++j) fgv[j] = *(const f32x4*)(fg + 4 * lane + 256 * j);
        f32x4 h[2][8]; float rstd[2];
#pragma unroll
        for (int rr = 0; rr < 2; ++rr) { float s = 0.f;
#pragma unroll
            for (int j = 0; j < 8; ++j) { f32x4 a = (f32x4){0.f, 0.f, 0.f, 0.f};
#pragma unroll
                for (int q = 0; q < 4; ++q) { const unsigned y = yv[rr][j][q]; const f32x2 lo = __builtin_amdgcn_cvt_pk_f32_fp8((int)y, false), hi = __builtin_amdgcn_cvt_pk_f32_fp8((int)y, true); a += (f32x4){lo.x, lo.y, hi.x, hi.y}; }
                const u32x2 hb = hv[rr][j]; h[rr][j] = (f32x4){bflo(hb.x), bfhi(hb.x), bflo(hb.y), bfhi(hb.y)} + g2v[j] * a; s += (h[rr][j].x * h[rr][j].x + h[rr][j].y * h[rr][j].y) + (h[rr][j].z * h[rr][j].z + h[rr][j].w * h[rr][j].w); }
            rstd[rr] = 1.0f / sqrtf(wave_sum(s) * (1.0f / D) + 1e-6f); }
#pragma unroll
        for (int rr = 0; rr < 2; ++rr) { float* xr = O + (size_t)(m0 + rr) * D;
#pragma unroll
            for (int j = 0; j < 8; ++j) { const int k = 4 * lane + 256 * j; *(GAS f32x4*)(xr + k) = h[rr][j] * rstd[rr] * fgv[j]; } }
    }
}

__global__ void __launch_bounds__(NTHR, 2) fwd(Args args) {
    extern __shared__ __attribute__((aligned(16))) unsigned char lds_raw[];
    Frame F;
    F.lds = (LAS unsigned char*)lds_raw;
    F.tid = threadIdx.x; F.lane = F.tid & 63; F.wave = __builtin_amdgcn_readfirstlane(F.tid >> 6);
    F.G = gridDim.x; F.bx = blockIdx.x; F.in = args.in; F.out = args.out; F.ws = args.ws; F.ctl = (GAS unsigned*)(args.ws + WS_CTL);
    for (int u = F.tid; u < (LDS_BYTES - MISC_OFF) / 4; u += NTHR) ((LAS unsigned*)(F.lds + MISC_OFF))[u] = 0u;
    __syncthreads();
    const int lo = args.ph_lo, hi = args.ph_hi;
    XcdBarrier bar; bar.bar = (unsigned*)(F.ctl + CW_BAR); bar.x = 0; bar.st = nullptr;
    if (hi - lo > 1) bar = xcd_barrier_post((unsigned*)(F.ctl + CW_BAR), (volatile LAS unsigned*)(F.lds + MISC_OFF));
#ifndef PH_MASK
#define PH_MASK 0xffff
#endif
#define IN(k) (((PH_MASK >> (k)) & 1) && lo <= (k) && (k) < hi)
#define SEAM(k) do { if (IN(k) && IN((k) + 1)) xcd_barrier(bar); } while (0)
    unsigned char* ws = args.ws;
#ifndef PROBE_DUP
#define PROBE_DUP 0
#endif
#define DUPBAR(k) if ((PROBE_DUP >> (k)) & 1) xcd_barrier(bar)
#define DUP2(k, body) do { body; if ((PROBE_DUP >> (k)) & 1) { xcd_barrier(bar); body; } } while (0)
    if (IN(0)) { DUP2(0, p0_prologue(F)); } SEAM(0);
    if (IN(1)) { DUP2(1, p1_norm(F)); } SEAM(1);
    if (IN(2)) { {
        const int GW = (F.G == 256) ? 192 : F.G; const int nr = ((PROBE_DUP >> 2) & 1) ? 2 : 1;
        if (F.bx < GW) {
            const int r1 = (128 * 4 + 8) % GW, r2 = (r1 + 128 * 16) % GW; const int c1 = F.bx, c2 = (F.bx - r1 + GW) % GW, c3 = (F.bx - r2 + GW) % GW;
            { SchedIn S{GW, c1, 128 * 4, 4, 0, nr, (const char*)(ws + WS_U), (const char*)(ws + WS_WIN)}; EpiInA E{ws};
              pg8::gemm_phase<EpiInA, SchedIn>(F.lds, D, S, E); }
            { SchedIn S{GW, c2, 128 * 16, 16, 2, nr, (const char*)(ws + WS_U8), (const char*)(ws + WS_WIN8)}; EpiInG8 E{(unsigned char*)(ws + WS_UG)};
              pg8::gemm_phase<EpiInG8, SchedIn>(F.lds, D, S, E); }
            { SchedIn S{GW, c3, 128 * 12, 12, 1, nr, (const char*)(ws + WS_U), (const char*)(ws + WS_WIN)}; EpiInH E{(bf16*)(ws + WS_UH)};
              pg8::gemm_phase<EpiInH, SchedIn>(F.lds, D, S, E); }
        }
        moe_weight_queue(F);
        }
    } SEAM(2);
    if (IN(3)) { DUP2(3, s5_pass3<false>(F)); p3_publish(F); }
    if (IN(4)) { int q4w = CW_Q4; DUP2(4, (p4_hyena_carry(F, q4w), q4w += 16)); } SEAM(4);
    if (IN(5)) { DUP2(5, s5_pass3<true>(F)); __syncthreads(); DUP2(14, yh_transpose(F)); } SEAM(5);
    if (IN(6)) { { SchedStd S{F.G, F.bx, 4, 1024, ((PROBE_DUP >> 6) & 1) ? 2 : 1, (const char*)(ws + WS_Y), (const char*)(ws + WS_WGLU)}; EpiMix<0> E{(const bf16*)(ws + WS_Y), nullptr, (bf16*)(ws + WS_YA)};
        pg8::gemm_phase<EpiMix<0>, SchedStd>(F.lds, 1024, S, E); } } SEAM(6);
    if (IN(7)) { { SchedStd S{F.G, F.bx, 8, 1024, ((PROBE_DUP >> 7) & 1) ? 2 : 1, (const char*)(ws + WS_YA), (const char*)(ws + WS_WBS5)}; EpiMix<1> E{(const bf16*)(ws + WS_UG), nullptr, (bf16*)(ws + WS_T1)};
        pg8::gemm_phase<EpiMix<1>, SchedStd>(F.lds, 1024, S, E); } }
    if (!(IN(7) && IN(8))) { SEAM(7); }
    if (IN(8)) { { SchedStd S{F.G, F.bx, 8, 1024, ((PROBE_DUP >> 8) & 1) ? 2 : 1, (const char*)(ws + WS_YH), (const char*)(ws + WS_WBHY)}; EpiMix<2> E{(const bf16*)(ws + WS_UG), (const bf16*)(ws + WS_T1), (bf16*)(ws + WS_T)};
        pg8::gemm_phase<EpiMix<2>, SchedStd>(F.lds, 1024, S, E); } } SEAM(8);
    if (IN(9)) { { SchedStd S{F.G, F.bx, 8, 2048, ((PROBE_DUP >> 9) & 1) ? 2 : 1, (const char*)(ws + WS_T), (const char*)(ws + WS_WO), 1}; EpiOut E{F.in[IN_X], (const float*)(ws + WS_MOD), (bf16*)(ws + WS_H1)};
        pg8::gemm_phase<EpiOut, SchedStd>(F.lds, 2048, S, E); } } SEAM(9);
    if (IN(10)) { p10_router(F); } SEAM(10);
    if (IN(11)) { { moe_tables(F); volatile LAS int* tb = (volatile LAS int*)(F.lds + LDS_X);
        SchedMoe<true> S{F.G, F.bx, 16, 4096, 2048, ((PROBE_DUP >> 11) & 1) ? 2 : 1, (const char*)(ws + WS_HM8), (const char*)(ws + WS_WGU), (const int*)(ws + WS_LIST), tb}; EpiMoe1 E{F.in[IN_BGU], (unsigned char*)(ws + WS_ACT)};
        pg8::gemm_phase<EpiMoe1, SchedMoe<true>>(F.lds, 2048, S, E); } } SEAM(11);
    if (IN(12)) { { moe_tables(F); volatile LAS int* tb = (volatile LAS int*)(F.lds + LDS_X);
        SchedMoe<false> S{F.G, F.bx, 8, 2048, 2048, ((PROBE_DUP >> 12) & 1) ? 2 : 1, (const char*)(ws + WS_ACT), (const char*)(ws + WS_WDN), (const int*)(ws + WS_LIST), tb}; EpiMoe2 E{F.in[IN_BDN], (const float*)(ws + WS_GATE), (const int*)(ws + WS_LIST), (unsigned char*)(ws + WS_YS), tb};
        pg8::gemm_phase<EpiMoe2, SchedMoe<false>>(F.lds, 2048, S, E); } } SEAM(12);
    if (IN(13)) { DUP2(13, p13_final(F)); }
#undef IN
#undef SEAM
}

extern "C" void kernel_launch(void* const* d_in, const int* in_sizes, int n_in, void* d_out, int out_size, void* d_ws, size_t ws_size, hipStream_t stream) {
    static int grid = 0;
    if (grid == 0) {
        if (n_in != 39 || out_size != NTOK * D || ws_size < WS_END) { fprintf(stderr, "kernel_launch: unexpected shapes: n_in %d out %d ws %zu (need %zu)\n", n_in, out_size, ws_size, (size_t)WS_END); grid = -1; return; }
        int dev = 0, cus = 0, per_cu = 0;
        if (hipGetDevice(&dev) != hipSuccess || hipDeviceGetAttribute(&cus, hipDeviceAttributeMultiprocessorCount, dev) != hipSuccess) { grid = -1; return; }
        if (hipFuncSetAttribute((const void*)fwd, hipFuncAttributeMaxDynamicSharedMemorySize, LDS_BYTES) != hipSuccess) { fprintf(stderr, "kernel_launch: hipFuncSetAttribute failed\n"); grid = -1; return; }
        if (hipOccupancyMaxActiveBlocksPerMultiprocessor(&per_cu, (const void*)fwd, NTHR, LDS_BYTES) != hipSuccess || per_cu < 1) fprintf(stderr, "kernel_launch: occupancy query says %d\n", per_cu);
        (void)hipGetLastError();
        grid = cus;
    }
    if (grid < 0) return;
    if (hipMemsetAsync((char*)d_ws + WS_CTL, 0, CTL_ZERO_BYTES, stream) != hipSuccess) return;
    Args a{};
    for (int i = 0; i < 39; ++i) a.in[i] = (const float*)d_in[i];
    a.out = (float*)d_out; a.ws = (unsigned char*)d_ws;
#ifndef ONE_LAUNCH
#define ONE_LAUNCH 1
#endif
    if (ONE_LAUNCH) { a.ph_lo = 0; a.ph_hi = NPHASE; hipLaunchKernelGGL(fwd, dim3(grid), dim3(NTHR), LDS_BYTES, stream, a); }
    else for (int p = 0; p < NPHASE; ++p) { a.ph_lo = p; a.ph_hi = p + 1; hipLaunchKernelGGL(fwd, dim3(grid), dim3(NTHR), LDS_BYTES, stream, a); }
}
```

```cpp
#include <hip/hip_runtime.h>
#include <cstdio>
#include <cstdint>

#define GAS __attribute__((address_space(1)))
#define LAS __attribute__((address_space(3)))
typedef unsigned short bf16;
typedef short bf16x8 __attribute__((ext_vector_type(8)));
typedef float f32x4 __attribute__((ext_vector_type(4)));
typedef float f32x16 __attribute__((ext_vector_type(16)));
typedef float f32x2 __attribute__((ext_vector_type(2)));
typedef unsigned u32x4 __attribute__((ext_vector_type(4)));
typedef unsigned u32x2 __attribute__((ext_vector_type(2)));
typedef int i32x4 __attribute__((ext_vector_type(4)));
typedef int i32x8 __attribute__((ext_vector_type(8)));

constexpr int D = 2048, NB = 2, SEQ = 16384, NTOK = NB * SEQ, CTX = 256, NCTX = NB * CTX;
constexpr int S5W = 1024, HYW = 1024, INC = 8192, NEXP = 32, TOPK = 4, DEXP = 2048;
constexpr int NCH = 260;
constexpr int LISTCAP = 32768;

constexpr size_t MiB = 1u << 20;
constexpr size_t WS_CTL = 0, CTL_ZERO_BYTES = 1 * MiB;
constexpr size_t WS_MOD = 6 * MiB;
constexpr size_t WS_BBT = 7 * MiB;
constexpr size_t WS_CTT = WS_BBT + 512 * 1024;
constexpr size_t WS_LAM = 8 * MiB;
constexpr size_t WS_RWT = 8 * MiB + 256 * 1024;
constexpr size_t WS_BB2 = 8 * MiB + 512 * 1024;
constexpr size_t WS_WIN = 16 * MiB;
constexpr size_t WS_WGLU = 48 * MiB;
constexpr size_t WS_WBS5 = 50 * MiB;
constexpr size_t WS_WBHY = 54 * MiB;
constexpr size_t WS_WO = 58 * MiB;
constexpr size_t WS_WGU = 66 * MiB;
constexpr size_t WS_WDN = 578 * MiB;
constexpr size_t WS_U = 834 * MiB;
constexpr size_t WS_UCA = 964 * MiB;
constexpr size_t WS_UA = 966 * MiB;
constexpr size_t WS_UH = 1030 * MiB;
constexpr size_t WS_UG = 1222 * MiB;
constexpr size_t WS_E = 1478 * MiB;
constexpr size_t WS_SIN = 1511 * MiB;
constexpr size_t WS_FILT = 1544 * MiB;
constexpr size_t WS_HYS = 1800 * MiB;
constexpr size_t HYS_STRIDE = 768 * 1024;
constexpr size_t WS_YHCM = 1992 * MiB;
constexpr size_t WS_YH = 2056 * MiB;
constexpr size_t WS_Y = 2120 * MiB;
constexpr size_t WS_YA = 2184 * MiB;
constexpr size_t WS_T1 = 2248 * MiB;
constexpr size_t WS_T = 2376 * MiB;
constexpr size_t WS_HM = 2504 * MiB;
constexpr size_t WS_GATE = 2632 * MiB;
constexpr size_t WS_LIST = 2633 * MiB;
constexpr size_t WS_ACT = 2638 * MiB;
constexpr size_t WS_YS = 3182 * MiB;
constexpr size_t WS_H1 = 3694 * MiB;
constexpr size_t WS_HM8 = WS_T1;
constexpr size_t WS_U8 = WS_ACT;
constexpr size_t WS_WIN8 = WS_YS;
constexpr size_t WS_END = 3950 * MiB;
constexpr long long YS_DUMP_OFF = (long long)(2 * MiB) - (long long)WS_YS;

constexpr int CW_TMO = 0;
constexpr int CW_Q4 = 64;
constexpr int CW_P3 = 112;
constexpr int CW_QT = 96;
constexpr int CW_CNT = 128;
constexpr int CW_BAR = 4096;

constexpr int RING_BYTES = 131072;
constexpr int LDS_X = 131072;
constexpr int MISC_OFF = 147456 - 512;
constexpr int LDS_BYTES = 147456;
constexpr int NWAVES = 8, NTHR = 512;
constexpr int NPHASE = 14;

__device__ __forceinline__ unsigned f2bf(float f) { unsigned u = __builtin_bit_cast(unsigned, f); return (u + 0x7fffu + ((u >> 16) & 1u)) >> 16; }
__device__ __forceinline__ unsigned pk2(float lo, float hi) { return f2bf(lo) | (f2bf(hi) << 16); }
__device__ __forceinline__ float bf2f(unsigned short b) { return __builtin_bit_cast(float, ((unsigned)b) << 16); }
__device__ __forceinline__ float bflo(unsigned w) { return __builtin_bit_cast(float, w << 16); }
__device__ __forceinline__ float bfhi(unsigned w) { return __builtin_bit_cast(float, w & 0xffff0000u); }
typedef __bf16 bf16x2_t __attribute__((ext_vector_type(2)));
__device__ __forceinline__ unsigned cvt_pk_bf16(float lo, float hi) { const f32x2 v = {lo, hi}; const bf16x2_t b = __builtin_convertvector(v, bf16x2_t); return __builtin_bit_cast(unsigned, b); }
__device__ __forceinline__ unsigned pk4_fp8(float a, float b, float c, float d) { unsigned w = 0u; w = (unsigned)__builtin_amdgcn_cvt_pk_fp8_f32(a, b, (int)w, false); w = (unsigned)__builtin_amdgcn_cvt_pk_fp8_f32(c, d, (int)w, true); return w; }
constexpr float Y8SCALE = 8.0f;
constexpr float T8SCALE = 16.0f;
constexpr float W8SCALE = 64.0f;
__device__ __forceinline__ float sigmoidf_(float x) { return __builtin_amdgcn_rcpf(1.0f + __expf(-x)); }
__device__ __forceinline__ float sin_rev(float r) { return __builtin_amdgcn_sinf(__builtin_amdgcn_fractf(r)); }
__device__ __forceinline__ float cos_rev(float r) { return __builtin_amdgcn_cosf(__builtin_amdgcn_fractf(r)); }
__device__ __forceinline__ float wave_sum(float v) {
#pragma unroll
    for (int o = 1; o < 64; o <<= 1) v += __shfl_xor(v, o);
    return v;
}
__device__ __forceinline__ float wave_max(float v) {
#pragma unroll
    for (int o = 1; o < 64; o <<= 1) v = fmaxf(v, __shfl_xor(v, o));
    return v;
}
__device__ __forceinline__ f32x2 cmul(f32x2 a, f32x2 b) { return (f32x2){a.x * b.x - a.y * b.y, a.x * b.y + a.y * b.x}; }
#define LDS_WAIT() asm volatile("s_waitcnt lgkmcnt(0)" ::: "memory")
#define VM_WAIT() asm volatile("s_waitcnt vmcnt(0)" ::: "memory")

namespace pg8 {
constexpr int BM = 256, BK = 64, HALF = 128, HTB = HALF * BK * 2, STAGE_BYTES = 8 * HTB;
__host__ __device__ __forceinline__ int lds_byte(int r, int c) { const int st = (r >> 4) * 2 + (c >> 5), rr = r & 15, cc = c & 31, ob = rr * 64 + cc * 2; return st * 1024 + (ob ^ (((ob >> 9) & 1) << 5)); }
__host__ __device__ __forceinline__ void stage_rc(int b, int& R, int& C) { const int st = b / 1024, sb = b % 1024, swz = sb ^ (((sb >> 9) & 1) << 5); R = (st >> 1) * 16 + swz / 64; C = (st & 1) * 32 + (swz % 64) / 2; }
__host__ __device__ __forceinline__ int perm32(int rho) { const int n = rho >> 4, i = rho & 15; return 8 * (i >> 2) + 4 * n + (i & 3); }

struct Unit { int pm, pn, e, valid; };

template <class Epi, class Sched>
__device__ __forceinline__ void gemm_phase(LAS unsigned char* lds, const int Kel, const Sched& S, const Epi& E) {
    const int tid = threadIdx.x, wid = __builtin_amdgcn_readfirstlane(tid >> 6), lane = tid & 63, wr = wid >> 2, wc = wid & 3, fr = lane & 15, fq = lane >> 4;
    const int K = Epi::FP8 ? (Kel >> 1) : Kel;
    const int nt = K / BK;
    int Rs[2], Cs[2]; unsigned voffB[2];
#pragma unroll
    for (int i = 0; i < 2; ++i) { int R, C; stage_rc(tid * 16 + i * 8192, R, C); Rs[i] = R; Cs[i] = C; const int Rb = Epi::PERM ? ((R & ~31) + perm32(R & 31)) : R; voffB[i] = (unsigned)(Rb * K + C) * 2u; }
    const size_t kstep = (size_t)(BK * 2);
    const size_t hstep = (size_t)HALF * K * 2;
    const unsigned ldsw = (unsigned)wid * 1024u;
    const int aoff = lds_byte(wr * 64 + fr, fq * 8), boff = lds_byte(wc * 32 + fr, fq * 8);
    const int aoff8 = lds_byte(wr * 64 + fr, fq * 16), boff8 = lds_byte(wc * 32 + fr, fq * 16);
#define PG8_SA(b, h) (((b) * 2 + (h)) * HTB)
#define PG8_SB(b, h) ((4 + (b) * 2 + (h)) * HTB)
#define PG8_STAGE(bufoff, gbase, voff) do { _Pragma("unroll") for (int _i = 0; _i < 2; ++_i) \
        __builtin_amdgcn_global_load_lds((const unsigned*)((const char*)(gbase) + (voff)[_i]), (LAS unsigned*)(lds + (bufoff) + ldsw + _i * 8192), 16, 0, 0); } while (0)
#define PG8_LDA(dst, b, h) do { if constexpr (Epi::FP8) { _Pragma("unroll") for (int m = 0; m < 4; ++m) { const i32x4 lo_ = *(const LAS i32x4*)(lds + PG8_SA(b, h) + aoff8 + m * 2048), hi_ = *(const LAS i32x4*)(lds + PG8_SA(b, h) + aoff8 + m * 2048 + 16); dst##8[m] = __builtin_shufflevector(lo_, hi_, 0, 1, 2, 3, 4, 5, 6, 7); } } \
        else { _Pragma("unroll") for (int m = 0; m < 4; ++m) _Pragma("unroll") for (int k = 0; k < 2; ++k) dst[m][k] = *(const LAS bf16x8*)(lds + PG8_SA(b, h) + aoff + m * 2048 + k * 1024); } } while (0)
#define PG8_LDB(dst, b, h) do { if constexpr (Epi::FP8) { _Pragma("unroll") for (int n = 0; n < 2; ++n) { const i32x4 lo_ = *(const LAS i32x4*)(lds + PG8_SB(b, h) + boff8 + n * 2048), hi_ = *(const LAS i32x4*)(lds + PG8_SB(b, h) + boff8 + n * 2048 + 16); dst##8[n] = __builtin_shufflevector(lo_, hi_, 0, 1, 2, 3, 4, 5, 6, 7); } } \
        else { _Pragma("unroll") for (int n = 0; n < 2; ++n) _Pragma("unroll") for (int k = 0; k < 2; ++k) dst[n][k] = *(const LAS bf16x8*)(lds + PG8_SB(b, h) + boff + n * 2048 + k * 1024); } } while (0)
#define PG8_MMA(ai, bj, At, Bt) do { __builtin_amdgcn_s_setprio(1); \
        if constexpr (Epi::FP8) { _Pragma("unroll") for (int m = 0; m < 4; ++m) _Pragma("unroll") for (int n = 0; n < 2; ++n) \
            asm volatile("v_mfma_scale_f32_16x16x128_f8f6f4 %0, %1, %2, %0, %3, %3 op_sel_hi:[0,0,0]" : "+v"(acc[ai][bj][m][n]) : "v"(Bt##8[n]), "v"(At##8[m]), "v"(scl1)); } \
        else { _Pragma("unroll") for (int m = 0; m < 4; ++m) _Pragma("unroll") for (int n = 0; n < 2; ++n) _Pragma("unroll") for (int k = 0; k < 2; ++k) \
        acc[ai][bj][m][n] = Epi::TRANS ? __builtin_amdgcn_mfma_f32_16x16x32_bf16(Bt[n][k], At[m][k], acc[ai][bj][m][n], 0, 0, 0) \
                                       : __builtin_amdgcn_mfma_f32_16x16x32_bf16(At[m][k], Bt[n][k], acc[ai][bj][m][n], 0, 0, 0); } __builtin_amdgcn_s_setprio(0); } while (0)
#define PG8_WAIT_V(n) asm volatile("s_waitcnt vmcnt(" #n ")" ::: "memory")
#define PG8_WAIT_L(n) asm volatile("s_waitcnt lgkmcnt(" #n ")" ::: "memory")
#define PG8_BAR __builtin_amdgcn_s_barrier()
#define PG8_SCHED __builtin_amdgcn_sched_barrier(0)
    Unit cur, nxt; int ui = 0;
    if (!S.next(0, cur)) return;
    f32x4 acc[2][2][4][2];
#pragma unroll
    for (int a = 0; a < 2; ++a)
#pragma unroll
        for (int b = 0; b < 2; ++b)
#pragma unroll
            for (int m = 0; m < 4; ++m)
#pragma unroll
                for (int n = 0; n < 2; ++n) acc[a][b][m][n] = (f32x4){0.f, 0.f, 0.f, 0.f};
    bf16x8 At[4][2], B0[2][2], B1[2][2]; i32x8 At8[4], B08[2], B18[2]; const int scl1 = 0x7F7F7F7F;
    const char* const Ab = S.a_base();
    const char* cB = S.b_base(cur);
    unsigned vC0[2], vC1[2];
#pragma unroll
    for (int i = 0; i < 2; ++i) { vC0[i] = (S.a_row(cur, Rs[i]) * (unsigned)K + (unsigned)Cs[i]) * 2u; vC1[i] = (S.a_row(cur, HALF + Rs[i]) * (unsigned)K + (unsigned)Cs[i]) * 2u; }
    PG8_STAGE(PG8_SB(0, 0), cB, voffB); PG8_STAGE(PG8_SB(0, 1), cB + hstep, voffB); PG8_STAGE(PG8_SA(0, 0), Ab, vC0); PG8_STAGE(PG8_SA(0, 1), Ab, vC1);
    if (wr == 1) PG8_BAR;
    PG8_WAIT_V(2); PG8_BAR;
    PG8_STAGE(PG8_SB(1, 0), cB + kstep, voffB); PG8_STAGE(PG8_SA(1, 0), Ab + kstep, vC0); PG8_STAGE(PG8_SB(1, 1), cB + hstep + kstep, voffB);
    PG8_WAIT_V(6); PG8_BAR;
    for (;;) {
        const bool has_next = S.next(ui + 1, nxt);
        const char* nB = has_next ? S.b_base(nxt) : cB;
        for (int t = 0; t < nt; t += 2) {
            const bool last = (t == nt - 2);
            const char* a1 = Ab + (size_t)(t + 1) * kstep;
            const char* a2 = last ? Ab : Ab + (size_t)(t + 2) * kstep; const char* b2 = last ? nB : cB + (size_t)(t + 2) * kstep;
            const char* a3 = a2 + kstep; const char* b3 = b2 + kstep;
            unsigned vX0[2], vX1[2];
            if (last && has_next) {
#pragma unroll
                for (int i = 0; i < 2; ++i) { vX0[i] = (S.a_row(nxt, Rs[i]) * (unsigned)K + (unsigned)Cs[i]) * 2u; vX1[i] = (S.a_row(nxt, HALF + Rs[i]) * (unsigned)K + (unsigned)Cs[i]) * 2u; }
            } else {
#pragma unroll
                for (int i = 0; i < 2; ++i) { vX0[i] = vC0[i]; vX1[i] = vC1[i]; }
            }
            PG8_LDB(B0, 0, 0); PG8_LDB(B1, 0, 1); PG8_SCHED; PG8_LDA(At, 0, 0); PG8_STAGE(PG8_SA(1, 1), a1, vC1);
            PG8_WAIT_V(8); PG8_WAIT_L(0); PG8_BAR; PG8_MMA(0, 0, At, B0); PG8_MMA(0, 1, At, B1); PG8_BAR; PG8_SCHED;
            PG8_LDA(At, 0, 1); PG8_STAGE(PG8_SB(0, 0), b2, voffB); PG8_STAGE(PG8_SB(0, 1), b2 + hstep, voffB); PG8_STAGE(PG8_SA(0, 0), a2, vX0);
            PG8_WAIT_V(8); PG8_WAIT_L(0); PG8_BAR; PG8_MMA(1, 0, At, B0); PG8_MMA(1, 1, At, B1); PG8_BAR; PG8_SCHED;
            PG8_LDB(B0, 1, 0); PG8_LDB(B1, 1, 1); PG8_SCHED; PG8_LDA(At, 1, 0); PG8_STAGE(PG8_SA(0, 1), a2, vX1);
            PG8_WAIT_V(8); PG8_WAIT_L(0); PG8_BAR; PG8_MMA(0, 0, At, B0); PG8_MMA(0, 1, At, B1); PG8_BAR; PG8_SCHED;
            PG8_LDA(At, 1, 1); PG8_STAGE(PG8_SB(1, 0), b3, voffB); PG8_STAGE(PG8_SB(1, 1), b3 + hstep, voffB); PG8_STAGE(PG8_SA(1, 0), a3, vX0);
            PG8_WAIT_V(8); PG8_WAIT_L(0); PG8_BAR; PG8_MMA(1, 0, At, B0); PG8_MMA(1, 1, At, B1); PG8_BAR; PG8_SCHED;
            if (last) {
#pragma unroll
                for (int i = 0; i < 2; ++i) { vC0[i] = vX0[i]; vC1[i] = vX1[i]; }
            }
        }
        if (wr == 0) PG8_BAR;
        if constexpr (Epi::FP8) asm volatile("s_nop 15\n\ts_nop 15" ::: "memory");
        E(acc, cur, wr, wc, fr, fq);
        if (!has_next) break;
#pragma unroll
        for (int a = 0; a < 2; ++a)
#pragma unroll
            for (int b = 0; b < 2; ++b)
#pragma unroll
                for (int m = 0; m < 4; ++m)
#pragma unroll
                    for (int n = 0; n < 2; ++n) acc[a][b][m][n] = (f32x4){0.f, 0.f, 0.f, 0.f};
        cur = nxt; cB = nB; ++ui;
        if (wr == 1) PG8_BAR;
    }
    PG8_WAIT_V(0);
    PG8_BAR;
#undef PG8_SA
#undef PG8_SB
#undef PG8_STAGE
#undef PG8_LDA
#undef PG8_LDB
#undef PG8_MMA
#undef PG8_WAIT_V
#undef PG8_WAIT_L
#undef PG8_BAR
#undef PG8_SCHED
}
}

#define XB_TMO      128
#define XB_XCNT(j)  (256  + 64 * (j))
#define XB_XSUB(j)  (1280 + 64 * (j))
#define XB_XGEN(j)  (2304 + 64 * (j))
#define XB_TOP      3328
#define XB_TOPGEN   3392
#define XCD_BAR_WORDS 3456
#define XB_SPIN_CAP (1u << 22)
__device__ __forceinline__ unsigned xb_ld(unsigned* p)              { return __hip_atomic_load(p, __ATOMIC_RELAXED, __HIP_MEMORY_SCOPE_AGENT); }
__device__ __forceinline__ unsigned xb_add(unsigned* p, unsigned v) { return __hip_atomic_fetch_add(p, v, __ATOMIC_RELAXED, __HIP_MEMORY_SCOPE_AGENT); }
__device__ __forceinline__ unsigned xb_xcc_id() { return (unsigned)__builtin_amdgcn_s_getreg((3 << 11) | 20) & 0xFu; }
#define XB_SPIN(cond, bar) do { unsigned _sp = 0; while (cond) { __builtin_amdgcn_s_sleep(1); \
    if ((++_sp & 255u) == 0u) { if (xb_ld(&(bar)[XB_TMO])) break; if (_sp > XB_SPIN_CAP) { atomicAdd(&(bar)[XB_TMO], 1u); break; } } } } while (0)
struct XcdBarrier { unsigned* bar; unsigned x; volatile LAS unsigned* st; };
__device__ __forceinline__ XcdBarrier xcd_barrier_post(unsigned* bar, volatile LAS unsigned* st) {
    XcdBarrier b; b.bar = bar; b.x = xb_xcc_id(); b.st = st;
    if (threadIdx.x == 0) (void)xb_add(&bar[XB_XCNT(b.x)], 1u);
    return b;
}
__device__ __forceinline__ void xcd_barrier_complete(unsigned* bar, unsigned x, unsigned& nloc, unsigned& nx) {
    const unsigned G = gridDim.x * gridDim.y * gridDim.z;
    unsigned sum, cnt, mine, sp = 0u;
    for (;;) {
        sum = 0u; cnt = 0u; mine = 0u;
#pragma unroll
        for (unsigned j = 0; j < 16; ++j) { const unsigned c = xb_ld(&bar[XB_XCNT(j)]); sum += c; cnt += (c > 0u) ? 1u : 0u; mine = (j == x) ? c : mine; }
        if (sum == G) break;
        __builtin_amdgcn_s_sleep(1);
        if ((++sp & 255u) == 0u) { if (xb_ld(&bar[XB_TMO])) break; if (sp > XB_SPIN_CAP) { atomicAdd(&bar[XB_TMO], 1u); break; } }
    }
    nloc = mine > 0u ? mine : 1u; nx = cnt > 0u ? cnt : 1u;
}
__device__ __forceinline__ void xcd_barrier(const XcdBarrier& b) {
    asm volatile("s_waitcnt vmcnt(0)" ::: "memory");
    __syncthreads();
    if (threadIdx.x == 0) {
        unsigned* bar = b.bar;
        __builtin_amdgcn_s_waitcnt(0);
        unsigned nloc = b.st[0], nx = b.st[1];
        if (nloc == 0u) { xcd_barrier_complete(bar, b.x, nloc, nx); b.st[0] = nloc; b.st[1] = nx; }
        const unsigned old = xb_add(&bar[XB_XSUB(b.x)], 1u);
        const unsigned gen = old / nloc;
        if (old + 1u == (gen + 1u) * nloc) {
            __builtin_amdgcn_fence(__ATOMIC_RELEASE, "agent");
            asm volatile("s_waitcnt vmcnt(0)" ::: "memory");
            const unsigned og = xb_add(&bar[XB_TOP], 1u);
            const unsigned tg = og / nx;
            if (og + 1u == (tg + 1u) * nx) xb_add(&bar[XB_TOPGEN], 1u);
            else XB_SPIN(xb_ld(&bar[XB_TOPGEN]) == tg, bar);
            __builtin_amdgcn_fence(__ATOMIC_ACQUIRE, "agent");
            xb_add(&bar[XB_XGEN(b.x)], 1u);
            asm volatile("s_waitcnt vmcnt(0)" ::: "memory");
        } else {
            XB_SPIN(xb_ld(&bar[XB_XGEN(b.x)]) == gen, bar);
            __builtin_amdgcn_fence(__ATOMIC_ACQUIRE, "agent");
            asm volatile("s_waitcnt vmcnt(0)" ::: "memory");
        }
    }
    __syncthreads();
}

struct Args { const float* in[39]; float* out; unsigned char* ws; int ph_lo, ph_hi; };
struct Frame {
    LAS unsigned char* lds;
    int tid, lane, wave, G, bx;
    const float* const* in; float* out; unsigned char* ws;
    GAS unsigned* ctl;
};
#define IN_X 0
#define IN_C 1
#define IN_CTX 2
#define IN_CCTX 3
#define IN_WADA 4
#define IN_BADA 5
#define IN_N1G 6
#define IN_N2G 7
#define IN_WIN 8
#define IN_LRE 9
#define IN_LIM 10
#define IN_LDT 11
#define IN_BRE 12
#define IN_BIM 13
#define IN_CRE 14
#define IN_CIM 15
#define IN_S5D 16
#define IN_WGLU 17
#define IN_HSW 18
#define IN_HW1 19
#define IN_HB1 20
#define IN_HF1 21
#define IN_HW2 22
#define IN_HB2 23
#define IN_HF2 24
#define IN_HW3 25
#define IN_HB3 26
#define IN_HDEC 27
#define IN_HBIAS 28
#define IN_WBS5 29
#define IN_WBHY 30
#define IN_WO 31
#define IN_RW 32
#define IN_RB 33
#define IN_WGU 34
#define IN_BGU 35
#define IN_WDN 36
#define IN_BDN 37
#define IN_FG 38

__device__ __forceinline__ void p0_adaln_item(Frame& F, int cb) {
    LAS float* sl = (LAS float*)F.lds;
    const float* c = F.in[IN_C]; const float* cc = F.in[IN_CCTX]; const float* W = F.in[IN_WADA];
    for (int i = F.tid; i < 3 * 2048; i += NTHR) { const int v = i >> 11, k = i & 2047; const float cv = (v < 2) ? c[v * 2048 + k] : cc[k]; sl[i] = cv * sigmoidf_(cv); }
    __syncthreads();
    const int col = F.tid % 48, ks = F.tid / 48;
    float a0 = 0.f, a1 = 0.f, a2 = 0.f;
    if (ks < 10) { const float* wp = W + 48 * cb + col;
#pragma unroll 16
        for (int j = 0; j < 205; ++j) { const int k = ks + 10 * j; if (k < 2048) { const float w = wp[(size_t)k * 12288]; a0 += sl[k] * w; a1 += sl[2048 + k] * w; a2 += sl[4096 + k] * w; } } }
    LAS float* red = sl + 6144;
    if (ks < 10) { red[(ks * 48 + col) * 3 + 0] = a0; red[(ks * 48 + col) * 3 + 1] = a1; red[(ks * 48 + col) * 3 + 2] = a2; }
    __syncthreads();
    if (F.tid < 144) { const int v = F.tid / 48, cl = F.tid % 48; float sacc = 0.f;
#pragma unroll
        for (int q = 0; q < 10; ++q) sacc += red[(q * 48 + cl) * 3 + v];
        ((float*)(F.ws + WS_MOD))[v * 12288 + 48 * cb + cl] = sacc + F.in[IN_BADA][48 * cb + cl]; }
    __syncthreads();
}
__device__ __forceinline__ void p0_filt_item(Frame& F, int tb) {
    LAS float* ft = (LAS float*)F.lds;
    LAS float* h1 = ft + 64 * 36;
    LAS float* h2 = h1 + 64 * 65;
    const int t0 = tb * 64, tl = F.tid >> 3, q = F.tid & 7; const float tf = (float)(t0 + tl);
    for (int f = q; f < 33; f += 8) {
        float v;
        if (f == 0) v = tf * (1.0f / 16383.0f);
        else { const int bi = (f - 1) & 15; const float band = 1e-4f + (float)bi * ((15.0f - 1e-4f) / 15.0f); const float rev = tf * band * (1.0f / 16384.0f);
               v = (f <= 16) ? cos_rev(rev) : -sin_rev(rev); }
        ft[tl * 36 + f] = v;
    }
    LAS float* w1s = ft + 13312; LAS float* w2s = w1s + 33 * 64;
    for (int i = F.tid; i < 33 * 64; i += NTHR) w1s[i] = F.in[IN_HW1][i];
    for (int i = F.tid; i < 64 * 64; i += NTHR) w2s[i] = F.in[IN_HW2][i];
    __syncthreads();
    { const float* b1 = F.in[IN_HB1]; const float* f1 = F.in[IN_HF1]; float a[8];
#pragma unroll
      for (int jj = 0; jj < 8; ++jj) a[jj] = b1[q * 8 + jj];
#pragma unroll 11
      for (int f = 0; f < 33; ++f) { const float xv = ft[tl * 36 + f]; const f32x4 wa = *(const LAS f32x4*)(w1s + f * 64 + q * 8), wb = *(const LAS f32x4*)(w1s + f * 64 + q * 8 + 4);
          a[0] += xv * wa.x; a[1] += xv * wa.y; a[2] += xv * wa.z; a[3] += xv * wa.w; a[4] += xv * wb.x; a[5] += xv * wb.y; a[6] += xv * wb.z; a[7] += xv * wb.w; }
#pragma unroll
      for (int jj = 0; jj < 8; ++jj) { const int j = q * 8 + jj; h1[tl * 65 + j] = sin_rev(f1[j] * a[jj] * 0.15915494309189535f); } }
    __syncthreads();
    { const float* b2 = F.in[IN_HB2]; const float* f2 = F.in[IN_HF2]; float a[8];
#pragma unroll
      for (int jj = 0; jj < 8; ++jj) a[jj] = b2[q * 8 + jj];
#pragma unroll 16
      for (int i = 0; i < 64; ++i) { const float xv = h1[tl * 65 + i]; const f32x4 wa = *(const LAS f32x4*)(w2s + i * 64 + q * 8), wb = *(const LAS f32x4*)(w2s + i * 64 + q * 8 + 4);
          a[0] += xv * wa.x; a[1] += xv * wa.y; a[2] += xv * wa.z; a[3] += xv * wa.w; a[4] += xv * wb.x; a[5] += xv * wb.y; a[6] += xv * wb.z; a[7] += xv * wb.w; }
#pragma unroll
      for (int jj = 0; jj < 8; ++jj) { const int j = q * 8 + jj; h2[tl * 64 + j] = sin_rev(f2[j] * a[jj] * 0.15915494309189535f); } }
    __syncthreads();
    LAS unsigned short* hb = (LAS unsigned short*)(h2 + 64 * 64);
    for (int i = F.tid; i < 64 * 64; i += NTHR) hb[(i >> 6) * 72 + (i & 63)] = (unsigned short)f2bf(h2[i]);
    __syncthreads();
    const float* w3 = F.in[IN_HW3]; const float* b3 = F.in[IN_HB3]; const float* dec = F.in[IN_HDEC]; bf16* FILT = (bf16*)(F.ws + WS_FILT);
    const int fr = F.lane & 15, fq = F.lane >> 4;
    bf16x8 af[4][2];
#pragma unroll
    for (int m = 0; m < 4; ++m)
#pragma unroll
        for (int ks = 0; ks < 2; ++ks) af[m][ks] = *(const LAS bf16x8*)(hb + (16 * m + fr) * 72 + 32 * ks + 8 * fq);
#pragma unroll 4
    for (int jt = F.wave; jt < 256; jt += NWAVES) {
        const int j = 16 * jt + fr;
        bf16x8 bfr[2];
#pragma unroll
        for (int ks = 0; ks < 2; ++ks) { float w[8];
#pragma unroll
            for (int e = 0; e < 8; ++e) w[e] = w3[(size_t)(32 * ks + 8 * fq + e) * 4096 + j];
            u32x4 pk; pk.x = pk2(w[0], w[1]); pk.y = pk2(w[2], w[3]); pk.z = pk2(w[4], w[5]); pk.w = pk2(w[6], w[7]); bfr[ks] = __builtin_bit_cast(bf16x8, pk); }
        const float bb = b3[j], dd = fabsf(dec[j]) * (1.0f / 16383.0f);
#pragma unroll
        for (int m = 0; m < 4; ++m) { f32x4 acc = (f32x4){0.f, 0.f, 0.f, 0.f};
#pragma unroll
            for (int ks = 0; ks < 2; ++ks) acc = __builtin_amdgcn_mfma_f32_16x16x32_bf16(af[m][ks], bfr[ks], acc, 0, 0, 0);
            const int tb0 = t0 + 16 * m + 4 * fq; f32x4 o;
#pragma unroll
            for (int e = 0; e < 4; ++e) o[e] = (acc[e] + bb) * __expf(-(float)(tb0 + e) * dd);
            *(u32x2*)(FILT + (size_t)j * SEQ + tb0) = (u32x2){cvt_pk_bf16(o[0], o[1]), cvt_pk_bf16(o[2], o[3])}; }
    }
    __syncthreads();
}
__device__ __forceinline__ void p0_s5tab_item(Frame& F, int item) {
    const int idx = item * NTHR + F.tid; const int d = idx >> 12, g = (idx >> 6) & 63, p = idx & 63, dg = d * 64 + g;
    const float lr = F.in[IN_LRE][dg * 64 + p], li = F.in[IN_LIM][dg * 64 + p], dt = expf(F.in[IN_LDT][dg]);
    const float mag = expf(lr * dt), ang = li * dt; const float lbr = mag * cosf(ang), lbi = mag * sinf(ang);
    const float den = lr * lr + li * li, cr = ((lbr - 1.f) * lr + lbi * li) / den, ci = (lbi * lr - (lbr - 1.f) * li) / den;
    bf16* BBT = (bf16*)(F.ws + WS_BBT); bf16* BB2 = (bf16*)(F.ws + WS_BB2); bf16* CTT = (bf16*)(F.ws + WS_CTT); f32x2* LAM = (f32x2*)(F.ws + WS_LAM);
    const float* bre = F.in[IN_BRE] + (size_t)(dg * 64 + p) * 16; const float* bim = F.in[IN_BIM] + (size_t)(dg * 64 + p) * 16;
    for (int c = 0; c < 16; ++c) { const float br = bre[c], bi = bim[c];
        BBT[(size_t)(dg * 128 + p) * 16 + c] = (bf16)f2bf(cr * br - ci * bi); BBT[(size_t)(dg * 128 + 64 + p) * 16 + c] = (bf16)f2bf(cr * bi + ci * br);
        BB2[(size_t)(dg * 128 + 2 * p) * 16 + c] = (bf16)f2bf(cr * br - ci * bi); BB2[(size_t)(dg * 128 + 2 * p + 1) * 16 + c] = (bf16)f2bf(cr * bi + ci * br); }
    const int k = 2 * p;
    for (int c = 0; c < 16; ++c) { const float cre = F.in[IN_CRE][(size_t)(dg * 16 + c) * 64 + p], cim = F.in[IN_CIM][(size_t)(dg * 16 + c) * 64 + p];
        CTT[(size_t)(dg * 16 + c) * 128 + k] = (bf16)f2bf(cre); CTT[(size_t)(dg * 16 + c) * 128 + k + 1] = (bf16)f2bf(-cim); }
    LAM[dg * 64 + p] = (f32x2){lbr, lbi};
}
__device__ __forceinline__ void p0_transpose_item(const float* W, int K, int N, bf16* WT, LAS unsigned short* scr, int kb, int nb, int lane) {
    const int k0 = 64 * kb, n0 = 128 * nb;
    const float* wp = W + (size_t)(k0 + (lane >> 5)) * N + n0 + 4 * (lane & 31);
#pragma unroll
    for (int half = 0; half < 2; ++half) { f32x4 v[16];
#pragma unroll
        for (int i = 0; i < 16; ++i) v[i] = *(const GAS f32x4*)(wp + (size_t)(32 * half + 2 * i) * N);
#pragma unroll
        for (int i = 0; i < 16; ++i) { const int kk = 32 * half + 2 * i + (lane >> 5); LAS unsigned* d = (LAS unsigned*)(scr + kk * 130 + 4 * (lane & 31)); d[0] = pk2(v[i].x, v[i].y); d[1] = pk2(v[i].z, v[i].w); } }
    LDS_WAIT(); asm volatile("" ::: "memory");
    const int c = lane & 7;
#pragma unroll
    for (int j = 0; j < 16; ++j) { const int r = (lane >> 3) + 8 * j; const LAS unsigned short* sp = scr + (8 * c) * 130 + r;
        u32x4 o; o.x = (unsigned)sp[0] | ((unsigned)sp[130] << 16); o.y = (unsigned)sp[2 * 130] | ((unsigned)sp[3 * 130] << 16); o.z = (unsigned)sp[4 * 130] | ((unsigned)sp[5 * 130] << 16); o.w = (unsigned)sp[6 * 130] | ((unsigned)sp[7 * 130] << 16);
        *(GAS u32x4*)(WT + (size_t)(n0 + r) * K + k0 + 8 * c) = o; }
    LDS_WAIT(); asm volatile("" ::: "memory");
}
__device__ __forceinline__ void p0_transpose_item8(const float* W, int K, int N, unsigned char* WT, LAS unsigned short* scr, int kb, int nb, int lane) {
    const int k0 = 64 * kb, n0 = 128 * nb;
    const float* wp = W + (size_t)(k0 + (lane >> 5)) * N + n0 + 4 * (lane & 31);
#pragma unroll
    for (int half = 0; half < 2; ++half) { f32x4 v[16];
#pragma unroll
        for (int i = 0; i < 16; ++i) v[i] = *(const GAS f32x4*)(wp + (size_t)(32 * half + 2 * i) * N);
#pragma unroll
        for (int i = 0; i < 16; ++i) { const int kk = 32 * half + 2 * i + (lane >> 5); LAS unsigned* d = (LAS unsigned*)(scr + kk * 130 + 4 * (lane & 31)); d[0] = pk2(v[i].x, v[i].y); d[1] = pk2(v[i].z, v[i].w); } }
    LDS_WAIT(); asm volatile("" ::: "memory");
    const int c = lane & 7;
#pragma unroll
    for (int j = 0; j < 16; ++j) { const int r = (lane >> 3) + 8 * j; const LAS unsigned short* sp = scr + (8 * c) * 130 + r;
        u32x2 o; o.x = pk4_fp8(bf2f(sp[0]) * W8SCALE, bf2f(sp[130]) * W8SCALE, bf2f(sp[2 * 130]) * W8SCALE, bf2f(sp[3 * 130]) * W8SCALE);
        o.y = pk4_fp8(bf2f(sp[4 * 130]) * W8SCALE, bf2f(sp[5 * 130]) * W8SCALE, bf2f(sp[6 * 130]) * W8SCALE, bf2f(sp[7 * 130]) * W8SCALE);
        *(GAS u32x2*)(WT + (size_t)(n0 + r) * K + k0 + 8 * c) = o; }
    LDS_WAIT(); asm volatile("" ::: "memory");
}
__device__ __forceinline__ void p0_transpose_item8d(const float* W, int K, int N, unsigned char* WT, LAS unsigned short* scr, int kb, int nb, int lane) {
    const int k0 = 64 * kb, n0 = 128 * nb;
    const float* wp = W + (size_t)(k0 + (lane >> 5)) * N + n0 + 4 * (lane & 31);
    f32x4 v[32];
#pragma unroll
    for (int i = 0; i < 32; ++i) v[i] = *(const GAS f32x4*)(wp + (size_t)(2 * i) * N);
#pragma unroll
    for (int i = 0; i < 32; ++i) { const int kk = 2 * i + (lane >> 5); LAS unsigned* d = (LAS unsigned*)(scr + kk * 130 + 4 * (lane & 31)); d[0] = pk2(v[i].x, v[i].y); d[1] = pk2(v[i].z, v[i].w); }
    LDS_WAIT(); asm volatile("" ::: "memory");
    const int c = lane & 7;
#pragma unroll
    for (int j = 0; j < 16; ++j) { const int r = (lane >> 3) + 8 * j; const LAS unsigned short* sp = scr + (8 * c) * 130 + r;
        u32x2 o; o.x = pk4_fp8(bf2f(sp[0]) * W8SCALE, bf2f(sp[130]) * W8SCALE, bf2f(sp[2 * 130]) * W8SCALE, bf2f(sp[3 * 130]) * W8SCALE);
        o.y = pk4_fp8(bf2f(sp[4 * 130]) * W8SCALE, bf2f(sp[5 * 130]) * W8SCALE, bf2f(sp[6 * 130]) * W8SCALE, bf2f(sp[7 * 130]) * W8SCALE);
        *(GAS u32x2*)(WT + (size_t)(n0 + r) * K + k0 + 8 * c) = o; }
    LDS_WAIT(); asm volatile("" ::: "memory");
}
__device__ __forceinline__ void moe_weight_queue(Frame& F) {
    constexpr int W_GU1 = 32 * 32, W_DN1 = 16 * 32, W_GU = 32 * W_GU1, W_DN = 32 * W_DN1;
    LAS unsigned short* scr = (LAS unsigned short*)(F.lds + F.wave * 16640);
    const int lane = F.lane;
    __syncthreads();
    for (;;) {
        int r0 = 0;
        if (lane == 0) r0 = (int)__hip_atomic_fetch_add((unsigned*)(F.ctl + CW_QT), 4u, __ATOMIC_RELAXED, __HIP_MEMORY_SCOPE_AGENT);
        r0 = __builtin_amdgcn_readfirstlane(r0);
        if (r0 >= W_GU + W_DN) break;
#pragma unroll 1
        for (int sub = 0; sub < 4; ++sub) { const int r = r0 + sub;
            const float* W; unsigned char* WT; int N, kb, nb;
            if (r < W_GU) { const int e = r / W_GU1, q = r % W_GU1; W = F.in[IN_WGU] + (size_t)e * 2048 * 4096; WT = (unsigned char*)(F.ws + WS_WGU) + (size_t)e * 4096 * 2048; N = 4096; kb = q & 31; nb = q >> 5; }
            else { const int rr = r - W_GU; const int e = rr / W_DN1, q = rr % W_DN1; W = F.in[IN_WDN] + (size_t)e * 2048 * 2048; WT = (unsigned char*)(F.ws + WS_WDN) + (size_t)e * 2048 * 2048; N = 2048; kb = q & 31; nb = q >> 5; }
            const int K = 2048, k0 = 64 * kb, n0 = 128 * nb;
            const float* wp = W + (size_t)(k0 + (lane >> 5)) * N + n0 + 4 * (lane & 31);
            f32x4 v[32];
#pragma unroll
            for (int i = 0; i < 32; ++i) v[i] = __builtin_nontemporal_load((const GAS f32x4*)(wp + (size_t)(2 * i) * N));
            LAS unsigned char* sb = (LAS unsigned char*)scr;
#pragma unroll
            for (int i = 0; i < 32; ++i) { const int kk = 2 * i + (lane >> 5); *(LAS unsigned*)(sb + kk * 132 + 4 * (lane & 31)) = pk4_fp8(v[i].x * W8SCALE, v[i].y * W8SCALE, v[i].z * W8SCALE, v[i].w * W8SCALE); }
            LDS_WAIT(); asm volatile("" ::: "memory");
            const int c = lane & 7;
#pragma unroll
            for (int j = 0; j < 16; ++j) { const int rw = (lane >> 3) + 8 * j; const LAS unsigned char* sp = sb + (8 * c) * 132 + rw;
                u32x2 o; o.x = (unsigned)sp[0] | ((unsigned)sp[132] << 8) | ((unsigned)sp[2 * 132] << 16) | ((unsigned)sp[3 * 132] << 24);
                o.y = (unsigned)sp[4 * 132] | ((unsigned)sp[5 * 132] << 8) | ((unsigned)sp[6 * 132] << 16) | ((unsigned)sp[7 * 132] << 24);
                __builtin_nontemporal_store(o, (GAS u32x2*)(WT + (size_t)(n0 + rw) * K + k0 + 8 * c)); }
            LDS_WAIT(); asm volatile("" ::: "memory");
        }
    }
    __syncthreads();
}
__device__ __forceinline__ void p0_prologue(Frame& F) {
    for (int it = F.bx; it < 256; it += F.G) p0_adaln_item(F, it);
    for (int it = F.bx; it < 256; it += F.G) p0_filt_item(F, it);
    for (int it = F.bx; it < 16; it += F.G) p0_s5tab_item(F, it);
    { const float* rw = F.in[IN_RW]; float* RWT = (float*)(F.ws + WS_RWT);
      for (int i = F.bx * NTHR + F.tid; i < 32 * 2048; i += F.G * NTHR) { const int e = i >> 11, k = i & 2047; RWT[i] = rw[k * 32 + e]; } }
    __syncthreads();
    LAS unsigned short* scr = (LAS unsigned short*)(F.lds + F.wave * 16640);
    constexpr int I_IN = 64 * 4, I_GLU = 8 * 2, I_BS5 = 16 * 2, I_BHY = 16 * 2, I_O = 16 * 4;
    constexpr int NITEMS = I_IN + I_GLU + I_BS5 + I_BHY + I_O;
    const int w = F.wave;
    for (int it = F.bx; it < NITEMS; it += F.G) {
        int r = it;
        if (r < I_IN) { if ((r >> 2) < 32) p0_transpose_item(F.in[IN_WIN], 2048, 8192, (bf16*)(F.ws + WS_WIN), scr, 8 * (r & 3) + w, r >> 2, F.lane);
                        else p0_transpose_item8(F.in[IN_WIN], 2048, 8192, (unsigned char*)(F.ws + WS_WIN8) - (size_t)4096 * 2048, scr, 8 * (r & 3) + w, r >> 2, F.lane); continue; } r -= I_IN;
        if (r < I_GLU) { p0_transpose_item(F.in[IN_WGLU], 1024, 1024, (bf16*)(F.ws + WS_WGLU), scr, 8 * (r & 1) + w, r >> 1, F.lane); continue; } r -= I_GLU;
        if (r < I_BS5) { p0_transpose_item(F.in[IN_WBS5], 1024, 2048, (bf16*)(F.ws + WS_WBS5), scr, 8 * (r & 1) + w, r >> 1, F.lane); continue; } r -= I_BS5;
        if (r < I_BHY) { p0_transpose_item(F.in[IN_WBHY], 1024, 2048, (bf16*)(F.ws + WS_WBHY), scr, 8 * (r & 1) + w, r >> 1, F.lane); continue; } r -= I_BHY;
        { p0_transpose_item8(F.in[IN_WO], 2048, 2048, (unsigned char*)(F.ws + WS_WO), scr, 8 * (r & 3) + w, r >> 2, F.lane); }
    }
}

__device__ __forceinline__ void p1_norm(Frame& F) {
    const int gw = F.bx * NWAVES + F.wave, NGW = F.G * NWAVES;
    const float* MOD = (const float*)(F.ws + WS_MOD); const float* g1n = F.in[IN_N1G];
    bf16* U = (bf16*)(F.ws + WS_U);
    int curv = -1; f32x4 ga[8], sh[8];
    for (int m = gw; m < NTOK + NCTX; m += NGW) {
        const int v = (m < NTOK) ? (m >> 14) : 2;
        if (v != curv) { curv = v;
#pragma unroll
            for (int j = 0; j < 8; ++j) { const int k = 4 * F.lane + 256 * j; const f32x4 g = *(const f32x4*)(g1n + k), sc = *(const f32x4*)(MOD + v * 12288 + 2048 + k); ga[j] = g * (sc + 1.0f); sh[j] = *(const f32x4*)(MOD + v * 12288 + k); } }
        const float* xr = (m < NTOK) ? (F.in[IN_X] + (size_t)m * D) : (F.in[IN_CTX] + (size_t)(m - NTOK) * D);
        f32x4 x[8]; float s = 0.f;
#pragma unroll
        for (int j = 0; j < 8; ++j) { x[j] = *(const GAS f32x4*)(xr + 4 * F.lane + 256 * j); s += (x[j].x * x[j].x + x[j].y * x[j].y) + (x[j].z * x[j].z + x[j].w * x[j].w); }
        const float rstd = 1.0f / sqrtf(wave_sum(s) * (1.0f / D) + 1e-6f);
        GAS u32x2* o = (GAS u32x2*)(U + (size_t)m * D) + F.lane; GAS unsigned* o8 = (GAS unsigned*)(F.ws + WS_U8 + (size_t)m * D) + F.lane;
#pragma unroll
        for (int j = 0; j < 8; ++j) { const f32x4 y = x[j] * rstd * ga[j] + sh[j]; o[64 * j] = (u32x2){pk2(y.x, y.y), pk2(y.z, y.w)}; if (m < NTOK) o8[64 * j] = pk4_fp8(y.x, y.y, y.z, y.w); }
    }
}

struct SchedIn {
    int G, c, nmain, npn, mode, nrep;
    const char* A; const char* Bt;
    __device__ __forceinline__ bool next(int i, pg8::Unit& u) const {
        int L = i * G + c; u.e = 0; u.valid = 256; { const int tot = nmain + (mode == 0 ? 8 : 0); if (nrep > 1 && L >= tot && L < 2 * tot) L -= tot; }
        if (L < nmain) {
            int wgid = L; { const int q = nmain / 8, xcd = wgid % 8, off = wgid / 8; wgid = xcd * q + off; }
            const int nig = 8 * npn, gid = wgid / nig; const int pm = gid * 8 + ((wgid % nig) % 8), pl = (wgid % nig) / 8;
            u.pm = pm; u.pn = (mode == 0) ? pl : (mode == 1 ? pl + 4 : pl + 16); return true;
        }
        if (mode == 0 && L < nmain + 8) { const int q = L - nmain; u.pm = 128 + (q >> 2); u.pn = q & 3; return true; }
        return false;
    }
    __device__ __forceinline__ unsigned a_row(const pg8::Unit& u, int r) const { return (u.pm < 128) ? (unsigned)((u.pm >> 6) * SEQ + r * 64 + (u.pm & 63)) : (unsigned)(NTOK + (u.pm - 128) * 256 + r); }
    __device__ __forceinline__ const char* a_base() const { return A; }
    __device__ __forceinline__ const char* b_base(const pg8::Unit& u) const { return (mode == 2) ? Bt + (size_t)(u.pn - 16) * 256 * D : Bt + (size_t)u.pn * 256 * D * 2; }
};
__device__ __forceinline__ unsigned q8(float s) { return (unsigned)(s * 255.0f + 0.5f); }
struct EpiInG8 {
    static constexpr bool PERM = true, TRANS = true, FP8 = true;
    unsigned char* UG;
    __device__ __forceinline__ void operator()(const f32x4 (&acc)[2][2][4][2], const pg8::Unit& u, int wr, int wc, int fr, int fq) const {
        const int col0 = (u.pn - 16) * 256 + wc * 32 + 8 * fq;
#pragma unroll
        for (int ai = 0; ai < 2; ++ai)
#pragma unroll
            for (int m = 0; m < 4; ++m) { const int r = ai * 128 + wr * 64 + m * 16 + fr; const size_t row = (size_t)((u.pm >> 6) * SEQ + r * 64 + (u.pm & 63));
                unsigned char* rowp = UG + row * 4096 + col0;
#pragma unroll
                for (int bj = 0; bj < 2; ++bj) { f32x4 v0 = acc[ai][bj][m][0] * (1.0f / W8SCALE), v1 = acc[ai][bj][m][1] * (1.0f / W8SCALE);
#pragma unroll
                    for (int j = 0; j < 4; ++j) { v0[j] = sigmoidf_(v0[j]); v1[j] = sigmoidf_(v1[j]); }
                    u32x2 w; w.x = q8(v0[0]) | (q8(v0[1]) << 8) | (q8(v0[2]) << 16) | (q8(v0[3]) << 24); w.y = q8(v1[0]) | (q8(v1[1]) << 8) | (q8(v1[2]) << 16) | (q8(v1[3]) << 24);
                    *(u32x2*)(rowp + bj * 128) = w; } }
    }
};
struct EpiInA {
    static constexpr bool PERM = true, TRANS = true, FP8 = false;
    unsigned char* ws;
    __device__ __forceinline__ void operator()(const f32x4 (&acc)[2][2][4][2], const pg8::Unit& u, int wr, int wc, int fr, int fq) const {
        const bool isctx = u.pm >= 128, isg = u.pn >= 16;
        const size_t boff = isctx ? WS_UCA : (isg ? WS_UG : WS_UA);
        bf16* base = (bf16*)(ws + boff); const size_t ld = isg ? 4096 : S5W; const int colt = isg ? (u.pn - 16) * 256 : u.pn * 256;
        const int col0 = colt + wc * 32 + 8 * fq;
#pragma unroll
        for (int ai = 0; ai < 2; ++ai)
#pragma unroll
            for (int m = 0; m < 4; ++m) { const int r = ai * 128 + wr * 64 + m * 16 + fr;
                const size_t row = isctx ? (size_t)((u.pm - 128) * 256 + r) : (size_t)((u.pm >> 6) * SEQ + r * 64 + (u.pm & 63));
                bf16* rowp = base + row * ld + col0;
#pragma unroll
                for (int bj = 0; bj < 2; ++bj) { f32x4 v0 = acc[ai][bj][m][0], v1 = acc[ai][bj][m][1];
                    if (isg) {
#pragma unroll
                        for (int j = 0; j < 4; ++j) { v0[j] = sigmoidf_(v0[j]); v1[j] = sigmoidf_(v1[j]); } }
                    u32x4 w; w.x = cvt_pk_bf16(v0[0], v0[1]); w.y = cvt_pk_bf16(v0[2], v0[3]); w.z = cvt_pk_bf16(v1[0], v1[1]); w.w = cvt_pk_bf16(v1[2], v1[3]);
                    *(u32x4*)(rowp + bj * 128) = w; } }
    }
};
struct EpiInH {
    static constexpr bool PERM = false, TRANS = false, FP8 = false;
    bf16* UH;
    __device__ __forceinline__ void operator()(const f32x4 (&acc)[2][2][4][2], const pg8::Unit& u, int wr, int wc, int fr, int fq) const {
        const int b = u.pm >> 6, w = u.pm & 63;
#pragma unroll
        for (int bj = 0; bj < 2; ++bj)
#pragma unroll
            for (int n = 0; n < 2; ++n) { const int ch = (u.pn - 4) * 256 + bj * 128 + wc * 32 + n * 16 + fr;
                bf16* cp = UH + ((size_t)(b * 3072 + ch) * SEQ + w * 256);
#pragma unroll
                for (int ai = 0; ai < 2; ++ai)
#pragma unroll
                    for (int m = 0; m < 4; ++m) { const int r0 = ai * 128 + wr * 64 + m * 16 + 4 * fq; const f32x4 v = acc[ai][bj][m][n];
                        *(u32x2*)(cp + r0) = (u32x2){cvt_pk_bf16(v[0], v[1]), cvt_pk_bf16(v[2], v[3])}; } }
    }
};

template <bool PASSB>
__device__ __forceinline__ void s5_pass(Frame& F) {
    constexpr int nk = PASSB ? 256 : 260;
    constexpr int nitems = 2 * nk * 8;
    LAS unsigned char* sl = F.lds + F.wave * 8704;
    const int lane = F.lane, pl = lane & 31, hi = lane >> 5, fr = lane & 15, fq = lane >> 4;
    const bf16* UA = (const bf16*)(F.ws + WS_UA); const bf16* UCA = (const bf16*)(F.ws + WS_UCA);
    const bf16* BBT = (const bf16*)(F.ws + WS_BBT); const bf16* CTT = (const bf16*)(F.ws + WS_CTT); const f32x2* LAM = (const f32x2*)(F.ws + WS_LAM);
    f32x2* EB = (f32x2*)(F.ws + WS_E); const f32x2* SINB = (const f32x2*)(F.ws + WS_SIN); bf16* Y = (bf16*)(F.ws + WS_Y);
    const int s_r = 16 * ((pl >> 2) & 1) + 4 * (pl >> 3) + (pl & 3);
    for (int it = F.bx; it < nitems; it += F.G) {
        const int gq = it & 7, rest = it >> 3; const int b = rest / nk, kk = rest % nk; const int kc = PASSB ? kk + 4 : kk;
        const int g = gq * 8 + F.wave;
        const bf16* urow = (kc < 4) ? (UCA + (size_t)(b * CTX + kc * 64) * S5W + 16 * g) : (UA + (size_t)(b * SEQ + (kc - 4) * 64) * S5W + 16 * g);
        f32x4 yacc[4];
#pragma unroll
        for (int q = 0; q < 4; ++q) yacc[q] = (f32x4){0.f, 0.f, 0.f, 0.f};
#pragma unroll
        for (int d = 0; d < 2; ++d) {
            const int dg = d * 64 + g;
            bf16x8 bb[4];
#pragma unroll
            for (int ni = 0; ni < 4; ++ni) bb[ni] = *(const bf16x8*)(BBT + (size_t)(dg * 128 + 32 * ni + pl) * 16 + 8 * hi);
            bf16x8 ct[4];
            if (PASSB) {
#pragma unroll
                for (int ks = 0; ks < 4; ++ks) ct[ks] = *(const bf16x8*)(CTT + (size_t)(dg * 16 + fr) * 128 + 32 * ks + 8 * fq);
            }
            const f32x2 lamA = LAM[dg * 64 + pl], lamB = LAM[dg * 64 + pl + 32];
            f32x2 l2 = cmul(lamA, lamA), l4 = cmul(l2, l2), l8 = cmul(l4, l4); const f32x2 lam16A = cmul(l8, l8);
            l2 = cmul(lamB, lamB); l4 = cmul(l2, l2); l8 = cmul(l4, l4); const f32x2 lam16B = cmul(l8, l8);
            f32x2 cA = (f32x2){0.f, 0.f}, cB = (f32x2){0.f, 0.f};
            const size_t sidx = ((size_t)((d * 2 + b) * NCH + kc)) * 4096 + g * 64 + pl;
            if (PASSB) { cA = SINB[sidx]; cB = SINB[sidx + 32]; }
#pragma unroll
            for (int sc = 0; sc < 2; ++sc) {
                const int iscan = 32 * sc + s_r; const int tok = (d == 0) ? iscan : 63 - iscan;
                const bf16x8 a = *(const bf16x8*)(urow + (size_t)tok * S5W + 8 * hi);
                f32x16 acc[4];
#pragma unroll
                for (int ni = 0; ni < 4; ++ni) { f32x16 z;
#pragma unroll
                    for (int i = 0; i < 16; ++i) z[i] = 0.f;
                    acc[ni] = __builtin_amdgcn_mfma_f32_32x32x16_bf16(a, bb[ni], z, 0, 0, 0); }
                asm volatile("s_nop 7\n\ts_nop 7" : "+v"(acc[0]), "+v"(acc[1]), "+v"(acc[2]), "+v"(acc[3]) : "v"(a), "v"(bb[0]), "v"(bb[1]), "v"(bb[2]), "v"(bb[3]));
                f32x2 sA = hi ? (f32x2){0.f, 0.f} : cA, sB = hi ? (f32x2){0.f, 0.f} : cB;
#pragma unroll
                for (int i = 0; i < 16; ++i) {
                    sA = (f32x2){lamA.x * sA.x - lamA.y * sA.y + acc[0][i], lamA.x * sA.y + lamA.y * sA.x + acc[2][i]}; acc[0][i] = sA.x; acc[2][i] = sA.y;
                    sB = (f32x2){lamB.x * sB.x - lamB.y * sB.y + acc[1][i], lamB.x * sB.y + lamB.y * sB.x + acc[3][i]}; acc[1][i] = sB.x; acc[3][i] = sB.y; }
                const f32x2 pA = (f32x2){__shfl_xor(sA.x, 32), __shfl_xor(sA.y, 32)}, pB = (f32x2){__shfl_xor(sB.x, 32), __shfl_xor(sB.y, 32)};
                const f32x2 tA = cmul(lam16A, hi ? pA : sA), tB = cmul(lam16B, hi ? pB : sB);
                const f32x2 e1A = (hi ? sA : pA) + tA, e1B = (hi ? sB : pB) + tB;
                const f32x2 ciA = hi ? pA : (f32x2){0.f, 0.f}, ciB = hi ? pB : (f32x2){0.f, 0.f};
                if (PASSB) {
                    f32x2 wA = cmul(lamA, ciA), wB = cmul(lamB, ciB);
#pragma unroll
                    for (int i = 0; i < 16; ++i) {
                        acc[0][i] += wA.x; acc[2][i] += wA.y; acc[1][i] += wB.x; acc[3][i] += wB.y;
                        *(LAS u32x2*)(sl + (16 * hi + i) * 272 + pl * 8) = (u32x2){cvt_pk_bf16(acc[0][i], acc[2][i]), cvt_pk_bf16(acc[1][i], acc[3][i])};
                        wA = cmul(wA, lamA); wB = cmul(wB, lamB); }
                    bf16x8 bsv[2][4];
#pragma unroll
                    for (int tt = 0; tt < 2; ++tt) {
                        const int rowi = (d == 0) ? (16 * tt + fr) : (16 * tt + 15 - fr);
#pragma unroll
                        for (int ks = 0; ks < 4; ++ks) bsv[tt][ks] = *(const LAS bf16x8*)(sl + rowi * 272 + (32 * ks + 8 * fq) * 2);
                    }
#pragma unroll
                    for (int tt = 0; tt < 2; ++tt) {
                        const int tq = (d == 0) ? (2 * sc + tt) : (3 - 2 * sc - tt);
#pragma unroll
                        for (int ks = 0; ks < 4; ++ks) yacc[tq] = __builtin_amdgcn_mfma_f32_16x16x32_bf16(ct[ks], bsv[tt][ks], yacc[tq], 0, 0, 0);
                    }
                    asm volatile("s_nop 7\n\ts_nop 7" : "+v"(yacc[0]), "+v"(yacc[1]), "+v"(yacc[2]), "+v"(yacc[3]) : "v"(bsv[0][0]), "v"(bsv[0][1]), "v"(bsv[0][2]), "v"(bsv[0][3]), "v"(bsv[1][0]), "v"(bsv[1][1]), "v"(bsv[1][2]), "v"(bsv[1][3]), "v"(ct[0]), "v"(ct[1]), "v"(ct[2]), "v"(ct[3]));
                    asm volatile("s_waitcnt lgkmcnt(0)" ::: "memory");
                }
                cA = e1A; cB = e1B;
            }
            if (!PASSB) { if (hi == 0) { EB[sidx] = cA; EB[sidx + 32] = cB; } }
        }
        if (PASSB) {
            const f32x4 dsk = *(const f32x4*)(F.in[IN_S5D] + 16 * g + 4 * fq);
#pragma unroll
            for (int tq = 0; tq < 4; ++tq) { const int tok = 16 * tq + fr;
                const u32x2 uu = *(const u32x2*)(urow + (size_t)tok * S5W + 4 * fq);
                f32x4 v; v[0] = yacc[tq][0] + bflo(uu.x) * dsk[0]; v[1] = yacc[tq][1] + bfhi(uu.x) * dsk[1]; v[2] = yacc[tq][2] + bflo(uu.y) * dsk[2]; v[3] = yacc[tq][3] + bfhi(uu.y) * dsk[3];
#pragma unroll
                for (int j = 0; j < 4; ++j) { const float x = v[j]; v[j] = x * sigmoidf_(1.5957691216f * (x + 0.044715f * x * x * x)); }
                *(u32x2*)(Y + (size_t)(b * SEQ + (kc - 4) * 64 + tok) * S5W + 16 * g + 4 * fq) = (u32x2){cvt_pk_bf16(v[0], v[1]), cvt_pk_bf16(v[2], v[3])}; }
        }
    }
}
__device__ __forceinline__ void s5_pass_a_simple(Frame& F) {
    constexpr int nitems = 2 * NCH * 8;
    const int lane = F.lane;
    const bf16* UA = (const bf16*)(F.ws + WS_UA); const bf16* UCA = (const bf16*)(F.ws + WS_UCA);
    const bf16* BBT = (const bf16*)(F.ws + WS_BBT); const f32x2* LAM = (const f32x2*)(F.ws + WS_LAM); f32x2* EB = (f32x2*)(F.ws + WS_E);
    for (int it = F.bx; it < nitems; it += F.G) {
        const int gq = it & 7, rest = it >> 3; const int b = rest / NCH, kc = rest % NCH; const int g = gq * 8 + F.wave;
        const bf16* urow = (kc < 4) ? (UCA + (size_t)(b * CTX + kc * 64) * S5W + 16 * g) : (UA + (size_t)(b * SEQ + (kc - 4) * 64) * S5W + 16 * g);
#pragma unroll 1
        for (int d = 0; d < 2; ++d) {
            const int dg = d * 64 + g; const f32x2 lam = LAM[dg * 64 + lane];
            float bre[16], bim[16];
            { const u32x4 r0 = *(const u32x4*)(BBT + (size_t)(dg * 128 + lane) * 16), r1 = *(const u32x4*)(BBT + (size_t)(dg * 128 + lane) * 16 + 8);
              const u32x4 i0 = *(const u32x4*)(BBT + (size_t)(dg * 128 + 64 + lane) * 16), i1 = *(const u32x4*)(BBT + (size_t)(dg * 128 + 64 + lane) * 16 + 8);
              bre[0] = bflo(r0.x); bre[1] = bfhi(r0.x); bre[2] = bflo(r0.y); bre[3] = bfhi(r0.y); bre[4] = bflo(r0.z); bre[5] = bfhi(r0.z); bre[6] = bflo(r0.w); bre[7] = bfhi(r0.w);
              bre[8] = bflo(r1.x); bre[9] = bfhi(r1.x); bre[10] = bflo(r1.y); bre[11] = bfhi(r1.y); bre[12] = bflo(r1.z); bre[13] = bfhi(r1.z); bre[14] = bflo(r1.w); bre[15] = bfhi(r1.w);
              bim[0] = bflo(i0.x); bim[1] = bfhi(i0.x); bim[2] = bflo(i0.y); bim[3] = bfhi(i0.y); bim[4] = bflo(i0.z); bim[5] = bfhi(i0.z); bim[6] = bflo(i0.w); bim[7] = bfhi(i0.w);
              bim[8] = bflo(i1.x); bim[9] = bfhi(i1.x); bim[10] = bflo(i1.y); bim[11] = bfhi(i1.y); bim[12] = bflo(i1.z); bim[13] = bfhi(i1.z); bim[14] = bflo(i1.w); bim[15] = bfhi(i1.w); }
            f32x2 st = (f32x2){0.f, 0.f};
#pragma unroll 4
            for (int i = 0; i < 64; ++i) { const int tok = (d == 0) ? i : 63 - i;
                const u32x4 u0 = *(const u32x4*)(urow + (size_t)tok * S5W), u1 = *(const u32x4*)(urow + (size_t)tok * S5W + 8);
                float u[16]; u[0] = bflo(u0.x); u[1] = bfhi(u0.x); u[2] = bflo(u0.y); u[3] = bfhi(u0.y); u[4] = bflo(u0.z); u[5] = bfhi(u0.z); u[6] = bflo(u0.w); u[7] = bfhi(u0.w);
                u[8] = bflo(u1.x); u[9] = bfhi(u1.x); u[10] = bflo(u1.y); u[11] = bfhi(u1.y); u[12] = bflo(u1.z); u[13] = bfhi(u1.z); u[14] = bflo(u1.w); u[15] = bfhi(u1.w);
                float br = 0.f, bi = 0.f;
#pragma unroll
                for (int c = 0; c < 16; ++c) { br += bre[c] * u[c]; bi += bim[c] * u[c]; }
                st = (f32x2){lam.x * st.x - lam.y * st.y + br, lam.x * st.y + lam.y * st.x + bi}; }
            EB[((size_t)((d * 2 + b) * NCH + kc)) * 4096 + g * 64 + lane] = st;
        }
    }
}
__device__ __forceinline__ void s5_pass_b2(Frame& F) {
    constexpr int nitems = 2 * 256 * 8;
    LAS unsigned char* sl = F.lds + F.wave * 8704;
    const int lane = F.lane, fr = lane & 15, fq = lane >> 4;
    const bf16* UA = (const bf16*)(F.ws + WS_UA); const bf16* BBT = (const bf16*)(F.ws + WS_BBT); const bf16* CTT = (const bf16*)(F.ws + WS_CTT);
    const f32x2* LAM = (const f32x2*)(F.ws + WS_LAM); const f32x2* SINB = (const f32x2*)(F.ws + WS_SIN); bf16* Y = (bf16*)(F.ws + WS_Y);
    for (int it = F.bx; it < nitems; it += F.G) {
        const int gq = it & 7, rest = it >> 3; const int b = rest >> 8, kc = (rest & 255) + 4; const int g = gq * 8 + F.wave;
        const bf16* urow = UA + (size_t)(b * SEQ + (kc - 4) * 64) * S5W + 16 * g;
        f32x4 yacc[4];
#pragma unroll
        for (int q = 0; q < 4; ++q) yacc[q] = (f32x4){0.f, 0.f, 0.f, 0.f};
#pragma unroll
        for (int d = 0; d < 2; ++d) {
            const int dg = d * 64 + g; const f32x2 lam = LAM[dg * 64 + lane];
            float bre[16], bim[16];
            { const u32x4 r0 = *(const u32x4*)(BBT + (size_t)(dg * 128 + lane) * 16), r1 = *(const u32x4*)(BBT + (size_t)(dg * 128 + lane) * 16 + 8);
              const u32x4 i0 = *(const u32x4*)(BBT + (size_t)(dg * 128 + 64 + lane) * 16), i1 = *(const u32x4*)(BBT + (size_t)(dg * 128 + 64 + lane) * 16 + 8);
              bre[0] = bflo(r0.x); bre[1] = bfhi(r0.x); bre[2] = bflo(r0.y); bre[3] = bfhi(r0.y); bre[4] = bflo(r0.z); bre[5] = bfhi(r0.z); bre[6] = bflo(r0.w); bre[7] = bfhi(r0.w);
              bre[8] = bflo(r1.x); bre[9] = bfhi(r1.x); bre[10] = bflo(r1.y); bre[11] = bfhi(r1.y); bre[12] = bflo(r1.z); bre[13] = bfhi(r1.z); bre[14] = bflo(r1.w); bre[15] = bfhi(r1.w);
              bim[0] = bflo(i0.x); bim[1] = bfhi(i0.x); bim[2] = bflo(i0.y); bim[3] = bfhi(i0.y); bim[4] = bflo(i0.z); bim[5] = bfhi(i0.z); bim[6] = bflo(i0.w); bim[7] = bfhi(i0.w);
              bim[8] = bflo(i1.x); bim[9] = bfhi(i1.x); bim[10] = bflo(i1.y); bim[11] = bfhi(i1.y); bim[12] = bflo(i1.z); bim[13] = bfhi(i1.z); bim[14] = bflo(i1.w); bim[15] = bfhi(i1.w); }
            bf16x8 ct[4];
#pragma unroll
            for (int ks = 0; ks < 4; ++ks) ct[ks] = *(const bf16x8*)(CTT + (size_t)(dg * 16 + fr) * 128 + 32 * ks + 8 * fq);
            f32x2 st = SINB[((size_t)((d * 2 + b) * NCH + kc)) * 4096 + g * 64 + lane];
#pragma unroll
            for (int h = 0; h < 2; ++h) {
#pragma unroll 4
                for (int i = 0; i < 32; ++i) { const int sc = 32 * h + i; const int tok = (d == 0) ? sc : 63 - sc;
                    const u32x4 u0 = *(const u32x4*)(urow + (size_t)tok * S5W), u1 = *(const u32x4*)(urow + (size_t)tok * S5W + 8);
                    float u[16]; u[0] = bflo(u0.x); u[1] = bfhi(u0.x); u[2] = bflo(u0.y); u[3] = bfhi(u0.y); u[4] = bflo(u0.z); u[5] = bfhi(u0.z); u[6] = bflo(u0.w); u[7] = bfhi(u0.w);
                    u[8] = bflo(u1.x); u[9] = bfhi(u1.x); u[10] = bflo(u1.y); u[11] = bfhi(u1.y); u[12] = bflo(u1.z); u[13] = bfhi(u1.z); u[14] = bflo(u1.w); u[15] = bfhi(u1.w);
                    float br = 0.f, bi = 0.f;
#pragma unroll
                    for (int c = 0; c < 16; ++c) { br += bre[c] * u[c]; bi += bim[c] * u[c]; }
                    st = (f32x2){lam.x * st.x - lam.y * st.y + br, lam.x * st.y + lam.y * st.x + bi};
                    *(LAS unsigned*)(sl + (tok & 31) * 272 + lane * 4) = cvt_pk_bf16(st.x, st.y); }
                const int t0q = (d == 0) ? 2 * h : 2 * (1 - h);
                bf16x8 bsv[2][4];
#pragma unroll
                for (int tt = 0; tt < 2; ++tt)
#pragma unroll
                    for (int ks = 0; ks < 4; ++ks) bsv[tt][ks] = *(const LAS bf16x8*)(sl + (16 * tt + fr) * 272 + (32 * ks + 8 * fq) * 2);
#pragma unroll
                for (int tt = 0; tt < 2; ++tt)
#pragma unroll
                    for (int ks = 0; ks < 4; ++ks) yacc[t0q + tt] = __builtin_amdgcn_mfma_f32_16x16x32_bf16(ct[ks], bsv[tt][ks], yacc[t0q + tt], 0, 0, 0);
                asm volatile("s_nop 7\n\ts_nop 7" : "+v"(yacc[0]), "+v"(yacc[1]), "+v"(yacc[2]), "+v"(yacc[3]) : "v"(bsv[0][0]), "v"(bsv[0][1]), "v"(bsv[0][2]), "v"(bsv[0][3]), "v"(bsv[1][0]), "v"(bsv[1][1]), "v"(bsv[1][2]), "v"(bsv[1][3]), "v"(ct[0]), "v"(ct[1]), "v"(ct[2]), "v"(ct[3]));
                asm volatile("s_waitcnt lgkmcnt(0)" ::: "memory");
            }
        }
        const f32x4 dsk = *(const f32x4*)(F.in[IN_S5D] + 16 * g + 4 * fq);
#pragma unroll
        for (int tq = 0; tq < 4; ++tq) { const int tok = 16 * tq + fr;
            const u32x2 uu = *(const u32x2*)(urow + (size_t)tok * S5W + 4 * fq);
            f32x4 v; v[0] = yacc[tq][0] + bflo(uu.x) * dsk[0]; v[1] = yacc[tq][1] + bfhi(uu.x) * dsk[1]; v[2] = yacc[tq][2] + bflo(uu.y) * dsk[2]; v[3] = yacc[tq][3] + bfhi(uu.y) * dsk[3];
#pragma unroll
            for (int j = 0; j < 4; ++j) { const float x = v[j]; v[j] = x * sigmoidf_(1.5957691216f * (x + 0.044715f * x * x * x)); }
            *(u32x2*)(Y + (size_t)(b * SEQ + (kc - 4) * 64 + tok) * S5W + 16 * g + 4 * fq) = (u32x2){cvt_pk_bf16(v[0], v[1]), cvt_pk_bf16(v[2], v[3])}; }
    }
}
template <bool PASSB>
__device__ __forceinline__ void s5_pass3(Frame& F) {
    constexpr int nk = PASSB ? 256 : NCH; constexpr int nitems = 2 * nk * 8;
    LAS unsigned char* sl = F.lds + F.wave * 8704;
    const int lane = F.lane, fr = lane & 15, fq = lane >> 4;
    const bf16* UA = (const bf16*)(F.ws + WS_UA); const bf16* UCA = (const bf16*)(F.ws + WS_UCA); const bf16* BB2 = (const bf16*)(F.ws + WS_BB2); const bf16* CTT = (const bf16*)(F.ws + WS_CTT);
    const f32x2* LAM = (const f32x2*)(F.ws + WS_LAM); const f32x2* SINB = (const f32x2*)(F.ws + WS_SIN); f32x2* EB = (f32x2*)(F.ws + WS_E); bf16* Y = (bf16*)(F.ws + WS_Y);
    const bf16x8 zf = (bf16x8){0, 0, 0, 0, 0, 0, 0, 0};
    int curg = -1; bf16x8 af[2][8], ct[2][4]; f32x2 lamv[2]; f32x4 dsk = (f32x4){0.f, 0.f, 0.f, 0.f};
    for (int it = F.bx; it < nitems; it += F.G) {
        const int gq = it & 7, rest = it >> 3; const int b = rest / nk, kk = rest % nk; const int kc = PASSB ? kk + 4 : kk; const int g = gq * 8 + F.wave;
        if (g != curg) { curg = g;
#pragma unroll
            for (int d = 0; d < 2; ++d) { const int dg = d * 64 + g; lamv[d] = LAM[dg * 64 + lane];
#pragma unroll
                for (int nt = 0; nt < 8; ++nt) af[d][nt] = (fq < 2) ? *(const bf16x8*)(BB2 + (size_t)(dg * 128 + 16 * nt + fr) * 16 + 8 * fq) : zf;
                if (PASSB) {
#pragma unroll
                    for (int ks = 0; ks < 4; ++ks) ct[d][ks] = *(const bf16x8*)(CTT + (size_t)(dg * 16 + fr) * 128 + 32 * ks + 8 * fq); } }
            if (PASSB) dsk = *(const f32x4*)(F.in[IN_S5D] + 16 * g + 4 * fq); }
        const bf16* urow = (kc < 4) ? (UCA + (size_t)(b * CTX + kc * 64) * S5W + 16 * g) : (UA + (size_t)(b * SEQ + (kc - 4) * 64) * S5W + 16 * g);
        bf16x8 uf[4];
#pragma unroll
        for (int q = 0; q < 4; ++q) uf[q] = (fq < 2) ? *(const bf16x8*)(urow + (size_t)(16 * q + fr) * S5W + 8 * fq) : zf;
        u32x2 uu[4];
        if (PASSB) {
#pragma unroll
            for (int tq = 0; tq < 4; ++tq) uu[tq] = *(const u32x2*)(urow + (size_t)(16 * tq + fr) * S5W + 4 * fq); }
        f32x2 st0[2];
#pragma unroll
        for (int d = 0; d < 2; ++d) st0[d] = PASSB ? SINB[((size_t)((d * 2 + b) * NCH + kc)) * 4096 + g * 64 + lane] : (f32x2){0.f, 0.f};
        f32x4 yacc[4];
#pragma unroll
        for (int q = 0; q < 4; ++q) yacc[q] = (f32x4){0.f, 0.f, 0.f, 0.f};
#pragma unroll
        for (int d = 0; d < 2; ++d) {
            const f32x2 lam = lamv[d]; f32x2 st = st0[d];
#pragma unroll
            for (int h = 0; h < 2; ++h) {
                const int T0 = (d == 0) ? 32 * h : 32 * (1 - h);
#pragma unroll
                for (int tt = 0; tt < 2; ++tt)
#pragma unroll
                    for (int nt = 0; nt < 8; ++nt) { const f32x4 dd = __builtin_amdgcn_mfma_f32_16x16x32_bf16(af[d][nt], uf[(T0 >> 4) + tt], (f32x4){0.f, 0.f, 0.f, 0.f}, 0, 0, 0);
                        *(LAS u32x2*)(sl + (16 * tt + fr) * 272 + (16 * nt + 4 * fq) * 2) = (u32x2){cvt_pk_bf16(dd[0], dd[1]), cvt_pk_bf16(dd[2], dd[3])}; }
                asm volatile("s_waitcnt lgkmcnt(0)" ::: "memory");
#pragma unroll 8
                for (int i = 0; i < 32; ++i) { const int r = (d == 0) ? i : 31 - i; LAS unsigned* cell = (LAS unsigned*)(sl + r * 272 + lane * 4);
                    const unsigned w = *cell; const float br = bflo(w), bi = bfhi(w);
                    st = (f32x2){lam.x * st.x - lam.y * st.y + br, lam.x * st.y + lam.y * st.x + bi};
                    if (PASSB) *cell = cvt_pk_bf16(st.x, st.y); }
                if (PASSB) {
                    const int t0q = T0 >> 4;
                    bf16x8 bsv[2][4];
#pragma unroll
                    for (int tt = 0; tt < 2; ++tt)
#pragma unroll
                        for (int ks = 0; ks < 4; ++ks) bsv[tt][ks] = *(const LAS bf16x8*)(sl + (16 * tt + fr) * 272 + (32 * ks + 8 * fq) * 2);
#pragma unroll
                    for (int tt = 0; tt < 2; ++tt)
#pragma unroll
                        for (int ks = 0; ks < 4; ++ks) yacc[t0q + tt] = __builtin_amdgcn_mfma_f32_16x16x32_bf16(ct[d][ks], bsv[tt][ks], yacc[t0q + tt], 0, 0, 0);
                    asm volatile("s_nop 7\n\ts_nop 7" : "+v"(yacc[0]), "+v"(yacc[1]), "+v"(yacc[2]), "+v"(yacc[3]) : "v"(bsv[0][0]), "v"(bsv[0][1]), "v"(bsv[0][2]), "v"(bsv[0][3]), "v"(bsv[1][0]), "v"(bsv[1][1]), "v"(bsv[1][2]), "v"(bsv[1][3]));
                }
                asm volatile("s_waitcnt lgkmcnt(0)" ::: "memory");
            }
            if (!PASSB) EB[((size_t)((d * 2 + b) * NCH + kc)) * 4096 + g * 64 + lane] = st;
        }
        if (PASSB) {
#pragma unroll
            for (int tq = 0; tq < 4; ++tq) { const int tok = 16 * tq + fr;
                f32x4 v; v[0] = yacc[tq][0] + bflo(uu[tq].x) * dsk[0]; v[1] = yacc[tq][1] + bfhi(uu[tq].x) * dsk[1]; v[2] = yacc[tq][2] + bflo(uu[tq].y) * dsk[2]; v[3] = yacc[tq][3] + bfhi(uu[tq].y) * dsk[3];
#pragma unroll
                for (int j = 0; j < 4; ++j) { const float x = v[j]; v[j] = x * sigmoidf_(1.5957691216f * (x + 0.044715f * x * x * x)); }
                *(u32x2*)(Y + (size_t)(b * SEQ + (kc - 4) * 64 + tok) * S5W + 16 * g + 4 * fq) = (u32x2){cvt_pk_bf16(v[0], v[1]), cvt_pk_bf16(v[2], v[3])}; }
        }
    }
}
__device__ __forceinline__ void s5_carry_item(Frame& F, int item) {
    const int idx = item * NTHR + F.tid; const int d = idx >> 13, b = (idx >> 12) & 1, gp = idx & 4095;
    const f32x2 lam = ((const f32x2*)(F.ws + WS_LAM))[d * 4096 + gp];
    f32x2 l = cmul(lam, lam); l = cmul(l, l); l = cmul(l, l); l = cmul(l, l); l = cmul(l, l); l = cmul(l, l);
    const f32x2* EB = (const f32x2*)(F.ws + WS_E) + (size_t)((d * 2 + b) * NCH) * 4096 + gp; f32x2* SB = (f32x2*)(F.ws + WS_SIN) + (size_t)((d * 2 + b) * NCH) * 4096 + gp;
    f32x2 s = (f32x2){0.f, 0.f};
#pragma unroll 1
    for (int st0 = 0; st0 < NCH; st0 += 20) { f32x2 e[20];
#pragma unroll
        for (int j = 0; j < 20; ++j) { const int st = st0 + j; const int kc = (d == 0) ? st : (st < 4 ? 3 - st : NCH + 3 - st); e[j] = EB[(size_t)kc * 4096]; }
#pragma unroll
        for (int j = 0; j < 20; ++j) { const int st = st0 + j; const int kc = (d == 0) ? st : (st < 4 ? 3 - st : NCH + 3 - st); SB[(size_t)kc * 4096] = s; s = cmul(l, s) + e[j]; } }
}

__device__ __forceinline__ int fsw(int i) { return i ^ ((i >> 5) & 7) ^ (((i >> 6) & 3) << 3); }
__host__ __device__ constexpr float w16c(int j) { return j == 0 ? 1.f : j == 1 ? 0.9238795325f : j == 2 ? 0.7071067812f : j == 3 ? 0.3826834324f : j == 4 ? 0.f : j == 5 ? -0.3826834324f : j == 6 ? -0.7071067812f : -0.9238795325f; }
__host__ __device__ constexpr float w16s(int j) { return j == 0 ? 0.f : j == 1 ? 0.3826834324f : j == 2 ? 0.7071067812f : j == 3 ? 0.9238795325f : j == 4 ? 1.f : j == 5 ? 0.9238795325f : j == 6 ? 0.7071067812f : 0.3826834324f; }
__host__ __device__ constexpr int bitrev(int q, int bits) { int r = 0; for (int i = 0; i < bits; ++i) r |= ((q >> i) & 1) << (bits - 1 - i); return r; }
template <int R, bool INV> __device__ __forceinline__ void dft_reg(f32x2 (&x)[R]) {
#pragma unroll
    for (int len = R; len >= 2; len >>= 1) { const int half = len >> 1, step = 16 / len;
#pragma unroll
        for (int b0 = 0; b0 < R; b0 += len)
#pragma unroll
            for (int k = 0; k < half; ++k) { const f32x2 a = x[b0 + k], b = x[b0 + k + half]; x[b0 + k] = a + b; const f32x2 dd = a - b; const int j = k * step;
                if (j == 0) x[b0 + k + half] = dd;
                else if (j == 4) x[b0 + k + half] = INV ? (f32x2){-dd.y, dd.x} : (f32x2){dd.y, -dd.x};
                else { const float c = w16c(j), s = w16s(j); x[b0 + k + half] = INV ? (f32x2){dd.x * c - dd.y * s, dd.x * s + dd.y * c} : (f32x2){dd.x * c + dd.y * s, dd.y * c - dd.x * s}; } } }
}
template <int R, int LOGN, bool INV> __device__ __forceinline__ void fft_pass(LAS f32x2* buf, int tid) {
    constexpr int LOGR = (R == 16) ? 4 : 3, LOGM = LOGN - LOGR, M = 1 << LOGM, NBF = 16384 / R / NTHR;
#pragma unroll 1
    for (int it = 0; it < NBF; ++it) {
        int tl = tid; asm volatile("" : "+v"(tl));
        const int bq = tl + NTHR * it, blk = bq >> LOGM, j = bq & (M - 1), base = (blk << LOGN) + j; const int fb = fsw(base);
#define FADDR(q) (fb ^ (((q) << LOGM) ^ ((((q) << LOGM) >> 5) & 7) ^ (((((q) << LOGM) >> 6) & 3) << 3)))
        f32x2 x[R];
#pragma unroll
        for (int q = 0; q < R; ++q) x[q] = buf[FADDR(q)];
        f32x2 w1 = (f32x2){1.f, 0.f};
        if (LOGM > 0) { const float rev = (float)j * (1.0f / (float)(1 << LOGN)); const float sn = sin_rev(rev); w1 = (f32x2){cos_rev(rev), INV ? sn : -sn}; }
        if (!INV) {
            dft_reg<R, false>(x);
            buf[fb] = x[0]; f32x2 w = w1;
#pragma unroll
            for (int q = 1; q < R; ++q) { buf[FADDR(q)] = (LOGM > 0) ? cmul(x[bitrev(q, LOGR)], w) : x[bitrev(q, LOGR)]; if (LOGM > 0) w = cmul(w, w1); }
        } else {
            if (LOGM > 0) { f32x2 w = w1;
#pragma unroll
                for (int q = 1; q < R; ++q) { x[q] = cmul(x[q], w); w = cmul(w, w1); } }
            dft_reg<R, true>(x);
#pragma unroll
            for (int q = 0; q < R; ++q) buf[FADDR(q)] = x[bitrev(q, LOGR)];
        }
#undef FADDR
    }
    __syncthreads();
}
#ifndef FFT_TEST
#define FFT_TEST 0
#endif
__device__ __forceinline__ void fft_fwd(LAS f32x2* buf, int tid) { if (FFT_TEST & 1) return; fft_pass<16, 14, false>(buf, tid); fft_pass<16, 10, false>(buf, tid); fft_pass<8, 6, false>(buf, tid); fft_pass<8, 3, false>(buf, tid); }
__device__ __forceinline__ void fft_inv(LAS f32x2* buf, int tid) { if (FFT_TEST & 2) return; fft_pass<8, 3, true>(buf, tid); fft_pass<8, 6, true>(buf, tid); fft_pass<16, 10, true>(buf, tid); fft_pass<16, 14, true>(buf, tid); }
__device__ __forceinline__ float block_sum(Frame& F, float v) {
    LAS float* red = (LAS float*)(F.lds + LDS_X);
    v = wave_sum(v); __syncthreads(); if (F.lane == 0) red[F.wave] = v; __syncthreads();
    float s = 0.f;
#pragma unroll
    for (int w = 0; w < NWAVES; ++w) s += red[w];
    return s;
}
__device__ __forceinline__ float sconv(const bf16* UH, int b, int ch, int t, float w0, float w1, float w2) {
    const bf16* p = UH + (size_t)(b * 3072 + ch) * SEQ;
    const int tm = t > 0 ? t - 1 : 0, tp = t < SEQ - 1 ? t + 1 : SEQ - 1;
    const float xm = bf2f(p[tm]), x0 = bf2f(p[t]), xp = bf2f(p[tp]);
    return w0 * (t > 0 ? xm : 0.f) + w1 * x0 + w2 * (t < SEQ - 1 ? xp : 0.f);
}
#define HY_UNPK(w) ((f32x2){bflo(w), bfhi(w)})
template <bool INV, class LD, class ST>
__device__ __forceinline__ void fft_edge_pass(LAS f32x2* buf, int tid, LD& ld, ST& st) {
    constexpr int R = 16, LOGN = 14, LOGM = 10;
#pragma unroll
    for (int it = 0; it < 2; ++it) {
        int tl = tid; asm volatile("" : "+v"(tl));
        const int j = tl + NTHR * it; const int fb = fsw(j);
        f32x2 x[R];
#pragma unroll
        for (int q = 0; q < R; ++q) x[q] = ld(2 * q + it, j + (q << LOGM), fb + (q << LOGM));
        const float rev = (float)j * (1.0f / 16384.0f); const float sn = sin_rev(rev); const f32x2 w1 = (f32x2){cos_rev(rev), INV ? sn : -sn};
        if (!INV) {
            dft_reg<R, false>(x);
            st(it, j, fb, x[0]); f32x2 w = w1;
#pragma unroll
            for (int q = 1; q < R; ++q) { st(2 * q + it, j + (q << LOGM), fb + (q << LOGM), cmul(x[bitrev(q, 4)], w)); w = cmul(w, w1); }
        } else {
            f32x2 w = w1;
#pragma unroll
            for (int q = 1; q < R; ++q) { x[q] = cmul(x[q], w); w = cmul(w, w1); }
            dft_reg<R, true>(x);
#pragma unroll
            for (int q = 0; q < R; ++q) st(2 * q + it, j + (q << LOGM), fb + (q << LOGM), x[bitrev(q, 4)]);
        }
        __builtin_amdgcn_sched_barrier(0);
    }
}
__device__ __forceinline__ void fft_last_to_ks(LAS f32x2* buf, int tid, unsigned* KS, float scale) {
#pragma unroll 1
    for (int it = 0; it < 4; ++it) { int tl = tid; asm volatile("" : "+v"(tl)); const int b = tl + NTHR * it; const int fb = fsw(8 * b);
        f32x2 x[8];
#pragma unroll
        for (int q = 0; q < 8; ++q) x[q] = buf[fb ^ q];
        dft_reg<8, false>(x);
        u32x4 o0, o1; f32x2 v;
        v = x[bitrev(0, 3)] * scale; o0.x = cvt_pk_bf16(v.x, v.y); v = x[bitrev(1, 3)] * scale; o0.y = cvt_pk_bf16(v.x, v.y); v = x[bitrev(2, 3)] * scale; o0.z = cvt_pk_bf16(v.x, v.y); v = x[bitrev(3, 3)] * scale; o0.w = cvt_pk_bf16(v.x, v.y);
        v = x[bitrev(4, 3)] * scale; o1.x = cvt_pk_bf16(v.x, v.y); v = x[bitrev(5, 3)] * scale; o1.y = cvt_pk_bf16(v.x, v.y); v = x[bitrev(6, 3)] * scale; o1.z = cvt_pk_bf16(v.x, v.y); v = x[bitrev(7, 3)] * scale; o1.w = cvt_pk_bf16(v.x, v.y);
        *(GAS u32x4*)(KS + 8 * b) = o0; *(GAS u32x4*)(KS + 8 * b + 4) = o1; }
}
__device__ __forceinline__ void fft_mid_mul(LAS f32x2* buf, int tid, const unsigned* KS) {
#pragma unroll 2
    for (int it = 0; it < 4; ++it) { int tl = tid; asm volatile("" : "+v"(tl)); const int b = tl + NTHR * it; const int fb = fsw(8 * b);
        const u32x4 k0 = *(const GAS u32x4*)(KS + 8 * b), k1 = *(const GAS u32x4*)(KS + 8 * b + 4);
        f32x2 x[8], y[8];
#pragma unroll
        for (int q = 0; q < 8; ++q) x[q] = buf[fb ^ q];
        dft_reg<8, false>(x);
        y[0] = cmul(x[bitrev(0, 3)], HY_UNPK(k0.x)); y[1] = cmul(x[bitrev(1, 3)], HY_UNPK(k0.y)); y[2] = cmul(x[bitrev(2, 3)], HY_UNPK(k0.z)); y[3] = cmul(x[bitrev(3, 3)], HY_UNPK(k0.w));
        y[4] = cmul(x[bitrev(4, 3)], HY_UNPK(k1.x)); y[5] = cmul(x[bitrev(5, 3)], HY_UNPK(k1.y)); y[6] = cmul(x[bitrev(6, 3)], HY_UNPK(k1.z)); y[7] = cmul(x[bitrev(7, 3)], HY_UNPK(k1.w));
        dft_reg<8, true>(y);
#pragma unroll
        for (int q = 0; q < 8; ++q) buf[fb ^ q] = y[bitrev(q, 3)]; }
    __syncthreads();
}
struct HyStLds { LAS f32x2* buf; __device__ __forceinline__ void operator()(int, int, int addr, f32x2 v) { buf[addr] = v; } };
struct HyLdLds { LAS f32x2* buf; __device__ __forceinline__ f32x2 operator()(int, int, int addr) { return buf[addr]; } };
struct HyLdKc { const bf16* f0; const bf16* f1; float part; __device__ __forceinline__ f32x2 operator()(int, int t, int) { const float a0 = bf2f(f0[t]), r1 = (t == 0) ? 0.f : bf2f(f1[SEQ - t]); part += fabsf(a0) + fabsf(r1); return (f32x2){a0 + r1, 0.f}; } };
struct HyLdKn { const bf16* f0; const bf16* f1; __device__ __forceinline__ f32x2 operator()(int, int t, int) { const float a0 = bf2f(f0[t]), r1 = (t == 0) ? 0.f : bf2f(f1[SEQ - t]); const float rev = (float)t * (1.0f / 32768.0f), v = a0 - r1; return (f32x2){v * cos_rev(rev), v * sin_rev(rev)}; } };
struct HyLdZ { const unsigned* z; __device__ __forceinline__ f32x2 operator()(int k, int, int) { return HY_UNPK(z[k]); } };
struct HyLdZpsi { const unsigned* z; __device__ __forceinline__ f32x2 operator()(int k, int t, int) { const float rev = (float)t * (1.0f / 32768.0f); return cmul(HY_UNPK(z[k]), (f32x2){cos_rev(rev), sin_rev(rev)}); } };
struct HyStYc { unsigned* yc; __device__ __forceinline__ void operator()(int k, int, int, f32x2 v) { const f32x2 w = v * (0.5f / 16384.0f); yc[k] = cvt_pk_bf16(w.x, w.y); } };
struct HyStComb { unsigned* z; const unsigned* yc; float bias;
    __device__ __forceinline__ void operator()(int k, int t, int, f32x2 v) { const float rev = (float)t * (1.0f / 32768.0f);
        const f32x2 yn = cmul(v, (f32x2){cos_rev(rev), -sin_rev(rev)}) * (0.5f / 16384.0f); const f32x2 y = yn + HY_UNPK(yc[k]) + HY_UNPK(z[k]) * bias; z[k] = cvt_pk_bf16(y.x, y.y); } };
template <bool NEG> __device__ __forceinline__ float hy_load_kernel(LAS f32x2* buf, int tid, const bf16* f0, const bf16* f1) {
    float part = 0.f;
#pragma unroll 2
    for (int r = 0; r < 4; ++r) { int tl = tid; asm volatile("" : "+v"(tl)); const int t0 = 8 * (tl + NTHR * r); const int fb = fsw(t0); float a[8], q[8];
        const u32x4 va = *(const GAS u32x4*)(f0 + t0), vr = *(const GAS u32x4*)(f1 + SEQ - t0 - 8); const float r0 = bf2f(f1[t0 > 0 ? SEQ - t0 : 0]);
        a[0] = bflo(va.x); a[1] = bfhi(va.x); a[2] = bflo(va.y); a[3] = bfhi(va.y); a[4] = bflo(va.z); a[5] = bfhi(va.z); a[6] = bflo(va.w); a[7] = bfhi(va.w);
        q[0] = t0 > 0 ? r0 : 0.f; q[1] = bfhi(vr.w); q[2] = bflo(vr.w); q[3] = bfhi(vr.z); q[4] = bflo(vr.z); q[5] = bfhi(vr.y); q[6] = bflo(vr.y); q[7] = bfhi(vr.x);
#pragma unroll
        for (int e = 0; e < 8; ++e) {
            if (!NEG) { part += fabsf(a[e]) + fabsf(q[e]); buf[fb ^ e] = (f32x2){a[e] + q[e], 0.f}; }
            else { const float rev = (float)(t0 + e) * (1.0f / 32768.0f), v = a[e] - q[e]; buf[fb ^ e] = (f32x2){v * cos_rev(rev), v * sin_rev(rev)}; } } }
    return part;
}
template <bool NEG> __device__ __forceinline__ void hy_load_kernel2(LAS f32x2* buf, int tid, const bf16* f0a, const bf16* f1a, const bf16* f0b, const bf16* f1b, float& part0, float& part1) {
#pragma unroll 2
    for (int r = 0; r < 4; ++r) { int tl = tid; asm volatile("" : "+v"(tl)); const int t0 = 8 * (tl + NTHR * r); const int fb = fsw(t0); float a[8], q[8], b[8], p[8];
        const u32x4 va = *(const GAS u32x4*)(f0a + t0), vr = *(const GAS u32x4*)(f1a + SEQ - t0 - 8); const float r0 = bf2f(f1a[t0 > 0 ? SEQ - t0 : 0]);
        const u32x4 vb = *(const GAS u32x4*)(f0b + t0), vs = *(const GAS u32x4*)(f1b + SEQ - t0 - 8); const float s0 = bf2f(f1b[t0 > 0 ? SEQ - t0 : 0]);
        a[0] = bflo(va.x); a[1] = bfhi(va.x); a[2] = bflo(va.y); a[3] = bfhi(va.y); a[4] = bflo(va.z); a[5] = bfhi(va.z); a[6] = bflo(va.w); a[7] = bfhi(va.w);
        q[0] = t0 > 0 ? r0 : 0.f; q[1] = bfhi(vr.w); q[2] = bflo(vr.w); q[3] = bfhi(vr.z); q[4] = bflo(vr.z); q[5] = bfhi(vr.y); q[6] = bflo(vr.y); q[7] = bfhi(vr.x);
        b[0] = bflo(vb.x); b[1] = bfhi(vb.x); b[2] = bflo(vb.y); b[3] = bfhi(vb.y); b[4] = bflo(vb.z); b[5] = bfhi(vb.z); b[6] = bflo(vb.w); b[7] = bfhi(vb.w);
        p[0] = t0 > 0 ? s0 : 0.f; p[1] = bfhi(vs.w); p[2] = bflo(vs.w); p[3] = bfhi(vs.z); p[4] = bflo(vs.z); p[5] = bfhi(vs.y); p[6] = bflo(vs.y); p[7] = bfhi(vs.x);
#pragma unroll
        for (int e = 0; e < 8; ++e) {
            if (!NEG) { part0 += fabsf(a[e]) + fabsf(q[e]); part1 += fabsf(b[e]) + fabsf(p[e]); buf[fb ^ e] = (f32x2){a[e] + q[e], b[e] + p[e]}; }
            else { const float rev = (float)(t0 + e) * (1.0f / 32768.0f), v0 = a[e] - q[e], v1 = b[e] - p[e]; buf[fb ^ e] = cmul((f32x2){v0, v1}, (f32x2){cos_rev(rev), sin_rev(rev)}); } } }
}
template <bool NEG> __device__ __forceinline__ void hy_split_to_ks(LAS f32x2* buf, int tid, unsigned* KS0, unsigned* KS1, float inv0, float inv1) {
    constexpr int S = NEG ? 1 : 0;
#pragma unroll 1
    for (int it = 0; it < 4; ++it) { int tl = tid; asm volatile("" : "+v"(tl)); const int b = tl + NTHR * it;
        const int l = (b >> 7) + 16 * ((b >> 3) & 15) + 256 * (b & 7); const int nl = (S - l) & 2047; const int br = (l > S) ? 1 : 0;
        const int bp = (nl & 15) * 128 + ((nl >> 4) & 15) * 8 + ((nl >> 8) & 7);
        const int fb = fsw(8 * b), fp = fsw(8 * bp);
        unsigned o0[8], o1[8]; const float h0 = 0.5f * inv0, h1 = 0.5f * inv1;
#pragma unroll
        for (int q = 0; q < 8; ++q) { const f32x2 zz = buf[fb ^ q], zp = buf[fp ^ ((-q - br) & 7)];
            o0[q] = cvt_pk_bf16((zz.x + zp.x) * h0, (zz.y - zp.y) * h0); o1[q] = cvt_pk_bf16((zz.y + zp.y) * h1, (zp.x - zz.x) * h1); }
        *(GAS u32x4*)(KS0 + 8 * b) = (u32x4){o0[0], o0[1], o0[2], o0[3]}; *(GAS u32x4*)(KS0 + 8 * b + 4) = (u32x4){o0[4], o0[5], o0[6], o0[7]};
        *(GAS u32x4*)(KS1 + 8 * b) = (u32x4){o1[0], o1[1], o1[2], o1[3]}; *(GAS u32x4*)(KS1 + 8 * b + 4) = (u32x4){o1[4], o1[5], o1[6], o1[7]}; }
}
__device__ __forceinline__ void hy_conv8(const u32x4 v, float hm, float hp, float w0, float w1, float w2, float (&o)[8]) {
    const float x1 = bflo(v.x), x2 = bfhi(v.x), x3 = bflo(v.y), x4 = bfhi(v.y), x5 = bflo(v.z), x6 = bfhi(v.z), x7 = bflo(v.w), x8 = bfhi(v.w);
    o[0] = w0 * hm + w1 * x1 + w2 * x2; o[1] = w0 * x1 + w1 * x2 + w2 * x3; o[2] = w0 * x2 + w1 * x3 + w2 * x4; o[3] = w0 * x3 + w1 * x4 + w2 * x5;
    o[4] = w0 * x4 + w1 * x5 + w2 * x6; o[5] = w0 * x5 + w1 * x6 + w2 * x7; o[6] = w0 * x6 + w1 * x7 + w2 * x8; o[7] = w0 * x7 + w1 * x8 + w2 * hp;
}
__device__ __forceinline__ void hy_load_conv(LAS f32x2* buf, int tid, const bf16* UH, int ch, float w0, float w1, float w2) {
    const bf16* p0 = UH + (size_t)ch * SEQ; const bf16* p1 = UH + (size_t)(3072 + ch) * SEQ;
#pragma unroll 2
    for (int r = 0; r < 4; ++r) { int tl = tid; asm volatile("" : "+v"(tl)); const int t0 = 8 * (tl + NTHR * r); const int fb = fsw(t0);
        const int tm = t0 > 0 ? t0 - 1 : 0, tp = t0 + 8 < SEQ ? t0 + 8 : SEQ - 1;
        const u32x4 va = *(const GAS u32x4*)(p0 + t0), vb = *(const GAS u32x4*)(p1 + t0);
        float am = bf2f(p0[tm]), ap = bf2f(p0[tp]), bm = bf2f(p1[tm]), bp = bf2f(p1[tp]);
        if (t0 == 0) { am = 0.f; bm = 0.f; } if (t0 + 8 >= SEQ) { ap = 0.f; bp = 0.f; }
        float oa[8], ob[8]; hy_conv8(va, am, ap, w0, w1, w2, oa); hy_conv8(vb, bm, bp, w0, w1, w2, ob);
        buf[fb ^ 0] = (f32x2){oa[0], ob[0]}; buf[fb ^ 1] = (f32x2){oa[1], ob[1]}; buf[fb ^ 2] = (f32x2){oa[2], ob[2]}; buf[fb ^ 3] = (f32x2){oa[3], ob[3]};
        buf[fb ^ 4] = (f32x2){oa[4], ob[4]}; buf[fb ^ 5] = (f32x2){oa[5], ob[5]}; buf[fb ^ 6] = (f32x2){oa[6], ob[6]}; buf[fb ^ 7] = (f32x2){oa[7], ob[7]}; }
}
__device__ __forceinline__ void hyena_item(Frame& F, int c) {
    LAS f32x2* buf = (LAS f32x2*)F.lds;
    unsigned* KS = (unsigned*)(F.ws + WS_HYS + (size_t)F.bx * HYS_STRIDE);
    const bf16* FILT = (const bf16*)(F.ws + WS_FILT); const bf16* UH = (const bf16*)(F.ws + WS_UH);
    const int tid = F.tid; const int ft = fsw(tid);
#define FB(k) buf[ft + NTHR * (k)]
    const float* sw = F.in[IN_HSW];
    unsigned z[32], yc[32];
    HyStLds stl{buf}; HyLdLds ldl{buf};
    hy_load_conv(buf, tid, UH, c, sw[c], sw[3072 + c], sw[6144 + c]);
    __syncthreads();
#pragma unroll
    for (int k = 0; k < 32; ++k) { const f32x2 v_ = FB(k); z[k] = cvt_pk_bf16(v_.x, v_.y); }
    { const bf16* f0a = FILT + (size_t)c * SEQ; const bf16* f1a = FILT + (size_t)(2048 + c) * SEQ; const bf16* f0b = FILT + (size_t)(1024 + c) * SEQ; const bf16* f1b = FILT + (size_t)(3072 + c) * SEQ;
      float part0 = 0.f, part1 = 0.f;
      __syncthreads();
      hy_load_kernel2<false>(buf, tid, f0a, f1a, f0b, f1b, part0, part1);
      const float inv0 = 1.0f / (block_sum(F, part0) + 1e-6f); const float inv1 = 1.0f / (block_sum(F, part1) + 1e-6f);
      fft_edge_pass<false>(buf, tid, ldl, stl); __syncthreads();
      fft_pass<16, 10, false>(buf, tid); fft_pass<8, 6, false>(buf, tid); fft_pass<8, 3, false>(buf, tid);
      hy_split_to_ks<false>(buf, tid, KS, KS + 16384, inv0, inv1); __syncthreads();
      { float d0 = 0.f, d1 = 0.f; hy_load_kernel2<true>(buf, tid, f0a, f1a, f0b, f1b, d0, d1); } __syncthreads();
      fft_edge_pass<false>(buf, tid, ldl, stl); __syncthreads();
      fft_pass<16, 10, false>(buf, tid); fft_pass<8, 6, false>(buf, tid); fft_pass<8, 3, false>(buf, tid);
      hy_split_to_ks<true>(buf, tid, KS + 2 * 16384, KS + 3 * 16384, inv0, inv1); __syncthreads(); }
#pragma unroll 1
    for (int o = 0; o < 2; ++o) {
        { HyLdZ ldz{z}; fft_edge_pass<false>(buf, tid, ldz, stl); __syncthreads(); }
        fft_pass<16, 10, false>(buf, tid); fft_pass<8, 6, false>(buf, tid);
        fft_mid_mul(buf, tid, KS + o * 16384);
        fft_pass<8, 6, true>(buf, tid); fft_pass<16, 10, true>(buf, tid);
        { HyStYc styc{yc}; fft_edge_pass<true>(buf, tid, ldl, styc); }
        __syncthreads();
        { HyLdZpsi ldzp{z}; fft_edge_pass<false>(buf, tid, ldzp, stl); __syncthreads(); }
        fft_pass<16, 10, false>(buf, tid); fft_pass<8, 6, false>(buf, tid);
        { const bf16* g0 = UH + (size_t)((o + 1) * 1024 + c) * SEQ + 8 * tid; const bf16* g1 = g0 + (size_t)3072 * SEQ;
          u32x4 t0 = *(const GAS u32x4*)(g0), t1 = *(const GAS u32x4*)(g0 + 4096), t2 = *(const GAS u32x4*)(g0 + 8192), t3 = *(const GAS u32x4*)(g0 + 12288);
          u32x4 t4 = *(const GAS u32x4*)(g1), t5 = *(const GAS u32x4*)(g1 + 4096), t6 = *(const GAS u32x4*)(g1 + 8192), t7 = *(const GAS u32x4*)(g1 + 12288);
          fft_mid_mul(buf, tid, KS + (2 + o) * 16384);
          asm volatile("" :: "v"(t0), "v"(t1), "v"(t2), "v"(t3), "v"(t4), "v"(t5), "v"(t6), "v"(t7)); }
        fft_pass<8, 6, true>(buf, tid); fft_pass<16, 10, true>(buf, tid);
        { HyStComb stc{z, yc, F.in[IN_HBIAS][o * 1024 + c]}; fft_edge_pass<true>(buf, tid, ldl, stc); }
#pragma unroll
        for (int k = 0; k < 32; ++k) FB(k) = HY_UNPK(z[k]);
        { const int xch = (o + 1) * 1024 + c; const float w0 = sw[xch], w1 = sw[3072 + xch], w2 = sw[6144 + xch];
#pragma unroll 8
          for (int k = 0; k < 32; ++k) { const int t = tid + NTHR * k; f32x2 v_ = FB(k); v_.x *= sconv(UH, 0, xch, t, w0, w1, w2); v_.y *= sconv(UH, 1, xch, t, w0, w1, w2); FB(k) = v_; } }
#pragma unroll
        for (int k = 0; k < 32; ++k) { const f32x2 v_ = FB(k); z[k] = cvt_pk_bf16(v_.x, v_.y); }
        __syncthreads();
    }
    bf16* YHCM = (bf16*)(F.ws + WS_YHCM);
#pragma unroll
    for (int k = 0; k < 32; ++k) FB(k) = HY_UNPK(z[k]);
#pragma unroll 8
    for (int k = 0; k < 32; ++k) { const int t = tid + NTHR * k; const f32x2 v_ = FB(k); YHCM[(size_t)c * SEQ + t] = (bf16)f2bf(v_.x); YHCM[(size_t)(1024 + c) * SEQ + t] = (bf16)f2bf(v_.y); }
    __syncthreads();
#undef FB
}
__device__ __forceinline__ void p3_publish(Frame& F) {
    asm volatile("s_waitcnt vmcnt(0)" ::: "memory");
    __syncthreads();
    if (F.tid == 0) { __builtin_amdgcn_fence(__ATOMIC_RELEASE, "agent"); asm volatile("s_waitcnt vmcnt(0)" ::: "memory"); (void)xb_add((unsigned*)(F.ctl + CW_P3), 1u); }
}
__device__ __forceinline__ void p3_wait(Frame& F) {
    if (F.tid == 0) { unsigned* bar = (unsigned*)(F.ctl + CW_BAR);
        XB_SPIN(xb_ld((unsigned*)(F.ctl + CW_P3)) < (unsigned)F.G, bar);
        __builtin_amdgcn_fence(__ATOMIC_ACQUIRE, "agent"); asm volatile("s_waitcnt vmcnt(0)" ::: "memory"); }
    __syncthreads();
}
__device__ __forceinline__ void p4_hyena_carry(Frame& F, int qw) {
    volatile LAS int* qs = (volatile LAS int*)(F.lds + MISC_OFF + 64);
    for (;;) {
        __syncthreads();
        if (F.tid == 0) qs[0] = (int)__hip_atomic_fetch_add((unsigned*)(F.ctl + qw), 1u, __ATOMIC_RELAXED, __HIP_MEMORY_SCOPE_AGENT);
        __syncthreads();
        const int q = qs[0];
        if (q >= 32 + 1024) break;
        if (q < 1024) hyena_item(F, q); else { p3_wait(F); s5_carry_item(F, q - 1024); }
    }
}
__device__ __forceinline__ void yh_transpose(Frame& F) {
    const bf16* YHCM = (const bf16*)(F.ws + WS_YHCM); bf16* YH = (bf16*)(F.ws + WS_YH);
    LAS unsigned short* tl = (LAS unsigned short*)(F.lds + 8 * 8704 + F.wave * (64 * 72 * 2));
    const int gw = F.bx * NWAVES + F.wave, NGW = F.G * NWAVES, lane = F.lane;
    for (int it = gw; it < 2 * 16 * 256; it += NGW) {
        const int mt = it & 255, ct = (it >> 8) & 15, b = it >> 12; const int m0 = mt * 64, c0 = ct * 64;
#pragma unroll
        for (int j = 0; j < 8; ++j) { const int ch = 8 * j + (lane >> 3), mc = (lane & 7) * 8;
            const u32x4 v = *(const GAS u32x4*)(YHCM + (size_t)(b * 1024 + c0 + ch) * SEQ + m0 + mc); *(LAS u32x4*)(tl + ch * 72 + mc) = v; }
        LDS_WAIT(); asm volatile("" ::: "memory");
#pragma unroll
        for (int j = 0; j < 8; ++j) { const int mm = 8 * j + (lane >> 3), cc = (lane & 7) * 8; const int m = m0 + mm, w = m >> 8, r = m & 255;
            u32x4 o; o.x = (unsigned)tl[(cc + 0) * 72 + mm] | ((unsigned)tl[(cc + 1) * 72 + mm] << 16); o.y = (unsigned)tl[(cc + 2) * 72 + mm] | ((unsigned)tl[(cc + 3) * 72 + mm] << 16);
            o.z = (unsigned)tl[(cc + 4) * 72 + mm] | ((unsigned)tl[(cc + 5) * 72 + mm] << 16); o.w = (unsigned)tl[(cc + 6) * 72 + mm] | ((unsigned)tl[(cc + 7) * 72 + mm] << 16);
            *(GAS u32x4*)(YH + (size_t)(b * SEQ + r * 64 + w) * HYW + c0 + cc) = o; }
        LDS_WAIT(); asm volatile("" ::: "memory");
    }
}

struct SchedStd {
    int G, c, npn, K, nrep; const char* A; const char* Bt; int esz = 2;
    __device__ __forceinline__ bool next(int i, pg8::Unit& u) const {
        int L = i * G + c; const int nwg = 128 * npn; u.e = 0; u.valid = 256;
        if (nrep > 1 && L >= nwg) L -= nwg;
        if (L >= nwg) return false;
        int wgid = L; { const int q = nwg / 8, xcd = wgid % 8, off = wgid / 8; wgid = xcd * q + off; }
        const int nig = 8 * npn, gid = wgid / nig; u.pm = gid * 8 + ((wgid % nig) % 8); u.pn = (wgid % nig) / 8; return true;
    }
    __device__ __forceinline__ unsigned a_row(const pg8::Unit& u, int r) const { return (unsigned)(u.pm * 256 + r); }
    __device__ __forceinline__ const char* a_base() const { return A; }
    __device__ __forceinline__ const char* b_base(const pg8::Unit& u) const { return Bt + (size_t)u.pn * 256 * K * esz; }
};
template <int MODE> struct EpiMix {
    static constexpr bool PERM = true, TRANS = true, FP8 = false;
    const bf16* P; const bf16* Q; bf16* O;
    __device__ __forceinline__ void operator()(const f32x4 (&acc)[2][2][4][2], const pg8::Unit& u, int wr, int wc, int fr, int fq) const {
        constexpr int ld = (MODE == 0) ? 1024 : 2048;
        const int col0 = u.pn * 256 + wc * 32 + 8 * fq;
#pragma unroll
        for (int ai = 0; ai < 2; ++ai) {
            u32x4 pv[4][2], qv[4][2];
#pragma unroll
            for (int m = 0; m < 4; ++m) { const size_t row = (size_t)u.pm * 256 + ai * 128 + wr * 64 + m * 16 + fr;
#pragma unroll
                for (int bj = 0; bj < 2; ++bj) { const int col = col0 + bj * 128;
                    if (MODE == 0) pv[m][bj] = *(const u32x4*)(P + row * 1024 + col);
                    else { const u32x2 g8 = *(const u32x2*)((const unsigned char*)P + row * 4096 + (MODE == 2 ? 2048 : 0) + col); pv[m][bj] = (u32x4){g8.x, g8.y, 0u, 0u}; }
                    if (MODE == 2) qv[m][bj] = *(const u32x4*)(Q + row * 2048 + col); } }
#pragma unroll
            for (int m = 0; m < 4; ++m) { const size_t row = (size_t)u.pm * 256 + ai * 128 + wr * 64 + m * 16 + fr;
#pragma unroll
                for (int bj = 0; bj < 2; ++bj) { const int col = col0 + bj * 128; const f32x4 v0 = acc[ai][bj][m][0], v1 = acc[ai][bj][m][1]; float r[8];
                    if (MODE == 0) { const u32x4 y = pv[m][bj];
                        r[0] = bflo(y.x) * sigmoidf_(v0[0]); r[1] = bfhi(y.x) * sigmoidf_(v0[1]); r[2] = bflo(y.y) * sigmoidf_(v0[2]); r[3] = bfhi(y.y) * sigmoidf_(v0[3]);
                        r[4] = bflo(y.z) * sigmoidf_(v1[0]); r[5] = bfhi(y.z) * sigmoidf_(v1[1]); r[6] = bflo(y.w) * sigmoidf_(v1[2]); r[7] = bfhi(y.w) * sigmoidf_(v1[3]); }
                    else { const u32x4 gg = pv[m][bj]; constexpr float q = 1.0f / 255.0f;
                        r[0] = (float)(gg.x & 255u) * q * v0[0]; r[1] = (float)((gg.x >> 8) & 255u) * q * v0[1]; r[2] = (float)((gg.x >> 16) & 255u) * q * v0[2]; r[3] = (float)(gg.x >> 24) * q * v0[3];
                        r[4] = (float)(gg.y & 255u) * q * v1[0]; r[5] = (float)((gg.y >> 8) & 255u) * q * v1[1]; r[6] = (float)((gg.y >> 16) & 255u) * q * v1[2]; r[7] = (float)(gg.y >> 24) * q * v1[3];
                        if (MODE == 2) { const u32x4 t1 = qv[m][bj];
                            r[0] += bflo(t1.x); r[1] += bfhi(t1.x); r[2] += bflo(t1.y); r[3] += bfhi(t1.y); r[4] += bflo(t1.z); r[5] += bfhi(t1.z); r[6] += bflo(t1.w); r[7] += bfhi(t1.w); } }
                    if (MODE == 2) {
                        *(u32x2*)((unsigned char*)O + row * ld + col) = (u32x2){pk4_fp8(r[0] * T8SCALE, r[1] * T8SCALE, r[2] * T8SCALE, r[3] * T8SCALE), pk4_fp8(r[4] * T8SCALE, r[5] * T8SCALE, r[6] * T8SCALE, r[7] * T8SCALE)}; }
                    else { u32x4 w; w.x = cvt_pk_bf16(r[0], r[1]); w.y = cvt_pk_bf16(r[2], r[3]); w.z = cvt_pk_bf16(r[4], r[5]); w.w = cvt_pk_bf16(r[6], r[7]);
                        *(u32x4*)(O + row * ld + col) = w; } } }
        }
    }
};
struct EpiOut {
    static constexpr bool PERM = true, TRANS = true, FP8 = true;
    const float* X; const float* MOD; bf16* H1;
    __device__ __forceinline__ void operator()(const f32x4 (&acc)[2][2][4][2], const pg8::Unit& u, int wr, int wc, int fr, int fq) const {
        const int b = u.pm >> 6; const int c0 = u.pn * 256 + wc * 32 + 8 * fq;
        f32x4 gv[2][2];
#pragma unroll
        for (int bj = 0; bj < 2; ++bj)
#pragma unroll
            for (int n = 0; n < 2; ++n) gv[bj][n] = *(const f32x4*)(MOD + b * 12288 + 2 * 2048 + c0 + bj * 128 + 4 * n) * (1.0f / (W8SCALE * T8SCALE));
#pragma unroll
        for (int ai = 0; ai < 2; ++ai) {
            f32x4 xv[4][2][2];
#pragma unroll
            for (int m = 0; m < 4; ++m) { const size_t off = ((size_t)u.pm * 256 + ai * 128 + wr * 64 + m * 16 + fr) * D + c0;
#pragma unroll
                for (int bj = 0; bj < 2; ++bj)
#pragma unroll
                    for (int n = 0; n < 2; ++n) xv[m][bj][n] = *(const f32x4*)(X + off + bj * 128 + 4 * n); }
#pragma unroll
            for (int m = 0; m < 4; ++m) { const size_t off = ((size_t)u.pm * 256 + ai * 128 + wr * 64 + m * 16 + fr) * D + c0;
#pragma unroll
                for (int bj = 0; bj < 2; ++bj) { const f32x4 v0 = xv[m][bj][0] + gv[bj][0] * acc[ai][bj][m][0], v1 = xv[m][bj][1] + gv[bj][1] * acc[ai][bj][m][1];
                    u32x4 w; w.x = cvt_pk_bf16(v0[0], v0[1]); w.y = cvt_pk_bf16(v0[2], v0[3]); w.z = cvt_pk_bf16(v1[0], v1[1]); w.w = cvt_pk_bf16(v1[2], v1[3]);
                    *(u32x4*)(H1 + off + bj * 128) = w; } }
        }
    }
};

__device__ __forceinline__ void p10_router(Frame& F) {
    const int gw = F.bx * NWAVES + F.wave, NGW = F.G * NWAVES, lane = F.lane;
    const float* MOD = (const float*)(F.ws + WS_MOD); const float* g2n = F.in[IN_N2G]; const float* RWT = (const float*)(F.ws + WS_RWT); const float* rb = F.in[IN_RB];
    const bf16* H1 = (const bf16*)(F.ws + WS_H1); unsigned char* HM8 = (unsigned char*)(F.ws + WS_HM8); float* GATE = (float*)(F.ws + WS_GATE); int* LIST = (int*)(F.ws + WS_LIST);
    for (int m0 = 2 * gw; m0 < NTOK; m0 += 2 * NGW) {
        const int b = m0 >> 14;
        f32x4 h[2][8];
#pragma unroll
        for (int rr = 0; rr < 2; ++rr) { const bf16* xr = H1 + (size_t)(m0 + rr) * D; float s = 0.f;
#pragma unroll
            for (int j = 0; j < 8; ++j) { const u32x2 hb = *(const GAS u32x2*)(xr + 4 * lane + 256 * j); h[rr][j] = (f32x4){bflo(hb.x), bfhi(hb.x), bflo(hb.y), bfhi(hb.y)}; s += (h[rr][j].x * h[rr][j].x + h[rr][j].y * h[rr][j].y) + (h[rr][j].z * h[rr][j].z + h[rr][j].w * h[rr][j].w); }
            const float rstd = 1.0f / sqrtf(wave_sum(s) * (1.0f / D) + 1e-6f);
            GAS unsigned* o = (GAS unsigned*)(HM8 + (size_t)(m0 + rr) * D) + lane;
#pragma unroll
            for (int j = 0; j < 8; ++j) { const int k = 4 * lane + 256 * j; const f32x4 g = *(const f32x4*)(g2n + k), sc = *(const f32x4*)(MOD + b * 12288 + 4 * 2048 + k), sh = *(const f32x4*)(MOD + b * 12288 + 3 * 2048 + k);
                h[rr][j] = h[rr][j] * rstd * g * (sc + 1.0f) + sh; }
#pragma unroll
            for (int j = 0; j < 8; ++j) o[64 * j] = pk4_fp8(h[rr][j].x, h[rr][j].y, h[rr][j].z, h[rr][j].w); }
        float lg0 = -3.0e38f, lg1 = -3.0e38f;
#pragma unroll 2
        for (int e = 0; e < NEXP; ++e) { float s0 = 0.f, s1 = 0.f;
#pragma unroll
            for (int j = 0; j < 8; ++j) { const f32x4 w = *(const f32x4*)(RWT + e * 2048 + 4 * lane + 256 * j);
                s0 += (h[0][j].x * w.x + h[0][j].y * w.y) + (h[0][j].z * w.z + h[0][j].w * w.w); s1 += (h[1][j].x * w.x + h[1][j].y * w.y) + (h[1][j].z * w.z + h[1][j].w * w.w); }
            s0 = wave_sum(s0) + rb[e]; s1 = wave_sum(s1) + rb[e];
            if (lane == e) { lg0 = s0; lg1 = s1; } }
#pragma unroll
        for (int rr = 0; rr < 2; ++rr) { float lg = rr ? lg1 : lg0; int es[4]; float vs[4];
#pragma unroll
            for (int k = 0; k < 4; ++k) { const float mx = wave_max(lg); const unsigned long long bal = __ballot(lg == mx); const int idx = __ffsll((long long)bal) - 1; es[k] = idx; vs[k] = mx; if (lane == idx) lg = -3.0e38f; }
            const float e1 = __expf(vs[1] - vs[0]), e2 = __expf(vs[2] - vs[0]), e3 = __expf(vs[3] - vs[0]); const float inv = 1.0f / (1.0f + e1 + e2 + e3);
            if (lane < 4) { const int ee = lane == 0 ? es[0] : lane == 1 ? es[1] : lane == 2 ? es[2] : es[3]; const float gt = (lane == 0 ? 1.0f : lane == 1 ? e1 : lane == 2 ? e2 : e3) * inv;
                const int slot = (m0 + rr) * 4 + lane;
                const unsigned pos = __hip_atomic_fetch_add((unsigned*)(F.ctl + CW_CNT + 64 * ee), 1u, __ATOMIC_RELAXED, __HIP_MEMORY_SCOPE_AGENT);
                LIST[ee * LISTCAP + (int)pos] = slot; GATE[slot] = gt; } }
    }
}

__device__ __forceinline__ void moe_tables(Frame& F) {
    volatile LAS int* tb = (volatile LAS int*)(F.lds + LDS_X);
    __syncthreads();
    if (F.tid < NEXP) tb[64 + F.tid] = (int)__hip_atomic_load((unsigned*)(F.ctl + CW_CNT + 64 * F.tid), __ATOMIC_RELAXED, __HIP_MEMORY_SCOPE_AGENT);
    __syncthreads();
    if (F.tid == 0) { int acc = 0; for (int e = 0; e < NEXP; ++e) { const int c = tb[64 + e]; tb[e] = acc; acc += (c + 255) >> 8; } tb[32] = acc; }
    __syncthreads();
}
template <bool GATHER> struct SchedMoe {
    int G, c, npn, N, K, nrep; const char* A; const char* Bt; const int* LIST; volatile LAS int* tb;
    __device__ __forceinline__ bool next(int i, pg8::Unit& u) const {
        int L = i * G + c; { const int tot = tb[32] * npn; if (nrep > 1 && L >= tot) L -= tot; }
        int rt = L / npn, pnq = L % npn;
        if (G == 256 && nrep == 1) {
            const int x = c & 7, j = c >> 3;
            if (npn == 16) { pnq = 4 * (x & 3) + (j & 3); rt = 16 * i + (x >> 2) * 8 + (j >> 2); }
            else           { pnq = 2 * (x & 3) + (j & 1); rt = 32 * i + (x >> 2) * 16 + (j >> 1); }
        }
        if (rt >= tb[32]) return false;
        int e = 0;
        for (int q = 1; q < NEXP; ++q) e += (tb[q] <= rt) ? 1 : 0;
        e = __builtin_amdgcn_readfirstlane(e);
        u.pm = rt; u.pn = pnq; u.e = e; const int left = tb[64 + e] - 256 * (rt - tb[e]); u.valid = left < 256 ? left : 256; return true;
    }
    __device__ __forceinline__ unsigned a_row(const pg8::Unit& u, int r) const {
        if (GATHER) { const int rc = r < u.valid ? r : u.valid - 1; return (unsigned)(LIST[u.e * LISTCAP + (u.pm - tb[u.e]) * 256 + rc] >> 2); }
        return (unsigned)(u.pm * 256 + r);
    }
    __device__ __forceinline__ const char* a_base() const { return A; }
    __device__ __forceinline__ const char* b_base(const pg8::Unit& u) const { return Bt + ((size_t)u.e * N + (size_t)u.pn * 256) * K; }
};
struct EpiMoe1 {
    static constexpr bool PERM = true, TRANS = true, FP8 = true;
    const float* BG; unsigned char* ACT;
    __device__ __forceinline__ void operator()(const f32x4 (&acc)[2][2][4][2], const pg8::Unit& u, int wr, int wc, int fr, int fq) const {
        const int c0 = u.pn * 256 + wc * 32 + 8 * fq;
        f32x4 bv[2][2];
#pragma unroll
        for (int bj = 0; bj < 2; ++bj)
#pragma unroll
            for (int n = 0; n < 2; ++n) bv[bj][n] = *(const f32x4*)(BG + (size_t)u.e * 4096 + c0 + bj * 128 + 4 * n);
#pragma unroll
        for (int ai = 0; ai < 2; ++ai)
#pragma unroll
            for (int m = 0; m < 4; ++m) { const size_t row = (size_t)u.pm * 256 + ai * 128 + wr * 64 + m * 16 + fr;
#pragma unroll
                for (int bj = 0; bj < 2; ++bj) { const f32x4 v0 = acc[ai][bj][m][0] * (1.0f / W8SCALE) + bv[bj][0], v1 = acc[ai][bj][m][1] * (1.0f / W8SCALE) + bv[bj][1]; float a[4];
#pragma unroll
                    for (int j = 0; j < 4; ++j) { const float gl = fminf(j < 2 ? v0[2 * j] : v1[2 * j - 4], 7.0f); const float ln = fminf(fmaxf(j < 2 ? v0[2 * j + 1] : v1[2 * j - 3], -7.0f), 7.0f);
                        a[j] = gl * sigmoidf_(1.702f * gl) * (ln + 1.0f); }
                    *(unsigned*)(ACT + row * DEXP + ((c0 + bj * 128) >> 1)) = pk4_fp8(a[0], a[1], a[2], a[3]); } }
    }
};
struct EpiMoe2 {
    static constexpr bool PERM = true, TRANS = true, FP8 = true;
    const float* BD; const float* GATE; const int* LIST; unsigned char* YS; volatile LAS int* tb;
    __device__ __forceinline__ void operator()(const f32x4 (&acc)[2][2][4][2], const pg8::Unit& u, int wr, int wc, int fr, int fq) const {
        const int c0 = u.pn * 256 + wc * 32 + 8 * fq; const int lbase = u.e * LISTCAP + (u.pm - tb[u.e]) * 256;
        f32x4 bv[2][2];
#pragma unroll
        for (int bj = 0; bj < 2; ++bj)
#pragma unroll
            for (int n = 0; n < 2; ++n) bv[bj][n] = *(const f32x4*)(BD + (size_t)u.e * D + c0 + bj * 128 + 4 * n);
        int slot[2][4]; float gt_[2][4];
#pragma unroll
        for (int ai = 0; ai < 2; ++ai)
#pragma unroll
            for (int m = 0; m < 4; ++m) { const int r = ai * 128 + wr * 64 + m * 16 + fr; slot[ai][m] = LIST[lbase + (r < u.valid ? r : u.valid - 1)]; }
#pragma unroll
        for (int ai = 0; ai < 2; ++ai)
#pragma unroll
            for (int m = 0; m < 4; ++m) gt_[ai][m] = GATE[slot[ai][m]] * Y8SCALE;
#pragma unroll
        for (int ai = 0; ai < 2; ++ai)
#pragma unroll
            for (int m = 0; m < 4; ++m) { const int r = ai * 128 + wr * 64 + m * 16 + fr; const float gt = gt_[ai][m];
                const long long ro = (r < u.valid) ? (long long)slot[ai][m] * D : YS_DUMP_OFF;
#pragma unroll
                for (int bj = 0; bj < 2; ++bj) { const f32x4 v0 = (acc[ai][bj][m][0] * (1.0f / W8SCALE) + bv[bj][0]) * gt, v1 = (acc[ai][bj][m][1] * (1.0f / W8SCALE) + bv[bj][1]) * gt;
                    *(u32x2*)(YS + ro + c0 + bj * 128) = (u32x2){pk4_fp8(v0[0], v0[1], v0[2], v0[3]), pk4_fp8(v1[0], v1[1], v1[2], v1[3])}; } }
    }
};
__device__ __forceinline__ void p13_final(Frame& F) {
    const int gw = F.bx * NWAVES + F.wave, NGW = F.G * NWAVES, lane = F.lane;
    const float* MOD = (const float*)(F.ws + WS_MOD); const float* fg = F.in[IN_FG]; const unsigned char* YS = (const unsigned char*)(F.ws + WS_YS); float* O = F.out;
    f32x4 g2v[8]; int curb = -1;
    for (int m0 = 2 * gw; m0 < NTOK; m0 += 2 * NGW) {
        const int b = m0 >> 14;
        if (b != curb) { curb = b;
#pragma unroll
            for (int j = 0; j < 8; ++j) g2v[j] = *(const f32x4*)(MOD + b * 12288 + 5 * 2048 + 4 * lane + 256 * j) * (1.0f / Y8SCALE); }
        unsigned yv[2][8][4]; u32x2 hv[2][8]; f32x4 fgv[8];
#pragma unroll
        for (int rr = 0; rr < 2; ++rr) { const int m = m0 + rr; const bf16* hr = (const bf16*)(F.ws + WS_H1) + (size_t)m * D;
#pragma unroll
            for (int j = 0; j < 8; ++j) { const int k = 4 * lane + 256 * j;
#pragma unroll
                for (int q = 0; q < 4; ++q) yv[rr][j][q] = *(const GAS unsigned*)(YS + (size_t)(m * 4 + q) * D + k);
                hv[rr][j] = *(const GAS u32x2*)(hr + k); } }
#pragma unroll
        for (int j = 0; j < 8; ++j) fgv[j] = *(const f32x4*)(fg + 4 * lane + 256 * j);
        f32x4 h[2][8]; float rstd[2];
#pragma unroll
        for (int rr = 0; rr < 2; ++rr) { float s = 0.f;
#pragma unroll
            for (int j = 0; j < 8; ++j) { f32x4 a = (f32x4){0.f, 0.f, 0.f, 0.f};
#pragma unroll
                for (int q = 0; q < 4; ++q) { const unsigned y = yv[rr][j][q]; const f32x2 lo = __builtin_amdgcn_cvt_pk_f32_fp8((int)y, false), hi = __builtin_amdgcn_cvt_pk_f32_fp8((int)y, true); a += (f32x4){lo.x, lo.y, hi.x, hi.y}; }
                const u32x2 hb = hv[rr][j]; h[rr][j] = (f32x4){bflo(hb.x), bfhi(hb.x), bflo(hb.y), bfhi(hb.y)} + g2v[j] * a; s += (h[rr][j].x * h[rr][j].x + h[rr][j].y * h[rr][j].y) + (h[rr][j].z * h[rr][j].z + h[rr][j].w * h[rr][j].w); }
            rstd[rr] = 1.0f / sqrtf(wave_sum(s) * (1.0f / D) + 1e-6f); }
#pragma unroll
        for (int rr = 0; rr < 2; ++rr) { float* xr = O + (size_t)(m0 + rr) * D;
#pragma unroll
            for (int j = 0; j < 8; ++j) { const int k = 4 * lane + 256 * j; *(GAS f32x4*)(xr + k) = h[rr][j] * rstd[rr] * fgv[j]; } }
    }
}

__global__ void __launch_bounds__(NTHR, 2) fwd(Args args) {
    extern __shared__ __attribute__((aligned(16))) unsigned char lds_raw[];
    Frame F;
    F.lds = (LAS unsigned char*)lds_raw;
    F.tid = threadIdx.x; F.lane = F.tid & 63; F.wave = __builtin_amdgcn_readfirstlane(F.tid >> 6);
    F.G = gridDim.x; F.bx = blockIdx.x; F.in = args.in; F.out = args.out; F.ws = args.ws; F.ctl = (GAS unsigned*)(args.ws + WS_CTL);
    for (int u = F.tid; u < (LDS_BYTES - MISC_OFF) / 4; u += NTHR) ((LAS unsigned*)(F.lds + MISC_OFF))[u] = 0u;
    __syncthreads();
    const int lo = args.ph_lo, hi = args.ph_hi;
    XcdBarrier bar; bar.bar = (unsigned*)(F.ctl + CW_BAR); bar.x = 0; bar.st = nullptr;
    if (hi - lo > 1) bar = xcd_barrier_post((unsigned*)(F.ctl + CW_BAR), (volatile LAS unsigned*)(F.lds + MISC_OFF));
#ifndef PH_MASK
#define PH_MASK 0xffff
#endif
#define IN(k) (((PH_MASK >> (k)) & 1) && lo <= (k) && (k) < hi)
#define SEAM(k) do { if (IN(k) && IN((k) + 1)) xcd_barrier(bar); } while (0)
    unsigned char* ws = args.ws;
#ifndef PROBE_DUP
#define PROBE_DUP 0
#endif
#define DUPBAR(k) if ((PROBE_DUP >> (k)) & 1) xcd_barrier(bar)
#define DUP2(k, body) do { body; if ((PROBE_DUP >> (k)) & 1) { xcd_barrier(bar); body; } } while (0)
    if (IN(0)) { DUP2(0, p0_prologue(F)); } SEAM(0);
    if (IN(1)) { DUP2(1, p1_norm(F)); } SEAM(1);
    if (IN(2)) { {
        const int GW = (F.G == 256) ? 192 : F.G; const int nr = ((PROBE_DUP >> 2) & 1) ? 2 : 1;
        if (F.bx < GW) {
            const int r1 = (128 * 4 + 8) % GW, r2 = (r1 + 128 * 16) % GW; const int c1 = F.bx, c2 = (F.bx - r1 + GW) % GW, c3 = (F.bx - r2 + GW) % GW;
            { SchedIn S{GW, c1, 128 * 4, 4, 0, nr, (const char*)(ws + WS_U), (const char*)(ws + WS_WIN)}; EpiInA E{ws};
              pg8::gemm_phase<EpiInA, SchedIn>(F.lds, D, S, E); }
            { SchedIn S{GW, c2, 128 * 16, 16, 2, nr, (const char*)(ws + WS_U8), (const char*)(ws + WS_WIN8)}; EpiInG8 E{(unsigned char*)(ws + WS_UG)};
              pg8::gemm_phase<EpiInG8, SchedIn>(F.lds, D, S, E); }
            { SchedIn S{GW, c3, 128 * 12, 12, 1, nr, (const char*)(ws + WS_U), (const char*)(ws + WS_WIN)}; EpiInH E{(bf16*)(ws + WS_UH)};
              pg8::gemm_phase<EpiInH, SchedIn>(F.lds, D, S, E); }
        }
        moe_weight_queue(F);
        }
    } SEAM(2);
    if (IN(3)) { DUP2(3, s5_pass3<false>(F)); p3_publish(F); }
    if (IN(4)) { int q4w = CW_Q4; DUP2(4, (p4_hyena_carry(F, q4w), q4w += 16)); } SEAM(4);
    if (IN(5)) { DUP2(5, s5_pass3<true>(F)); __syncthreads(); DUP2(14, yh_transpose(F)); } SEAM(5);
    if (IN(6)) { { SchedStd S{F.G, F.bx, 4, 1024, ((PROBE_DUP >> 6) & 1) ? 2 : 1, (const char*)(ws + WS_Y), (const char*)(ws + WS_WGLU)}; EpiMix<0> E{(const bf16*)(ws + WS_Y), nullptr, (bf16*)(ws + WS_YA)};
        pg8::gemm_phase<EpiMix<0>, SchedStd>(F.lds, 1024, S, E); } } SEAM(6);
    if (IN(7)) { { SchedStd S{F.G, F.bx, 8, 1024, ((PROBE_DUP >> 7) & 1) ? 2 : 1, (const char*)(ws + WS_YA), (const char*)(ws + WS_WBS5)}; EpiMix<1> E{(const bf16*)(ws + WS_UG), nullptr, (bf16*)(ws + WS_T1)};
        pg8::gemm_phase<EpiMix<1>, SchedStd>(F.lds, 1024, S, E); } }
    if (!(IN(7) && IN(8))) { SEAM(7); }
    if (IN(8)) { { SchedStd S{F.G, F.bx, 8, 1024, ((PROBE_DUP >> 8) & 1) ? 2 : 1, (const char*)(ws + WS_YH), (const char*)(ws + WS_WBHY)}; EpiMix<2> E{(const bf16*)(ws + WS_UG), (const bf16*)(ws + WS_T1), (bf16*)(ws + WS_T)};
        pg8::gemm_phase<EpiMix<2>, SchedStd>(F.lds, 1024, S, E); } } SEAM(8);
    if (IN(9)) { { SchedStd S{F.G, F.bx, 8, 2048, ((PROBE_DUP >> 9) & 1) ? 2 : 1, (const char*)(ws + WS_T), (const char*)(ws + WS_WO), 1}; EpiOut E{F.in[IN_X], (const float*)(ws + WS_MOD), (bf16*)(ws + WS_H1)};
        pg8::gemm_phase<EpiOut, SchedStd>(F.lds, 2048, S, E); } } SEAM(9);
    if (IN(10)) { p10_router(F); } SEAM(10);
    if (IN(11)) { { moe_tables(F); volatile LAS int* tb = (volatile LAS int*)(F.lds + LDS_X);
        SchedMoe<true> S{F.G, F.bx, 16, 4096, 2048, ((PROBE_DUP >> 11) & 1) ? 2 : 1, (const char*)(ws + WS_HM8), (const char*)(ws + WS_WGU), (const int*)(ws + WS_LIST), tb}; EpiMoe1 E{F.in[IN_BGU], (unsigned char*)(ws + WS_ACT)};
        pg8::gemm_phase<EpiMoe1, SchedMoe<true>>(F.lds, 2048, S, E); } } SEAM(11);
    if (IN(12)) { { moe_tables(F); volatile LAS int* tb = (volatile LAS int*)(F.lds + LDS_X);
        SchedMoe<false> S{F.G, F.bx, 8, 2048, 2048, ((PROBE_DUP >> 12) & 1) ? 2 : 1, (const char*)(ws + WS_ACT), (const char*)(ws + WS_WDN), (const int*)(ws + WS_LIST), tb}; EpiMoe2 E{F.in[IN_BDN], (const float*)(ws + WS_GATE), (const int*)(ws + WS_LIST), (unsigned char*)(ws + WS_YS), tb};
        pg8::gemm_phase<EpiMoe2, SchedMoe<false>>(F.lds, 2048, S, E); } } SEAM(12);
    if (IN(13)) { DUP2(13, p13_final(F)); }
#undef IN
#undef SEAM
}

extern "C" void kernel_launch(void* const* d_in, const int* in_sizes, int n_in, void* d_out, int out_size, void* d_ws, size_t ws_size, hipStream_t stream) {
    static int grid = 0;
    if (grid == 0) {
        if (n_in != 39 || out_size != NTOK * D || ws_size < WS_END) { fprintf(stderr, "kernel_launch: unexpected shapes: n_in %d out %d ws %zu (need %zu)\n", n_in, out_size, ws_size, (size_t)WS_END); grid = -1; return; }
        int dev = 0, cus = 0, per_cu = 0;
        if (hipGetDevice(&dev) != hipSuccess || hipDeviceGetAttribute(&cus, hipDeviceAttributeMultiprocessorCount, dev) != hipSuccess) { grid = -1; return; }
        if (hipFuncSetAttribute((const void*)fwd, hipFuncAttributeMaxDynamicSharedMemorySize, LDS_BYTES) != hipSuccess) { fprintf(stderr, "kernel_launch: hipFuncSetAttribute failed\n"); grid = -1; return; }
        if (hipOccupancyMaxActiveBlocksPerMultiprocessor(&per_cu, (const void*)fwd, NTHR, LDS_BYTES) != hipSuccess || per_cu < 1) fprintf(stderr, "kernel_launch: occupancy query says %d\n", per_cu);
        (void)hipGetLastError();
        grid = cus;
    }
    if (grid < 0) return;
    if (hipMemsetAsync((char*)d_ws + WS_CTL, 0, CTL_ZERO_BYTES, stream) != hipSuccess) return;
    Args a{};
    for (int i = 0; i < 39; ++i) a.in[i] = (const float*)d_in[i];
    a.out = (float*)d_out; a.ws = (unsigned char*)d_ws;
#ifndef ONE_LAUNCH
#define ONE_LAUNCH 1
#endif
    if (ONE_LAUNCH) { a.ph_lo = 0; a.ph_hi = NPHASE; hipLaunchKernelGGL(fwd, dim3(grid), dim3(NTHR), LDS_BYTES, stream, a); }
    else for (int p = 0; p < NPHASE; ++p) { a.ph_lo = p; a.ph_hi = p + 1; hipLaunchKernelGGL(fwd, dim3(grid), dim3(NTHR), LDS_BYTES, stream, a); }
}
```

```cpp
#include <hip/hip_runtime.h>
#include <cstdio>
#include <cstdint>

#define GAS __attribute__((address_space(1)))
#define LAS __attribute__((address_space(3)))
typedef unsigned short bf16;
typedef short bf16x8 __attribute__((ext_vector_type(8)));
typedef float f32x4 __attribute__((ext_vector_type(4)));
typedef float f32x16 __attribute__((ext_vector_type(16)));
typedef float f32x2 __attribute__((ext_vector_type(2)));
typedef unsigned u32x4 __attribute__((ext_vector_type(4)));
typedef unsigned u32x2 __attribute__((ext_vector_type(2)));
typedef int i32x4 __attribute__((ext_vector_type(4)));
typedef int i32x8 __attribute__((ext_vector_type(8)));

constexpr int D = 2048, NB = 2, SEQ = 16384, NTOK = NB * SEQ, CTX = 256, NCTX = NB * CTX;
constexpr int S5W = 1024, HYW = 1024, INC = 8192, NEXP = 32, TOPK = 4, DEXP = 2048;
constexpr int NCH = 260;
constexpr int LISTCAP = 32768;

constexpr size_t MiB = 1u << 20;
constexpr size_t WS_CTL = 0, CTL_ZERO_BYTES = 1 * MiB;
constexpr size_t WS_MOD = 6 * MiB;
constexpr size_t WS_BBT = 7 * MiB;
constexpr size_t WS_CTT = WS_BBT + 512 * 1024;
constexpr size_t WS_LAM = 8 * MiB;
constexpr size_t WS_RWT = 8 * MiB + 256 * 1024;
constexpr size_t WS_BB2 = 8 * MiB + 512 * 1024;
constexpr size_t WS_WIN = 16 * MiB;
constexpr size_t WS_WGLU = 48 * MiB;
constexpr size_t WS_WBS5 = 50 * MiB;
constexpr size_t WS_WBHY = 54 * MiB;
constexpr size_t WS_WO = 58 * MiB;
constexpr size_t WS_WGU = 66 * MiB;
constexpr size_t WS_WDN = 578 * MiB;
constexpr size_t WS_U = 834 * MiB;
constexpr size_t WS_UCA = 964 * MiB;
constexpr size_t WS_UA = 966 * MiB;
constexpr size_t WS_UH = 1030 * MiB;
constexpr size_t WS_UG = 1222 * MiB;
constexpr size_t WS_E = 1478 * MiB;
constexpr size_t WS_SIN = 1511 * MiB;
constexpr size_t WS_FILT = 1544 * MiB;
constexpr size_t WS_HYS = 1800 * MiB;
constexpr size_t HYS_STRIDE = 768 * 1024;
constexpr size_t WS_YHCM = 1992 * MiB;
constexpr size_t WS_YH = 2056 * MiB;
constexpr size_t WS_Y = 2120 * MiB;
constexpr size_t WS_YA = 2184 * MiB;
constexpr size_t WS_T1 = 2248 * MiB;
constexpr size_t WS_T = 2376 * MiB;
constexpr size_t WS_HM = 2504 * MiB;
constexpr size_t WS_GATE = 2632 * MiB;
constexpr size_t WS_LIST = 2633 * MiB;
constexpr size_t WS_ACT = 2638 * MiB;
constexpr size_t WS_YS = 3182 * MiB;
constexpr size_t WS_H1 = 3694 * MiB;
constexpr size_t WS_HM8 = WS_T1;
constexpr size_t WS_U8 = WS_ACT;
constexpr size_t WS_WIN8 = WS_YS;
constexpr size_t WS_END = 3950 * MiB;
constexpr long long YS_DUMP_OFF = (long long)(2 * MiB) - (long long)WS_YS;

constexpr int CW_TMO = 0;
constexpr int CW_Q4 = 64;
constexpr int CW_P3 = 112;
constexpr int CW_QT = 96;
constexpr int CW_CNT = 128;
constexpr int CW_BAR = 4096;

constexpr int RING_BYTES = 131072;
constexpr int LDS_X = 131072;
constexpr int MISC_OFF = 147456 - 512;
constexpr int LDS_BYTES = 147456;
constexpr int NWAVES = 8, NTHR = 512;
constexpr int NPHASE = 14;

__device__ __forceinline__ unsigned f2bf(float f) { unsigned u = __builtin_bit_cast(unsigned, f); return (u + 0x7fffu + ((u >> 16) & 1u)) >> 16; }
__device__ __forceinline__ unsigned pk2(float lo, float hi) { return f2bf(lo) | (f2bf(hi) << 16); }
__device__ __forceinline__ float bf2f(unsigned short b) { return __builtin_bit_cast(float, ((unsigned)b) << 16); }
__device__ __forceinline__ float bflo(unsigned w) { return __builtin_bit_cast(float, w << 16); }
__device__ __forceinline__ float bfhi(unsigned w) { return __builtin_bit_cast(float, w & 0xffff0000u); }
typedef __bf16 bf16x2_t __attribute__((ext_vector_type(2)));
__device__ __forceinline__ unsigned cvt_pk_bf16(float lo, float hi) { const f32x2 v = {lo, hi}; const bf16x2_t b = __builtin_convertvector(v, bf16x2_t); return __builtin_bit_cast(unsigned, b); }
__device__ __forceinline__ unsigned pk4_fp8(float a, float b, float c, float d) { unsigned w = 0u; w = (unsigned)__builtin_amdgcn_cvt_pk_fp8_f32(a, b, (int)w, false); w = (unsigned)__builtin_amdgcn_cvt_pk_fp8_f32(c, d, (int)w, true); return w; }
constexpr float Y8SCALE = 8.0f;
constexpr float T8SCALE = 16.0f;
constexpr float W8SCALE = 64.0f;
__device__ __forceinline__ float sigmoidf_(float x) { return __builtin_amdgcn_rcpf(1.0f + __expf(-x)); }
__device__ __forceinline__ float sin_rev(float r) { return __builtin_amdgcn_sinf(__builtin_amdgcn_fractf(r)); }
__device__ __forceinline__ float cos_rev(float r) { return __builtin_amdgcn_cosf(__builtin_amdgcn_fractf(r)); }
__device__ __forceinline__ float wave_sum(float v) {
#pragma unroll
    for (int o = 1; o < 64; o <<= 1) v += __shfl_xor(v, o);
    return v;
}
__device__ __forceinline__ float wave_max(float v) {
#pragma unroll
    for (int o = 1; o < 64; o <<= 1) v = fmaxf(v, __shfl_xor(v, o));
    return v;
}
__device__ __forceinline__ f32x2 cmul(f32x2 a, f32x2 b) { return (f32x2){a.x * b.x - a.y * b.y, a.x * b.y + a.y * b.x}; }
#define LDS_WAIT() asm volatile("s_waitcnt lgkmcnt(0)" ::: "memory")
#define VM_WAIT() asm volatile("s_waitcnt vmcnt(0)" ::: "memory")

namespace pg8 {
constexpr int BM = 256, BK = 64, HALF = 128, HTB = HALF * BK * 2, STAGE_BYTES = 8 * HTB;
__host__ __device__ __forceinline__ int lds_byte(int r, int c) { const int st = (r >> 4) * 2 + (c >> 5), rr = r & 15, cc = c & 31, ob = rr * 64 + cc * 2; return st * 1024 + (ob ^ (((ob >> 9) & 1) << 5)); }
__host__ __device__ __forceinline__ void stage_rc(int b, int& R, int& C) { const int st = b / 1024, sb = b % 1024, swz = sb ^ (((sb >> 9) & 1) << 5); R = (st >> 1) * 16 + swz / 64; C = (st & 1) * 32 + (swz % 64) / 2; }
__host__ __device__ __forceinline__ int perm32(int rho) { const int n = rho >> 4, i = rho & 15; return 8 * (i >> 2) + 4 * n + (i & 3); }

struct Unit { int pm, pn, e, valid; };

template <class Epi, class Sched>
__device__ __forceinline__ void gemm_phase(LAS unsigned char* lds, const int Kel, const Sched& S, const Epi& E) {
    const int tid = threadIdx.x, wid = __builtin_amdgcn_readfirstlane(tid >> 6), lane = tid & 63, wr = wid >> 2, wc = wid & 3, fr = lane & 15, fq = lane >> 4;
    const int K = Epi::FP8 ? (Kel >> 1) : Kel;
    const int nt = K / BK;
    int Rs[2], Cs[2]; unsigned voffB[2];
#pragma unroll
    for (int i = 0; i < 2; ++i) { int R, C; stage_rc(tid * 16 + i * 8192, R, C); Rs[i] = R; Cs[i] = C; const int Rb = Epi::PERM ? ((R & ~31) + perm32(R & 31)) : R; voffB[i] = (unsigned)(Rb * K + C) * 2u; }
    const size_t kstep = (size_t)(BK * 2);
    const size_t hstep = (size_t)HALF * K * 2;
    const unsigned ldsw = (unsigned)wid * 1024u;
    const int aoff = lds_byte(wr * 64 + fr, fq * 8), boff = lds_byte(wc * 32 + fr, fq * 8);
    const int aoff8 = lds_byte(wr * 64 + fr, fq * 16), boff8 = lds_byte(wc * 32 + fr, fq * 16);
#define PG8_SA(b, h) (((b) * 2 + (h)) * HTB)
#define PG8_SB(b, h) ((4 + (b) * 2 + (h)) * HTB)
#define PG8_STAGE(bufoff, gbase, voff) do { _Pragma("unroll") for (int _i = 0; _i < 2; ++_i) \
        __builtin_amdgcn_global_load_lds((const unsigned*)((const char*)(gbase) + (voff)[_i]), (LAS unsigned*)(lds + (bufoff) + ldsw + _i * 8192), 16, 0, 0); } while (0)
#define PG8_LDA(dst, b, h) do { if constexpr (Epi::FP8) { _Pragma("unroll") for (int m = 0; m < 4; ++m) { const i32x4 lo_ = *(const LAS i32x4*)(lds + PG8_SA(b, h) + aoff8 + m * 2048), hi_ = *(const LAS i32x4*)(lds + PG8_SA(b, h) + aoff8 + m * 2048 + 16); dst##8[m] = __builtin_shufflevector(lo_, hi_, 0, 1, 2, 3, 4, 5, 6, 7); } } \
        else { _Pragma("unroll") for (int m = 0; m < 4; ++m) _Pragma("unroll") for (int k = 0; k < 2; ++k) dst[m][k] = *(const LAS bf16x8*)(lds + PG8_SA(b, h) + aoff + m * 2048 + k * 1024); } } while (0)
#define PG8_LDB(dst, b, h) do { if constexpr (Epi::FP8) { _Pragma("unroll") for (int n = 0; n < 2; ++n) { const i32x4 lo_ = *(const LAS i32x4*)(lds + PG8_SB(b, h) + boff8 + n * 2048), hi_ = *(const LAS i32x4*)(lds + PG8_SB(b, h) + boff8 + n * 2048 + 16); dst##8[n] = __builtin_shufflevector(lo_, hi_, 0, 1, 2, 3, 4, 5, 6, 7); } } \
        else { _Pragma("unroll") for (int n = 0; n < 2; ++n) _Pragma("unroll") for (int k = 0; k < 2; ++k) dst[n][k] = *(const LAS bf16x8*)(lds + PG8_SB(b, h) + boff + n * 2048 + k * 1024); } } while (0)
#define PG8_MMA(ai, bj, At, Bt) do { __builtin_amdgcn_s_setprio(1); \
        if constexpr (Epi::FP8) { _Pragma("unroll") for (int m = 0; m < 4; ++m) _Pragma("unroll") for (int n = 0; n < 2; ++n) \
            asm volatile("v_mfma_scale_f32_16x16x128_f8f6f4 %0, %1, %2, %0, %3, %3 op_sel_hi:[0,0,0]" : "+v"(acc[ai][bj][m][n]) : "v"(Bt##8[n]), "v"(At##8[m]), "v"(scl1)); } \
        else { _Pragma("unroll") for (int m = 0; m < 4; ++m) _Pragma("unroll") for (int n = 0; n < 2; ++n) _Pragma("unroll") for (int k = 0; k < 2; ++k) \
        acc[ai][bj][m][n] = Epi::TRANS ? __builtin_amdgcn_mfma_f32_16x16x32_bf16(Bt[n][k], At[m][k], acc[ai][bj][m][n], 0, 0, 0) \
                                       : __builtin_amdgcn_mfma_f32_16x16x32_bf16(At[m][k], Bt[n][k], acc[ai][bj][m][n], 0, 0, 0); } __builtin_amdgcn_s_setprio(0); } while (0)
#define PG8_WAIT_V(n) asm volatile("s_waitcnt vmcnt(" #n ")" ::: "memory")
#define PG8_WAIT_L(n) asm volatile("s_waitcnt lgkmcnt(" #n ")" ::: "memory")
#define PG8_BAR __builtin_amdgcn_s_barrier()
#define PG8_SCHED __builtin_amdgcn_sched_barrier(0)
    Unit cur, nxt; int ui = 0;
    if (!S.next(0, cur)) return;
    f32x4 acc[2][2][4][2];
#pragma unroll
    for (int a = 0; a < 2; ++a)
#pragma unroll
        for (int b = 0; b < 2; ++b)
#pragma unroll
            for (int m = 0; m < 4; ++m)
#pragma unroll
                for (int n = 0; n < 2; ++n) acc[a][b][m][n] = (f32x4){0.f, 0.f, 0.f, 0.f};
    bf16x8 At[4][2], B0[2][2], B1[2][2]; i32x8 At8[4], B08[2], B18[2]; const int scl1 = 0x7F7F7F7F;
    const char* const Ab = S.a_base();
    const char* cB = S.b_base(cur);
    unsigned vC0[2], vC1[2];
#pragma unroll
    for (int i = 0; i < 2; ++i) { vC0[i] = (S.a_row(cur, Rs[i]) * (unsigned)K + (unsigned)Cs[i]) * 2u; vC1[i] = (S.a_row(cur, HALF + Rs[i]) * (unsigned)K + (unsigned)Cs[i]) * 2u; }
    PG8_STAGE(PG8_SB(0, 0), cB, voffB); PG8_STAGE(PG8_SB(0, 1), cB + hstep, voffB); PG8_STAGE(PG8_SA(0, 0), Ab, vC0); PG8_STAGE(PG8_SA(0, 1), Ab, vC1);
    if (wr == 1) PG8_BAR;
    PG8_WAIT_V(2); PG8_BAR;
    PG8_STAGE(PG8_SB(1, 0), cB + kstep, voffB); PG8_STAGE(PG8_SA(1, 0), Ab + kstep, vC0); PG8_STAGE(PG8_SB(1, 1), cB + hstep + kstep, voffB);
    PG8_WAIT_V(6); PG8_BAR;
    for (;;) {
        const bool has_next = S.next(ui + 1, nxt);
        const char* nB = has_next ? S.b_base(nxt) : cB;
        for (int t = 0; t < nt; t += 2) {
            const bool last = (t == nt - 2);
            const char* a1 = Ab + (size_t)(t + 1) * kstep;
            const char* a2 = last ? Ab : Ab + (size_t)(t + 2) * kstep; const char* b2 = last ? nB : cB + (size_t)(t + 2) * kstep;
            const char* a3 = a2 + kstep; const char* b3 = b2 + kstep;
            unsigned vX0[2], vX1[2];
            if (last && has_next) {
#pragma unroll
                for (int i = 0; i < 2; ++i) { vX0[i] = (S.a_row(nxt, Rs[i]) * (unsigned)K + (unsigned)Cs[i]) * 2u; vX1[i] = (S.a_row(nxt, HALF + Rs[i]) * (unsigned)K + (unsigned)Cs[i]) * 2u; }
            } else {
#pragma unroll
                for (int i = 0; i < 2; ++i) { vX0[i] = vC0[i]; vX1[i] = vC1[i]; }
            }
            PG8_LDB(B0, 0, 0); PG8_LDB(B1, 0, 1); PG8_SCHED; PG8_LDA(At, 0, 0); PG8_STAGE(PG8_SA(1, 1), a1, vC1);
            PG8_WAIT_V(8); PG8_WAIT_L(0); PG8_BAR; PG8_MMA(0, 0, At, B0); PG8_MMA(0, 1, At, B1); PG8_BAR; PG8_SCHED;
            PG8_LDA(At, 0, 1); PG8_STAGE(PG8_SB(0, 0), b2, voffB); PG8_STAGE(PG8_SB(0, 1), b2 + hstep, voffB); PG8_STAGE(PG8_SA(0, 0), a2, vX0);
            PG8_WAIT_V(8); PG8_WAIT_L(0); PG8_BAR; PG8_MMA(1, 0, At, B0); PG8_MMA(1, 1, At, B1); PG8_BAR; PG8_SCHED;
            PG8_LDB(B0, 1, 0); PG8_LDB(B1, 1, 1); PG8_SCHED; PG8_LDA(At, 1, 0); PG8_STAGE(PG8_SA(0, 1), a2, vX1);
            PG8_WAIT_V(8); PG8_WAIT_L(0); PG8_BAR; PG8_MMA(0, 0, At, B0); PG8_MMA(0, 1, At, B1); PG8_BAR; PG8_SCHED;
            PG8_LDA(At, 1, 1); PG8_STAGE(PG8_SB(1, 0), b3, voffB); PG8_STAGE(PG8_SB(1, 1), b3 + hstep, voffB); PG8_STAGE(PG8_SA(1, 0), a3, vX0);
            PG8_WAIT_V(8); PG8_WAIT_L(0); PG8_BAR; PG8_MMA(1, 0, At, B0); PG8_MMA(1, 1, At, B1); PG8_BAR; PG8_SCHED;
            if (last) {
#pragma unroll
                for (int i = 0; i < 2; ++i) { vC0[i] = vX0[i]; vC1[i] = vX1[i]; }
            }
        }
        if (wr == 0) PG8_BAR;
        if constexpr (Epi::FP8) asm volatile("s_nop 15\n\ts_nop 15" ::: "memory");
        E(acc, cur, wr, wc, fr, fq);
        if (!has_next) break;
#pragma unroll
        for (int a = 0; a < 2; ++a)
#pragma unroll
            for (int b = 0; b < 2; ++b)
#pragma unroll
                for (int m = 0; m < 4; ++m)
#pragma unroll
                    for (int n = 0; n < 2; ++n) acc[a][b][m][n] = (f32x4){0.f, 0.f, 0.f, 0.f};
        cur = nxt; cB = nB; ++ui;
        if (wr == 1) PG8_BAR;
    }
    PG8_WAIT_V(0);
    PG8_BAR;
#undef PG8_SA
#undef PG8_SB
#undef PG8_STAGE
#undef PG8_LDA
#undef PG8_LDB
#undef PG8_MMA
#undef PG8_WAIT_V
#undef PG8_WAIT_L
#undef PG8_BAR
#undef PG8_SCHED
}
}

#define XB_TMO      128
#define XB_XCNT(j)  (256  + 64 * (j))
#define XB_XSUB(j)  (1280 + 64 * (j))
#define XB_XGEN(j)  (2304 + 64 * (j))
#define XB_TOP      3328
#define XB_TOPGEN   3392
#define XCD_BAR_WORDS 3456
#define XB_SPIN_CAP (1u << 22)
__device__ __forceinline__ unsigned xb_ld(unsigned* p)              { return __hip_atomic_load(p, __ATOMIC_RELAXED, __HIP_MEMORY_SCOPE_AGENT); }
__device__ __forceinline__ unsigned xb_add(unsigned* p, unsigned v) { return __hip_atomic_fetch_add(p, v, __ATOMIC_RELAXED, __HIP_MEMORY_SCOPE_AGENT); }
__device__ __forceinline__ unsigned xb_xcc_id() { return (unsigned)__builtin_amdgcn_s_getreg((3 << 11) | 20) & 0xFu; }
#define XB_SPIN(cond, bar) do { unsigned _sp = 0; while (cond) { __builtin_amdgcn_s_sleep(1); \
    if ((++_sp & 255u) == 0u) { if (xb_ld(&(bar)[XB_TMO])) break; if (_sp > XB_SPIN_CAP) { atomicAdd(&(bar)[XB_TMO], 1u); break; } } } } while (0)
struct XcdBarrier { unsigned* bar; unsigned x; volatile LAS unsigned* st; };
__device__ __forceinline__ XcdBarrier xcd_barrier_post(unsigned* bar, volatile LAS unsigned* st) {
    XcdBarrier b; b.bar = bar; b.x = xb_xcc_id(); b.st = st;
    if (threadIdx.x == 0) (void)xb_add(&bar[XB_XCNT(b.x)], 1u);
    return b;
}
__device__ __forceinline__ void xcd_barrier_complete(unsigned* bar, unsigned x, unsigned& nloc, unsigned& nx) {
    const unsigned G = gridDim.x * gridDim.y * gridDim.z;
    unsigned sum, cnt, mine, sp = 0u;
    for (;;) {
        sum = 0u; cnt = 0u; mine = 0u;
#pragma unroll
        for (unsigned j = 0; j < 16; ++j) { const unsigned c = xb_ld(&bar[XB_XCNT(j)]); sum += c; cnt += (c > 0u) ? 1u : 0u; mine = (j == x) ? c : mine; }
        if (sum == G) break;
        __builtin_amdgcn_s_sleep(1);
        if ((++sp & 255u) == 0u) { if (xb_ld(&bar[XB_TMO])) break; if (sp > XB_SPIN_CAP) { atomicAdd(&bar[XB_TMO], 1u); break; } }
    }
    nloc = mine > 0u ? mine : 1u; nx = cnt > 0u ? cnt : 1u;
}
__device__ __forceinline__ void xcd_barrier(const XcdBarrier& b) {
    asm volatile("s_waitcnt vmcnt(0)" ::: "memory");
    __syncthreads();
    if (threadIdx.x == 0) {
        unsigned* bar = b.bar;
        __builtin_amdgcn_s_waitcnt(0);
        unsigned nloc = b.st[0], nx = b.st[1];
        if (nloc == 0u) { xcd_barrier_complete(bar, b.x, nloc, nx); b.st[0] = nloc; b.st[1] = nx; }
        const unsigned old = xb_add(&bar[XB_XSUB(b.x)], 1u);
        const unsigned gen = old / nloc;
        if (old + 1u == (gen + 1u) * nloc) {
            __builtin_amdgcn_fence(__ATOMIC_RELEASE, "agent");
            asm volatile("s_waitcnt vmcnt(0)" ::: "memory");
            const unsigned og = xb_add(&bar[XB_TOP], 1u);
            const unsigned tg = og / nx;
            if (og + 1u == (tg + 1u) * nx) xb_add(&bar[XB_TOPGEN], 1u);
            else XB_SPIN(xb_ld(&bar[XB_TOPGEN]) == tg, bar);
            __builtin_amdgcn_fence(__ATOMIC_ACQUIRE, "agent");
            xb_add(&bar[XB_XGEN(b.x)], 1u);
            asm volatile("s_waitcnt vmcnt(0)" ::: "memory");
        } else {
            XB_SPIN(xb_ld(&bar[XB_XGEN(b.x)]) == gen, bar);
            __builtin_amdgcn_fence(__ATOMIC_ACQUIRE, "agent");
            asm volatile("s_waitcnt vmcnt(0)" ::: "memory");
        }
    }
    __syncthreads();
}

struct Args { const float* in[39]; float* out; unsigned char* ws; int ph_lo, ph_hi; };
struct Frame {
    LAS unsigned char* lds;
    int tid, lane, wave, G, bx;
    const float* const* in; float* out; unsigned char* ws;
    GAS unsigned* ctl;
};
#define IN_X 0
#define IN_C 1
#define IN_CTX 2
#define IN_CCTX 3
#define IN_WADA 4
#define IN_BADA 5
#define IN_N1G 6
#define IN_N2G 7
#define IN_WIN 8
#define IN_LRE 9
#define IN_LIM 10
#define IN_LDT 11
#define IN_BRE 12
#define IN_BIM 13
#define IN_CRE 14
#define IN_CIM 15
#define IN_S5D 16
#define IN_WGLU 17
#define IN_HSW 18
#define IN_HW1 19
#define IN_HB1 20
#define IN_HF1 21
#define IN_HW2 22
#define IN_HB2 23
#define IN_HF2 24
#define IN_HW3 25
#define IN_HB3 26
#define IN_HDEC 27
#define IN_HBIAS 28
#define IN_WBS5 29
#define IN_WBHY 30
#define IN_WO 31
#define IN_RW 32
#define IN_RB 33
#define IN_WGU 34
#define IN_BGU 35
#define IN_WDN 36
#define IN_BDN 37
#define IN_FG 38

__device__ __forceinline__ void p0_adaln_item(Frame& F, int cb) {
    LAS float* sl = (LAS float*)F.lds;
    const float* c = F.in[IN_C]; const float* cc = F.in[IN_CCTX]; const float* W = F.in[IN_WADA];
    for (int i = F.tid; i < 3 * 2048; i += NTHR) { const int v = i >> 11, k = i & 2047; const float cv = (v < 2) ? c[v * 2048 + k] : cc[k]; sl[i] = cv * sigmoidf_(cv); }
    __syncthreads();
    const int col = F.tid % 48, ks = F.tid / 48;
    float a0 = 0.f, a1 = 0.f, a2 = 0.f;
    if (ks < 10) { const float* wp = W + 48 * cb + col;
#pragma unroll 16
        for (int j = 0; j < 205; ++j) { const int k = ks + 10 * j; if (k < 2048) { const float w = wp[(size_t)k * 12288]; a0 += sl[k] * w; a1 += sl[2048 + k] * w; a2 += sl[4096 + k] * w; } } }
    LAS float* red = sl + 6144;
    if (ks < 10) { red[(ks * 48 + col) * 3 + 0] = a0; red[(ks * 48 + col) * 3 + 1] = a1; red[(ks * 48 + col) * 3 + 2] = a2; }
    __syncthreads();
    if (F.tid < 144) { const int v = F.tid / 48, cl = F.tid % 48; float sacc = 0.f;
#pragma unroll
        for (int q = 0; q < 10; ++q) sacc += red[(q * 48 + cl) * 3 + v];
        ((float*)(F.ws + WS_MOD))[v * 12288 + 48 * cb + cl] = sacc + F.in[IN_BADA][48 * cb + cl]; }
    __syncthreads();
}
__device__ __forceinline__ void p0_filt_item(Frame& F, int tb) {
    LAS float* ft = (LAS float*)F.lds;
    LAS float* h1 = ft + 64 * 36;
    LAS float* h2 = h1 + 64 * 65;
    const int t0 = tb * 64, tl = F.tid >> 3, q = F.tid & 7; const float tf = (float)(t0 + tl);
    for (int f = q; f < 33; f += 8) {
        float v;
        if (f == 0) v = tf * (1.0f / 16383.0f);
        else { const int bi = (f - 1) & 15; const float band = 1e-4f + (float)bi * ((15.0f - 1e-4f) / 15.0f); const float rev = tf * band * (1.0f / 16384.0f);
               v = (f <= 16) ? cos_rev(rev) : -sin_rev(rev); }
        ft[tl * 36 + f] = v;
    }
    LAS float* w1s = ft + 13312; LAS float* w2s = w1s + 33 * 64;
    for (int i = F.tid; i < 33 * 64; i += NTHR) w1s[i] = F.in[IN_HW1][i];
    for (int i = F.tid; i < 64 * 64; i += NTHR) w2s[i] = F.in[IN_HW2][i];
    __syncthreads();
    { const float* b1 = F.in[IN_HB1]; const float* f1 = F.in[IN_HF1]; float a[8];
#pragma unroll
      for (int jj = 0; jj < 8; ++jj) a[jj] = b1[q * 8 + jj];
#pragma unroll 11
      for (int f = 0; f < 33; ++f) { const float xv = ft[tl * 36 + f]; const f32x4 wa = *(const LAS f32x4*)(w1s + f * 64 + q * 8), wb = *(const LAS f32x4*)(w1s + f * 64 + q * 8 + 4);
          a[0] += xv * wa.x; a[1] += xv * wa.y; a[2] += xv * wa.z; a[3] += xv * wa.w; a[4] += xv * wb.x; a[5] += xv * wb.y; a[6] += xv * wb.z; a[7] += xv * wb.w; }
#pragma unroll
      for (int jj = 0; jj < 8; ++jj) { const int j = q * 8 + jj; h1[tl * 65 + j] = sin_rev(f1[j] * a[jj] * 0.15915494309189535f); } }
    __syncthreads();
    { const float* b2 = F.in[IN_HB2]; const float* f2 = F.in[IN_HF2]; float a[8];
#pragma unroll
      for (int jj = 0; jj < 8; ++jj) a[jj] = b2[q * 8 + jj];
#pragma unroll 16
      for (int i = 0; i < 64; ++i) { const float xv = h1[tl * 65 + i]; const f32x4 wa = *(const LAS f32x4*)(w2s + i * 64 + q * 8), wb = *(const LAS f32x4*)(w2s + i * 64 + q * 8 + 4);
          a[0] += xv * wa.x; a[1] += xv * wa.y; a[2] += xv * wa.z; a[3] += xv * wa.w; a[4] += xv * wb.x; a[5] += xv * wb.y; a[6] += xv * wb.z; a[7] += xv * wb.w; }
#pragma unroll
      for (int jj = 0; jj < 8; ++jj) { const int j = q * 8 + jj; h2[tl * 64 + j] = sin_rev(f2[j] * a[jj] * 0.15915494309189535f); } }
    __syncthreads();
    LAS unsigned short* hb = (LAS unsigned short*)(h2 + 64 * 64);
    for (int i = F.tid; i < 64 * 64; i += NTHR) hb[(i >> 6) * 72 + (i & 63)] = (unsigned short)f2bf(h2[i]);
    __syncthreads();
    const float* w3 = F.in[IN_HW3]; const float* b3 = F.in[IN_HB3]; const float* dec = F.in[IN_HDEC]; bf16* FILT = (bf16*)(F.ws + WS_FILT);
    const int fr = F.lane & 15, fq = F.lane >> 4;
    bf16x8 af[4][2];
#pragma unroll
    for (int m = 0; m < 4; ++m)
#pragma unroll
        for (int ks = 0; ks < 2; ++ks) af[m][ks] = *(const LAS bf16x8*)(hb + (16 * m + fr) * 72 + 32 * ks + 8 * fq);
#pragma unroll 4
    for (int jt = F.wave; jt < 256; jt += NWAVES) {
        const int j = 16 * jt + fr;
        bf16x8 bfr[2];
#pragma unroll
        for (int ks = 0; ks < 2; ++ks) { float w[8];
#pragma unroll
            for (int e = 0; e < 8; ++e) w[e] = w3[(size_t)(32 * ks + 8 * fq + e) * 4096 + j];
            u32x4 pk; pk.x = pk2(w[0], w[1]); pk.y = pk2(w[2], w[3]); pk.z = pk2(w[4], w[5]); pk.w = pk2(w[6], w[7]); bfr[ks] = __builtin_bit_cast(bf16x8, pk); }
        const float bb = b3[j], dd = fabsf(dec[j]) * (1.0f / 16383.0f);
#pragma unroll
        for (int m = 0; m < 4; ++m) { f32x4 acc = (f32x4){0.f, 0.f, 0.f, 0.f};
#pragma unroll
            for (int ks = 0; ks < 2; ++ks) acc = __builtin_amdgcn_mfma_f32_16x16x32_bf16(af[m][ks], bfr[ks], acc, 0, 0, 0);
            const int tb0 = t0 + 16 * m + 4 * fq; f32x4 o;
#pragma unroll
            for (int e = 0; e < 4; ++e) o[e] = (acc[e] + bb) * __expf(-(float)(tb0 + e) * dd);
            *(u32x2*)(FILT + (size_t)j * SEQ + tb0) = (u32x2){cvt_pk_bf16(o[0], o[1]), cvt_pk_bf16(o[2], o[3])}; }
    }
    __syncthreads();
}
__device__ __forceinline__ void p0_s5tab_item(Frame& F, int item) {
    const int idx = item * NTHR + F.tid; const int d = idx >> 12, g = (idx >> 6) & 63, p = idx & 63, dg = d * 64 + g;
    const float lr = F.in[IN_LRE][dg * 64 + p], li = F.in[IN_LIM][dg * 64 + p], dt = expf(F.in[IN_LDT][dg]);
    const float mag = expf(lr * dt), ang = li * dt; const float lbr = mag * cosf(ang), lbi = mag * sinf(ang);
    const float den = lr * lr + li * li, cr = ((lbr - 1.f) * lr + lbi * li) / den, ci = (lbi * lr - (lbr - 1.f) * li) / den;
    bf16* BBT = (bf16*)(F.ws + WS_BBT); bf16* BB2 = (bf16*)(F.ws + WS_BB2); bf16* CTT = (bf16*)(F.ws + WS_CTT); f32x2* LAM = (f32x2*)(F.ws + WS_LAM);
    const float* bre = F.in[IN_BRE] + (size_t)(dg * 64 + p) * 16; const float* bim = F.in[IN_BIM] + (size_t)(dg * 64 + p) * 16;
    for (int c = 0; c < 16; ++c) { const float br = bre[c], bi = bim[c];
        BBT[(size_t)(dg * 128 + p) * 16 + c] = (bf16)f2bf(cr * br - ci * bi); BBT[(size_t)(dg * 128 + 64 + p) * 16 + c] = (bf16)f2bf(cr * bi + ci * br);
        BB2[(size_t)(dg * 128 + 2 * p) * 16 + c] = (bf16)f2bf(cr * br - ci * bi); BB2[(size_t)(dg * 128 + 2 * p + 1) * 16 + c] = (bf16)f2bf(cr * bi + ci * br); }
    const int k = 2 * p;
    for (int c = 0; c < 16; ++c) { const float cre = F.in[IN_CRE][(size_t)(dg * 16 + c) * 64 + p], cim = F.in[IN_CIM][(size_t)(dg * 16 + c) * 64 + p];
        CTT[(size_t)(dg * 16 + c) * 128 + k] = (bf16)f2bf(cre); CTT[(size_t)(dg * 16 + c) * 128 + k + 1] = (bf16)f2bf(-cim); }
    LAM[dg * 64 + p] = (f32x2){lbr, lbi};
}
__device__ __forceinline__ void p0_transpose_item(const float* W, int K, int N, bf16* WT, LAS unsigned short* scr, int kb, int nb, int lane) {
    const int k0 = 64 * kb, n0 = 128 * nb;
    const float* wp = W + (size_t)(k0 + (lane >> 5)) * N + n0 + 4 * (lane & 31);
#pragma unroll
    for (int half = 0; half < 2; ++half) { f32x4 v[16];
#pragma unroll
        for (int i = 0; i < 16; ++i) v[i] = *(const GAS f32x4*)(wp + (size_t)(32 * half + 2 * i) * N);
#pragma unroll
        for (int i = 0; i < 16; ++i) { const int kk = 32 * half + 2 * i + (lane >> 5); LAS unsigned* d = (LAS unsigned*)(scr + kk * 130 + 4 * (lane & 31)); d[0] = pk2(v[i].x, v[i].y); d[1] = pk2(v[i].z, v[i].w); } }
    LDS_WAIT(); asm volatile("" ::: "memory");
    const int c = lane & 7;
#pragma unroll
    for (int j = 0; j < 16; ++j) { const int r = (lane >> 3) + 8 * j; const LAS unsigned short* sp = scr + (8 * c) * 130 + r;
        u32x4 o; o.x = (unsigned)sp[0] | ((unsigned)sp[130] << 16); o.y = (unsigned)sp[2 * 130] | ((unsigned)sp[3 * 130] << 16); o.z = (unsigned)sp[4 * 130] | ((unsigned)sp[5 * 130] << 16); o.w = (unsigned)sp[6 * 130] | ((unsigned)sp[7 * 130] << 16);
        *(GAS u32x4*)(WT + (size_t)(n0 + r) * K + k0 + 8 * c) = o; }
    LDS_WAIT(); asm volatile("" ::: "memory");
}
__device__ __forceinline__ void p0_transpose_item8(const float* W, int K, int N, unsigned char* WT, LAS unsigned short* scr, int kb, int nb, int lane) {
    const int k0 = 64 * kb, n0 = 128 * nb;
    const float* wp = W + (size_t)(k0 + (lane >> 5)) * N + n0 + 4 * (lane & 31);
#pragma unroll
    for (int half = 0; half < 2; ++half) { f32x4 v[16];
#pragma unroll
        for (int i = 0; i < 16; ++i) v[i] = *(const GAS f32x4*)(wp + (size_t)(32 * half + 2 * i) * N);
#pragma unroll
        for (int i = 0; i < 16; ++i) { const int kk = 32 * half + 2 * i + (lane >> 5); LAS unsigned* d = (LAS unsigned*)(scr + kk * 130 + 4 * (lane & 31)); d[0] = pk2(v[i].x, v[i].y); d[1] = pk2(v[i].z, v[i].w); } }
    LDS_WAIT(); asm volatile("" ::: "memory");
    const int c = lane & 7;
#pragma unroll
    for (int j = 0; j < 16; ++j) { const int r = (lane >> 3) + 8 * j; const LAS unsigned short* sp = scr + (8 * c) * 130 + r;
        u32x2 o; o.x = pk4_fp8(bf2f(sp[0]) * W8SCALE, bf2f(sp[130]) * W8SCALE, bf2f(sp[2 * 130]) * W8SCALE, bf2f(sp[3 * 130]) * W8SCALE);
        o.y = pk4_fp8(bf2f(sp[4 * 130]) * W8SCALE, bf2f(sp[5 * 130]) * W8SCALE, bf2f(sp[6 * 130]) * W8SCALE, bf2f(sp[7 * 130]) * W8SCALE);
        *(GAS u32x2*)(WT + (size_t)(n0 + r) * K + k0 + 8 * c) = o; }
    LDS_WAIT(); asm volatile("" ::: "memory");
}
__device__ __forceinline__ void p0_transpose_item8d(const float* W, int K, int N, unsigned char* WT, LAS unsigned short* scr, int kb, int nb, int lane) {
    const int k0 = 64 * kb, n0 = 128 * nb;
    const float* wp = W + (size_t)(k0 + (lane >> 5)) * N + n0 + 4 * (lane & 31);
    f32x4 v[32];
#pragma unroll
    for (int i = 0; i < 32; ++i) v[i] = *(const GAS f32x4*)(wp + (size_t)(2 * i) * N);
#pragma unroll
    for (int i = 0; i < 32; ++i) { const int kk = 2 * i + (lane >> 5); LAS unsigned* d = (LAS unsigned*)(scr + kk * 130 + 4 * (lane & 31)); d[0] = pk2(v[i].x, v[i].y); d[1] = pk2(v[i].z, v[i].w); }
    LDS_WAIT(); asm volatile("" ::: "memory");
    const int c = lane & 7;
#pragma unroll
    for (int j = 0; j < 16; ++j) { const int r = (lane >> 3) + 8 * j; const LAS unsigned short* sp = scr + (8 * c) * 130 + r;
        u32x2 o; o.x = pk4_fp8(bf2f(sp[0]) * W8SCALE, bf2f(sp[130]) * W8SCALE, bf2f(sp[2 * 130]) * W8SCALE, bf2f(sp[3 * 130]) * W8SCALE);
        o.y = pk4_fp8(bf2f(sp[4 * 130]) * W8SCALE, bf2f(sp[5 * 130]) * W8SCALE, bf2f(sp[6 * 130]) * W8SCALE, bf2f(sp[7 * 130]) * W8SCALE);
        *(GAS u32x2*)(WT + (size_t)(n0 + r) * K + k0 + 8 * c) = o; }
    LDS_WAIT(); asm volatile("" ::: "memory");
}
__device__ __forceinline__ void moe_weight_queue(Frame& F) {
    constexpr int W_GU1 = 32 * 32, W_DN1 = 16 * 32, W_GU = 32 * W_GU1, W_DN = 32 * W_DN1;
    LAS unsigned short* scr = (LAS unsigned short*)(F.lds + F.wave * 16640);
    const int lane = F.lane;
    __syncthreads();
    for (;;) {
        int r0 = 0;
        if (lane == 0) r0 = (int)__hip_atomic_fetch_add((unsigned*)(F.ctl + CW_QT), 4u, __ATOMIC_RELAXED, __HIP_MEMORY_SCOPE_AGENT);
        r0 = __builtin_amdgcn_readfirstlane(r0);
        if (r0 >= W_GU + W_DN) break;
#pragma unroll 1
        for (int sub = 0; sub < 4; ++sub) { const int r = r0 + sub;
            const float* W; unsigned char* WT; int N, kb, nb;
            if (r < W_GU) { const int e = r / W_GU1, q = r % W_GU1; W = F.in[IN_WGU] + (size_t)e * 2048 * 4096; WT = (unsigned char*)(F.ws + WS_WGU) + (size_t)e * 4096 * 2048; N = 4096; kb = q & 31; nb = q >> 5; }
            else { const int rr = r - W_GU; const int e = rr / W_DN1, q = rr % W_DN1; W = F.in[IN_WDN] + (size_t)e * 2048 * 2048; WT = (unsigned char*)(F.ws + WS_WDN) + (size_t)e * 2048 * 2048; N = 2048; kb = q & 31; nb = q >> 5; }
            const int K = 2048, k0 = 64 * kb, n0 = 128 * nb;
            const float* wp = W + (size_t)(k0 + (lane >> 5)) * N + n0 + 4 * (lane & 31);
            f32x4 v[32];
#pragma unroll
            for (int i = 0; i < 32; ++i) v[i] = __builtin_nontemporal_load((const GAS f32x4*)(wp + (size_t)(2 * i) * N));
            LAS unsigned char* sb = (LAS unsigned char*)scr;
#pragma unroll
            for (int i = 0; i < 32; ++i) { const int kk = 2 * i + (lane >> 5); *(LAS unsigned*)(sb + kk * 132 + 4 * (lane & 31)) = pk4_fp8(v[i].x * W8SCALE, v[i].y * W8SCALE, v[i].z * W8SCALE, v[i].w * W8SCALE); }
            LDS_WAIT(); asm volatile("" ::: "memory");
            const int c = lane & 7;
#pragma unroll
            for (int j = 0; j < 16; ++j) { const int rw = (lane >> 3) + 8 * j; const LAS unsigned char* sp = sb + (8 * c) * 132 + rw;
                u32x2 o; o.x = (unsigned)sp[0] | ((unsigned)sp[132] << 8) | ((unsigned)sp[2 * 132] << 16) | ((unsigned)sp[3 * 132] << 24);
                o.y = (unsigned)sp[4 * 132] | ((unsigned)sp[5 * 132] << 8) | ((unsigned)sp[6 * 132] << 16) | ((unsigned)sp[7 * 132] << 24);
                __builtin_nontemporal_store(o, (GAS u32x2*)(WT + (size_t)(n0 + rw) * K + k0 + 8 * c)); }
            LDS_WAIT(); asm volatile("" ::: "memory");
        }
    }
    __syncthreads();
}
__device__ __forceinline__ void p0_prologue(Frame& F) {
    for (int it = F.bx; it < 256; it += F.G) p0_adaln_item(F, it);
    for (int it = F.bx; it < 256; it += F.G) p0_filt_item(F, it);
    for (int it = F.bx; it < 16; it += F.G) p0_s5tab_item(F, it);
    { const float* rw = F.in[IN_RW]; float* RWT = (float*)(F.ws + WS_RWT);
      for (int i = F.bx * NTHR + F.tid; i < 32 * 2048; i += F.G * NTHR) { const int e = i >> 11, k = i & 2047; RWT[i] = rw[k * 32 + e]; } }
    __syncthreads();
    LAS unsigned short* scr = (LAS unsigned short*)(F.lds + F.wave * 16640);
    constexpr int I_IN = 64 * 4, I_GLU = 8 * 2, I_BS5 = 16 * 2, I_BHY = 16 * 2, I_O = 16 * 4;
    constexpr int NITEMS = I_IN + I_GLU + I_BS5 + I_BHY + I_O;
    const int w = F.wave;
    for (int it = F.bx; it < NITEMS; it += F.G) {
        int r = it;
        if (r < I_IN) { if ((r >> 2) < 32) p0_transpose_item(F.in[IN_WIN], 2048, 8192, (bf16*)(F.ws + WS_WIN), scr, 8 * (r & 3) + w, r >> 2, F.lane);
                        else p0_transpose_item8(F.in[IN_WIN], 2048, 8192, (unsigned char*)(F.ws + WS_WIN8) - (size_t)4096 * 2048, scr, 8 * (r & 3) + w, r >> 2, F.lane); continue; } r -= I_IN;
        if (r < I_GLU) { p0_transpose_item(F.in[IN_WGLU], 1024, 1024, (bf16*)(F.ws + WS_WGLU), scr, 8 * (r & 1) + w, r >> 1, F.lane); continue; } r -= I_GLU;
        if (r < I_BS5) { p0_transpose_item(F.in[IN_WBS5], 1024, 2048, (bf16*)(F.ws + WS_WBS5), scr, 8 * (r & 1) + w, r >> 1, F.lane); continue; } r -= I_BS5;
        if (r < I_BHY) { p0_transpose_item(F.in[IN_WBHY], 1024, 2048, (bf16*)(F.ws + WS_WBHY), scr, 8 * (r & 1) + w, r >> 1, F.lane); continue; } r -= I_BHY;
        { p0_transpose_item8(F.in[IN_WO], 2048, 2048, (unsigned char*)(F.ws + WS_WO), scr, 8 * (r & 3) + w, r >> 2, F.lane); }
    }
}

__device__ __forceinline__ void p1_norm(Frame& F) {
    const int gw = F.bx * NWAVES + F.wave, NGW = F.G * NWAVES;
    const float* MOD = (const float*)(F.ws + WS_MOD); const float* g1n = F.in[IN_N1G];
    bf16* U = (bf16*)(F.ws + WS_U);
    int curv = -1; f32x4 ga[8], sh[8];
    for (int m = gw; m < NTOK + NCTX; m += NGW) {
        const int v = (m < NTOK) ? (m >> 14) : 2;
        if (v != curv) { curv = v;
#pragma unroll
            for (int j = 0; j < 8; ++j) { const int k = 4 * F.lane + 256 * j; const f32x4 g = *(const f32x4*)(g1n + k), sc = *(const f32x4*)(MOD + v * 12288 + 2048 + k); ga[j] = g * (sc + 1.0f); sh[j] = *(const f32x4*)(MOD + v * 12288 + k); } }
        const float* xr = (m < NTOK) ? (F.in[IN_X] + (size_t)m * D) : (F.in[IN_CTX] + (size_t)(m - NTOK) * D);
        f32x4 x[8]; float s = 0.f;
#pragma unroll
        for (int j = 0; j < 8; ++j) { x[j] = *(const GAS f32x4*)(xr + 4 * F.lane + 256 * j); s += (x[j].x * x[j].x + x[j].y * x[j].y) + (x[j].z * x[j].z + x[j].w * x[j].w); }
        const float rstd = 1.0f / sqrtf(wave_sum(s) * (1.0f / D) + 1e-6f);
        GAS u32x2* o = (GAS u32x2*)(U + (size_t)m * D) + F.lane; GAS unsigned* o8 = (GAS unsigned*)(F.ws + WS_U8 + (size_t)m * D) + F.lane;
#pragma unroll
        for (int j = 0; j < 8; ++j) { const f32x4 y = x[j] * rstd * ga[j] + sh[j]; o[64 * j] = (u32x2){pk2(y.x, y.y), pk2(y.z, y.w)}; if (m < NTOK) o8[64 * j] = pk4_fp8(y.x, y.y, y.z, y.w); }
    }
}

struct SchedIn {
    int G, c, nmain, npn, mode, nrep;
    const char* A; const char* Bt;
    __device__ __forceinline__ bool next(int i, pg8::Unit& u) const {
        int L = i * G + c; u.e = 0; u.valid = 256; { const int tot = nmain + (mode == 0 ? 8 : 0); if (nrep > 1 && L >= tot && L < 2 * tot) L -= tot; }
        if (L < nmain) {
            int wgid = L; { const int q = nmain / 8, xcd = wgid % 8, off = wgid / 8; wgid = xcd * q + off; }
            const int nig = 8 * npn, gid = wgid / nig; const int pm = gid * 8 + ((wgid % nig) % 8), pl = (wgid % nig) / 8;
            u.pm = pm; u.pn = (mode == 0) ? pl : (mode == 1 ? pl + 4 : pl + 16); return true;
        }
        if (mode == 0 && L < nmain + 8) { const int q = L - nmain; u.pm = 128 + (q >> 2); u.pn = q & 3; return true; }
        return false;
    }
    __device__ __forceinline__ unsigned a_row(const pg8::Unit& u, int r) const { return (u.pm < 128) ? (unsigned)((u.pm >> 6) * SEQ + r * 64 + (u.pm & 63)) : (unsigned)(NTOK + (u.pm - 128) * 256 + r); }
    __device__ __forceinline__ const char* a_base() const { return A; }
    __device__ __forceinline__ const char* b_base(const pg8::Unit& u) const { return (mode == 2) ? Bt + (size_t)(u.pn - 16) * 256 * D : Bt + (size_t)u.pn * 256 * D * 2; }
};
__device__ __forceinline__ unsigned q8(float s) { return (unsigned)(s * 255.0f + 0.5f); }
struct EpiInG8 {
    static constexpr bool PERM = true, TRANS = true, FP8 = true;
    unsigned char* UG;
    __device__ __forceinline__ void operator()(const f32x4 (&acc)[2][2][4][2], const pg8::Unit& u, int wr, int wc, int fr, int fq) const {
        const int col0 = (u.pn - 16) * 256 + wc * 32 + 8 * fq;
#pragma unroll
        for (int ai = 0; ai < 2; ++ai)
#pragma unroll
            for (int m = 0; m < 4; ++m) { const int r = ai * 128 + wr * 64 + m * 16 + fr; const size_t row = (size_t)((u.pm >> 6) * SEQ + r * 64 + (u.pm & 63));
                unsigned char* rowp = UG + row * 4096 + col0;
#pragma unroll
                for (int bj = 0; bj < 2; ++bj) { f32x4 v0 = acc[ai][bj][m][0] * (1.0f / W8SCALE), v1 = acc[ai][bj][m][1] * (1.0f / W8SCALE);
#pragma unroll
                    for (int j = 0; j < 4; ++j) { v0[j] = sigmoidf_(v0[j]); v1[j] = sigmoidf_(v1[j]); }
                    u32x2 w; w.x = q8(v0[0]) | (q8(v0[1]) << 8) | (q8(v0[2]) << 16) | (q8(v0[3]) << 24); w.y = q8(v1[0]) | (q8(v1[1]) << 8) | (q8(v1[2]) << 16) | (q8(v1[3]) << 24);
                    *(u32x2*)(rowp + bj * 128) = w; } }
    }
};
struct EpiInA {
    static constexpr bool PERM = true, TRANS = true, FP8 = false;
    unsigned char* ws;
    __device__ __forceinline__ void operator()(const f32x4 (&acc)[2][2][4][2], const pg8::Unit& u, int wr, int wc, int fr, int fq) const {
        const bool isctx = u.pm >= 128, isg = u.pn >= 16;
        const size_t boff = isctx ? WS_UCA : (isg ? WS_UG : WS_UA);
        bf16* base = (bf16*)(ws + boff); const size_t ld = isg ? 4096 : S5W; const int colt = isg ? (u.pn - 16) * 256 : u.pn * 256;
        const int col0 = colt + wc * 32 + 8 * fq;
#pragma unroll
        for (int ai = 0; ai < 2; ++ai)
#pragma unroll
            for (int m = 0; m < 4; ++m) { const int r = ai * 128 + wr * 64 + m * 16 + fr;
                const size_t row = isctx ? (size_t)((u.pm - 128) * 256 + r) : (size_t)((u.pm >> 6) * SEQ + r * 64 + (u.pm & 63));
                bf16* rowp = base + row * ld + col0;
#pragma unroll
                for (int bj = 0; bj < 2; ++bj) { f32x4 v0 = acc[ai][bj][m][0], v1 = acc[ai][bj][m][1];
                    if (isg) {
#pragma unroll
                        for (int j = 0; j < 4; ++j) { v0[j] = sigmoidf_(v0[j]); v1[j] = sigmoidf_(v1[j]); } }
                    u32x4 w; w.x = cvt_pk_bf16(v0[0], v0[1]); w.y = cvt_pk_bf16(v0[2], v0[3]); w.z = cvt_pk_bf16(v1[0], v1[1]); w.w = cvt_pk_bf16(v1[2], v1[3]);
                    *(u32x4*)(rowp + bj * 128) = w; } }
    }
};
struct EpiInH {
    static constexpr bool PERM = false, TRANS = false, FP8 = false;
    bf16* UH;
    __device__ __forceinline__ void operator()(const f32x4 (&acc)[2][2][4][2], const pg8::Unit& u, int wr, int wc, int fr, int fq) const {
        const int b = u.pm >> 6, w = u.pm & 63;
#pragma unroll
        for (int bj = 0; bj < 2; ++bj)
#pragma unroll
            for (int n = 0; n < 2; ++n) { const int ch = (u.pn - 4) * 256 + bj * 128 + wc * 32 + n * 16 + fr;
                bf16* cp = UH + ((size_t)(b * 3072 + ch) * SEQ + w * 256);
#pragma unroll
                for (int ai = 0; ai < 2; ++ai)
#pragma unroll
                    for (int m = 0; m < 4; ++m) { const int r0 = ai * 128 + wr * 64 + m * 16 + 4 * fq; const f32x4 v = acc[ai][bj][m][n];
                        *(u32x2*)(cp + r0) = (u32x2){cvt_pk_bf16(v[0], v[1]), cvt_pk_bf16(v[2], v[3])}; } }
    }
};

template <bool PASSB>
__device__ __forceinline__ void s5_pass(Frame& F) {
    constexpr int nk = PASSB ? 256 : 260;
    constexpr int nitems = 2 * nk * 8;
    LAS unsigned char* sl = F.lds + F.wave * 8704;
    const int lane = F.lane, pl = lane & 31, hi = lane >> 5, fr = lane & 15, fq = lane >> 4;
    const bf16* UA = (const bf16*)(F.ws + WS_UA); const bf16* UCA = (const bf16*)(F.ws + WS_UCA);
    const bf16* BBT = (const bf16*)(F.ws + WS_BBT); const bf16* CTT = (const bf16*)(F.ws + WS_CTT); const f32x2* LAM = (const f32x2*)(F.ws + WS_LAM);
    f32x2* EB = (f32x2*)(F.ws + WS_E); const f32x2* SINB = (const f32x2*)(F.ws + WS_SIN); bf16* Y = (bf16*)(F.ws + WS_Y);
    const int s_r = 16 * ((pl >> 2) & 1) + 4 * (pl >> 3) + (pl & 3);
    for (int it = F.bx; it < nitems; it += F.G) {
        const int gq = it & 7, rest = it >> 3; const int b = rest / nk, kk = rest % nk; const int kc = PASSB ? kk + 4 : kk;
        const int g = gq * 8 + F.wave;
        const bf16* urow = (kc < 4) ? (UCA + (size_t)(b * CTX + kc * 64) * S5W + 16 * g) : (UA + (size_t)(b * SEQ + (kc - 4) * 64) * S5W + 16 * g);
        f32x4 yacc[4];
#pragma unroll
        for (int q = 0; q < 4; ++q) yacc[q] = (f32x4){0.f, 0.f, 0.f, 0.f};
#pragma unroll
        for (int d = 0; d < 2; ++d) {
            const int dg = d * 64 + g;
            bf16x8 bb[4];
#pragma unroll
            for (int ni = 0; ni < 4; ++ni) bb[ni] = *(const bf16x8*)(BBT + (size_t)(dg * 128 + 32 * ni + pl) * 16 + 8 * hi);
            bf16x8 ct[4];
            if (PASSB) {
#pragma unroll
                for (int ks = 0; ks < 4; ++ks) ct[ks] = *(const bf16x8*)(CTT + (size_t)(dg * 16 + fr) * 128 + 32 * ks + 8 * fq);
            }
            const f32x2 lamA = LAM[dg * 64 + pl], lamB = LAM[dg * 64 + pl + 32];
            f32x2 l2 = cmul(lamA, lamA), l4 = cmul(l2, l2), l8 = cmul(l4, l4); const f32x2 lam16A = cmul(l8, l8);
            l2 = cmul(lamB, lamB); l4 = cmul(l2, l2); l8 = cmul(l4, l4); const f32x2 lam16B = cmul(l8, l8);
            f32x2 cA = (f32x2){0.f, 0.f}, cB = (f32x2){0.f, 0.f};
            const size_t sidx = ((size_t)((d * 2 + b) * NCH + kc)) * 4096 + g * 64 + pl;
            if (PASSB) { cA = SINB[sidx]; cB = SINB[sidx + 32]; }
#pragma unroll
            for (int sc = 0; sc < 2; ++sc) {
                const int iscan = 32 * sc + s_r; const int tok = (d == 0) ? iscan : 63 - iscan;
                const bf16x8 a = *(const bf16x8*)(urow + (size_t)tok * S5W + 8 * hi);
                f32x16 acc[4];
#pragma unroll
                for (int ni = 0; ni < 4; ++ni) { f32x16 z;
#pragma unroll
                    for (int i = 0; i < 16; ++i) z[i] = 0.f;
                    acc[ni] = __builtin_amdgcn_mfma_f32_32x32x16_bf16(a, bb[ni], z, 0, 0, 0); }
                asm volatile("s_nop 7\n\ts_nop 7" : "+v"(acc[0]), "+v"(acc[1]), "+v"(acc[2]), "+v"(acc[3]) : "v"(a), "v"(bb[0]), "v"(bb[1]), "v"(bb[2]), "v"(bb[3]));
                f32x2 sA = hi ? (f32x2){0.f, 0.f} : cA, sB = hi ? (f32x2){0.f, 0.f} : cB;
#pragma unroll
                for (int i = 0; i < 16; ++i) {
                    sA = (f32x2){lamA.x * sA.x - lamA.y * sA.y + acc[0][i], lamA.x * sA.y + lamA.y * sA.x + acc[2][i]}; acc[0][i] = sA.x; acc[2][i] = sA.y;
                    sB = (f32x2){lamB.x * sB.x - lamB.y * sB.y + acc[1][i], lamB.x * sB.y + lamB.y * sB.x + acc[3][i]}; acc[1][i] = sB.x; acc[3][i] = sB.y; }
                const f32x2 pA = (f32x2){__shfl_xor(sA.x, 32), __shfl_xor(sA.y, 32)}, pB = (f32x2){__shfl_xor(sB.x, 32), __shfl_xor(sB.y, 32)};
                const f32x2 tA = cmul(lam16A, hi ? pA : sA), tB = cmul(lam16B, hi ? pB : sB);
                const f32x2 e1A = (hi ? sA : pA) + tA, e1B = (hi ? sB : pB) + tB;
                const f32x2 ciA = hi ? pA : (f32x2){0.f, 0.f}, ciB = hi ? pB : (f32x2){0.f, 0.f};
                if (PASSB) {
                    f32x2 wA = cmul(lamA, ciA), wB = cmul(lamB, ciB);
#pragma unroll
                    for (int i = 0; i < 16; ++i) {
                        acc[0][i] += wA.x; acc[2][i] += wA.y; acc[1][i] += wB.x; acc[3][i] += wB.y;
                        *(LAS u32x2*)(sl + (16 * hi + i) * 272 + pl * 8) = (u32x2){cvt_pk_bf16(acc[0][i], acc[2][i]), cvt_pk_bf16(acc[1][i], acc[3][i])};
                        wA = cmul(wA, lamA); wB = cmul(wB, lamB); }
                    bf16x8 bsv[2][4];
#pragma unroll
                    for (int tt = 0; tt < 2; ++tt) {
                        const int rowi = (d == 0) ? (16 * tt + fr) : (16 * tt + 15 - fr);
#pragma unroll
                        for (int ks = 0; ks < 4; ++ks) bsv[tt][ks] = *(const LAS bf16x8*)(sl + rowi * 272 + (32 * ks + 8 * fq) * 2);
                    }
#pragma unroll
                    for (int tt = 0; tt < 2; ++tt) {
                        const int tq = (d == 0) ? (2 * sc + tt) : (3 - 2 * sc - tt);
#pragma unroll
                        for (int ks = 0; ks < 4; ++ks) yacc[tq] = __builtin_amdgcn_mfma_f32_16x16x32_bf16(ct[ks], bsv[tt][ks], yacc[tq], 0, 0, 0);
                    }
                    asm volatile("s_nop 7\n\ts_nop 7" : "+v"(yacc[0]), "+v"(yacc[1]), "+v"(yacc[2]), "+v"(yacc[3]) : "v"(bsv[0][0]), "v"(bsv[0][1]), "v"(bsv[0][2]), "v"(bsv[0][3]), "v"(bsv[1][0]), "v"(bsv[1][1]), "v"(bsv[1][2]), "v"(bsv[1][3]), "v"(ct[0]), "v"(ct[1]), "v"(ct[2]), "v"(ct[3]));
                    asm volatile("s_waitcnt lgkmcnt(0)" ::: "memory");
                }
                cA = e1A; cB = e1B;
            }
            if (!PASSB) { if (hi == 0) { EB[sidx] = cA; EB[sidx + 32] = cB; } }
        }
        if (PASSB) {
            const f32x4 dsk = *(const f32x4*)(F.in[IN_S5D] + 16 * g + 4 * fq);
#pragma unroll
            for (int tq = 0; tq < 4; ++tq) { const int tok = 16 * tq + fr;
                const u32x2 uu = *(const u32x2*)(urow + (size_t)tok * S5W + 4 * fq);
                f32x4 v; v[0] = yacc[tq][0] + bflo(uu.x) * dsk[0]; v[1] = yacc[tq][1] + bfhi(uu.x) * dsk[1]; v[2] = yacc[tq][2] + bflo(uu.y) * dsk[2]; v[3] = yacc[tq][3] + bfhi(uu.y) * dsk[3];
#pragma unroll
                for (int j = 0; j < 4; ++j) { const float x = v[j]; v[j] = x * sigmoidf_(1.5957691216f * (x + 0.044715f * x * x * x)); }
                *(u32x2*)(Y + (size_t)(b * SEQ + (kc - 4) * 64 + tok) * S5W + 16 * g + 4 * fq) = (u32x2){cvt_pk_bf16(v[0], v[1]), cvt_pk_bf16(v[2], v[3])}; }
        }
    }
}
__device__ __forceinline__ void s5_pass_a_simple(Frame& F) {
    constexpr int nitems = 2 * NCH * 8;
    const int lane = F.lane;
    const bf16* UA = (const bf16*)(F.ws + WS_UA); const bf16* UCA = (const bf16*)(F.ws + WS_UCA);
    const bf16* BBT = (const bf16*)(F.ws + WS_BBT); const f32x2* LAM = (const f32x2*)(F.ws + WS_LAM); f32x2* EB = (f32x2*)(F.ws + WS_E);
    for (int it = F.bx; it < nitems; it += F.G) {
        const int gq = it & 7, rest = it >> 3; const int b = rest / NCH, kc = rest % NCH; const int g = gq * 8 + F.wave;
        const bf16* urow = (kc < 4) ? (UCA + (size_t)(b * CTX + kc * 64) * S5W + 16 * g) : (UA + (size_t)(b * SEQ + (kc - 4) * 64) * S5W + 16 * g);
#pragma unroll 1
        for (int d = 0; d < 2; ++d) {
            const int dg = d * 64 + g; const f32x2 lam = LAM[dg * 64 + lane];
            float bre[16], bim[16];
            { const u32x4 r0 = *(const u32x4*)(BBT + (size_t)(dg * 128 + lane) * 16), r1 = *(const u32x4*)(BBT + (size_t)(dg * 128 + lane) * 16 + 8);
              const u32x4 i0 = *(const u32x4*)(BBT + (size_t)(dg * 128 + 64 + lane) * 16), i1 = *(const u32x4*)(BBT + (size_t)(dg * 128 + 64 + lane) * 16 + 8);
              bre[0] = bflo(r0.x); bre[1] = bfhi(r0.x); bre[2] = bflo(r0.y); bre[3] = bfhi(r0.y); bre[4] = bflo(r0.z); bre[5] = bfhi(r0.z); bre[6] = bflo(r0.w); bre[7] = bfhi(r0.w);
              bre[8] = bflo(r1.x); bre[9] = bfhi(r1.x); bre[10] = bflo(r1.y); bre[11] = bfhi(r1.y); bre[12] = bflo(r1.z); bre[13] = bfhi(r1.z); bre[14] = bflo(r1.w); bre[15] = bfhi(r1.w);
              bim[0] = bflo(i0.x); bim[1] = bfhi(i0.x); bim[2] = bflo(i0.y); bim[3] = bfhi(i0.y); bim[4] = bflo(i0.z); bim[5] = bfhi(i0.z); bim[6] = bflo(i0.w); bim[7] = bfhi(i0.w);
              bim[8] = bflo(i1.x); bim[9] = bfhi(i1.x); bim[10] = bflo(i1.y); bim[11] = bfhi(i1.y); bim[12] = bflo(i1.z); bim[13] = bfhi(i1.z); bim[14] = bflo(i1.w); bim[15] = bfhi(i1.w); }
            f32x2 st = (f32x2){0.f, 0.f};
#pragma unroll 4
            for (int i = 0; i < 64; ++i) { const int tok = (d == 0) ? i : 63 - i;
                const u32x4 u0 = *(const u32x4*)(urow + (size_t)tok * S5W), u1 = *(const u32x4*)(urow + (size_t)tok * S5W + 8);
                float u[16]; u[0] = bflo(u0.x); u[1] = bfhi(u0.x); u[2] = bflo(u0.y); u[3] = bfhi(u0.y); u[4] = bflo(u0.z); u[5] = bfhi(u0.z); u[6] = bflo(u0.w); u[7] = bfhi(u0.w);
                u[8] = bflo(u1.x); u[9] = bfhi(u1.x); u[10] = bflo(u1.y); u[11] = bfhi(u1.y); u[12] = bflo(u1.z); u[13] = bfhi(u1.z); u[14] = bflo(u1.w); u[15] = bfhi(u1.w);
                float br = 0.f, bi = 0.f;
#pragma unroll
                for (int c = 0; c < 16; ++c) { br += bre[c] * u[c]; bi += bim[c] * u[c]; }
                st = (f32x2){lam.x * st.x - lam.y * st.y + br, lam.x * st.y + lam.y * st.x + bi}; }
            EB[((size_t)((d * 2 + b) * NCH + kc)) * 4096 + g * 64 + lane] = st;
        }
    }
}
__device__ __forceinline__ void s5_pass_b2(Frame& F) {
    constexpr int nitems = 2 * 256 * 8;
    LAS unsigned char* sl = F.lds + F.wave * 8704;
    const int lane = F.lane, fr = lane & 15, fq = lane >> 4;
    const bf16* UA = (const bf16*)(F.ws + WS_UA); const bf16* BBT = (const bf16*)(F.ws + WS_BBT); const bf16* CTT = (const bf16*)(F.ws + WS_CTT);
    const f32x2* LAM = (const f32x2*)(F.ws + WS_LAM); const f32x2* SINB = (const f32x2*)(F.ws + WS_SIN); bf16* Y = (bf16*)(F.ws + WS_Y);
    for (int it = F.bx; it < nitems; it += F.G) {
        const int gq = it & 7, rest = it >> 3; const int b = rest >> 8, kc = (rest & 255) + 4; const int g = gq * 8 + F.wave;
        const bf16* urow = UA + (size_t)(b * SEQ + (kc - 4) * 64) * S5W + 16 * g;
        f32x4 yacc[4];
#pragma unroll
        for (int q = 0; q < 4; ++q) yacc[q] = (f32x4){0.f, 0.f, 0.f, 0.f};
#pragma unroll
        for (int d = 0; d < 2; ++d) {
            const int dg = d * 64 + g; const f32x2 lam = LAM[dg * 64 + lane];
            float bre[16], bim[16];
            { const u32x4 r0 = *(const u32x4*)(BBT + (size_t)(dg * 128 + lane) * 16), r1 = *(const u32x4*)(BBT + (size_t)(dg * 128 + lane) * 16 + 8);
              const u32x4 i0 = *(const u32x4*)(BBT + (size_t)(dg * 128 + 64 + lane) * 16), i1 = *(const u32x4*)(BBT + (size_t)(dg * 128 + 64 + lane) * 16 + 8);
              bre[0] = bflo(r0.x); bre[1] = bfhi(r0.x); bre[2] = bflo(r0.y); bre[3] = bfhi(r0.y); bre[4] = bflo(r0.z); bre[5] = bfhi(r0.z); bre[6] = bflo(r0.w); bre[7] = bfhi(r0.w);
              bre[8] = bflo(r1.x); bre[9] = bfhi(r1.x); bre[10] = bflo(r1.y); bre[11] = bfhi(r1.y); bre[12] = bflo(r1.z); bre[13] = bfhi(r1.z); bre[14] = bflo(r1.w); bre[15] = bfhi(r1.w);
              bim[0] = bflo(i0.x); bim[1] = bfhi(i0.x); bim[2] = bflo(i0.y); bim[3] = bfhi(i0.y); bim[4] = bflo(i0.z); bim[5] = bfhi(i0.z); bim[6] = bflo(i0.w); bim[7] = bfhi(i0.w);
              bim[8] = bflo(i1.x); bim[9] = bfhi(i1.x); bim[10] = bflo(i1.y); bim[11] = bfhi(i1.y); bim[12] = bflo(i1.z); bim[13] = bfhi(i1.z); bim[14] = bflo(i1.w); bim[15] = bfhi(i1.w); }
            bf16x8 ct[4];
#pragma unroll
            for (int ks = 0; ks < 4; ++ks) ct[ks] = *(const bf16x8*)(CTT + (size_t)(dg * 16 + fr) * 128 + 32 * ks + 8 * fq);
            f32x2 st = SINB[((size_t)((d * 2 + b) * NCH + kc)) * 4096 + g * 64 + lane];
#pragma unroll
            for (int h = 0; h < 2; ++h) {
#pragma unroll 4
                for (int i = 0; i < 32; ++i) { const int sc = 32 * h + i; const int tok = (d == 0) ? sc : 63 - sc;
                    const u32x4 u0 = *(const u32x4*)(urow + (size_t)tok * S5W), u1 = *(const u32x4*)(urow + (size_t)tok * S5W + 8);
                    float u[16]; u[0] = bflo(u0.x); u[1] = bfhi(u0.x); u[2] = bflo(u0.y); u[3] = bfhi(u0.y); u[4] = bflo(u0.z); u[5] = bfhi(u0.z); u[6] = bflo(u0.w); u[7] = bfhi(u0.w);
                    u[8] = bflo(u1.x); u[9] = bfhi(u1.x); u[10] = bflo(u1.y); u[11] = bfhi(u1.y); u[12] = bflo(u1.z); u[13] = bfhi(u1.z); u[14] = bflo(u1.w); u[15] = bfhi(u1.w);
                    float br = 0.f, bi = 0.f;
#pragma unroll
                    for (int c = 0; c < 16; ++c) { br += bre[c] * u[c]; bi += bim[c] * u[c]; }
                    st = (f32x2){lam.x * st.x - lam.y * st.y + br, lam.x * st.y + lam.y * st.x + bi};
                    *(LAS unsigned*)(sl + (tok & 31) * 272 + lane * 4) = cvt_pk_bf16(st.x, st.y); }
                const int t0q = (d == 0) ? 2 * h : 2 * (1 - h);
                bf16x8 bsv[2][4];
#pragma unroll
                for (int tt = 0; tt < 2; ++tt)
#pragma unroll
                    for (int ks = 0; ks < 4; ++ks) bsv[tt][ks] = *(const LAS bf16x8*)(sl + (16 * tt + fr) * 272 + (32 * ks + 8 * fq) * 2);
#pragma unroll
                for (int tt = 0; tt < 2; ++tt)
#pragma unroll
                    for (int ks = 0; ks < 4; ++ks) yacc[t0q + tt] = __builtin_amdgcn_mfma_f32_16x16x32_bf16(ct[ks], bsv[tt][ks], yacc[t0q + tt], 0, 0, 0);
                asm volatile("s_nop 7\n\ts_nop 7" : "+v"(yacc[0]), "+v"(yacc[1]), "+v"(yacc[2]), "+v"(yacc[3]) : "v"(bsv[0][0]), "v"(bsv[0][1]), "v"(bsv[0][2]), "v"(bsv[0][3]), "v"(bsv[1][0]), "v"(bsv[1][1]), "v"(bsv[1][2]), "v"(bsv[1][3]), "v"(ct[0]), "v"(ct[1]), "v"(ct[2]), "v"(ct[3]));
                asm volatile("s_waitcnt lgkmcnt(0)" ::: "memory");
            }
        }
        const f32x4 dsk = *(const f32x4*)(F.in[IN_S5D] + 16 * g + 4 * fq);
#pragma unroll
        for (int tq = 0; tq < 4; ++tq) { const int tok = 16 * tq + fr;
            const u32x2 uu = *(const u32x2*)(urow + (size_t)tok * S5W + 4 * fq);
            f32x4 v; v[0] = yacc[tq][0] + bflo(uu.x) * dsk[0]; v[1] = yacc[tq][1] + bfhi(uu.x) * dsk[1]; v[2] = yacc[tq][2] + bflo(uu.y) * dsk[2]; v[3] = yacc[tq][3] + bfhi(uu.y) * dsk[3];
#pragma unroll
            for (int j = 0; j < 4; ++j) { const float x = v[j]; v[j] = x * sigmoidf_(1.5957691216f * (x + 0.044715f * x * x * x)); }
            *(u32x2*)(Y + (size_t)(b * SEQ + (kc - 4) * 64 + tok) * S5W + 16 * g + 4 * fq) = (u32x2){cvt_pk_bf16(v[0], v[1]), cvt_pk_bf16(v[2], v[3])}; }
    }
}
template <bool PASSB>
__device__ __forceinline__ void s5_pass3(Frame& F) {
    constexpr int nk = PASSB ? 256 : NCH; constexpr int nitems = 2 * nk * 8;
    LAS unsigned char* sl = F.lds + F.wave * 8704;
    const int lane = F.lane, fr = lane & 15, fq = lane >> 4;
    const bf16* UA = (const bf16*)(F.ws + WS_UA); const bf16* UCA = (const bf16*)(F.ws + WS_UCA); const bf16* BB2 = (const bf16*)(F.ws + WS_BB2); const bf16* CTT = (const bf16*)(F.ws + WS_CTT);
    const f32x2* LAM = (const f32x2*)(F.ws + WS_LAM); const f32x2* SINB = (const f32x2*)(F.ws + WS_SIN); f32x2* EB = (f32x2*)(F.ws + WS_E); bf16* Y = (bf16*)(F.ws + WS_Y);
    const bf16x8 zf = (bf16x8){0, 0, 0, 0, 0, 0, 0, 0};
    int curg = -1; bf16x8 af[2][8], ct[2][4]; f32x2 lamv[2]; f32x4 dsk = (f32x4){0.f, 0.f, 0.f, 0.f};
    for (int it = F.bx; it < nitems; it += F.G) {
        const int gq = it & 7, rest = it >> 3; const int b = rest / nk, kk = rest % nk; const int kc = PASSB ? kk + 4 : kk; const int g = gq * 8 + F.wave;
        if (g != curg) { curg = g;
#pragma unroll
            for (int d = 0; d < 2; ++d) { const int dg = d * 64 + g; lamv[d] = LAM[dg * 64 + lane];
#pragma unroll
                for (int nt = 0; nt < 8; ++nt) af[d][nt] = (fq < 2) ? *(const bf16x8*)(BB2 + (size_t)(dg * 128 + 16 * nt + fr) * 16 + 8 * fq) : zf;
                if (PASSB) {
#pragma unroll
                    for (int ks = 0; ks < 4; ++ks) ct[d][ks] = *(const bf16x8*)(CTT + (size_t)(dg * 16 + fr) * 128 + 32 * ks + 8 * fq); } }
            if (PASSB) dsk = *(const f32x4*)(F.in[IN_S5D] + 16 * g + 4 * fq); }
        const bf16* urow = (kc < 4) ? (UCA + (size_t)(b * CTX + kc * 64) * S5W + 16 * g) : (UA + (size_t)(b * SEQ + (kc - 4) * 64) * S5W + 16 * g);
        bf16x8 uf[4];
#pragma unroll
        for (int q = 0; q < 4; ++q) uf[q] = (fq < 2) ? *(const bf16x8*)(urow + (size_t)(16 * q + fr) * S5W + 8 * fq) : zf;
        u32x2 uu[4];
        if (PASSB) {
#pragma unroll
            for (int tq = 0; tq < 4; ++tq) uu[tq] = *(const u32x2*)(urow + (size_t)(16 * tq + fr) * S5W + 4 * fq); }
        f32x2 st0[2];
#pragma unroll
        for (int d = 0; d < 2; ++d) st0[d] = PASSB ? SINB[((size_t)((d * 2 + b) * NCH + kc)) * 4096 + g * 64 + lane] : (f32x2){0.f, 0.f};
        f32x4 yacc[4];
#pragma unroll
        for (int q = 0; q < 4; ++q) yacc[q] = (f32x4){0.f, 0.f, 0.f, 0.f};
#pragma unroll
        for (int d = 0; d < 2; ++d) {
            const f32x2 lam = lamv[d]; f32x2 st = st0[d];
#pragma unroll
            for (int h = 0; h < 2; ++h) {
                const int T0 = (d == 0) ? 32 * h : 32 * (1 - h);
#pragma unroll
                for (int tt = 0; tt < 2; ++tt)
#pragma unroll
                    for (int nt = 0; nt < 8; ++nt) { const f32x4 dd = __builtin_amdgcn_mfma_f32_16x16x32_bf16(af[d][nt], uf[(T0 >> 4) + tt], (f32x4){0.f, 0.f, 0.f, 0.f}, 0, 0, 0);
                        *(LAS u32x2*)(sl + (16 * tt + fr) * 272 + (16 * nt + 4 * fq) * 2) = (u32x2){cvt_pk_bf16(dd[0], dd[1]), cvt_pk_bf16(dd[2], dd[3])}; }
                asm volatile("s_waitcnt lgkmcnt(0)" ::: "memory");
#pragma unroll 8
                for (int i = 0; i < 32; ++i) { const int r = (d == 0) ? i : 31 - i; LAS unsigned* cell = (LAS unsigned*)(sl + r * 272 + lane * 4);
                    const unsigned w = *cell; const float br = bflo(w), bi = bfhi(w);
                    st = (f32x2){lam.x * st.x - lam.y * st.y + br, lam.x * st.y + lam.y * st.x + bi};
                    if (PASSB) *cell = cvt_pk_bf16(st.x, st.y); }
                if (PASSB) {
                    const int t0q = T0 >> 4;
                    bf16x8 bsv[2][4];
#pragma unroll
                    for (int tt = 0; tt < 2; ++tt)
#pragma unroll
                        for (int ks = 0; ks < 4; ++ks) bsv[tt][ks] = *(const LAS bf16x8*)(sl + (16 * tt + fr) * 272 + (32 * ks + 8 * fq) * 2);
#pragma unroll
                    for (int tt = 0; tt < 2; ++tt)
#pragma unroll
                        for (int ks = 0; ks < 4; ++ks) yacc[t0q + tt] = __builtin_amdgcn_mfma_f32_16x16x32_bf16(ct[d][ks], bsv[tt][ks], yacc[t0q + tt], 0, 0, 0);
                    asm volatile("s_nop 7\n\ts_nop 7" : "+v"(yacc[0]), "+v"(yacc[1]), "+v"(yacc[2]), "+v"(yacc[3]) : "v"(bsv[0][0]), "v"(bsv[0][1]), "v"(bsv[0][2]), "v"(bsv[0][3]), "v"(bsv[1][0]), "v"(bsv[1][1]), "v"(bsv[1][2]), "v"(bsv[1][3]));
                }
                asm volatile("s_waitcnt lgkmcnt(0)" ::: "memory");
            }
            if (!PASSB) EB[((size_t)((d * 2 + b) * NCH + kc)) * 4096 + g * 64 + lane] = st;
        }
        if (PASSB) {
#pragma unroll
            for (int tq = 0; tq < 4; ++tq) { const int tok = 16 * tq + fr;
                f32x4 v; v[0] = yacc[tq][0] + bflo(uu[tq].x) * dsk[0]; v[1] = yacc[tq][1] + bfhi(uu[tq].x) * dsk[1]; v[2] = yacc[tq][2] + bflo(uu[tq].y) * dsk[2]; v[3] = yacc[tq][3] + bfhi(uu[tq].y) * dsk[3];
#pragma unroll
                for (int j = 0; j < 4; ++j) { const float x = v[j]; v[j] = x * sigmoidf_(1.5957691216f * (x + 0.044715f * x * x * x)); }
                *(u32x2*)(Y + (size_t)(b * SEQ + (kc - 4) * 64 + tok) * S5W + 16 * g + 4 * fq) = (u32x2){cvt_pk_bf16(v[0], v[1]), cvt_pk_bf16(v[2], v[3])}; }
        }
    }
}
__device__ __forceinline__ void s5_carry_item(Frame& F, int item) {
    const int idx = item * NTHR + F.tid; const int d = idx >> 13, b = (idx >> 12) & 1, gp = idx & 4095;
    const f32x2 lam = ((const f32x2*)(F.ws + WS_LAM))[d * 4096 + gp];
    f32x2 l = cmul(lam, lam); l = cmul(l, l); l = cmul(l, l); l = cmul(l, l); l = cmul(l, l); l = cmul(l, l);
    const f32x2* EB = (const f32x2*)(F.ws + WS_E) + (size_t)((d * 2 + b) * NCH) * 4096 + gp; f32x2* SB = (f32x2*)(F.ws + WS_SIN) + (size_t)((d * 2 + b) * NCH) * 4096 + gp;
    f32x2 s = (f32x2){0.f, 0.f};
#pragma unroll 1
    for (int st0 = 0; st0 < NCH; st0 += 20) { f32x2 e[20];
#pragma unroll
        for (int j = 0; j < 20; ++j) { const int st = st0 + j; const int kc = (d == 0) ? st : (st < 4 ? 3 - st : NCH + 3 - st); e[j] = EB[(size_t)kc * 4096]; }
#pragma unroll
        for (int j = 0; j < 20; ++j) { const int st = st0 + j; const int kc = (d == 0) ? st : (st < 4 ? 3 - st : NCH + 3 - st); SB[(size_t)kc * 4096] = s; s = cmul(l, s) + e[j]; } }
}

__device__ __forceinline__ int fsw(int i) { return i ^ ((i >> 5) & 7) ^ (((i >> 6) & 3) << 3); }
__host__ __device__ constexpr float w16c(int j) { return j == 0 ? 1.f : j == 1 ? 0.9238795325f : j == 2 ? 0.7071067812f : j == 3 ? 0.3826834324f : j == 4 ? 0.f : j == 5 ? -0.3826834324f : j == 6 ? -0.7071067812f : -0.9238795325f; }
__host__ __device__ constexpr float w16s(int j) { return j == 0 ? 0.f : j == 1 ? 0.3826834324f : j == 2 ? 0.7071067812f : j == 3 ? 0.9238795325f : j == 4 ? 1.f : j == 5 ? 0.9238795325f : j == 6 ? 0.7071067812f : 0.3826834324f; }
__host__ __device__ constexpr int bitrev(int q, int bits) { int r = 0; for (int i = 0; i < bits; ++i) r |= ((q >> i) & 1) << (bits - 1 - i); return r; }
template <int R, bool INV> __device__ __forceinline__ void dft_reg(f32x2 (&x)[R]) {
#pragma unroll
    for (int len = R; len >= 2; len >>= 1) { const int half = len >> 1, step = 16 / len;
#pragma unroll
        for (int b0 = 0; b0 < R; b0 += len)
#pragma unroll
            for (int k = 0; k < half; ++k) { const f32x2 a = x[b0 + k], b = x[b0 + k + half]; x[b0 + k] = a + b; const f32x2 dd = a - b; const int j = k * step;
                if (j == 0) x[b0 + k + half] = dd;
                else if (j == 4) x[b0 + k + half] = INV ? (f32x2){-dd.y, dd.x} : (f32x2){dd.y, -dd.x};
                else { const float c = w16c(j), s = w16s(j); x[b0 + k + half] = INV ? (f32x2){dd.x * c - dd.y * s, dd.x * s + dd.y * c} : (f32x2){dd.x * c + dd.y * s, dd.y * c - dd.x * s}; } } }
}
template <int R, int LOGN, bool INV> __device__ __forceinline__ void fft_pass(LAS f32x2* buf, int tid) {
    constexpr int LOGR = (R == 16) ? 4 : 3, LOGM = LOGN - LOGR, M = 1 << LOGM, NBF = 16384 / R / NTHR;
#pragma unroll 1
    for (int it = 0; it < NBF; ++it) {
        int tl = tid; asm volatile("" : "+v"(tl));
        const int bq = tl + NTHR * it, blk = bq >> LOGM, j = bq & (M - 1), base = (blk << LOGN) + j; const int fb = fsw(base);
#define FADDR(q) (fb ^ (((q) << LOGM) ^ ((((q) << LOGM) >> 5) & 7) ^ (((((q) << LOGM) >> 6) & 3) << 3)))
        f32x2 x[R];
#pragma unroll
        for (int q = 0; q < R; ++q) x[q] = buf[FADDR(q)];
        f32x2 w1 = (f32x2){1.f, 0.f};
        if (LOGM > 0) { const float rev = (float)j * (1.0f / (float)(1 << LOGN)); const float sn = sin_rev(rev); w1 = (f32x2){cos_rev(rev), INV ? sn : -sn}; }
        if (!INV) {
            dft_reg<R, false>(x);
            buf[fb] = x[0]; f32x2 w = w1;
#pragma unroll
            for (int q = 1; q < R; ++q) { buf[FADDR(q)] = (LOGM > 0) ? cmul(x[bitrev(q, LOGR)], w) : x[bitrev(q, LOGR)]; if (LOGM > 0) w = cmul(w, w1); }
        } else {
            if (LOGM > 0) { f32x2 w = w1;
#pragma unroll
                for (int q = 1; q < R; ++q) { x[q] = cmul(x[q], w); w = cmul(w, w1); } }
            dft_reg<R, true>(x);
#pragma unroll
            for (int q = 0; q < R; ++q) buf[FADDR(q)] = x[bitrev(q, LOGR)];
        }
#undef FADDR
    }
    __syncthreads();
}
#ifndef FFT_TEST
#define FFT_TEST 0
#endif
__device__ __forceinline__ void fft_fwd(LAS f32x2* buf, int tid) { if (FFT_TEST & 1) return; fft_pass<16, 14, false>(buf, tid); fft_pass<16, 10, false>(buf, tid); fft_pass<8, 6, false>(buf, tid); fft_pass<8, 3, false>(buf, tid); }
__device__ __forceinline__ void fft_inv(LAS f32x2* buf, int tid) { if (FFT_TEST & 2) return; fft_pass<8, 3, true>(buf, tid); fft_pass<8, 6, true>(buf, tid); fft_pass<16, 10, true>(buf, tid); fft_pass<16, 14, true>(buf, tid); }
__device__ __forceinline__ float block_sum(Frame& F, float v) {
    LAS float* red = (LAS float*)(F.lds + LDS_X);
    v = wave_sum(v); __syncthreads(); if (F.lane == 0) red[F.wave] = v; __syncthreads();
    float s = 0.f;
#pragma unroll
    for (int w = 0; w < NWAVES; ++w) s += red[w];
    return s;
}
__device__ __forceinline__ float sconv(const bf16* UH, int b, int ch, int t, float w0, float w1, float w2) {
    const bf16* p = UH + (size_t)(b * 3072 + ch) * SEQ;
    const int tm = t > 0 ? t - 1 : 0, tp = t < SEQ - 1 ? t + 1 : SEQ - 1;
    const float xm = bf2f(p[tm]), x0 = bf2f(p[t]), xp = bf2f(p[tp]);
    return w0 * (t > 0 ? xm : 0.f) + w1 * x0 + w2 * (t < SEQ - 1 ? xp : 0.f);
}
#define HY_UNPK(w) ((f32x2){bflo(w), bfhi(w)})
template <bool INV, class LD, class ST>
__device__ __forceinline__ void fft_edge_pass(LAS f32x2* buf, int tid, LD& ld, ST& st) {
    constexpr int R = 16, LOGN = 14, LOGM = 10;
#pragma unroll
    for (int it = 0; it < 2; ++it) {
        int tl = tid; asm volatile("" : "+v"(tl));
        const int j = tl + NTHR * it; const int fb = fsw(j);
        f32x2 x[R];
#pragma unroll
        for (int q = 0; q < R; ++q) x[q] = ld(2 * q + it, j + (q << LOGM), fb + (q << LOGM));
        const float rev = (float)j * (1.0f / 16384.0f); const float sn = sin_rev(rev); const f32x2 w1 = (f32x2){cos_rev(rev), INV ? sn : -sn};
        if (!INV) {
            dft_reg<R, false>(x);
            st(it, j, fb, x[0]); f32x2 w = w1;
#pragma unroll
            for (int q = 1; q < R; ++q) { st(2 * q + it, j + (q << LOGM), fb + (q << LOGM), cmul(x[bitrev(q, 4)], w)); w = cmul(w, w1); }
        } else {
            f32x2 w = w1;
#pragma unroll
            for (int q = 1; q < R; ++q) { x[q] = cmul(x[q], w); w = cmul(w, w1); }
            dft_reg<R, true>(x);
#pragma unroll
            for (int q = 0; q < R; ++q) st(2 * q + it, j + (q << LOGM), fb + (q << LOGM), x[bitrev(q, 4)]);
        }
        __builtin_amdgcn_sched_barrier(0);
    }
}
__device__ __forceinline__ void fft_last_to_ks(LAS f32x2* buf, int tid, unsigned* KS, float scale) {
#pragma unroll 1
    for (int it = 0; it < 4; ++it) { int tl = tid; asm volatile("" : "+v"(tl)); const int b = tl + NTHR * it; const int fb = fsw(8 * b);
        f32x2 x[8];
#pragma unroll
        for (int q = 0; q < 8; ++q) x[q] = buf[fb ^ q];
        dft_reg<8, false>(x);
        u32x4 o0, o1; f32x2 v;
        v = x[bitrev(0, 3)] * scale; o0.x = cvt_pk_bf16(v.x, v.y); v = x[bitrev(1, 3)] * scale; o0.y = cvt_pk_bf16(v.x, v.y); v = x[bitrev(2, 3)] * scale; o0.z = cvt_pk_bf16(v.x, v.y); v = x[bitrev(3, 3)] * scale; o0.w = cvt_pk_bf16(v.x, v.y);
        v = x[bitrev(4, 3)] * scale; o1.x = cvt_pk_bf16(v.x, v.y); v = x[bitrev(5, 3)] * scale; o1.y = cvt_pk_bf16(v.x, v.y); v = x[bitrev(6, 3)] * scale; o1.z = cvt_pk_bf16(v.x, v.y); v = x[bitrev(7, 3)] * scale; o1.w = cvt_pk_bf16(v.x, v.y);
        *(GAS u32x4*)(KS + 8 * b) = o0; *(GAS u32x4*)(KS + 8 * b + 4) = o1; }
}
__device__ __forceinline__ void fft_mid_mul(LAS f32x2* buf, int tid, const unsigned* KS) {
#pragma unroll 2
    for (int it = 0; it < 4; ++it) { int tl = tid; asm volatile("" : "+v"(tl)); const int b = tl + NTHR * it; const int fb = fsw(8 * b);
        const u32x4 k0 = *(const GAS u32x4*)(KS + 8 * b), k1 = *(const GAS u32x4*)(KS + 8 * b + 4);
        f32x2 x[8], y[8];
#pragma unroll
        for (int q = 0; q < 8; ++q) x[q] = buf[fb ^ q];
        dft_reg<8, false>(x);
        y[0] = cmul(x[bitrev(0, 3)], HY_UNPK(k0.x)); y[1] = cmul(x[bitrev(1, 3)], HY_UNPK(k0.y)); y[2] = cmul(x[bitrev(2, 3)], HY_UNPK(k0.z)); y[3] = cmul(x[bitrev(3, 3)], HY_UNPK(k0.w));
        y[4] = cmul(x[bitrev(4, 3)], HY_UNPK(k1.x)); y[5] = cmul(x[bitrev(5, 3)], HY_UNPK(k1.y)); y[6] = cmul(x[bitrev(6, 3)], HY_UNPK(k1.z)); y[7] = cmul(x[bitrev(7, 3)], HY_UNPK(k1.w));
        dft_reg<8, true>(y);
#pragma unroll
        for (int q = 0; q < 8; ++q) buf[fb ^ q] = y[bitrev(q, 3)]; }
    __syncthreads();
}
struct HyStLds { LAS f32x2* buf; __device__ __forceinline__ void operator()(int, int, int addr, f32x2 v) { buf[addr] = v; } };
struct HyLdLds { LAS f32x2* buf; __device__ __forceinline__ f32x2 operator()(int, int, int addr) { return buf[addr]; } };
struct HyLdKc { const bf16* f0; const bf16* f1; float part; __device__ __forceinline__ f32x2 operator()(int, int t, int) { const float a0 = bf2f(f0[t]), r1 = (t == 0) ? 0.f : bf2f(f1[SEQ - t]); part += fabsf(a0) + fabsf(r1); return (f32x2){a0 + r1, 0.f}; } };
struct HyLdKn { const bf16* f0; const bf16* f1; __device__ __forceinline__ f32x2 operator()(int, int t, int) { const float a0 = bf2f(f0[t]), r1 = (t == 0) ? 0.f : bf2f(f1[SEQ - t]); const float rev = (float)t * (1.0f / 32768.0f), v = a0 - r1; return (f32x2){v * cos_rev(rev), v * sin_rev(rev)}; } };
struct HyLdZ { const unsigned* z; __device__ __forceinline__ f32x2 operator()(int k, int, int) { return HY_UNPK(z[k]); } };
struct HyLdZpsi { const unsigned* z; __device__ __forceinline__ f32x2 operator()(int k, int t, int) { const float rev = (float)t * (1.0f / 32768.0f); return cmul(HY_UNPK(z[k]), (f32x2){cos_rev(rev), sin_rev(rev)}); } };
struct HyStYc { unsigned* yc; __device__ __forceinline__ void operator()(int k, int, int, f32x2 v) { const f32x2 w = v * (0.5f / 16384.0f); yc[k] = cvt_pk_bf16(w.x, w.y); } };
struct HyStComb { unsigned* z; const unsigned* yc; float bias;
    __device__ __forceinline__ void operator()(int k, int t, int, f32x2 v) { const float rev = (float)t * (1.0f / 32768.0f);
        const f32x2 yn = cmul(v, (f32x2){cos_rev(rev), -sin_rev(rev)}) * (0.5f / 16384.0f); const f32x2 y = yn + HY_UNPK(yc[k]) + HY_UNPK(z[k]) * bias; z[k] = cvt_pk_bf16(y.x, y.y); } };
template <bool NEG> __device__ __forceinline__ float hy_load_kernel(LAS f32x2* buf, int tid, const bf16* f0, const bf16* f1) {
    float part = 0.f;
#pragma unroll 2
    for (int r = 0; r < 4; ++r) { int tl = tid; asm volatile("" : "+v"(tl)); const int t0 = 8 * (tl + NTHR * r); const int fb = fsw(t0); float a[8], q[8];
        const u32x4 va = *(const GAS u32x4*)(f0 + t0), vr = *(const GAS u32x4*)(f1 + SEQ - t0 - 8); const float r0 = bf2f(f1[t0 > 0 ? SEQ - t0 : 0]);
        a[0] = bflo(va.x); a[1] = bfhi(va.x); a[2] = bflo(va.y); a[3] = bfhi(va.y); a[4] = bflo(va.z); a[5] = bfhi(va.z); a[6] = bflo(va.w); a[7] = bfhi(va.w);
        q[0] = t0 > 0 ? r0 : 0.f; q[1] = bfhi(vr.w); q[2] = bflo(vr.w); q[3] = bfhi(vr.z); q[4] = bflo(vr.z); q[5] = bfhi(vr.y); q[6] = bflo(vr.y); q[7] = bfhi(vr.x);
#pragma unroll
        for (int e = 0; e < 8; ++e) {
            if (!NEG) { part += fabsf(a[e]) + fabsf(q[e]); buf[fb ^ e] = (f32x2){a[e] + q[e], 0.f}; }
            else { const float rev = (float)(t0 + e) * (1.0f / 32768.0f), v = a[e] - q[e]; buf[fb ^ e] = (f32x2){v * cos_rev(rev), v * sin_rev(rev)}; } } }
    return part;
}
template <bool NEG> __device__ __forceinline__ void hy_load_kernel2(LAS f32x2* buf, int tid, const bf16* f0a, const bf16* f1a, const bf16* f0b, const bf16* f1b, float& part0, float& part1) {
#pragma unroll 2
    for (int r = 0; r < 4; ++r) { int tl = tid; asm volatile("" : "+v"(tl)); const int t0 = 8 * (tl + NTHR * r); const int fb = fsw(t0); float a[8], q[8], b[8], p[8];
        const u32x4 va = *(const GAS u32x4*)(f0a + t0), vr = *(const GAS u32x4*)(f1a + SEQ - t0 - 8); const float r0 = bf2f(f1a[t0 > 0 ? SEQ - t0 : 0]);
        const u32x4 vb = *(const GAS u32x4*)(f0b + t0), vs = *(const GAS u32x4*)(f1b + SEQ - t0 - 8); const float s0 = bf2f(f1b[t0 > 0 ? SEQ - t0 : 0]);
        a[0] = bflo(va.x); a[1] = bfhi(va.x); a[2] = bflo(va.y); a[3] = bfhi(va.y); a[4] = bflo(va.z); a[5] = bfhi(va.z); a[6] = bflo(va.w); a[7] = bfhi(va.w);
        q[0] = t0 > 0 ? r0 : 0.f; q[1] = bfhi(vr.w); q[2] = bflo(vr.w); q[3] = bfhi(vr.z); q[4] = bflo(vr.z); q[5] = bfhi(vr.y); q[6] = bflo(vr.y); q[7] = bfhi(vr.x);
        b[0] = bflo(vb.x); b[1] = bfhi(vb.x); b[2] = bflo(vb.y); b[3] = bfhi(vb.y); b[4] = bflo(vb.z); b[5] = bfhi(vb.z); b[6] = bflo(vb.w); b[7] = bfhi(vb.w);
        p[0] = t0 > 0 ? s0 : 0.f; p[1] = bfhi(vs.w); p[2] = bflo(vs.w); p[3] = bfhi(vs.z); p[4] = bflo(vs.z); p[5] = bfhi(vs.y); p[6] = bflo(vs.y); p[7] = bfhi(vs.x);
#pragma unroll
        for (int e = 0; e < 8; ++e) {
            if (!NEG) { part0 += fabsf(a[e]) + fabsf(q[e]); part1 += fabsf(b[e]) + fabsf(p[e]); buf[fb ^ e] = (f32x2){a[e] + q[e], b[e] + p[e]}; }
            else { const float rev = (float)(t0 + e) * (1.0f / 32768.0f), v0 = a[e] - q[e], v1 = b[e] - p[e]; buf[fb ^ e] = cmul((f32x2){v0, v1}, (f32x2){cos_rev(rev), sin_rev(rev)}); } } }
}
template <bool NEG> __device__ __forceinline__ void hy_split_to_ks(LAS f32x2* buf, int tid, unsigned* KS0, unsigned* KS1, float inv0, float inv1) {
    constexpr int S = NEG ? 1 : 0;
#pragma unroll 1
    for (int it = 0; it < 4; ++it) { int tl = tid; asm volatile("" : "+v"(tl)); const int b = tl + NTHR * it;
        const int l = (b >> 7) + 16 * ((b >> 3) & 15) + 256 * (b & 7); const int nl = (S - l) & 2047; const int br = (l > S) ? 1 : 0;
        const int bp = (nl & 15) * 128 + ((nl >> 4) & 15) * 8 + ((nl >> 8) & 7);
        const int fb = fsw(8 * b), fp = fsw(8 * bp);
        unsigned o0[8], o1[8]; const float h0 = 0.5f * inv0, h1 = 0.5f * inv1;
#pragma unroll
        for (int q = 0; q < 8; ++q) { const f32x2 zz = buf[fb ^ q], zp = buf[fp ^ ((-q - br) & 7)];
            o0[q] = cvt_pk_bf16((zz.x + zp.x) * h0, (zz.y - zp.y) * h0); o1[q] = cvt_pk_bf16((zz.y + zp.y) * h1, (zp.x - zz.x) * h1); }
        *(GAS u32x4*)(KS0 + 8 * b) = (u32x4){o0[0], o0[1], o0[2], o0[3]}; *(GAS u32x4*)(KS0 + 8 * b + 4) = (u32x4){o0[4], o0[5], o0[6], o0[7]};
        *(GAS u32x4*)(KS1 + 8 * b) = (u32x4){o1[0], o1[1], o1[2], o1[3]}; *(GAS u32x4*)(KS1 + 8 * b + 4) = (u32x4){o1[4], o1[5], o1[6], o1[7]}; }
}
__device__ __forceinline__ void hy_conv8(const u32x4 v, float hm, float hp, float w0, float w1, float w2, float (&o)[8]) {
    const float x1 = bflo(v.x), x2 = bfhi(v.x), x3 = bflo(v.y), x4 = bfhi(v.y), x5 = bflo(v.z), x6 = bfhi(v.z), x7 = bflo(v.w), x8 = bfhi(v.w);
    o[0] = w0 * hm + w1 * x1 + w2 * x2; o[1] = w0 * x1 + w1 * x2 + w2 * x3; o[2] = w0 * x2 + w1 * x3 + w2 * x4; o[3] = w0 * x3 + w1 * x4 + w2 * x5;
    o[4] = w0 * x4 + w1 * x5 + w2 * x6; o[5] = w0 * x5 + w1 * x6 + w2 * x7; o[6] = w0 * x6 + w1 * x7 + w2 * x8; o[7] = w0 * x7 + w1 * x8 + w2 * hp;
}
__device__ __forceinline__ void hy_load_conv(LAS f32x2* buf, int tid, const bf16* UH, int ch, float w0, float w1, float w2) {
    const bf16* p0 = UH + (size_t)ch * SEQ; const bf16* p1 = UH + (size_t)(3072 + ch) * SEQ;
#pragma unroll 2
    for (int r = 0; r < 4; ++r) { int tl = tid; asm volatile("" : "+v"(tl)); const int t0 = 8 * (tl + NTHR * r); const int fb = fsw(t0);
        const int tm = t0 > 0 ? t0 - 1 : 0, tp = t0 + 8 < SEQ ? t0 + 8 : SEQ - 1;
        const u32x4 va = *(const GAS u32x4*)(p0 + t0), vb = *(const GAS u32x4*)(p1 + t0);
        float am = bf2f(p0[tm]), ap = bf2f(p0[tp]), bm = bf2f(p1[tm]), bp = bf2f(p1[tp]);
        if (t0 == 0) { am = 0.f; bm = 0.f; } if (t0 + 8 >= SEQ) { ap = 0.f; bp = 0.f; }
        float oa[8], ob[8]; hy_conv8(va, am, ap, w0, w1, w2, oa); hy_conv8(vb, bm, bp, w0, w1, w2, ob);
        buf[fb ^ 0] = (f32x2){oa[0], ob[0]}; buf[fb ^ 1] = (f32x2){oa[1], ob[1]}; buf[fb ^ 2] = (f32x2){oa[2], ob[2]}; buf[fb ^ 3] = (f32x2){oa[3], ob[3]};
        buf[fb ^ 4] = (f32x2){oa[4], ob[4]}; buf[fb ^ 5] = (f32x2){oa[5], ob[5]}; buf[fb ^ 6] = (f32x2){oa[6], ob[6]}; buf[fb ^ 7] = (f32x2){oa[7], ob[7]}; }
}
__device__ __forceinline__ void hyena_item(Frame& F, int c) {
    LAS f32x2* buf = (LAS f32x2*)F.lds;
    unsigned* KS = (unsigned*)(F.ws + WS_HYS + (size_t)F.bx * HYS_STRIDE);
    const bf16* FILT = (const bf16*)(F.ws + WS_FILT); const bf16* UH = (const bf16*)(F.ws + WS_UH);
    const int tid = F.tid; const int ft = fsw(tid);
#define FB(k) buf[ft + NTHR * (k)]
    const float* sw = F.in[IN_HSW];
    unsigned z[32], yc[32];
    HyStLds stl{buf}; HyLdLds ldl{buf};
    hy_load_conv(buf, tid, UH, c, sw[c], sw[3072 + c], sw[6144 + c]);
    __syncthreads();
#pragma unroll
    for (int k = 0; k < 32; ++k) { const f32x2 v_ = FB(k); z[k] = cvt_pk_bf16(v_.x, v_.y); }
    { const bf16* f0a = FILT + (size_t)c * SEQ; const bf16* f1a = FILT + (size_t)(2048 + c) * SEQ; const bf16* f0b = FILT + (size_t)(1024 + c) * SEQ; const bf16* f1b = FILT + (size_t)(3072 + c) * SEQ;
      float part0 = 0.f, part1 = 0.f;
      __syncthreads();
      hy_load_kernel2<false>(buf, tid, f0a, f1a, f0b, f1b, part0, part1);
      const float inv0 = 1.0f / (block_sum(F, part0) + 1e-6f); const float inv1 = 1.0f / (block_sum(F, part1) + 1e-6f);
      fft_edge_pass<false>(buf, tid, ldl, stl); __syncthreads();
      fft_pass<16, 10, false>(buf, tid); fft_pass<8, 6, false>(buf, tid); fft_pass<8, 3, false>(buf, tid);
      hy_split_to_ks<false>(buf, tid, KS, KS + 16384, inv0, inv1); __syncthreads();
      { float d0 = 0.f, d1 = 0.f; hy_load_kernel2<true>(buf, tid, f0a, f1a, f0b, f1b, d0, d1); } __syncthreads();
      fft_edge_pass<false>(buf, tid, ldl, stl); __syncthreads();
      fft_pass<16, 10, false>(buf, tid); fft_pass<8, 6, false>(buf, tid); fft_pass<8, 3, false>(buf, tid);
      hy_split_to_ks<true>(buf, tid, KS + 2 * 16384, KS + 3 * 16384, inv0, inv1); __syncthreads(); }
#pragma unroll 1
    for (int o = 0; o < 2; ++o) {
        { HyLdZ ldz{z}; fft_edge_pass<false>(buf, tid, ldz, stl); __syncthreads(); }
        fft_pass<16, 10, false>(buf, tid); fft_pass<8, 6, false>(buf, tid);
        fft_mid_mul(buf, tid, KS + o * 16384);
        fft_pass<8, 6, true>(buf, tid); fft_pass<16, 10, true>(buf, tid);
        { HyStYc styc{yc}; fft_edge_pass<true>(buf, tid, ldl, styc); }
        __syncthreads();
        { HyLdZpsi ldzp{z}; fft_edge_pass<false>(buf, tid, ldzp, stl); __syncthreads(); }
        fft_pass<16, 10, false>(buf, tid); fft_pass<8, 6, false>(buf, tid);
        { const bf16* g0 = UH + (size_t)((o + 1) * 1024 + c) * SEQ + 8 * tid; const bf16* g1 = g0 + (size_t)3072 * SEQ;
          u32x4 t0 = *(const GAS u32x4*)(g0), t1 = *(const GAS u32x4*)(g0 + 4096), t2 = *(const GAS u32x4*)(g0 + 8192), t3 = *(const GAS u32x4*)(g0 + 12288);
          u32x4 t4 = *(const GAS u32x4*)(g1), t5 = *(const GAS u32x4*)(g1 + 4096), t6 = *(const GAS u32x4*)(g1 + 8192), t7 = *(const GAS u32x4*)(g1 + 12288);
          fft_mid_mul(buf, tid, KS + (2 + o) * 16384);
          asm volatile("" :: "v"(t0), "v"(t1), "v"(t2), "v"(t3), "v"(t4), "v"(t5), "v"(t6), "v"(t7)); }
        fft_pass<8, 6, true>(buf, tid); fft_pass<16, 10, true>(buf, tid);
        { HyStComb stc{z, yc, F.in[IN_HBIAS][o * 1024 + c]}; fft_edge_pass<true>(buf, tid, ldl, stc); }
#pragma unroll
        for (int k = 0; k < 32; ++k) FB(k) = HY_UNPK(z[k]);
        { const int xch = (o + 1) * 1024 + c; const float w0 = sw[xch], w1 = sw[3072 + xch], w2 = sw[6144 + xch];
#pragma unroll 8
          for (int k = 0; k < 32; ++k) { const int t = tid + NTHR * k; f32x2 v_ = FB(k); v_.x *= sconv(UH, 0, xch, t, w0, w1, w2); v_.y *= sconv(UH, 1, xch, t, w0, w1, w2); FB(k) = v_; } }
#pragma unroll
        for (int k = 0; k < 32; ++k) { const f32x2 v_ = FB(k); z[k] = cvt_pk_bf16(v_.x, v_.y); }
        __syncthreads();
    }
    bf16* YHCM = (bf16*)(F.ws + WS_YHCM);
#pragma unroll
    for (int k = 0; k < 32; ++k) FB(k) = HY_UNPK(z[k]);
#pragma unroll 8
    for (int k = 0; k < 32; ++k) { const int t = tid + NTHR * k; const f32x2 v_ = FB(k); YHCM[(size_t)c * SEQ + t] = (bf16)f2bf(v_.x); YHCM[(size_t)(1024 + c) * SEQ + t] = (bf16)f2bf(v_.y); }
    __syncthreads();
#undef FB
}
__device__ __forceinline__ void p3_publish(Frame& F) {
    asm volatile("s_waitcnt vmcnt(0)" ::: "memory");
    __syncthreads();
    if (F.tid == 0) { __builtin_amdgcn_fence(__ATOMIC_RELEASE, "agent"); asm volatile("s_waitcnt vmcnt(0)" ::: "memory"); (void)xb_add((unsigned*)(F.ctl + CW_P3), 1u); }
}
__device__ __forceinline__ void p3_wait(Frame& F) {
    if (F.tid == 0) { unsigned* bar = (unsigned*)(F.ctl + CW_BAR);
        XB_SPIN(xb_ld((unsigned*)(F.ctl + CW_P3)) < (unsigned)F.G, bar);
        __builtin_amdgcn_fence(__ATOMIC_ACQUIRE, "agent"); asm volatile("s_waitcnt vmcnt(0)" ::: "memory"); }
    __syncthreads();
}
__device__ __forceinline__ void p4_hyena_carry(Frame& F, int qw) {
    volatile LAS int* qs = (volatile LAS int*)(F.lds + MISC_OFF + 64);
    for (;;) {
        __syncthreads();
        if (F.tid == 0) qs[0] = (int)__hip_atomic_fetch_add((unsigned*)(F.ctl + qw), 1u, __ATOMIC_RELAXED, __HIP_MEMORY_SCOPE_AGENT);
        __syncthreads();
        const int q = qs[0];
        if (q >= 32 + 1024) break;
        if (q < 1024) hyena_item(F, q); else { p3_wait(F); s5_carry_item(F, q - 1024); }
    }
}
__device__ __forceinline__ void yh_transpose(Frame& F) {
    const bf16* YHCM = (const bf16*)(F.ws + WS_YHCM); bf16* YH = (bf16*)(F.ws + WS_YH);
    LAS unsigned short* tl = (LAS unsigned short*)(F.lds + 8 * 8704 + F.wave * (64 * 72 * 2));
    const int gw = F.bx * NWAVES + F.wave, NGW = F.G * NWAVES, lane = F.lane;
    for (int it = gw; it < 2 * 16 * 256; it += NGW) {
        const int mt = it & 255, ct = (it >> 8) & 15, b = it >> 12; const int m0 = mt * 64, c0 = ct * 64;
#pragma unroll
        for (int j = 0; j < 8; ++j) { const int ch = 8 * j + (lane >> 3), mc = (lane & 7) * 8;
            const u32x4 v = *(const GAS u32x4*)(YHCM + (size_t)(b * 1024 + c0 + ch) * SEQ + m0 + mc); *(LAS u32x4*)(tl + ch * 72 + mc) = v; }
        LDS_WAIT(); asm volatile("" ::: "memory");
#pragma unroll
        for (int j = 0; j < 8; ++j) { const int mm = 8 * j + (lane >> 3), cc = (lane & 7) * 8; const int m = m0 + mm, w = m >> 8, r = m & 255;
            u32x4 o; o.x = (unsigned)tl[(cc + 0) * 72 + mm] | ((unsigned)tl[(cc + 1) * 72 + mm] << 16); o.y = (unsigned)tl[(cc + 2) * 72 + mm] | ((unsigned)tl[(cc + 3) * 72 + mm] << 16);
            o.z = (unsigned)tl[(cc + 4) * 72 + mm] | ((unsigned)tl[(cc + 5) * 72 + mm] << 16); o.w = (unsigned)tl[(cc + 6) * 72 + mm] | ((unsigned)tl[(cc + 7) * 72 + mm] << 16);
            *(GAS u32x4*)(YH + (size_t)(b * SEQ + r * 64 + w) * HYW + c0 + cc) = o; }
        LDS_WAIT(); asm volatile("" ::: "memory");
    }
}

struct SchedStd {
    int G, c, npn, K, nrep; const char* A; const char* Bt; int esz = 2;
    __device__ __forceinline__ bool next(int i, pg8::Unit& u) const {
        int L = i * G + c; const int nwg = 128 * npn; u.e = 0; u.valid = 256;
        if (nrep > 1 && L >= nwg) L -= nwg;
        if (L >= nwg) return false;
        int wgid = L; { const int q = nwg / 8, xcd = wgid % 8, off = wgid / 8; wgid = xcd * q + off; }
        const int nig = 8 * npn, gid = wgid / nig; u.pm = gid * 8 + ((wgid % nig) % 8); u.pn = (wgid % nig) / 8; return true;
    }
    __device__ __forceinline__ unsigned a_row(const pg8::Unit& u, int r) const { return (unsigned)(u.pm * 256 + r); }
    __device__ __forceinline__ const char* a_base() const { return A; }
    __device__ __forceinline__ const char* b_base(const pg8::Unit& u) const { return Bt + (size_t)u.pn * 256 * K * esz; }
};
template <int MODE> struct EpiMix {
    static constexpr bool PERM = true, TRANS = true, FP8 = false;
    const bf16* P; const bf16* Q; bf16* O;
    __device__ __forceinline__ void operator()(const f32x4 (&acc)[2][2][4][2], const pg8::Unit& u, int wr, int wc, int fr, int fq) const {
        constexpr int ld = (MODE == 0) ? 1024 : 2048;
        const int col0 = u.pn * 256 + wc * 32 + 8 * fq;
#pragma unroll
        for (int ai = 0; ai < 2; ++ai) {
            u32x4 pv[4][2], qv[4][2];
#pragma unroll
            for (int m = 0; m < 4; ++m) { const size_t row = (size_t)u.pm * 256 + ai * 128 + wr * 64 + m * 16 + fr;
#pragma unroll
                for (int bj = 0; bj < 2; ++bj) { const int col = col0 + bj * 128;
                    if (MODE == 0) pv[m][bj] = *(const u32x4*)(P + row * 1024 + col);
                    else { const u32x2 g8 = *(const u32x2*)((const unsigned char*)P + row * 4096 + (MODE == 2 ? 2048 : 0) + col); pv[m][bj] = (u32x4){g8.x, g8.y, 0u, 0u}; }
                    if (MODE == 2) qv[m][bj] = *(const u32x4*)(Q + row * 2048 + col); } }
#pragma unroll
            for (int m = 0; m < 4; ++m) { const size_t row = (size_t)u.pm * 256 + ai * 128 + wr * 64 + m * 16 + fr;
#pragma unroll
                for (int bj = 0; bj < 2; ++bj) { const int col = col0 + bj * 128; const f32x4 v0 = acc[ai][bj][m][0], v1 = acc[ai][bj][m][1]; float r[8];
                    if (MODE == 0) { const u32x4 y = pv[m][bj];
                        r[0] = bflo(y.x) * sigmoidf_(v0[0]); r[1] = bfhi(y.x) * sigmoidf_(v0[1]); r[2] = bflo(y.y) * sigmoidf_(v0[2]); r[3] = bfhi(y.y) * sigmoidf_(v0[3]);
                        r[4] = bflo(y.z) * sigmoidf_(v1[0]); r[5] = bfhi(y.z) * sigmoidf_(v1[1]); r[6] = bflo(y.w) * sigmoidf_(v1[2]); r[7] = bfhi(y.w) * sigmoidf_(v1[3]); }
                    else { const u32x4 gg = pv[m][bj]; constexpr float q = 1.0f / 255.0f;
                        r[0] = (float)(gg.x & 255u) * q * v0[0]; r[1] = (float)((gg.x >> 8) & 255u) * q * v0[1]; r[2] = (float)((gg.x >> 16) & 255u) * q * v0[2]; r[3] = (float)(gg.x >> 24) * q * v0[3];
                        r[4] = (float)(gg.y & 255u) * q * v1[0]; r[5] = (float)((gg.y >> 8) & 255u) * q * v1[1]; r[6] = (float)((gg.y >> 16) & 255u) * q * v1[2]; r[7] = (float)(gg.y >> 24) * q * v1[3];
                        if (MODE == 2) { const u32x4 t1 = qv[m][bj];
                            r[0] += bflo(t1.x); r[1] += bfhi(t1.x); r[2] += bflo(t1.y); r[3] += bfhi(t1.y); r[4] += bflo(t1.z); r[5] += bfhi(t1.z); r[6] += bflo(t1.w); r[7] += bfhi(t1.w); } }
                    if (MODE == 2) {
                        *(u32x2*)((unsigned char*)O + row * ld + col) = (u32x2){pk4_fp8(r[0] * T8SCALE, r[1] * T8SCALE, r[2] * T8SCALE, r[3] * T8SCALE), pk4_fp8(r[4] * T8SCALE, r[5] * T8SCALE, r[6] * T8SCALE, r[7] * T8SCALE)}; }
                    else { u32x4 w; w.x = cvt_pk_bf16(r[0], r[1]); w.y = cvt_pk_bf16(r[2], r[3]); w.z = cvt_pk_bf16(r[4], r[5]); w.w = cvt_pk_bf16(r[6], r[7]);
                        *(u32x4*)(O + row * ld + col) = w; } } }
        }
    }
};
struct EpiOut {
    static constexpr bool PERM = true, TRANS = true, FP8 = true;
    const float* X; const float* MOD; bf16* H1;
    __device__ __forceinline__ void operator()(const f32x4 (&acc)[2][2][4][2], const pg8::Unit& u, int wr, int wc, int fr, int fq) const {
        const int b = u.pm >> 6; const int c0 = u.pn * 256 + wc * 32 + 8 * fq;
        f32x4 gv[2][2];
#pragma unroll
        for (int bj = 0; bj < 2; ++bj)
#pragma unroll
            for (int n = 0; n < 2; ++n) gv[bj][n] = *(const f32x4*)(MOD + b * 12288 + 2 * 2048 + c0 + bj * 128 + 4 * n) * (1.0f / (W8SCALE * T8SCALE));
#pragma unroll
        for (int ai = 0; ai < 2; ++ai) {
            f32x4 xv[4][2][2];
#pragma unroll
            for (int m = 0; m < 4; ++m) { const size_t off = ((size_t)u.pm * 256 + ai * 128 + wr * 64 + m * 16 + fr) * D + c0;
#pragma unroll
                for (int bj = 0; bj < 2; ++bj)
#pragma unroll
                    for (int n = 0; n < 2; ++n) xv[m][bj][n] = *(const f32x4*)(X + off + bj * 128 + 4 * n); }
#pragma unroll
            for (int m = 0; m < 4; ++m) { const size_t off = ((size_t)u.pm * 256 + ai * 128 + wr * 64 + m * 16 + fr) * D + c0;
#pragma unroll
                for (int bj = 0; bj < 2; ++bj) { const f32x4 v0 = xv[m][bj][0] + gv[bj][0] * acc[ai][bj][m][0], v1 = xv[m][bj][1] + gv[bj][1] * acc[ai][bj][m][1];
                    u32x4 w; w.x = cvt_pk_bf16(v0[0], v0[1]); w.y = cvt_pk_bf16(v0[2], v0[3]); w.z = cvt_pk_bf16(v1[0], v1[1]); w.w = cvt_pk_bf16(v1[2], v1[3]);
                    *(u32x4*)(H1 + off + bj * 128) = w; } }
        }
    }
};

__device__ __forceinline__ float row16_max(float v) {
    v = fmaxf(v, __builtin_bit_cast(float, __builtin_amdgcn_update_dpp(0, __builtin_bit_cast(int, v), 0xB1, 0xf, 0xf, true)));
    v = fmaxf(v, __builtin_bit_cast(float, __builtin_amdgcn_update_dpp(0, __builtin_bit_cast(int, v), 0x4E, 0xf, 0xf, true)));
    v = fmaxf(v, __builtin_bit_cast(float, __builtin_amdgcn_update_dpp(0, __builtin_bit_cast(int, v), 0x141, 0xf, 0xf, true)));
    v = fmaxf(v, __builtin_bit_cast(float, __builtin_amdgcn_update_dpp(0, __builtin_bit_cast(int, v), 0x140, 0xf, 0xf, true)));
    return v;
}
__device__ __forceinline__ void p10_router(Frame& F) {
    const int gw = F.bx * NWAVES + F.wave, NGW = F.G * NWAVES, lane = F.lane;
    const float* MOD = (const float*)(F.ws + WS_MOD); const float* g2n = F.in[IN_N2G]; const float* RWT = (const float*)(F.ws + WS_RWT); const float* rb = F.in[IN_RB];
    const bf16* H1 = (const bf16*)(F.ws + WS_H1); unsigned char* HM8 = (unsigned char*)(F.ws + WS_HM8); float* GATE = (float*)(F.ws + WS_GATE); int* LIST = (int*)(F.ws + WS_LIST);
    LAS float* rs = (LAS float*)(F.lds + F.wave * 64);
    volatile LAS int* lcnt = (volatile LAS int*)(F.lds + 1024); volatile LAS int* lbase = lcnt + 32;
    const int nblk = NTOK / 16, ntrips = (nblk + NGW - 1) / NGW;
    for (int tr = 0; tr < ntrips; ++tr) {
        const int blk = gw + NGW * tr; const bool act = blk < nblk;
        if (F.tid < NEXP) lcnt[F.tid] = 0;
        __syncthreads();
        int tke[4], tkp[4]; float tkg[4];
#pragma unroll
        for (int r = 0; r < 4; ++r) { tke[r] = 0; tkp[r] = 0; tkg[r] = 0.f; }
        const int mb = 16 * (act ? blk : 0); const int b = mb >> 14;
        if (act) {
#pragma unroll 1
        for (int rp = 0; rp < 8; ++rp) { const int m0 = mb + 2 * rp;
            f32x4 h[2][8];
#pragma unroll
            for (int rr = 0; rr < 2; ++rr) { const bf16* xr = H1 + (size_t)(m0 + rr) * D; float sq = 0.f;
#pragma unroll
                for (int j = 0; j < 8; ++j) { const u32x2 hb = *(const GAS u32x2*)(xr + 4 * lane + 256 * j); h[rr][j] = (f32x4){bflo(hb.x), bfhi(hb.x), bflo(hb.y), bfhi(hb.y)}; sq += (h[rr][j].x * h[rr][j].x + h[rr][j].y * h[rr][j].y) + (h[rr][j].z * h[rr][j].z + h[rr][j].w * h[rr][j].w); }
                const float rstd = 1.0f / sqrtf(wave_sum(sq) * (1.0f / D) + 1e-6f);
                if (lane == 0) rs[2 * rp + rr] = rstd;
#pragma unroll
                for (int j = 0; j < 8; ++j) { const int k = 4 * lane + 256 * j; const f32x4 g = *(const f32x4*)(g2n + k), sc = *(const f32x4*)(MOD + b * 12288 + 4 * 2048 + k), sh = *(const f32x4*)(MOD + b * 12288 + 3 * 2048 + k);
                    h[rr][j] = h[rr][j] * rstd * g * (sc + 1.0f) + sh; }
                GAS unsigned* o = (GAS unsigned*)(HM8 + (size_t)(m0 + rr) * D) + lane;
#pragma unroll
                for (int j = 0; j < 8; ++j) o[64 * j] = pk4_fp8(h[rr][j].x, h[rr][j].y, h[rr][j].z, h[rr][j].w); } }
        const int jr = lane & 15, kq = lane >> 4;
        const float rstd = rs[jr];
        const bf16* hrow = H1 + (size_t)(mb + jr) * D + 8 * kq; const float* gp = g2n + 8 * kq; const float* scp = MOD + b * 12288 + 4 * 2048 + 8 * kq; const float* shp = MOD + b * 12288 + 3 * 2048 + 8 * kq;
        const float* w0p = RWT + (size_t)jr * 2048 + 8 * kq; const float* w1p = w0p + 16 * 2048;
        f32x4 acc0 = (f32x4){0.f, 0.f, 0.f, 0.f}, acc1 = (f32x4){0.f, 0.f, 0.f, 0.f};
#pragma unroll 2
        for (int t = 0; t < 64; ++t) { const int ko = 32 * t;
            const u32x4 hb = *(const GAS u32x4*)(hrow + ko);
            const f32x4 g0 = *(const f32x4*)(gp + ko), g1 = *(const f32x4*)(gp + ko + 4), s0 = *(const f32x4*)(scp + ko), s1 = *(const f32x4*)(scp + ko + 4), t0 = *(const f32x4*)(shp + ko), t1 = *(const f32x4*)(shp + ko + 4);
            const f32x4 a0 = *(const f32x4*)(w0p + ko), a1 = *(const f32x4*)(w0p + ko + 4), c0 = *(const f32x4*)(w1p + ko), c1 = *(const f32x4*)(w1p + ko + 4);
            float hm[8];
            hm[0] = bflo(hb.x) * rstd * g0.x * (s0.x + 1.0f) + t0.x; hm[1] = bfhi(hb.x) * rstd * g0.y * (s0.y + 1.0f) + t0.y; hm[2] = bflo(hb.y) * rstd * g0.z * (s0.z + 1.0f) + t0.z; hm[3] = bfhi(hb.y) * rstd * g0.w * (s0.w + 1.0f) + t0.w;
            hm[4] = bflo(hb.z) * rstd * g1.x * (s1.x + 1.0f) + t1.x; hm[5] = bfhi(hb.z) * rstd * g1.y * (s1.y + 1.0f) + t1.y; hm[6] = bflo(hb.w) * rstd * g1.z * (s1.z + 1.0f) + t1.z; hm[7] = bfhi(hb.w) * rstd * g1.w * (s1.w + 1.0f) + t1.w;
            acc0 = __builtin_amdgcn_mfma_f32_16x16x4f32(hm[0], a0.x, acc0, 0, 0, 0); acc1 = __builtin_amdgcn_mfma_f32_16x16x4f32(hm[0], c0.x, acc1, 0, 0, 0);
            acc0 = __builtin_amdgcn_mfma_f32_16x16x4f32(hm[1], a0.y, acc0, 0, 0, 0); acc1 = __builtin_amdgcn_mfma_f32_16x16x4f32(hm[1], c0.y, acc1, 0, 0, 0);
            acc0 = __builtin_amdgcn_mfma_f32_16x16x4f32(hm[2], a0.z, acc0, 0, 0, 0); acc1 = __builtin_amdgcn_mfma_f32_16x16x4f32(hm[2], c0.z, acc1, 0, 0, 0);
            acc0 = __builtin_amdgcn_mfma_f32_16x16x4f32(hm[3], a0.w, acc0, 0, 0, 0); acc1 = __builtin_amdgcn_mfma_f32_16x16x4f32(hm[3], c0.w, acc1, 0, 0, 0);
            acc0 = __builtin_amdgcn_mfma_f32_16x16x4f32(hm[4], a1.x, acc0, 0, 0, 0); acc1 = __builtin_amdgcn_mfma_f32_16x16x4f32(hm[4], c1.x, acc1, 0, 0, 0);
            acc0 = __builtin_amdgcn_mfma_f32_16x16x4f32(hm[5], a1.y, acc0, 0, 0, 0); acc1 = __builtin_amdgcn_mfma_f32_16x16x4f32(hm[5], c1.y, acc1, 0, 0, 0);
            acc0 = __builtin_amdgcn_mfma_f32_16x16x4f32(hm[6], a1.z, acc0, 0, 0, 0); acc1 = __builtin_amdgcn_mfma_f32_16x16x4f32(hm[6], c1.z, acc1, 0, 0, 0);
            acc0 = __builtin_amdgcn_mfma_f32_16x16x4f32(hm[7], a1.w, acc0, 0, 0, 0); acc1 = __builtin_amdgcn_mfma_f32_16x16x4f32(hm[7], c1.w, acc1, 0, 0, 0); }
        const float be0 = rb[jr], be1 = rb[16 + jr];
#pragma unroll
        for (int r = 0; r < 4; ++r) { float va = acc0[r] + be0, vc = acc1[r] + be1; int es[4]; float vs[4];
#pragma unroll
            for (int k = 0; k < 4; ++k) { const float mx = row16_max(fmaxf(va, vc));
                const unsigned long long b0 = __ballot(va == mx), b1 = __ballot(vc == mx); const unsigned m0 = (unsigned)(b0 >> (16 * kq)) & 0xffffu, m1 = (unsigned)(b1 >> (16 * kq)) & 0xffffu;
                const int idx = m0 ? (__ffs((int)m0) - 1) : (16 + __ffs((int)m1) - 1);
                es[k] = idx; vs[k] = mx; if (jr == idx) va = -3.0e38f; if (jr + 16 == idx) vc = -3.0e38f; }
            const float e1 = __expf(vs[1] - vs[0]), e2 = __expf(vs[2] - vs[0]), e3 = __expf(vs[3] - vs[0]); const float inv = 1.0f / (1.0f + e1 + e2 + e3);
            if (jr < 4) { const int ee = jr == 0 ? es[0] : jr == 1 ? es[1] : jr == 2 ? es[2] : es[3]; tke[r] = ee; tkg[r] = (jr == 0 ? 1.0f : jr == 1 ? e1 : jr == 2 ? e2 : e3) * inv;
                tkp[r] = __hip_atomic_fetch_add((LAS int*)(F.lds + 1024) + ee, 1, __ATOMIC_RELAXED, __HIP_MEMORY_SCOPE_WORKGROUP); } }
        }
        __syncthreads();
        if (F.tid < NEXP) { const int cnt = lcnt[F.tid]; int base = 0;
            if (cnt > 0) base = (int)__hip_atomic_fetch_add((unsigned*)(F.ctl + CW_CNT + 64 * F.tid), (unsigned)cnt, __ATOMIC_RELAXED, __HIP_MEMORY_SCOPE_AGENT);
            lbase[F.tid] = base; }
        __syncthreads();
        if (act && (lane & 15) < 4) {
#pragma unroll
            for (int r = 0; r < 4; ++r) { const int slot = (mb + 4 * (lane >> 4) + r) * 4 + (lane & 15); LIST[tke[r] * LISTCAP + lbase[tke[r]] + tkp[r]] = slot; GATE[slot] = tkg[r]; } }
    }
}

__device__ __forceinline__ void moe_tables(Frame& F) {
    volatile LAS int* tb = (volatile LAS int*)(F.lds + LDS_X);
    __syncthreads();
    if (F.tid < NEXP) tb[64 + F.tid] = (int)__hip_atomic_load((unsigned*)(F.ctl + CW_CNT + 64 * F.tid), __ATOMIC_RELAXED, __HIP_MEMORY_SCOPE_AGENT);
    __syncthreads();
    if (F.tid == 0) { int acc = 0; for (int e = 0; e < NEXP; ++e) { const int c = tb[64 + e]; tb[e] = acc; acc += (c + 255) >> 8; } tb[32] = acc; }
    __syncthreads();
}
template <bool GATHER> struct SchedMoe {
    int G, c, npn, N, K, nrep; const char* A; const char* Bt; const int* LIST; volatile LAS int* tb;
    __device__ __forceinline__ bool next(int i, pg8::Unit& u) const {
        int L = i * G + c; { const int tot = tb[32] * npn; if (nrep > 1 && L >= tot) L -= tot; }
        int rt = L / npn, pnq = L % npn;
        if (G == 256 && nrep == 1) {
            const int x = c & 7, j = c >> 3;
            if (npn == 16) { pnq = 4 * (x & 3) + (j & 3); rt = 16 * i + (x >> 2) * 8 + (j >> 2); }
            else           { pnq = 2 * (x & 3) + (j & 1); rt = 32 * i + (x >> 2) * 16 + (j >> 1); }
        }
        if (rt >= tb[32]) return false;
        int e = 0;
        for (int q = 1; q < NEXP; ++q) e += (tb[q] <= rt) ? 1 : 0;
        e = __builtin_amdgcn_readfirstlane(e);
        u.pm = rt; u.pn = pnq; u.e = e; const int left = tb[64 + e] - 256 * (rt - tb[e]); u.valid = left < 256 ? left : 256; return true;
    }
    __device__ __forceinline__ unsigned a_row(const pg8::Unit& u, int r) const {
        if (GATHER) { const int rc = r < u.valid ? r : u.valid - 1; return (unsigned)(LIST[u.e * LISTCAP + (u.pm - tb[u.e]) * 256 + rc] >> 2); }
        return (unsigned)(u.pm * 256 + r);
    }
    __device__ __forceinline__ const char* a_base() const { return A; }
    __device__ __forceinline__ const char* b_base(const pg8::Unit& u) const { return Bt + ((size_t)u.e * N + (size_t)u.pn * 256) * K; }
};
struct EpiMoe1 {
    static constexpr bool PERM = true, TRANS = true, FP8 = true;
    const float* BG; unsigned char* ACT;
    __device__ __forceinline__ void operator()(const f32x4 (&acc)[2][2][4][2], const pg8::Unit& u, int wr, int wc, int fr, int fq) const {
        const int c0 = u.pn * 256 + wc * 32 + 8 * fq;
        f32x4 bv[2][2];
#pragma unroll
        for (int bj = 0; bj < 2; ++bj)
#pragma unroll
            for (int n = 0; n < 2; ++n) bv[bj][n] = *(const f32x4*)(BG + (size_t)u.e * 4096 + c0 + bj * 128 + 4 * n);
#pragma unroll
        for (int ai = 0; ai < 2; ++ai)
#pragma unroll
            for (int m = 0; m < 4; ++m) { const size_t row = (size_t)u.pm * 256 + ai * 128 + wr * 64 + m * 16 + fr;
#pragma unroll
                for (int bj = 0; bj < 2; ++bj) { const f32x4 v0 = acc[ai][bj][m][0] * (1.0f / W8SCALE) + bv[bj][0], v1 = acc[ai][bj][m][1] * (1.0f / W8SCALE) + bv[bj][1]; float a[4];
#pragma unroll
                    for (int j = 0; j < 4; ++j) { const float gl = fminf(j < 2 ? v0[2 * j] : v1[2 * j - 4], 7.0f); const float ln = fminf(fmaxf(j < 2 ? v0[2 * j + 1] : v1[2 * j - 3], -7.0f), 7.0f);
                        a[j] = gl * sigmoidf_(1.702f * gl) * (ln + 1.0f); }
                    *(unsigned*)(ACT + row * DEXP + ((c0 + bj * 128) >> 1)) = pk4_fp8(a[0], a[1], a[2], a[3]); } }
    }
};
struct EpiMoe2 {
    static constexpr bool PERM = true, TRANS = true, FP8 = true;
    const float* BD; const float* GATE; const int* LIST; unsigned char* YS; volatile LAS int* tb;
    __device__ __forceinline__ void operator()(const f32x4 (&acc)[2][2][4][2], const pg8::Unit& u, int wr, int wc, int fr, int fq) const {
        const int c0 = u.pn * 256 + wc * 32 + 8 * fq; const int lbase = u.e * LISTCAP + (u.pm - tb[u.e]) * 256;
        f32x4 bv[2][2];
#pragma unroll
        for (int bj = 0; bj < 2; ++bj)
#pragma unroll
            for (int n = 0; n < 2; ++n) bv[bj][n] = *(const f32x4*)(BD + (size_t)u.e * D + c0 + bj * 128 + 4 * n);
        int slot[2][4]; float gt_[2][4];
#pragma unroll
        for (int ai = 0; ai < 2; ++ai)
#pragma unroll
            for (int m = 0; m < 4; ++m) { const int r = ai * 128 + wr * 64 + m * 16 + fr; slot[ai][m] = LIST[lbase + (r < u.valid ? r : u.valid - 1)]; }
#pragma unroll
        for (int ai = 0; ai < 2; ++ai)
#pragma unroll
            for (int m = 0; m < 4; ++m) gt_[ai][m] = GATE[slot[ai][m]] * Y8SCALE;
#pragma unroll
        for (int ai = 0; ai < 2; ++ai)
#pragma unroll
            for (int m = 0; m < 4; ++m) { const int r = ai * 128 + wr * 64 + m * 16 + fr; const float gt = gt_[ai][m];
                const long long ro = (r < u.valid) ? (long long)slot[ai][m] * D : YS_DUMP_OFF;
#pragma unroll
                for (int bj = 0; bj < 2; ++bj) { const f32x4 v0 = (acc[ai][bj][m][0] * (1.0f / W8SCALE) + bv[bj][0]) * gt, v1 = (acc[ai][bj][m][1] * (1.0f / W8SCALE) + bv[bj][1]) * gt;
                    *(u32x2*)(YS + ro + c0 + bj * 128) = (u32x2){pk4_fp8(v0[0], v0[1], v0[2], v0[3]), pk4_fp8(v1[0], v1[1], v1[2], v1[3])}; } }
    }
};
__device__ __forceinline__ void p13_final(Frame& F) {
    const int gw = F.bx * NWAVES + F.wave, NGW = F.G * NWAVES, lane = F.lane;
    const float* MOD = (const float*)(F.ws + WS_MOD); const float* fg = F.in[IN_FG]; const unsigned char* YS = (const unsigned char*)(F.ws + WS_YS); float* O = F.out;
    f32x4 g2v[8]; int curb = -1;
    for (int m0 = 2 * gw; m0 < NTOK; m0 += 2 * NGW) {
        const int b = m0 >> 14;
        if (b != curb) { curb = b;
#pragma unroll
            for (int j = 0; j < 8; ++j) g2v[j] = *(const f32x4*)(MOD + b * 12288 + 5 * 2048 + 4 * lane + 256 * j) * (1.0f / Y8SCALE); }
        unsigned yv[2][8][4]; u32x2 hv[2][8]; f32x4 fgv[8];
#pragma unroll
        for (int rr = 0; rr < 2; ++rr) { const int m = m0 + rr; const bf16* hr = (const bf16*)(F.ws + WS_H1) + (size_t)m * D;
#pragma unroll
            for (int j = 0; j < 8; ++j) { const int k = 4 * lane + 256 * j;
#pragma unroll
                for (int q = 0; q < 4; ++q) yv[rr][j][q] = *(const GAS unsigned*)(YS + (size_t)(m * 4 + q) * D + k);
                hv[rr][j] = *(const GAS u32x2*)(hr + k); } }
#pragma unroll
        for (int j = 0; j < 8; ++j) fgv[j] = *(const f32x4*)(fg + 4 * lane + 256 * j);
        f32x4 h[2][8]; float rstd[2];
#pragma unroll
        for (int rr = 0; rr < 2; ++rr) { float s = 0.f;
#pragma unroll
            for (int j = 0; j < 8; ++j) { f32x4 a = (f32x4){0.f, 0.f, 0.f, 0.f};
#pragma unroll
                for (int q = 0; q < 4; ++q) { const unsigned y = yv[rr][j][q]; const f32x2 lo = __builtin_amdgcn_cvt_pk_f32_fp8((int)y, false), hi = __builtin_amdgcn_cvt_pk_f32_fp8((int)y, true); a += (f32x4){lo.x, lo.y, hi.x, hi.y}; }
                const u32x2 hb = hv[rr][j]; h[rr][j] = (f32x4){bflo(hb.x), bfhi(hb.x), bflo(hb.y), bfhi(hb.y)} + g2v[j] * a; s += (h[rr][j].x * h[rr][j].x + h[rr][j].y * h[rr][j].y) + (h[rr][j].z * h[rr][j].z + h[rr][j].w * h[rr][j].w); }
            rstd[rr] = 1.0f / sqrtf(wave_sum(s) * (1.0f / D) + 1e-6f); }
#pragma unroll
        for (int rr = 0; rr < 2; ++rr) { float* xr = O + (size_t)(m0 + rr) * D;
#pragma unroll
            for (int j = 0; j < 8; ++j) { const int k = 4 * lane + 256 * j; *(GAS f32x4*)(xr + k) = h[rr][j] * rstd[rr] * fgv[j]; } }
    }
}

__global__ void __launch_bounds__(NTHR, 2) fwd(Args args) {
    extern __shared__ __attribute__((aligned(16))) unsigned char lds_raw[];
    Frame F;
    F.lds = (LAS unsigned char*)lds_raw;
    F.tid = threadIdx.x; F.lane = F.tid & 63; F.wave = __builtin_amdgcn_readfirstlane(F.tid >> 6);
    F.G = gridDim.x; F.bx = blockIdx.x; F.in = args.in; F.out = args.out; F.ws = args.ws; F.ctl = (GAS unsigned*)(args.ws + WS_CTL);
    for (int u = F.tid; u < (LDS_BYTES - MISC_OFF) / 4; u += NTHR) ((LAS unsigned*)(F.lds + MISC_OFF))[u] = 0u;
    __syncthreads();
    const int lo = args.ph_lo, hi = args.ph_hi;
    XcdBarrier bar; bar.bar = (unsigned*)(F.ctl + CW_BAR); bar.x = 0; bar.st = nullptr;
    if (hi - lo > 1) bar = xcd_barrier_post((unsigned*)(F.ctl + CW_BAR), (volatile LAS unsigned*)(F.lds + MISC_OFF));
#ifndef PH_MASK
#define PH_MASK 0xffff
#endif
#define IN(k) (((PH_MASK >> (k)) & 1) && lo <= (k) && (k) < hi)
#define SEAM(k) do { if (IN(k) && IN((k) + 1)) xcd_barrier(bar); } while (0)
    unsigned char* ws = args.ws;
#ifndef PROBE_DUP
#define PROBE_DUP 0
#endif
#define DUPBAR(k) if ((PROBE_DUP >> (k)) & 1) xcd_barrier(bar)
#define DUP2(k, body) do { body; if ((PROBE_DUP >> (k)) & 1) { xcd_barrier(bar); body; } } while (0)
    if (IN(0)) { DUP2(0, p0_prologue(F)); } SEAM(0);
    if (IN(1)) { DUP2(1, p1_norm(F)); } SEAM(1);
    if (IN(2)) { {
        const int GW = (F.G == 256) ? 192 : F.G; const int nr = ((PROBE_DUP >> 2) & 1) ? 2 : 1;
        if (F.bx < GW) {
            const int r1 = (128 * 4 + 8) % GW, r2 = (r1 + 128 * 16) % GW; const int c1 = F.bx, c2 = (F.bx - r1 + GW) % GW, c3 = (F.bx - r2 + GW) % GW;
            { SchedIn S{GW, c1, 128 * 4, 4, 0, nr, (const char*)(ws + WS_U), (const char*)(ws + WS_WIN)}; EpiInA E{ws};
              pg8::gemm_phase<EpiInA, SchedIn>(F.lds, D, S, E); }
            { SchedIn S{GW, c2, 128 * 16, 16, 2, nr, (const char*)(ws + WS_U8), (const char*)(ws + WS_WIN8)}; EpiInG8 E{(unsigned char*)(ws + WS_UG)};
              pg8::gemm_phase<EpiInG8, SchedIn>(F.lds, D, S, E); }
            { SchedIn S{GW, c3, 128 * 12, 12, 1, nr, (const char*)(ws + WS_U), (const char*)(ws + WS_WIN)}; EpiInH E{(bf16*)(ws + WS_UH)};
              pg8::gemm_phase<EpiInH, SchedIn>(F.lds, D, S, E); }
        }
        moe_weight_queue(F);
        }
    } SEAM(2);
    if (IN(3)) { DUP2(3, s5_pass3<false>(F)); p3_publish(F); }
    if (IN(4)) { int q4w = CW_Q4; DUP2(4, (p4_hyena_carry(F, q4w), q4w += 16)); } SEAM(4);
    if (IN(5)) { DUP2(5, s5_pass3<true>(F)); __syncthreads(); DUP2(14, yh_transpose(F)); } SEAM(5);
    if (IN(6)) { { SchedStd S{F.G, F.bx, 4, 1024, ((PROBE_DUP >> 6) & 1) ? 2 : 1, (const char*)(ws + WS_Y), (const char*)(ws + WS_WGLU)}; EpiMix<0> E{(const bf16*)(ws + WS_Y), nullptr, (bf16*)(ws + WS_YA)};
        pg8::gemm_phase<EpiMix<0>, SchedStd>(F.lds, 1024, S, E); } } SEAM(6);
    if (IN(7)) { { SchedStd S{F.G, F.bx, 8, 1024, ((PROBE_DUP >> 7) & 1) ? 2 : 1, (const char*)(ws + WS_YA), (const char*)(ws + WS_WBS5)}; EpiMix<1> E{(const bf16*)(ws + WS_UG), nullptr, (bf16*)(ws + WS_T1)};
        pg8::gemm_phase<EpiMix<1>, SchedStd>(F.lds, 1024, S, E); } }
    if (!(IN(7) && IN(8))) { SEAM(7); }
    if (IN(8)) { { SchedStd S{F.G, F.bx, 8, 1024, ((PROBE_DUP >> 8) & 1) ? 2 : 1, (const char*)(ws + WS_YH), (const char*)(ws + WS_WBHY)}; EpiMix<2> E{(const bf16*)(ws + WS_UG), (const bf16*)(ws + WS_T1), (bf16*)(ws + WS_T)};
        pg8::gemm_phase<EpiMix<2>, SchedStd>(F.lds, 1024, S, E); } } SEAM(8);
    if (IN(9)) { { SchedStd S{F.G, F.bx, 8, 2048, ((PROBE_DUP >> 9) & 1) ? 2 : 1, (const char*)(ws + WS_T), (const char*)(ws + WS_WO), 1}; EpiOut E{F.in[IN_X], (const float*)(ws + WS_MOD), (bf16*)(ws + WS_H1)};
        pg8::gemm_phase<EpiOut, SchedStd>(F.lds, 2048, S, E); } } SEAM(9);
    if (IN(10)) { p10_router(F); } SEAM(10);
    if (IN(11)) { { moe_tables(F); volatile LAS int* tb = (volatile LAS int*)(F.lds + LDS_X);
        SchedMoe<true> S{F.G, F.bx, 16, 4096, 2048, ((PROBE_DUP >> 11) & 1) ? 2 : 1, (const char*)(ws + WS_HM8), (const char*)(ws + WS_WGU), (const int*)(ws + WS_LIST), tb}; EpiMoe1 E{F.in[IN_BGU], (unsigned char*)(ws + WS_ACT)};
        pg8::gemm_phase<EpiMoe1, SchedMoe<true>>(F.lds, 2048, S, E); } } SEAM(11);
    if (IN(12)) { { moe_tables(F); volatile LAS int* tb = (volatile LAS int*)(F.lds + LDS_X);
        SchedMoe<false> S{F.G, F.bx, 8, 2048, 2048, ((PROBE_DUP >> 12) & 1) ? 2 : 1, (const char*)(ws + WS_ACT), (const char*)(ws + WS_WDN), (const int*)(ws + WS_LIST), tb}; EpiMoe2 E{F.in[IN_BDN], (const float*)(ws + WS_GATE), (const int*)(ws + WS_LIST), (unsigned char*)(ws + WS_YS), tb};
        pg8::gemm_phase<EpiMoe2, SchedMoe<false>>(F.lds, 2048, S, E); } } SEAM(12);
    if (IN(13)) { DUP2(13, p13_final(F)); }
#undef IN
#undef SEAM
}

extern "C" void kernel_launch(void* const* d_in, const int* in_sizes, int n_in, void* d_out, int out_size, void* d_ws, size_t ws_size, hipStream_t stream) {
    static int grid = 0;
    if (grid == 0) {
        if (n_in != 39 || out_size != NTOK * D || ws_size < WS_END) { fprintf(stderr, "kernel_launch: unexpected shapes: n_in %d out %d ws %zu (need %zu)\n", n_in, out_size, ws_size, (size_t)WS_END); grid = -1; return; }
        int dev = 0, cus = 0, per_cu = 0;
        if (hipGetDevice(&dev) != hipSuccess || hipDeviceGetAttribute(&cus, hipDeviceAttributeMultiprocessorCount, dev) != hipSuccess) { grid = -1; return; }
        if (hipFuncSetAttribute((const void*)fwd, hipFuncAttributeMaxDynamicSharedMemorySize, LDS_BYTES) != hipSuccess) { fprintf(stderr, "kernel_launch: hipFuncSetAttribute failed\n"); grid = -1; return; }
        if (hipOccupancyMaxActiveBlocksPerMultiprocessor(&per_cu, (const void*)fwd, NTHR, LDS_BYTES) != hipSuccess || per_cu < 1) fprintf(stderr, "kernel_launch: occupancy query says %d\n", per_cu);
        (void)hipGetLastError();
        grid = cus;
    }
    if (grid < 0) return;
    if (hipMemsetAsync((char*)d_ws + WS_CTL, 0, CTL_ZERO_BYTES, stream) != hipSuccess) return;
    Args a{};
    for (int i = 0; i < 39; ++i) a.in[i] = (const float*)d_in[i];
    a.out = (float*)d_out; a.ws = (unsigned char*)d_ws;
#ifndef ONE_LAUNCH
#define ONE_LAUNCH 1
#endif
    if (ONE_LAUNCH) { a.ph_lo = 0; a.ph_hi = NPHASE; hipLaunchKernelGGL(fwd, dim3(grid), dim3(NTHR), LDS_BYTES, stream, a); }
    else for (int p = 0; p < NPHASE; ++p) { a.ph_lo = p; a.ph_hi = p + 1; hipLaunchKernelGGL(fwd, dim3(grid), dim3(NTHR), LDS_BYTES, stream, a); }
}
```

```cpp
#include <hip/hip_runtime.h>
#include <cstdio>
#include <cstdint>

#define GAS __attribute__((address_space(1)))
#define LAS __attribute__((address_space(3)))
typedef unsigned short bf16;
typedef short bf16x8 __attribute__((ext_vector_type(8)));
typedef float f32x4 __attribute__((ext_vector_type(4)));
typedef float f32x16 __attribute__((ext_vector_type(16)));
typedef float f32x2 __attribute__((ext_vector_type(2)));
typedef unsigned u32x4 __attribute__((ext_vector_type(4)));
typedef unsigned u32x2 __attribute__((ext_vector_type(2)));
typedef int i32x4 __attribute__((ext_vector_type(4)));
typedef int i32x8 __attribute__((ext_vector_type(8)));

constexpr int D = 2048, NB = 2, SEQ = 16384, NTOK = NB * SEQ, CTX = 256, NCTX = NB * CTX;
constexpr int S5W = 1024, HYW = 1024, INC = 8192, NEXP = 32, TOPK = 4, DEXP = 2048;
constexpr int NCH = 260;
constexpr int LISTCAP = 32768;

constexpr size_t MiB = 1u << 20;
constexpr size_t WS_CTL = 0, CTL_ZERO_BYTES = 1 * MiB;
constexpr size_t WS_MOD = 6 * MiB;
constexpr size_t WS_BBT = 7 * MiB;
constexpr size_t WS_CTT = WS_BBT + 512 * 1024;
constexpr size_t WS_LAM = 8 * MiB;
constexpr size_t WS_RWT = 8 * MiB + 256 * 1024;
constexpr size_t WS_BB2 = 8 * MiB + 512 * 1024;
constexpr size_t WS_WIN = 16 * MiB;
constexpr size_t WS_WGLU = 48 * MiB;
constexpr size_t WS_WBS5 = 50 * MiB;
constexpr size_t WS_WBHY = 54 * MiB;
constexpr size_t WS_WO = 58 * MiB;
constexpr size_t WS_WGU = 66 * MiB;
constexpr size_t WS_WDN = 578 * MiB;
constexpr size_t WS_U = 834 * MiB;
constexpr size_t WS_UCA = 964 * MiB;
constexpr size_t WS_UA = 966 * MiB;
constexpr size_t WS_UH = 1030 * MiB;
constexpr size_t WS_UG = 1222 * MiB;
constexpr size_t WS_E = 1478 * MiB;
constexpr size_t WS_SIN = 1511 * MiB;
constexpr size_t WS_FILT = 1544 * MiB;
constexpr size_t WS_HYS = 1800 * MiB;
constexpr size_t HYS_STRIDE = 768 * 1024;
constexpr size_t WS_YHCM = 1992 * MiB;
constexpr size_t WS_YH = 2056 * MiB;
constexpr size_t WS_Y = 2120 * MiB;
constexpr size_t WS_YA = 2184 * MiB;
constexpr size_t WS_T1 = 2248 * MiB;
constexpr size_t WS_T = 2376 * MiB;
constexpr size_t WS_HM = 2504 * MiB;
constexpr size_t WS_GATE = 2632 * MiB;
constexpr size_t WS_LIST = 2633 * MiB;
constexpr size_t WS_ACT = 2638 * MiB;
constexpr size_t WS_YS = 3182 * MiB;
constexpr size_t WS_H1 = 3694 * MiB;
constexpr size_t WS_HM8 = WS_T1;
constexpr size_t WS_U8 = WS_ACT;
constexpr size_t WS_WIN8 = WS_YS;
constexpr size_t WS_END = 3950 * MiB;
constexpr long long YS_DUMP_OFF = (long long)(2 * MiB) - (long long)WS_YS;

constexpr int CW_TMO = 0;
constexpr int CW_Q4 = 64;
constexpr int CW_P3 = 112;
constexpr int CW_QT = 96;
constexpr int CW_CNT = 128;
constexpr int CW_BAR = 4096;

constexpr int RING_BYTES = 131072;
constexpr int LDS_X = 131072;
constexpr int MISC_OFF = 147456 - 512;
constexpr int LDS_BYTES = 147456;
constexpr int NWAVES = 8, NTHR = 512;
constexpr int NPHASE = 14;

__device__ __forceinline__ unsigned f2bf(float f) { unsigned u = __builtin_bit_cast(unsigned, f); return (u + 0x7fffu + ((u >> 16) & 1u)) >> 16; }
__device__ __forceinline__ unsigned pk2(float lo, float hi) { return f2bf(lo) | (f2bf(hi) << 16); }
__device__ __forceinline__ float bf2f(unsigned short b) { return __builtin_bit_cast(float, ((unsigned)b) << 16); }
__device__ __forceinline__ float bflo(unsigned w) { return __builtin_bit_cast(float, w << 16); }
__device__ __forceinline__ float bfhi(unsigned w) { return __builtin_bit_cast(float, w & 0xffff0000u); }
typedef __bf16 bf16x2_t __attribute__((ext_vector_type(2)));
__device__ __forceinline__ unsigned cvt_pk_bf16(float lo, float hi) { const f32x2 v = {lo, hi}; const bf16x2_t b = __builtin_convertvector(v, bf16x2_t); return __builtin_bit_cast(unsigned, b); }
__device__ __forceinline__ unsigned pk4_fp8(float a, float b, float c, float d) { unsigned w = 0u; w = (unsigned)__builtin_amdgcn_cvt_pk_fp8_f32(a, b, (int)w, false); w = (unsigned)__builtin_amdgcn_cvt_pk_fp8_f32(c, d, (int)w, true); return w; }
constexpr float Y8SCALE = 8.0f;
constexpr float T8SCALE = 16.0f;
constexpr float W8SCALE = 64.0f;
__device__ __forceinline__ float sigmoidf_(float x) { return __builtin_amdgcn_rcpf(1.0f + __expf(-x)); }
__device__ __forceinline__ float sin_rev(float r) { return __builtin_amdgcn_sinf(__builtin_amdgcn_fractf(r)); }
__device__ __forceinline__ float cos_rev(float r) { return __builtin_amdgcn_cosf(__builtin_amdgcn_fractf(r)); }
__device__ __forceinline__ float wave_sum(float v) {
#pragma unroll
    for (int o = 1; o < 64; o <<= 1) v += __shfl_xor(v, o);
    return v;
}
__device__ __forceinline__ float wave_max(float v) {
#pragma unroll
    for (int o = 1; o < 64; o <<= 1) v = fmaxf(v, __shfl_xor(v, o));
    return v;
}
__device__ __forceinline__ f32x2 cmul(f32x2 a, f32x2 b) { return (f32x2){a.x * b.x - a.y * b.y, a.x * b.y + a.y * b.x}; }
#define LDS_WAIT() asm volatile("s_waitcnt lgkmcnt(0)" ::: "memory")
#define VM_WAIT() asm volatile("s_waitcnt vmcnt(0)" ::: "memory")

namespace pg8 {
constexpr int BM = 256, BK = 64, HALF = 128, HTB = HALF * BK * 2, STAGE_BYTES = 8 * HTB;
__host__ __device__ __forceinline__ int lds_byte(int r, int c) { const int st = (r >> 4) * 2 + (c >> 5), rr = r & 15, cc = c & 31, ob = rr * 64 + cc * 2; return st * 1024 + (ob ^ (((ob >> 9) & 1) << 5)); }
__host__ __device__ __forceinline__ void stage_rc(int b, int& R, int& C) { const int st = b / 1024, sb = b % 1024, swz = sb ^ (((sb >> 9) & 1) << 5); R = (st >> 1) * 16 + swz / 64; C = (st & 1) * 32 + (swz % 64) / 2; }
__host__ __device__ __forceinline__ int perm32(int rho) { const int n = rho >> 4, i = rho & 15; return 8 * (i >> 2) + 4 * n + (i & 3); }

struct Unit { int pm, pn, e, valid; };

template <class Epi, class Sched>
__device__ __forceinline__ void gemm_phase(LAS unsigned char* lds, const int Kel, const Sched& S, const Epi& E) {
    const int tid = threadIdx.x, wid = __builtin_amdgcn_readfirstlane(tid >> 6), lane = tid & 63, wr = wid >> 2, wc = wid & 3, fr = lane & 15, fq = lane >> 4;
    const int K = Epi::FP8 ? (Kel >> 1) : Kel;
    const int nt = K / BK;
    int Rs[2], Cs[2]; unsigned voffB[2];
#pragma unroll
    for (int i = 0; i < 2; ++i) { int R, C; stage_rc(tid * 16 + i * 8192, R, C); Rs[i] = R; Cs[i] = C; const int Rb = Epi::PERM ? ((R & ~31) + perm32(R & 31)) : R; voffB[i] = (unsigned)(Rb * K + C) * 2u; }
    const size_t kstep = (size_t)(BK * 2);
    const size_t hstep = (size_t)HALF * K * 2;
    const unsigned ldsw = (unsigned)wid * 1024u;
    const int aoff = lds_byte(wr * 64 + fr, fq * 8), boff = lds_byte(wc * 32 + fr, fq * 8);
    const int aoff8 = lds_byte(wr * 64 + fr, fq * 16), boff8 = lds_byte(wc * 32 + fr, fq * 16);
#define PG8_SA(b, h) (((b) * 2 + (h)) * HTB)
#define PG8_SB(b, h) ((4 + (b) * 2 + (h)) * HTB)
#define PG8_STAGE(bufoff, gbase, voff) do { _Pragma("unroll") for (int _i = 0; _i < 2; ++_i) \
        __builtin_amdgcn_global_load_lds((const unsigned*)((const char*)(gbase) + (voff)[_i]), (LAS unsigned*)(lds + (bufoff) + ldsw + _i * 8192), 16, 0, 0); } while (0)
#define PG8_LDA(dst, b, h) do { if constexpr (Epi::FP8) { _Pragma("unroll") for (int m = 0; m < 4; ++m) { const i32x4 lo_ = *(const LAS i32x4*)(lds + PG8_SA(b, h) + aoff8 + m * 2048), hi_ = *(const LAS i32x4*)(lds + PG8_SA(b, h) + aoff8 + m * 2048 + 16); dst##8[m] = __builtin_shufflevector(lo_, hi_, 0, 1, 2, 3, 4, 5, 6, 7); } } \
        else { _Pragma("unroll") for (int m = 0; m < 4; ++m) _Pragma("unroll") for (int k = 0; k < 2; ++k) dst[m][k] = *(const LAS bf16x8*)(lds + PG8_SA(b, h) + aoff + m * 2048 + k * 1024); } } while (0)
#define PG8_LDB(dst, b, h) do { if constexpr (Epi::FP8) { _Pragma("unroll") for (int n = 0; n < 2; ++n) { const i32x4 lo_ = *(const LAS i32x4*)(lds + PG8_SB(b, h) + boff8 + n * 2048), hi_ = *(const LAS i32x4*)(lds + PG8_SB(b, h) + boff8 + n * 2048 + 16); dst##8[n] = __builtin_shufflevector(lo_, hi_, 0, 1, 2, 3, 4, 5, 6, 7); } } \
        else { _Pragma("unroll") for (int n = 0; n < 2; ++n) _Pragma("unroll") for (int k = 0; k < 2; ++k) dst[n][k] = *(const LAS bf16x8*)(lds + PG8_SB(b, h) + boff + n * 2048 + k * 1024); } } while (0)
#define PG8_MMA(ai, bj, At, Bt) do { __builtin_amdgcn_s_setprio(1); \
        if constexpr (Epi::FP8) { _Pragma("unroll") for (int m = 0; m < 4; ++m) _Pragma("unroll") for (int n = 0; n < 2; ++n) \
            asm volatile("v_mfma_scale_f32_16x16x128_f8f6f4 %0, %1, %2, %0, %3, %3 op_sel_hi:[0,0,0]" : "+v"(acc[ai][bj][m][n]) : "v"(Bt##8[n]), "v"(At##8[m]), "v"(scl1)); } \
        else { _Pragma("unroll") for (int m = 0; m < 4; ++m) _Pragma("unroll") for (int n = 0; n < 2; ++n) _Pragma("unroll") for (int k = 0; k < 2; ++k) \
        acc[ai][bj][m][n] = Epi::TRANS ? __builtin_amdgcn_mfma_f32_16x16x32_bf16(Bt[n][k], At[m][k], acc[ai][bj][m][n], 0, 0, 0) \
                                       : __builtin_amdgcn_mfma_f32_16x16x32_bf16(At[m][k], Bt[n][k], acc[ai][bj][m][n], 0, 0, 0); } __builtin_amdgcn_s_setprio(0); } while (0)
#define PG8_WAIT_V(n) asm volatile("s_waitcnt vmcnt(" #n ")" ::: "memory")
#define PG8_WAIT_L(n) asm volatile("s_waitcnt lgkmcnt(" #n ")" ::: "memory")
#define PG8_BAR __builtin_amdgcn_s_barrier()
#define PG8_SCHED __builtin_amdgcn_sched_barrier(0)
    Unit cur, nxt; int ui = 0;
    if (!S.next(0, cur)) return;
    f32x4 acc[2][2][4][2];
#pragma unroll
    for (int a = 0; a < 2; ++a)
#pragma unroll
        for (int b = 0; b < 2; ++b)
#pragma unroll
            for (int m = 0; m < 4; ++m)
#pragma unroll
                for (int n = 0; n < 2; ++n) acc[a][b][m][n] = (f32x4){0.f, 0.f, 0.f, 0.f};
    bf16x8 At[4][2], B0[2][2], B1[2][2]; i32x8 At8[4], B08[2], B18[2]; const int scl1 = 0x7F7F7F7F;
    const char* const Ab = S.a_base();
    const char* cB = S.b_base(cur);
    unsigned vC0[2], vC1[2];
#pragma unroll
    for (int i = 0; i < 2; ++i) { vC0[i] = (S.a_row(cur, Rs[i]) * (unsigned)K + (unsigned)Cs[i]) * 2u; vC1[i] = (S.a_row(cur, HALF + Rs[i]) * (unsigned)K + (unsigned)Cs[i]) * 2u; }
    PG8_STAGE(PG8_SB(0, 0), cB, voffB); PG8_STAGE(PG8_SB(0, 1), cB + hstep, voffB); PG8_STAGE(PG8_SA(0, 0), Ab, vC0); PG8_STAGE(PG8_SA(0, 1), Ab, vC1);
    if (wr == 1) PG8_BAR;
    PG8_WAIT_V(2); PG8_BAR;
    PG8_STAGE(PG8_SB(1, 0), cB + kstep, voffB); PG8_STAGE(PG8_SA(1, 0), Ab + kstep, vC0); PG8_STAGE(PG8_SB(1, 1), cB + hstep + kstep, voffB);
    PG8_WAIT_V(6); PG8_BAR;
    for (;;) {
        const bool has_next = S.next(ui + 1, nxt);
        const char* nB = has_next ? S.b_base(nxt) : cB;
        for (int t = 0; t < nt; t += 2) {
            const bool last = (t == nt - 2);
            const char* a1 = Ab + (size_t)(t + 1) * kstep;
            const char* a2 = last ? Ab : Ab + (size_t)(t + 2) * kstep; const char* b2 = last ? nB : cB + (size_t)(t + 2) * kstep;
            const char* a3 = a2 + kstep; const char* b3 = b2 + kstep;
            unsigned vX0[2], vX1[2];
            if (last && has_next) {
#pragma unroll
                for (int i = 0; i < 2; ++i) { vX0[i] = (S.a_row(nxt, Rs[i]) * (unsigned)K + (unsigned)Cs[i]) * 2u; vX1[i] = (S.a_row(nxt, HALF + Rs[i]) * (unsigned)K + (unsigned)Cs[i]) * 2u; }
            } else {
#pragma unroll
                for (int i = 0; i < 2; ++i) { vX0[i] = vC0[i]; vX1[i] = vC1[i]; }
            }
            PG8_LDB(B0, 0, 0); PG8_LDB(B1, 0, 1); PG8_SCHED; PG8_LDA(At, 0, 0); PG8_STAGE(PG8_SA(1, 1), a1, vC1);
            PG8_WAIT_V(8); PG8_WAIT_L(0); PG8_BAR; PG8_MMA(0, 0, At, B0); PG8_MMA(0, 1, At, B1); PG8_BAR; PG8_SCHED;
            PG8_LDA(At, 0, 1); PG8_STAGE(PG8_SB(0, 0), b2, voffB); PG8_STAGE(PG8_SB(0, 1), b2 + hstep, voffB); PG8_STAGE(PG8_SA(0, 0), a2, vX0);
            PG8_WAIT_V(8); PG8_WAIT_L(0); PG8_BAR; PG8_MMA(1, 0, At, B0); PG8_MMA(1, 1, At, B1); PG8_BAR; PG8_SCHED;
            PG8_LDB(B0, 1, 0); PG8_LDB(B1, 1, 1); PG8_SCHED; PG8_LDA(At, 1, 0); PG8_STAGE(PG8_SA(0, 1), a2, vX1);
            PG8_WAIT_V(8); PG8_WAIT_L(0); PG8_BAR; PG8_MMA(0, 0, At, B0); PG8_MMA(0, 1, At, B1); PG8_BAR; PG8_SCHED;
            PG8_LDA(At, 1, 1); PG8_STAGE(PG8_SB(1, 0), b3, voffB); PG8_STAGE(PG8_SB(1, 1), b3 + hstep, voffB); PG8_STAGE(PG8_SA(1, 0), a3, vX0);
            PG8_WAIT_V(8); PG8_WAIT_L(0); PG8_BAR; PG8_MMA(1, 0, At, B0); PG8_MMA(1, 1, At, B1); PG8_BAR; PG8_SCHED;
            if (last) {
#pragma unroll
                for (int i = 0; i < 2; ++i) { vC0[i] = vX0[i]; vC1[i] = vX1[i]; }
            }
        }
        if (wr == 0) PG8_BAR;
        if constexpr (Epi::FP8) asm volatile("s_nop 15\n\ts_nop 15" ::: "memory");
        E(acc, cur, wr, wc, fr, fq);
        if (!has_next) break;
#pragma unroll
        for (int a = 0; a < 2; ++a)
#pragma unroll
            for (int b = 0; b < 2; ++b)
#pragma unroll
                for (int m = 0; m < 4; ++m)
#pragma unroll
                    for (int n = 0; n < 2; ++n) acc[a][b][m][n] = (f32x4){0.f, 0.f, 0.f, 0.f};
        cur = nxt; cB = nB; ++ui;
        if (wr == 1) PG8_BAR;
    }
    PG8_WAIT_V(0);
    PG8_BAR;
#undef PG8_SA
#undef PG8_SB
#undef PG8_STAGE
#undef PG8_LDA
#undef PG8_LDB
#undef PG8_MMA
#undef PG8_WAIT_V
#undef PG8_WAIT_L
#undef PG8_BAR
#undef PG8_SCHED
}
}

#define XB_TMO      128
#define XB_XCNT(j)  (256  + 64 * (j))
#define XB_XSUB(j)  (1280 + 64 * (j))
#define XB_XGEN(j)  (2304 + 64 * (j))
#define XB_TOP      3328
#define XB_TOPGEN   3392
#define XCD_BAR_WORDS 3456
#define XB_SPIN_CAP (1u << 22)
__device__ __forceinline__ unsigned xb_ld(unsigned* p)              { return __hip_atomic_load(p, __ATOMIC_RELAXED, __HIP_MEMORY_SCOPE_AGENT); }
__device__ __forceinline__ unsigned xb_add(unsigned* p, unsigned v) { return __hip_atomic_fetch_add(p, v, __ATOMIC_RELAXED, __HIP_MEMORY_SCOPE_AGENT); }
__device__ __forceinline__ unsigned xb_xcc_id() { return (unsigned)__builtin_amdgcn_s_getreg((3 << 11) | 20) & 0xFu; }
#define XB_SPIN(cond, bar) do { unsigned _sp = 0; while (cond) { __builtin_amdgcn_s_sleep(1); \
    if ((++_sp & 255u) == 0u) { if (xb_ld(&(bar)[XB_TMO])) break; if (_sp > XB_SPIN_CAP) { atomicAdd(&(bar)[XB_TMO], 1u); break; } } } } while (0)
struct XcdBarrier { unsigned* bar; unsigned x; volatile LAS unsigned* st; };
__device__ __forceinline__ XcdBarrier xcd_barrier_post(unsigned* bar, volatile LAS unsigned* st) {
    XcdBarrier b; b.bar = bar; b.x = xb_xcc_id(); b.st = st;
    if (threadIdx.x == 0) (void)xb_add(&bar[XB_XCNT(b.x)], 1u);
    return b;
}
__device__ __forceinline__ void xcd_barrier_complete(unsigned* bar, unsigned x, unsigned& nloc, unsigned& nx) {
    const unsigned G = gridDim.x * gridDim.y * gridDim.z;
    unsigned sum, cnt, mine, sp = 0u;
    for (;;) {
        sum = 0u; cnt = 0u; mine = 0u;
#pragma unroll
        for (unsigned j = 0; j < 16; ++j) { const unsigned c = xb_ld(&bar[XB_XCNT(j)]); sum += c; cnt += (c > 0u) ? 1u : 0u; mine = (j == x) ? c : mine; }
        if (sum == G) break;
        __builtin_amdgcn_s_sleep(1);
        if ((++sp & 255u) == 0u) { if (xb_ld(&bar[XB_TMO])) break; if (sp > XB_SPIN_CAP) { atomicAdd(&bar[XB_TMO], 1u); break; } }
    }
    nloc = mine > 0u ? mine : 1u; nx = cnt > 0u ? cnt : 1u;
}
__device__ __forceinline__ void xcd_barrier(const XcdBarrier& b) {
    asm volatile("s_waitcnt vmcnt(0)" ::: "memory");
    __syncthreads();
    if (threadIdx.x == 0) {
        unsigned* bar = b.bar;
        __builtin_amdgcn_s_waitcnt(0);
        unsigned nloc = b.st[0], nx = b.st[1];
        if (nloc == 0u) { xcd_barrier_complete(bar, b.x, nloc, nx); b.st[0] = nloc; b.st[1] = nx; }
        const unsigned old = xb_add(&bar[XB_XSUB(b.x)], 1u);
        const unsigned gen = old / nloc;
        if (old + 1u == (gen + 1u) * nloc) {
            __builtin_amdgcn_fence(__ATOMIC_RELEASE, "agent");
            asm volatile("s_waitcnt vmcnt(0)" ::: "memory");
            const unsigned og = xb_add(&bar[XB_TOP], 1u);
            const unsigned tg = og / nx;
            if (og + 1u == (tg + 1u) * nx) xb_add(&bar[XB_TOPGEN], 1u);
            else XB_SPIN(xb_ld(&bar[XB_TOPGEN]) == tg, bar);
            __builtin_amdgcn_fence(__ATOMIC_ACQUIRE, "agent");
            xb_add(&bar[XB_XGEN(b.x)], 1u);
            asm volatile("s_waitcnt vmcnt(0)" ::: "memory");
        } else {
            XB_SPIN(xb_ld(&bar[XB_XGEN(b.x)]) == gen, bar);
            __builtin_amdgcn_fence(__ATOMIC_ACQUIRE, "agent");
            asm volatile("s_waitcnt vmcnt(0)" ::: "memory");
        }
    }
    __syncthreads();
}

struct Args { const float* in[39]; float* out; unsigned char* ws; int ph_lo, ph_hi; };
struct Frame {
    LAS unsigned char* lds;
    int tid, lane, wave, G, bx;
    const float* const* in; float* out; unsigned char* ws;
    GAS unsigned* ctl;
};
#define IN_X 0
#define IN_C 1
#define IN_CTX 2
#define IN_CCTX 3
#define IN_WADA 4
#define IN_BADA 5
#define IN_N1G 6
#define IN_N2G 7
#define IN_WIN 8
#define IN_LRE 9
#define IN_LIM 10
#define IN_LDT 11
#define IN_BRE 12
#define IN_BIM 13
#define IN_CRE 14
#define IN_CIM 15
#define IN_S5D 16
#define IN_WGLU 17
#define IN_HSW 18
#define IN_HW1 19
#define IN_HB1 20
#define IN_HF1 21
#define IN_HW2 22
#define IN_HB2 23
#define IN_HF2 24
#define IN_HW3 25
#define IN_HB3 26
#define IN_HDEC 27
#define IN_HBIAS 28
#define IN_WBS5 29
#define IN_WBHY 30
#define IN_WO 31
#define IN_RW 32
#define IN_RB 33
#define IN_WGU 34
#define IN_BGU 35
#define IN_WDN 36
#define IN_BDN 37
#define IN_FG 38

__device__ __forceinline__ void p0_adaln_item(Frame& F, int cb) {
    LAS float* sl = (LAS float*)F.lds;
    const float* c = F.in[IN_C]; const float* cc = F.in[IN_CCTX]; const float* W = F.in[IN_WADA];
    for (int i = F.tid; i < 3 * 2048; i += NTHR) { const int v = i >> 11, k = i & 2047; const float cv = (v < 2) ? c[v * 2048 + k] : cc[k]; sl[i] = cv * sigmoidf_(cv); }
    __syncthreads();
    const int col = F.tid % 48, ks = F.tid / 48;
    float a0 = 0.f, a1 = 0.f, a2 = 0.f;
    if (ks < 10) { const float* wp = W + 48 * cb + col;
#pragma unroll 16
        for (int j = 0; j < 205; ++j) { const int k = ks + 10 * j; if (k < 2048) { const float w = wp[(size_t)k * 12288]; a0 += sl[k] * w; a1 += sl[2048 + k] * w; a2 += sl[4096 + k] * w; } } }
    LAS float* red = sl + 6144;
    if (ks < 10) { red[(ks * 48 + col) * 3 + 0] = a0; red[(ks * 48 + col) * 3 + 1] = a1; red[(ks * 48 + col) * 3 + 2] = a2; }
    __syncthreads();
    if (F.tid < 144) { const int v = F.tid / 48, cl = F.tid % 48; float sacc = 0.f;
#pragma unroll
        for (int q = 0; q < 10; ++q) sacc += red[(q * 48 + cl) * 3 + v];
        ((float*)(F.ws + WS_MOD))[v * 12288 + 48 * cb + cl] = sacc + F.in[IN_BADA][48 * cb + cl]; }
    __syncthreads();
}
__device__ __forceinline__ void p0_filt_item(Frame& F, int tb) {
    LAS float* ft = (LAS float*)F.lds;
    LAS float* h1 = ft + 64 * 36;
    LAS float* h2 = h1 + 64 * 65;
    const int t0 = tb * 64, tl = F.tid >> 3, q = F.tid & 7; const float tf = (float)(t0 + tl);
    for (int f = q; f < 33; f += 8) {
        float v;
        if (f == 0) v = tf * (1.0f / 16383.0f);
        else { const int bi = (f - 1) & 15; const float band = 1e-4f + (float)bi * ((15.0f - 1e-4f) / 15.0f); const float rev = tf * band * (1.0f / 16384.0f);
               v = (f <= 16) ? cos_rev(rev) : -sin_rev(rev); }
        ft[tl * 36 + f] = v;
    }
    LAS float* w1s = ft + 13312; LAS float* w2s = w1s + 33 * 64;
    for (int i = F.tid; i < 33 * 64; i += NTHR) w1s[i] = F.in[IN_HW1][i];
    for (int i = F.tid; i < 64 * 64; i += NTHR) w2s[i] = F.in[IN_HW2][i];
    __syncthreads();
    { const float* b1 = F.in[IN_HB1]; const float* f1 = F.in[IN_HF1]; float a[8];
#pragma unroll
      for (int jj = 0; jj < 8; ++jj) a[jj] = b1[q * 8 + jj];
#pragma unroll 11
      for (int f = 0; f < 33; ++f) { const float xv = ft[tl * 36 + f]; const f32x4 wa = *(const LAS f32x4*)(w1s + f * 64 + q * 8), wb = *(const LAS f32x4*)(w1s + f * 64 + q * 8 + 4);
          a[0] += xv * wa.x; a[1] += xv * wa.y; a[2] += xv * wa.z; a[3] += xv * wa.w; a[4] += xv * wb.x; a[5] += xv * wb.y; a[6] += xv * wb.z; a[7] += xv * wb.w; }
#pragma unroll
      for (int jj = 0; jj < 8; ++jj) { const int j = q * 8 + jj; h1[tl * 65 + j] = sin_rev(f1[j] * a[jj] * 0.15915494309189535f); } }
    __syncthreads();
    { const float* b2 = F.in[IN_HB2]; const float* f2 = F.in[IN_HF2]; float a[8];
#pragma unroll
      for (int jj = 0; jj < 8; ++jj) a[jj] = b2[q * 8 + jj];
#pragma unroll 16
      for (int i = 0; i < 64; ++i) { const float xv = h1[tl * 65 + i]; const f32x4 wa = *(const LAS f32x4*)(w2s + i * 64 + q * 8), wb = *(const LAS f32x4*)(w2s + i * 64 + q * 8 + 4);
          a[0] += xv * wa.x; a[1] += xv * wa.y; a[2] += xv * wa.z; a[3] += xv * wa.w; a[4] += xv * wb.x; a[5] += xv * wb.y; a[6] += xv * wb.z; a[7] += xv * wb.w; }
#pragma unroll
      for (int jj = 0; jj < 8; ++jj) { const int j = q * 8 + jj; h2[tl * 64 + j] = sin_rev(f2[j] * a[jj] * 0.15915494309189535f); } }
    __syncthreads();
    LAS unsigned short* hb = (LAS unsigned short*)(h2 + 64 * 64);
    for (int i = F.tid; i < 64 * 64; i += NTHR) hb[(i >> 6) * 72 + (i & 63)] = (unsigned short)f2bf(h2[i]);
    __syncthreads();
    const float* w3 = F.in[IN_HW3]; const float* b3 = F.in[IN_HB3]; const float* dec = F.in[IN_HDEC]; bf16* FILT = (bf16*)(F.ws + WS_FILT);
    const int fr = F.lane & 15, fq = F.lane >> 4;
    bf16x8 af[4][2];
#pragma unroll
    for (int m = 0; m < 4; ++m)
#pragma unroll
        for (int ks = 0; ks < 2; ++ks) af[m][ks] = *(const LAS bf16x8*)(hb + (16 * m + fr) * 72 + 32 * ks + 8 * fq);
#pragma unroll 4
    for (int jt = F.wave; jt < 256; jt += NWAVES) {
        const int j = 16 * jt + fr;
        bf16x8 bfr[2];
#pragma unroll
        for (int ks = 0; ks < 2; ++ks) { float w[8];
#pragma unroll
            for (int e = 0; e < 8; ++e) w[e] = w3[(size_t)(32 * ks + 8 * fq + e) * 4096 + j];
            u32x4 pk; pk.x = pk2(w[0], w[1]); pk.y = pk2(w[2], w[3]); pk.z = pk2(w[4], w[5]); pk.w = pk2(w[6], w[7]); bfr[ks] = __builtin_bit_cast(bf16x8, pk); }
        const float bb = b3[j], dd = fabsf(dec[j]) * (1.0f / 16383.0f);
#pragma unroll
        for (int m = 0; m < 4; ++m) { f32x4 acc = (f32x4){0.f, 0.f, 0.f, 0.f};
#pragma unroll
            for (int ks = 0; ks < 2; ++ks) acc = __builtin_amdgcn_mfma_f32_16x16x32_bf16(af[m][ks], bfr[ks], acc, 0, 0, 0);
            const int tb0 = t0 + 16 * m + 4 * fq; f32x4 o;
#pragma unroll
            for (int e = 0; e < 4; ++e) o[e] = (acc[e] + bb) * __expf(-(float)(tb0 + e) * dd);
            *(u32x2*)(FILT + (size_t)j * SEQ + tb0) = (u32x2){cvt_pk_bf16(o[0], o[1]), cvt_pk_bf16(o[2], o[3])}; }
    }
    __syncthreads();
}
__device__ __forceinline__ void p0_s5tab_item(Frame& F, int item) {
    const int idx = item * NTHR + F.tid; const int d = idx >> 12, g = (idx >> 6) & 63, p = idx & 63, dg = d * 64 + g;
    const float lr = F.in[IN_LRE][dg * 64 + p], li = F.in[IN_LIM][dg * 64 + p], dt = expf(F.in[IN_LDT][dg]);
    const float mag = expf(lr * dt), ang = li * dt; const float lbr = mag * cosf(ang), lbi = mag * sinf(ang);
    const float den = lr * lr + li * li, cr = ((lbr - 1.f) * lr + lbi * li) / den, ci = (lbi * lr - (lbr - 1.f) * li) / den;
    bf16* BBT = (bf16*)(F.ws + WS_BBT); bf16* BB2 = (bf16*)(F.ws + WS_BB2); bf16* CTT = (bf16*)(F.ws + WS_CTT); f32x2* LAM = (f32x2*)(F.ws + WS_LAM);
    const float* bre = F.in[IN_BRE] + (size_t)(dg * 64 + p) * 16; const float* bim = F.in[IN_BIM] + (size_t)(dg * 64 + p) * 16;
    for (int c = 0; c < 16; ++c) { const float br = bre[c], bi = bim[c];
        BBT[(size_t)(dg * 128 + p) * 16 + c] = (bf16)f2bf(cr * br - ci * bi); BBT[(size_t)(dg * 128 + 64 + p) * 16 + c] = (bf16)f2bf(cr * bi + ci * br);
        BB2[(size_t)(dg * 128 + 2 * p) * 16 + c] = (bf16)f2bf(cr * br - ci * bi); BB2[(size_t)(dg * 128 + 2 * p + 1) * 16 + c] = (bf16)f2bf(cr * bi + ci * br); }
    const int k = 2 * p;
    for (int c = 0; c < 16; ++c) { const float cre = F.in[IN_CRE][(size_t)(dg * 16 + c) * 64 + p], cim = F.in[IN_CIM][(size_t)(dg * 16 + c) * 64 + p];
        CTT[(size_t)(dg * 16 + c) * 128 + k] = (bf16)f2bf(cre); CTT[(size_t)(dg * 16 + c) * 128 + k + 1] = (bf16)f2bf(-cim); }
    LAM[dg * 64 + p] = (f32x2){lbr, lbi};
}
__device__ __forceinline__ void p0_transpose_item(const float* W, int K, int N, bf16* WT, LAS unsigned short* scr, int kb, int nb, int lane) {
    const int k0 = 64 * kb, n0 = 128 * nb;
    const float* wp = W + (size_t)(k0 + (lane >> 5)) * N + n0 + 4 * (lane & 31);
#pragma unroll
    for (int half = 0; half < 2; ++half) { f32x4 v[16];
#pragma unroll
        for (int i = 0; i < 16; ++i) v[i] = *(const GAS f32x4*)(wp + (size_t)(32 * half + 2 * i) * N);
#pragma unroll
        for (int i = 0; i < 16; ++i) { const int kk = 32 * half + 2 * i + (lane >> 5); LAS unsigned* d = (LAS unsigned*)(scr + kk * 130 + 4 * (lane & 31)); d[0] = pk2(v[i].x, v[i].y); d[1] = pk2(v[i].z, v[i].w); } }
    LDS_WAIT(); asm volatile("" ::: "memory");
    const int c = lane & 7;
#pragma unroll
    for (int j = 0; j < 16; ++j) { const int r = (lane >> 3) + 8 * j; const LAS unsigned short* sp = scr + (8 * c) * 130 + r;
        u32x4 o; o.x = (unsigned)sp[0] | ((unsigned)sp[130] << 16); o.y = (unsigned)sp[2 * 130] | ((unsigned)sp[3 * 130] << 16); o.z = (unsigned)sp[4 * 130] | ((unsigned)sp[5 * 130] << 16); o.w = (unsigned)sp[6 * 130] | ((unsigned)sp[7 * 130] << 16);
        *(GAS u32x4*)(WT + (size_t)(n0 + r) * K + k0 + 8 * c) = o; }
    LDS_WAIT(); asm volatile("" ::: "memory");
}
__device__ __forceinline__ void p0_transpose_item8(const float* W, int K, int N, unsigned char* WT, LAS unsigned short* scr, int kb, int nb, int lane) {
    const int k0 = 64 * kb, n0 = 128 * nb;
    const float* wp = W + (size_t)(k0 + (lane >> 5)) * N + n0 + 4 * (lane & 31);
#pragma unroll
    for (int half = 0; half < 2; ++half) { f32x4 v[16];
#pragma unroll
        for (int i = 0; i < 16; ++i) v[i] = *(const GAS f32x4*)(wp + (size_t)(32 * half + 2 * i) * N);
#pragma unroll
        for (int i = 0; i < 16; ++i) { const int kk = 32 * half + 2 * i + (lane >> 5); LAS unsigned* d = (LAS unsigned*)(scr + kk * 130 + 4 * (lane & 31)); d[0] = pk2(v[i].x, v[i].y); d[1] = pk2(v[i].z, v[i].w); } }
    LDS_WAIT(); asm volatile("" ::: "memory");
    const int c = lane & 7;
#pragma unroll
    for (int j = 0; j < 16; ++j) { const int r = (lane >> 3) + 8 * j; const LAS unsigned short* sp = scr + (8 * c) * 130 + r;
        u32x2 o; o.x = pk4_fp8(bf2f(sp[0]) * W8SCALE, bf2f(sp[130]) * W8SCALE, bf2f(sp[2 * 130]) * W8SCALE, bf2f(sp[3 * 130]) * W8SCALE);
        o.y = pk4_fp8(bf2f(sp[4 * 130]) * W8SCALE, bf2f(sp[5 * 130]) * W8SCALE, bf2f(sp[6 * 130]) * W8SCALE, bf2f(sp[7 * 130]) * W8SCALE);
        *(GAS u32x2*)(WT + (size_t)(n0 + r) * K + k0 + 8 * c) = o; }
    LDS_WAIT(); asm volatile("" ::: "memory");
}
__device__ __forceinline__ void p0_transpose_item8d(const float* W, int K, int N, unsigned char* WT, LAS unsigned short* scr, int kb, int nb, int lane) {
    const int k0 = 64 * kb, n0 = 128 * nb;
    const float* wp = W + (size_t)(k0 + (lane >> 5)) * N + n0 + 4 * (lane & 31);
    f32x4 v[32];
#pragma unroll
    for (int i = 0; i < 32; ++i) v[i] = *(const GAS f32x4*)(wp + (size_t)(2 * i) * N);
#pragma unroll
    for (int i = 0; i < 32; ++i) { const int kk = 2 * i + (lane >> 5); LAS unsigned* d = (LAS unsigned*)(scr + kk * 130 + 4 * (lane & 31)); d[0] = pk2(v[i].x, v[i].y); d[1] = pk2(v[i].z, v[i].w); }
    LDS_WAIT(); asm volatile("" ::: "memory");
    const int c = lane & 7;
#pragma unroll
    for (int j = 0; j < 16; ++j) { const int r = (lane >> 3) + 8 * j; const LAS unsigned short* sp = scr + (8 * c) * 130 + r;
        u32x2 o; o.x = pk4_fp8(bf2f(sp[0]) * W8SCALE, bf2f(sp[130]) * W8SCALE, bf2f(sp[2 * 130]) * W8SCALE, bf2f(sp[3 * 130]) * W8SCALE);
        o.y = pk4_fp8(bf2f(sp[4 * 130]) * W8SCALE, bf2f(sp[5 * 130]) * W8SCALE, bf2f(sp[6 * 130]) * W8SCALE, bf2f(sp[7 * 130]) * W8SCALE);
        *(GAS u32x2*)(WT + (size_t)(n0 + r) * K + k0 + 8 * c) = o; }
    LDS_WAIT(); asm volatile("" ::: "memory");
}
__device__ __forceinline__ void moe_weight_queue(Frame& F) {
    constexpr int W_GU1 = 32 * 32, W_DN1 = 16 * 32, W_GU = 32 * W_GU1, W_DN = 32 * W_DN1;
    LAS unsigned short* scr = (LAS unsigned short*)(F.lds + F.wave * 16640);
    const int lane = F.lane;
    __syncthreads();
    for (;;) {
        int r0 = 0;
        if (lane == 0) r0 = (int)__hip_atomic_fetch_add((unsigned*)(F.ctl + CW_QT), 4u, __ATOMIC_RELAXED, __HIP_MEMORY_SCOPE_AGENT);
        r0 = __builtin_amdgcn_readfirstlane(r0);
        if (r0 >= W_GU + W_DN) break;
#pragma unroll 1
        for (int sub = 0; sub < 4; ++sub) { const int r = r0 + sub;
            const float* W; unsigned char* WT; int N, kb, nb;
            if (r < W_GU) { const int e = r / W_GU1, q = r % W_GU1; W = F.in[IN_WGU] + (size_t)e * 2048 * 4096; WT = (unsigned char*)(F.ws + WS_WGU) + (size_t)e * 4096 * 2048; N = 4096; kb = q & 31; nb = q >> 5; }
            else { const int rr = r - W_GU; const int e = rr / W_DN1, q = rr % W_DN1; W = F.in[IN_WDN] + (size_t)e * 2048 * 2048; WT = (unsigned char*)(F.ws + WS_WDN) + (size_t)e * 2048 * 2048; N = 2048; kb = q & 31; nb = q >> 5; }
            const int K = 2048, k0 = 64 * kb, n0 = 128 * nb;
            const float* wp = W + (size_t)(k0 + (lane >> 5)) * N + n0 + 4 * (lane & 31);
            f32x4 v[32];
#pragma unroll
            for (int i = 0; i < 32; ++i) v[i] = __builtin_nontemporal_load((const GAS f32x4*)(wp + (size_t)(2 * i) * N));
            LAS unsigned char* sb = (LAS unsigned char*)scr;
#pragma unroll
            for (int i = 0; i < 32; ++i) { const int kk = 2 * i + (lane >> 5); *(LAS unsigned*)(sb + kk * 132 + 4 * (lane & 31)) = pk4_fp8(v[i].x * W8SCALE, v[i].y * W8SCALE, v[i].z * W8SCALE, v[i].w * W8SCALE); }
            LDS_WAIT(); asm volatile("" ::: "memory");
            const int c = lane & 7;
#pragma unroll
            for (int j = 0; j < 16; ++j) { const int rw = (lane >> 3) + 8 * j; const LAS unsigned char* sp = sb + (8 * c) * 132 + rw;
                u32x2 o; o.x = (unsigned)sp[0] | ((unsigned)sp[132] << 8) | ((unsigned)sp[2 * 132] << 16) | ((unsigned)sp[3 * 132] << 24);
                o.y = (unsigned)sp[4 * 132] | ((unsigned)sp[5 * 132] << 8) | ((unsigned)sp[6 * 132] << 16) | ((unsigned)sp[7 * 132] << 24);
                __builtin_nontemporal_store(o, (GAS u32x2*)(WT + (size_t)(n0 + rw) * K + k0 + 8 * c)); }
            LDS_WAIT(); asm volatile("" ::: "memory");
        }
    }
    __syncthreads();
}
__device__ __forceinline__ void p0_prologue(Frame& F) {
    for (int it = F.bx; it < 256; it += F.G) p0_adaln_item(F, it);
    for (int it = F.bx; it < 256; it += F.G) p0_filt_item(F, it);
    for (int it = F.bx; it < 16; it += F.G) p0_s5tab_item(F, it);
    { const float* rw = F.in[IN_RW]; float* RWT = (float*)(F.ws + WS_RWT);
      for (int i = F.bx * NTHR + F.tid; i < 32 * 2048; i += F.G * NTHR) { const int e = i >> 11, k = i & 2047; RWT[i] = rw[k * 32 + e]; } }
    __syncthreads();
    LAS unsigned short* scr = (LAS unsigned short*)(F.lds + F.wave * 16640);
    constexpr int I_IN = 64 * 4, I_GLU = 8 * 2, I_BS5 = 16 * 2, I_BHY = 16 * 2, I_O = 16 * 4;
    constexpr int NITEMS = I_IN + I_GLU + I_BS5 + I_BHY + I_O;
    const int w = F.wave;
    for (int it = F.bx; it < NITEMS; it += F.G) {
        int r = it;
        if (r < I_IN) { if ((r >> 2) < 32) p0_transpose_item(F.in[IN_WIN], 2048, 8192, (bf16*)(F.ws + WS_WIN), scr, 8 * (r & 3) + w, r >> 2, F.lane);
                        else p0_transpose_item8(F.in[IN_WIN], 2048, 8192, (unsigned char*)(F.ws + WS_WIN8) - (size_t)4096 * 2048, scr, 8 * (r & 3) + w, r >> 2, F.lane); continue; } r -= I_IN;
        if (r < I_GLU) { p0_transpose_item(F.in[IN_WGLU], 1024, 1024, (bf16*)(F.ws + WS_WGLU), scr, 8 * (r & 1) + w, r >> 1, F.lane); continue; } r -= I_GLU;
        if (r < I_BS5) { p0_transpose_item(F.in[IN_WBS5], 1024, 2048, (bf16*)(F.ws + WS_WBS5), scr, 8 * (r & 1) + w, r >> 1, F.lane); continue; } r -= I_BS5;
        if (r < I_BHY) { p0_transpose_item(F.in[IN_WBHY], 1024, 2048, (bf16*)(F.ws + WS_WBHY), scr, 8 * (r & 1) + w, r >> 1, F.lane); continue; } r -= I_BHY;
        { p0_transpose_item8(F.in[IN_WO], 2048, 2048, (unsigned char*)(F.ws + WS_WO), scr, 8 * (r & 3) + w, r >> 2, F.lane); }
    }
}

__device__ __forceinline__ void p1_norm(Frame& F) {
    const int gw = F.bx * NWAVES + F.wave, NGW = F.G * NWAVES;
    const float* MOD = (const float*)(F.ws + WS_MOD); const float* g1n = F.in[IN_N1G];
    bf16* U = (bf16*)(F.ws + WS_U);
    int curv = -1; f32x4 ga[8], sh[8];
    for (int m = gw; m < NTOK + NCTX; m += NGW) {
        const int v = (m < NTOK) ? (m >> 14) : 2;
        if (v != curv) { curv = v;
#pragma unroll
            for (int j = 0; j < 8; ++j) { const int k = 4 * F.lane + 256 * j; const f32x4 g = *(const f32x4*)(g1n + k), sc = *(const f32x4*)(MOD + v * 12288 + 2048 + k); ga[j] = g * (sc + 1.0f); sh[j] = *(const f32x4*)(MOD + v * 12288 + k); } }
        const float* xr = (m < NTOK) ? (F.in[IN_X] + (size_t)m * D) : (F.in[IN_CTX] + (size_t)(m - NTOK) * D);
        f32x4 x[8]; float s = 0.f;
#pragma unroll
        for (int j = 0; j < 8; ++j) { x[j] = *(const GAS f32x4*)(xr + 4 * F.lane + 256 * j); s += (x[j].x * x[j].x + x[j].y * x[j].y) + (x[j].z * x[j].z + x[j].w * x[j].w); }
        const float rstd = 1.0f / sqrtf(wave_sum(s) * (1.0f / D) + 1e-6f);
        GAS u32x2* o = (GAS u32x2*)(U + (size_t)m * D) + F.lane; GAS unsigned* o8 = (GAS unsigned*)(F.ws + WS_U8 + (size_t)m * D) + F.lane;
#pragma unroll
        for (int j = 0; j < 8; ++j) { const f32x4 y = x[j] * rstd * ga[j] + sh[j]; o[64 * j] = (u32x2){pk2(y.x, y.y), pk2(y.z, y.w)}; if (m < NTOK) o8[64 * j] = pk4_fp8(y.x, y.y, y.z, y.w); }
    }
}

struct SchedIn {
    int G, c, nmain, npn, mode, nrep;
    const char* A; const char* Bt;
    __device__ __forceinline__ bool next(int i, pg8::Unit& u) const {
        int L = i * G + c; u.e = 0; u.valid = 256; { const int tot = nmain + (mode == 0 ? 8 : 0); if (nrep > 1 && L >= tot && L < 2 * tot) L -= tot; }
        if (L < nmain) {
            int wgid = L; { const int q = nmain / 8, xcd = wgid % 8, off = wgid / 8; wgid = xcd * q + off; }
            const int nig = 8 * npn, gid = wgid / nig; const int pm = gid * 8 + ((wgid % nig) % 8), pl = (wgid % nig) / 8;
            u.pm = pm; u.pn = (mode == 0) ? pl : (mode == 1 ? pl + 4 : pl + 16); return true;
        }
        if (mode == 0 && L < nmain + 8) { const int q = L - nmain; u.pm = 128 + (q >> 2); u.pn = q & 3; return true; }
        return false;
    }
    __device__ __forceinline__ unsigned a_row(const pg8::Unit& u, int r) const { return (u.pm < 128) ? (unsigned)((u.pm >> 6) * SEQ + r * 64 + (u.pm & 63)) : (unsigned)(NTOK + (u.pm - 128) * 256 + r); }
    __device__ __forceinline__ const char* a_base() const { return A; }
    __device__ __forceinline__ const char* b_base(const pg8::Unit& u) const { return (mode == 2) ? Bt + (size_t)(u.pn - 16) * 256 * D : Bt + (size_t)u.pn * 256 * D * 2; }
};
__device__ __forceinline__ unsigned q8(float s) { return (unsigned)(s * 255.0f + 0.5f); }
struct EpiInG8 {
    static constexpr bool PERM = true, TRANS = true, FP8 = true;
    unsigned char* UG;
    __device__ __forceinline__ void operator()(const f32x4 (&acc)[2][2][4][2], const pg8::Unit& u, int wr, int wc, int fr, int fq) const {
        const int col0 = (u.pn - 16) * 256 + wc * 32 + 8 * fq;
#pragma unroll
        for (int ai = 0; ai < 2; ++ai)
#pragma unroll
            for (int m = 0; m < 4; ++m) { const int r = ai * 128 + wr * 64 + m * 16 + fr; const size_t row = (size_t)((u.pm >> 6) * SEQ + r * 64 + (u.pm & 63));
                unsigned char* rowp = UG + row * 4096 + col0;
#pragma unroll
                for (int bj = 0; bj < 2; ++bj) { f32x4 v0 = acc[ai][bj][m][0] * (1.0f / W8SCALE), v1 = acc[ai][bj][m][1] * (1.0f / W8SCALE);
#pragma unroll
                    for (int j = 0; j < 4; ++j) { v0[j] = sigmoidf_(v0[j]); v1[j] = sigmoidf_(v1[j]); }
                    u32x2 w; w.x = q8(v0[0]) | (q8(v0[1]) << 8) | (q8(v0[2]) << 16) | (q8(v0[3]) << 24); w.y = q8(v1[0]) | (q8(v1[1]) << 8) | (q8(v1[2]) << 16) | (q8(v1[3]) << 24);
                    *(u32x2*)(rowp + bj * 128) = w; } }
    }
};
struct EpiInA {
    static constexpr bool PERM = true, TRANS = true, FP8 = false;
    unsigned char* ws;
    __device__ __forceinline__ void operator()(const f32x4 (&acc)[2][2][4][2], const pg8::Unit& u, int wr, int wc, int fr, int fq) const {
        const bool isctx = u.pm >= 128, isg = u.pn >= 16;
        const size_t boff = isctx ? WS_UCA : (isg ? WS_UG : WS_UA);
        bf16* base = (bf16*)(ws + boff); const size_t ld = isg ? 4096 : S5W; const int colt = isg ? (u.pn - 16) * 256 : u.pn * 256;
        const int col0 = colt + wc * 32 + 8 * fq;
#pragma unroll
        for (int ai = 0; ai < 2; ++ai)
#pragma unroll
            for (int m = 0; m < 4; ++m) { const int r = ai * 128 + wr * 64 + m * 16 + fr;
                const size_t row = isctx ? (size_t)((u.pm - 128) * 256 + r) : (size_t)((u.pm >> 6) * SEQ + r * 64 + (u.pm & 63));
                bf16* rowp = base + row * ld + col0;
#pragma unroll
                for (int bj = 0; bj < 2; ++bj) { f32x4 v0 = acc[ai][bj][m][0], v1 = acc[ai][bj][m][1];
                    if (isg) {
#pragma unroll
                        for (int j = 0; j < 4; ++j) { v0[j] = sigmoidf_(v0[j]); v1[j] = sigmoidf_(v1[j]); } }
                    u32x4 w; w.x = cvt_pk_bf16(v0[0], v0[1]); w.y = cvt_pk_bf16(v0[2], v0[3]); w.z = cvt_pk_bf16(v1[0], v1[1]); w.w = cvt_pk_bf16(v1[2], v1[3]);
                    *(u32x4*)(rowp + bj * 128) = w; } }
    }
};
struct EpiInH {
    static constexpr bool PERM = false, TRANS = false, FP8 = false;
    bf16* UH;
    __device__ __forceinline__ void operator()(const f32x4 (&acc)[2][2][4][2], const pg8::Unit& u, int wr, int wc, int fr, int fq) const {
        const int b = u.pm >> 6, w = u.pm & 63;
#pragma unroll
        for (int bj = 0; bj < 2; ++bj)
#pragma unroll
            for (int n = 0; n < 2; ++n) { const int ch = (u.pn - 4) * 256 + bj * 128 + wc * 32 + n * 16 + fr;
                bf16* cp = UH + ((size_t)(b * 3072 + ch) * SEQ + w * 256);
#pragma unroll
                for (int ai = 0; ai < 2; ++ai)
#pragma unroll
                    for (int m = 0; m < 4; ++m) { const int r0 = ai * 128 + wr * 64 + m * 16 + 4 * fq; const f32x4 v = acc[ai][bj][m][n];
                        *(u32x2*)(cp + r0) = (u32x2){cvt_pk_bf16(v[0], v[1]), cvt_pk_bf16(v[2], v[3])}; } }
    }
};

template <bool PASSB>
__device__ __forceinline__ void s5_pass(Frame& F) {
    constexpr int nk = PASSB ? 256 : 260;
    constexpr int nitems = 2 * nk * 8;
    LAS unsigned char* sl = F.lds + F.wave * 8704;
    const int lane = F.lane, pl = lane & 31, hi = lane >> 5, fr = lane & 15, fq = lane >> 4;
    const bf16* UA = (const bf16*)(F.ws + WS_UA); const bf16* UCA = (const bf16*)(F.ws + WS_UCA);
    const bf16* BBT = (const bf16*)(F.ws + WS_BBT); const bf16* CTT = (const bf16*)(F.ws + WS_CTT); const f32x2* LAM = (const f32x2*)(F.ws + WS_LAM);
    f32x2* EB = (f32x2*)(F.ws + WS_E); const f32x2* SINB = (const f32x2*)(F.ws + WS_SIN); bf16* Y = (bf16*)(F.ws + WS_Y);
    const int s_r = 16 * ((pl >> 2) & 1) + 4 * (pl >> 3) + (pl & 3);
    for (int it = F.bx; it < nitems; it += F.G) {
        const int gq = it & 7, rest = it >> 3; const int b = rest / nk, kk = rest % nk; const int kc = PASSB ? kk + 4 : kk;
        const int g = gq * 8 + F.wave;
        const bf16* urow = (kc < 4) ? (UCA + (size_t)(b * CTX + kc * 64) * S5W + 16 * g) : (UA + (size_t)(b * SEQ + (kc - 4) * 64) * S5W + 16 * g);
        f32x4 yacc[4];
#pragma unroll
        for (int q = 0; q < 4; ++q) yacc[q] = (f32x4){0.f, 0.f, 0.f, 0.f};
#pragma unroll
        for (int d = 0; d < 2; ++d) {
            const int dg = d * 64 + g;
            bf16x8 bb[4];
#pragma unroll
            for (int ni = 0; ni < 4; ++ni) bb[ni] = *(const bf16x8*)(BBT + (size_t)(dg * 128 + 32 * ni + pl) * 16 + 8 * hi);
            bf16x8 ct[4];
            if (PASSB) {
#pragma unroll
                for (int ks = 0; ks < 4; ++ks) ct[ks] = *(const bf16x8*)(CTT + (size_t)(dg * 16 + fr) * 128 + 32 * ks + 8 * fq);
            }
            const f32x2 lamA = LAM[dg * 64 + pl], lamB = LAM[dg * 64 + pl + 32];
            f32x2 l2 = cmul(lamA, lamA), l4 = cmul(l2, l2), l8 = cmul(l4, l4); const f32x2 lam16A = cmul(l8, l8);
            l2 = cmul(lamB, lamB); l4 = cmul(l2, l2); l8 = cmul(l4, l4); const f32x2 lam16B = cmul(l8, l8);
            f32x2 cA = (f32x2){0.f, 0.f}, cB = (f32x2){0.f, 0.f};
            const size_t sidx = ((size_t)((d * 2 + b) * NCH + kc)) * 4096 + g * 64 + pl;
            if (PASSB) { cA = SINB[sidx]; cB = SINB[sidx + 32]; }
#pragma unroll
            for (int sc = 0; sc < 2; ++sc) {
                const int iscan = 32 * sc + s_r; const int tok = (d == 0) ? iscan : 63 - iscan;
                const bf16x8 a = *(const bf16x8*)(urow + (size_t)tok * S5W + 8 * hi);
                f32x16 acc[4];
#pragma unroll
                for (int ni = 0; ni < 4; ++ni) { f32x16 z;
#pragma unroll
                    for (int i = 0; i < 16; ++i) z[i] = 0.f;
                    acc[ni] = __builtin_amdgcn_mfma_f32_32x32x16_bf16(a, bb[ni], z, 0, 0, 0); }
                asm volatile("s_nop 7\n\ts_nop 7" : "+v"(acc[0]), "+v"(acc[1]), "+v"(acc[2]), "+v"(acc[3]) : "v"(a), "v"(bb[0]), "v"(bb[1]), "v"(bb[2]), "v"(bb[3]));
                f32x2 sA = hi ? (f32x2){0.f, 0.f} : cA, sB = hi ? (f32x2){0.f, 0.f} : cB;
#pragma unroll
                for (int i = 0; i < 16; ++i) {
                    sA = (f32x2){lamA.x * sA.x - lamA.y * sA.y + acc[0][i], lamA.x * sA.y + lamA.y * sA.x + acc[2][i]}; acc[0][i] = sA.x; acc[2][i] = sA.y;
                    sB = (f32x2){lamB.x * sB.x - lamB.y * sB.y + acc[1][i], lamB.x * sB.y + lamB.y * sB.x + acc[3][i]}; acc[1][i] = sB.x; acc[3][i] = sB.y; }
                const f32x2 pA = (f32x2){__shfl_xor(sA.x, 32), __shfl_xor(sA.y, 32)}, pB = (f32x2){__shfl_xor(sB.x, 32), __shfl_xor(sB.y, 32)};
                const f32x2 tA = cmul(lam16A, hi ? pA : sA), tB = cmul(lam16B, hi ? pB : sB);
                const f32x2 e1A = (hi ? sA : pA) + tA, e1B = (hi ? sB : pB) + tB;
                const f32x2 ciA = hi ? pA : (f32x2){0.f, 0.f}, ciB = hi ? pB : (f32x2){0.f, 0.f};
                if (PASSB) {
                    f32x2 wA = cmul(lamA, ciA), wB = cmul(lamB, ciB);
#pragma unroll
                    for (int i = 0; i < 16; ++i) {
                        acc[0][i] += wA.x; acc[2][i] += wA.y; acc[1][i] += wB.x; acc[3][i] += wB.y;
                        *(LAS u32x2*)(sl + (16 * hi + i) * 272 + pl * 8) = (u32x2){cvt_pk_bf16(acc[0][i], acc[2][i]), cvt_pk_bf16(acc[1][i], acc[3][i])};
                        wA = cmul(wA, lamA); wB = cmul(wB, lamB); }
                    bf16x8 bsv[2][4];
#pragma unroll
                    for (int tt = 0; tt < 2; ++tt) {
                        const int rowi = (d == 0) ? (16 * tt + fr) : (16 * tt + 15 - fr);
#pragma unroll
                        for (int ks = 0; ks < 4; ++ks) bsv[tt][ks] = *(const LAS bf16x8*)(sl + rowi * 272 + (32 * ks + 8 * fq) * 2);
                    }
#pragma unroll
                    for (int tt = 0; tt < 2; ++tt) {
                        const int tq = (d == 0) ? (2 * sc + tt) : (3 - 2 * sc - tt);
#pragma unroll
                        for (int ks = 0; ks < 4; ++ks) yacc[tq] = __builtin_amdgcn_mfma_f32_16x16x32_bf16(ct[ks], bsv[tt][ks], yacc[tq], 0, 0, 0);
                    }
                    asm volatile("s_nop 7\n\ts_nop 7" : "+v"(yacc[0]), "+v"(yacc[1]), "+v"(yacc[2]), "+v"(yacc[3]) : "v"(bsv[0][0]), "v"(bsv[0][1]), "v"(bsv[0][2]), "v"(bsv[0][3]), "v"(bsv[1][0]), "v"(bsv[1][1]), "v"(bsv[1][2]), "v"(bsv[1][3]), "v"(ct[0]), "v"(ct[1]), "v"(ct[2]), "v"(ct[3]));
                    asm volatile("s_waitcnt lgkmcnt(0)" ::: "memory");
                }
                cA = e1A; cB = e1B;
            }
            if (!PASSB) { if (hi == 0) { EB[sidx] = cA; EB[sidx + 32] = cB; } }
        }
        if (PASSB) {
            const f32x4 dsk = *(const f32x4*)(F.in[IN_S5D] + 16 * g + 4 * fq);
#pragma unroll
            for (int tq = 0; tq < 4; ++tq) { const int tok = 16 * tq + fr;
                const u32x2 uu = *(const u32x2*)(urow + (size_t)tok * S5W + 4 * fq);
                f32x4 v; v[0] = yacc[tq][0] + bflo(uu.x) * dsk[0]; v[1] = yacc[tq][1] + bfhi(uu.x) * dsk[1]; v[2] = yacc[tq][2] + bflo(uu.y) * dsk[2]; v[3] = yacc[tq][3] + bfhi(uu.y) * dsk[3];
#pragma unroll
                for (int j = 0; j < 4; ++j) { const float x = v[j]; v[j] = x * sigmoidf_(1.5957691216f * (x + 0.044715f * x * x * x)); }
                *(u32x2*)(Y + (size_t)(b * SEQ + (kc - 4) * 64 + tok) * S5W + 16 * g + 4 * fq) = (u32x2){cvt_pk_bf16(v[0], v[1]), cvt_pk_bf16(v[2], v[3])}; }
        }
    }
}
__device__ __forceinline__ void s5_pass_a_simple(Frame& F) {
    constexpr int nitems = 2 * NCH * 8;
    const int lane = F.lane;
    const bf16* UA = (const bf16*)(F.ws + WS_UA); const bf16* UCA = (const bf16*)(F.ws + WS_UCA);
    const bf16* BBT = (const bf16*)(F.ws + WS_BBT); const f32x2* LAM = (const f32x2*)(F.ws + WS_LAM); f32x2* EB = (f32x2*)(F.ws + WS_E);
    for (int it = F.bx; it < nitems; it += F.G) {
        const int gq = it & 7, rest = it >> 3; const int b = rest / NCH, kc = rest % NCH; const int g = gq * 8 + F.wave;
        const bf16* urow = (kc < 4) ? (UCA + (size_t)(b * CTX + kc * 64) * S5W + 16 * g) : (UA + (size_t)(b * SEQ + (kc - 4) * 64) * S5W + 16 * g);
#pragma unroll 1
        for (int d = 0; d < 2; ++d) {
            const int dg = d * 64 + g; const f32x2 lam = LAM[dg * 64 + lane];
            float bre[16], bim[16];
            { const u32x4 r0 = *(const u32x4*)(BBT + (size_t)(dg * 128 + lane) * 16), r1 = *(const u32x4*)(BBT + (size_t)(dg * 128 + lane) * 16 + 8);
              const u32x4 i0 = *(const u32x4*)(BBT + (size_t)(dg * 128 + 64 + lane) * 16), i1 = *(const u32x4*)(BBT + (size_t)(dg * 128 + 64 + lane) * 16 + 8);
              bre[0] = bflo(r0.x); bre[1] = bfhi(r0.x); bre[2] = bflo(r0.y); bre[3] = bfhi(r0.y); bre[4] = bflo(r0.z); bre[5] = bfhi(r0.z); bre[6] = bflo(r0.w); bre[7] = bfhi(r0.w);
              bre[8] = bflo(r1.x); bre[9] = bfhi(r1.x); bre[10] = bflo(r1.y); bre[11] = bfhi(r1.y); bre[12] = bflo(r1.z); bre[13] = bfhi(r1.z); bre[14] = bflo(r1.w); bre[15] = bfhi(r1.w);
              bim[0] = bflo(i0.x); bim[1] = bfhi(i0.x); bim[2] = bflo(i0.y); bim[3] = bfhi(i0.y); bim[4] = bflo(i0.z); bim[5] = bfhi(i0.z); bim[6] = bflo(i0.w); bim[7] = bfhi(i0.w);
              bim[8] = bflo(i1.x); bim[9] = bfhi(i1.x); bim[10] = bflo(i1.y); bim[11] = bfhi(i1.y); bim[12] = bflo(i1.z); bim[13] = bfhi(i1.z); bim[14] = bflo(i1.w); bim[15] = bfhi(i1.w); }
            f32x2 st = (f32x2){0.f, 0.f};
#pragma unroll 4
            for (int i = 0; i < 64; ++i) { const int tok = (d == 0) ? i : 63 - i;
                const u32x4 u0 = *(const u32x4*)(urow + (size_t)tok * S5W), u1 = *(const u32x4*)(urow + (size_t)tok * S5W + 8);
                float u[16]; u[0] = bflo(u0.x); u[1] = bfhi(u0.x); u[2] = bflo(u0.y); u[3] = bfhi(u0.y); u[4] = bflo(u0.z); u[5] = bfhi(u0.z); u[6] = bflo(u0.w); u[7] = bfhi(u0.w);
                u[8] = bflo(u1.x); u[9] = bfhi(u1.x); u[10] = bflo(u1.y); u[11] = bfhi(u1.y); u[12] = bflo(u1.z); u[13] = bfhi(u1.z); u[14] = bflo(u1.w); u[15] = bfhi(u1.w);
                float br = 0.f, bi = 0.f;
#pragma unroll
                for (int c = 0; c < 16; ++c) { br += bre[c] * u[c]; bi += bim[c] * u[c]; }
                st = (f32x2){lam.x * st.x - lam.y * st.y + br, lam.x * st.y + lam.y * st.x + bi}; }
            EB[((size_t)((d * 2 + b) * NCH + kc)) * 4096 + g * 64 + lane] = st;
        }
    }
}
__device__ __forceinline__ void s5_pass_b2(Frame& F) {
    constexpr int nitems = 2 * 256 * 8;
    LAS unsigned char* sl = F.lds + F.wave * 8704;
    const int lane = F.lane, fr = lane & 15, fq = lane >> 4;
    const bf16* UA = (const bf16*)(F.ws + WS_UA); const bf16* BBT = (const bf16*)(F.ws + WS_BBT); const bf16* CTT = (const bf16*)(F.ws + WS_CTT);
    const f32x2* LAM = (const f32x2*)(F.ws + WS_LAM); const f32x2* SINB = (const f32x2*)(F.ws + WS_SIN); bf16* Y = (bf16*)(F.ws + WS_Y);
    for (int it = F.bx; it < nitems; it += F.G) {
        const int gq = it & 7, rest = it >> 3; const int b = rest >> 8, kc = (rest & 255) + 4; const int g = gq * 8 + F.wave;
        const bf16* urow = UA + (size_t)(b * SEQ + (kc - 4) * 64) * S5W + 16 * g;
        f32x4 yacc[4];
#pragma unroll
        for (int q = 0; q < 4; ++q) yacc[q] = (f32x4){0.f, 0.f, 0.f, 0.f};
#pragma unroll
        for (int d = 0; d < 2; ++d) {
            const int dg = d * 64 + g; const f32x2 lam = LAM[dg * 64 + lane];
            float bre[16], bim[16];
            { const u32x4 r0 = *(const u32x4*)(BBT + (size_t)(dg * 128 + lane) * 16), r1 = *(const u32x4*)(BBT + (size_t)(dg * 128 + lane) * 16 + 8);
              const u32x4 i0 = *(const u32x4*)(BBT + (size_t)(dg * 128 + 64 + lane) * 16), i1 = *(const u32x4*)(BBT + (size_t)(dg * 128 + 64 + lane) * 16 + 8);
              bre[0] = bflo(r0.x); bre[1] = bfhi(r0.x); bre[2] = bflo(r0.y); bre[3] = bfhi(r0.y); bre[4] = bflo(r0.z); bre[5] = bfhi(r0.z); bre[6] = bflo(r0.w); bre[7] = bfhi(r0.w);
              bre[8] = bflo(r1.x); bre[9] = bfhi(r1.x); bre[10] = bflo(r1.y); bre[11] = bfhi(r1.y); bre[12] = bflo(r1.z); bre[13] = bfhi(r1.z); bre[14] = bflo(r1.w); bre[15] = bfhi(r1.w);
              bim[0] = bflo(i0.x); bim[1] = bfhi(i0.x); bim[2] = bflo(i0.y); bim[3] = bfhi(i0.y); bim[4] = bflo(i0.z); bim[5] = bfhi(i0.z); bim[6] = bflo(i0.w); bim[7] = bfhi(i0.w);
              bim[8] = bflo(i1.x); bim[9] = bfhi(i1.x); bim[10] = bflo(i1.y); bim[11] = bfhi(i1.y); bim[12] = bflo(i1.z); bim[13] = bfhi(i1.z); bim[14] = bflo(i1.w); bim[15] = bfhi(i1.w); }
            bf16x8 ct[4];
#pragma unroll
            for (int ks = 0; ks < 4; ++ks) ct[ks] = *(const bf16x8*)(CTT + (size_t)(dg * 16 + fr) * 128 + 32 * ks + 8 * fq);
            f32x2 st = SINB[((size_t)((d * 2 + b) * NCH + kc)) * 4096 + g * 64 + lane];
#pragma unroll
            for (int h = 0; h < 2; ++h) {
#pragma unroll 4
                for (int i = 0; i < 32; ++i) { const int sc = 32 * h + i; const int tok = (d == 0) ? sc : 63 - sc;
                    const u32x4 u0 = *(const u32x4*)(urow + (size_t)tok * S5W), u1 = *(const u32x4*)(urow + (size_t)tok * S5W + 8);
                    float u[16]; u[0] = bflo(u0.x); u[1] = bfhi(u0.x); u[2] = bflo(u0.y); u[3] = bfhi(u0.y); u[4] = bflo(u0.z); u[5] = bfhi(u0.z); u[6] = bflo(u0.w); u[7] = bfhi(u0.w);
                    u[8] = bflo(u1.x); u[9] = bfhi(u1.x); u[10] = bflo(u1.y); u[11] = bfhi(u1.y); u[12] = bflo(u1.z); u[13] = bfhi(u1.z); u[14] = bflo(u1.w); u[15] = bfhi(u1.w);
                    float br = 0.f, bi = 0.f;
#pragma unroll
                    for (int c = 0; c < 16; ++c) { br += bre[c] * u[c]; bi += bim[c] * u[c]; }
                    st = (f32x2){lam.x * st.x - lam.y * st.y + br, lam.x * st.y + lam.y * st.x + bi};
                    *(LAS unsigned*)(sl + (tok & 31) * 272 + lane * 4) = cvt_pk_bf16(st.x, st.y); }
                const int t0q = (d == 0) ? 2 * h : 2 * (1 - h);
                bf16x8 bsv[2][4];
#pragma unroll
                for (int tt = 0; tt < 2; ++tt)
#pragma unroll
                    for (int ks = 0; ks < 4; ++ks) bsv[tt][ks] = *(const LAS bf16x8*)(sl + (16 * tt + fr) * 272 + (32 * ks + 8 * fq) * 2);
#pragma unroll
                for (int tt = 0; tt < 2; ++tt)
#pragma unroll
                    for (int ks = 0; ks < 4; ++ks) yacc[t0q + tt] = __builtin_amdgcn_mfma_f32_16x16x32_bf16(ct[ks], bsv[tt][ks], yacc[t0q + tt], 0, 0, 0);
                asm volatile("s_nop 7\n\ts_nop 7" : "+v"(yacc[0]), "+v"(yacc[1]), "+v"(yacc[2]), "+v"(yacc[3]) : "v"(bsv[0][0]), "v"(bsv[0][1]), "v"(bsv[0][2]), "v"(bsv[0][3]), "v"(bsv[1][0]), "v"(bsv[1][1]), "v"(bsv[1][2]), "v"(bsv[1][3]), "v"(ct[0]), "v"(ct[1]), "v"(ct[2]), "v"(ct[3]));
                asm volatile("s_waitcnt lgkmcnt(0)" ::: "memory");
            }
        }
        const f32x4 dsk = *(const f32x4*)(F.in[IN_S5D] + 16 * g + 4 * fq);
#pragma unroll
        for (int tq = 0; tq < 4; ++tq) { const int tok = 16 * tq + fr;
            const u32x2 uu = *(const u32x2*)(urow + (size_t)tok * S5W + 4 * fq);
            f32x4 v; v[0] = yacc[tq][0] + bflo(uu.x) * dsk[0]; v[1] = yacc[tq][1] + bfhi(uu.x) * dsk[1]; v[2] = yacc[tq][2] + bflo(uu.y) * dsk[2]; v[3] = yacc[tq][3] + bfhi(uu.y) * dsk[3];
#pragma unroll
            for (int j = 0; j < 4; ++j) { const float x = v[j]; v[j] = x * sigmoidf_(1.5957691216f * (x + 0.044715f * x * x * x)); }
            *(u32x2*)(Y + (size_t)(b * SEQ + (kc - 4) * 64 + tok) * S5W + 16 * g + 4 * fq) = (u32x2){cvt_pk_bf16(v[0], v[1]), cvt_pk_bf16(v[2], v[3])}; }
    }
}
template <bool PASSB>
__device__ __forceinline__ void s5_pass3(Frame& F) {
    constexpr int nk = PASSB ? 256 : NCH; constexpr int nitems = 2 * nk * 8;
    LAS unsigned char* sl = F.lds + F.wave * 8704;
    const int lane = F.lane, fr = lane & 15, fq = lane >> 4;
    const bf16* UA = (const bf16*)(F.ws + WS_UA); const bf16* UCA = (const bf16*)(F.ws + WS_UCA); const bf16* BB2 = (const bf16*)(F.ws + WS_BB2); const bf16* CTT = (const bf16*)(F.ws + WS_CTT);
    const f32x2* LAM = (const f32x2*)(F.ws + WS_LAM); const f32x2* SINB = (const f32x2*)(F.ws + WS_SIN); f32x2* EB = (f32x2*)(F.ws + WS_E); bf16* Y = (bf16*)(F.ws + WS_Y);
    const bf16x8 zf = (bf16x8){0, 0, 0, 0, 0, 0, 0, 0};
    int curg = -1; bf16x8 af[2][8], ct[2][4]; f32x2 lamv[2]; f32x4 dsk = (f32x4){0.f, 0.f, 0.f, 0.f};
    for (int it = F.bx; it < nitems; it += F.G) {
        const int gq = it & 7, rest = it >> 3; const int b = rest / nk, kk = rest % nk; const int kc = PASSB ? kk + 4 : kk; const int g = gq * 8 + F.wave;
        if (g != curg) { curg = g;
#pragma unroll
            for (int d = 0; d < 2; ++d) { const int dg = d * 64 + g; lamv[d] = LAM[dg * 64 + lane];
#pragma unroll
                for (int nt = 0; nt < 8; ++nt) af[d][nt] = (fq < 2) ? *(const bf16x8*)(BB2 + (size_t)(dg * 128 + 16 * nt + fr) * 16 + 8 * fq) : zf;
                if (PASSB) {
#pragma unroll
                    for (int ks = 0; ks < 4; ++ks) ct[d][ks] = *(const bf16x8*)(CTT + (size_t)(dg * 16 + fr) * 128 + 32 * ks + 8 * fq); } }
            if (PASSB) dsk = *(const f32x4*)(F.in[IN_S5D] + 16 * g + 4 * fq); }
        const bf16* urow = (kc < 4) ? (UCA + (size_t)(b * CTX + kc * 64) * S5W + 16 * g) : (UA + (size_t)(b * SEQ + (kc - 4) * 64) * S5W + 16 * g);
        bf16x8 uf[4];
#pragma unroll
        for (int q = 0; q < 4; ++q) uf[q] = (fq < 2) ? *(const bf16x8*)(urow + (size_t)(16 * q + fr) * S5W + 8 * fq) : zf;
        u32x2 uu[4];
        if (PASSB) {
#pragma unroll
            for (int tq = 0; tq < 4; ++tq) uu[tq] = *(const u32x2*)(urow + (size_t)(16 * tq + fr) * S5W + 4 * fq); }
        f32x2 st0[2];
#pragma unroll
        for (int d = 0; d < 2; ++d) st0[d] = PASSB ? SINB[((size_t)((d * 2 + b) * NCH + kc)) * 4096 + g * 64 + lane] : (f32x2){0.f, 0.f};
        f32x4 yacc[4];
#pragma unroll
        for (int q = 0; q < 4; ++q) yacc[q] = (f32x4){0.f, 0.f, 0.f, 0.f};
#pragma unroll
        for (int d = 0; d < 2; ++d) {
            const f32x2 lam = lamv[d]; f32x2 st = st0[d];
#pragma unroll
            for (int h = 0; h < 2; ++h) {
                const int T0 = (d == 0) ? 32 * h : 32 * (1 - h);
#pragma unroll
                for (int tt = 0; tt < 2; ++tt)
#pragma unroll
                    for (int nt = 0; nt < 8; ++nt) { const f32x4 dd = __builtin_amdgcn_mfma_f32_16x16x32_bf16(af[d][nt], uf[(T0 >> 4) + tt], (f32x4){0.f, 0.f, 0.f, 0.f}, 0, 0, 0);
                        *(LAS u32x2*)(sl + (16 * tt + fr) * 272 + (16 * nt + 4 * fq) * 2) = (u32x2){cvt_pk_bf16(dd[0], dd[1]), cvt_pk_bf16(dd[2], dd[3])}; }
                asm volatile("s_waitcnt lgkmcnt(0)" ::: "memory");
#pragma unroll 8
                for (int i = 0; i < 32; ++i) { const int r = (d == 0) ? i : 31 - i; LAS unsigned* cell = (LAS unsigned*)(sl + r * 272 + lane * 4);
                    const unsigned w = *cell; const float br = bflo(w), bi = bfhi(w);
                    st = (f32x2){lam.x * st.x - lam.y * st.y + br, lam.x * st.y + lam.y * st.x + bi};
                    if (PASSB) *cell = cvt_pk_bf16(st.x, st.y); }
                if (PASSB) {
                    const int t0q = T0 >> 4;
                    bf16x8 bsv[2][4];
#pragma unroll
                    for (int tt = 0; tt < 2; ++tt)
#pragma unroll
                        for (int ks = 0; ks < 4; ++ks) bsv[tt][ks] = *(const LAS bf16x8*)(sl + (16 * tt + fr) * 272 + (32 * ks + 8 * fq) * 2);
#pragma unroll
                    for (int tt = 0; tt < 2; ++tt)
#pragma unroll
                        for (int ks = 0; ks < 4; ++ks) yacc[t0q + tt] = __builtin_amdgcn_mfma_f32_16x16x32_bf16(ct[d][ks], bsv[tt][ks], yacc[t0q + tt], 0, 0, 0);
                    asm volatile("s_nop 7\n\ts_nop 7" : "+v"(yacc[0]), "+v"(yacc[1]), "+v"(yacc[2]), "+v"(yacc[3]) : "v"(bsv[0][0]), "v"(bsv[0][1]), "v"(bsv[0][2]), "v"(bsv[0][3]), "v"(bsv[1][0]), "v"(bsv[1][1]), "v"(bsv[1][2]), "v"(bsv[1][3]));
                }
                asm volatile("s_waitcnt lgkmcnt(0)" ::: "memory");
            }
            if (!PASSB) EB[((size_t)((d * 2 + b) * NCH + kc)) * 4096 + g * 64 + lane] = st;
        }
        if (PASSB) {
#pragma unroll
            for (int tq = 0; tq < 4; ++tq) { const int tok = 16 * tq + fr;
                f32x4 v; v[0] = yacc[tq][0] + bflo(uu[tq].x) * dsk[0]; v[1] = yacc[tq][1] + bfhi(uu[tq].x) * dsk[1]; v[2] = yacc[tq][2] + bflo(uu[tq].y) * dsk[2]; v[3] = yacc[tq][3] + bfhi(uu[tq].y) * dsk[3];
#pragma unroll
                for (int j = 0; j < 4; ++j) { const float x = v[j]; v[j] = x * sigmoidf_(1.5957691216f * (x + 0.044715f * x * x * x)); }
                *(u32x2*)(Y + (size_t)(b * SEQ + (kc - 4) * 64 + tok) * S5W + 16 * g + 4 * fq) = (u32x2){cvt_pk_bf16(v[0], v[1]), cvt_pk_bf16(v[2], v[3])}; }
        }
    }
}
__device__ __forceinline__ void s5_carry_item(Frame& F, int item) {
    const int idx = item * NTHR + F.tid; const int d = idx >> 13, b = (idx >> 12) & 1, gp = idx & 4095;
    const f32x2 lam = ((const f32x2*)(F.ws + WS_LAM))[d * 4096 + gp];
    f32x2 l = cmul(lam, lam); l = cmul(l, l); l = cmul(l, l); l = cmul(l, l); l = cmul(l, l); l = cmul(l, l);
    const f32x2* EB = (const f32x2*)(F.ws + WS_E) + (size_t)((d * 2 + b) * NCH) * 4096 + gp; f32x2* SB = (f32x2*)(F.ws + WS_SIN) + (size_t)((d * 2 + b) * NCH) * 4096 + gp;
    f32x2 s = (f32x2){0.f, 0.f};
#pragma unroll 1
    for (int st0 = 0; st0 < NCH; st0 += 20) { f32x2 e[20];
#pragma unroll
        for (int j = 0; j < 20; ++j) { const int st = st0 + j; const int kc = (d == 0) ? st : (st < 4 ? 3 - st : NCH + 3 - st); e[j] = EB[(size_t)kc * 4096]; }
#pragma unroll
        for (int j = 0; j < 20; ++j) { const int st = st0 + j; const int kc = (d == 0) ? st : (st < 4 ? 3 - st : NCH + 3 - st); SB[(size_t)kc * 4096] = s; s = cmul(l, s) + e[j]; } }
}

__device__ __forceinline__ int fsw(int i) { return i ^ ((i >> 5) & 7) ^ (((i >> 6) & 3) << 3); }
__host__ __device__ constexpr float w16c(int j) { return j == 0 ? 1.f : j == 1 ? 0.9238795325f : j == 2 ? 0.7071067812f : j == 3 ? 0.3826834324f : j == 4 ? 0.f : j == 5 ? -0.3826834324f : j == 6 ? -0.7071067812f : -0.9238795325f; }
__host__ __device__ constexpr float w16s(int j) { return j == 0 ? 0.f : j == 1 ? 0.3826834324f : j == 2 ? 0.7071067812f : j == 3 ? 0.9238795325f : j == 4 ? 1.f : j == 5 ? 0.9238795325f : j == 6 ? 0.7071067812f : 0.3826834324f; }
__host__ __device__ constexpr int bitrev(int q, int bits) { int r = 0; for (int i = 0; i < bits; ++i) r |= ((q >> i) & 1) << (bits - 1 - i); return r; }
template <int R, bool INV> __device__ __forceinline__ void dft_reg(f32x2 (&x)[R]) {
#pragma unroll
    for (int len = R; len >= 2; len >>= 1) { const int half = len >> 1, step = 16 / len;
#pragma unroll
        for (int b0 = 0; b0 < R; b0 += len)
#pragma unroll
            for (int k = 0; k < half; ++k) { const f32x2 a = x[b0 + k], b = x[b0 + k + half]; x[b0 + k] = a + b; const f32x2 dd = a - b; const int j = k * step;
                if (j == 0) x[b0 + k + half] = dd;
                else if (j == 4) x[b0 + k + half] = INV ? (f32x2){-dd.y, dd.x} : (f32x2){dd.y, -dd.x};
                else { const float c = w16c(j), s = w16s(j); x[b0 + k + half] = INV ? (f32x2){dd.x * c - dd.y * s, dd.x * s + dd.y * c} : (f32x2){dd.x * c + dd.y * s, dd.y * c - dd.x * s}; } } }
}
template <int R, int LOGN, bool INV> __device__ __forceinline__ void fft_pass(LAS f32x2* buf, int tid) {
    constexpr int LOGR = (R == 16) ? 4 : 3, LOGM = LOGN - LOGR, M = 1 << LOGM, NBF = 16384 / R / NTHR;
#pragma unroll 1
    for (int it = 0; it < NBF; ++it) {
        int tl = tid; asm volatile("" : "+v"(tl));
        const int bq = tl + NTHR * it, blk = bq >> LOGM, j = bq & (M - 1), base = (blk << LOGN) + j; const int fb = fsw(base);
#define FADDR(q) (fb ^ (((q) << LOGM) ^ ((((q) << LOGM) >> 5) & 7) ^ (((((q) << LOGM) >> 6) & 3) << 3)))
        f32x2 x[R];
#pragma unroll
        for (int q = 0; q < R; ++q) x[q] = buf[FADDR(q)];
        f32x2 w1 = (f32x2){1.f, 0.f};
        if (LOGM > 0) { const float rev = (float)j * (1.0f / (float)(1 << LOGN)); const float sn = sin_rev(rev); w1 = (f32x2){cos_rev(rev), INV ? sn : -sn}; }
        if (!INV) {
            dft_reg<R, false>(x);
            buf[fb] = x[0]; f32x2 w = w1;
#pragma unroll
            for (int q = 1; q < R; ++q) { buf[FADDR(q)] = (LOGM > 0) ? cmul(x[bitrev(q, LOGR)], w) : x[bitrev(q, LOGR)]; if (LOGM > 0) w = cmul(w, w1); }
        } else {
            if (LOGM > 0) { f32x2 w = w1;
#pragma unroll
                for (int q = 1; q < R; ++q) { x[q] = cmul(x[q], w); w = cmul(w, w1); } }
            dft_reg<R, true>(x);
#pragma unroll
            for (int q = 0; q < R; ++q) buf[FADDR(q)] = x[bitrev(q, LOGR)];
        }
#undef FADDR
    }
    __syncthreads();
}
#ifndef FFT_TEST
#define FFT_TEST 0
#endif
__device__ __forceinline__ void fft_fwd(LAS f32x2* buf, int tid) { if (FFT_TEST & 1) return; fft_pass<16, 14, false>(buf, tid); fft_pass<16, 10, false>(buf, tid); fft_pass<8, 6, false>(buf, tid); fft_pass<8, 3, false>(buf, tid); }
__device__ __forceinline__ void fft_inv(LAS f32x2* buf, int tid) { if (FFT_TEST & 2) return; fft_pass<8, 3, true>(buf, tid); fft_pass<8, 6, true>(buf, tid); fft_pass<16, 10, true>(buf, tid); fft_pass<16, 14, true>(buf, tid); }
__device__ __forceinline__ float block_sum(Frame& F, float v) {
    LAS float* red = (LAS float*)(F.lds + LDS_X);
    v = wave_sum(v); __syncthreads(); if (F.lane == 0) red[F.wave] = v; __syncthreads();
    float s = 0.f;
#pragma unroll
    for (int w = 0; w < NWAVES; ++w) s += red[w];
    return s;
}
__device__ __forceinline__ float sconv(const bf16* UH, int b, int ch, int t, float w0, float w1, float w2) {
    const bf16* p = UH + (size_t)(b * 3072 + ch) * SEQ;
    const int tm = t > 0 ? t - 1 : 0, tp = t < SEQ - 1 ? t + 1 : SEQ - 1;
    const float xm = bf2f(p[tm]), x0 = bf2f(p[t]), xp = bf2f(p[tp]);
    return w0 * (t > 0 ? xm : 0.f) + w1 * x0 + w2 * (t < SEQ - 1 ? xp : 0.f);
}
#define HY_UNPK(w) ((f32x2){bflo(w), bfhi(w)})
template <bool INV, class LD, class ST>
__device__ __forceinline__ void fft_edge_pass(LAS f32x2* buf, int tid, LD& ld, ST& st) {
    constexpr int R = 16, LOGN = 14, LOGM = 10;
#pragma unroll
    for (int it = 0; it < 2; ++it) {
        int tl = tid; asm volatile("" : "+v"(tl));
        const int j = tl + NTHR * it; const int fb = fsw(j);
        f32x2 x[R];
#pragma unroll
        for (int q = 0; q < R; ++q) x[q] = ld(2 * q + it, j + (q << LOGM), fb + (q << LOGM));
        const float rev = (float)j * (1.0f / 16384.0f); const float sn = sin_rev(rev); const f32x2 w1 = (f32x2){cos_rev(rev), INV ? sn : -sn};
        if (!INV) {
            dft_reg<R, false>(x);
            st(it, j, fb, x[0]); f32x2 w = w1;
#pragma unroll
            for (int q = 1; q < R; ++q) { st(2 * q + it, j + (q << LOGM), fb + (q << LOGM), cmul(x[bitrev(q, 4)], w)); w = cmul(w, w1); }
        } else {
            f32x2 w = w1;
#pragma unroll
            for (int q = 1; q < R; ++q) { x[q] = cmul(x[q], w); w = cmul(w, w1); }
            dft_reg<R, true>(x);
#pragma unroll
            for (int q = 0; q < R; ++q) st(2 * q + it, j + (q << LOGM), fb + (q << LOGM), x[bitrev(q, 4)]);
        }
        __builtin_amdgcn_sched_barrier(0);
    }
}
__device__ __forceinline__ void fft_last_to_ks(LAS f32x2* buf, int tid, unsigned* KS, float scale) {
#pragma unroll 1
    for (int it = 0; it < 4; ++it) { int tl = tid; asm volatile("" : "+v"(tl)); const int b = tl + NTHR * it; const int fb = fsw(8 * b);
        f32x2 x[8];
#pragma unroll
        for (int q = 0; q < 8; ++q) x[q] = buf[fb ^ q];
        dft_reg<8, false>(x);
        u32x4 o0, o1; f32x2 v;
        v = x[bitrev(0, 3)] * scale; o0.x = cvt_pk_bf16(v.x, v.y); v = x[bitrev(1, 3)] * scale; o0.y = cvt_pk_bf16(v.x, v.y); v = x[bitrev(2, 3)] * scale; o0.z = cvt_pk_bf16(v.x, v.y); v = x[bitrev(3, 3)] * scale; o0.w = cvt_pk_bf16(v.x, v.y);
        v = x[bitrev(4, 3)] * scale; o1.x = cvt_pk_bf16(v.x, v.y); v = x[bitrev(5, 3)] * scale; o1.y = cvt_pk_bf16(v.x, v.y); v = x[bitrev(6, 3)] * scale; o1.z = cvt_pk_bf16(v.x, v.y); v = x[bitrev(7, 3)] * scale; o1.w = cvt_pk_bf16(v.x, v.y);
        *(GAS u32x4*)(KS + 8 * b) = o0; *(GAS u32x4*)(KS + 8 * b + 4) = o1; }
}
__device__ __forceinline__ void fft_mid_mul(LAS f32x2* buf, int tid, const unsigned* KS) {
#pragma unroll 2
    for (int it = 0; it < 4; ++it) { int tl = tid; asm volatile("" : "+v"(tl)); const int b = tl + NTHR * it; const int fb = fsw(8 * b);
        const u32x4 k0 = *(const GAS u32x4*)(KS + 8 * b), k1 = *(const GAS u32x4*)(KS + 8 * b + 4);
        f32x2 x[8], y[8];
#pragma unroll
        for (int q = 0; q < 8; ++q) x[q] = buf[fb ^ q];
        dft_reg<8, false>(x);
        y[0] = cmul(x[bitrev(0, 3)], HY_UNPK(k0.x)); y[1] = cmul(x[bitrev(1, 3)], HY_UNPK(k0.y)); y[2] = cmul(x[bitrev(2, 3)], HY_UNPK(k0.z)); y[3] = cmul(x[bitrev(3, 3)], HY_UNPK(k0.w));
        y[4] = cmul(x[bitrev(4, 3)], HY_UNPK(k1.x)); y[5] = cmul(x[bitrev(5, 3)], HY_UNPK(k1.y)); y[6] = cmul(x[bitrev(6, 3)], HY_UNPK(k1.z)); y[7] = cmul(x[bitrev(7, 3)], HY_UNPK(k1.w));
        dft_reg<8, true>(y);
#pragma unroll
        for (int q = 0; q < 8; ++q) buf[fb ^ q] = y[bitrev(q, 3)]; }
    __syncthreads();
}
struct HyStLds { LAS f32x2* buf; __device__ __forceinline__ void operator()(int, int, int addr, f32x2 v) { buf[addr] = v; } };
struct HyLdLds { LAS f32x2* buf; __device__ __forceinline__ f32x2 operator()(int, int, int addr) { return buf[addr]; } };
struct HyLdKc { const bf16* f0; const bf16* f1; float part; __device__ __forceinline__ f32x2 operator()(int, int t, int) { const float a0 = bf2f(f0[t]), r1 = (t == 0) ? 0.f : bf2f(f1[SEQ - t]); part += fabsf(a0) + fabsf(r1); return (f32x2){a0 + r1, 0.f}; } };
struct HyLdKn { const bf16* f0; const bf16* f1; __device__ __forceinline__ f32x2 operator()(int, int t, int) { const float a0 = bf2f(f0[t]), r1 = (t == 0) ? 0.f : bf2f(f1[SEQ - t]); const float rev = (float)t * (1.0f / 32768.0f), v = a0 - r1; return (f32x2){v * cos_rev(rev), v * sin_rev(rev)}; } };
struct HyLdZ { const unsigned* z; __device__ __forceinline__ f32x2 operator()(int k, int, int) { return HY_UNPK(z[k]); } };
struct HyLdZpsi { const unsigned* z; __device__ __forceinline__ f32x2 operator()(int k, int t, int) { const float rev = (float)t * (1.0f / 32768.0f); return cmul(HY_UNPK(z[k]), (f32x2){cos_rev(rev), sin_rev(rev)}); } };
struct HyStYc { unsigned* yc; __device__ __forceinline__ void operator()(int k, int, int, f32x2 v) { const f32x2 w = v * (0.5f / 16384.0f); yc[k] = cvt_pk_bf16(w.x, w.y); } };
struct HyStComb { unsigned* z; const unsigned* yc; float bias;
    __device__ __forceinline__ void operator()(int k, int t, int, f32x2 v) { const float rev = (float)t * (1.0f / 32768.0f);
        const f32x2 yn = cmul(v, (f32x2){cos_rev(rev), -sin_rev(rev)}) * (0.5f / 16384.0f); const f32x2 y = yn + HY_UNPK(yc[k]) + HY_UNPK(z[k]) * bias; z[k] = cvt_pk_bf16(y.x, y.y); } };
template <bool NEG> __device__ __forceinline__ float hy_load_kernel(LAS f32x2* buf, int tid, const bf16* f0, const bf16* f1) {
    float part = 0.f;
#pragma unroll 2
    for (int r = 0; r < 4; ++r) { int tl = tid; asm volatile("" : "+v"(tl)); const int t0 = 8 * (tl + NTHR * r); const int fb = fsw(t0); float a[8], q[8];
        const u32x4 va = *(const GAS u32x4*)(f0 + t0), vr = *(const GAS u32x4*)(f1 + SEQ - t0 - 8); const float r0 = bf2f(f1[t0 > 0 ? SEQ - t0 : 0]);
        a[0] = bflo(va.x); a[1] = bfhi(va.x); a[2] = bflo(va.y); a[3] = bfhi(va.y); a[4] = bflo(va.z); a[5] = bfhi(va.z); a[6] = bflo(va.w); a[7] = bfhi(va.w);
        q[0] = t0 > 0 ? r0 : 0.f; q[1] = bfhi(vr.w); q[2] = bflo(vr.w); q[3] = bfhi(vr.z); q[4] = bflo(vr.z); q[5] = bfhi(vr.y); q[6] = bflo(vr.y); q[7] = bfhi(vr.x);
#pragma unroll
        for (int e = 0; e < 8; ++e) {
            if (!NEG) { part += fabsf(a[e]) + fabsf(q[e]); buf[fb ^ e] = (f32x2){a[e] + q[e], 0.f}; }
            else { const float rev = (float)(t0 + e) * (1.0f / 32768.0f), v = a[e] - q[e]; buf[fb ^ e] = (f32x2){v * cos_rev(rev), v * sin_rev(rev)}; } } }
    return part;
}
template <bool NEG> __device__ __forceinline__ void hy_load_kernel2(LAS f32x2* buf, int tid, const bf16* f0a, const bf16* f1a, const bf16* f0b, const bf16* f1b, float& part0, float& part1) {
#pragma unroll 2
    for (int r = 0; r < 4; ++r) { int tl = tid; asm volatile("" : "+v"(tl)); const int t0 = 8 * (tl + NTHR * r); const int fb = fsw(t0); float a[8], q[8], b[8], p[8];
        const u32x4 va = *(const GAS u32x4*)(f0a + t0), vr = *(const GAS u32x4*)(f1a + SEQ - t0 - 8); const float r0 = bf2f(f1a[t0 > 0 ? SEQ - t0 : 0]);
        const u32x4 vb = *(const GAS u32x4*)(f0b + t0), vs = *(const GAS u32x4*)(f1b + SEQ - t0 - 8); const float s0 = bf2f(f1b[t0 > 0 ? SEQ - t0 : 0]);
        a[0] = bflo(va.x); a[1] = bfhi(va.x); a[2] = bflo(va.y); a[3] = bfhi(va.y); a[4] = bflo(va.z); a[5] = bfhi(va.z); a[6] = bflo(va.w); a[7] = bfhi(va.w);
        q[0] = t0 > 0 ? r0 : 0.f; q[1] = bfhi(vr.w); q[2] = bflo(vr.w); q[3] = bfhi(vr.z); q[4] = bflo(vr.z); q[5] = bfhi(vr.y); q[6] = bflo(vr.y); q[7] = bfhi(vr.x);
        b[0] = bflo(vb.x); b[1] = bfhi(vb.x); b[2] = bflo(vb.y); b[3] = bfhi(vb.y); b[4] = bflo(vb.z); b[5] = bfhi(vb.z); b[6] = bflo(vb.w); b[7] = bfhi(vb.w);
        p[0] = t0 > 0 ? s0 : 0.f; p[1] = bfhi(vs.w); p[2] = bflo(vs.w); p[3] = bfhi(vs.z); p[4] = bflo(vs.z); p[5] = bfhi(vs.y); p[6] = bflo(vs.y); p[7] = bfhi(vs.x);
#pragma unroll
        for (int e = 0; e < 8; ++e) {
            if (!NEG) { part0 += fabsf(a[e]) + fabsf(q[e]); part1 += fabsf(b[e]) + fabsf(p[e]); buf[fb ^ e] = (f32x2){a[e] + q[e], b[e] + p[e]}; }
            else { const float rev = (float)(t0 + e) * (1.0f / 32768.0f), v0 = a[e] - q[e], v1 = b[e] - p[e]; buf[fb ^ e] = cmul((f32x2){v0, v1}, (f32x2){cos_rev(rev), sin_rev(rev)}); } } }
}
template <bool NEG> __device__ __forceinline__ void hy_split_to_ks(LAS f32x2* buf, int tid, unsigned* KS0, unsigned* KS1, float inv0, float inv1) {
    constexpr int S = NEG ? 1 : 0;
#pragma unroll 1
    for (int it = 0; it < 4; ++it) { int tl = tid; asm volatile("" : "+v"(tl)); const int b = tl + NTHR * it;
        const int l = (b >> 7) + 16 * ((b >> 3) & 15) + 256 * (b & 7); const int nl = (S - l) & 2047; const int br = (l > S) ? 1 : 0;
        const int bp = (nl & 15) * 128 + ((nl >> 4) & 15) * 8 + ((nl >> 8) & 7);
        const int fb = fsw(8 * b), fp = fsw(8 * bp);
        unsigned o0[8], o1[8]; const float h0 = 0.5f * inv0, h1 = 0.5f * inv1;
#pragma unroll
        for (int q = 0; q < 8; ++q) { const f32x2 zz = buf[fb ^ q], zp = buf[fp ^ ((-q - br) & 7)];
            o0[q] = cvt_pk_bf16((zz.x + zp.x) * h0, (zz.y - zp.y) * h0); o1[q] = cvt_pk_bf16((zz.y + zp.y) * h1, (zp.x - zz.x) * h1); }
        *(GAS u32x4*)(KS0 + 8 * b) = (u32x4){o0[0], o0[1], o0[2], o0[3]}; *(GAS u32x4*)(KS0 + 8 * b + 4) = (u32x4){o0[4], o0[5], o0[6], o0[7]};
        *(GAS u32x4*)(KS1 + 8 * b) = (u32x4){o1[0], o1[1], o1[2], o1[3]}; *(GAS u32x4*)(KS1 + 8 * b + 4) = (u32x4){o1[4], o1[5], o1[6], o1[7]}; }
}
__device__ __forceinline__ void hy_conv8(const u32x4 v, float hm, float hp, float w0, float w1, float w2, float (&o)[8]) {
    const float x1 = bflo(v.x), x2 = bfhi(v.x), x3 = bflo(v.y), x4 = bfhi(v.y), x5 = bflo(v.z), x6 = bfhi(v.z), x7 = bflo(v.w), x8 = bfhi(v.w);
    o[0] = w0 * hm + w1 * x1 + w2 * x2; o[1] = w0 * x1 + w1 * x2 + w2 * x3; o[2] = w0 * x2 + w1 * x3 + w2 * x4; o[3] = w0 * x3 + w1 * x4 + w2 * x5;
    o[4] = w0 * x4 + w1 * x5 + w2 * x6; o[5] = w0 * x5 + w1 * x6 + w2 * x7; o[6] = w0 * x6 + w1 * x7 + w2 * x8; o[7] = w0 * x7 + w1 * x8 + w2 * hp;
}
__device__ __forceinline__ void hy_load_conv(LAS f32x2* buf, int tid, const bf16* UH, int ch, float w0, float w1, float w2) {
    const bf16* p0 = UH + (size_t)ch * SEQ; const bf16* p1 = UH + (size_t)(3072 + ch) * SEQ;
#pragma unroll 2
    for (int r = 0; r < 4; ++r) { int tl = tid; asm volatile("" : "+v"(tl)); const int t0 = 8 * (tl + NTHR * r); const int fb = fsw(t0);
        const int tm = t0 > 0 ? t0 - 1 : 0, tp = t0 + 8 < SEQ ? t0 + 8 : SEQ - 1;
        const u32x4 va = *(const GAS u32x4*)(p0 + t0), vb = *(const GAS u32x4*)(p1 + t0);
        float am = bf2f(p0[tm]), ap = bf2f(p0[tp]), bm = bf2f(p1[tm]), bp = bf2f(p1[tp]);
        if (t0 == 0) { am = 0.f; bm = 0.f; } if (t0 + 8 >= SEQ) { ap = 0.f; bp = 0.f; }
        float oa[8], ob[8]; hy_conv8(va, am, ap, w0, w1, w2, oa); hy_conv8(vb, bm, bp, w0, w1, w2, ob);
        buf[fb ^ 0] = (f32x2){oa[0], ob[0]}; buf[fb ^ 1] = (f32x2){oa[1], ob[1]}; buf[fb ^ 2] = (f32x2){oa[2], ob[2]}; buf[fb ^ 3] = (f32x2){oa[3], ob[3]};
        buf[fb ^ 4] = (f32x2){oa[4], ob[4]}; buf[fb ^ 5] = (f32x2){oa[5], ob[5]}; buf[fb ^ 6] = (f32x2){oa[6], ob[6]}; buf[fb ^ 7] = (f32x2){oa[7], ob[7]}; }
}
__device__ __forceinline__ void hyena_item(Frame& F, int c) {
    LAS f32x2* buf = (LAS f32x2*)F.lds;
    unsigned* KS = (unsigned*)(F.ws + WS_HYS + (size_t)F.bx * HYS_STRIDE);
    const bf16* FILT = (const bf16*)(F.ws + WS_FILT); const bf16* UH = (const bf16*)(F.ws + WS_UH);
    const int tid = F.tid; const int ft = fsw(tid);
#define FB(k) buf[ft + NTHR * (k)]
    const float* sw = F.in[IN_HSW];
    unsigned z[32], yc[32];
    HyStLds stl{buf}; HyLdLds ldl{buf};
    hy_load_conv(buf, tid, UH, c, sw[c], sw[3072 + c], sw[6144 + c]);
    __syncthreads();
#pragma unroll
    for (int k = 0; k < 32; ++k) { const f32x2 v_ = FB(k); z[k] = cvt_pk_bf16(v_.x, v_.y); }
    { const bf16* f0a = FILT + (size_t)c * SEQ; const bf16* f1a = FILT + (size_t)(2048 + c) * SEQ; const bf16* f0b = FILT + (size_t)(1024 + c) * SEQ; const bf16* f1b = FILT + (size_t)(3072 + c) * SEQ;
      float part0 = 0.f, part1 = 0.f;
      __syncthreads();
      hy_load_kernel2<false>(buf, tid, f0a, f1a, f0b, f1b, part0, part1);
      const float inv0 = 1.0f / (block_sum(F, part0) + 1e-6f); const float inv1 = 1.0f / (block_sum(F, part1) + 1e-6f);
      fft_edge_pass<false>(buf, tid, ldl, stl); __syncthreads();
      fft_pass<16, 10, false>(buf, tid); fft_pass<8, 6, false>(buf, tid); fft_pass<8, 3, false>(buf, tid);
      hy_split_to_ks<false>(buf, tid, KS, KS + 16384, inv0, inv1); __syncthreads();
      { float d0 = 0.f, d1 = 0.f; hy_load_kernel2<true>(buf, tid, f0a, f1a, f0b, f1b, d0, d1); } __syncthreads();
      fft_edge_pass<false>(buf, tid, ldl, stl); __syncthreads();
      fft_pass<16, 10, false>(buf, tid); fft_pass<8, 6, false>(buf, tid); fft_pass<8, 3, false>(buf, tid);
      hy_split_to_ks<true>(buf, tid, KS + 2 * 16384, KS + 3 * 16384, inv0, inv1); __syncthreads(); }
#pragma unroll 1
    for (int o = 0; o < 2; ++o) {
        { HyLdZ ldz{z}; fft_edge_pass<false>(buf, tid, ldz, stl); __syncthreads(); }
        fft_pass<16, 10, false>(buf, tid); fft_pass<8, 6, false>(buf, tid);
        fft_mid_mul(buf, tid, KS + o * 16384);
        fft_pass<8, 6, true>(buf, tid); fft_pass<16, 10, true>(buf, tid);
        { HyStYc styc{yc}; fft_edge_pass<true>(buf, tid, ldl, styc); }
        __syncthreads();
        { HyLdZpsi ldzp{z}; fft_edge_pass<false>(buf, tid, ldzp, stl); __syncthreads(); }
        fft_pass<16, 10, false>(buf, tid); fft_pass<8, 6, false>(buf, tid);
        { const bf16* g0 = UH + (size_t)((o + 1) * 1024 + c) * SEQ + 8 * tid; const bf16* g1 = g0 + (size_t)3072 * SEQ;
          u32x4 t0 = *(const GAS u32x4*)(g0), t1 = *(const GAS u32x4*)(g0 + 4096), t2 = *(const GAS u32x4*)(g0 + 8192), t3 = *(const GAS u32x4*)(g0 + 12288);
          u32x4 t4 = *(const GAS u32x4*)(g1), t5 = *(const GAS u32x4*)(g1 + 4096), t6 = *(const GAS u32x4*)(g1 + 8192), t7 = *(const GAS u32x4*)(g1 + 12288);
          fft_mid_mul(buf, tid, KS + (2 + o) * 16384);
          asm volatile("" :: "v"(t0), "v"(t1), "v"(t2), "v"(t3), "v"(t4), "v"(t5), "v"(t6), "v"(t7)); }
        fft_pass<8, 6, true>(buf, tid); fft_pass<16, 10, true>(buf, tid);
        { HyStComb stc{z, yc, F.in[IN_HBIAS][o * 1024 + c]}; fft_edge_pass<true>(buf, tid, ldl, stc); }
#pragma unroll
        for (int k = 0; k < 32; ++k) FB(k) = HY_UNPK(z[k]);
        { const int xch = (o + 1) * 1024 + c; const float w0 = sw[xch], w1 = sw[3072 + xch], w2 = sw[6144 + xch];
#pragma unroll 8
          for (int k = 0; k < 32; ++k) { const int t = tid + NTHR * k; f32x2 v_ = FB(k); v_.x *= sconv(UH, 0, xch, t, w0, w1, w2); v_.y *= sconv(UH, 1, xch, t, w0, w1, w2); FB(k) = v_; } }
#pragma unroll
        for (int k = 0; k < 32; ++k) { const f32x2 v_ = FB(k); z[k] = cvt_pk_bf16(v_.x, v_.y); }
        __syncthreads();
    }
    bf16* YHCM = (bf16*)(F.ws + WS_YHCM);
#pragma unroll
    for (int k = 0; k < 32; ++k) FB(k) = HY_UNPK(z[k]);
#pragma unroll 8
    for (int k = 0; k < 32; ++k) { const int t = tid + NTHR * k; const f32x2 v_ = FB(k); YHCM[(size_t)c * SEQ + t] = (bf16)f2bf(v_.x); YHCM[(size_t)(1024 + c) * SEQ + t] = (bf16)f2bf(v_.y); }
    __syncthreads();
#undef FB
}
__device__ __forceinline__ void p3_publish(Frame& F) {
    asm volatile("s_waitcnt vmcnt(0)" ::: "memory");
    __syncthreads();
    if (F.tid == 0) { __builtin_amdgcn_fence(__ATOMIC_RELEASE, "agent"); asm volatile("s_waitcnt vmcnt(0)" ::: "memory"); (void)xb_add((unsigned*)(F.ctl + CW_P3), 1u); }
}
__device__ __forceinline__ void p3_wait(Frame& F) {
    if (F.tid == 0) { unsigned* bar = (unsigned*)(F.ctl + CW_BAR);
        XB_SPIN(xb_ld((unsigned*)(F.ctl + CW_P3)) < (unsigned)F.G, bar);
        __builtin_amdgcn_fence(__ATOMIC_ACQUIRE, "agent"); asm volatile("s_waitcnt vmcnt(0)" ::: "memory"); }
    __syncthreads();
}
__device__ __forceinline__ void p4_hyena_carry(Frame& F, int qw) {
    volatile LAS int* qs = (volatile LAS int*)(F.lds + MISC_OFF + 64);
    for (;;) {
        __syncthreads();
        if (F.tid == 0) qs[0] = (int)__hip_atomic_fetch_add((unsigned*)(F.ctl + qw), 1u, __ATOMIC_RELAXED, __HIP_MEMORY_SCOPE_AGENT);
        __syncthreads();
        const int q = qs[0];
        if (q >= 32 + 1024) break;
        if (q < 1024) hyena_item(F, q); else { p3_wait(F); s5_carry_item(F, q - 1024); }
    }
}
__device__ __forceinline__ void yh_transpose(Frame& F) {
    const bf16* YHCM = (const bf16*)(F.ws + WS_YHCM); bf16* YH = (bf16*)(F.ws + WS_YH);
    LAS unsigned short* tl = (LAS unsigned short*)(F.lds + 8 * 8704 + F.wave * (64 * 72 * 2));
    const int gw = F.bx * NWAVES + F.wave, NGW = F.G * NWAVES, lane = F.lane;
    for (int it = gw; it < 2 * 16 * 256; it += NGW) {
        const int mt = it & 255, ct = (it >> 8) & 15, b = it >> 12; const int m0 = mt * 64, c0 = ct * 64;
#pragma unroll
        for (int j = 0; j < 8; ++j) { const int ch = 8 * j + (lane >> 3), mc = (lane & 7) * 8;
            const u32x4 v = *(const GAS u32x4*)(YHCM + (size_t)(b * 1024 + c0 + ch) * SEQ + m0 + mc); *(LAS u32x4*)(tl + ch * 72 + mc) = v; }
        LDS_WAIT(); asm volatile("" ::: "memory");
#pragma unroll
        for (int j = 0; j < 8; ++j) { const int mm = 8 * j + (lane >> 3), cc = (lane & 7) * 8; const int m = m0 + mm, w = m >> 8, r = m & 255;
            u32x4 o; o.x = (unsigned)tl[(cc + 0) * 72 + mm] | ((unsigned)tl[(cc + 1) * 72 + mm] << 16); o.y = (unsigned)tl[(cc + 2) * 72 + mm] | ((unsigned)tl[(cc + 3) * 72 + mm] << 16);
            o.z = (unsigned)tl[(cc + 4) * 72 + mm] | ((unsigned)tl[(cc + 5) * 72 + mm] << 16); o.w = (unsigned)tl[(cc + 6) * 72 + mm] | ((unsigned)tl[(cc + 7) * 72 + mm] << 16);
            *(GAS u32x4*)(YH + (size_t)(b * SEQ + r * 64 + w) * HYW + c0 + cc) = o; }
        LDS_WAIT(); asm volatile("" ::: "memory");
    }
}

struct SchedStd {
    int G, c, npn, K, nrep; const char* A; const char* Bt; int esz = 2;
    __device__ __forceinline__ bool next(int i, pg8::Unit& u) const {
        int L = i * G + c; const int nwg = 128 * npn; u.e = 0; u.valid = 256;
        if (nrep > 1 && L >= nwg) L -= nwg;
        if (L >= nwg) return false;
        int wgid = L; { const int q = nwg / 8, xcd = wgid % 8, off = wgid / 8; wgid = xcd * q + off; }
        const int nig = 8 * npn, gid = wgid / nig; u.pm = gid * 8 + ((wgid % nig) % 8); u.pn = (wgid % nig) / 8; return true;
    }
    __device__ __forceinline__ unsigned a_row(const pg8::Unit& u, int r) const { return (unsigned)(u.pm * 256 + r); }
    __device__ __forceinline__ const char* a_base() const { return A; }
    __device__ __forceinline__ const char* b_base(const pg8::Unit& u) const { return Bt + (size_t)u.pn * 256 * K * esz; }
};
template <int MODE> struct EpiMix {
    static constexpr bool PERM = true, TRANS = true, FP8 = false;
    const bf16* P; const bf16* Q; bf16* O;
    __device__ __forceinline__ void operator()(const f32x4 (&acc)[2][2][4][2], const pg8::Unit& u, int wr, int wc, int fr, int fq) const {
        constexpr int ld = (MODE == 0) ? 1024 : 2048;
        const int col0 = u.pn * 256 + wc * 32 + 8 * fq;
#pragma unroll
        for (int ai = 0; ai < 2; ++ai) {
            u32x4 pv[4][2], qv[4][2];
#pragma unroll
            for (int m = 0; m < 4; ++m) { const size_t row = (size_t)u.pm * 256 + ai * 128 + wr * 64 + m * 16 + fr;
#pragma unroll
                for (int bj = 0; bj < 2; ++bj) { const int col = col0 + bj * 128;
                    if (MODE == 0) pv[m][bj] = *(const u32x4*)(P + row * 1024 + col);
                    else { const u32x2 g8 = *(const u32x2*)((const unsigned char*)P + row * 4096 + (MODE == 2 ? 2048 : 0) + col); pv[m][bj] = (u32x4){g8.x, g8.y, 0u, 0u}; }
                    if (MODE == 2) qv[m][bj] = *(const u32x4*)(Q + row * 2048 + col); } }
#pragma unroll
            for (int m = 0; m < 4; ++m) { const size_t row = (size_t)u.pm * 256 + ai * 128 + wr * 64 + m * 16 + fr;
#pragma unroll
                for (int bj = 0; bj < 2; ++bj) { const int col = col0 + bj * 128; const f32x4 v0 = acc[ai][bj][m][0], v1 = acc[ai][bj][m][1]; float r[8];
                    if (MODE == 0) { const u32x4 y = pv[m][bj];
                        r[0] = bflo(y.x) * sigmoidf_(v0[0]); r[1] = bfhi(y.x) * sigmoidf_(v0[1]); r[2] = bflo(y.y) * sigmoidf_(v0[2]); r[3] = bfhi(y.y) * sigmoidf_(v0[3]);
                        r[4] = bflo(y.z) * sigmoidf_(v1[0]); r[5] = bfhi(y.z) * sigmoidf_(v1[1]); r[6] = bflo(y.w) * sigmoidf_(v1[2]); r[7] = bfhi(y.w) * sigmoidf_(v1[3]); }
                    else { const u32x4 gg = pv[m][bj]; constexpr float q = 1.0f / 255.0f;
                        r[0] = (float)(gg.x & 255u) * q * v0[0]; r[1] = (float)((gg.x >> 8) & 255u) * q * v0[1]; r[2] = (float)((gg.x >> 16) & 255u) * q * v0[2]; r[3] = (float)(gg.x >> 24) * q * v0[3];
                        r[4] = (float)(gg.y & 255u) * q * v1[0]; r[5] = (float)((gg.y >> 8) & 255u) * q * v1[1]; r[6] = (float)((gg.y >> 16) & 255u) * q * v1[2]; r[7] = (float)(gg.y >> 24) * q * v1[3];
                        if (MODE == 2) { const u32x4 t1 = qv[m][bj];
                            r[0] += bflo(t1.x); r[1] += bfhi(t1.x); r[2] += bflo(t1.y); r[3] += bfhi(t1.y); r[4] += bflo(t1.z); r[5] += bfhi(t1.z); r[6] += bflo(t1.w); r[7] += bfhi(t1.w); } }
                    if (MODE == 2) {
                        *(u32x2*)((unsigned char*)O + row * ld + col) = (u32x2){pk4_fp8(r[0] * T8SCALE, r[1] * T8SCALE, r[2] * T8SCALE, r[3] * T8SCALE), pk4_fp8(r[4] * T8SCALE, r[5] * T8SCALE, r[6] * T8SCALE, r[7] * T8SCALE)}; }
                    else { u32x4 w; w.x = cvt_pk_bf16(r[0], r[1]); w.y = cvt_pk_bf16(r[2], r[3]); w.z = cvt_pk_bf16(r[4], r[5]); w.w = cvt_pk_bf16(r[6], r[7]);
                        *(u32x4*)(O + row * ld + col) = w; } } }
        }
    }
};
struct EpiOut {
    static constexpr bool PERM = true, TRANS = true, FP8 = true;
    const float* X; const float* MOD; bf16* H1;
    __device__ __forceinline__ void operator()(const f32x4 (&acc)[2][2][4][2], const pg8::Unit& u, int wr, int wc, int fr, int fq) const {
        const int b = u.pm >> 6; const int c0 = u.pn * 256 + wc * 32 + 8 * fq;
        f32x4 gv[2][2];
#pragma unroll
        for (int bj = 0; bj < 2; ++bj)
#pragma unroll
            for (int n = 0; n < 2; ++n) gv[bj][n] = *(const f32x4*)(MOD + b * 12288 + 2 * 2048 + c0 + bj * 128 + 4 * n) * (1.0f / (W8SCALE * T8SCALE));
#pragma unroll
        for (int ai = 0; ai < 2; ++ai) {
            f32x4 xv[4][2][2];
#pragma unroll
            for (int m = 0; m < 4; ++m) { const size_t off = ((size_t)u.pm * 256 + ai * 128 + wr * 64 + m * 16 + fr) * D + c0;
#pragma unroll
                for (int bj = 0; bj < 2; ++bj)
#pragma unroll
                    for (int n = 0; n < 2; ++n) xv[m][bj][n] = *(const f32x4*)(X + off + bj * 128 + 4 * n); }
#pragma unroll
            for (int m = 0; m < 4; ++m) { const size_t off = ((size_t)u.pm * 256 + ai * 128 + wr * 64 + m * 16 + fr) * D + c0;
#pragma unroll
                for (int bj = 0; bj < 2; ++bj) { const f32x4 v0 = xv[m][bj][0] + gv[bj][0] * acc[ai][bj][m][0], v1 = xv[m][bj][1] + gv[bj][1] * acc[ai][bj][m][1];
                    u32x4 w; w.x = cvt_pk_bf16(v0[0], v0[1]); w.y = cvt_pk_bf16(v0[2], v0[3]); w.z = cvt_pk_bf16(v1[0], v1[1]); w.w = cvt_pk_bf16(v1[2], v1[3]);
                    *(u32x4*)(H1 + off + bj * 128) = w; } }
        }
    }
};

__device__ __forceinline__ float row16_max(float v) {
    v = fmaxf(v, __builtin_bit_cast(float, __builtin_amdgcn_update_dpp(0, __builtin_bit_cast(int, v), 0xB1, 0xf, 0xf, true)));
    v = fmaxf(v, __builtin_bit_cast(float, __builtin_amdgcn_update_dpp(0, __builtin_bit_cast(int, v), 0x4E, 0xf, 0xf, true)));
    v = fmaxf(v, __builtin_bit_cast(float, __builtin_amdgcn_update_dpp(0, __builtin_bit_cast(int, v), 0x141, 0xf, 0xf, true)));
    v = fmaxf(v, __builtin_bit_cast(float, __builtin_amdgcn_update_dpp(0, __builtin_bit_cast(int, v), 0x140, 0xf, 0xf, true)));
    return v;
}
__device__ __forceinline__ void p10_router(Frame& F) {
    const int gw = F.bx * NWAVES + F.wave, NGW = F.G * NWAVES, lane = F.lane;
    const float* MOD = (const float*)(F.ws + WS_MOD); const float* g2n = F.in[IN_N2G]; const float* RWT = (const float*)(F.ws + WS_RWT); const float* rb = F.in[IN_RB];
    const bf16* H1 = (const bf16*)(F.ws + WS_H1); unsigned char* HM8 = (unsigned char*)(F.ws + WS_HM8); float* GATE = (float*)(F.ws + WS_GATE); int* LIST = (int*)(F.ws + WS_LIST);
    LAS float* rs = (LAS float*)(F.lds + F.wave * 64);
    volatile LAS int* lcnt = (volatile LAS int*)(F.lds + 1024); volatile LAS int* lbase = lcnt + 32;
    LAS float* gmt = (LAS float*)(F.lds + 4096); LAS float* sht = gmt + 2 * 2048;
    for (int i = F.tid; i < 2 * 2048; i += NTHR) { const int bb = i >> 11, k = i & 2047; gmt[i] = g2n[k] * (MOD[bb * 12288 + 4 * 2048 + k] + 1.0f); sht[i] = MOD[bb * 12288 + 3 * 2048 + k]; }
    const int nblk = NTOK / 16, ntrips = (nblk + NGW - 1) / NGW;
    for (int tr = 0; tr < ntrips; ++tr) {
        const int blk = gw + NGW * tr; const bool act = blk < nblk;
        if (F.tid < NEXP) lcnt[F.tid] = 0;
        __syncthreads();
        int tke[4], tkp[4]; float tkg[4];
#pragma unroll
        for (int r = 0; r < 4; ++r) { tke[r] = 0; tkp[r] = 0; tkg[r] = 0.f; }
        const int mb = 16 * (act ? blk : 0); const int b = mb >> 14;
        if (act) {
#pragma unroll 1
        for (int rp = 0; rp < 4; ++rp) { const int m0 = mb + 4 * rp;
            f32x4 h[4][8];
#pragma unroll
            for (int rr = 0; rr < 4; ++rr) { const bf16* xr = H1 + (size_t)(m0 + rr) * D;
#pragma unroll
                for (int j = 0; j < 8; ++j) { const u32x2 hb = *(const GAS u32x2*)(xr + 4 * lane + 256 * j); h[rr][j] = (f32x4){bflo(hb.x), bfhi(hb.x), bflo(hb.y), bfhi(hb.y)}; } }
#pragma unroll
            for (int rr = 0; rr < 4; ++rr) { float sq = 0.f;
#pragma unroll
                for (int j = 0; j < 8; ++j) sq += (h[rr][j].x * h[rr][j].x + h[rr][j].y * h[rr][j].y) + (h[rr][j].z * h[rr][j].z + h[rr][j].w * h[rr][j].w);
                const float rstd = 1.0f / sqrtf(wave_sum(sq) * (1.0f / D) + 1e-6f);
                if (lane == 0) rs[4 * rp + rr] = rstd;
                GAS unsigned* o = (GAS unsigned*)(HM8 + (size_t)(m0 + rr) * D) + lane;
#pragma unroll
                for (int j = 0; j < 8; ++j) { const int k = 4 * lane + 256 * j; const f32x4 gm = *(const LAS f32x4*)(gmt + b * 2048 + k), sh = *(const LAS f32x4*)(sht + b * 2048 + k);
                    const f32x4 v = h[rr][j] * rstd * gm + sh; o[64 * j] = pk4_fp8(v.x, v.y, v.z, v.w); } } }
        const int jr = lane & 15, kq = lane >> 4;
        const float rstd = rs[jr];
        const bf16* hrow = H1 + (size_t)(mb + jr) * D + 8 * kq; const LAS float* gp = gmt + b * 2048 + 8 * kq; const LAS float* shp = sht + b * 2048 + 8 * kq;
        const float* w0p = RWT + (size_t)jr * 2048 + 8 * kq; const float* w1p = w0p + 16 * 2048;
        f32x4 acc0 = (f32x4){0.f, 0.f, 0.f, 0.f}, acc1 = (f32x4){0.f, 0.f, 0.f, 0.f};
#pragma unroll 4
        for (int t = 0; t < 64; ++t) { const int ko = 32 * t;
            const u32x4 hb = *(const GAS u32x4*)(hrow + ko);
            const f32x4 a0 = *(const GAS f32x4*)(w0p + ko), a1 = *(const GAS f32x4*)(w0p + ko + 4), c0 = *(const GAS f32x4*)(w1p + ko), c1 = *(const GAS f32x4*)(w1p + ko + 4);
            const f32x4 g0 = *(const LAS f32x4*)(gp + ko), g1 = *(const LAS f32x4*)(gp + ko + 4), t0 = *(const LAS f32x4*)(shp + ko), t1 = *(const LAS f32x4*)(shp + ko + 4);
            float hm[8];
            hm[0] = bflo(hb.x) * rstd * g0.x + t0.x; hm[1] = bfhi(hb.x) * rstd * g0.y + t0.y; hm[2] = bflo(hb.y) * rstd * g0.z + t0.z; hm[3] = bfhi(hb.y) * rstd * g0.w + t0.w;
            hm[4] = bflo(hb.z) * rstd * g1.x + t1.x; hm[5] = bfhi(hb.z) * rstd * g1.y + t1.y; hm[6] = bflo(hb.w) * rstd * g1.z + t1.z; hm[7] = bfhi(hb.w) * rstd * g1.w + t1.w;
            acc0 = __builtin_amdgcn_mfma_f32_16x16x4f32(hm[0], a0.x, acc0, 0, 0, 0); acc1 = __builtin_amdgcn_mfma_f32_16x16x4f32(hm[0], c0.x, acc1, 0, 0, 0);
            acc0 = __builtin_amdgcn_mfma_f32_16x16x4f32(hm[1], a0.y, acc0, 0, 0, 0); acc1 = __builtin_amdgcn_mfma_f32_16x16x4f32(hm[1], c0.y, acc1, 0, 0, 0);
            acc0 = __builtin_amdgcn_mfma_f32_16x16x4f32(hm[2], a0.z, acc0, 0, 0, 0); acc1 = __builtin_amdgcn_mfma_f32_16x16x4f32(hm[2], c0.z, acc1, 0, 0, 0);
            acc0 = __builtin_amdgcn_mfma_f32_16x16x4f32(hm[3], a0.w, acc0, 0, 0, 0); acc1 = __builtin_amdgcn_mfma_f32_16x16x4f32(hm[3], c0.w, acc1, 0, 0, 0);
            acc0 = __builtin_amdgcn_mfma_f32_16x16x4f32(hm[4], a1.x, acc0, 0, 0, 0); acc1 = __builtin_amdgcn_mfma_f32_16x16x4f32(hm[4], c1.x, acc1, 0, 0, 0);
            acc0 = __builtin_amdgcn_mfma_f32_16x16x4f32(hm[5], a1.y, acc0, 0, 0, 0); acc1 = __builtin_amdgcn_mfma_f32_16x16x4f32(hm[5], c1.y, acc1, 0, 0, 0);
            acc0 = __builtin_amdgcn_mfma_f32_16x16x4f32(hm[6], a1.z, acc0, 0, 0, 0); acc1 = __builtin_amdgcn_mfma_f32_16x16x4f32(hm[6], c1.z, acc1, 0, 0, 0);
            acc0 = __builtin_amdgcn_mfma_f32_16x16x4f32(hm[7], a1.w, acc0, 0, 0, 0); acc1 = __builtin_amdgcn_mfma_f32_16x16x4f32(hm[7], c1.w, acc1, 0, 0, 0); }
        const float be0 = rb[jr], be1 = rb[16 + jr];
#pragma unroll
        for (int r = 0; r < 4; ++r) { float va = acc0[r] + be0, vc = acc1[r] + be1; int es[4]; float vs[4];
#pragma unroll
            for (int k = 0; k < 4; ++k) { const float mx = row16_max(fmaxf(va, vc));
                const unsigned long long b0 = __ballot(va == mx), b1 = __ballot(vc == mx); const unsigned m0 = (unsigned)(b0 >> (16 * kq)) & 0xffffu, m1 = (unsigned)(b1 >> (16 * kq)) & 0xffffu;
                const int idx = m0 ? (__ffs((int)m0) - 1) : (16 + __ffs((int)m1) - 1);
                es[k] = idx; vs[k] = mx; if (jr == idx) va = -3.0e38f; if (jr + 16 == idx) vc = -3.0e38f; }
            const float e1 = __expf(vs[1] - vs[0]), e2 = __expf(vs[2] - vs[0]), e3 = __expf(vs[3] - vs[0]); const float inv = 1.0f / (1.0f + e1 + e2 + e3);
            if (jr < 4) { const int ee = jr == 0 ? es[0] : jr == 1 ? es[1] : jr == 2 ? es[2] : es[3]; tke[r] = ee; tkg[r] = (jr == 0 ? 1.0f : jr == 1 ? e1 : jr == 2 ? e2 : e3) * inv;
                tkp[r] = __hip_atomic_fetch_add((LAS int*)(F.lds + 1024) + ee, 1, __ATOMIC_RELAXED, __HIP_MEMORY_SCOPE_WORKGROUP); } }
        }
        __syncthreads();
        if (F.tid < NEXP) { const int cnt = lcnt[F.tid]; int base = 0;
            if (cnt > 0) base = (int)__hip_atomic_fetch_add((unsigned*)(F.ctl + CW_CNT + 64 * F.tid), (unsigned)cnt, __ATOMIC_RELAXED, __HIP_MEMORY_SCOPE_AGENT);
            lbase[F.tid] = base; }
        __syncthreads();
        if (act && (lane & 15) < 4) {
#pragma unroll
            for (int r = 0; r < 4; ++r) { const int slot = (mb + 4 * (lane >> 4) + r) * 4 + (lane & 15); LIST[tke[r] * LISTCAP + lbase[tke[r]] + tkp[r]] = slot; GATE[slot] = tkg[r]; } }
    }
}

__device__ __forceinline__ void moe_tables(Frame& F) {
    volatile LAS int* tb = (volatile LAS int*)(F.lds + LDS_X);
    __syncthreads();
    if (F.tid < NEXP) tb[64 + F.tid] = (int)__hip_atomic_load((unsigned*)(F.ctl + CW_CNT + 64 * F.tid), __ATOMIC_RELAXED, __HIP_MEMORY_SCOPE_AGENT);
    __syncthreads();
    if (F.tid == 0) { int acc = 0; for (int e = 0; e < NEXP; ++e) { const int c = tb[64 + e]; tb[e] = acc; acc += (c + 255) >> 8; } tb[32] = acc; }
    __syncthreads();
}
template <bool GATHER> struct SchedMoe {
    int G, c, npn, N, K, nrep; const char* A; const char* Bt; const int* LIST; volatile LAS int* tb;
    __device__ __forceinline__ bool next(int i, pg8::Unit& u) const {
        int L = i * G + c; { const int tot = tb[32] * npn; if (nrep > 1 && L >= tot) L -= tot; }
        int rt = L / npn, pnq = L % npn;
        if (G == 256 && nrep == 1) {
            const int x = c & 7, j = c >> 3;
            if (npn == 16) { pnq = 4 * (x & 3) + (j & 3); rt = 16 * i + (x >> 2) * 8 + (j >> 2); }
            else           { pnq = 2 * (x & 3) + (j & 1); rt = 32 * i + (x >> 2) * 16 + (j >> 1); }
        }
        if (rt >= tb[32]) return false;
        int e = 0;
        for (int q = 1; q < NEXP; ++q) e += (tb[q] <= rt) ? 1 : 0;
        e = __builtin_amdgcn_readfirstlane(e);
        u.pm = rt; u.pn = pnq; u.e = e; const int left = tb[64 + e] - 256 * (rt - tb[e]); u.valid = left < 256 ? left : 256; return true;
    }
    __device__ __forceinline__ unsigned a_row(const pg8::Unit& u, int r) const {
        if (GATHER) { const int rc = r < u.valid ? r : u.valid - 1; return (unsigned)(LIST[u.e * LISTCAP + (u.pm - tb[u.e]) * 256 + rc] >> 2); }
        return (unsigned)(u.pm * 256 + r);
    }
    __device__ __forceinline__ const char* a_base() const { return A; }
    __device__ __forceinline__ const char* b_base(const pg8::Unit& u) const { return Bt + ((size_t)u.e * N + (size_t)u.pn * 256) * K; }
};
struct EpiMoe1 {
    static constexpr bool PERM = true, TRANS = true, FP8 = true;
    const float* BG; unsigned char* ACT;
    __device__ __forceinline__ void operator()(const f32x4 (&acc)[2][2][4][2], const pg8::Unit& u, int wr, int wc, int fr, int fq) const {
        const int c0 = u.pn * 256 + wc * 32 + 8 * fq;
        f32x4 bv[2][2];
#pragma unroll
        for (int bj = 0; bj < 2; ++bj)
#pragma unroll
            for (int n = 0; n < 2; ++n) bv[bj][n] = *(const f32x4*)(BG + (size_t)u.e * 4096 + c0 + bj * 128 + 4 * n);
#pragma unroll
        for (int ai = 0; ai < 2; ++ai)
#pragma unroll
            for (int m = 0; m < 4; ++m) { const size_t row = (size_t)u.pm * 256 + ai * 128 + wr * 64 + m * 16 + fr;
#pragma unroll
                for (int bj = 0; bj < 2; ++bj) { const f32x4 v0 = acc[ai][bj][m][0] * (1.0f / W8SCALE) + bv[bj][0], v1 = acc[ai][bj][m][1] * (1.0f / W8SCALE) + bv[bj][1]; float a[4];
#pragma unroll
                    for (int j = 0; j < 4; ++j) { const float gl = fminf(j < 2 ? v0[2 * j] : v1[2 * j - 4], 7.0f); const float ln = fminf(fmaxf(j < 2 ? v0[2 * j + 1] : v1[2 * j - 3], -7.0f), 7.0f);
                        a[j] = gl * sigmoidf_(1.702f * gl) * (ln + 1.0f); }
                    *(unsigned*)(ACT + row * DEXP + ((c0 + bj * 128) >> 1)) = pk4_fp8(a[0], a[1], a[2], a[3]); } }
    }
};
struct EpiMoe2 {
    static constexpr bool PERM = true, TRANS = true, FP8 = true;
    const float* BD; const float* GATE; const int* LIST; unsigned char* YS; volatile LAS int* tb;
    __device__ __forceinline__ void operator()(const f32x4 (&acc)[2][2][4][2], const pg8::Unit& u, int wr, int wc, int fr, int fq) const {
        const int c0 = u.pn * 256 + wc * 32 + 8 * fq; const int lbase = u.e * LISTCAP + (u.pm - tb[u.e]) * 256;
        f32x4 bv[2][2];
#pragma unroll
        for (int bj = 0; bj < 2; ++bj)
#pragma unroll
            for (int n = 0; n < 2; ++n) bv[bj][n] = *(const f32x4*)(BD + (size_t)u.e * D + c0 + bj * 128 + 4 * n);
        int slot[2][4]; float gt_[2][4];
#pragma unroll
        for (int ai = 0; ai < 2; ++ai)
#pragma unroll
            for (int m = 0; m < 4; ++m) { const int r = ai * 128 + wr * 64 + m * 16 + fr; slot[ai][m] = LIST[lbase + (r < u.valid ? r : u.valid - 1)]; }
#pragma unroll
        for (int ai = 0; ai < 2; ++ai)
#pragma unroll
            for (int m = 0; m < 4; ++m) gt_[ai][m] = GATE[slot[ai][m]] * Y8SCALE;
#pragma unroll
        for (int ai = 0; ai < 2; ++ai)
#pragma unroll
            for (int m = 0; m < 4; ++m) { const int r = ai * 128 + wr * 64 + m * 16 + fr; const float gt = gt_[ai][m];
                const long long ro = (r < u.valid) ? (long long)slot[ai][m] * D : YS_DUMP_OFF;
#pragma unroll
                for (int bj = 0; bj < 2; ++bj) { const f32x4 v0 = (acc[ai][bj][m][0] * (1.0f / W8SCALE) + bv[bj][0]) * gt, v1 = (acc[ai][bj][m][1] * (1.0f / W8SCALE) + bv[bj][1]) * gt;
                    *(u32x2*)(YS + ro + c0 + bj * 128) = (u32x2){pk4_fp8(v0[0], v0[1], v0[2], v0[3]), pk4_fp8(v1[0], v1[1], v1[2], v1[3])}; } }
    }
};
__device__ __forceinline__ void p13_final(Frame& F) {
    const int gw = F.bx * NWAVES + F.wave, NGW = F.G * NWAVES, lane = F.lane;
    const float* MOD = (const float*)(F.ws + WS_MOD); const float* fg = F.in[IN_FG]; const unsigned char* YS = (const unsigned char*)(F.ws + WS_YS); float* O = F.out;
    f32x4 g2v[8]; int curb = -1;
    for (int m0 = 2 * gw; m0 < NTOK; m0 += 2 * NGW) {
        const int b = m0 >> 14;
        if (b != curb) { curb = b;
#pragma unroll
            for (int j = 0; j < 8; ++j) g2v[j] = *(const f32x4*)(MOD + b * 12288 + 5 * 2048 + 4 * lane + 256 * j) * (1.0f / Y8SCALE); }
        unsigned yv[2][8][4]; u32x2 hv[2][8]; f32x4 fgv[8];
#pragma unroll
        for (int rr = 0; rr < 2; ++rr) { const int m = m0 + rr; const bf16* hr = (const bf16*)(F.ws + WS_H1) + (size_t)m * D;
#pragma unroll
            for (int j = 0; j < 8; ++j) { const int k = 4 * lane + 256 * j;
#pragma unroll
                for (int q = 0; q < 4; ++q) yv[rr][j][q] = *(const GAS unsigned*)(YS + (size_t)(m * 4 + q) * D + k);
                hv[rr][j] = *(const GAS u32x2*)(hr + k); } }
#pragma unroll
        for (int j = 0; j < 8; ++j) fgv[j] = *(const f32x4*)(fg + 4 * lane + 256 * j);
        f32x4 h[2][8]; float rstd[2];
#pragma unroll
        for (int rr = 0; rr < 2; ++rr) { float s = 0.f;
#pragma unroll
            for (int j = 0; j < 8; ++j) { f32x4 a = (f32x4){0.f, 0.f, 0.f, 0.f};
#pragma unroll
                for (int q = 0; q < 4; ++q) { const unsigned y = yv[rr][j][q]; const f32x2 lo = __builtin_amdgcn_cvt_pk_f32_fp8((int)y, false), hi = __builtin_amdgcn_cvt_pk_f32_fp8((int)y, true); a += (f32x4){lo.x, lo.y, hi.x, hi.y}; }
                const u32x2 hb = hv[rr][j]; h[rr][j] = (f32x4){bflo(hb.x), bfhi(hb.x), bflo(hb.y), bfhi(hb.y)} + g2v[j] * a; s += (h[rr][j].x * h[rr][j].x + h[rr][j].y * h[rr][j].y) + (h[rr][j].z * h[rr][j].z + h[rr][j].w * h[rr][j].w); }
            rstd[rr] = 1.0f / sqrtf(wave_sum(s) * (1.0f / D) + 1e-6f); }
#pragma unroll
        for (int rr = 0; rr < 2; ++rr) { float* xr = O + (size_t)(m0 + rr) * D;
#pragma unroll
            for (int j = 0; j < 8; ++j) { const int k = 4 * lane + 256 * j; *(GAS f32x4*)(xr + k) = h[rr][j] * rstd[rr] * fgv[j]; } }
    }
}

__global__ void __launch_bounds__(NTHR, 2) fwd(Args args) {
    extern __shared__ __attribute__((aligned(16))) unsigned char lds_raw[];
    Frame F;
    F.lds = (LAS unsigned char*)lds_raw;
    F.tid = threadIdx.x; F.lane = F.tid & 63; F.wave = __builtin_amdgcn_readfirstlane(F.tid >> 6);
    F.G = gridDim.x; F.bx = blockIdx.x; F.in = args.in; F.out = args.out; F.ws = args.ws; F.ctl = (GAS unsigned*)(args.ws + WS_CTL);
    for (int u = F.tid; u < (LDS_BYTES - MISC_OFF) / 4; u += NTHR) ((LAS unsigned*)(F.lds + MISC_OFF))[u] = 0u;
    __syncthreads();
    const int lo = args.ph_lo, hi = args.ph_hi;
    XcdBarrier bar; bar.bar = (unsigned*)(F.ctl + CW_BAR); bar.x = 0; bar.st = nullptr;
    if (hi - lo > 1) bar = xcd_barrier_post((unsigned*)(F.ctl + CW_BAR), (volatile LAS unsigned*)(F.lds + MISC_OFF));
#ifndef PH_MASK
#define PH_MASK 0xffff
#endif
#define IN(k) (((PH_MASK >> (k)) & 1) && lo <= (k) && (k) < hi)
#define SEAM(k) do { if (IN(k) && IN((k) + 1)) xcd_barrier(bar); } while (0)
    unsigned char* ws = args.ws;
#ifndef PROBE_DUP
#define PROBE_DUP 0
#endif
#define DUPBAR(k) if ((PROBE_DUP >> (k)) & 1) xcd_barrier(bar)
#define DUP2(k, body) do { body; if ((PROBE_DUP >> (k)) & 1) { xcd_barrier(bar); body; } } while (0)
    if (IN(0)) { DUP2(0, p0_prologue(F)); } SEAM(0);
    if (IN(1)) { DUP2(1, p1_norm(F)); } SEAM(1);
    if (IN(2)) { {
        const int GW = (F.G == 256) ? 192 : F.G; const int nr = ((PROBE_DUP >> 2) & 1) ? 2 : 1;
        if (F.bx < GW) {
            const int r1 = (128 * 4 + 8) % GW, r2 = (r1 + 128 * 16) % GW; const int c1 = F.bx, c2 = (F.bx - r1 + GW) % GW, c3 = (F.bx - r2 + GW) % GW;
            { SchedIn S{GW, c1, 128 * 4, 4, 0, nr, (const char*)(ws + WS_U), (const char*)(ws + WS_WIN)}; EpiInA E{ws};
              pg8::gemm_phase<EpiInA, SchedIn>(F.lds, D, S, E); }
            { SchedIn S{GW, c2, 128 * 16, 16, 2, nr, (const char*)(ws + WS_U8), (const char*)(ws + WS_WIN8)}; EpiInG8 E{(unsigned char*)(ws + WS_UG)};
              pg8::gemm_phase<EpiInG8, SchedIn>(F.lds, D, S, E); }
            { SchedIn S{GW, c3, 128 * 12, 12, 1, nr, (const char*)(ws + WS_U), (const char*)(ws + WS_WIN)}; EpiInH E{(bf16*)(ws + WS_UH)};
              pg8::gemm_phase<EpiInH, SchedIn>(F.lds, D, S, E); }
        }
        moe_weight_queue(F);
        }
    } SEAM(2);
    if (IN(3)) { DUP2(3, s5_pass3<false>(F)); p3_publish(F); }
    if (IN(4)) { int q4w = CW_Q4; DUP2(4, (p4_hyena_carry(F, q4w), q4w += 16)); } SEAM(4);
    if (IN(5)) { DUP2(5, s5_pass3<true>(F)); __syncthreads(); DUP2(14, yh_transpose(F)); } SEAM(5);
    if (IN(6)) { { SchedStd S{F.G, F.bx, 4, 1024, ((PROBE_DUP >> 6) & 1) ? 2 : 1, (const char*)(ws + WS_Y), (const char*)(ws + WS_WGLU)}; EpiMix<0> E{(const bf16*)(ws + WS_Y), nullptr, (bf16*)(ws + WS_YA)};
        pg8::gemm_phase<EpiMix<0>, SchedStd>(F.lds, 1024, S, E); } } SEAM(6);
    if (IN(7)) { { SchedStd S{F.G, F.bx, 8, 1024, ((PROBE_DUP >> 7) & 1) ? 2 : 1, (const char*)(ws + WS_YA), (const char*)(ws + WS_WBS5)}; EpiMix<1> E{(const bf16*)(ws + WS_UG), nullptr, (bf16*)(ws + WS_T1)};
        pg8::gemm_phase<EpiMix<1>, SchedStd>(F.lds, 1024, S, E); } }
    if (!(IN(7) && IN(8))) { SEAM(7); }
    if (IN(8)) { { SchedStd S{F.G, F.bx, 8, 1024, ((PROBE_DUP >> 8) & 1) ? 2 : 1, (const char*)(ws + WS_YH), (const char*)(ws + WS_WBHY)}; EpiMix<2> E{(const bf16*)(ws + WS_UG), (const bf16*)(ws + WS_T1), (bf16*)(ws + WS_T)};
        pg8::gemm_phase<EpiMix<2>, SchedStd>(F.lds, 1024, S, E); } } SEAM(8);
    if (IN(9)) { { SchedStd S{F.G, F.bx, 8, 2048, ((PROBE_DUP >> 9) & 1) ? 2 : 1, (const char*)(ws + WS_T), (const char*)(ws + WS_WO), 1}; EpiOut E{F.in[IN_X], (const float*)(ws + WS_MOD), (bf16*)(ws + WS_H1)};
        pg8::gemm_phase<EpiOut, SchedStd>(F.lds, 2048, S, E); } } SEAM(9);
    if (IN(10)) { p10_router(F); } SEAM(10);
    if (IN(11)) { { moe_tables(F); volatile LAS int* tb = (volatile LAS int*)(F.lds + LDS_X);
        SchedMoe<true> S{F.G, F.bx, 16, 4096, 2048, ((PROBE_DUP >> 11) & 1) ? 2 : 1, (const char*)(ws + WS_HM8), (const char*)(ws + WS_WGU), (const int*)(ws + WS_LIST), tb}; EpiMoe1 E{F.in[IN_BGU], (unsigned char*)(ws + WS_ACT)};
        pg8::gemm_phase<EpiMoe1, SchedMoe<true>>(F.lds, 2048, S, E); } } SEAM(11);
    if (IN(12)) { { moe_tables(F); volatile LAS int* tb = (volatile LAS int*)(F.lds + LDS_X);
        SchedMoe<false> S{F.G, F.bx, 8, 2048, 2048, ((PROBE_DUP >> 12) & 1) ? 2 : 1, (const char*)(ws + WS_ACT), (const char*)(ws + WS_WDN), (const int*)(ws + WS_LIST), tb}; EpiMoe2 E{F.in[IN_BDN], (const float*)(ws + WS_GATE), (const int*)(ws + WS_LIST), (unsigned char*)(ws + WS_YS), tb};
        pg8::gemm_phase<EpiMoe2, SchedMoe<false>>(F.lds, 2048, S, E); } } SEAM(12);
    if (IN(13)) { DUP2(13, p13_final(F)); }
#undef IN
#undef SEAM
}

extern "C" void kernel_launch(void* const* d_in, const int* in_sizes, int n_in, void* d_out, int out_size, void* d_ws, size_t ws_size, hipStream_t stream) {
    static int grid = 0;
    if (grid == 0) {
        if (n_in != 39 || out_size != NTOK * D || ws_size < WS_END) { fprintf(stderr, "kernel_launch: unexpected shapes: n_in %d out %d ws %zu (need %zu)\n", n_in, out_size, ws_size, (size_t)WS_END); grid = -1; return; }
        int dev = 0, cus = 0, per_cu = 0;
        if (hipGetDevice(&dev) != hipSuccess || hipDeviceGetAttribute(&cus, hipDeviceAttributeMultiprocessorCount, dev) != hipSuccess) { grid = -1; return; }
        if (hipFuncSetAttribute((const void*)fwd, hipFuncAttributeMaxDynamicSharedMemorySize, LDS_BYTES) != hipSuccess) { fprintf(stderr, "kernel_launch: hipFuncSetAttribute failed\n"); grid = -1; return; }
        if (hipOccupancyMaxActiveBlocksPerMultiprocessor(&per_cu, (const void*)fwd, NTHR, LDS_BYTES) != hipSuccess || per_cu < 1) fprintf(stderr, "kernel_launch: occupancy query says %d\n", per_cu);
        (void)hipGetLastError();
        grid = cus;
    }
    if (grid < 0) return;
    if (hipMemsetAsync((char*)d_ws + WS_CTL, 0, CTL_ZERO_BYTES, stream) != hipSuccess) return;
    Args a{};
    for (int i = 0; i < 39; ++i) a.in[i] = (const float*)d_in[i];
    a.out = (float*)d_out; a.ws = (unsigned char*)d_ws;
#ifndef ONE_LAUNCH
#define ONE_LAUNCH 1
#endif
    if (ONE_LAUNCH) { a.ph_lo = 0; a.ph_hi = NPHASE; hipLaunchKernelGGL(fwd, dim3(grid), dim3(NTHR), LDS_BYTES, stream, a); }
    else for (int p = 0; p < NPHASE; ++p) { a.ph_lo = p; a.ph_hi = p + 1; hipLaunchKernelGGL(fwd, dim3(grid), dim3(NTHR), LDS_BYTES, stream, a); }
}
```

```cpp
#include <hip/hip_runtime.h>
#include <cstdio>
#include <cstdint>

#define GAS __attribute__((address_space(1)))
#define LAS __attribute__((address_space(3)))
typedef unsigned short bf16;
typedef short bf16x8 __attribute__((ext_vector_type(8)));
typedef float f32x4 __attribute__((ext_vector_type(4)));
typedef float f32x16 __attribute__((ext_vector_type(16)));
typedef float f32x2 __attribute__((ext_vector_type(2)));
typedef unsigned u32x4 __attribute__((ext_vector_type(4)));
typedef unsigned u32x2 __attribute__((ext_vector_type(2)));
typedef int i32x4 __attribute__((ext_vector_type(4)));
typedef int i32x8 __attribute__((ext_vector_type(8)));

constexpr int D = 2048, NB = 2, SEQ = 16384, NTOK = NB * SEQ, CTX = 256, NCTX = NB * CTX;
constexpr int S5W = 1024, HYW = 1024, INC = 8192, NEXP = 32, TOPK = 4, DEXP = 2048;
constexpr int NCH = 260;
constexpr int LISTCAP = 32768;

constexpr size_t MiB = 1u << 20;
constexpr size_t WS_CTL = 0, CTL_ZERO_BYTES = 1 * MiB;
constexpr size_t WS_MOD = 6 * MiB;
constexpr size_t WS_BBT = 7 * MiB;
constexpr size_t WS_CTT = WS_BBT + 512 * 1024;
constexpr size_t WS_LAM = 8 * MiB;
constexpr size_t WS_RWT = 8 * MiB + 256 * 1024;
constexpr size_t WS_BB2 = 8 * MiB + 512 * 1024;
constexpr size_t WS_WIN = 16 * MiB;
constexpr size_t WS_WGLU = 48 * MiB;
constexpr size_t WS_WBS5 = 50 * MiB;
constexpr size_t WS_WBHY = 54 * MiB;
constexpr size_t WS_WO = 58 * MiB;
constexpr size_t WS_WGU = 66 * MiB;
constexpr size_t WS_WDN = 578 * MiB;
constexpr size_t WS_U = 834 * MiB;
constexpr size_t WS_UCA = 964 * MiB;
constexpr size_t WS_UA = 966 * MiB;
constexpr size_t WS_UH = 1030 * MiB;
constexpr size_t WS_UG = 1222 * MiB;
constexpr size_t WS_E = 1478 * MiB;
constexpr size_t WS_SIN = 1511 * MiB;
constexpr size_t WS_FILT = 1544 * MiB;
constexpr size_t WS_HYS = 1800 * MiB;
constexpr size_t HYS_STRIDE = 768 * 1024;
constexpr size_t WS_YHCM = 1992 * MiB;
constexpr size_t WS_YH = 2056 * MiB;
constexpr size_t WS_Y = 2120 * MiB;
constexpr size_t WS_YA = 2184 * MiB;
constexpr size_t WS_T1 = 2248 * MiB;
constexpr size_t WS_T = 2376 * MiB;
constexpr size_t WS_HM = 2504 * MiB;
constexpr size_t WS_GATE = 2632 * MiB;
constexpr size_t WS_LIST = 2633 * MiB;
constexpr size_t WS_ACT = 2638 * MiB;
constexpr size_t WS_YS = 3182 * MiB;
constexpr size_t WS_H1 = 3694 * MiB;
constexpr size_t WS_HM8 = WS_T1;
constexpr size_t WS_U8 = WS_ACT;
constexpr size_t WS_WIN8 = WS_YS;
constexpr size_t WS_END = 3950 * MiB;
constexpr long long YS_DUMP_OFF = (long long)(2 * MiB) - (long long)WS_YS;

constexpr int CW_TMO = 0;
constexpr int CW_Q4 = 64;
constexpr int CW_P0 = 120;
constexpr int CW_P3 = 112;
constexpr int CW_QT = 96;
constexpr int CW_CNT = 128;
constexpr int CW_BAR = 4096;

constexpr int RING_BYTES = 131072;
constexpr int LDS_X = 131072;
constexpr int MISC_OFF = 147456 - 512;
constexpr int LDS_BYTES = 147456;
constexpr int NWAVES = 8, NTHR = 512;
constexpr int NPHASE = 14;

__device__ __forceinline__ unsigned f2bf(float f) { unsigned u = __builtin_bit_cast(unsigned, f); return (u + 0x7fffu + ((u >> 16) & 1u)) >> 16; }
__device__ __forceinline__ unsigned pk2(float lo, float hi) { return f2bf(lo) | (f2bf(hi) << 16); }
__device__ __forceinline__ float bf2f(unsigned short b) { return __builtin_bit_cast(float, ((unsigned)b) << 16); }
__device__ __forceinline__ float bflo(unsigned w) { return __builtin_bit_cast(float, w << 16); }
__device__ __forceinline__ float bfhi(unsigned w) { return __builtin_bit_cast(float, w & 0xffff0000u); }
typedef __bf16 bf16x2_t __attribute__((ext_vector_type(2)));
__device__ __forceinline__ unsigned cvt_pk_bf16(float lo, float hi) { const f32x2 v = {lo, hi}; const bf16x2_t b = __builtin_convertvector(v, bf16x2_t); return __builtin_bit_cast(unsigned, b); }
__device__ __forceinline__ unsigned pk4_fp8(float a, float b, float c, float d) { unsigned w = 0u; w = (unsigned)__builtin_amdgcn_cvt_pk_fp8_f32(a, b, (int)w, false); w = (unsigned)__builtin_amdgcn_cvt_pk_fp8_f32(c, d, (int)w, true); return w; }
constexpr float Y8SCALE = 8.0f;
constexpr float T8SCALE = 16.0f;
constexpr float W8SCALE = 64.0f;
__device__ __forceinline__ float sigmoidf_(float x) { return __builtin_amdgcn_rcpf(1.0f + __expf(-x)); }
__device__ __forceinline__ float sin_rev(float r) { return __builtin_amdgcn_sinf(__builtin_amdgcn_fractf(r)); }
__device__ __forceinline__ float cos_rev(float r) { return __builtin_amdgcn_cosf(__builtin_amdgcn_fractf(r)); }
__device__ __forceinline__ float wave_sum(float v) {
#pragma unroll
    for (int o = 1; o < 64; o <<= 1) v += __shfl_xor(v, o);
    return v;
}
__device__ __forceinline__ float wave_max(float v) {
#pragma unroll
    for (int o = 1; o < 64; o <<= 1) v = fmaxf(v, __shfl_xor(v, o));
    return v;
}
__device__ __forceinline__ f32x2 cmul(f32x2 a, f32x2 b) { return (f32x2){a.x * b.x - a.y * b.y, a.x * b.y + a.y * b.x}; }
#define LDS_WAIT() asm volatile("s_waitcnt lgkmcnt(0)" ::: "memory")
#define VM_WAIT() asm volatile("s_waitcnt vmcnt(0)" ::: "memory")

namespace pg8 {
constexpr int BM = 256, BK = 64, HALF = 128, HTB = HALF * BK * 2, STAGE_BYTES = 8 * HTB;
__host__ __device__ __forceinline__ int lds_byte(int r, int c) { const int st = (r >> 4) * 2 + (c >> 5), rr = r & 15, cc = c & 31, ob = rr * 64 + cc * 2; return st * 1024 + (ob ^ (((ob >> 9) & 1) << 5)); }
__host__ __device__ __forceinline__ void stage_rc(int b, int& R, int& C) { const int st = b / 1024, sb = b % 1024, swz = sb ^ (((sb >> 9) & 1) << 5); R = (st >> 1) * 16 + swz / 64; C = (st & 1) * 32 + (swz % 64) / 2; }
__host__ __device__ __forceinline__ int perm32(int rho) { const int n = rho >> 4, i = rho & 15; return 8 * (i >> 2) + 4 * n + (i & 3); }

struct Unit { int pm, pn, e, valid; };

template <class Epi, class Sched>
__device__ __forceinline__ void gemm_phase(LAS unsigned char* lds, const int Kel, const Sched& S, const Epi& E) {
    const int tid = threadIdx.x, wid = __builtin_amdgcn_readfirstlane(tid >> 6), lane = tid & 63, wr = wid >> 2, wc = wid & 3, fr = lane & 15, fq = lane >> 4;
    const int K = Epi::FP8 ? (Kel >> 1) : Kel;
    const int nt = K / BK;
    int Rs[2], Cs[2]; unsigned voffB[2];
#pragma unroll
    for (int i = 0; i < 2; ++i) { int R, C; stage_rc(tid * 16 + i * 8192, R, C); Rs[i] = R; Cs[i] = C; const int Rb = Epi::PERM ? ((R & ~31) + perm32(R & 31)) : R; voffB[i] = (unsigned)(Rb * K + C) * 2u; }
    const size_t kstep = (size_t)(BK * 2);
    const size_t hstep = (size_t)HALF * K * 2;
    const unsigned ldsw = (unsigned)wid * 1024u;
    const int aoff = lds_byte(wr * 64 + fr, fq * 8), boff = lds_byte(wc * 32 + fr, fq * 8);
    const int aoff8 = lds_byte(wr * 64 + fr, fq * 16), boff8 = lds_byte(wc * 32 + fr, fq * 16);
#define PG8_SA(b, h) (((b) * 2 + (h)) * HTB)
#define PG8_SB(b, h) ((4 + (b) * 2 + (h)) * HTB)
#define PG8_STAGE(bufoff, gbase, voff) do { _Pragma("unroll") for (int _i = 0; _i < 2; ++_i) \
        __builtin_amdgcn_global_load_lds((const unsigned*)((const char*)(gbase) + (voff)[_i]), (LAS unsigned*)(lds + (bufoff) + ldsw + _i * 8192), 16, 0, 0); } while (0)
#define PG8_LDA(dst, b, h) do { if constexpr (Epi::FP8) { _Pragma("unroll") for (int m = 0; m < 4; ++m) { const i32x4 lo_ = *(const LAS i32x4*)(lds + PG8_SA(b, h) + aoff8 + m * 2048), hi_ = *(const LAS i32x4*)(lds + PG8_SA(b, h) + aoff8 + m * 2048 + 16); dst##8[m] = __builtin_shufflevector(lo_, hi_, 0, 1, 2, 3, 4, 5, 6, 7); } } \
        else { _Pragma("unroll") for (int m = 0; m < 4; ++m) _Pragma("unroll") for (int k = 0; k < 2; ++k) dst[m][k] = *(const LAS bf16x8*)(lds + PG8_SA(b, h) + aoff + m * 2048 + k * 1024); } } while (0)
#define PG8_LDB(dst, b, h) do { if constexpr (Epi::FP8) { _Pragma("unroll") for (int n = 0; n < 2; ++n) { const i32x4 lo_ = *(const LAS i32x4*)(lds + PG8_SB(b, h) + boff8 + n * 2048), hi_ = *(const LAS i32x4*)(lds + PG8_SB(b, h) + boff8 + n * 2048 + 16); dst##8[n] = __builtin_shufflevector(lo_, hi_, 0, 1, 2, 3, 4, 5, 6, 7); } } \
        else { _Pragma("unroll") for (int n = 0; n < 2; ++n) _Pragma("unroll") for (int k = 0; k < 2; ++k) dst[n][k] = *(const LAS bf16x8*)(lds + PG8_SB(b, h) + boff + n * 2048 + k * 1024); } } while (0)
#define PG8_MMA(ai, bj, At, Bt) do { __builtin_amdgcn_s_setprio(1); \
        if constexpr (Epi::FP8) { _Pragma("unroll") for (int m = 0; m < 4; ++m) _Pragma("unroll") for (int n = 0; n < 2; ++n) \
            asm volatile("v_mfma_scale_f32_16x16x128_f8f6f4 %0, %1, %2, %0, %3, %3 op_sel_hi:[0,0,0]" : "+v"(acc[ai][bj][m][n]) : "v"(Bt##8[n]), "v"(At##8[m]), "v"(scl1)); } \
        else { _Pragma("unroll") for (int m = 0; m < 4; ++m) _Pragma("unroll") for (int n = 0; n < 2; ++n) _Pragma("unroll") for (int k = 0; k < 2; ++k) \
        acc[ai][bj][m][n] = Epi::TRANS ? __builtin_amdgcn_mfma_f32_16x16x32_bf16(Bt[n][k], At[m][k], acc[ai][bj][m][n], 0, 0, 0) \
                                       : __builtin_amdgcn_mfma_f32_16x16x32_bf16(At[m][k], Bt[n][k], acc[ai][bj][m][n], 0, 0, 0); } __builtin_amdgcn_s_setprio(0); } while (0)
#define PG8_WAIT_V(n) asm volatile("s_waitcnt vmcnt(" #n ")" ::: "memory")
#define PG8_WAIT_L(n) asm volatile("s_waitcnt lgkmcnt(" #n ")" ::: "memory")
#define PG8_BAR __builtin_amdgcn_s_barrier()
#define PG8_SCHED __builtin_amdgcn_sched_barrier(0)
    Unit cur, nxt; int ui = 0;
    if (!S.next(0, cur)) return;
    f32x4 acc[2][2][4][2];
#pragma unroll
    for (int a = 0; a < 2; ++a)
#pragma unroll
        for (int b = 0; b < 2; ++b)
#pragma unroll
            for (int m = 0; m < 4; ++m)
#pragma unroll
                for (int n = 0; n < 2; ++n) acc[a][b][m][n] = (f32x4){0.f, 0.f, 0.f, 0.f};
    bf16x8 At[4][2], B0[2][2], B1[2][2]; i32x8 At8[4], B08[2], B18[2]; const int scl1 = 0x7F7F7F7F;
    const char* const Ab = S.a_base();
    const char* cB = S.b_base(cur);
    unsigned vC0[2], vC1[2];
#pragma unroll
    for (int i = 0; i < 2; ++i) { vC0[i] = (S.a_row(cur, Rs[i]) * (unsigned)K + (unsigned)Cs[i]) * 2u; vC1[i] = (S.a_row(cur, HALF + Rs[i]) * (unsigned)K + (unsigned)Cs[i]) * 2u; }
    PG8_STAGE(PG8_SB(0, 0), cB, voffB); PG8_STAGE(PG8_SB(0, 1), cB + hstep, voffB); PG8_STAGE(PG8_SA(0, 0), Ab, vC0); PG8_STAGE(PG8_SA(0, 1), Ab, vC1);
    if (wr == 1) PG8_BAR;
    PG8_WAIT_V(2); PG8_BAR;
    PG8_STAGE(PG8_SB(1, 0), cB + kstep, voffB); PG8_STAGE(PG8_SA(1, 0), Ab + kstep, vC0); PG8_STAGE(PG8_SB(1, 1), cB + hstep + kstep, voffB);
    PG8_WAIT_V(6); PG8_BAR;
    for (;;) {
        const bool has_next = S.next(ui + 1, nxt);
        const char* nB = has_next ? S.b_base(nxt) : cB;
        for (int t = 0; t < nt; t += 2) {
            const bool last = (t == nt - 2);
            const char* a1 = Ab + (size_t)(t + 1) * kstep;
            const char* a2 = last ? Ab : Ab + (size_t)(t + 2) * kstep; const char* b2 = last ? nB : cB + (size_t)(t + 2) * kstep;
            const char* a3 = a2 + kstep; const char* b3 = b2 + kstep;
            unsigned vX0[2], vX1[2];
            if (last && has_next) {
#pragma unroll
                for (int i = 0; i < 2; ++i) { vX0[i] = (S.a_row(nxt, Rs[i]) * (unsigned)K + (unsigned)Cs[i]) * 2u; vX1[i] = (S.a_row(nxt, HALF + Rs[i]) * (unsigned)K + (unsigned)Cs[i]) * 2u; }
            } else {
#pragma unroll
                for (int i = 0; i < 2; ++i) { vX0[i] = vC0[i]; vX1[i] = vC1[i]; }
            }
            PG8_LDB(B0, 0, 0); PG8_LDB(B1, 0, 1); PG8_SCHED; PG8_LDA(At, 0, 0); PG8_STAGE(PG8_SA(1, 1), a1, vC1);
            PG8_WAIT_V(8); PG8_WAIT_L(0); PG8_BAR; PG8_MMA(0, 0, At, B0); PG8_MMA(0, 1, At, B1); PG8_BAR; PG8_SCHED;
            PG8_LDA(At, 0, 1); PG8_STAGE(PG8_SB(0, 0), b2, voffB); PG8_STAGE(PG8_SB(0, 1), b2 + hstep, voffB); PG8_STAGE(PG8_SA(0, 0), a2, vX0);
            PG8_WAIT_V(8); PG8_WAIT_L(0); PG8_BAR; PG8_MMA(1, 0, At, B0); PG8_MMA(1, 1, At, B1); PG8_BAR; PG8_SCHED;
            PG8_LDB(B0, 1, 0); PG8_LDB(B1, 1, 1); PG8_SCHED; PG8_LDA(At, 1, 0); PG8_STAGE(PG8_SA(0, 1), a2, vX1);
            PG8_WAIT_V(8); PG8_WAIT_L(0); PG8_BAR; PG8_MMA(0, 0, At, B0); PG8_MMA(0, 1, At, B1); PG8_BAR; PG8_SCHED;
            PG8_LDA(At, 1, 1); PG8_STAGE(PG8_SB(1, 0), b3, voffB); PG8_STAGE(PG8_SB(1, 1), b3 + hstep, voffB); PG8_STAGE(PG8_SA(1, 0), a3, vX0);
            PG8_WAIT_V(8); PG8_WAIT_L(0); PG8_BAR; PG8_MMA(1, 0, At, B0); PG8_MMA(1, 1, At, B1); PG8_BAR; PG8_SCHED;
            if (last) {
#pragma unroll
                for (int i = 0; i < 2; ++i) { vC0[i] = vX0[i]; vC1[i] = vX1[i]; }
            }
        }
        if (wr == 0) PG8_BAR;
        if constexpr (Epi::FP8) asm volatile("s_nop 15\n\ts_nop 15" ::: "memory");
        E(acc, cur, wr, wc, fr, fq);
        if (!has_next) break;
#pragma unroll
        for (int a = 0; a < 2; ++a)
#pragma unroll
            for (int b = 0; b < 2; ++b)
#pragma unroll
                for (int m = 0; m < 4; ++m)
#pragma unroll
                    for (int n = 0; n < 2; ++n) acc[a][b][m][n] = (f32x4){0.f, 0.f, 0.f, 0.f};
        cur = nxt; cB = nB; ++ui;
        if (wr == 1) PG8_BAR;
    }
    PG8_WAIT_V(0);
    PG8_BAR;
#undef PG8_SA
#undef PG8_SB
#undef PG8_STAGE
#undef PG8_LDA
#undef PG8_LDB
#undef PG8_MMA
#undef PG8_WAIT_V
#undef PG8_WAIT_L
#undef PG8_BAR
#undef PG8_SCHED
}
}

#define XB_TMO      128
#define XB_XCNT(j)  (256  + 64 * (j))
#define XB_XSUB(j)  (1280 + 64 * (j))
#define XB_XGEN(j)  (2304 + 64 * (j))
#define XB_TOP      3328
#define XB_TOPGEN   3392
#define XCD_BAR_WORDS 3456
#define XB_SPIN_CAP (1u << 22)
__device__ __forceinline__ unsigned xb_ld(unsigned* p)              { return __hip_atomic_load(p, __ATOMIC_RELAXED, __HIP_MEMORY_SCOPE_AGENT); }
__device__ __forceinline__ unsigned xb_add(unsigned* p, unsigned v) { return __hip_atomic_fetch_add(p, v, __ATOMIC_RELAXED, __HIP_MEMORY_SCOPE_AGENT); }
__device__ __forceinline__ unsigned xb_xcc_id() { return (unsigned)__builtin_amdgcn_s_getreg((3 << 11) | 20) & 0xFu; }
#define XB_SPIN(cond, bar) do { unsigned _sp = 0; while (cond) { __builtin_amdgcn_s_sleep(1); \
    if ((++_sp & 255u) == 0u) { if (xb_ld(&(bar)[XB_TMO])) break; if (_sp > XB_SPIN_CAP) { atomicAdd(&(bar)[XB_TMO], 1u); break; } } } } while (0)
struct XcdBarrier { unsigned* bar; unsigned x; volatile LAS unsigned* st; };
__device__ __forceinline__ XcdBarrier xcd_barrier_post(unsigned* bar, volatile LAS unsigned* st) {
    XcdBarrier b; b.bar = bar; b.x = xb_xcc_id(); b.st = st;
    if (threadIdx.x == 0) (void)xb_add(&bar[XB_XCNT(b.x)], 1u);
    return b;
}
__device__ __forceinline__ void xcd_barrier_complete(unsigned* bar, unsigned x, unsigned& nloc, unsigned& nx) {
    const unsigned G = gridDim.x * gridDim.y * gridDim.z;
    unsigned sum, cnt, mine, sp = 0u;
    for (;;) {
        sum = 0u; cnt = 0u; mine = 0u;
#pragma unroll
        for (unsigned j = 0; j < 16; ++j) { const unsigned c = xb_ld(&bar[XB_XCNT(j)]); sum += c; cnt += (c > 0u) ? 1u : 0u; mine = (j == x) ? c : mine; }
        if (sum == G) break;
        __builtin_amdgcn_s_sleep(1);
        if ((++sp & 255u) == 0u) { if (xb_ld(&bar[XB_TMO])) break; if (sp > XB_SPIN_CAP) { atomicAdd(&bar[XB_TMO], 1u); break; } }
    }
    nloc = mine > 0u ? mine : 1u; nx = cnt > 0u ? cnt : 1u;
}
__device__ __forceinline__ void xcd_barrier(const XcdBarrier& b) {
    asm volatile("s_waitcnt vmcnt(0)" ::: "memory");
    __syncthreads();
    if (threadIdx.x == 0) {
        unsigned* bar = b.bar;
        __builtin_amdgcn_s_waitcnt(0);
        unsigned nloc = b.st[0], nx = b.st[1];
        if (nloc == 0u) { xcd_barrier_complete(bar, b.x, nloc, nx); b.st[0] = nloc; b.st[1] = nx; }
        const unsigned old = xb_add(&bar[XB_XSUB(b.x)], 1u);
        const unsigned gen = old / nloc;
        if (old + 1u == (gen + 1u) * nloc) {
            __builtin_amdgcn_fence(__ATOMIC_RELEASE, "agent");
            asm volatile("s_waitcnt vmcnt(0)" ::: "memory");
            const unsigned og = xb_add(&bar[XB_TOP], 1u);
            const unsigned tg = og / nx;
            if (og + 1u == (tg + 1u) * nx) xb_add(&bar[XB_TOPGEN], 1u);
            else XB_SPIN(xb_ld(&bar[XB_TOPGEN]) == tg, bar);
            __builtin_amdgcn_fence(__ATOMIC_ACQUIRE, "agent");
            xb_add(&bar[XB_XGEN(b.x)], 1u);
            asm volatile("s_waitcnt vmcnt(0)" ::: "memory");
        } else {
            XB_SPIN(xb_ld(&bar[XB_XGEN(b.x)]) == gen, bar);
            __builtin_amdgcn_fence(__ATOMIC_ACQUIRE, "agent");
            asm volatile("s_waitcnt vmcnt(0)" ::: "memory");
        }
    }
    __syncthreads();
}

struct Args { const float* in[39]; float* out; unsigned char* ws; int ph_lo, ph_hi; };
struct Frame {
    LAS unsigned char* lds;
    int tid, lane, wave, G, bx;
    const float* const* in; float* out; unsigned char* ws;
    GAS unsigned* ctl;
};
#define IN_X 0
#define IN_C 1
#define IN_CTX 2
#define IN_CCTX 3
#define IN_WADA 4
#define IN_BADA 5
#define IN_N1G 6
#define IN_N2G 7
#define IN_WIN 8
#define IN_LRE 9
#define IN_LIM 10
#define IN_LDT 11
#define IN_BRE 12
#define IN_BIM 13
#define IN_CRE 14
#define IN_CIM 15
#define IN_S5D 16
#define IN_WGLU 17
#define IN_HSW 18
#define IN_HW1 19
#define IN_HB1 20
#define IN_HF1 21
#define IN_HW2 22
#define IN_HB2 23
#define IN_HF2 24
#define IN_HW3 25
#define IN_HB3 26
#define IN_HDEC 27
#define IN_HBIAS 28
#define IN_WBS5 29
#define IN_WBHY 30
#define IN_WO 31
#define IN_RW 32
#define IN_RB 33
#define IN_WGU 34
#define IN_BGU 35
#define IN_WDN 36
#define IN_BDN 37
#define IN_FG 38

__device__ __forceinline__ void seam_publish(Frame& F, int cw) {
    asm volatile("s_waitcnt vmcnt(0)" ::: "memory");
    __syncthreads();
    if (F.tid == 0) { __builtin_amdgcn_fence(__ATOMIC_RELEASE, "agent"); asm volatile("s_waitcnt vmcnt(0)" ::: "memory"); (void)xb_add((unsigned*)(F.ctl + cw), 1u); }
}
__device__ __forceinline__ void seam_wait(Frame& F, int cw) {
    if (F.tid == 0) { unsigned* bar = (unsigned*)(F.ctl + CW_BAR);
        XB_SPIN(xb_ld((unsigned*)(F.ctl + cw)) < (unsigned)F.G, bar);
        __builtin_amdgcn_fence(__ATOMIC_ACQUIRE, "agent"); asm volatile("s_waitcnt vmcnt(0)" ::: "memory"); }
    __syncthreads();
}
__device__ __forceinline__ void p0_adaln_item(Frame& F, int cb) {
    LAS float* sl = (LAS float*)F.lds;
    const float* c = F.in[IN_C]; const float* cc = F.in[IN_CCTX]; const float* W = F.in[IN_WADA];
    for (int i = F.tid; i < 3 * 2048; i += NTHR) { const int v = i >> 11, k = i & 2047; const float cv = (v < 2) ? c[v * 2048 + k] : cc[k]; sl[i] = cv * sigmoidf_(cv); }
    __syncthreads();
    const int col = F.tid % 48, ks = F.tid / 48;
    float a0 = 0.f, a1 = 0.f, a2 = 0.f;
    if (ks < 10) { const float* wp = W + 48 * cb + col;
#pragma unroll 16
        for (int j = 0; j < 205; ++j) { const int k = ks + 10 * j; if (k < 2048) { const float w = wp[(size_t)k * 12288]; a0 += sl[k] * w; a1 += sl[2048 + k] * w; a2 += sl[4096 + k] * w; } } }
    LAS float* red = sl + 6144;
    if (ks < 10) { red[(ks * 48 + col) * 3 + 0] = a0; red[(ks * 48 + col) * 3 + 1] = a1; red[(ks * 48 + col) * 3 + 2] = a2; }
    __syncthreads();
    if (F.tid < 144) { const int v = F.tid / 48, cl = F.tid % 48; float sacc = 0.f;
#pragma unroll
        for (int q = 0; q < 10; ++q) sacc += red[(q * 48 + cl) * 3 + v];
        ((float*)(F.ws + WS_MOD))[v * 12288 + 48 * cb + cl] = sacc + F.in[IN_BADA][48 * cb + cl]; }
    __syncthreads();
}
__device__ __forceinline__ void p0_filt_item(Frame& F, int tb) {
    LAS float* ft = (LAS float*)F.lds;
    LAS float* h1 = ft + 64 * 36;
    LAS float* h2 = h1 + 64 * 65;
    const int t0 = tb * 64, tl = F.tid >> 3, q = F.tid & 7; const float tf = (float)(t0 + tl);
    for (int f = q; f < 33; f += 8) {
        float v;
        if (f == 0) v = tf * (1.0f / 16383.0f);
        else { const int bi = (f - 1) & 15; const float band = 1e-4f + (float)bi * ((15.0f - 1e-4f) / 15.0f); const float rev = tf * band * (1.0f / 16384.0f);
               v = (f <= 16) ? cos_rev(rev) : -sin_rev(rev); }
        ft[tl * 36 + f] = v;
    }
    LAS float* w1s = ft + 13312; LAS float* w2s = w1s + 33 * 64;
    for (int i = F.tid; i < 33 * 64; i += NTHR) w1s[i] = F.in[IN_HW1][i];
    for (int i = F.tid; i < 64 * 64; i += NTHR) w2s[i] = F.in[IN_HW2][i];
    __syncthreads();
    { const float* b1 = F.in[IN_HB1]; const float* f1 = F.in[IN_HF1]; float a[8];
#pragma unroll
      for (int jj = 0; jj < 8; ++jj) a[jj] = b1[q * 8 + jj];
#pragma unroll 11
      for (int f = 0; f < 33; ++f) { const float xv = ft[tl * 36 + f]; const f32x4 wa = *(const LAS f32x4*)(w1s + f * 64 + q * 8), wb = *(const LAS f32x4*)(w1s + f * 64 + q * 8 + 4);
          a[0] += xv * wa.x; a[1] += xv * wa.y; a[2] += xv * wa.z; a[3] += xv * wa.w; a[4] += xv * wb.x; a[5] += xv * wb.y; a[6] += xv * wb.z; a[7] += xv * wb.w; }
#pragma unroll
      for (int jj = 0; jj < 8; ++jj) { const int j = q * 8 + jj; h1[tl * 65 + j] = sin_rev(f1[j] * a[jj] * 0.15915494309189535f); } }
    __syncthreads();
    { const float* b2 = F.in[IN_HB2]; const float* f2 = F.in[IN_HF2]; float a[8];
#pragma unroll
      for (int jj = 0; jj < 8; ++jj) a[jj] = b2[q * 8 + jj];
#pragma unroll 16
      for (int i = 0; i < 64; ++i) { const float xv = h1[tl * 65 + i]; const f32x4 wa = *(const LAS f32x4*)(w2s + i * 64 + q * 8), wb = *(const LAS f32x4*)(w2s + i * 64 + q * 8 + 4);
          a[0] += xv * wa.x; a[1] += xv * wa.y; a[2] += xv * wa.z; a[3] += xv * wa.w; a[4] += xv * wb.x; a[5] += xv * wb.y; a[6] += xv * wb.z; a[7] += xv * wb.w; }
#pragma unroll
      for (int jj = 0; jj < 8; ++jj) { const int j = q * 8 + jj; h2[tl * 64 + j] = sin_rev(f2[j] * a[jj] * 0.15915494309189535f); } }
    __syncthreads();
    LAS unsigned short* hb = (LAS unsigned short*)(h2 + 64 * 64);
    for (int i = F.tid; i < 64 * 64; i += NTHR) hb[(i >> 6) * 72 + (i & 63)] = (unsigned short)f2bf(h2[i]);
    __syncthreads();
    const float* w3 = F.in[IN_HW3]; const float* b3 = F.in[IN_HB3]; const float* dec = F.in[IN_HDEC]; bf16* FILT = (bf16*)(F.ws + WS_FILT);
    const int fr = F.lane & 15, fq = F.lane >> 4;
    bf16x8 af[4][2];
#pragma unroll
    for (int m = 0; m < 4; ++m)
#pragma unroll
        for (int ks = 0; ks < 2; ++ks) af[m][ks] = *(const LAS bf16x8*)(hb + (16 * m + fr) * 72 + 32 * ks + 8 * fq);
#pragma unroll 4
    for (int jt = F.wave; jt < 256; jt += NWAVES) {
        const int j = 16 * jt + fr;
        bf16x8 bfr[2];
#pragma unroll
        for (int ks = 0; ks < 2; ++ks) { float w[8];
#pragma unroll
            for (int e = 0; e < 8; ++e) w[e] = w3[(size_t)(32 * ks + 8 * fq + e) * 4096 + j];
            u32x4 pk; pk.x = pk2(w[0], w[1]); pk.y = pk2(w[2], w[3]); pk.z = pk2(w[4], w[5]); pk.w = pk2(w[6], w[7]); bfr[ks] = __builtin_bit_cast(bf16x8, pk); }
        const float bb = b3[j], dd = fabsf(dec[j]) * (1.0f / 16383.0f);
#pragma unroll
        for (int m = 0; m < 4; ++m) { f32x4 acc = (f32x4){0.f, 0.f, 0.f, 0.f};
#pragma unroll
            for (int ks = 0; ks < 2; ++ks) acc = __builtin_amdgcn_mfma_f32_16x16x32_bf16(af[m][ks], bfr[ks], acc, 0, 0, 0);
            const int tb0 = t0 + 16 * m + 4 * fq; f32x4 o;
#pragma unroll
            for (int e = 0; e < 4; ++e) o[e] = (acc[e] + bb) * __expf(-(float)(tb0 + e) * dd);
            *(u32x2*)(FILT + (size_t)j * SEQ + tb0) = (u32x2){cvt_pk_bf16(o[0], o[1]), cvt_pk_bf16(o[2], o[3])}; }
    }
    __syncthreads();
}
__device__ __forceinline__ void p0_s5tab_item(Frame& F, int item) {
    const int idx = item * NTHR + F.tid; const int d = idx >> 12, g = (idx >> 6) & 63, p = idx & 63, dg = d * 64 + g;
    const float lr = F.in[IN_LRE][dg * 64 + p], li = F.in[IN_LIM][dg * 64 + p], dt = expf(F.in[IN_LDT][dg]);
    const float mag = expf(lr * dt), ang = li * dt; const float lbr = mag * cosf(ang), lbi = mag * sinf(ang);
    const float den = lr * lr + li * li, cr = ((lbr - 1.f) * lr + lbi * li) / den, ci = (lbi * lr - (lbr - 1.f) * li) / den;
    bf16* BBT = (bf16*)(F.ws + WS_BBT); bf16* BB2 = (bf16*)(F.ws + WS_BB2); bf16* CTT = (bf16*)(F.ws + WS_CTT); f32x2* LAM = (f32x2*)(F.ws + WS_LAM);
    const float* bre = F.in[IN_BRE] + (size_t)(dg * 64 + p) * 16; const float* bim = F.in[IN_BIM] + (size_t)(dg * 64 + p) * 16;
    for (int c = 0; c < 16; ++c) { const float br = bre[c], bi = bim[c];
        BBT[(size_t)(dg * 128 + p) * 16 + c] = (bf16)f2bf(cr * br - ci * bi); BBT[(size_t)(dg * 128 + 64 + p) * 16 + c] = (bf16)f2bf(cr * bi + ci * br);
        BB2[(size_t)(dg * 128 + 2 * p) * 16 + c] = (bf16)f2bf(cr * br - ci * bi); BB2[(size_t)(dg * 128 + 2 * p + 1) * 16 + c] = (bf16)f2bf(cr * bi + ci * br); }
    const int k = 2 * p;
    for (int c = 0; c < 16; ++c) { const float cre = F.in[IN_CRE][(size_t)(dg * 16 + c) * 64 + p], cim = F.in[IN_CIM][(size_t)(dg * 16 + c) * 64 + p];
        CTT[(size_t)(dg * 16 + c) * 128 + k] = (bf16)f2bf(cre); CTT[(size_t)(dg * 16 + c) * 128 + k + 1] = (bf16)f2bf(-cim); }
    LAM[dg * 64 + p] = (f32x2){lbr, lbi};
}
__device__ __forceinline__ void p0_transpose_item(const float* W, int K, int N, bf16* WT, LAS unsigned short* scr, int kb, int nb, int lane) {
    const int k0 = 64 * kb, n0 = 128 * nb;
    const float* wp = W + (size_t)(k0 + (lane >> 5)) * N + n0 + 4 * (lane & 31);
#pragma unroll
    for (int half = 0; half < 2; ++half) { f32x4 v[16];
#pragma unroll
        for (int i = 0; i < 16; ++i) v[i] = *(const GAS f32x4*)(wp + (size_t)(32 * half + 2 * i) * N);
#pragma unroll
        for (int i = 0; i < 16; ++i) { const int kk = 32 * half + 2 * i + (lane >> 5); LAS unsigned* d = (LAS unsigned*)(scr + kk * 130 + 4 * (lane & 31)); d[0] = pk2(v[i].x, v[i].y); d[1] = pk2(v[i].z, v[i].w); } }
    LDS_WAIT(); asm volatile("" ::: "memory");
    const int c = lane & 7;
#pragma unroll
    for (int j = 0; j < 16; ++j) { const int r = (lane >> 3) + 8 * j; const LAS unsigned short* sp = scr + (8 * c) * 130 + r;
        u32x4 o; o.x = (unsigned)sp[0] | ((unsigned)sp[130] << 16); o.y = (unsigned)sp[2 * 130] | ((unsigned)sp[3 * 130] << 16); o.z = (unsigned)sp[4 * 130] | ((unsigned)sp[5 * 130] << 16); o.w = (unsigned)sp[6 * 130] | ((unsigned)sp[7 * 130] << 16);
        *(GAS u32x4*)(WT + (size_t)(n0 + r) * K + k0 + 8 * c) = o; }
    LDS_WAIT(); asm volatile("" ::: "memory");
}
__device__ __forceinline__ void p0_transpose_item8(const float* W, int K, int N, unsigned char* WT, LAS unsigned short* scr, int kb, int nb, int lane) {
    const int k0 = 64 * kb, n0 = 128 * nb;
    const float* wp = W + (size_t)(k0 + (lane >> 5)) * N + n0 + 4 * (lane & 31);
#pragma unroll
    for (int half = 0; half < 2; ++half) { f32x4 v[16];
#pragma unroll
        for (int i = 0; i < 16; ++i) v[i] = *(const GAS f32x4*)(wp + (size_t)(32 * half + 2 * i) * N);
#pragma unroll
        for (int i = 0; i < 16; ++i) { const int kk = 32 * half + 2 * i + (lane >> 5); LAS unsigned* d = (LAS unsigned*)(scr + kk * 130 + 4 * (lane & 31)); d[0] = pk2(v[i].x, v[i].y); d[1] = pk2(v[i].z, v[i].w); } }
    LDS_WAIT(); asm volatile("" ::: "memory");
    const int c = lane & 7;
#pragma unroll
    for (int j = 0; j < 16; ++j) { const int r = (lane >> 3) + 8 * j; const LAS unsigned short* sp = scr + (8 * c) * 130 + r;
        u32x2 o; o.x = pk4_fp8(bf2f(sp[0]) * W8SCALE, bf2f(sp[130]) * W8SCALE, bf2f(sp[2 * 130]) * W8SCALE, bf2f(sp[3 * 130]) * W8SCALE);
        o.y = pk4_fp8(bf2f(sp[4 * 130]) * W8SCALE, bf2f(sp[5 * 130]) * W8SCALE, bf2f(sp[6 * 130]) * W8SCALE, bf2f(sp[7 * 130]) * W8SCALE);
        *(GAS u32x2*)(WT + (size_t)(n0 + r) * K + k0 + 8 * c) = o; }
    LDS_WAIT(); asm volatile("" ::: "memory");
}
__device__ __forceinline__ void p0_transpose_item8d(const float* W, int K, int N, unsigned char* WT, LAS unsigned short* scr, int kb, int nb, int lane) {
    const int k0 = 64 * kb, n0 = 128 * nb;
    const float* wp = W + (size_t)(k0 + (lane >> 5)) * N + n0 + 4 * (lane & 31);
    f32x4 v[32];
#pragma unroll
    for (int i = 0; i < 32; ++i) v[i] = *(const GAS f32x4*)(wp + (size_t)(2 * i) * N);
#pragma unroll
    for (int i = 0; i < 32; ++i) { const int kk = 2 * i + (lane >> 5); LAS unsigned* d = (LAS unsigned*)(scr + kk * 130 + 4 * (lane & 31)); d[0] = pk2(v[i].x, v[i].y); d[1] = pk2(v[i].z, v[i].w); }
    LDS_WAIT(); asm volatile("" ::: "memory");
    const int c = lane & 7;
#pragma unroll
    for (int j = 0; j < 16; ++j) { const int r = (lane >> 3) + 8 * j; const LAS unsigned short* sp = scr + (8 * c) * 130 + r;
        u32x2 o; o.x = pk4_fp8(bf2f(sp[0]) * W8SCALE, bf2f(sp[130]) * W8SCALE, bf2f(sp[2 * 130]) * W8SCALE, bf2f(sp[3 * 130]) * W8SCALE);
        o.y = pk4_fp8(bf2f(sp[4 * 130]) * W8SCALE, bf2f(sp[5 * 130]) * W8SCALE, bf2f(sp[6 * 130]) * W8SCALE, bf2f(sp[7 * 130]) * W8SCALE);
        *(GAS u32x2*)(WT + (size_t)(n0 + r) * K + k0 + 8 * c) = o; }
    LDS_WAIT(); asm volatile("" ::: "memory");
}
__device__ __forceinline__ void moe_weight_queue(Frame& F) {
    constexpr int W_GU1 = 32 * 32, W_DN1 = 16 * 32, W_GU = 32 * W_GU1, W_DN = 32 * W_DN1;
    LAS unsigned short* scr = (LAS unsigned short*)(F.lds + F.wave * 16640);
    const int lane = F.lane;
    __syncthreads();
    for (;;) {
        int r0 = 0;
        if (lane == 0) r0 = (int)__hip_atomic_fetch_add((unsigned*)(F.ctl + CW_QT), 4u, __ATOMIC_RELAXED, __HIP_MEMORY_SCOPE_AGENT);
        r0 = __builtin_amdgcn_readfirstlane(r0);
        if (r0 >= W_GU + W_DN) break;
#pragma unroll 1
        for (int sub = 0; sub < 4; ++sub) { const int r = r0 + sub;
            const float* W; unsigned char* WT; int N, kb, nb;
            if (r < W_GU) { const int e = r / W_GU1, q = r % W_GU1; W = F.in[IN_WGU] + (size_t)e * 2048 * 4096; WT = (unsigned char*)(F.ws + WS_WGU) + (size_t)e * 4096 * 2048; N = 4096; kb = q & 31; nb = q >> 5; }
            else { const int rr = r - W_GU; const int e = rr / W_DN1, q = rr % W_DN1; W = F.in[IN_WDN] + (size_t)e * 2048 * 2048; WT = (unsigned char*)(F.ws + WS_WDN) + (size_t)e * 2048 * 2048; N = 2048; kb = q & 31; nb = q >> 5; }
            const int K = 2048, k0 = 64 * kb, n0 = 128 * nb;
            const float* wp = W + (size_t)(k0 + (lane >> 5)) * N + n0 + 4 * (lane & 31);
            f32x4 v[32];
#pragma unroll
            for (int i = 0; i < 32; ++i) v[i] = __builtin_nontemporal_load((const GAS f32x4*)(wp + (size_t)(2 * i) * N));
            LAS unsigned char* sb = (LAS unsigned char*)scr;
#pragma unroll
            for (int i = 0; i < 32; ++i) { const int kk = 2 * i + (lane >> 5); *(LAS unsigned*)(sb + kk * 132 + 4 * (lane & 31)) = pk4_fp8(v[i].x * W8SCALE, v[i].y * W8SCALE, v[i].z * W8SCALE, v[i].w * W8SCALE); }
            LDS_WAIT(); asm volatile("" ::: "memory");
            const int c = lane & 7;
#pragma unroll
            for (int j = 0; j < 16; ++j) { const int rw = (lane >> 3) + 8 * j; const LAS unsigned char* sp = sb + (8 * c) * 132 + rw;
                u32x2 o; o.x = (unsigned)sp[0] | ((unsigned)sp[132] << 8) | ((unsigned)sp[2 * 132] << 16) | ((unsigned)sp[3 * 132] << 24);
                o.y = (unsigned)sp[4 * 132] | ((unsigned)sp[5 * 132] << 8) | ((unsigned)sp[6 * 132] << 16) | ((unsigned)sp[7 * 132] << 24);
                __builtin_nontemporal_store(o, (GAS u32x2*)(WT + (size_t)(n0 + rw) * K + k0 + 8 * c)); }
            LDS_WAIT(); asm volatile("" ::: "memory");
        }
    }
    __syncthreads();
}
__device__ __forceinline__ void p0_prologue(Frame& F) {
    for (int it = F.bx; it < 256; it += F.G) p0_adaln_item(F, it);
    seam_publish(F, CW_P0);
    for (int it = F.bx; it < 256; it += F.G) p0_filt_item(F, it);
    for (int it = F.bx; it < 16; it += F.G) p0_s5tab_item(F, it);
    { const float* rw = F.in[IN_RW]; float* RWT = (float*)(F.ws + WS_RWT);
      for (int i = F.bx * NTHR + F.tid; i < 32 * 2048; i += F.G * NTHR) { const int e = i >> 11, k = i & 2047; RWT[i] = rw[k * 32 + e]; } }
    __syncthreads();
    LAS unsigned short* scr = (LAS unsigned short*)(F.lds + F.wave * 16640);
    constexpr int I_IN = 64 * 4, I_GLU = 8 * 2, I_BS5 = 16 * 2, I_BHY = 16 * 2, I_O = 16 * 4;
    constexpr int NITEMS = I_IN + I_GLU + I_BS5 + I_BHY + I_O;
    const int w = F.wave;
    for (int it = F.bx; it < NITEMS; it += F.G) {
        int r = it;
        if (r < I_IN) { if ((r >> 2) < 32) p0_transpose_item(F.in[IN_WIN], 2048, 8192, (bf16*)(F.ws + WS_WIN), scr, 8 * (r & 3) + w, r >> 2, F.lane);
                        else p0_transpose_item8(F.in[IN_WIN], 2048, 8192, (unsigned char*)(F.ws + WS_WIN8) - (size_t)4096 * 2048, scr, 8 * (r & 3) + w, r >> 2, F.lane); continue; } r -= I_IN;
        if (r < I_GLU) { p0_transpose_item(F.in[IN_WGLU], 1024, 1024, (bf16*)(F.ws + WS_WGLU), scr, 8 * (r & 1) + w, r >> 1, F.lane); continue; } r -= I_GLU;
        if (r < I_BS5) { p0_transpose_item(F.in[IN_WBS5], 1024, 2048, (bf16*)(F.ws + WS_WBS5), scr, 8 * (r & 1) + w, r >> 1, F.lane); continue; } r -= I_BS5;
        if (r < I_BHY) { p0_transpose_item(F.in[IN_WBHY], 1024, 2048, (bf16*)(F.ws + WS_WBHY), scr, 8 * (r & 1) + w, r >> 1, F.lane); continue; } r -= I_BHY;
        { p0_transpose_item8(F.in[IN_WO], 2048, 2048, (unsigned char*)(F.ws + WS_WO), scr, 8 * (r & 3) + w, r >> 2, F.lane); }
    }
}

__device__ __forceinline__ void p1_norm(Frame& F) {
    const int gw = F.bx * NWAVES + F.wave, NGW = F.G * NWAVES;
    const float* MOD = (const float*)(F.ws + WS_MOD); const float* g1n = F.in[IN_N1G];
    bf16* U = (bf16*)(F.ws + WS_U);
    int curv = -1; f32x4 ga[8], sh[8];
    for (int m = gw; m < NTOK + NCTX; m += NGW) {
        const int v = (m < NTOK) ? (m >> 14) : 2;
        if (v != curv) { curv = v;
#pragma unroll
            for (int j = 0; j < 8; ++j) { const int k = 4 * F.lane + 256 * j; const f32x4 g = *(const f32x4*)(g1n + k), sc = *(const f32x4*)(MOD + v * 12288 + 2048 + k); ga[j] = g * (sc + 1.0f); sh[j] = *(const f32x4*)(MOD + v * 12288 + k); } }
        const float* xr = (m < NTOK) ? (F.in[IN_X] + (size_t)m * D) : (F.in[IN_CTX] + (size_t)(m - NTOK) * D);
        f32x4 x[8]; float s = 0.f;
#pragma unroll
        for (int j = 0; j < 8; ++j) { x[j] = *(const GAS f32x4*)(xr + 4 * F.lane + 256 * j); s += (x[j].x * x[j].x + x[j].y * x[j].y) + (x[j].z * x[j].z + x[j].w * x[j].w); }
        const float rstd = 1.0f / sqrtf(wave_sum(s) * (1.0f / D) + 1e-6f);
        GAS u32x2* o = (GAS u32x2*)(U + (size_t)m * D) + F.lane; GAS unsigned* o8 = (GAS unsigned*)(F.ws + WS_U8 + (size_t)m * D) + F.lane;
#pragma unroll
        for (int j = 0; j < 8; ++j) { const f32x4 y = x[j] * rstd * ga[j] + sh[j]; o[64 * j] = (u32x2){pk2(y.x, y.y), pk2(y.z, y.w)}; if (m < NTOK) o8[64 * j] = pk4_fp8(y.x, y.y, y.z, y.w); }
    }
}

struct SchedIn {
    int G, c, nmain, npn, mode, nrep;
    const char* A; const char* Bt;
    __device__ __forceinline__ bool next(int i, pg8::Unit& u) const {
        int L = i * G + c; u.e = 0; u.valid = 256; { const int tot = nmain + (mode == 0 ? 8 : 0); if (nrep > 1 && L >= tot && L < 2 * tot) L -= tot; }
        if (L < nmain) {
            int wgid = L; { const int q = nmain / 8, xcd = wgid % 8, off = wgid / 8; wgid = xcd * q + off; }
            const int nig = 8 * npn, gid = wgid / nig; const int pm = gid * 8 + ((wgid % nig) % 8), pl = (wgid % nig) / 8;
            u.pm = pm; u.pn = (mode == 0) ? pl : (mode == 1 ? pl + 4 : pl + 16); return true;
        }
        if (mode == 0 && L < nmain + 8) { const int q = L - nmain; u.pm = 128 + (q >> 2); u.pn = q & 3; return true; }
        return false;
    }
    __device__ __forceinline__ unsigned a_row(const pg8::Unit& u, int r) const { return (u.pm < 128) ? (unsigned)((u.pm >> 6) * SEQ + r * 64 + (u.pm & 63)) : (unsigned)(NTOK + (u.pm - 128) * 256 + r); }
    __device__ __forceinline__ const char* a_base() const { return A; }
    __device__ __forceinline__ const char* b_base(const pg8::Unit& u) const { return (mode == 2) ? Bt + (size_t)(u.pn - 16) * 256 * D : Bt + (size_t)u.pn * 256 * D * 2; }
};
__device__ __forceinline__ unsigned q8(float s) { return (unsigned)(s * 255.0f + 0.5f); }
struct EpiInG8 {
    static constexpr bool PERM = true, TRANS = true, FP8 = true;
    unsigned char* UG;
    __device__ __forceinline__ void operator()(const f32x4 (&acc)[2][2][4][2], const pg8::Unit& u, int wr, int wc, int fr, int fq) const {
        const int col0 = (u.pn - 16) * 256 + wc * 32 + 8 * fq;
#pragma unroll
        for (int ai = 0; ai < 2; ++ai)
#pragma unroll
            for (int m = 0; m < 4; ++m) { const int r = ai * 128 + wr * 64 + m * 16 + fr; const size_t row = (size_t)((u.pm >> 6) * SEQ + r * 64 + (u.pm & 63));
                unsigned char* rowp = UG + row * 4096 + col0;
#pragma unroll
                for (int bj = 0; bj < 2; ++bj) { f32x4 v0 = acc[ai][bj][m][0] * (1.0f / W8SCALE), v1 = acc[ai][bj][m][1] * (1.0f / W8SCALE);
#pragma unroll
                    for (int j = 0; j < 4; ++j) { v0[j] = sigmoidf_(v0[j]); v1[j] = sigmoidf_(v1[j]); }
                    u32x2 w; w.x = q8(v0[0]) | (q8(v0[1]) << 8) | (q8(v0[2]) << 16) | (q8(v0[3]) << 24); w.y = q8(v1[0]) | (q8(v1[1]) << 8) | (q8(v1[2]) << 16) | (q8(v1[3]) << 24);
                    *(u32x2*)(rowp + bj * 128) = w; } }
    }
};
struct EpiInA {
    static constexpr bool PERM = true, TRANS = true, FP8 = false;
    unsigned char* ws;
    __device__ __forceinline__ void operator()(const f32x4 (&acc)[2][2][4][2], const pg8::Unit& u, int wr, int wc, int fr, int fq) const {
        const bool isctx = u.pm >= 128, isg = u.pn >= 16;
        const size_t boff = isctx ? WS_UCA : (isg ? WS_UG : WS_UA);
        bf16* base = (bf16*)(ws + boff); const size_t ld = isg ? 4096 : S5W; const int colt = isg ? (u.pn - 16) * 256 : u.pn * 256;
        const int col0 = colt + wc * 32 + 8 * fq;
#pragma unroll
        for (int ai = 0; ai < 2; ++ai)
#pragma unroll
            for (int m = 0; m < 4; ++m) { const int r = ai * 128 + wr * 64 + m * 16 + fr;
                const size_t row = isctx ? (size_t)((u.pm - 128) * 256 + r) : (size_t)((u.pm >> 6) * SEQ + r * 64 + (u.pm & 63));
                bf16* rowp = base + row * ld + col0;
#pragma unroll
                for (int bj = 0; bj < 2; ++bj) { f32x4 v0 = acc[ai][bj][m][0], v1 = acc[ai][bj][m][1];
                    if (isg) {
#pragma unroll
                        for (int j = 0; j < 4; ++j) { v0[j] = sigmoidf_(v0[j]); v1[j] = sigmoidf_(v1[j]); } }
                    u32x4 w; w.x = cvt_pk_bf16(v0[0], v0[1]); w.y = cvt_pk_bf16(v0[2], v0[3]); w.z = cvt_pk_bf16(v1[0], v1[1]); w.w = cvt_pk_bf16(v1[2], v1[3]);
                    *(u32x4*)(rowp + bj * 128) = w; } }
    }
};
struct EpiInH {
    static constexpr bool PERM = false, TRANS = false, FP8 = false;
    bf16* UH;
    __device__ __forceinline__ void operator()(const f32x4 (&acc)[2][2][4][2], const pg8::Unit& u, int wr, int wc, int fr, int fq) const {
        const int b = u.pm >> 6, w = u.pm & 63;
#pragma unroll
        for (int bj = 0; bj < 2; ++bj)
#pragma unroll
            for (int n = 0; n < 2; ++n) { const int ch = (u.pn - 4) * 256 + bj * 128 + wc * 32 + n * 16 + fr;
                bf16* cp = UH + ((size_t)(b * 3072 + ch) * SEQ + w * 256);
#pragma unroll
                for (int ai = 0; ai < 2; ++ai)
#pragma unroll
                    for (int m = 0; m < 4; ++m) { const int r0 = ai * 128 + wr * 64 + m * 16 + 4 * fq; const f32x4 v = acc[ai][bj][m][n];
                        *(u32x2*)(cp + r0) = (u32x2){cvt_pk_bf16(v[0], v[1]), cvt_pk_bf16(v[2], v[3])}; } }
    }
};

template <bool PASSB>
__device__ __forceinline__ void s5_pass(Frame& F) {
    constexpr int nk = PASSB ? 256 : 260;
    constexpr int nitems = 2 * nk * 8;
    LAS unsigned char* sl = F.lds + F.wave * 8704;
    const int lane = F.lane, pl = lane & 31, hi = lane >> 5, fr = lane & 15, fq = lane >> 4;
    const bf16* UA = (const bf16*)(F.ws + WS_UA); const bf16* UCA = (const bf16*)(F.ws + WS_UCA);
    const bf16* BBT = (const bf16*)(F.ws + WS_BBT); const bf16* CTT = (const bf16*)(F.ws + WS_CTT); const f32x2* LAM = (const f32x2*)(F.ws + WS_LAM);
    f32x2* EB = (f32x2*)(F.ws + WS_E); const f32x2* SINB = (const f32x2*)(F.ws + WS_SIN); bf16* Y = (bf16*)(F.ws + WS_Y);
    const int s_r = 16 * ((pl >> 2) & 1) + 4 * (pl >> 3) + (pl & 3);
    for (int it = F.bx; it < nitems; it += F.G) {
        const int gq = it & 7, rest = it >> 3; const int b = rest / nk, kk = rest % nk; const int kc = PASSB ? kk + 4 : kk;
        const int g = gq * 8 + F.wave;
        const bf16* urow = (kc < 4) ? (UCA + (size_t)(b * CTX + kc * 64) * S5W + 16 * g) : (UA + (size_t)(b * SEQ + (kc - 4) * 64) * S5W + 16 * g);
        f32x4 yacc[4];
#pragma unroll
        for (int q = 0; q < 4; ++q) yacc[q] = (f32x4){0.f, 0.f, 0.f, 0.f};
#pragma unroll
        for (int d = 0; d < 2; ++d) {
            const int dg = d * 64 + g;
            bf16x8 bb[4];
#pragma unroll
            for (int ni = 0; ni < 4; ++ni) bb[ni] = *(const bf16x8*)(BBT + (size_t)(dg * 128 + 32 * ni + pl) * 16 + 8 * hi);
            bf16x8 ct[4];
            if (PASSB) {
#pragma unroll
                for (int ks = 0; ks < 4; ++ks) ct[ks] = *(const bf16x8*)(CTT + (size_t)(dg * 16 + fr) * 128 + 32 * ks + 8 * fq);
            }
            const f32x2 lamA = LAM[dg * 64 + pl], lamB = LAM[dg * 64 + pl + 32];
            f32x2 l2 = cmul(lamA, lamA), l4 = cmul(l2, l2), l8 = cmul(l4, l4); const f32x2 lam16A = cmul(l8, l8);
            l2 = cmul(lamB, lamB); l4 = cmul(l2, l2); l8 = cmul(l4, l4); const f32x2 lam16B = cmul(l8, l8);
            f32x2 cA = (f32x2){0.f, 0.f}, cB = (f32x2){0.f, 0.f};
            const size_t sidx = ((size_t)((d * 2 + b) * NCH + kc)) * 4096 + g * 64 + pl;
            if (PASSB) { cA = SINB[sidx]; cB = SINB[sidx + 32]; }
#pragma unroll
            for (int sc = 0; sc < 2; ++sc) {
                const int iscan = 32 * sc + s_r; const int tok = (d == 0) ? iscan : 63 - iscan;
                const bf16x8 a = *(const bf16x8*)(urow + (size_t)tok * S5W + 8 * hi);
                f32x16 acc[4];
#pragma unroll
                for (int ni = 0; ni < 4; ++ni) { f32x16 z;
#pragma unroll
                    for (int i = 0; i < 16; ++i) z[i] = 0.f;
                    acc[ni] = __builtin_amdgcn_mfma_f32_32x32x16_bf16(a, bb[ni], z, 0, 0, 0); }
                asm volatile("s_nop 7\n\ts_nop 7" : "+v"(acc[0]), "+v"(acc[1]), "+v"(acc[2]), "+v"(acc[3]) : "v"(a), "v"(bb[0]), "v"(bb[1]), "v"(bb[2]), "v"(bb[3]));
                f32x2 sA = hi ? (f32x2){0.f, 0.f} : cA, sB = hi ? (f32x2){0.f, 0.f} : cB;
#pragma unroll
                for (int i = 0; i < 16; ++i) {
                    sA = (f32x2){lamA.x * sA.x - lamA.y * sA.y + acc[0][i], lamA.x * sA.y + lamA.y * sA.x + acc[2][i]}; acc[0][i] = sA.x; acc[2][i] = sA.y;
                    sB = (f32x2){lamB.x * sB.x - lamB.y * sB.y + acc[1][i], lamB.x * sB.y + lamB.y * sB.x + acc[3][i]}; acc[1][i] = sB.x; acc[3][i] = sB.y; }
                const f32x2 pA = (f32x2){__shfl_xor(sA.x, 32), __shfl_xor(sA.y, 32)}, pB = (f32x2){__shfl_xor(sB.x, 32), __shfl_xor(sB.y, 32)};
                const f32x2 tA = cmul(lam16A, hi ? pA : sA), tB = cmul(lam16B, hi ? pB : sB);
                const f32x2 e1A = (hi ? sA : pA) + tA, e1B = (hi ? sB : pB) + tB;
                const f32x2 ciA = hi ? pA : (f32x2){0.f, 0.f}, ciB = hi ? pB : (f32x2){0.f, 0.f};
                if (PASSB) {
                    f32x2 wA = cmul(lamA, ciA), wB = cmul(lamB, ciB);
#pragma unroll
                    for (int i = 0; i < 16; ++i) {
                        acc[0][i] += wA.x; acc[2][i] += wA.y; acc[1][i] += wB.x; acc[3][i] += wB.y;
                        *(LAS u32x2*)(sl + (16 * hi + i) * 272 + pl * 8) = (u32x2){cvt_pk_bf16(acc[0][i], acc[2][i]), cvt_pk_bf16(acc[1][i], acc[3][i])};
                        wA = cmul(wA, lamA); wB = cmul(wB, lamB); }
                    bf16x8 bsv[2][4];
#pragma unroll
                    for (int tt = 0; tt < 2; ++tt) {
                        const int rowi = (d == 0) ? (16 * tt + fr) : (16 * tt + 15 - fr);
#pragma unroll
                        for (int ks = 0; ks < 4; ++ks) bsv[tt][ks] = *(const LAS bf16x8*)(sl + rowi * 272 + (32 * ks + 8 * fq) * 2);
                    }
#pragma unroll
                    for (int tt = 0; tt < 2; ++tt) {
                        const int tq = (d == 0) ? (2 * sc + tt) : (3 - 2 * sc - tt);
#pragma unroll
                        for (int ks = 0; ks < 4; ++ks) yacc[tq] = __builtin_amdgcn_mfma_f32_16x16x32_bf16(ct[ks], bsv[tt][ks], yacc[tq], 0, 0, 0);
                    }
                    asm volatile("s_nop 7\n\ts_nop 7" : "+v"(yacc[0]), "+v"(yacc[1]), "+v"(yacc[2]), "+v"(yacc[3]) : "v"(bsv[0][0]), "v"(bsv[0][1]), "v"(bsv[0][2]), "v"(bsv[0][3]), "v"(bsv[1][0]), "v"(bsv[1][1]), "v"(bsv[1][2]), "v"(bsv[1][3]), "v"(ct[0]), "v"(ct[1]), "v"(ct[2]), "v"(ct[3]));
                    asm volatile("s_waitcnt lgkmcnt(0)" ::: "memory");
                }
                cA = e1A; cB = e1B;
            }
            if (!PASSB) { if (hi == 0) { EB[sidx] = cA; EB[sidx + 32] = cB; } }
        }
        if (PASSB) {
            const f32x4 dsk = *(const f32x4*)(F.in[IN_S5D] + 16 * g + 4 * fq);
#pragma unroll
            for (int tq = 0; tq < 4; ++tq) { const int tok = 16 * tq + fr;
                const u32x2 uu = *(const u32x2*)(urow + (size_t)tok * S5W + 4 * fq);
                f32x4 v; v[0] = yacc[tq][0] + bflo(uu.x) * dsk[0]; v[1] = yacc[tq][1] + bfhi(uu.x) * dsk[1]; v[2] = yacc[tq][2] + bflo(uu.y) * dsk[2]; v[3] = yacc[tq][3] + bfhi(uu.y) * dsk[3];
#pragma unroll
                for (int j = 0; j < 4; ++j) { const float x = v[j]; v[j] = x * sigmoidf_(1.5957691216f * (x + 0.044715f * x * x * x)); }
                *(u32x2*)(Y + (size_t)(b * SEQ + (kc - 4) * 64 + tok) * S5W + 16 * g + 4 * fq) = (u32x2){cvt_pk_bf16(v[0], v[1]), cvt_pk_bf16(v[2], v[3])}; }
        }
    }
}
__device__ __forceinline__ void s5_pass_a_simple(Frame& F) {
    constexpr int nitems = 2 * NCH * 8;
    const int lane = F.lane;
    const bf16* UA = (const bf16*)(F.ws + WS_UA); const bf16* UCA = (const bf16*)(F.ws + WS_UCA);
    const bf16* BBT = (const bf16*)(F.ws + WS_BBT); const f32x2* LAM = (const f32x2*)(F.ws + WS_LAM); f32x2* EB = (f32x2*)(F.ws + WS_E);
    for (int it = F.bx; it < nitems; it += F.G) {
        const int gq = it & 7, rest = it >> 3; const int b = rest / NCH, kc = rest % NCH; const int g = gq * 8 + F.wave;
        const bf16* urow = (kc < 4) ? (UCA + (size_t)(b * CTX + kc * 64) * S5W + 16 * g) : (UA + (size_t)(b * SEQ + (kc - 4) * 64) * S5W + 16 * g);
#pragma unroll 1
        for (int d = 0; d < 2; ++d) {
            const int dg = d * 64 + g; const f32x2 lam = LAM[dg * 64 + lane];
            float bre[16], bim[16];
            { const u32x4 r0 = *(const u32x4*)(BBT + (size_t)(dg * 128 + lane) * 16), r1 = *(const u32x4*)(BBT + (size_t)(dg * 128 + lane) * 16 + 8);
              const u32x4 i0 = *(const u32x4*)(BBT + (size_t)(dg * 128 + 64 + lane) * 16), i1 = *(const u32x4*)(BBT + (size_t)(dg * 128 + 64 + lane) * 16 + 8);
              bre[0] = bflo(r0.x); bre[1] = bfhi(r0.x); bre[2] = bflo(r0.y); bre[3] = bfhi(r0.y); bre[4] = bflo(r0.z); bre[5] = bfhi(r0.z); bre[6] = bflo(r0.w); bre[7] = bfhi(r0.w);
              bre[8] = bflo(r1.x); bre[9] = bfhi(r1.x); bre[10] = bflo(r1.y); bre[11] = bfhi(r1.y); bre[12] = bflo(r1.z); bre[13] = bfhi(r1.z); bre[14] = bflo(r1.w); bre[15] = bfhi(r1.w);
              bim[0] = bflo(i0.x); bim[1] = bfhi(i0.x); bim[2] = bflo(i0.y); bim[3] = bfhi(i0.y); bim[4] = bflo(i0.z); bim[5] = bfhi(i0.z); bim[6] = bflo(i0.w); bim[7] = bfhi(i0.w);
              bim[8] = bflo(i1.x); bim[9] = bfhi(i1.x); bim[10] = bflo(i1.y); bim[11] = bfhi(i1.y); bim[12] = bflo(i1.z); bim[13] = bfhi(i1.z); bim[14] = bflo(i1.w); bim[15] = bfhi(i1.w); }
            f32x2 st = (f32x2){0.f, 0.f};
#pragma unroll 4
            for (int i = 0; i < 64; ++i) { const int tok = (d == 0) ? i : 63 - i;
                const u32x4 u0 = *(const u32x4*)(urow + (size_t)tok * S5W), u1 = *(const u32x4*)(urow + (size_t)tok * S5W + 8);
                float u[16]; u[0] = bflo(u0.x); u[1] = bfhi(u0.x); u[2] = bflo(u0.y); u[3] = bfhi(u0.y); u[4] = bflo(u0.z); u[5] = bfhi(u0.z); u[6] = bflo(u0.w); u[7] = bfhi(u0.w);
                u[8] = bflo(u1.x); u[9] = bfhi(u1.x); u[10] = bflo(u1.y); u[11] = bfhi(u1.y); u[12] = bflo(u1.z); u[13] = bfhi(u1.z); u[14] = bflo(u1.w); u[15] = bfhi(u1.w);
                float br = 0.f, bi = 0.f;
#pragma unroll
                for (int c = 0; c < 16; ++c) { br += bre[c] * u[c]; bi += bim[c] * u[c]; }
                st = (f32x2){lam.x * st.x - lam.y * st.y + br, lam.x * st.y + lam.y * st.x + bi}; }
            EB[((size_t)((d * 2 + b) * NCH + kc)) * 4096 + g * 64 + lane] = st;
        }
    }
}
__device__ __forceinline__ void s5_pass_b2(Frame& F) {
    constexpr int nitems = 2 * 256 * 8;
    LAS unsigned char* sl = F.lds + F.wave * 8704;
    const int lane = F.lane, fr = lane & 15, fq = lane >> 4;
    const bf16* UA = (const bf16*)(F.ws + WS_UA); const bf16* BBT = (const bf16*)(F.ws + WS_BBT); const bf16* CTT = (const bf16*)(F.ws + WS_CTT);
    const f32x2* LAM = (const f32x2*)(F.ws + WS_LAM); const f32x2* SINB = (const f32x2*)(F.ws + WS_SIN); bf16* Y = (bf16*)(F.ws + WS_Y);
    for (int it = F.bx; it < nitems; it += F.G) {
        const int gq = it & 7, rest = it >> 3; const int b = rest >> 8, kc = (rest & 255) + 4; const int g = gq * 8 + F.wave;
        const bf16* urow = UA + (size_t)(b * SEQ + (kc - 4) * 64) * S5W + 16 * g;
        f32x4 yacc[4];
#pragma unroll
        for (int q = 0; q < 4; ++q) yacc[q] = (f32x4){0.f, 0.f, 0.f, 0.f};
#pragma unroll
        for (int d = 0; d < 2; ++d) {
            const int dg = d * 64 + g; const f32x2 lam = LAM[dg * 64 + lane];
            float bre[16], bim[16];
            { const u32x4 r0 = *(const u32x4*)(BBT + (size_t)(dg * 128 + lane) * 16), r1 = *(const u32x4*)(BBT + (size_t)(dg * 128 + lane) * 16 + 8);
              const u32x4 i0 = *(const u32x4*)(BBT + (size_t)(dg * 128 + 64 + lane) * 16), i1 = *(const u32x4*)(BBT + (size_t)(dg * 128 + 64 + lane) * 16 + 8);
              bre[0] = bflo(r0.x); bre[1] = bfhi(r0.x); bre[2] = bflo(r0.y); bre[3] = bfhi(r0.y); bre[4] = bflo(r0.z); bre[5] = bfhi(r0.z); bre[6] = bflo(r0.w); bre[7] = bfhi(r0.w);
              bre[8] = bflo(r1.x); bre[9] = bfhi(r1.x); bre[10] = bflo(r1.y); bre[11] = bfhi(r1.y); bre[12] = bflo(r1.z); bre[13] = bfhi(r1.z); bre[14] = bflo(r1.w); bre[15] = bfhi(r1.w);
              bim[0] = bflo(i0.x); bim[1] = bfhi(i0.x); bim[2] = bflo(i0.y); bim[3] = bfhi(i0.y); bim[4] = bflo(i0.z); bim[5] = bfhi(i0.z); bim[6] = bflo(i0.w); bim[7] = bfhi(i0.w);
              bim[8] = bflo(i1.x); bim[9] = bfhi(i1.x); bim[10] = bflo(i1.y); bim[11] = bfhi(i1.y); bim[12] = bflo(i1.z); bim[13] = bfhi(i1.z); bim[14] = bflo(i1.w); bim[15] = bfhi(i1.w); }
            bf16x8 ct[4];
#pragma unroll
            for (int ks = 0; ks < 4; ++ks) ct[ks] = *(const bf16x8*)(CTT + (size_t)(dg * 16 + fr) * 128 + 32 * ks + 8 * fq);
            f32x2 st = SINB[((size_t)((d * 2 + b) * NCH + kc)) * 4096 + g * 64 + lane];
#pragma unroll
            for (int h = 0; h < 2; ++h) {
#pragma unroll 4
                for (int i = 0; i < 32; ++i) { const int sc = 32 * h + i; const int tok = (d == 0) ? sc : 63 - sc;
                    const u32x4 u0 = *(const u32x4*)(urow + (size_t)tok * S5W), u1 = *(const u32x4*)(urow + (size_t)tok * S5W + 8);
                    float u[16]; u[0] = bflo(u0.x); u[1] = bfhi(u0.x); u[2] = bflo(u0.y); u[3] = bfhi(u0.y); u[4] = bflo(u0.z); u[5] = bfhi(u0.z); u[6] = bflo(u0.w); u[7] = bfhi(u0.w);
                    u[8] = bflo(u1.x); u[9] = bfhi(u1.x); u[10] = bflo(u1.y); u[11] = bfhi(u1.y); u[12] = bflo(u1.z); u[13] = bfhi(u1.z); u[14] = bflo(u1.w); u[15] = bfhi(u1.w);
                    float br = 0.f, bi = 0.f;
#pragma unroll
                    for (int c = 0; c < 16; ++c) { br += bre[c] * u[c]; bi += bim[c] * u[c]; }
                    st = (f32x2){lam.x * st.x - lam.y * st.y + br, lam.x * st.y + lam.y * st.x + bi};
                    *(LAS unsigned*)(sl + (tok & 31) * 272 + lane * 4) = cvt_pk_bf16(st.x, st.y); }
                const int t0q = (d == 0) ? 2 * h : 2 * (1 - h);
                bf16x8 bsv[2][4];
#pragma unroll
                for (int tt = 0; tt < 2; ++tt)
#pragma unroll
                    for (int ks = 0; ks < 4; ++ks) bsv[tt][ks] = *(const LAS bf16x8*)(sl + (16 * tt + fr) * 272 + (32 * ks + 8 * fq) * 2);
#pragma unroll
                for (int tt = 0; tt < 2; ++tt)
#pragma unroll
                    for (int ks = 0; ks < 4; ++ks) yacc[t0q + tt] = __builtin_amdgcn_mfma_f32_16x16x32_bf16(ct[ks], bsv[tt][ks], yacc[t0q + tt], 0, 0, 0);
                asm volatile("s_nop 7\n\ts_nop 7" : "+v"(yacc[0]), "+v"(yacc[1]), "+v"(yacc[2]), "+v"(yacc[3]) : "v"(bsv[0][0]), "v"(bsv[0][1]), "v"(bsv[0][2]), "v"(bsv[0][3]), "v"(bsv[1][0]), "v"(bsv[1][1]), "v"(bsv[1][2]), "v"(bsv[1][3]), "v"(ct[0]), "v"(ct[1]), "v"(ct[2]), "v"(ct[3]));
                asm volatile("s_waitcnt lgkmcnt(0)" ::: "memory");
            }
        }
        const f32x4 dsk = *(const f32x4*)(F.in[IN_S5D] + 16 * g + 4 * fq);
#pragma unroll
        for (int tq = 0; tq < 4; ++tq) { const int tok = 16 * tq + fr;
            const u32x2 uu = *(const u32x2*)(urow + (size_t)tok * S5W + 4 * fq);
            f32x4 v; v[0] = yacc[tq][0] + bflo(uu.x) * dsk[0]; v[1] = yacc[tq][1] + bfhi(uu.x) * dsk[1]; v[2] = yacc[tq][2] + bflo(uu.y) * dsk[2]; v[3] = yacc[tq][3] + bfhi(uu.y) * dsk[3];
#pragma unroll
            for (int j = 0; j < 4; ++j) { const float x = v[j]; v[j] = x * sigmoidf_(1.5957691216f * (x + 0.044715f * x * x * x)); }
            *(u32x2*)(Y + (size_t)(b * SEQ + (kc - 4) * 64 + tok) * S5W + 16 * g + 4 * fq) = (u32x2){cvt_pk_bf16(v[0], v[1]), cvt_pk_bf16(v[2], v[3])}; }
    }
}
template <bool PASSB>
__device__ __forceinline__ void s5_pass3(Frame& F) {
    constexpr int nk = PASSB ? 256 : NCH; constexpr int nitems = 2 * nk * 8;
    LAS unsigned char* sl = F.lds + F.wave * 8704;
    const int lane = F.lane, fr = lane & 15, fq = lane >> 4;
    const bf16* UA = (const bf16*)(F.ws + WS_UA); const bf16* UCA = (const bf16*)(F.ws + WS_UCA); const bf16* BB2 = (const bf16*)(F.ws + WS_BB2); const bf16* CTT = (const bf16*)(F.ws + WS_CTT);
    const f32x2* LAM = (const f32x2*)(F.ws + WS_LAM); const f32x2* SINB = (const f32x2*)(F.ws + WS_SIN); f32x2* EB = (f32x2*)(F.ws + WS_E); bf16* Y = (bf16*)(F.ws + WS_Y);
    const bf16x8 zf = (bf16x8){0, 0, 0, 0, 0, 0, 0, 0};
    int curg = -1; bf16x8 af[2][8], ct[2][4]; f32x2 lamv[2]; f32x4 dsk = (f32x4){0.f, 0.f, 0.f, 0.f};
    for (int it = F.bx; it < nitems; it += F.G) {
        const int gq = it & 7, rest = it >> 3; const int b = rest / nk, kk = rest % nk; const int kc = PASSB ? kk + 4 : kk; const int g = gq * 8 + F.wave;
        if (g != curg) { curg = g;
#pragma unroll
            for (int d = 0; d < 2; ++d) { const int dg = d * 64 + g; lamv[d] = LAM[dg * 64 + lane];
#pragma unroll
                for (int nt = 0; nt < 8; ++nt) af[d][nt] = (fq < 2) ? *(const bf16x8*)(BB2 + (size_t)(dg * 128 + 16 * nt + fr) * 16 + 8 * fq) : zf;
                if (PASSB) {
#pragma unroll
                    for (int ks = 0; ks < 4; ++ks) ct[d][ks] = *(const bf16x8*)(CTT + (size_t)(dg * 16 + fr) * 128 + 32 * ks + 8 * fq); } }
            if (PASSB) dsk = *(const f32x4*)(F.in[IN_S5D] + 16 * g + 4 * fq); }
        const bf16* urow = (kc < 4) ? (UCA + (size_t)(b * CTX + kc * 64) * S5W + 16 * g) : (UA + (size_t)(b * SEQ + (kc - 4) * 64) * S5W + 16 * g);
        bf16x8 uf[4];
#pragma unroll
        for (int q = 0; q < 4; ++q) uf[q] = (fq < 2) ? *(const bf16x8*)(urow + (size_t)(16 * q + fr) * S5W + 8 * fq) : zf;
        u32x2 uu[4];
        if (PASSB) {
#pragma unroll
            for (int tq = 0; tq < 4; ++tq) uu[tq] = *(const u32x2*)(urow + (size_t)(16 * tq + fr) * S5W + 4 * fq); }
        f32x2 st0[2];
#pragma unroll
        for (int d = 0; d < 2; ++d) st0[d] = PASSB ? SINB[((size_t)((d * 2 + b) * NCH + kc)) * 4096 + g * 64 + lane] : (f32x2){0.f, 0.f};
        f32x4 yacc[4];
#pragma unroll
        for (int q = 0; q < 4; ++q) yacc[q] = (f32x4){0.f, 0.f, 0.f, 0.f};
#pragma unroll
        for (int d = 0; d < 2; ++d) {
            const f32x2 lam = lamv[d]; f32x2 st = st0[d];
#pragma unroll
            for (int h = 0; h < 2; ++h) {
                const int T0 = (d == 0) ? 32 * h : 32 * (1 - h);
#pragma unroll
                for (int tt = 0; tt < 2; ++tt)
#pragma unroll
                    for (int nt = 0; nt < 8; ++nt) { const f32x4 dd = __builtin_amdgcn_mfma_f32_16x16x32_bf16(af[d][nt], uf[(T0 >> 4) + tt], (f32x4){0.f, 0.f, 0.f, 0.f}, 0, 0, 0);
                        *(LAS u32x2*)(sl + (16 * tt + fr) * 272 + (16 * nt + 4 * fq) * 2) = (u32x2){cvt_pk_bf16(dd[0], dd[1]), cvt_pk_bf16(dd[2], dd[3])}; }
                asm volatile("s_waitcnt lgkmcnt(0)" ::: "memory");
#pragma unroll 8
                for (int i = 0; i < 32; ++i) { const int r = (d == 0) ? i : 31 - i; LAS unsigned* cell = (LAS unsigned*)(sl + r * 272 + lane * 4);
                    const unsigned w = *cell; const float br = bflo(w), bi = bfhi(w);
                    st = (f32x2){lam.x * st.x - lam.y * st.y + br, lam.x * st.y + lam.y * st.x + bi};
                    if (PASSB) *cell = cvt_pk_bf16(st.x, st.y); }
                if (PASSB) {
                    const int t0q = T0 >> 4;
                    bf16x8 bsv[2][4];
#pragma unroll
                    for (int tt = 0; tt < 2; ++tt)
#pragma unroll
                        for (int ks = 0; ks < 4; ++ks) bsv[tt][ks] = *(const LAS bf16x8*)(sl + (16 * tt + fr) * 272 + (32 * ks + 8 * fq) * 2);
#pragma unroll
                    for (int tt = 0; tt < 2; ++tt)
#pragma unroll
                        for (int ks = 0; ks < 4; ++ks) yacc[t0q + tt] = __builtin_amdgcn_mfma_f32_16x16x32_bf16(ct[d][ks], bsv[tt][ks], yacc[t0q + tt], 0, 0, 0);
                    asm volatile("s_nop 7\n\ts_nop 7" : "+v"(yacc[0]), "+v"(yacc[1]), "+v"(yacc[2]), "+v"(yacc[3]) : "v"(bsv[0][0]), "v"(bsv[0][1]), "v"(bsv[0][2]), "v"(bsv[0][3]), "v"(bsv[1][0]), "v"(bsv[1][1]), "v"(bsv[1][2]), "v"(bsv[1][3]));
                }
                asm volatile("s_waitcnt lgkmcnt(0)" ::: "memory");
            }
            if (!PASSB) EB[((size_t)((d * 2 + b) * NCH + kc)) * 4096 + g * 64 + lane] = st;
        }
        if (PASSB) {
#pragma unroll
            for (int tq = 0; tq < 4; ++tq) { const int tok = 16 * tq + fr;
                f32x4 v; v[0] = yacc[tq][0] + bflo(uu[tq].x) * dsk[0]; v[1] = yacc[tq][1] + bfhi(uu[tq].x) * dsk[1]; v[2] = yacc[tq][2] + bflo(uu[tq].y) * dsk[2]; v[3] = yacc[tq][3] + bfhi(uu[tq].y) * dsk[3];
#pragma unroll
                for (int j = 0; j < 4; ++j) { const float x = v[j]; v[j] = x * sigmoidf_(1.5957691216f * (x + 0.044715f * x * x * x)); }
                *(u32x2*)(Y + (size_t)(b * SEQ + (kc - 4) * 64 + tok) * S5W + 16 * g + 4 * fq) = (u32x2){cvt_pk_bf16(v[0], v[1]), cvt_pk_bf16(v[2], v[3])}; }
        }
    }
}
__device__ __forceinline__ void s5_carry_item(Frame& F, int item) {
    const int idx = item * NTHR + F.tid; const int d = idx >> 13, b = (idx >> 12) & 1, gp = idx & 4095;
    const f32x2 lam = ((const f32x2*)(F.ws + WS_LAM))[d * 4096 + gp];
    f32x2 l = cmul(lam, lam); l = cmul(l, l); l = cmul(l, l); l = cmul(l, l); l = cmul(l, l); l = cmul(l, l);
    const f32x2* EB = (const f32x2*)(F.ws + WS_E) + (size_t)((d * 2 + b) * NCH) * 4096 + gp; f32x2* SB = (f32x2*)(F.ws + WS_SIN) + (size_t)((d * 2 + b) * NCH) * 4096 + gp;
    f32x2 s = (f32x2){0.f, 0.f};
#pragma unroll 1
    for (int st0 = 0; st0 < NCH; st0 += 20) { f32x2 e[20];
#pragma unroll
        for (int j = 0; j < 20; ++j) { const int st = st0 + j; const int kc = (d == 0) ? st : (st < 4 ? 3 - st : NCH + 3 - st); e[j] = EB[(size_t)kc * 4096]; }
#pragma unroll
        for (int j = 0; j < 20; ++j) { const int st = st0 + j; const int kc = (d == 0) ? st : (st < 4 ? 3 - st : NCH + 3 - st); SB[(size_t)kc * 4096] = s; s = cmul(l, s) + e[j]; } }
}

__device__ __forceinline__ int fsw(int i) { return i ^ ((i >> 5) & 7) ^ (((i >> 6) & 3) << 3); }
__host__ __device__ constexpr float w16c(int j) { return j == 0 ? 1.f : j == 1 ? 0.9238795325f : j == 2 ? 0.7071067812f : j == 3 ? 0.3826834324f : j == 4 ? 0.f : j == 5 ? -0.3826834324f : j == 6 ? -0.7071067812f : -0.9238795325f; }
__host__ __device__ constexpr float w16s(int j) { return j == 0 ? 0.f : j == 1 ? 0.3826834324f : j == 2 ? 0.7071067812f : j == 3 ? 0.9238795325f : j == 4 ? 1.f : j == 5 ? 0.9238795325f : j == 6 ? 0.7071067812f : 0.3826834324f; }
__host__ __device__ constexpr int bitrev(int q, int bits) { int r = 0; for (int i = 0; i < bits; ++i) r |= ((q >> i) & 1) << (bits - 1 - i); return r; }
template <int R, bool INV> __device__ __forceinline__ void dft_reg(f32x2 (&x)[R]) {
#pragma unroll
    for (int len = R; len >= 2; len >>= 1) { const int half = len >> 1, step = 16 / len;
#pragma unroll
        for (int b0 = 0; b0 < R; b0 += len)
#pragma unroll
            for (int k = 0; k < half; ++k) { const f32x2 a = x[b0 + k], b = x[b0 + k + half]; x[b0 + k] = a + b; const f32x2 dd = a - b; const int j = k * step;
                if (j == 0) x[b0 + k + half] = dd;
                else if (j == 4) x[b0 + k + half] = INV ? (f32x2){-dd.y, dd.x} : (f32x2){dd.y, -dd.x};
                else { const float c = w16c(j), s = w16s(j); x[b0 + k + half] = INV ? (f32x2){dd.x * c - dd.y * s, dd.x * s + dd.y * c} : (f32x2){dd.x * c + dd.y * s, dd.y * c - dd.x * s}; } } }
}
template <int R, int LOGN, bool INV> __device__ __forceinline__ void fft_pass(LAS f32x2* buf, int tid) {
    constexpr int LOGR = (R == 16) ? 4 : 3, LOGM = LOGN - LOGR, M = 1 << LOGM, NBF = 16384 / R / NTHR;
#pragma unroll 1
    for (int it = 0; it < NBF; ++it) {
        int tl = tid; asm volatile("" : "+v"(tl));
        const int bq = tl + NTHR * it, blk = bq >> LOGM, j = bq & (M - 1), base = (blk << LOGN) + j; const int fb = fsw(base);
#define FADDR(q) (fb ^ (((q) << LOGM) ^ ((((q) << LOGM) >> 5) & 7) ^ (((((q) << LOGM) >> 6) & 3) << 3)))
        f32x2 x[R];
#pragma unroll
        for (int q = 0; q < R; ++q) x[q] = buf[FADDR(q)];
        f32x2 w1 = (f32x2){1.f, 0.f};
        if (LOGM > 0) { const float rev = (float)j * (1.0f / (float)(1 << LOGN)); const float sn = sin_rev(rev); w1 = (f32x2){cos_rev(rev), INV ? sn : -sn}; }
        if (!INV) {
            dft_reg<R, false>(x);
            buf[fb] = x[0]; f32x2 w = w1;
#pragma unroll
            for (int q = 1; q < R; ++q) { buf[FADDR(q)] = (LOGM > 0) ? cmul(x[bitrev(q, LOGR)], w) : x[bitrev(q, LOGR)]; if (LOGM > 0) w = cmul(w, w1); }
        } else {
            if (LOGM > 0) { f32x2 w = w1;
#pragma unroll
                for (int q = 1; q < R; ++q) { x[q] = cmul(x[q], w); w = cmul(w, w1); } }
            dft_reg<R, true>(x);
#pragma unroll
            for (int q = 0; q < R; ++q) buf[FADDR(q)] = x[bitrev(q, LOGR)];
        }
#undef FADDR
    }
    __syncthreads();
}
#ifndef FFT_TEST
#define FFT_TEST 0
#endif
__device__ __forceinline__ void fft_fwd(LAS f32x2* buf, int tid) { if (FFT_TEST & 1) return; fft_pass<16, 14, false>(buf, tid); fft_pass<16, 10, false>(buf, tid); fft_pass<8, 6, false>(buf, tid); fft_pass<8, 3, false>(buf, tid); }
__device__ __forceinline__ void fft_inv(LAS f32x2* buf, int tid) { if (FFT_TEST & 2) return; fft_pass<8, 3, true>(buf, tid); fft_pass<8, 6, true>(buf, tid); fft_pass<16, 10, true>(buf, tid); fft_pass<16, 14, true>(buf, tid); }
__device__ __forceinline__ float block_sum(Frame& F, float v) {
    LAS float* red = (LAS float*)(F.lds + LDS_X);
    v = wave_sum(v); __syncthreads(); if (F.lane == 0) red[F.wave] = v; __syncthreads();
    float s = 0.f;
#pragma unroll
    for (int w = 0; w < NWAVES; ++w) s += red[w];
    return s;
}
__device__ __forceinline__ float sconv(const bf16* UH, int b, int ch, int t, float w0, float w1, float w2) {
    const bf16* p = UH + (size_t)(b * 3072 + ch) * SEQ;
    const int tm = t > 0 ? t - 1 : 0, tp = t < SEQ - 1 ? t + 1 : SEQ - 1;
    const float xm = bf2f(p[tm]), x0 = bf2f(p[t]), xp = bf2f(p[tp]);
    return w0 * (t > 0 ? xm : 0.f) + w1 * x0 + w2 * (t < SEQ - 1 ? xp : 0.f);
}
#define HY_UNPK(w) ((f32x2){bflo(w), bfhi(w)})
template <bool INV, class LD, class ST>
__device__ __forceinline__ void fft_edge_pass(LAS f32x2* buf, int tid, LD& ld, ST& st) {
    constexpr int R = 16, LOGN = 14, LOGM = 10;
#pragma unroll
    for (int it = 0; it < 2; ++it) {
        int tl = tid; asm volatile("" : "+v"(tl));
        const int j = tl + NTHR * it; const int fb = fsw(j);
        f32x2 x[R];
#pragma unroll
        for (int q = 0; q < R; ++q) x[q] = ld(2 * q + it, j + (q << LOGM), fb + (q << LOGM));
        const float rev = (float)j * (1.0f / 16384.0f); const float sn = sin_rev(rev); const f32x2 w1 = (f32x2){cos_rev(rev), INV ? sn : -sn};
        if (!INV) {
            dft_reg<R, false>(x);
            st(it, j, fb, x[0]); f32x2 w = w1;
#pragma unroll
            for (int q = 1; q < R; ++q) { st(2 * q + it, j + (q << LOGM), fb + (q << LOGM), cmul(x[bitrev(q, 4)], w)); w = cmul(w, w1); }
        } else {
            f32x2 w = w1;
#pragma unroll
            for (int q = 1; q < R; ++q) { x[q] = cmul(x[q], w); w = cmul(w, w1); }
            dft_reg<R, true>(x);
#pragma unroll
            for (int q = 0; q < R; ++q) st(2 * q + it, j + (q << LOGM), fb + (q << LOGM), x[bitrev(q, 4)]);
        }
        __builtin_amdgcn_sched_barrier(0);
    }
}
__device__ __forceinline__ void fft_last_to_ks(LAS f32x2* buf, int tid, unsigned* KS, float scale) {
#pragma unroll 1
    for (int it = 0; it < 4; ++it) { int tl = tid; asm volatile("" : "+v"(tl)); const int b = tl + NTHR * it; const int fb = fsw(8 * b);
        f32x2 x[8];
#pragma unroll
        for (int q = 0; q < 8; ++q) x[q] = buf[fb ^ q];
        dft_reg<8, false>(x);
        u32x4 o0, o1; f32x2 v;
        v = x[bitrev(0, 3)] * scale; o0.x = cvt_pk_bf16(v.x, v.y); v = x[bitrev(1, 3)] * scale; o0.y = cvt_pk_bf16(v.x, v.y); v = x[bitrev(2, 3)] * scale; o0.z = cvt_pk_bf16(v.x, v.y); v = x[bitrev(3, 3)] * scale; o0.w = cvt_pk_bf16(v.x, v.y);
        v = x[bitrev(4, 3)] * scale; o1.x = cvt_pk_bf16(v.x, v.y); v = x[bitrev(5, 3)] * scale; o1.y = cvt_pk_bf16(v.x, v.y); v = x[bitrev(6, 3)] * scale; o1.z = cvt_pk_bf16(v.x, v.y); v = x[bitrev(7, 3)] * scale; o1.w = cvt_pk_bf16(v.x, v.y);
        *(GAS u32x4*)(KS + 8 * b) = o0; *(GAS u32x4*)(KS + 8 * b + 4) = o1; }
}
__device__ __forceinline__ void fft_mid_mul(LAS f32x2* buf, int tid, const unsigned* KS) {
#pragma unroll 2
    for (int it = 0; it < 4; ++it) { int tl = tid; asm volatile("" : "+v"(tl)); const int b = tl + NTHR * it; const int fb = fsw(8 * b);
        const u32x4 k0 = *(const GAS u32x4*)(KS + 8 * b), k1 = *(const GAS u32x4*)(KS + 8 * b + 4);
        f32x2 x[8], y[8];
#pragma unroll
        for (int q = 0; q < 8; ++q) x[q] = buf[fb ^ q];
        dft_reg<8, false>(x);
        y[0] = cmul(x[bitrev(0, 3)], HY_UNPK(k0.x)); y[1] = cmul(x[bitrev(1, 3)], HY_UNPK(k0.y)); y[2] = cmul(x[bitrev(2, 3)], HY_UNPK(k0.z)); y[3] = cmul(x[bitrev(3, 3)], HY_UNPK(k0.w));
        y[4] = cmul(x[bitrev(4, 3)], HY_UNPK(k1.x)); y[5] = cmul(x[bitrev(5, 3)], HY_UNPK(k1.y)); y[6] = cmul(x[bitrev(6, 3)], HY_UNPK(k1.z)); y[7] = cmul(x[bitrev(7, 3)], HY_UNPK(k1.w));
        dft_reg<8, true>(y);
#pragma unroll
        for (int q = 0; q < 8; ++q) buf[fb ^ q] = y[bitrev(q, 3)]; }
    __syncthreads();
}
struct HyStLds { LAS f32x2* buf; __device__ __forceinline__ void operator()(int, int, int addr, f32x2 v) { buf[addr] = v; } };
struct HyLdLds { LAS f32x2* buf; __device__ __forceinline__ f32x2 operator()(int, int, int addr) { return buf[addr]; } };
struct HyLdKc { const bf16* f0; const bf16* f1; float part; __device__ __forceinline__ f32x2 operator()(int, int t, int) { const float a0 = bf2f(f0[t]), r1 = (t == 0) ? 0.f : bf2f(f1[SEQ - t]); part += fabsf(a0) + fabsf(r1); return (f32x2){a0 + r1, 0.f}; } };
struct HyLdKn { const bf16* f0; const bf16* f1; __device__ __forceinline__ f32x2 operator()(int, int t, int) { const float a0 = bf2f(f0[t]), r1 = (t == 0) ? 0.f : bf2f(f1[SEQ - t]); const float rev = (float)t * (1.0f / 32768.0f), v = a0 - r1; return (f32x2){v * cos_rev(rev), v * sin_rev(rev)}; } };
struct HyLdZ { const unsigned* z; __device__ __forceinline__ f32x2 operator()(int k, int, int) { return HY_UNPK(z[k]); } };
struct HyLdZpsi { const unsigned* z; __device__ __forceinline__ f32x2 operator()(int k, int t, int) { const float rev = (float)t * (1.0f / 32768.0f); return cmul(HY_UNPK(z[k]), (f32x2){cos_rev(rev), sin_rev(rev)}); } };
struct HyStYc { unsigned* yc; __device__ __forceinline__ void operator()(int k, int, int, f32x2 v) { const f32x2 w = v * (0.5f / 16384.0f); yc[k] = cvt_pk_bf16(w.x, w.y); } };
struct HyStComb { unsigned* z; const unsigned* yc; float bias;
    __device__ __forceinline__ void operator()(int k, int t, int, f32x2 v) { const float rev = (float)t * (1.0f / 32768.0f);
        const f32x2 yn = cmul(v, (f32x2){cos_rev(rev), -sin_rev(rev)}) * (0.5f / 16384.0f); const f32x2 y = yn + HY_UNPK(yc[k]) + HY_UNPK(z[k]) * bias; z[k] = cvt_pk_bf16(y.x, y.y); } };
template <bool NEG> __device__ __forceinline__ float hy_load_kernel(LAS f32x2* buf, int tid, const bf16* f0, const bf16* f1) {
    float part = 0.f;
#pragma unroll 2
    for (int r = 0; r < 4; ++r) { int tl = tid; asm volatile("" : "+v"(tl)); const int t0 = 8 * (tl + NTHR * r); const int fb = fsw(t0); float a[8], q[8];
        const u32x4 va = *(const GAS u32x4*)(f0 + t0), vr = *(const GAS u32x4*)(f1 + SEQ - t0 - 8); const float r0 = bf2f(f1[t0 > 0 ? SEQ - t0 : 0]);
        a[0] = bflo(va.x); a[1] = bfhi(va.x); a[2] = bflo(va.y); a[3] = bfhi(va.y); a[4] = bflo(va.z); a[5] = bfhi(va.z); a[6] = bflo(va.w); a[7] = bfhi(va.w);
        q[0] = t0 > 0 ? r0 : 0.f; q[1] = bfhi(vr.w); q[2] = bflo(vr.w); q[3] = bfhi(vr.z); q[4] = bflo(vr.z); q[5] = bfhi(vr.y); q[6] = bflo(vr.y); q[7] = bfhi(vr.x);
#pragma unroll
        for (int e = 0; e < 8; ++e) {
            if (!NEG) { part += fabsf(a[e]) + fabsf(q[e]); buf[fb ^ e] = (f32x2){a[e] + q[e], 0.f}; }
            else { const float rev = (float)(t0 + e) * (1.0f / 32768.0f), v = a[e] - q[e]; buf[fb ^ e] = (f32x2){v * cos_rev(rev), v * sin_rev(rev)}; } } }
    return part;
}
template <bool NEG> __device__ __forceinline__ void hy_load_kernel2(LAS f32x2* buf, int tid, const bf16* f0a, const bf16* f1a, const bf16* f0b, const bf16* f1b, float& part0, float& part1) {
#pragma unroll 2
    for (int r = 0; r < 4; ++r) { int tl = tid; asm volatile("" : "+v"(tl)); const int t0 = 8 * (tl + NTHR * r); const int fb = fsw(t0); float a[8], q[8], b[8], p[8];
        const u32x4 va = *(const GAS u32x4*)(f0a + t0), vr = *(const GAS u32x4*)(f1a + SEQ - t0 - 8); const float r0 = bf2f(f1a[t0 > 0 ? SEQ - t0 : 0]);
        const u32x4 vb = *(const GAS u32x4*)(f0b + t0), vs = *(const GAS u32x4*)(f1b + SEQ - t0 - 8); const float s0 = bf2f(f1b[t0 > 0 ? SEQ - t0 : 0]);
        a[0] = bflo(va.x); a[1] = bfhi(va.x); a[2] = bflo(va.y); a[3] = bfhi(va.y); a[4] = bflo(va.z); a[5] = bfhi(va.z); a[6] = bflo(va.w); a[7] = bfhi(va.w);
        q[0] = t0 > 0 ? r0 : 0.f; q[1] = bfhi(vr.w); q[2] = bflo(vr.w); q[3] = bfhi(vr.z); q[4] = bflo(vr.z); q[5] = bfhi(vr.y); q[6] = bflo(vr.y); q[7] = bfhi(vr.x);
        b[0] = bflo(vb.x); b[1] = bfhi(vb.x); b[2] = bflo(vb.y); b[3] = bfhi(vb.y); b[4] = bflo(vb.z); b[5] = bfhi(vb.z); b[6] = bflo(vb.w); b[7] = bfhi(vb.w);
        p[0] = t0 > 0 ? s0 : 0.f; p[1] = bfhi(vs.w); p[2] = bflo(vs.w); p[3] = bfhi(vs.z); p[4] = bflo(vs.z); p[5] = bfhi(vs.y); p[6] = bflo(vs.y); p[7] = bfhi(vs.x);
#pragma unroll
        for (int e = 0; e < 8; ++e) {
            if (!NEG) { part0 += fabsf(a[e]) + fabsf(q[e]); part1 += fabsf(b[e]) + fabsf(p[e]); buf[fb ^ e] = (f32x2){a[e] + q[e], b[e] + p[e]}; }
            else { const float rev = (float)(t0 + e) * (1.0f / 32768.0f), v0 = a[e] - q[e], v1 = b[e] - p[e]; buf[fb ^ e] = cmul((f32x2){v0, v1}, (f32x2){cos_rev(rev), sin_rev(rev)}); } } }
}
template <bool NEG> __device__ __forceinline__ void hy_split_to_ks(LAS f32x2* buf, int tid, unsigned* KS0, unsigned* KS1, float inv0, float inv1) {
    constexpr int S = NEG ? 1 : 0;
#pragma unroll 1
    for (int it = 0; it < 4; ++it) { int tl = tid; asm volatile("" : "+v"(tl)); const int b = tl + NTHR * it;
        const int l = (b >> 7) + 16 * ((b >> 3) & 15) + 256 * (b & 7); const int nl = (S - l) & 2047; const int br = (l > S) ? 1 : 0;
        const int bp = (nl & 15) * 128 + ((nl >> 4) & 15) * 8 + ((nl >> 8) & 7);
        const int fb = fsw(8 * b), fp = fsw(8 * bp);
        unsigned o0[8], o1[8]; const float h0 = 0.5f * inv0, h1 = 0.5f * inv1;
#pragma unroll
        for (int q = 0; q < 8; ++q) { const f32x2 zz = buf[fb ^ q], zp = buf[fp ^ ((-q - br) & 7)];
            o0[q] = cvt_pk_bf16((zz.x + zp.x) * h0, (zz.y - zp.y) * h0); o1[q] = cvt_pk_bf16((zz.y + zp.y) * h1, (zp.x - zz.x) * h1); }
        *(GAS u32x4*)(KS0 + 8 * b) = (u32x4){o0[0], o0[1], o0[2], o0[3]}; *(GAS u32x4*)(KS0 + 8 * b + 4) = (u32x4){o0[4], o0[5], o0[6], o0[7]};
        *(GAS u32x4*)(KS1 + 8 * b) = (u32x4){o1[0], o1[1], o1[2], o1[3]}; *(GAS u32x4*)(KS1 + 8 * b + 4) = (u32x4){o1[4], o1[5], o1[6], o1[7]}; }
}
__device__ __forceinline__ void hy_conv8(const u32x4 v, float hm, float hp, float w0, float w1, float w2, float (&o)[8]) {
    const float x1 = bflo(v.x), x2 = bfhi(v.x), x3 = bflo(v.y), x4 = bfhi(v.y), x5 = bflo(v.z), x6 = bfhi(v.z), x7 = bflo(v.w), x8 = bfhi(v.w);
    o[0] = w0 * hm + w1 * x1 + w2 * x2; o[1] = w0 * x1 + w1 * x2 + w2 * x3; o[2] = w0 * x2 + w1 * x3 + w2 * x4; o[3] = w0 * x3 + w1 * x4 + w2 * x5;
    o[4] = w0 * x4 + w1 * x5 + w2 * x6; o[5] = w0 * x5 + w1 * x6 + w2 * x7; o[6] = w0 * x6 + w1 * x7 + w2 * x8; o[7] = w0 * x7 + w1 * x8 + w2 * hp;
}
__device__ __forceinline__ void hy_load_conv(LAS f32x2* buf, int tid, const bf16* UH, int ch, float w0, float w1, float w2) {
    const bf16* p0 = UH + (size_t)ch * SEQ; const bf16* p1 = UH + (size_t)(3072 + ch) * SEQ;
#pragma unroll 2
    for (int r = 0; r < 4; ++r) { int tl = tid; asm volatile("" : "+v"(tl)); const int t0 = 8 * (tl + NTHR * r); const int fb = fsw(t0);
        const int tm = t0 > 0 ? t0 - 1 : 0, tp = t0 + 8 < SEQ ? t0 + 8 : SEQ - 1;
        const u32x4 va = *(const GAS u32x4*)(p0 + t0), vb = *(const GAS u32x4*)(p1 + t0);
        float am = bf2f(p0[tm]), ap = bf2f(p0[tp]), bm = bf2f(p1[tm]), bp = bf2f(p1[tp]);
        if (t0 == 0) { am = 0.f; bm = 0.f; } if (t0 + 8 >= SEQ) { ap = 0.f; bp = 0.f; }
        float oa[8], ob[8]; hy_conv8(va, am, ap, w0, w1, w2, oa); hy_conv8(vb, bm, bp, w0, w1, w2, ob);
        buf[fb ^ 0] = (f32x2){oa[0], ob[0]}; buf[fb ^ 1] = (f32x2){oa[1], ob[1]}; buf[fb ^ 2] = (f32x2){oa[2], ob[2]}; buf[fb ^ 3] = (f32x2){oa[3], ob[3]};
        buf[fb ^ 4] = (f32x2){oa[4], ob[4]}; buf[fb ^ 5] = (f32x2){oa[5], ob[5]}; buf[fb ^ 6] = (f32x2){oa[6], ob[6]}; buf[fb ^ 7] = (f32x2){oa[7], ob[7]}; }
}
__device__ __forceinline__ void hyena_item(Frame& F, int c) {
    LAS f32x2* buf = (LAS f32x2*)F.lds;
    unsigned* KS = (unsigned*)(F.ws + WS_HYS + (size_t)F.bx * HYS_STRIDE);
    const bf16* FILT = (const bf16*)(F.ws + WS_FILT); const bf16* UH = (const bf16*)(F.ws + WS_UH);
    const int tid = F.tid; const int ft = fsw(tid);
#define FB(k) buf[ft + NTHR * (k)]
    const float* sw = F.in[IN_HSW];
    unsigned z[32], yc[32];
    HyStLds stl{buf}; HyLdLds ldl{buf};
    hy_load_conv(buf, tid, UH, c, sw[c], sw[3072 + c], sw[6144 + c]);
    __syncthreads();
#pragma unroll
    for (int k = 0; k < 32; ++k) { const f32x2 v_ = FB(k); z[k] = cvt_pk_bf16(v_.x, v_.y); }
    { const bf16* f0a = FILT + (size_t)c * SEQ; const bf16* f1a = FILT + (size_t)(2048 + c) * SEQ; const bf16* f0b = FILT + (size_t)(1024 + c) * SEQ; const bf16* f1b = FILT + (size_t)(3072 + c) * SEQ;
      float part0 = 0.f, part1 = 0.f;
      __syncthreads();
      hy_load_kernel2<false>(buf, tid, f0a, f1a, f0b, f1b, part0, part1);
      const float inv0 = 1.0f / (block_sum(F, part0) + 1e-6f); const float inv1 = 1.0f / (block_sum(F, part1) + 1e-6f);
      fft_edge_pass<false>(buf, tid, ldl, stl); __syncthreads();
      fft_pass<16, 10, false>(buf, tid); fft_pass<8, 6, false>(buf, tid); fft_pass<8, 3, false>(buf, tid);
      hy_split_to_ks<false>(buf, tid, KS, KS + 16384, inv0, inv1); __syncthreads();
      { float d0 = 0.f, d1 = 0.f; hy_load_kernel2<true>(buf, tid, f0a, f1a, f0b, f1b, d0, d1); } __syncthreads();
      fft_edge_pass<false>(buf, tid, ldl, stl); __syncthreads();
      fft_pass<16, 10, false>(buf, tid); fft_pass<8, 6, false>(buf, tid); fft_pass<8, 3, false>(buf, tid);
      hy_split_to_ks<true>(buf, tid, KS + 2 * 16384, KS + 3 * 16384, inv0, inv1); __syncthreads(); }
#pragma unroll 1
    for (int o = 0; o < 2; ++o) {
        { HyLdZ ldz{z}; fft_edge_pass<false>(buf, tid, ldz, stl); __syncthreads(); }
        fft_pass<16, 10, false>(buf, tid); fft_pass<8, 6, false>(buf, tid);
        fft_mid_mul(buf, tid, KS + o * 16384);
        fft_pass<8, 6, true>(buf, tid); fft_pass<16, 10, true>(buf, tid);
        { HyStYc styc{yc}; fft_edge_pass<true>(buf, tid, ldl, styc); }
        __syncthreads();
        { HyLdZpsi ldzp{z}; fft_edge_pass<false>(buf, tid, ldzp, stl); __syncthreads(); }
        fft_pass<16, 10, false>(buf, tid); fft_pass<8, 6, false>(buf, tid);
        { const bf16* g0 = UH + (size_t)((o + 1) * 1024 + c) * SEQ + 8 * tid; const bf16* g1 = g0 + (size_t)3072 * SEQ;
          u32x4 t0 = *(const GAS u32x4*)(g0), t1 = *(const GAS u32x4*)(g0 + 4096), t2 = *(const GAS u32x4*)(g0 + 8192), t3 = *(const GAS u32x4*)(g0 + 12288);
          u32x4 t4 = *(const GAS u32x4*)(g1), t5 = *(const GAS u32x4*)(g1 + 4096), t6 = *(const GAS u32x4*)(g1 + 8192), t7 = *(const GAS u32x4*)(g1 + 12288);
          fft_mid_mul(buf, tid, KS + (2 + o) * 16384);
          asm volatile("" :: "v"(t0), "v"(t1), "v"(t2), "v"(t3), "v"(t4), "v"(t5), "v"(t6), "v"(t7)); }
        fft_pass<8, 6, true>(buf, tid); fft_pass<16, 10, true>(buf, tid);
        { HyStComb stc{z, yc, F.in[IN_HBIAS][o * 1024 + c]}; fft_edge_pass<true>(buf, tid, ldl, stc); }
#pragma unroll
        for (int k = 0; k < 32; ++k) FB(k) = HY_UNPK(z[k]);
        { const int xch = (o + 1) * 1024 + c; const float w0 = sw[xch], w1 = sw[3072 + xch], w2 = sw[6144 + xch];
#pragma unroll 8
          for (int k = 0; k < 32; ++k) { const int t = tid + NTHR * k; f32x2 v_ = FB(k); v_.x *= sconv(UH, 0, xch, t, w0, w1, w2); v_.y *= sconv(UH, 1, xch, t, w0, w1, w2); FB(k) = v_; } }
#pragma unroll
        for (int k = 0; k < 32; ++k) { const f32x2 v_ = FB(k); z[k] = cvt_pk_bf16(v_.x, v_.y); }
        __syncthreads();
    }
    bf16* YHCM = (bf16*)(F.ws + WS_YHCM);
#pragma unroll
    for (int k = 0; k < 32; ++k) FB(k) = HY_UNPK(z[k]);
#pragma unroll 8
    for (int k = 0; k < 32; ++k) { const int t = tid + NTHR * k; const f32x2 v_ = FB(k); YHCM[(size_t)c * SEQ + t] = (bf16)f2bf(v_.x); YHCM[(size_t)(1024 + c) * SEQ + t] = (bf16)f2bf(v_.y); }
    __syncthreads();
#undef FB
}
__device__ __forceinline__ void p3_publish(Frame& F) {
    asm volatile("s_waitcnt vmcnt(0)" ::: "memory");
    __syncthreads();
    if (F.tid == 0) { __builtin_amdgcn_fence(__ATOMIC_RELEASE, "agent"); asm volatile("s_waitcnt vmcnt(0)" ::: "memory"); (void)xb_add((unsigned*)(F.ctl + CW_P3), 1u); }
}
__device__ __forceinline__ void p3_wait(Frame& F) {
    if (F.tid == 0) { unsigned* bar = (unsigned*)(F.ctl + CW_BAR);
        XB_SPIN(xb_ld((unsigned*)(F.ctl + CW_P3)) < (unsigned)F.G, bar);
        __builtin_amdgcn_fence(__ATOMIC_ACQUIRE, "agent"); asm volatile("s_waitcnt vmcnt(0)" ::: "memory"); }
    __syncthreads();
}
__device__ __forceinline__ void p4_hyena_carry(Frame& F, int qw) {
    volatile LAS int* qs = (volatile LAS int*)(F.lds + MISC_OFF + 64);
    for (;;) {
        __syncthreads();
        if (F.tid == 0) qs[0] = (int)__hip_atomic_fetch_add((unsigned*)(F.ctl + qw), 1u, __ATOMIC_RELAXED, __HIP_MEMORY_SCOPE_AGENT);
        __syncthreads();
        const int q = qs[0];
        if (q >= 32 + 1024) break;
        if (q < 1024) hyena_item(F, q); else { p3_wait(F); s5_carry_item(F, q - 1024); }
    }
}
__device__ __forceinline__ void yh_transpose(Frame& F) {
    const bf16* YHCM = (const bf16*)(F.ws + WS_YHCM); bf16* YH = (bf16*)(F.ws + WS_YH);
    LAS unsigned short* tl = (LAS unsigned short*)(F.lds + 8 * 8704 + F.wave * (64 * 72 * 2));
    const int gw = F.bx * NWAVES + F.wave, NGW = F.G * NWAVES, lane = F.lane;
    for (int it = gw; it < 2 * 16 * 256; it += NGW) {
        const int mt = it & 255, ct = (it >> 8) & 15, b = it >> 12; const int m0 = mt * 64, c0 = ct * 64;
#pragma unroll
        for (int j = 0; j < 8; ++j) { const int ch = 8 * j + (lane >> 3), mc = (lane & 7) * 8;
            const u32x4 v = *(const GAS u32x4*)(YHCM + (size_t)(b * 1024 + c0 + ch) * SEQ + m0 + mc); *(LAS u32x4*)(tl + ch * 72 + mc) = v; }
        LDS_WAIT(); asm volatile("" ::: "memory");
#pragma unroll
        for (int j = 0; j < 8; ++j) { const int mm = 8 * j + (lane >> 3), cc = (lane & 7) * 8; const int m = m0 + mm, w = m >> 8, r = m & 255;
            u32x4 o; o.x = (unsigned)tl[(cc + 0) * 72 + mm] | ((unsigned)tl[(cc + 1) * 72 + mm] << 16); o.y = (unsigned)tl[(cc + 2) * 72 + mm] | ((unsigned)tl[(cc + 3) * 72 + mm] << 16);
            o.z = (unsigned)tl[(cc + 4) * 72 + mm] | ((unsigned)tl[(cc + 5) * 72 + mm] << 16); o.w = (unsigned)tl[(cc + 6) * 72 + mm] | ((unsigned)tl[(cc + 7) * 72 + mm] << 16);
            *(GAS u32x4*)(YH + (size_t)(b * SEQ + r * 64 + w) * HYW + c0 + cc) = o; }
        LDS_WAIT(); asm volatile("" ::: "memory");
    }
}

struct SchedStd {
    int G, c, npn, K, nrep; const char* A; const char* Bt; int esz = 2;
    __device__ __forceinline__ bool next(int i, pg8::Unit& u) const {
        int L = i * G + c; const int nwg = 128 * npn; u.e = 0; u.valid = 256;
        if (nrep > 1 && L >= nwg) L -= nwg;
        if (L >= nwg) return false;
        int wgid = L; { const int q = nwg / 8, xcd = wgid % 8, off = wgid / 8; wgid = xcd * q + off; }
        const int nig = 8 * npn, gid = wgid / nig; u.pm = gid * 8 + ((wgid % nig) % 8); u.pn = (wgid % nig) / 8; return true;
    }
    __device__ __forceinline__ unsigned a_row(const pg8::Unit& u, int r) const { return (unsigned)(u.pm * 256 + r); }
    __device__ __forceinline__ const char* a_base() const { return A; }
    __device__ __forceinline__ const char* b_base(const pg8::Unit& u) const { return Bt + (size_t)u.pn * 256 * K * esz; }
};
template <int MODE> struct EpiMix {
    static constexpr bool PERM = true, TRANS = true, FP8 = false;
    const bf16* P; const bf16* Q; bf16* O;
    __device__ __forceinline__ void operator()(const f32x4 (&acc)[2][2][4][2], const pg8::Unit& u, int wr, int wc, int fr, int fq) const {
        constexpr int ld = (MODE == 0) ? 1024 : 2048;
        const int col0 = u.pn * 256 + wc * 32 + 8 * fq;
#pragma unroll
        for (int ai = 0; ai < 2; ++ai) {
            u32x4 pv[4][2], qv[4][2];
#pragma unroll
            for (int m = 0; m < 4; ++m) { const size_t row = (size_t)u.pm * 256 + ai * 128 + wr * 64 + m * 16 + fr;
#pragma unroll
                for (int bj = 0; bj < 2; ++bj) { const int col = col0 + bj * 128;
                    if (MODE == 0) pv[m][bj] = *(const u32x4*)(P + row * 1024 + col);
                    else { const u32x2 g8 = *(const u32x2*)((const unsigned char*)P + row * 4096 + (MODE == 2 ? 2048 : 0) + col); pv[m][bj] = (u32x4){g8.x, g8.y, 0u, 0u}; }
                    if (MODE == 2) qv[m][bj] = *(const u32x4*)(Q + row * 2048 + col); } }
#pragma unroll
            for (int m = 0; m < 4; ++m) { const size_t row = (size_t)u.pm * 256 + ai * 128 + wr * 64 + m * 16 + fr;
#pragma unroll
                for (int bj = 0; bj < 2; ++bj) { const int col = col0 + bj * 128; const f32x4 v0 = acc[ai][bj][m][0], v1 = acc[ai][bj][m][1]; float r[8];
                    if (MODE == 0) { const u32x4 y = pv[m][bj];
                        r[0] = bflo(y.x) * sigmoidf_(v0[0]); r[1] = bfhi(y.x) * sigmoidf_(v0[1]); r[2] = bflo(y.y) * sigmoidf_(v0[2]); r[3] = bfhi(y.y) * sigmoidf_(v0[3]);
                        r[4] = bflo(y.z) * sigmoidf_(v1[0]); r[5] = bfhi(y.z) * sigmoidf_(v1[1]); r[6] = bflo(y.w) * sigmoidf_(v1[2]); r[7] = bfhi(y.w) * sigmoidf_(v1[3]); }
                    else { const u32x4 gg = pv[m][bj]; constexpr float q = 1.0f / 255.0f;
                        r[0] = (float)(gg.x & 255u) * q * v0[0]; r[1] = (float)((gg.x >> 8) & 255u) * q * v0[1]; r[2] = (float)((gg.x >> 16) & 255u) * q * v0[2]; r[3] = (float)(gg.x >> 24) * q * v0[3];
                        r[4] = (float)(gg.y & 255u) * q * v1[0]; r[5] = (float)((gg.y >> 8) & 255u) * q * v1[1]; r[6] = (float)((gg.y >> 16) & 255u) * q * v1[2]; r[7] = (float)(gg.y >> 24) * q * v1[3];
                        if (MODE == 2) { const u32x4 t1 = qv[m][bj];
                            r[0] += bflo(t1.x); r[1] += bfhi(t1.x); r[2] += bflo(t1.y); r[3] += bfhi(t1.y); r[4] += bflo(t1.z); r[5] += bfhi(t1.z); r[6] += bflo(t1.w); r[7] += bfhi(t1.w); } }
                    if (MODE == 2) {
                        *(u32x2*)((unsigned char*)O + row * ld + col) = (u32x2){pk4_fp8(r[0] * T8SCALE, r[1] * T8SCALE, r[2] * T8SCALE, r[3] * T8SCALE), pk4_fp8(r[4] * T8SCALE, r[5] * T8SCALE, r[6] * T8SCALE, r[7] * T8SCALE)}; }
                    else { u32x4 w; w.x = cvt_pk_bf16(r[0], r[1]); w.y = cvt_pk_bf16(r[2], r[3]); w.z = cvt_pk_bf16(r[4], r[5]); w.w = cvt_pk_bf16(r[6], r[7]);
                        *(u32x4*)(O + row * ld + col) = w; } } }
        }
    }
};
struct EpiOut {
    static constexpr bool PERM = true, TRANS = true, FP8 = true;
    const float* X; const float* MOD; bf16* H1;
    __device__ __forceinline__ void operator()(const f32x4 (&acc)[2][2][4][2], const pg8::Unit& u, int wr, int wc, int fr, int fq) const {
        const int b = u.pm >> 6; const int c0 = u.pn * 256 + wc * 32 + 8 * fq;
        f32x4 gv[2][2];
#pragma unroll
        for (int bj = 0; bj < 2; ++bj)
#pragma unroll
            for (int n = 0; n < 2; ++n) gv[bj][n] = *(const f32x4*)(MOD + b * 12288 + 2 * 2048 + c0 + bj * 128 + 4 * n) * (1.0f / (W8SCALE * T8SCALE));
#pragma unroll
        for (int ai = 0; ai < 2; ++ai) {
            f32x4 xv[4][2][2];
#pragma unroll
            for (int m = 0; m < 4; ++m) { const size_t off = ((size_t)u.pm * 256 + ai * 128 + wr * 64 + m * 16 + fr) * D + c0;
#pragma unroll
                for (int bj = 0; bj < 2; ++bj)
#pragma unroll
                    for (int n = 0; n < 2; ++n) xv[m][bj][n] = *(const f32x4*)(X + off + bj * 128 + 4 * n); }
#pragma unroll
            for (int m = 0; m < 4; ++m) { const size_t off = ((size_t)u.pm * 256 + ai * 128 + wr * 64 + m * 16 + fr) * D + c0;
#pragma unroll
                for (int bj = 0; bj < 2; ++bj) { const f32x4 v0 = xv[m][bj][0] + gv[bj][0] * acc[ai][bj][m][0], v1 = xv[m][bj][1] + gv[bj][1] * acc[ai][bj][m][1];
                    u32x4 w; w.x = cvt_pk_bf16(v0[0], v0[1]); w.y = cvt_pk_bf16(v0[2], v0[3]); w.z = cvt_pk_bf16(v1[0], v1[1]); w.w = cvt_pk_bf16(v1[2], v1[3]);
                    *(u32x4*)(H1 + off + bj * 128) = w; } }
        }
    }
};

__device__ __forceinline__ float row16_max(float v) {
    v = fmaxf(v, __builtin_bit_cast(float, __builtin_amdgcn_update_dpp(0, __builtin_bit_cast(int, v), 0xB1, 0xf, 0xf, true)));
    v = fmaxf(v, __builtin_bit_cast(float, __builtin_amdgcn_update_dpp(0, __builtin_bit_cast(int, v), 0x4E, 0xf, 0xf, true)));
    v = fmaxf(v, __builtin_bit_cast(float, __builtin_amdgcn_update_dpp(0, __builtin_bit_cast(int, v), 0x141, 0xf, 0xf, true)));
    v = fmaxf(v, __builtin_bit_cast(float, __builtin_amdgcn_update_dpp(0, __builtin_bit_cast(int, v), 0x140, 0xf, 0xf, true)));
    return v;
}
__device__ __forceinline__ void p10_router(Frame& F) {
    const int gw = F.bx * NWAVES + F.wave, NGW = F.G * NWAVES, lane = F.lane;
    const float* MOD = (const float*)(F.ws + WS_MOD); const float* g2n = F.in[IN_N2G]; const float* RWT = (const float*)(F.ws + WS_RWT); const float* rb = F.in[IN_RB];
    const bf16* H1 = (const bf16*)(F.ws + WS_H1); unsigned char* HM8 = (unsigned char*)(F.ws + WS_HM8); float* GATE = (float*)(F.ws + WS_GATE); int* LIST = (int*)(F.ws + WS_LIST);
    LAS float* rs = (LAS float*)(F.lds + F.wave * 64);
    volatile LAS int* lcnt = (volatile LAS int*)(F.lds + 1024); volatile LAS int* lbase = lcnt + 32;
    LAS float* gmt = (LAS float*)(F.lds + 4096); LAS float* sht = gmt + 2 * 2048;
    for (int i = F.tid; i < 2 * 2048; i += NTHR) { const int bb = i >> 11, k = i & 2047; gmt[i] = g2n[k] * (MOD[bb * 12288 + 4 * 2048 + k] + 1.0f); sht[i] = MOD[bb * 12288 + 3 * 2048 + k]; }
    const int nblk = NTOK / 16, ntrips = (nblk + NGW - 1) / NGW;
    for (int tr = 0; tr < ntrips; ++tr) {
        const int blk = gw + NGW * tr; const bool act = blk < nblk;
        if (F.tid < NEXP) lcnt[F.tid] = 0;
        __syncthreads();
        int tke[4], tkp[4]; float tkg[4];
#pragma unroll
        for (int r = 0; r < 4; ++r) { tke[r] = 0; tkp[r] = 0; tkg[r] = 0.f; }
        const int mb = 16 * (act ? blk : 0); const int b = mb >> 14;
        if (act) {
#pragma unroll 1
        for (int rp = 0; rp < 4; ++rp) { const int m0 = mb + 4 * rp;
            f32x4 h[4][8];
#pragma unroll
            for (int rr = 0; rr < 4; ++rr) { const bf16* xr = H1 + (size_t)(m0 + rr) * D;
#pragma unroll
                for (int j = 0; j < 8; ++j) { const u32x2 hb = *(const GAS u32x2*)(xr + 4 * lane + 256 * j); h[rr][j] = (f32x4){bflo(hb.x), bfhi(hb.x), bflo(hb.y), bfhi(hb.y)}; } }
#pragma unroll
            for (int rr = 0; rr < 4; ++rr) { float sq = 0.f;
#pragma unroll
                for (int j = 0; j < 8; ++j) sq += (h[rr][j].x * h[rr][j].x + h[rr][j].y * h[rr][j].y) + (h[rr][j].z * h[rr][j].z + h[rr][j].w * h[rr][j].w);
                const float rstd = 1.0f / sqrtf(wave_sum(sq) * (1.0f / D) + 1e-6f);
                if (lane == 0) rs[4 * rp + rr] = rstd;
                GAS unsigned* o = (GAS unsigned*)(HM8 + (size_t)(m0 + rr) * D) + lane;
#pragma unroll
                for (int j = 0; j < 8; ++j) { const int k = 4 * lane + 256 * j; const f32x4 gm = *(const LAS f32x4*)(gmt + b * 2048 + k), sh = *(const LAS f32x4*)(sht + b * 2048 + k);
                    const f32x4 v = h[rr][j] * rstd * gm + sh; o[64 * j] = pk4_fp8(v.x, v.y, v.z, v.w); } } }
        const int jr = lane & 15, kq = lane >> 4;
        const float rstd = rs[jr];
        const bf16* hrow = H1 + (size_t)(mb + jr) * D + 8 * kq; const LAS float* gp = gmt + b * 2048 + 8 * kq; const LAS float* shp = sht + b * 2048 + 8 * kq;
        const float* w0p = RWT + (size_t)jr * 2048 + 8 * kq; const float* w1p = w0p + 16 * 2048;
        f32x4 acc0 = (f32x4){0.f, 0.f, 0.f, 0.f}, acc1 = (f32x4){0.f, 0.f, 0.f, 0.f};
#pragma unroll 4
        for (int t = 0; t < 64; ++t) { const int ko = 32 * t;
            const u32x4 hb = *(const GAS u32x4*)(hrow + ko);
            const f32x4 a0 = *(const GAS f32x4*)(w0p + ko), a1 = *(const GAS f32x4*)(w0p + ko + 4), c0 = *(const GAS f32x4*)(w1p + ko), c1 = *(const GAS f32x4*)(w1p + ko + 4);
            const f32x4 g0 = *(const LAS f32x4*)(gp + ko), g1 = *(const LAS f32x4*)(gp + ko + 4), t0 = *(const LAS f32x4*)(shp + ko), t1 = *(const LAS f32x4*)(shp + ko + 4);
            float hm[8];
            hm[0] = bflo(hb.x) * rstd * g0.x + t0.x; hm[1] = bfhi(hb.x) * rstd * g0.y + t0.y; hm[2] = bflo(hb.y) * rstd * g0.z + t0.z; hm[3] = bfhi(hb.y) * rstd * g0.w + t0.w;
            hm[4] = bflo(hb.z) * rstd * g1.x + t1.x; hm[5] = bfhi(hb.z) * rstd * g1.y + t1.y; hm[6] = bflo(hb.w) * rstd * g1.z + t1.z; hm[7] = bfhi(hb.w) * rstd * g1.w + t1.w;
            acc0 = __builtin_amdgcn_mfma_f32_16x16x4f32(hm[0], a0.x, acc0, 0, 0, 0); acc1 = __builtin_amdgcn_mfma_f32_16x16x4f32(hm[0], c0.x, acc1, 0, 0, 0);
            acc0 = __builtin_amdgcn_mfma_f32_16x16x4f32(hm[1], a0.y, acc0, 0, 0, 0); acc1 = __builtin_amdgcn_mfma_f32_16x16x4f32(hm[1], c0.y, acc1, 0, 0, 0);
            acc0 = __builtin_amdgcn_mfma_f32_16x16x4f32(hm[2], a0.z, acc0, 0, 0, 0); acc1 = __builtin_amdgcn_mfma_f32_16x16x4f32(hm[2], c0.z, acc1, 0, 0, 0);
            acc0 = __builtin_amdgcn_mfma_f32_16x16x4f32(hm[3], a0.w, acc0, 0, 0, 0); acc1 = __builtin_amdgcn_mfma_f32_16x16x4f32(hm[3], c0.w, acc1, 0, 0, 0);
            acc0 = __builtin_amdgcn_mfma_f32_16x16x4f32(hm[4], a1.x, acc0, 0, 0, 0); acc1 = __builtin_amdgcn_mfma_f32_16x16x4f32(hm[4], c1.x, acc1, 0, 0, 0);
            acc0 = __builtin_amdgcn_mfma_f32_16x16x4f32(hm[5], a1.y, acc0, 0, 0, 0); acc1 = __builtin_amdgcn_mfma_f32_16x16x4f32(hm[5], c1.y, acc1, 0, 0, 0);
            acc0 = __builtin_amdgcn_mfma_f32_16x16x4f32(hm[6], a1.z, acc0, 0, 0, 0); acc1 = __builtin_amdgcn_mfma_f32_16x16x4f32(hm[6], c1.z, acc1, 0, 0, 0);
            acc0 = __builtin_amdgcn_mfma_f32_16x16x4f32(hm[7], a1.w, acc0, 0, 0, 0); acc1 = __builtin_amdgcn_mfma_f32_16x16x4f32(hm[7], c1.w, acc1, 0, 0, 0); }
        const float be0 = rb[jr], be1 = rb[16 + jr];
#pragma unroll
        for (int r = 0; r < 4; ++r) { float va = acc0[r] + be0, vc = acc1[r] + be1; int es[4]; float vs[4];
#pragma unroll
            for (int k = 0; k < 4; ++k) { const float mx = row16_max(fmaxf(va, vc));
                const unsigned long long b0 = __ballot(va == mx), b1 = __ballot(vc == mx); const unsigned m0 = (unsigned)(b0 >> (16 * kq)) & 0xffffu, m1 = (unsigned)(b1 >> (16 * kq)) & 0xffffu;
                const int idx = m0 ? (__ffs((int)m0) - 1) : (16 + __ffs((int)m1) - 1);
                es[k] = idx; vs[k] = mx; if (jr == idx) va = -3.0e38f; if (jr + 16 == idx) vc = -3.0e38f; }
            const float e1 = __expf(vs[1] - vs[0]), e2 = __expf(vs[2] - vs[0]), e3 = __expf(vs[3] - vs[0]); const float inv = 1.0f / (1.0f + e1 + e2 + e3);
            if (jr < 4) { const int ee = jr == 0 ? es[0] : jr == 1 ? es[1] : jr == 2 ? es[2] : es[3]; tke[r] = ee; tkg[r] = (jr == 0 ? 1.0f : jr == 1 ? e1 : jr == 2 ? e2 : e3) * inv;
                tkp[r] = __hip_atomic_fetch_add((LAS int*)(F.lds + 1024) + ee, 1, __ATOMIC_RELAXED, __HIP_MEMORY_SCOPE_WORKGROUP); } }
        }
        __syncthreads();
        if (F.tid < NEXP) { const int cnt = lcnt[F.tid]; int base = 0;
            if (cnt > 0) base = (int)__hip_atomic_fetch_add((unsigned*)(F.ctl + CW_CNT + 64 * F.tid), (unsigned)cnt, __ATOMIC_RELAXED, __HIP_MEMORY_SCOPE_AGENT);
            lbase[F.tid] = base; }
        __syncthreads();
        if (act && (lane & 15) < 4) {
#pragma unroll
            for (int r = 0; r < 4; ++r) { const int slot = (mb + 4 * (lane >> 4) + r) * 4 + (lane & 15); LIST[tke[r] * LISTCAP + lbase[tke[r]] + tkp[r]] = slot; GATE[slot] = tkg[r]; } }
    }
}

__device__ __forceinline__ void moe_tables(Frame& F) {
    volatile LAS int* tb = (volatile LAS int*)(F.lds + LDS_X);
    __syncthreads();
    if (F.tid < NEXP) tb[64 + F.tid] = (int)__hip_atomic_load((unsigned*)(F.ctl + CW_CNT + 64 * F.tid), __ATOMIC_RELAXED, __HIP_MEMORY_SCOPE_AGENT);
    __syncthreads();
    if (F.tid == 0) { int acc = 0; for (int e = 0; e < NEXP; ++e) { const int c = tb[64 + e]; tb[e] = acc; acc += (c + 255) >> 8; } tb[32] = acc; }
    __syncthreads();
}
template <bool GATHER> struct SchedMoe {
    int G, c, npn, N, K, nrep; const char* A; const char* Bt; const int* LIST; volatile LAS int* tb;
    __device__ __forceinline__ bool next(int i, pg8::Unit& u) const {
        int L = i * G + c; { const int tot = tb[32] * npn; if (nrep > 1 && L >= tot) L -= tot; }
        int rt = L / npn, pnq = L % npn;
        if (G == 256 && nrep == 1) {
            const int x = c & 7, j = c >> 3;
            if (npn == 16) { pnq = 4 * (x & 3) + (j & 3); rt = 16 * i + (x >> 2) * 8 + (j >> 2); }
            else           { pnq = 2 * (x & 3) + (j & 1); rt = 32 * i + (x >> 2) * 16 + (j >> 1); }
        }
        if (rt >= tb[32]) return false;
        int e = 0;
        for (int q = 1; q < NEXP; ++q) e += (tb[q] <= rt) ? 1 : 0;
        e = __builtin_amdgcn_readfirstlane(e);
        u.pm = rt; u.pn = pnq; u.e = e; const int left = tb[64 + e] - 256 * (rt - tb[e]); u.valid = left < 256 ? left : 256; return true;
    }
    __device__ __forceinline__ unsigned a_row(const pg8::Unit& u, int r) const {
        if (GATHER) { const int rc = r < u.valid ? r : u.valid - 1; return (unsigned)(LIST[u.e * LISTCAP + (u.pm - tb[u.e]) * 256 + rc] >> 2); }
        return (unsigned)(u.pm * 256 + r);
    }
    __device__ __forceinline__ const char* a_base() const { return A; }
    __device__ __forceinline__ const char* b_base(const pg8::Unit& u) const { return Bt + ((size_t)u.e * N + (size_t)u.pn * 256) * K; }
};
struct EpiMoe1 {
    static constexpr bool PERM = true, TRANS = true, FP8 = true;
    const float* BG; unsigned char* ACT;
    __device__ __forceinline__ void operator()(const f32x4 (&acc)[2][2][4][2], const pg8::Unit& u, int wr, int wc, int fr, int fq) const {
        const int c0 = u.pn * 256 + wc * 32 + 8 * fq;
        f32x4 bv[2][2];
#pragma unroll
        for (int bj = 0; bj < 2; ++bj)
#pragma unroll
            for (int n = 0; n < 2; ++n) bv[bj][n] = *(const f32x4*)(BG + (size_t)u.e * 4096 + c0 + bj * 128 + 4 * n);
#pragma unroll
        for (int ai = 0; ai < 2; ++ai)
#pragma unroll
            for (int m = 0; m < 4; ++m) { const size_t row = (size_t)u.pm * 256 + ai * 128 + wr * 64 + m * 16 + fr;
#pragma unroll
                for (int bj = 0; bj < 2; ++bj) { const f32x4 v0 = acc[ai][bj][m][0] * (1.0f / W8SCALE) + bv[bj][0], v1 = acc[ai][bj][m][1] * (1.0f / W8SCALE) + bv[bj][1]; float a[4];
#pragma unroll
                    for (int j = 0; j < 4; ++j) { const float gl = fminf(j < 2 ? v0[2 * j] : v1[2 * j - 4], 7.0f); const float ln = fminf(fmaxf(j < 2 ? v0[2 * j + 1] : v1[2 * j - 3], -7.0f), 7.0f);
                        a[j] = gl * sigmoidf_(1.702f * gl) * (ln + 1.0f); }
                    *(unsigned*)(ACT + row * DEXP + ((c0 + bj * 128) >> 1)) = pk4_fp8(a[0], a[1], a[2], a[3]); } }
    }
};
struct EpiMoe2 {
    static constexpr bool PERM = true, TRANS = true, FP8 = true;
    const float* BD; const float* GATE; const int* LIST; unsigned char* YS; volatile LAS int* tb;
    __device__ __forceinline__ void operator()(const f32x4 (&acc)[2][2][4][2], const pg8::Unit& u, int wr, int wc, int fr, int fq) const {
        const int c0 = u.pn * 256 + wc * 32 + 8 * fq; const int lbase = u.e * LISTCAP + (u.pm - tb[u.e]) * 256;
        f32x4 bv[2][2];
#pragma unroll
        for (int bj = 0; bj < 2; ++bj)
#pragma unroll
            for (int n = 0; n < 2; ++n) bv[bj][n] = *(const f32x4*)(BD + (size_t)u.e * D + c0 + bj * 128 + 4 * n);
        int slot[2][4]; float gt_[2][4];
#pragma unroll
        for (int ai = 0; ai < 2; ++ai)
#pragma unroll
            for (int m = 0; m < 4; ++m) { const int r = ai * 128 + wr * 64 + m * 16 + fr; slot[ai][m] = LIST[lbase + (r < u.valid ? r : u.valid - 1)]; }
#pragma unroll
        for (int ai = 0; ai < 2; ++ai)
#pragma unroll
            for (int m = 0; m < 4; ++m) gt_[ai][m] = GATE[slot[ai][m]] * Y8SCALE;
#pragma unroll
        for (int ai = 0; ai < 2; ++ai)
#pragma unroll
            for (int m = 0; m < 4; ++m) { const int r = ai * 128 + wr * 64 + m * 16 + fr; const float gt = gt_[ai][m];
                const long long ro = (r < u.valid) ? (long long)slot[ai][m] * D : YS_DUMP_OFF;
#pragma unroll
                for (int bj = 0; bj < 2; ++bj) { const f32x4 v0 = (acc[ai][bj][m][0] * (1.0f / W8SCALE) + bv[bj][0]) * gt, v1 = (acc[ai][bj][m][1] * (1.0f / W8SCALE) + bv[bj][1]) * gt;
                    *(u32x2*)(YS + ro + c0 + bj * 128) = (u32x2){pk4_fp8(v0[0], v0[1], v0[2], v0[3]), pk4_fp8(v1[0], v1[1], v1[2], v1[3])}; } }
    }
};
__device__ __forceinline__ void p13_final(Frame& F) {
    const int gw = F.bx * NWAVES + F.wave, NGW = F.G * NWAVES, lane = F.lane;
    const float* MOD = (const float*)(F.ws + WS_MOD); const float* fg = F.in[IN_FG]; const unsigned char* YS = (const unsigned char*)(F.ws + WS_YS); float* O = F.out;
    f32x4 g2v[8]; int curb = -1;
    for (int m0 = 2 * gw; m0 < NTOK; m0 += 2 * NGW) {
        const int b = m0 >> 14;
        if (b != curb) { curb = b;
#pragma unroll
            for (int j = 0; j < 8; ++j) g2v[j] = *(const f32x4*)(MOD + b * 12288 + 5 * 2048 + 4 * lane + 256 * j) * (1.0f / Y8SCALE); }
        unsigned yv[2][8][4]; u32x2 hv[2][8]; f32x4 fgv[8];
#pragma unroll
        for (int rr = 0; rr < 2; ++rr) { const int m = m0 + rr; const bf16* hr = (const bf16*)(F.ws + WS_H1) + (size_t)m * D;
#pragma unroll
            for (int j = 0; j < 8; ++j) { const int k = 4 * lane + 256 * j;
#pragma unroll
                for (int q = 0; q < 4; ++q) yv[rr][j][q] = *(const GAS unsigned*)(YS + (size_t)(m * 4 + q) * D + k);
                hv[rr][j] = *(const GAS u32x2*)(hr + k); } }
#pragma unroll
        for (int j = 0; j < 8; ++j) fgv[j] = *(const f32x4*)(fg + 4 * lane + 256 * j);
        f32x4 h[2][8]; float rstd[2];
#pragma unroll
        for (int rr = 0; rr < 2; ++rr) { float s = 0.f;
#pragma unroll
            for (int j = 0; j < 8; ++j) { f32x4 a = (f32x4){0.f, 0.f, 0.f, 0.f};
#pragma unroll
                for (int q = 0; q < 4; ++q) { const unsigned y = yv[rr][j][q]; const f32x2 lo = __builtin_amdgcn_cvt_pk_f32_fp8((int)y, false), hi = __builtin_amdgcn_cvt_pk_f32_fp8((int)y, true); a += (f32x4){lo.x, lo.y, hi.x, hi.y}; }
                const u32x2 hb = hv[rr][j]; h[rr][j] = (f32x4){bflo(hb.x), bfhi(hb.x), bflo(hb.y), bfhi(hb.y)} + g2v[j] * a; s += (h[rr][j].x * h[rr][j].x + h[rr][j].y * h[rr][j].y) + (h[rr][j].z * h[rr][j].z + h[rr][j].w * h[rr][j].w); }
            rstd[rr] = 1.0f / sqrtf(wave_sum(s) * (1.0f / D) + 1e-6f); }
#pragma unroll
        for (int rr = 0; rr < 2; ++rr) { float* xr = O + (size_t)(m0 + rr) * D;
#pragma unroll
            for (int j = 0; j < 8; ++j) { const int k = 4 * lane + 256 * j; *(GAS f32x4*)(xr + k) = h[rr][j] * rstd[rr] * fgv[j]; } }
    }
}

__global__ void __launch_bounds__(NTHR, 2) fwd(Args args) {
    extern __shared__ __attribute__((aligned(16))) unsigned char lds_raw[];
    Frame F;
    F.lds = (LAS unsigned char*)lds_raw;
    F.tid = threadIdx.x; F.lane = F.tid & 63; F.wave = __builtin_amdgcn_readfirstlane(F.tid >> 6);
    F.G = gridDim.x; F.bx = blockIdx.x; F.in = args.in; F.out = args.out; F.ws = args.ws; F.ctl = (GAS unsigned*)(args.ws + WS_CTL);
    for (int u = F.tid; u < (LDS_BYTES - MISC_OFF) / 4; u += NTHR) ((LAS unsigned*)(F.lds + MISC_OFF))[u] = 0u;
    __syncthreads();
    const int lo = args.ph_lo, hi = args.ph_hi;
    XcdBarrier bar; bar.bar = (unsigned*)(F.ctl + CW_BAR); bar.x = 0; bar.st = nullptr;
    if (hi - lo > 1) bar = xcd_barrier_post((unsigned*)(F.ctl + CW_BAR), (volatile LAS unsigned*)(F.lds + MISC_OFF));
#ifndef PH_MASK
#define PH_MASK 0xffff
#endif
#define IN(k) (((PH_MASK >> (k)) & 1) && lo <= (k) && (k) < hi)
#define SEAM(k) do { if (IN(k) && IN((k) + 1)) xcd_barrier(bar); } while (0)
    unsigned char* ws = args.ws;
#ifndef PROBE_DUP
#define PROBE_DUP 0
#endif
#define DUPBAR(k) if ((PROBE_DUP >> (k)) & 1) xcd_barrier(bar)
#define DUP2(k, body) do { body; if ((PROBE_DUP >> (k)) & 1) { xcd_barrier(bar); body; } } while (0)
    if (IN(0)) { DUP2(0, p0_prologue(F)); }
    if (IN(1)) { seam_wait(F, CW_P0); DUP2(1, p1_norm(F)); } SEAM(1);
    if (IN(2)) { {
        const int GW = (F.G == 256) ? 192 : F.G; const int nr = ((PROBE_DUP >> 2) & 1) ? 2 : 1;
        if (F.bx < GW) {
            const int r1 = (128 * 4 + 8) % GW, r2 = (r1 + 128 * 16) % GW; const int c1 = F.bx, c2 = (F.bx - r1 + GW) % GW, c3 = (F.bx - r2 + GW) % GW;
            { SchedIn S{GW, c1, 128 * 4, 4, 0, nr, (const char*)(ws + WS_U), (const char*)(ws + WS_WIN)}; EpiInA E{ws};
              pg8::gemm_phase<EpiInA, SchedIn>(F.lds, D, S, E); }
            { SchedIn S{GW, c2, 128 * 16, 16, 2, nr, (const char*)(ws + WS_U8), (const char*)(ws + WS_WIN8)}; EpiInG8 E{(unsigned char*)(ws + WS_UG)};
              pg8::gemm_phase<EpiInG8, SchedIn>(F.lds, D, S, E); }
            { SchedIn S{GW, c3, 128 * 12, 12, 1, nr, (const char*)(ws + WS_U), (const char*)(ws + WS_WIN)}; EpiInH E{(bf16*)(ws + WS_UH)};
              pg8::gemm_phase<EpiInH, SchedIn>(F.lds, D, S, E); }
        }
        moe_weight_queue(F);
        }
    } SEAM(2);
    if (IN(3)) { DUP2(3, s5_pass3<false>(F)); p3_publish(F); }
    if (IN(4)) { int q4w = CW_Q4; DUP2(4, (p4_hyena_carry(F, q4w), q4w += 16)); } SEAM(4);
    if (IN(5)) { DUP2(5, s5_pass3<true>(F)); __syncthreads(); DUP2(14, yh_transpose(F)); } SEAM(5);
    if (IN(6)) { { SchedStd S{F.G, F.bx, 4, 1024, ((PROBE_DUP >> 6) & 1) ? 2 : 1, (const char*)(ws + WS_Y), (const char*)(ws + WS_WGLU)}; EpiMix<0> E{(const bf16*)(ws + WS_Y), nullptr, (bf16*)(ws + WS_YA)};
        pg8::gemm_phase<EpiMix<0>, SchedStd>(F.lds, 1024, S, E); } } SEAM(6);
    if (IN(7)) { { SchedStd S{F.G, F.bx, 8, 1024, ((PROBE_DUP >> 7) & 1) ? 2 : 1, (const char*)(ws + WS_YA), (const char*)(ws + WS_WBS5)}; EpiMix<1> E{(const bf16*)(ws + WS_UG), nullptr, (bf16*)(ws + WS_T1)};
        pg8::gemm_phase<EpiMix<1>, SchedStd>(F.lds, 1024, S, E); } }
    if (!(IN(7) && IN(8))) { SEAM(7); }
    if (IN(8)) { { SchedStd S{F.G, F.bx, 8, 1024, ((PROBE_DUP >> 8) & 1) ? 2 : 1, (const char*)(ws + WS_YH), (const char*)(ws + WS_WBHY)}; EpiMix<2> E{(const bf16*)(ws + WS_UG), (const bf16*)(ws + WS_T1), (bf16*)(ws + WS_T)};
        pg8::gemm_phase<EpiMix<2>, SchedStd>(F.lds, 1024, S, E); } } SEAM(8);
    if (IN(9)) { { SchedStd S{F.G, F.bx, 8, 2048, ((PROBE_DUP >> 9) & 1) ? 2 : 1, (const char*)(ws + WS_T), (const char*)(ws + WS_WO), 1}; EpiOut E{F.in[IN_X], (const float*)(ws + WS_MOD), (bf16*)(ws + WS_H1)};
        pg8::gemm_phase<EpiOut, SchedStd>(F.lds, 2048, S, E); } } SEAM(9);
    if (IN(10)) { p10_router(F); } SEAM(10);
    if (IN(11)) { { moe_tables(F); volatile LAS int* tb = (volatile LAS int*)(F.lds + LDS_X);
        SchedMoe<true> S{F.G, F.bx, 16, 4096, 2048, ((PROBE_DUP >> 11) & 1) ? 2 : 1, (const char*)(ws + WS_HM8), (const char*)(ws + WS_WGU), (const int*)(ws + WS_LIST), tb}; EpiMoe1 E{F.in[IN_BGU], (unsigned char*)(ws + WS_ACT)};
        pg8::gemm_phase<EpiMoe1, SchedMoe<true>>(F.lds, 2048, S, E); } } SEAM(11);
    if (IN(12)) { { moe_tables(F); volatile LAS int* tb = (volatile LAS int*)(F.lds + LDS_X);
        SchedMoe<false> S{F.G, F.bx, 8, 2048, 2048, ((PROBE_DUP >> 12) & 1) ? 2 : 1, (const char*)(ws + WS_ACT), (const char*)(ws + WS_WDN), (const int*)(ws + WS_LIST), tb}; EpiMoe2 E{F.in[IN_BDN], (const float*)(ws + WS_GATE), (const int*)(ws + WS_LIST), (unsigned char*)(ws + WS_YS), tb};
        pg8::gemm_phase<EpiMoe2, SchedMoe<false>>(F.lds, 2048, S, E); } } SEAM(12);
    if (IN(13)) { DUP2(13, p13_final(F)); }
#undef IN
#undef SEAM
}

extern "C" void kernel_launch(void* const* d_in, const int* in_sizes, int n_in, void* d_out, int out_size, void* d_ws, size_t ws_size, hipStream_t stream) {
    static int grid = 0;
    if (grid == 0) {
        if (n_in != 39 || out_size != NTOK * D || ws_size < WS_END) { fprintf(stderr, "kernel_launch: unexpected shapes: n_in %d out %d ws %zu (need %zu)\n", n_in, out_size, ws_size, (size_t)WS_END); grid = -1; return; }
        int dev = 0, cus = 0, per_cu = 0;
        if (hipGetDevice(&dev) != hipSuccess || hipDeviceGetAttribute(&cus, hipDeviceAttributeMultiprocessorCount, dev) != hipSuccess) { grid = -1; return; }
        if (hipFuncSetAttribute((const void*)fwd, hipFuncAttributeMaxDynamicSharedMemorySize, LDS_BYTES) != hipSuccess) { fprintf(stderr, "kernel_launch: hipFuncSetAttribute failed\n"); grid = -1; return; }
        if (hipOccupancyMaxActiveBlocksPerMultiprocessor(&per_cu, (const void*)fwd, NTHR, LDS_BYTES) != hipSuccess || per_cu < 1) fprintf(stderr, "kernel_launch: occupancy query says %d\n", per_cu);
        (void)hipGetLastError();
        grid = cus;
    }
    if (grid < 0) return;
    if (hipMemsetAsync((char*)d_ws + WS_CTL, 0, CTL_ZERO_BYTES, stream) != hipSuccess) return;
    Args a{};
    for (int i = 0; i < 39; ++i) a.in[i] = (const float*)d_in[i];
    a.out = (float*)d_out; a.ws = (unsigned char*)d_ws;
#ifndef ONE_LAUNCH
#define ONE_LAUNCH 1
#endif
    if (ONE_LAUNCH) { a.ph_lo = 0; a.ph_hi = NPHASE; hipLaunchKernelGGL(fwd, dim3(grid), dim3(NTHR), LDS_BYTES, stream, a); }
    else for (int p = 0; p < NPHASE; ++p) { a.ph_lo = p; a.ph_hi = p + 1; hipLaunchKernelGGL(fwd, dim3(grid), dim3(NTHR), LDS_BYTES, stream, a); }
}
```
